# Optimizing an MI355X kernel written in HIP

```python
import jax, jax.numpy as jnp
from jax import lax
import numpy as np

D_MODEL = 1024
BATCH = 8
SEQ = 2048
DEPTH = 4

GRID_W = 64
CTX_LEN = 256
A_HEADS = 8
A_KV_HEADS = 2
A_HEAD_DIM = 64
ROPE_THETA = 10000.0
Q_BLOCK = 128
B_HEADS = 4
B_HEAD_DIM = 128
B_CHUNK = 128
B_CONV = 3
POOL_WINDOWS = (2, 4, 8, 16)
POOL_GROUP = D_MODEL // 4
N_EXPERTS = 16
EC_FACTOR = 2
D_EXPERT = 1024
NORM_EPS = 1e-6

A_Q = A_HEADS * A_HEAD_DIM
A_KV = A_KV_HEADS * A_HEAD_DIM
B_W = B_HEADS * B_HEAD_DIM
N_GATES = 2 * 2 * B_HEADS
EVEN_IN = A_Q + 2 * A_KV + 4 * B_W + N_GATES
MIX_W = A_Q + B_W
EVEN_SPLITS = (A_Q, A_Q + A_KV, A_Q + 2 * A_KV, A_Q + 2 * A_KV + B_W, A_Q + 2 * A_KV + 2 * B_W,
               A_Q + 2 * A_KV + 3 * B_W, A_Q + 2 * A_KV + 4 * B_W)
N_EVEN = (DEPTH + 1) // 2
N_ODD = DEPTH // 2

kernel_name = "hybrid_diffusion_gqa_mlstm_pool_ecmoe"


def rmsnorm(x, g):
    xf = x.astype(jnp.float32)
    y = xf * lax.rsqrt(jnp.mean(xf * xf, axis=-1, keepdims=True) + NORM_EPS)
    return (y * g.astype(jnp.float32)).astype(x.dtype)


def adaln(cond, w, b):
    m = jax.nn.silu(cond) @ w + b
    return m.reshape(cond.shape[:-1] + (1, 6, D_MODEL))


def modulate(x, g, shift, scale):
    return rmsnorm(x, g) * (1 + scale) + shift


def axial_rope(n_tokens):
    rows = n_tokens // GRID_W
    row_ids = jnp.repeat(jnp.arange(rows, dtype=jnp.float32), GRID_W)
    col_ids = jnp.tile(jnp.arange(GRID_W, dtype=jnp.float32), rows)
    half = A_HEAD_DIM // 2
    inv = ROPE_THETA ** (-jnp.arange(0, half, 2, dtype=jnp.float32) / half)
    ang = jnp.stack([row_ids[:, None] * inv, col_ids[:, None] * inv], axis=1)
    return jnp.cos(ang), jnp.sin(ang)


def apply_rope(x, cos, sin):
    Bn, n, H, d = x.shape
    xr = x.reshape(Bn, n, H, 2, 2, d // 4)
    x1, x2 = xr[..., 0, :], xr[..., 1, :]
    c = cos[None, :, None].astype(x.dtype)
    s = sin[None, :, None].astype(x.dtype)
    return jnp.stack([x1 * c - x2 * s, x2 * c + x1 * s], axis=-2).reshape(x.shape)


def attend_blocks(q, k, v):
    Bn, Lq, _, d = q.shape
    G = A_HEADS // A_KV_HEADS
    nb = Lq // Q_BLOCK
    qb = q.reshape(Bn, nb, Q_BLOCK, A_KV_HEADS, G, d).transpose(1, 0, 3, 4, 2, 5)
    kt = jnp.swapaxes(k, 1, 2)
    vt = jnp.swapaxes(v, 1, 2)
    scale = d ** -0.5

    def one_block(qblk):
        s = jnp.einsum('bhgtd,bhsd->bhgts', qblk, kt).astype(jnp.float32) * scale
        p = jax.nn.softmax(s, axis=-1).astype(vt.dtype)
        return jnp.einsum('bhgts,bhsd->bhgtd', p, vt)

    o = lax.map(one_block, qb)
    return o.transpose(1, 0, 4, 2, 3, 5).reshape(Bn, Lq, A_HEADS * d)


def short_conv(x, w):
    n = x.shape[1]
    pad = B_CONV // 2
    xp = jnp.pad(x, ((0, 0), (pad, B_CONV - 1 - pad), (0, 0)))
    return sum(xp[:, j:j + n] * w[j] for j in range(B_CONV))


def mlstm_zero_state(Bn):
    return (jnp.zeros((Bn, B_HEADS, B_HEAD_DIM, B_HEAD_DIM), jnp.float32),
            jnp.zeros((Bn, B_HEADS, B_HEAD_DIM), jnp.float32),
            jnp.full((Bn, B_HEADS), -1e30, jnp.float32))


def mlstm_scan(q, k, v, ig, lf, state):
    Bn, H, L, d = q.shape
    nc = L // B_CHUNK
    k = k * (d ** -0.5)

    def to_chunks(a):
        a = a.reshape(a.shape[:2] + (nc, B_CHUNK) + a.shape[3:])
        return jnp.moveaxis(a, 2, 0)

    tril = jnp.tril(jnp.ones((B_CHUNK, B_CHUNK), dtype=bool))

    def step(carry, inp):
        C, n, m = carry
        qc, kc, vc, ic, fc = inp
        b = jnp.cumsum(fc, axis=-1)
        log_d = jnp.where(tril, b[..., :, None] - b[..., None, :] + ic[..., None, :], -jnp.inf)
        log_inter = m[..., None] + b
        m_t = jnp.maximum(log_inter, jnp.max(log_d, axis=-1))
        w_intra = jnp.exp(log_d - m_t[..., None]) * jnp.einsum('bhtd,bhsd->bhts', qc, kc)
        w_inter = jnp.exp(log_inter - m_t)
        num = (w_inter[..., None] * jnp.einsum('bhed,bhtd->bhte', C, qc)
               + jnp.einsum('bhts,bhse->bhte', w_intra, vc))
        den = w_inter * jnp.einsum('bhd,bhtd->bht', n, qc) + jnp.sum(w_intra, axis=-1)
        h = num / jnp.maximum(jnp.abs(den), jnp.exp(-m_t))[..., None]
        b_end = b[..., -1]
        log_w = b_end[..., None] - b + ic
        m_new = jnp.maximum(m + b_end, jnp.max(log_w, axis=-1))
        w_s = jnp.exp(log_w - m_new[..., None])
        decay = jnp.exp(m + b_end - m_new)
        C = decay[..., None, None] * C + jnp.einsum('bhs,bhse,bhsd->bhed', w_s, vc, kc)
        n = decay[..., None] * n + jnp.einsum('bhs,bhsd->bhd', w_s, kc)
        return (C, n, m_new), h

    state, h = lax.scan(step, state, tuple(to_chunks(a) for a in (q, k, v, ig, lf)))
    h = jnp.moveaxis(h, 0, 2).reshape(Bn, H, L, d)
    return h, state


def mlstm_bidir(q, k, v, ig, lf, states):
    h_f, s_f = mlstm_scan(q, k, v, ig[0], lf[0], states[0])
    flip = lambda a: jnp.flip(a, axis=2)
    h_b, s_b = mlstm_scan(flip(q), flip(k), flip(v), flip(ig[1]), flip(lf[1]), states[1])
    return h_f + flip(h_b), (s_f, s_b)


def even_mixer(h_lat, h_ctx, ctx_out, w_in, w_out, g_qn, g_kn, w_conv, b_gate, g_hn):
    Bn, L, _ = h_lat.shape

    def project(h):
        n = h.shape[1]
        qa, ka, va, qb, kb, vb, ob, gt = jnp.split(h @ w_in, EVEN_SPLITS, axis=-1)
        qa = rmsnorm(qa.reshape(Bn, n, A_HEADS, A_HEAD_DIM), g_qn)
        ka = rmsnorm(ka.reshape(Bn, n, A_KV_HEADS, A_HEAD_DIM), g_kn)
        va = va.reshape(Bn, n, A_KV_HEADS, A_HEAD_DIM)
        qk = jax.nn.silu(short_conv(jnp.concatenate([qb, kb], axis=-1), w_conv))
        to_heads = lambda a: a.reshape(Bn, n, B_HEADS, B_HEAD_DIM).transpose(0, 2, 1, 3).astype(jnp.float32)
        qm, km, vm = to_heads(qk[..., :B_W]), to_heads(qk[..., B_W:]), to_heads(vb)
        g = (gt + b_gate).astype(jnp.float32).reshape(Bn, n, 2, 2, B_HEADS).transpose(2, 3, 0, 4, 1)
        ig = g[:, 0]
        lf = jax.nn.log_sigmoid(g[:, 1])
        return (qa, ka, va), (qm, km, vm, ig, lf), ob

    def mlstm_out(hm, ob):
        n = hm.shape[2]
        hm = rmsnorm(jnp.swapaxes(hm, 1, 2), g_hn.reshape(B_HEADS, B_HEAD_DIM))
        return hm.reshape(Bn, n, B_W).astype(ob.dtype) * jax.nn.sigmoid(ob)

    (qa_c, ka_c, va_c), mc, ob_c = project(h_ctx)
    (qa_l, ka_l, va_l), ml, ob_l = project(h_lat)
    cos, sin = axial_rope(L)
    qa_l = apply_rope(qa_l, cos, sin)
    ka_l = apply_rope(ka_l, cos, sin)
    o_a = attend_blocks(qa_l, jnp.concatenate([ka_c, ka_l], axis=1), jnp.concatenate([va_c, va_l], axis=1))
    st0 = mlstm_zero_state(Bn)
    h_c, ctx_states = mlstm_bidir(*mc, (st0, st0))
    h_l, _ = mlstm_bidir(*ml, ctx_states)
    y = jnp.concatenate([o_a, mlstm_out(h_l, ob_l)], axis=-1) @ w_out
    yc = None
    if ctx_out:
        yc = jnp.concatenate([attend_blocks(qa_c, ka_c, va_c), mlstm_out(h_c, ob_c)], axis=-1) @ w_out
    return y, yc


def pool_mixer(h, w_in, w_grp, s_pool):
    Bn, n, _ = h.shape
    u = h @ w_in
    uf = u.astype(jnp.float32)
    S = jnp.pad(jnp.cumsum(uf, axis=1), ((0, 0), (1, 0), (0, 0)))
    t = jnp.arange(n)
    outs = []
    for gi, w in enumerate(POOL_WINDOWS):
        lo = w // 2
        hi = w - 1 - lo
        a = jnp.clip(t - lo, 0, n - 1)
        e = jnp.clip(t + hi, 0, n - 1)
        Sg = S[:, :, gi * POOL_GROUP:(gi + 1) * POOL_GROUP]
        cnt = (e - a + 1).astype(jnp.float32)[None, :, None]
        outs.append((Sg[:, e + 1] - Sg[:, a]) / cnt - uf[:, :, gi * POOL_GROUP:(gi + 1) * POOL_GROUP])
    p = jnp.stack(outs, axis=2).astype(u.dtype)
    y = jnp.einsum('bngc,gce->bnge', p, w_grp).reshape(Bn, n, D_MODEL)
    return y * s_pool


def ec_moe(h, w_router, w_gate, w_up, w_down):
    Bn, n, Dm = h.shape
    cap = max(1, EC_FACTOR * n // N_EXPERTS)
    aff = jax.nn.softmax(jnp.einsum('bnd,de->bne', h, w_router).astype(jnp.float32), axis=-1)
    gate, idx = lax.top_k(jnp.swapaxes(aff, 1, 2), cap)
    xs = jax.vmap(lambda hb, ib: hb[ib])(h, idx)
    a = jax.nn.silu(jnp.einsum('becd,edf->becf', xs, w_gate)) * jnp.einsum('becd,edf->becf', xs, w_up)
    out = jnp.einsum('becf,efd->becd', a, w_down) * gate[..., None].astype(h.dtype)
    return jax.vmap(lambda ob, ib: jnp.zeros((n, Dm), ob.dtype).at[ib.reshape(-1)].add(ob.reshape(-1, Dm)))(out, idx)


def setup_inputs(seed: int = 0) -> dict:
    key = jax.random.key(seed)
    ks = jax.random.split(key, 23)
    nrm = lambda k, shape, s: s * jax.random.normal(k, shape, jnp.float32)
    fb = jnp.linspace(3.0, 6.0, B_HEADS)
    gate_base = jnp.concatenate([jnp.zeros((B_HEADS,)), fb, jnp.zeros((B_HEADS,)), fb])
    return {
        "x": nrm(ks[0], (BATCH, SEQ, D_MODEL), 1.0),
        "c": nrm(ks[1], (BATCH, D_MODEL), 1.0),
        "ctx": nrm(ks[2], (BATCH, CTX_LEN, D_MODEL), 1.0),
        "c_ctx": nrm(ks[3], (D_MODEL,), 1.0),
        "w_mod": nrm(ks[4], (DEPTH, D_MODEL, 6 * D_MODEL), 0.5 * D_MODEL ** -0.5),
        "b_mod": nrm(ks[5], (DEPTH, 6 * D_MODEL), 0.02),
        "g_norm1": 1.0 + nrm(ks[6], (DEPTH, D_MODEL), 0.02),
        "g_norm2": 1.0 + nrm(ks[7], (DEPTH, D_MODEL), 0.02),
        "w_in_even": nrm(ks[8], (N_EVEN, D_MODEL, EVEN_IN), D_MODEL ** -0.5),
        "w_out_even": nrm(ks[9], (N_EVEN, MIX_W, D_MODEL), MIX_W ** -0.5),
        "g_qnorm": 1.0 + nrm(ks[10], (N_EVEN, A_HEAD_DIM), 0.02),
        "g_knorm": 1.0 + nrm(ks[11], (N_EVEN, A_HEAD_DIM), 0.02),
        "w_conv": nrm(ks[12], (N_EVEN, B_CONV, 2 * B_W), B_CONV ** -0.5),
        "b_gate": gate_base[None] + nrm(ks[13], (N_EVEN, N_GATES), 0.1),
        "g_hnorm": 1.0 + nrm(ks[14], (N_EVEN, B_W), 0.02),
        "w_in_odd": nrm(ks[15], (N_ODD, D_MODEL, D_MODEL), D_MODEL ** -0.5),
        "w_pool_grp": nrm(ks[16], (N_ODD, 4, POOL_GROUP, POOL_GROUP), POOL_GROUP ** -0.5),
        "s_pool": 1.0 + nrm(ks[17], (N_ODD, D_MODEL), 0.1),
        "w_router": nrm(ks[18], (DEPTH, D_MODEL, N_EXPERTS), D_MODEL ** -0.5),
        "w_exp_gate": nrm(ks[19], (DEPTH, N_EXPERTS, D_MODEL, D_EXPERT), D_MODEL ** -0.5),
        "w_exp_up": nrm(ks[20], (DEPTH, N_EXPERTS, D_MODEL, D_EXPERT), D_MODEL ** -0.5),
        "w_exp_down": nrm(ks[21], (DEPTH, N_EXPERTS, D_EXPERT, D_MODEL), D_EXPERT ** -0.5),
        "g_final": 1.0 + nrm(ks[22], (D_MODEL,), 0.02),
    }


def reference(x, c, ctx, c_ctx, w_mod, b_mod, g_norm1, g_norm2, w_in_even, w_out_even, g_qnorm, g_knorm,
              w_conv, b_gate, g_hnorm, w_in_odd, w_pool_grp, s_pool, w_router, w_exp_gate, w_exp_up,
              w_exp_down, g_final):
    xc = ctx
    for i in range(DEPTH):
        ctx_next = any(j % 2 == 0 for j in range(i + 1, DEPTH))
        ctx_used = (i % 2 == 0) or ctx_next
        m_lat = adaln(c, w_mod[i], b_mod[i])
        h = modulate(x, g_norm1[i], m_lat[..., 0, :], m_lat[..., 1, :])
        yc = None
        if ctx_used:
            m_ctx = adaln(c_ctx, w_mod[i], b_mod[i])
            hc = modulate(xc, g_norm1[i], m_ctx[..., 0, :], m_ctx[..., 1, :])
        if i % 2 == 0:
            e = i // 2
            y, yc = even_mixer(h, hc, ctx_next, w_in_even[e], w_out_even[e], g_qnorm[e], g_knorm[e],
                               w_conv[e], b_gate[e], g_hnorm[e])
        else:
            o = i // 2
            y = pool_mixer(h, w_in_odd[o], w_pool_grp[o], s_pool[o])
            if ctx_next:
                yc = pool_mixer(hc, w_in_odd[o], w_pool_grp[o], s_pool[o])
        x = x + m_lat[..., 2, :] * y
        h = modulate(x, g_norm2[i], m_lat[..., 3, :], m_lat[..., 4, :])
        x = x + m_lat[..., 5, :] * ec_moe(h, w_router[i], w_exp_gate[i], w_exp_up[i], w_exp_down[i])
        if ctx_next:
            xc = xc + m_ctx[..., 2, :] * yc
            hc = modulate(xc, g_norm2[i], m_ctx[..., 3, :], m_ctx[..., 4, :])
            xc = xc + m_ctx[..., 5, :] * ec_moe(hc, w_router[i], w_exp_gate[i], w_exp_up[i], w_exp_down[i])
    return rmsnorm(x, g_final)
```

```cpp
#include <hip/hip_runtime.h>
#include <math.h>
#include <stdio.h>

#define DM 1024
#define NB 8
#define SEQ 2048
#define CTXL 256
#define NL (NB * SEQ)
#define NC (NB * CTXL)
#define NT (NL + NC)
#define EVEN_IN 2832
#define NEXP 16
#define MOE_L (NEXP * NB * 256)
#define MOE_C (NEXP * NB * 32)
#define MOE_T (MOE_L + MOE_C)
#define EPS 1e-6f

struct Params {
  const float *x, *c, *ctx, *c_ctx, *w_mod, *b_mod, *g_norm1, *g_norm2, *w_in_even, *w_out_even, *g_qnorm, *g_knorm,
      *w_conv, *b_gate, *g_hnorm, *w_in_odd, *w_pool_grp, *s_pool, *w_router, *w_exp_gate, *w_exp_up, *w_exp_down, *g_final;
  float* out;
  float *xcur, *mod, *hbuf, *proj, *qa, *ka, *qm, *km, *gates, *hmF, *hmB, *mix, *aff, *Abuf, *Ybuf, *gatev;
  int *rowidx, *slotmap;
};

__device__ __forceinline__ float siluf(float v) { return v / (1.f + expf(-v)); }
__device__ __forceinline__ float sigmoidf_(float v) { return 1.f / (1.f + expf(-v)); }
__device__ __forceinline__ float logsigmoidf_(float v) { return fminf(v, 0.f) - log1pf(expf(-fabsf(v))); }
__device__ __forceinline__ float wave_sum(float v) {
#pragma unroll
  for (int o = 32; o > 0; o >>= 1) v += __shfl_xor(v, o);
  return v;
}
__device__ __forceinline__ int modrow(int r) { return r < NL ? (r >> 11) : 8; }

__device__ void ph_init(const Params& p, float* sm) {
  const size_t gtid = (size_t)blockIdx.x * 256 + threadIdx.x, gsz = (size_t)gridDim.x * 256;
  for (size_t i = gtid; i < (size_t)NL * DM / 4; i += gsz) ((float4*)p.xcur)[i] = ((const float4*)p.x)[i];
  for (size_t i = gtid; i < (size_t)NC * DM / 4; i += gsz) ((float4*)(p.xcur + (size_t)NL * DM))[i] = ((const float4*)p.ctx)[i];
  for (int i = threadIdx.x; i < 9 * 1024; i += 256) {
    int r = i >> 10, k = i & 1023;
    float v = r < 8 ? p.c[r * 1024 + k] : p.c_ctx[k];
    sm[i] = siluf(v);
  }
  __syncthreads();
  for (size_t o = gtid; o < 4 * 6144; o += gsz) {
    int l = (int)(o / 6144), j = (int)(o % 6144);
    const float* w = p.w_mod + (size_t)l * 1024 * 6144 + j;
    float acc[9];
#pragma unroll
    for (int r = 0; r < 9; ++r) acc[r] = 0.f;
    for (int k = 0; k < 1024; ++k) {
      float wv = w[(size_t)k * 6144];
#pragma unroll
      for (int r = 0; r < 9; ++r) acc[r] += sm[r * 1024 + k] * wv;
    }
    float bv = p.b_mod[l * 6144 + j];
#pragma unroll
    for (int r = 0; r < 9; ++r) p.mod[(size_t)(l * 9 + r) * 6144 + j] = acc[r] + bv;
  }
  __syncthreads();
}

__device__ void ph_norm(const Params& p, int l, int which, int nrows, int ncomb, int lprev) {
  const int lane = threadIdx.x & 63;
  const int gw = (blockIdx.x * 256 + threadIdx.x) >> 6, nw = (gridDim.x * 256) >> 6;
  for (int r = gw; r < nrows; r += nw) {
    float* xr = p.xcur + (size_t)r * DM;
    float4 v[4];
#pragma unroll
    for (int i = 0; i < 4; ++i) v[i] = ((const float4*)xr)[i * 64 + lane];
    const int mr = modrow(r);
    if (r < ncomb) {
      float4 s[4];
#pragma unroll
      for (int i = 0; i < 4; ++i) s[i] = make_float4(0.f, 0.f, 0.f, 0.f);
      for (int e = 0; e < NEXP; ++e) {
        int sl = p.slotmap[r * 16 + e];
        if (sl >= 0) {
          size_t yrow;
          if (r < NL) yrow = (size_t)e * 2048 + (size_t)(r >> 11) * 256 + sl;
          else yrow = (size_t)MOE_L + (size_t)e * 256 + (size_t)((r - NL) >> 8) * 32 + sl;
          const float4* yp = (const float4*)(p.Ybuf + yrow * DM);
#pragma unroll
          for (int i = 0; i < 4; ++i) {
            float4 y = yp[i * 64 + lane];
            s[i].x += y.x; s[i].y += y.y; s[i].z += y.z; s[i].w += y.w;
          }
        }
      }
      const float4* g5 = (const float4*)(p.mod + (size_t)(lprev * 9 + mr) * 6144 + 5 * 1024);
#pragma unroll
      for (int i = 0; i < 4; ++i) {
        float4 g = g5[i * 64 + lane];
        v[i].x += g.x * s[i].x; v[i].y += g.y * s[i].y; v[i].z += g.z * s[i].z; v[i].w += g.w * s[i].w;
        ((float4*)xr)[i * 64 + lane] = v[i];
      }
    }
    float ss = 0.f;
#pragma unroll
    for (int i = 0; i < 4; ++i) ss += v[i].x * v[i].x + v[i].y * v[i].y + v[i].z * v[i].z + v[i].w * v[i].w;
    ss = wave_sum(ss);
    const float inv = rsqrtf(ss * (1.f / 1024.f) + EPS);
    if (which == 3) {
#pragma unroll
      for (int i = 0; i < 4; ++i) {
        float4 g = ((const float4*)p.g_final)[i * 64 + lane];
        float4 o = make_float4(v[i].x * inv * g.x, v[i].y * inv * g.y, v[i].z * inv * g.z, v[i].w * inv * g.w);
        ((float4*)(p.out + (size_t)r * DM))[i * 64 + lane] = o;
      }
      continue;
    }
    const float* gn = (which == 1 ? p.g_norm1 : p.g_norm2) + l * 1024;
    const float* mrow = p.mod + (size_t)(l * 9 + mr) * 6144;
    const float4* shp = (const float4*)(mrow + (which == 1 ? 0 : 3) * 1024);
    const float4* scp = (const float4*)(mrow + (which == 1 ? 1 : 4) * 1024);
    float4 h[4];
#pragma unroll
    for (int i = 0; i < 4; ++i) {
      float4 g = ((const float4*)gn)[i * 64 + lane];
      float4 sh = shp[i * 64 + lane], sc = scp[i * 64 + lane];
      h[i].x = v[i].x * inv * g.x * (1.f + sc.x) + sh.x;
      h[i].y = v[i].y * inv * g.y * (1.f + sc.y) + sh.y;
      h[i].z = v[i].z * inv * g.z * (1.f + sc.z) + sh.z;
      h[i].w = v[i].w * inv * g.w * (1.f + sc.w) + sh.w;
      ((float4*)(p.hbuf + (size_t)r * DM))[i * 64 + lane] = h[i];
    }
    if (which == 2) {
      float lg[16];
#pragma unroll
      for (int e = 0; e < 16; ++e) lg[e] = 0.f;
      const float* wr = p.w_router + (size_t)l * 1024 * 16;
#pragma unroll
      for (int i = 0; i < 4; ++i) {
        const int d0 = (i * 64 + lane) * 4;
        const float hv[4] = {h[i].x, h[i].y, h[i].z, h[i].w};
#pragma unroll
        for (int j = 0; j < 4; ++j) {
          const float4* wp = (const float4*)(wr + (size_t)(d0 + j) * 16);
#pragma unroll
          for (int q = 0; q < 4; ++q) {
            float4 w4 = wp[q];
            lg[q * 4 + 0] += hv[j] * w4.x; lg[q * 4 + 1] += hv[j] * w4.y; lg[q * 4 + 2] += hv[j] * w4.z; lg[q * 4 + 3] += hv[j] * w4.w;
          }
        }
      }
      float mx = -1e30f;
#pragma unroll
      for (int e = 0; e < 16; ++e) { lg[e] = wave_sum(lg[e]); mx = fmaxf(mx, lg[e]); }
      float sum = 0.f;
#pragma unroll
      for (int e = 0; e < 16; ++e) { lg[e] = expf(lg[e] - mx); sum += lg[e]; }
      const float is = 1.f / sum;
      float myv = 0.f;
#pragma unroll
      for (int e = 0; e < 16; ++e) if (lane == e) myv = lg[e] * is;
      if (lane < 16) p.aff[r * 16 + lane] = myv;
    }
  }
}

template <class ARow, class BFun, class Epi>
__device__ void gemm_naive(int M, int N, int K, int ldb, ARow arow, BFun bfun, Epi epi, float* sm) {
  float* As = sm;
  float* Bs = sm + 16 * 64;
  const int tid = threadIdx.x, ty = tid >> 4, tx = tid & 15;
  const int tilesN = (N + 63) / 64, tilesM = M / 64;
  for (int tile = blockIdx.x; tile < tilesM * tilesN; tile += gridDim.x) {
    const int m0 = (tile / tilesN) * 64, n0 = (tile % tilesN) * 64;
    const float* ap = arow(m0 + (tid >> 2), n0) + (tid & 3) * 4;
    const float* bp = bfun(m0, n0);
    const int bk = tid >> 4, bn = (tid & 15) * 4;
    const bool bok = (n0 + bn) < N;
    float acc[4][4];
#pragma unroll
    for (int i = 0; i < 4; ++i)
#pragma unroll
      for (int j = 0; j < 4; ++j) acc[i][j] = 0.f;
    for (int k0 = 0; k0 < K; k0 += 16) {
      float4 av = *(const float4*)(ap + k0);
      float4 bv = bok ? *(const float4*)(bp + (size_t)(k0 + bk) * ldb + bn) : make_float4(0.f, 0.f, 0.f, 0.f);
      __syncthreads();
      As[((tid & 3) * 4 + 0) * 64 + (tid >> 2)] = av.x;
      As[((tid & 3) * 4 + 1) * 64 + (tid >> 2)] = av.y;
      As[((tid & 3) * 4 + 2) * 64 + (tid >> 2)] = av.z;
      As[((tid & 3) * 4 + 3) * 64 + (tid >> 2)] = av.w;
      *(float4*)(Bs + bk * 64 + bn) = bv;
      __syncthreads();
#pragma unroll
      for (int kk = 0; kk < 16; ++kk) {
        float4 a4 = *(const float4*)(As + kk * 64 + ty * 4);
        float4 b4 = *(const float4*)(Bs + kk * 64 + tx * 4);
        const float a[4] = {a4.x, a4.y, a4.z, a4.w}, b[4] = {b4.x, b4.y, b4.z, b4.w};
#pragma unroll
        for (int i = 0; i < 4; ++i)
#pragma unroll
          for (int j = 0; j < 4; ++j) acc[i][j] += a[i] * b[j];
      }
    }
#pragma unroll
    for (int i = 0; i < 4; ++i)
#pragma unroll
      for (int j = 0; j < 4; ++j) {
        const int n = n0 + tx * 4 + j;
        if (n < N) epi(m0 + ty * 4 + i, n, acc[i][j]);
      }
  }
  __syncthreads();
}

__device__ void ph_post_even(const Params& p, int l) {
  const int e = l >> 1;
  const size_t gtid = (size_t)blockIdx.x * 256 + threadIdx.x, gsz = (size_t)gridDim.x * 256;
  for (size_t it = gtid; it < (size_t)NT * 10; it += gsz) {
    const int r = (int)(it / 10), hh = (int)(it % 10);
    const float* src; float* dst; const float* g;
    if (hh < 8) { src = p.proj + (size_t)r * EVEN_IN + hh * 64; dst = p.qa + (size_t)r * 512 + hh * 64; g = p.g_qnorm + e * 64; }
    else { src = p.proj + (size_t)r * EVEN_IN + 512 + (hh - 8) * 64; dst = p.ka + (size_t)r * 128 + (hh - 8) * 64; g = p.g_knorm + e * 64; }
    float ss = 0.f;
    for (int j = 0; j < 64; ++j) ss += src[j] * src[j];
    const float inv = rsqrtf(ss * (1.f / 64.f) + EPS);
    const bool lat = r < NL;
    const int t = r & 2047;
    for (int a = 0; a < 2; ++a)
      for (int i = 0; i < 16; ++i) {
        const int j1 = a * 32 + i, j2 = a * 32 + 16 + i;
        const float x1 = src[j1] * inv * g[j1], x2 = src[j2] * inv * g[j2];
        float o1 = x1, o2 = x2;
        if (lat) {
          const float pa = (a == 0) ? (float)(t >> 6) : (float)(t & 63);
          const float ang = pa * powf(10000.f, -(float)i / 16.f);
          float sn, cs;
          sincosf(ang, &sn, &cs);
          o1 = x1 * cs - x2 * sn;
          o2 = x2 * cs + x1 * sn;
        }
        dst[j1] = o1; dst[j2] = o2;
      }
  }
  const float* wc = p.w_conv + (size_t)e * 3 * 1024;
  for (size_t it = gtid; it < (size_t)NT * 1024; it += gsz) {
    const int r = (int)(it >> 10), ch = (int)(it & 1023);
    int t, n;
    if (r < NL) { t = r & 2047; n = 2048; } else { t = (r - NL) & 255; n = 256; }
    const float* s = p.proj + (size_t)r * EVEN_IN + 768 + ch;
    float v = wc[1024 + ch] * s[0];
    if (t > 0) v += wc[ch] * s[-EVEN_IN];
    if (t < n - 1) v += wc[2048 + ch] * s[EVEN_IN];
    v = siluf(v);
    if (ch < 512) p.qm[(size_t)r * 512 + ch] = v;
    else p.km[(size_t)r * 512 + ch - 512] = v * 0.08838834764831845f;
  }
  const float* bg = p.b_gate + e * 16;
  for (size_t it = gtid; it < (size_t)NT * 16; it += gsz) {
    const int r = (int)(it >> 4), j = (int)(it & 15);
    float v = p.proj[(size_t)r * EVEN_IN + 2816 + j] + bg[j];
    if ((j >> 2) & 1) v = logsigmoidf_(v);
    p.gates[it] = v;
  }
}

__device__ void ph_att_naive(const Params& p, bool ctx_q) {
  const size_t gtid = (size_t)blockIdx.x * 256 + threadIdx.x, gsz = (size_t)gridDim.x * 256;
  const int nq = ctx_q ? NT : NL;
  for (size_t gi = gtid; gi < (size_t)nq * 8; gi += gsz) {
    const int h = (int)(gi / nq), r = (int)(gi % nq), kv = h >> 2;
    int b, nk;
    if (r < NL) { b = r >> 11; nk = 256 + 2048; } else { b = (r - NL) >> 8; nk = 256; }
    float q[64], o[64];
#pragma unroll
    for (int d = 0; d < 64; ++d) { q[d] = p.qa[(size_t)r * 512 + h * 64 + d] * 0.125f; o[d] = 0.f; }
    float m = -1e30f, ls = 0.f;
    for (int j = 0; j < nk; ++j) {
      const int kr = j < 256 ? NL + b * 256 + j : b * 2048 + (j - 256);
      const float* kp = p.ka + (size_t)kr * 128 + kv * 64;
      const float* vp = p.proj + (size_t)kr * EVEN_IN + 640 + kv * 64;
      float s = 0.f;
#pragma unroll
      for (int d = 0; d < 64; ++d) s += q[d] * kp[d];
      const float mn = fmaxf(m, s), corr = expf(m - mn), pj = expf(s - mn);
      ls = ls * corr + pj;
#pragma unroll
      for (int d = 0; d < 64; ++d) o[d] = o[d] * corr + pj * vp[d];
      m = mn;
    }
    const float il = 1.f / ls;
#pragma unroll
    for (int d = 0; d < 64; ++d) p.mix[(size_t)r * 1024 + h * 64 + d] = o[d] * il;
  }
}

__device__ void ph_mlstm_naive(const Params& p, bool ctx_out, float* sm) {
  float* Cs = sm;
  float* Ss = Cs + 32 * 129;
  float* nv = Ss + 128 * 129;
  float* bb = nv + 128;
  float* ig = bb + 128;
  float* mt = ig + 128;
  float* den = mt + 128;
  float* wint = den + 128;
  float* wsv = wint + 128;
  int* rows = (int*)(wsv + 128);
  const int tid = threadIdx.x;
  for (int item = blockIdx.x; item < 256; item += gridDim.x) {
    const int chain = item >> 2, eq = item & 3;
    const int b = chain >> 3, hd = (chain >> 1) & 3, dir = chain & 1;
    float* hm = dir ? p.hmB : p.hmF;
    for (int i = tid; i < 32 * 129; i += 256) Cs[i] = 0.f;
    if (tid < 128) nv[tid] = 0.f;
    float m = -1e30f;
    __syncthreads();
    for (int c = 0; c < 18; ++c) {
      if (tid < 128) {
        const int pch = c * 128 + tid;
        int r;
        if (pch < 256) { const int t = dir ? 255 - pch : pch; r = NL + b * 256 + t; }
        else { const int q = pch - 256; const int t = dir ? 2047 - q : q; r = b * 2048 + t; }
        rows[tid] = r;
        ig[tid] = p.gates[(size_t)r * 16 + dir * 8 + hd];
        bb[tid] = p.gates[(size_t)r * 16 + dir * 8 + 4 + hd];
      }
      __syncthreads();
      float bt = 0.f;
      if (tid < 128) for (int u = 0; u <= tid; ++u) bt += bb[u];
      __syncthreads();
      if (tid < 128) bb[tid] = bt;
      __syncthreads();
      if (tid < 128) {
        float mx = m + bb[tid];
        for (int s = 0; s <= tid; ++s) mx = fmaxf(mx, bb[tid] - bb[s] + ig[s]);
        mt[tid] = mx;
        wint[tid] = expf(m + bb[tid] - mx);
      }
      __syncthreads();
      for (int idx = tid; idx < 128 * 128; idx += 256) {
        const int t = idx >> 7, s = idx & 127;
        float v = 0.f;
        if (s <= t) {
          const float* qp = p.qm + (size_t)rows[t] * 512 + hd * 128;
          const float* kp = p.km + (size_t)rows[s] * 512 + hd * 128;
          float acc = 0.f;
          for (int d = 0; d < 128; ++d) acc += qp[d] * kp[d];
          v = expf(bb[t] - bb[s] + ig[s] - mt[t]) * acc;
        }
        Ss[t * 129 + s] = v;
      }
      __syncthreads();
      if (tid < 128) {
        const float* qp = p.qm + (size_t)rows[tid] * 512 + hd * 128;
        float nq = 0.f;
        for (int d = 0; d < 128; ++d) nq += nv[d] * qp[d];
        float sw = 0.f;
        for (int s = 0; s <= tid; ++s) sw += Ss[tid * 129 + s];
        den[tid] = wint[tid] * nq + sw;
      }
      __syncthreads();
      if (c >= 2 || ctx_out) {
        for (int idx = tid; idx < 128 * 32; idx += 256) {
          const int t = idx >> 5, el = idx & 31, e = eq * 32 + el;
          const float* qp = p.qm + (size_t)rows[t] * 512 + hd * 128;
          float cq = 0.f;
          for (int d = 0; d < 128; ++d) cq += Cs[el * 129 + d] * qp[d];
          float iv = 0.f;
          for (int s = 0; s <= t; ++s) iv += Ss[t * 129 + s] * p.proj[(size_t)rows[s] * EVEN_IN + 1792 + hd * 128 + e];
          const float num = wint[t] * cq + iv;
          const float dn = fmaxf(fabsf(den[t]), expf(-mt[t]));
          hm[(size_t)rows[t] * 512 + hd * 128 + e] = num / dn;
        }
      }
      __syncthreads();
      const float bend = bb[127];
      float mx = m + bend;
      for (int s = 0; s < 128; ++s) mx = fmaxf(mx, bend - bb[s] + ig[s]);
      const float decay = expf(m + bend - mx);
      if (tid < 128) wsv[tid] = expf(bend - bb[tid] + ig[tid] - mx);
      __syncthreads();
      for (int idx = tid; idx < 32 * 128; idx += 256) {
        const int el = idx >> 7, d = idx & 127, e = eq * 32 + el;
        float acc = 0.f;
        for (int s = 0; s < 128; ++s)
          acc += wsv[s] * p.proj[(size_t)rows[s] * EVEN_IN + 1792 + hd * 128 + e] * p.km[(size_t)rows[s] * 512 + hd * 128 + d];
        Cs[el * 129 + d] = decay * Cs[el * 129 + d] + acc;
      }
      if (tid < 128) {
        float acc = 0.f;
        for (int s = 0; s < 128; ++s) acc += wsv[s] * p.km[(size_t)rows[s] * 512 + hd * 128 + tid];
        nv[tid] = decay * nv[tid] + acc;
      }
      m = mx;
      __syncthreads();
    }
  }
}

__device__ void ph_mlstm_out(const Params& p, int l, int nrows) {
  const int e = l >> 1;
  const int lane = threadIdx.x & 63;
  const int gw = (blockIdx.x * 256 + threadIdx.x) >> 6, nw = (gridDim.x * 256) >> 6;
  for (int it = gw; it < nrows * 4; it += nw) {
    const int r = it >> 2, hd = it & 3;
    const size_t o = (size_t)r * 512 + hd * 128;
    const float v0 = p.hmF[o + lane] + p.hmB[o + lane], v1 = p.hmF[o + 64 + lane] + p.hmB[o + 64 + lane];
    float ss = wave_sum(v0 * v0 + v1 * v1);
    const float inv = rsqrtf(ss * (1.f / 128.f) + EPS);
    const float* g = p.g_hnorm + e * 512 + hd * 128;
    const float* ob = p.proj + (size_t)r * EVEN_IN + 2304 + hd * 128;
    p.mix[(size_t)r * 1024 + 512 + hd * 128 + lane] = v0 * inv * g[lane] * sigmoidf_(ob[lane]);
    p.mix[(size_t)r * 1024 + 512 + hd * 128 + 64 + lane] = v1 * inv * g[64 + lane] * sigmoidf_(ob[64 + lane]);
  }
}

__device__ void ph_topk(const Params& p, bool ctx) {
  const size_t gtid = (size_t)blockIdx.x * 256 + threadIdx.x, gsz = (size_t)gridDim.x * 256;
  const size_t nlat = (size_t)NEXP * NL, nctx = ctx ? (size_t)NEXP * NC : 0;
  for (size_t it = gtid; it < nlat + nctx; it += gsz) {
    int e, r, base, n, cap;
    size_t mbase;
    if (it < nlat) {
      e = (int)(it / NL); r = (int)(it % NL); const int b = r >> 11; base = b * 2048; n = 2048; cap = 256;
      mbase = (size_t)e * 2048 + (size_t)b * 256;
    } else {
      const size_t i2 = it - nlat;
      e = (int)(i2 / NC); const int rc = (int)(i2 % NC); r = NL + rc; const int b = rc >> 8; base = NL + b * 256; n = 256; cap = 32;
      mbase = (size_t)MOE_L + (size_t)e * 256 + (size_t)b * 32;
    }
    const float v = p.aff[(size_t)r * 16 + e];
    const int i = r - base;
    int rank = 0;
    for (int j = 0; j < n; ++j) {
      const float u = p.aff[(size_t)(base + j) * 16 + e];
      rank += (u > v || (u == v && j < i)) ? 1 : 0;
    }
    if (rank < cap) {
      p.slotmap[(size_t)r * 16 + e] = rank;
      p.rowidx[mbase + rank] = r;
      p.gatev[mbase + rank] = v;
    } else p.slotmap[(size_t)r * 16 + e] = -1;
  }
}

__device__ void ph_pool(const Params& p, int nrows) {
  const size_t gtid = (size_t)blockIdx.x * 256 + threadIdx.x, gsz = (size_t)gridDim.x * 256;
  for (size_t it = gtid; it < (size_t)nrows * 1024; it += gsz) {
    const int r = (int)(it >> 10), c = (int)(it & 1023);
    int t, n, base;
    if (r < NL) { t = r & 2047; n = 2048; base = r - t; } else { t = (r - NL) & 255; n = 256; base = r - t; }
    const int w = 2 << (c >> 8), lo = w >> 1, hi = w - 1 - lo;
    const int a = max(t - lo, 0), en = min(t + hi, n - 1);
    float s = 0.f;
    for (int tt = a; tt <= en; ++tt) s += p.proj[(size_t)(base + tt) * 1024 + c];
    p.mix[it] = s / (float)(en - a + 1) - p.proj[it];
  }
}

enum { PH_INIT = 0, PH_NORM1, PH_GEMM_IN_EVEN, PH_POST_EVEN, PH_ATT, PH_MLSTM, PH_MLSTM_OUT, PH_GEMM_OUT, PH_NORM2, PH_TOPK,
       PH_MOE_G, PH_MOE_U, PH_MOE_D, PH_GEMM_IN_ODD, PH_POOL, PH_GEMM_GRP, PH_FINAL };

__global__ void __launch_bounds__(256) phase_kernel(Params p, int ph, int l) {
  extern __shared__ __attribute__((aligned(16))) float sm[];
  const bool ctx_next = (l < 2);
  const bool ctx_used = (l < 3);
  switch (ph) {
    case PH_INIT: ph_init(p, sm); break;
    case PH_NORM1: {
      const int ncomb = (l == 0) ? 0 : ((l - 1) < 2 ? NT : NL);
      ph_norm(p, l, 1, ctx_used ? NT : NL, ncomb, l - 1);
    } break;
    case PH_GEMM_IN_EVEN: {
      const float* B = p.w_in_even + (size_t)(l >> 1) * 1024 * EVEN_IN;
      gemm_naive(NT, EVEN_IN, 1024, EVEN_IN,
                 [&](int m, int) { return p.hbuf + (size_t)m * 1024; },
                 [&](int, int n0) { return B + n0; },
                 [&](int m, int n, float v) { p.proj[(size_t)m * EVEN_IN + n] = v; }, sm);
    } break;
    case PH_POST_EVEN: ph_post_even(p, l); break;
    case PH_ATT: ph_att_naive(p, ctx_next); break;
    case PH_MLSTM: ph_mlstm_naive(p, ctx_next, sm); break;
    case PH_MLSTM_OUT: ph_mlstm_out(p, l, ctx_next ? NT : NL); break;
    case PH_GEMM_OUT: {
      const float* B = p.w_out_even + (size_t)(l >> 1) * 1024 * 1024;
      gemm_naive(ctx_next ? NT : NL, 1024, 1024, 1024,
                 [&](int m, int) { return p.mix + (size_t)m * 1024; },
                 [&](int, int n0) { return B + n0; },
                 [&](int m, int n, float v) { p.xcur[(size_t)m * 1024 + n] += p.mod[(size_t)(l * 9 + modrow(m)) * 6144 + 2 * 1024 + n] * v; }, sm);
    } break;
    case PH_NORM2: ph_norm(p, l, 2, ctx_next ? NT : NL, 0, 0); break;
    case PH_TOPK: ph_topk(p, ctx_next); break;
    case PH_MOE_G:
    case PH_MOE_U: {
      const float* W = (ph == PH_MOE_G ? p.w_exp_gate : p.w_exp_up) + (size_t)l * NEXP * 1024 * 1024;
      const bool isU = ph == PH_MOE_U;
      gemm_naive(ctx_next ? MOE_T : MOE_L, 1024, 1024, 1024,
                 [&](int m, int) { return p.hbuf + (size_t)p.rowidx[m] * 1024; },
                 [&](int m0, int n0) { const int e = m0 < MOE_L ? (m0 >> 11) : ((m0 - MOE_L) >> 8); return W + (size_t)e * 1024 * 1024 + n0; },
                 [&](int m, int n, float v) {
                   float* a = p.Abuf + (size_t)m * 1024 + n;
                   if (isU) *a = siluf(*a) * v; else *a = v;
                 }, sm);
    } break;
    case PH_MOE_D: {
      const float* W = p.w_exp_down + (size_t)l * NEXP * 1024 * 1024;
      gemm_naive(ctx_next ? MOE_T : MOE_L, 1024, 1024, 1024,
                 [&](int m, int) { return p.Abuf + (size_t)m * 1024; },
                 [&](int m0, int n0) { const int e = m0 < MOE_L ? (m0 >> 11) : ((m0 - MOE_L) >> 8); return W + (size_t)e * 1024 * 1024 + n0; },
                 [&](int m, int n, float v) { p.Ybuf[(size_t)m * 1024 + n] = v * p.gatev[m]; }, sm);
    } break;
    case PH_GEMM_IN_ODD: {
      const float* B = p.w_in_odd + (size_t)(l >> 1) * 1024 * 1024;
      gemm_naive(ctx_next ? NT : NL, 1024, 1024, 1024,
                 [&](int m, int) { return p.hbuf + (size_t)m * 1024; },
                 [&](int, int n0) { return B + n0; },
                 [&](int m, int n, float v) { p.proj[(size_t)m * 1024 + n] = v; }, sm);
    } break;
    case PH_POOL: ph_pool(p, ctx_next ? NT : NL); break;
    case PH_GEMM_GRP: {
      const float* W = p.w_pool_grp + (size_t)(l >> 1) * 4 * 256 * 256;
      const float* sp = p.s_pool + (size_t)(l >> 1) * 1024;
      gemm_naive(ctx_next ? NT : NL, 1024, 256, 256,
                 [&](int m, int n0) { return p.mix + (size_t)m * 1024 + (n0 >> 8) * 256; },
                 [&](int, int n0) { return W + (size_t)(n0 >> 8) * 256 * 256 + (n0 & 255); },
                 [&](int m, int n, float v) { p.xcur[(size_t)m * 1024 + n] += p.mod[(size_t)(l * 9 + modrow(m)) * 6144 + 2 * 1024 + n] * v * sp[n]; }, sm);
    } break;
    case PH_FINAL: ph_norm(p, 3, 3, NL, NL, 3); break;
  }
}

extern "C" void kernel_launch(void* const* d_in, const int* in_sizes, int n_in, void* d_out, int out_size, void* d_ws, size_t ws_size,
                              hipStream_t stream) {
  Params p{};
  const float* const* in = (const float* const*)d_in;
  p.x = in[0]; p.c = in[1]; p.ctx = in[2]; p.c_ctx = in[3]; p.w_mod = in[4]; p.b_mod = in[5]; p.g_norm1 = in[6]; p.g_norm2 = in[7];
  p.w_in_even = in[8]; p.w_out_even = in[9]; p.g_qnorm = in[10]; p.g_knorm = in[11]; p.w_conv = in[12]; p.b_gate = in[13];
  p.g_hnorm = in[14]; p.w_in_odd = in[15]; p.w_pool_grp = in[16]; p.s_pool = in[17]; p.w_router = in[18]; p.w_exp_gate = in[19];
  p.w_exp_up = in[20]; p.w_exp_down = in[21]; p.g_final = in[22];
  p.out = (float*)d_out;
  float* w = (float*)d_ws;
  size_t off = 0;
  auto take = [&](size_t n) { float* r = w + off; off += (n + 63) & ~(size_t)63; return r; };
  p.xcur = take((size_t)NT * 1024);
  p.mod = take(4 * 9 * 6144);
  p.hbuf = take((size_t)NT * 1024);
  p.proj = take((size_t)NT * EVEN_IN);
  p.Abuf = p.proj;
  p.qa = take((size_t)NT * 512);
  p.ka = take((size_t)NT * 128);
  p.qm = take((size_t)NT * 512);
  p.km = take((size_t)NT * 512);
  p.gates = take((size_t)NT * 16);
  p.hmF = take((size_t)NT * 512);
  p.hmB = take((size_t)NT * 512);
  p.mix = take((size_t)NT * 1024);
  p.aff = take((size_t)NT * 16);
  p.Ybuf = take((size_t)MOE_T * 1024);
  p.gatev = take(MOE_T);
  p.rowidx = (int*)take(MOE_T);
  p.slotmap = (int*)take((size_t)NT * 16);
  if (off * 4 > ws_size) { fprintf(stderr, "ws too small: need %zu have %zu\n", off * 4, ws_size); return; }

  static bool attr_set = false;
  const int LDS = 96 * 1024;
  if (!attr_set) { hipFuncSetAttribute((const void*)phase_kernel, hipFuncAttributeMaxDynamicSharedMemorySize, LDS); attr_set = true; }
  auto run = [&](int ph, int l) { hipLaunchKernelGGL(phase_kernel, dim3(2048), dim3(256), LDS, stream, p, ph, l); };
  run(PH_INIT, 0);
  for (int l = 0; l < 4; ++l) {
    run(PH_NORM1, l);
    if ((l & 1) == 0) {
      run(PH_GEMM_IN_EVEN, l);
      run(PH_POST_EVEN, l);
      run(PH_ATT, l);
      run(PH_MLSTM, l);
      run(PH_MLSTM_OUT, l);
      run(PH_GEMM_OUT, l);
    } else {
      run(PH_GEMM_IN_ODD, l);
      run(PH_POOL, l);
      run(PH_GEMM_GRP, l);
    }
    run(PH_NORM2, l);
    run(PH_TOPK, l);
    run(PH_MOE_G, l);
    run(PH_MOE_U, l);
    run(PH_MOE_D, l);
  }
  run(PH_FINAL, 0);
}
```

```cpp
#include <hip/hip_runtime.h>
#include <hip/hip_cooperative_groups.h>
#include <math.h>
#include <stdio.h>
namespace cg = cooperative_groups;

#define DM 1024
#define NB 8
#define SEQ 2048
#define CTXL 256
#define NL (NB * SEQ)
#define NC (NB * CTXL)
#define NT (NL + NC)
#define EVEN_IN 2832
#define PROJW 2816
#define NEXP 16
#define MOE_L (NEXP * NB * 256)
#define MOE_C (NEXP * NB * 32)
#define MOE_T (MOE_L + MOE_C)
#define EPS 1e-6f
#define NTHR 512
#define LAS __attribute__((address_space(3)))

typedef unsigned short bf16_t;
typedef short bf16x8 __attribute__((ext_vector_type(8)));
typedef float f32x4 __attribute__((ext_vector_type(4)));
typedef unsigned u32x4 __attribute__((ext_vector_type(4)));
typedef unsigned u32x2 __attribute__((ext_vector_type(2)));

struct Params {
  const float *x, *c, *ctx, *c_ctx, *w_mod, *b_mod, *g_norm1, *g_norm2, *w_in_even, *w_out_even, *g_qnorm, *g_knorm,
      *w_conv, *b_gate, *g_hnorm, *w_in_odd, *w_pool_grp, *s_pool, *w_router, *w_exp_gate, *w_exp_up, *w_exp_down, *g_final;
  float* out;
  float *xcur, *mod, *gates, *aff, *gatev, *gsG, *gsR, *gsB, *cMIN, *cE1, *cDEC, *Ubuf, *NLb, *NVb;
  bf16_t *hbuf, *proj, *mix, *Xs, *Abuf, *Ybuf, *Qb, *Kb, *Vb, *qm, *km, *Cbf;
  bf16_t *WinE, *WoutE, *WinO, *Wgrp, *Wgu, *Wd;
  int *rowidx, *slotmap;
  unsigned* barw;
  int nprog;
  unsigned char prog_ph[60], prog_l[60];
};

__device__ __forceinline__ float siluf(float v) { return v / (1.f + expf(-v)); }
__device__ __forceinline__ float sigmoidf_(float v) { return 1.f / (1.f + expf(-v)); }
__device__ __forceinline__ float logsigmoidf_(float v) { return fminf(v, 0.f) - log1pf(expf(-fabsf(v))); }
__device__ __forceinline__ float wave_sum(float v) {
#pragma unroll
  for (int o = 32; o > 0; o >>= 1) v += __shfl_xor(v, o);
  return v;
}
__device__ __forceinline__ int modrow(int r) { return r < NL ? (r >> 11) : 8; }
__device__ __forceinline__ float bf2f(bf16_t v) { return __uint_as_float(((unsigned)v) << 16); }
typedef float f32x2_t __attribute__((ext_vector_type(2)));
typedef __bf16 bf16x2_t __attribute__((ext_vector_type(2)));
__device__ __forceinline__ unsigned cvt_pk_bf16(float lo, float hi) {
  const f32x2_t v = {lo, hi};
  return __builtin_bit_cast(unsigned, __builtin_convertvector(v, bf16x2_t));
}
__device__ __forceinline__ bf16_t f2bf(float f) { return (bf16_t)(cvt_pk_bf16(f, 0.f) & 0xffffu); }

__device__ __forceinline__ int ltid() { int t = threadIdx.x; asm volatile("" : "+v"(t)); return t; }
__device__ __forceinline__ int lbid() { int b = blockIdx.x; asm volatile("" : "+s"(b)); return b; }
__device__ __forceinline__ int lgdim() { int g = gridDim.x; asm volatile("" : "+s"(g)); return g; }

#define XB_TMO      128
#define XB_XCNT(j)  (256  + 64 * (j))
#define XB_XSUB(j)  (1280 + 64 * (j))
#define XB_XGEN(j)  (2304 + 64 * (j))
#define XB_TOP      3328
#define XB_TOPGEN   3392
#define XCD_BAR_WORDS 3456
#define XB_SPIN_CAP (1u << 18)
__device__ __forceinline__ unsigned xb_ld(unsigned* p)              { return __hip_atomic_load(p, __ATOMIC_RELAXED, __HIP_MEMORY_SCOPE_AGENT); }
__device__ __forceinline__ unsigned xb_add(unsigned* p, unsigned v) { return __hip_atomic_fetch_add(p, v, __ATOMIC_RELAXED, __HIP_MEMORY_SCOPE_AGENT); }
__device__ __forceinline__ unsigned xb_xcc_id() { return (unsigned)__builtin_amdgcn_s_getreg((3 << 11) | 20) & 0xFu; }
#define XB_SPIN(cond, bar) do { unsigned _sp = 0; while (cond) { __builtin_amdgcn_s_sleep(1); \
    if ((++_sp & 255u) == 0u) { if (xb_ld(&(bar)[XB_TMO])) break; if (_sp > XB_SPIN_CAP) { atomicAdd(&(bar)[XB_TMO], 1u); break; } } } } while (0)
struct XcdBarrier { unsigned* bar; unsigned x; volatile LAS unsigned* st; };
__device__ __forceinline__ XcdBarrier xcd_barrier_post(unsigned* bar, volatile LAS unsigned* st) {
  XcdBarrier b; b.bar = bar; b.x = xb_xcc_id(); b.st = st;
  if (threadIdx.x == 0) (void)xb_add(&bar[XB_XCNT(b.x)], 1u);
  return b;
}
__device__ __forceinline__ void xcd_barrier_complete(unsigned* bar, unsigned x, unsigned& nloc, unsigned& nx) {
  const unsigned G = gridDim.x * gridDim.y * gridDim.z;
  unsigned sum, cnt, mine, sp = 0u;
  for (;;) {
    sum = 0u; cnt = 0u; mine = 0u;
#pragma unroll
    for (unsigned j = 0; j < 16; ++j) { const unsigned c = xb_ld(&bar[XB_XCNT(j)]); sum += c; cnt += (c > 0u) ? 1u : 0u; mine = (j == x) ? c : mine; }
    if (sum == G) break;
    __builtin_amdgcn_s_sleep(1);
    if ((++sp & 255u) == 0u) { if (xb_ld(&bar[XB_TMO])) break; if (sp > XB_SPIN_CAP) { atomicAdd(&bar[XB_TMO], 1u); break; } }
  }
  nloc = mine > 0u ? mine : 1u; nx = cnt > 0u ? cnt : 1u;
}
__device__ __forceinline__ void xcd_barrier(const XcdBarrier& b) {
  asm volatile("s_waitcnt vmcnt(0)" ::: "memory");
  __syncthreads();
  if (threadIdx.x == 0) {
    unsigned* bar = b.bar;
    __builtin_amdgcn_s_waitcnt(0);
    unsigned nloc = b.st[0], nx = b.st[1];
    if (nloc == 0u) { xcd_barrier_complete(bar, b.x, nloc, nx); b.st[0] = nloc; b.st[1] = nx; }
    const unsigned old = xb_add(&bar[XB_XSUB(b.x)], 1u);
    const unsigned gen = old / nloc;
    if (old + 1u == (gen + 1u) * nloc) {
      __builtin_amdgcn_fence(__ATOMIC_RELEASE, "agent");
      asm volatile("s_waitcnt vmcnt(0)" ::: "memory");
      const unsigned og = xb_add(&bar[XB_TOP], 1u);
      const unsigned tg = og / nx;
      if (og + 1u == (tg + 1u) * nx) xb_add(&bar[XB_TOPGEN], 1u);
      else XB_SPIN(xb_ld(&bar[XB_TOPGEN]) == tg, bar);
      __builtin_amdgcn_fence(__ATOMIC_ACQUIRE, "agent");
      xb_add(&bar[XB_XGEN(b.x)], 1u);
      asm volatile("s_waitcnt vmcnt(0)" ::: "memory");
    } else {
      XB_SPIN(xb_ld(&bar[XB_XGEN(b.x)]) == gen, bar);
      __builtin_amdgcn_fence(__ATOMIC_ACQUIRE, "agent");
      asm volatile("s_waitcnt vmcnt(0)" ::: "memory");
    }
  }
  __syncthreads();
}

namespace g8 {
constexpr int BM = 256, BK = 64, HALF = 128, HTB = HALF * BK * 2, STAGE_BYTES = 8 * HTB;
__device__ __forceinline__ int lds_byte(int r, int c) { const int st = (r >> 4) * 2 + (c >> 5), rr = r & 15, cc = c & 31, ob = rr * 64 + cc * 2; return st * 1024 + (ob ^ (((ob >> 9) & 1) << 5)); }
__device__ __forceinline__ void stage_rc(int b, int& R, int& C) { const int st = b / 1024, sb = b % 1024, swz = sb ^ (((sb >> 9) & 1) << 5); R = (st >> 1) * 16 + swz / 64; C = (st & 1) * 32 + (swz % 64) / 2; }
__device__ __forceinline__ int perm32(int rho) { const int n = rho >> 4, i = rho & 15; return 8 * (i >> 2) + 4 * n + (i & 3); }

struct Unit { const char* A; const char* B; int row0, col0; };

template <class Epi, class Sched>
__device__ __forceinline__ void gemm_phase(LAS unsigned char* lds, const int K, const int lda, const int ldb, const Sched& S, const Epi& E) {
  const int tid = ltid(), wid = __builtin_amdgcn_readfirstlane(tid >> 6), lane = tid & 63, wr = wid >> 2, wc = wid & 3, fr = lane & 15, fq = lane >> 4;
  const int nt = K / BK;
  unsigned voffA[2], voffB[2];
#pragma unroll
  for (int i = 0; i < 2; ++i) {
    int R, C;
    stage_rc(tid * 16 + i * 8192, R, C);
    const int Rb = (R & ~31) + perm32(R & 31);
    voffA[i] = (unsigned)(R * lda + C) * 2u;
    voffB[i] = (unsigned)(Rb * ldb + C) * 2u;
  }
  const size_t kstep = (size_t)(BK * 2);
  const size_t hstepA = (size_t)HALF * lda * 2, hstepB = (size_t)HALF * ldb * 2;
  const unsigned ldsw = (unsigned)wid * 1024u;
  const int aoff = lds_byte(wr * 64 + fr, fq * 8), boff = lds_byte(wc * 32 + fr, fq * 8);
#define PG8_SA(b, h) (((b) * 2 + (h)) * HTB)
#define PG8_SB(b, h) ((4 + (b) * 2 + (h)) * HTB)
#define PG8_STAGE(bufoff, gbase, voff) do { _Pragma("unroll") for (int _i = 0; _i < 2; ++_i) \
    __builtin_amdgcn_global_load_lds((const unsigned*)((const char*)(gbase) + (voff)[_i]), (LAS unsigned*)(lds + (bufoff) + ldsw + _i * 8192), 16, 0, 0); } while (0)
#define PG8_LDA(dst, b, h) do { _Pragma("unroll") for (int m = 0; m < 4; ++m) _Pragma("unroll") for (int k = 0; k < 2; ++k) dst[m][k] = *(const LAS bf16x8*)(lds + PG8_SA(b, h) + aoff + m * 2048 + k * 1024); } while (0)
#define PG8_LDB(dst, b, h) do { _Pragma("unroll") for (int n = 0; n < 2; ++n) _Pragma("unroll") for (int k = 0; k < 2; ++k) dst[n][k] = *(const LAS bf16x8*)(lds + PG8_SB(b, h) + boff + n * 2048 + k * 1024); } while (0)
#define PG8_MMA(ai, bj, At, Bt) do { __builtin_amdgcn_s_setprio(1); _Pragma("unroll") for (int m = 0; m < 4; ++m) _Pragma("unroll") for (int n = 0; n < 2; ++n) _Pragma("unroll") for (int k = 0; k < 2; ++k) \
    acc[ai][bj][m][n] = __builtin_amdgcn_mfma_f32_16x16x32_bf16(Bt[n][k], At[m][k], acc[ai][bj][m][n], 0, 0, 0); __builtin_amdgcn_s_setprio(0); } while (0)
#define PG8_WAIT_V(n) asm volatile("s_waitcnt vmcnt(" #n ")" ::: "memory")
#define PG8_WAIT_L(n) asm volatile("s_waitcnt lgkmcnt(" #n ")" ::: "memory")
#define PG8_BAR __builtin_amdgcn_s_barrier()
#define PG8_SCHED __builtin_amdgcn_sched_barrier(0)
  Unit cur, nxt;
  int ui = 0;
  if (!S.next(0, cur)) return;
  f32x4 acc[2][2][4][2];
#pragma unroll
  for (int a = 0; a < 2; ++a)
#pragma unroll
    for (int b = 0; b < 2; ++b)
#pragma unroll
      for (int m = 0; m < 4; ++m)
#pragma unroll
        for (int n = 0; n < 2; ++n) acc[a][b][m][n] = (f32x4){0.f, 0.f, 0.f, 0.f};
  bf16x8 At[4][2], B0[2][2], B1[2][2];
  const char* cA = cur.A;
  const char* cB = cur.B;
  PG8_STAGE(PG8_SB(0, 0), cB, voffB); PG8_STAGE(PG8_SB(0, 1), cB + hstepB, voffB); PG8_STAGE(PG8_SA(0, 0), cA, voffA); PG8_STAGE(PG8_SA(0, 1), cA + hstepA, voffA);
  if (wr == 1) PG8_BAR;
  PG8_WAIT_V(2); PG8_BAR;
  PG8_STAGE(PG8_SB(1, 0), cB + kstep, voffB); PG8_STAGE(PG8_SA(1, 0), cA + kstep, voffA); PG8_STAGE(PG8_SB(1, 1), cB + hstepB + kstep, voffB);
  PG8_WAIT_V(6); PG8_BAR;
  for (;;) {
    const bool has_next = S.next(ui + 1, nxt);
    const char* nA = has_next ? nxt.A : cA;
    const char* nB = has_next ? nxt.B : cB;
    for (int t = 0; t < nt; t += 2) {
      const bool last = (t == nt - 2);
      const char* a1 = cA + (size_t)(t + 1) * kstep;
      const char* a2 = last ? nA : cA + (size_t)(t + 2) * kstep;
      const char* b2 = last ? nB : cB + (size_t)(t + 2) * kstep;
      const char* a3 = a2 + kstep;
      const char* b3 = b2 + kstep;
      PG8_LDB(B0, 0, 0); PG8_LDB(B1, 0, 1); PG8_SCHED; PG8_LDA(At, 0, 0); PG8_STAGE(PG8_SA(1, 1), a1 + hstepA, voffA);
      PG8_WAIT_V(8); PG8_WAIT_L(0); PG8_BAR; PG8_MMA(0, 0, At, B0); PG8_MMA(0, 1, At, B1); PG8_BAR; PG8_SCHED;
      PG8_LDA(At, 0, 1); PG8_STAGE(PG8_SB(0, 0), b2, voffB); PG8_STAGE(PG8_SB(0, 1), b2 + hstepB, voffB); PG8_STAGE(PG8_SA(0, 0), a2, voffA);
      PG8_WAIT_V(8); PG8_WAIT_L(0); PG8_BAR; PG8_MMA(1, 0, At, B0); PG8_MMA(1, 1, At, B1); PG8_BAR; PG8_SCHED;
      PG8_LDB(B0, 1, 0); PG8_LDB(B1, 1, 1); PG8_SCHED; PG8_LDA(At, 1, 0); PG8_STAGE(PG8_SA(0, 1), a2 + hstepA, voffA);
      PG8_WAIT_V(8); PG8_WAIT_L(0); PG8_BAR; PG8_MMA(0, 0, At, B0); PG8_MMA(0, 1, At, B1); PG8_BAR; PG8_SCHED;
      PG8_LDA(At, 1, 1); PG8_STAGE(PG8_SB(1, 0), b3, voffB); PG8_STAGE(PG8_SB(1, 1), b3 + hstepB, voffB); PG8_STAGE(PG8_SA(1, 0), a3, voffA);
      PG8_WAIT_V(8); PG8_WAIT_L(0); PG8_BAR; PG8_MMA(1, 0, At, B0); PG8_MMA(1, 1, At, B1); PG8_BAR; PG8_SCHED;
    }
    if (wr == 0) PG8_BAR;
    E(acc, cur, wr, wc, fr, fq);
    if (!has_next) break;
#pragma unroll
    for (int a = 0; a < 2; ++a)
#pragma unroll
      for (int b = 0; b < 2; ++b)
#pragma unroll
        for (int m = 0; m < 4; ++m)
#pragma unroll
          for (int n = 0; n < 2; ++n) acc[a][b][m][n] = (f32x4){0.f, 0.f, 0.f, 0.f};
    cur = nxt; cA = nA; cB = nB; ++ui;
    if (wr == 1) PG8_BAR;
  }
  PG8_WAIT_V(0);
  PG8_BAR;
#undef PG8_SA
#undef PG8_SB
#undef PG8_STAGE
#undef PG8_LDA
#undef PG8_LDB
#undef PG8_MMA
#undef PG8_WAIT_V
#undef PG8_WAIT_L
#undef PG8_BAR
#undef PG8_SCHED
}

struct SchedDense {
  const char* A; const char* B; int lda, ldb, nM, nN, acolstep, G, c;
  __device__ __forceinline__ bool next(int i, Unit& u) const {
    const int nwg = nM * nN;
    const long L = (long)i * G + c;
    if (L >= nwg) return false;
    int wgid = (int)L;
    { const int q = nwg / 8, r = nwg % 8, xcd = wgid % 8, off = wgid / 8; wgid = (xcd < r ? xcd * (q + 1) : r * (q + 1) + (xcd - r) * q) + off; }
    const int nig = 8 * nN, gid = wgid / nig, fm = gid * 8, gsz = (nM - fm) < 8 ? (nM - fm) : 8;
    const int pm = fm + ((wgid % nig) % gsz), pn = (wgid % nig) / gsz;
    u.A = A + (size_t)pm * 256 * lda * 2 + (size_t)pn * acolstep;
    u.B = B + (size_t)pn * 256 * ldb * 2;
    u.row0 = pm * 256; u.col0 = pn * 256;
    return true;
  }
};
struct SchedMoe {
  const char* A; const char* W; int ncol, wrows, colw, nu, G, c;
  __device__ __forceinline__ bool next(int i, Unit& u) const {
    const long L = (long)i * G + c;
    if (L >= nu) return false;
    const int wgid = (int)(L % 8) * (nu / 8) + (int)(L / 8);
    const int UL = 128 * ncol;
    int e, pn, row0;
    if (wgid < UL) { e = wgid / (8 * ncol); const int rem = wgid % (8 * ncol); row0 = e * 2048 + (rem % 8) * 256; pn = rem / 8; }
    else { const int w2 = wgid - UL; e = w2 / ncol; pn = w2 % ncol; row0 = MOE_L + e * 256; }
    u.A = A + (size_t)row0 * 1024 * 2;
    u.B = W + ((size_t)e * wrows + (size_t)pn * 256) * 1024 * 2;
    u.row0 = row0; u.col0 = pn * colw;
    return true;
  }
};

struct EpiBf16 {
  bf16_t* O; int ldo;
  __device__ __forceinline__ void operator()(const f32x4 (&acc)[2][2][4][2], const Unit& u, int wr, int wc, int fr, int fq) const {
#pragma unroll
    for (int ai = 0; ai < 2; ++ai)
#pragma unroll
      for (int m = 0; m < 4; ++m) {
        const int row = u.row0 + ai * 128 + wr * 64 + m * 16 + fr;
        bf16_t* rp = O + (size_t)row * ldo + u.col0 + wc * 32 + 8 * fq;
#pragma unroll
        for (int bj = 0; bj < 2; ++bj) {
          const f32x4 v0 = acc[ai][bj][m][0], v1 = acc[ai][bj][m][1];
          u32x4 w; w.x = cvt_pk_bf16(v0[0], v0[1]); w.y = cvt_pk_bf16(v0[2], v0[3]); w.z = cvt_pk_bf16(v1[0], v1[1]); w.w = cvt_pk_bf16(v1[2], v1[3]);
          *(u32x4*)(rp + bj * 128) = w;
        }
      }
  }
};
struct EpiResid {
  float* x; const float* modg; const float* cs; const float* xl; const float* xc;
  __device__ __forceinline__ void operator()(const f32x4 (&acc)[2][2][4][2], const Unit& u, int wr, int wc, int fr, int fq) const {
#pragma unroll
    for (int ai = 0; ai < 2; ++ai)
#pragma unroll
      for (int m = 0; m < 4; ++m) {
        const int row = u.row0 + ai * 128 + wr * 64 + m * 16 + fr;
        const int c0 = u.col0 + wc * 32 + 8 * fq;
        float* xp = x + (size_t)row * 1024 + c0;
        const float* xi = xl ? (row < NL ? xl + (size_t)row * 1024 + c0 : xc + (size_t)(row - NL) * 1024 + c0) : xp;
        const float* gp = modg + (size_t)modrow(row) * 6144 + c0;
#pragma unroll
        for (int bj = 0; bj < 2; ++bj) {
          f32x4 g0 = *(const f32x4*)(gp + bj * 128), g1 = *(const f32x4*)(gp + bj * 128 + 4);
          if (cs) { g0 *= *(const f32x4*)(cs + c0 + bj * 128); g1 *= *(const f32x4*)(cs + c0 + bj * 128 + 4); }
          f32x4 x0 = *(const f32x4*)(xi + bj * 128), x1 = *(const f32x4*)(xi + bj * 128 + 4);
          x0 += g0 * acc[ai][bj][m][0]; x1 += g1 * acc[ai][bj][m][1];
          *(f32x4*)(xp + bj * 128) = x0; *(f32x4*)(xp + bj * 128 + 4) = x1;
        }
      }
  }
};
struct EpiSwiGLU {
  bf16_t* O;
  __device__ __forceinline__ void operator()(const f32x4 (&acc)[2][2][4][2], const Unit& u, int wr, int wc, int fr, int fq) const {
#pragma unroll
    for (int ai = 0; ai < 2; ++ai)
#pragma unroll
      for (int m = 0; m < 4; ++m) {
        const int row = u.row0 + ai * 128 + wr * 64 + m * 16 + fr;
        bf16_t* rp = O + (size_t)row * 1024 + u.col0 + wc * 32 + 8 * fq;
        float o[8];
#pragma unroll
        for (int n = 0; n < 2; ++n)
#pragma unroll
          for (int j = 0; j < 4; ++j) { const float g = acc[ai][0][m][n][j], up = acc[ai][1][m][n][j]; o[n * 4 + j] = g / (1.f + __expf(-g)) * up; }
        u32x4 w; w.x = cvt_pk_bf16(o[0], o[1]); w.y = cvt_pk_bf16(o[2], o[3]); w.z = cvt_pk_bf16(o[4], o[5]); w.w = cvt_pk_bf16(o[6], o[7]);
        *(u32x4*)rp = w;
      }
  }
};
struct EpiDown {
  bf16_t* O; const float* gatev;
  __device__ __forceinline__ void operator()(const f32x4 (&acc)[2][2][4][2], const Unit& u, int wr, int wc, int fr, int fq) const {
#pragma unroll
    for (int ai = 0; ai < 2; ++ai)
#pragma unroll
      for (int m = 0; m < 4; ++m) {
        const int row = u.row0 + ai * 128 + wr * 64 + m * 16 + fr;
        const float gv = gatev[row];
        bf16_t* rp = O + (size_t)row * 1024 + u.col0 + wc * 32 + 8 * fq;
#pragma unroll
        for (int bj = 0; bj < 2; ++bj) {
          const f32x4 v0 = acc[ai][bj][m][0] * gv, v1 = acc[ai][bj][m][1] * gv;
          u32x4 w; w.x = cvt_pk_bf16(v0[0], v0[1]); w.y = cvt_pk_bf16(v0[2], v0[3]); w.z = cvt_pk_bf16(v1[0], v1[1]); w.w = cvt_pk_bf16(v1[2], v1[3]);
          *(u32x4*)(rp + bj * 128) = w;
        }
      }
  }
};
}

#define NT_WINE 1408
#define NT_WOUT 512
#define NT_WINO 512
#define NT_WGRP 128
#define NT_EXP 16384
#define NT_ALL (NT_WINE + NT_WOUT + NT_WINO + NT_WGRP + 3 * NT_EXP)
__device__ __forceinline__ void ph_init(const Params& p, float* sm) {
  const int tid = ltid(), lane = tid & 63, wv = tid >> 6;
  const size_t gtid = (size_t)lbid() * NTHR + tid, gsz = (size_t)lgdim() * NTHR;
  for (int i = tid; i < 9 * 1024; i += NTHR) {
    const int r = i >> 10, k = i & 1023;
    sm[i] = siluf(r < 8 ? p.c[r * 1024 + k] : p.c_ctx[k]);
  }
  __syncthreads();
  float* part = sm + 9 * 1024;
  for (int item = lbid(); item < 768; item += lgdim()) {
    const int l = item / 192, j0 = (item % 192) * 32;
    const int col = lane & 31, kh = lane >> 5;
    const float* w = p.w_mod + (size_t)l * 1024 * 6144 + j0 + col;
    float acc[9];
#pragma unroll
    for (int r = 0; r < 9; ++r) acc[r] = 0.f;
    const int kb = wv * 128 + kh * 64;
#pragma unroll 4
    for (int kk = 0; kk < 64; ++kk) {
      const float wvv = w[(size_t)(kb + kk) * 6144];
#pragma unroll
      for (int r = 0; r < 9; ++r) acc[r] += sm[r * 1024 + kb + kk] * wvv;
    }
#pragma unroll
    for (int r = 0; r < 9; ++r) part[((wv * 2 + kh) * 9 + r) * 32 + col] = acc[r];
    __syncthreads();
    if (tid < 288) {
      const int r = tid >> 5, cc = tid & 31;
      float s = 0.f;
#pragma unroll
      for (int sl = 0; sl < 16; ++sl) s += part[(sl * 9 + r) * 32 + cc];
      p.mod[(size_t)(l * 9 + r) * 6144 + j0 + cc] = s + p.b_mod[l * 6144 + j0 + cc];
    }
    __syncthreads();
  }
  float* T = sm;
  for (int t = lbid(); t < NT_ALL; t += lgdim()) {
    const float* src; bf16_t* dst; int ld, dK, k0, n0, drow0;
    if (t < NT_WINE) {
      const int e = t / 704, r = t % 704; k0 = (r / 44) * 64; n0 = (r % 44) * 64;
      src = p.w_in_even + (size_t)e * 1024 * EVEN_IN; ld = EVEN_IN; dst = p.WinE + (size_t)e * PROJW * 1024; dK = 1024; drow0 = n0;
    } else if (t < NT_WINE + NT_WOUT + NT_WINO) {
      const int t2 = t - NT_WINE, which = t2 / 512, t3 = t2 % 512, e = t3 / 256, r = t3 % 256; k0 = (r / 16) * 64; n0 = (r % 16) * 64;
      src = (which ? p.w_in_odd : p.w_out_even) + (size_t)e * 1024 * 1024; ld = 1024; dst = (which ? p.WinO : p.WoutE) + (size_t)e * 1024 * 1024; dK = 1024; drow0 = n0;
    } else if (t < NT_WINE + NT_WOUT + NT_WINO + NT_WGRP) {
      const int t2 = t - (NT_WINE + NT_WOUT + NT_WINO), o = t2 / 64, r = t2 % 64, g = r / 16; k0 = ((r % 16) / 4) * 64; n0 = (r % 4) * 64;
      src = p.w_pool_grp + (size_t)(o * 4 + g) * 65536; ld = 256; dst = p.Wgrp + (size_t)o * 1024 * 256; dK = 256; drow0 = g * 256 + n0;
    } else {
      const int t2 = t - (NT_WINE + NT_WOUT + NT_WINO + NT_WGRP), which = t2 / NT_EXP, r = t2 % NT_EXP, le = r / 256; k0 = ((r % 256) / 16) * 64; n0 = (r % 16) * 64;
      const float* base = which == 0 ? p.w_exp_gate : (which == 1 ? p.w_exp_up : p.w_exp_down);
      src = base + (size_t)le * 1024 * 1024; ld = 1024; dK = 1024;
      if (which < 2) { dst = p.Wgu + (size_t)le * 2048 * 1024; drow0 = (n0 >> 7) * 256 + which * 128 + (n0 & 127); }
      else { dst = p.Wd + (size_t)le * 1024 * 1024; drow0 = n0; }
    }
#pragma unroll
    for (int q = 0; q < 2; ++q) {
      const int idx = tid + q * NTHR, k = idx >> 4, c4 = idx & 15;
      const float4 v = *(const float4*)(src + (size_t)(k0 + k) * ld + n0 + c4 * 4);
      float* tp = T + k * 65 + c4 * 4;
      tp[0] = v.x; tp[1] = v.y; tp[2] = v.z; tp[3] = v.w;
    }
    __syncthreads();
    {
      const int nl = wv * 8 + (lane >> 3), kq = lane & 7;
      float f[8];
#pragma unroll
      for (int j = 0; j < 8; ++j) f[j] = T[(kq * 8 + j) * 65 + nl];
      u32x4 w; w.x = cvt_pk_bf16(f[0], f[1]); w.y = cvt_pk_bf16(f[2], f[3]); w.z = cvt_pk_bf16(f[4], f[5]); w.w = cvt_pk_bf16(f[6], f[7]);
      *(u32x4*)(dst + (size_t)(drow0 + nl) * dK + k0 + kq * 8) = w;
    }
    __syncthreads();
  }
}

#define NORM_R 1
__device__ __forceinline__ void ph_norm(const Params& p, int l, int which, int nrows, int ncomb, int lprev, float* sm) {
  const int tid = ltid(), lane = tid & 63, wv = tid >> 6;
  const bool skinny = (which == 2) || (which == 1 && (l & 1) == 0);
  if (skinny) {
    const float* wbase; int stride;
    if (which == 2) { wbase = p.w_router + (size_t)l * 1024 * 16; stride = 16; }
    else { wbase = p.w_in_even + (size_t)(l >> 1) * 1024 * EVEN_IN + PROJW; stride = EVEN_IN; }
    __syncthreads();
    for (int idx = tid; idx < 4096; idx += NTHR) {
      const int d = idx >> 2, q = idx & 3;
      const float4 w4 = *(const float4*)(wbase + (size_t)d * stride + q * 4);
      const int i = d >> 8, ln = (d >> 2) & 63, j = d & 3;
      ((float4*)sm)[((i * 4 + j) * 4 + q) * 64 + ln] = w4;
    }
    __syncthreads();
  }
  const int nwaves = lgdim() * (NTHR / 64), gw = lbid() * (NTHR / 64) + wv;
  const int per = (nrows + nwaves - 1) / nwaves;
  const int rbeg = gw * per, rend = min(nrows, rbeg + per);
  for (int rb = rbeg; rb < rend; rb += NORM_R) {
    float4 h[NORM_R][4];
#pragma unroll
    for (int rr = 0; rr < NORM_R; ++rr) {
      const int r = min(rb + rr, rend - 1);
      const bool live = (rb + rr) < rend;
      float* xr = p.xcur + (size_t)r * DM;
      const float* xsrc = (which == 1 && l == 0) ? (r < NL ? p.x + (size_t)r * DM : p.ctx + (size_t)(r - NL) * DM) : xr;
      float4 v[4];
#pragma unroll
      for (int i = 0; i < 4; ++i) v[i] = ((const float4*)xsrc)[i * 64 + lane];
      const int mr = modrow(r);
      if (r < ncomb) {
        float4 s4[4];
#pragma unroll
        for (int i = 0; i < 4; ++i) s4[i] = make_float4(0.f, 0.f, 0.f, 0.f);
        for (int e = 0; e < NEXP; ++e) {
          const int sl = p.slotmap[r * 16 + e];
          if (sl >= 0) {
            size_t yrow;
            if (r < NL) yrow = (size_t)e * 2048 + (size_t)(r >> 11) * 256 + sl;
            else yrow = (size_t)MOE_L + (size_t)e * 256 + (size_t)((r - NL) >> 8) * 32 + sl;
            const u32x2* yp = (const u32x2*)(p.Ybuf + yrow * DM);
#pragma unroll
            for (int i = 0; i < 4; ++i) {
              const u32x2 y = yp[i * 64 + lane];
              s4[i].x += __uint_as_float(y.x << 16); s4[i].y += __uint_as_float(y.x & 0xffff0000u);
              s4[i].z += __uint_as_float(y.y << 16); s4[i].w += __uint_as_float(y.y & 0xffff0000u);
            }
          }
        }
        const float4* g5 = (const float4*)(p.mod + (size_t)(lprev * 9 + mr) * 6144 + 5 * 1024);
#pragma unroll
        for (int i = 0; i < 4; ++i) {
          const float4 g = g5[i * 64 + lane];
          v[i].x += g.x * s4[i].x; v[i].y += g.y * s4[i].y; v[i].z += g.z * s4[i].z; v[i].w += g.w * s4[i].w;
          if (live) ((float4*)xr)[i * 64 + lane] = v[i];
        }
      }
      float ss = 0.f;
#pragma unroll
      for (int i = 0; i < 4; ++i) ss += v[i].x * v[i].x + v[i].y * v[i].y + v[i].z * v[i].z + v[i].w * v[i].w;
      ss = wave_sum(ss);
      const float inv = rsqrtf(ss * (1.f / 1024.f) + EPS);
      if (which == 3) {
        if (live) {
#pragma unroll
          for (int i = 0; i < 4; ++i) {
            const float4 g = ((const float4*)p.g_final)[i * 64 + lane];
            ((float4*)(p.out + (size_t)r * DM))[i * 64 + lane] = make_float4(v[i].x * inv * g.x, v[i].y * inv * g.y, v[i].z * inv * g.z, v[i].w * inv * g.w);
          }
        }
        continue;
      }
      const float* gn = (which == 1 ? p.g_norm1 : p.g_norm2) + l * 1024;
      const float* mrow = p.mod + (size_t)(l * 9 + mr) * 6144;
      const float4* shp = (const float4*)(mrow + (which == 1 ? 0 : 3) * 1024);
      const float4* scp = (const float4*)(mrow + (which == 1 ? 1 : 4) * 1024);
#pragma unroll
      for (int i = 0; i < 4; ++i) {
        const float4 g = ((const float4*)gn)[i * 64 + lane];
        const float4 sh = shp[i * 64 + lane], sc = scp[i * 64 + lane];
        h[rr][i].x = v[i].x * inv * g.x * (1.f + sc.x) + sh.x;
        h[rr][i].y = v[i].y * inv * g.y * (1.f + sc.y) + sh.y;
        h[rr][i].z = v[i].z * inv * g.z * (1.f + sc.z) + sh.z;
        h[rr][i].w = v[i].w * inv * g.w * (1.f + sc.w) + sh.w;
        u32x2 w; w.x = cvt_pk_bf16(h[rr][i].x, h[rr][i].y); w.y = cvt_pk_bf16(h[rr][i].z, h[rr][i].w);
        if (live) ((u32x2*)(p.hbuf + (size_t)r * DM))[i * 64 + lane] = w;
      }
      __builtin_amdgcn_sched_barrier(0);
    }
    if (!skinny) continue;
    float lg[NORM_R][16];
#pragma unroll
    for (int rr = 0; rr < NORM_R; ++rr)
#pragma unroll
      for (int e = 0; e < 16; ++e) lg[rr][e] = 0.f;
#pragma unroll
    for (int i = 0; i < 4; ++i)
#pragma unroll
      for (int j = 0; j < 4; ++j)
#pragma unroll
        for (int q = 0; q < 4; ++q) {
          const float4 w4 = ((const float4*)sm)[((i * 4 + j) * 4 + q) * 64 + lane];
#pragma unroll
          for (int rr = 0; rr < NORM_R; ++rr) {
            const float hv = j == 0 ? h[rr][i].x : (j == 1 ? h[rr][i].y : (j == 2 ? h[rr][i].z : h[rr][i].w));
            lg[rr][q * 4 + 0] += hv * w4.x; lg[rr][q * 4 + 1] += hv * w4.y; lg[rr][q * 4 + 2] += hv * w4.z; lg[rr][q * 4 + 3] += hv * w4.w;
          }
          if (q == 3) __builtin_amdgcn_sched_barrier(0);
        }
#pragma unroll
    for (int rr = 0; rr < NORM_R; ++rr) {
      const int r = rb + rr;
      float v8[8];
#pragma unroll
      for (int k = 0; k < 8; ++k) { const bool up = lane & 32; const float keep = up ? lg[rr][k + 8] : lg[rr][k], send = up ? lg[rr][k] : lg[rr][k + 8]; v8[k] = keep + __shfl_xor(send, 32); }
      float v4[4];
#pragma unroll
      for (int k = 0; k < 4; ++k) { const bool up = lane & 16; const float keep = up ? v8[k + 4] : v8[k], send = up ? v8[k] : v8[k + 4]; v4[k] = keep + __shfl_xor(send, 16); }
      float v2[2];
#pragma unroll
      for (int k = 0; k < 2; ++k) { const bool up = lane & 8; const float keep = up ? v4[k + 2] : v4[k], send = up ? v4[k] : v4[k + 2]; v2[k] = keep + __shfl_xor(send, 8); }
      float v1;
      { const bool up = lane & 4; const float keep = up ? v2[1] : v2[0], send = up ? v2[0] : v2[1]; v1 = keep + __shfl_xor(send, 4); }
      v1 += __shfl_xor(v1, 2);
      v1 += __shfl_xor(v1, 1);
      const int col = lane >> 2;
      if (which == 2) {
        float mx = v1;
        mx = fmaxf(mx, __shfl_xor(mx, 4)); mx = fmaxf(mx, __shfl_xor(mx, 8)); mx = fmaxf(mx, __shfl_xor(mx, 16)); mx = fmaxf(mx, __shfl_xor(mx, 32));
        const float ex = expf(v1 - mx);
        float sum = ex;
        sum += __shfl_xor(sum, 4); sum += __shfl_xor(sum, 8); sum += __shfl_xor(sum, 16); sum += __shfl_xor(sum, 32);
        if (r < rend && (lane & 3) == 0) p.aff[(size_t)r * 16 + col] = ex / sum;
      } else {
        float gvv = v1 + p.b_gate[(l >> 1) * 16 + col];
        if ((col >> 2) & 1) gvv = logsigmoidf_(gvv);
        if (r < rend && (lane & 3) == 0) p.gates[(size_t)r * 16 + col] = gvv;
      }
    }
  }
  __syncthreads();
}

#define LOG2E 1.4426950408889634f
__device__ __forceinline__ int chain_row(int b, int dir, int p) {
  if (p < 256) { const int t = dir ? 255 - p : p; return NL + b * 256 + t; }
  const int q = p - 256; const int t = dir ? 2047 - q : q; return b * 2048 + t;
}
__device__ __forceinline__ float wave_incl_sum(float v, int lane) {
#pragma unroll
  for (int o = 1; o < 64; o <<= 1) { const float t = __shfl_up(v, o); if (lane >= o) v += t; }
  return v;
}
__device__ __forceinline__ float wave_incl_max(float v, int lane) {
#pragma unroll
  for (int o = 1; o < 64; o <<= 1) { const float t = __shfl_up(v, o); if (lane >= o) v = fmaxf(v, t); }
  return v;
}
__device__ __forceinline__ void unpack8(const u32x4 w, float (&f)[8]) {
  f[0] = __uint_as_float(w.x << 16); f[1] = __uint_as_float(w.x & 0xffff0000u); f[2] = __uint_as_float(w.y << 16); f[3] = __uint_as_float(w.y & 0xffff0000u);
  f[4] = __uint_as_float(w.z << 16); f[5] = __uint_as_float(w.z & 0xffff0000u); f[6] = __uint_as_float(w.w << 16); f[7] = __uint_as_float(w.w & 0xffff0000u);
}
__device__ __forceinline__ u32x4 pack8(const float (&f)[8]) {
  u32x4 w; w.x = cvt_pk_bf16(f[0], f[1]); w.y = cvt_pk_bf16(f[2], f[3]); w.z = cvt_pk_bf16(f[4], f[5]); w.w = cvt_pk_bf16(f[6], f[7]);
  return w;
}
__device__ __forceinline__ void ph_post_even(const Params& p, int l, float* sm) {
  const int e = l >> 1;
  const int tid = ltid(), lane = tid & 63;
  __syncthreads();
  for (int idx = tid; idx < 1024; idx += NTHR) {
    const int pos = idx >> 4, i = idx & 15;
    const float ang = (float)pos * exp2f(-(float)i * (13.287712379549449f / 16.f));
    float sn, cs;
    sincosf(ang, &sn, &cs);
    sm[2 * idx] = cs; sm[2 * idx + 1] = sn;
  }
  __syncthreads();
  const int bid = lbid(), G = lgdim();
  const bool scanner = (bid < 64) && (tid < 64) && (G > 64);
  const size_t nthr_e = (size_t)G * NTHR - (G > 64 ? 64 * 64 : 0);
  size_t gtid;
  if (G > 64) gtid = bid < 64 ? (size_t)bid * (NTHR - 64) + (tid - 64) : (size_t)64 * (NTHR - 64) + (size_t)(bid - 64) * NTHR + tid;
  else gtid = (size_t)bid * NTHR + tid;
  const size_t gsz = nthr_e;
  if (!scanner) {
  for (size_t it = gtid; it < (size_t)NT * 10; it += gsz) {
    const int r = (int)(it / 10), hh = (int)(it % 10);
    const bool lat = r < NL;
    const int t = r & 2047;
    const int bb = lat ? (r >> 11) : ((r - NL) >> 8);
    const int key = lat ? 256 + t : ((r - NL) & 255);
    const bf16_t* src; bf16_t* dst; const float* g; float osc;
    if (hh < 8) { src = p.proj + (size_t)r * PROJW + hh * 64; dst = p.Qb + (size_t)r * 512 + hh * 64; g = p.g_qnorm + e * 64; osc = 0.125f * LOG2E; }
    else { src = p.proj + (size_t)r * PROJW + 512 + (hh - 8) * 64; dst = p.Kb + ((size_t)(bb * 2 + (hh - 8)) * 2304 + key) * 64; g = p.g_knorm + e * 64; osc = 1.f;
           const u32x4* vs = (const u32x4*)(p.proj + (size_t)r * PROJW + 640 + (hh - 8) * 64);
           u32x4* vd = (u32x4*)(p.Vb + ((size_t)(bb * 2 + (hh - 8)) * 2304 + key) * 64);
#pragma unroll
           for (int q = 0; q < 8; ++q) vd[q] = vs[q]; }
    float x[64];
#pragma unroll
    for (int q = 0; q < 8; ++q) { float f[8]; unpack8(((const u32x4*)src)[q], f);
#pragma unroll
      for (int j = 0; j < 8; ++j) x[q * 8 + j] = f[j]; }
    float ss = 0.f;
#pragma unroll
    for (int j = 0; j < 64; ++j) ss += x[j] * x[j];
    const float inv = rsqrtf(ss * (1.f / 64.f) + EPS) * osc;
#pragma unroll
    for (int j = 0; j < 64; ++j) x[j] *= inv * g[j];
    if (lat) {
#pragma unroll
      for (int a = 0; a < 2; ++a) {
        const int pos = (a == 0) ? (t >> 6) : (t & 63);
#pragma unroll
        for (int i = 0; i < 16; ++i) {
          const float2 cssn = *(const float2*)(sm + 2 * (pos * 16 + i));
          const float x1 = x[a * 32 + i], x2 = x[a * 32 + 16 + i];
          x[a * 32 + i] = x1 * cssn.x - x2 * cssn.y;
          x[a * 32 + 16 + i] = x2 * cssn.x + x1 * cssn.y;
        }
      }
    }
#pragma unroll
    for (int q = 0; q < 8; ++q) { float f[8];
#pragma unroll
      for (int j = 0; j < 8; ++j) f[j] = x[q * 8 + j];
      ((u32x4*)dst)[q] = pack8(f); }
  }
  const float* wc = p.w_conv + (size_t)e * 3 * 1024;
  for (size_t it = gtid; it < (size_t)NT * 128; it += gsz) {
    const int r = (int)(it >> 7), c8 = (int)(it & 127) * 8;
    int t, n;
    if (r < NL) { t = r & 2047; n = 2048; } else { t = (r - NL) & 255; n = 256; }
    const bf16_t* sp = p.proj + (size_t)r * PROJW + 768 + c8;
    float xc[8], xm[8], xp[8], o[8];
    unpack8(*(const u32x4*)sp, xc);
    if (t > 0) unpack8(*(const u32x4*)(sp - PROJW), xm); else {
#pragma unroll
      for (int j = 0; j < 8; ++j) xm[j] = 0.f; }
    if (t < n - 1) unpack8(*(const u32x4*)(sp + PROJW), xp); else {
#pragma unroll
      for (int j = 0; j < 8; ++j) xp[j] = 0.f; }
    const float ksc = c8 < 512 ? 1.f : 0.08838834764831845f;
#pragma unroll
    for (int j = 0; j < 8; ++j) { const float v = wc[c8 + j] * xm[j] + wc[1024 + c8 + j] * xc[j] + wc[2048 + c8 + j] * xp[j]; o[j] = siluf(v) * ksc; }
    bf16_t* dp = c8 < 512 ? p.qm + (size_t)r * 512 + c8 : p.km + (size_t)r * 512 + c8 - 512;
    *(u32x4*)dp = pack8(o);
  }
  }
  if (scanner || G <= 64) {
    const int gw = (G > 64) ? bid : (int)(((size_t)bid * NTHR + tid) >> 6), nw = (G > 64) ? 64 : (int)(((size_t)G * NTHR) >> 6);
    for (int chain = gw; chain < 64; chain += nw) {
      const int b = chain >> 3, hd = (chain >> 1) & 3, dir = chain & 1;
      float m_in = -1e30f;
      for (int c = 0; c < 18; ++c) {
        const int p0 = c * 128 + 2 * lane;
        const int r0 = chain_row(b, dir, p0), r1 = chain_row(b, dir, p0 + 1);
        const float ig0 = p.gates[(size_t)r0 * 16 + dir * 8 + hd], lf0 = p.gates[(size_t)r0 * 16 + dir * 8 + 4 + hd];
        const float ig1 = p.gates[(size_t)r1 * 16 + dir * 8 + hd], lf1 = p.gates[(size_t)r1 * 16 + dir * 8 + 4 + hd];
        const float ssum = lf0 + lf1;
        const float incl = wave_incl_sum(ssum, lane);
        const float bq0 = (incl - ssum) + lf0, bq1 = bq0 + lf1;
        const float bend = __shfl(incl, 63);
        const float g0 = ig0 - bq0, g1 = ig1 - bq1;
        const float inclm = wave_incl_max(fmaxf(g0, g1), lane);
        float exclm = __shfl_up(inclm, 1);
        if (lane == 0) exclm = -3.0e38f;
        const float pm0 = fmaxf(exclm, g0), pm1 = fmaxf(pm0, g1);
        const float gmax = __shfl(inclm, 63);
        const float m_next = fmaxf(m_in + bend, bend + gmax);
        const size_t i0 = (size_t)r0 * 8 + dir * 4 + hd, i1 = (size_t)r1 * 8 + dir * 4 + hd;
        p.gsG[i0] = g0 * LOG2E; p.gsR[i0] = -fmaxf(m_in, pm0) * LOG2E; p.gsB[i0] = bq0 * LOG2E;
        p.gsG[i1] = g1 * LOG2E; p.gsR[i1] = -fmaxf(m_in, pm1) * LOG2E; p.gsB[i1] = bq1 * LOG2E;
        if (lane == 0) { p.cMIN[chain * 18 + c] = m_in * LOG2E; p.cE1[chain * 18 + c] = (bend - m_next) * LOG2E; p.cDEC[chain * 18 + c] = expf(m_in + bend - m_next); }
        m_in = m_next;
      }
    }
  }
}

typedef float f32x16 __attribute__((ext_vector_type(16)));
typedef short s16x4 __attribute__((ext_vector_type(4)));
typedef __attribute__((address_space(3))) const char* lds_cptr;
__device__ __forceinline__ s16x4 vtr(lds_cptr p) { return __builtin_bit_cast(s16x4, __builtin_amdgcn_ds_read_tr16_b64_v4i16((__attribute__((address_space(3))) s16x4*)p)); }
#define MX3(a, b, c) __builtin_fmaxf(__builtin_fmaxf((a), (b)), (c))
__device__ __forceinline__ float rowmax32(const f32x16& p0, const f32x16& p1) {
  float a = MX3(p0[0], p0[1], p1[0]), b = MX3(p0[2], p0[3], p1[1]);
  a = MX3(a, p1[2], p1[3]);
#pragma unroll
  for (int r = 4; r < 16; r += 4) { a = MX3(a, p0[r], p0[r + 1]); b = MX3(b, p0[r + 2], p0[r + 3]); a = MX3(a, p1[r], p1[r + 1]); b = MX3(b, p1[r + 2], p1[r + 3]); }
  const float m = __builtin_fmaxf(a, b);
  auto rr = __builtin_amdgcn_permlane32_swap(__float_as_uint(m), __float_as_uint(m), false, false);
  return __builtin_fmaxf(__uint_as_float(rr[0]), __uint_as_float(rr[1]));
}
__device__ __forceinline__ float half_swap_add(float v) {
  auto rr = __builtin_amdgcn_permlane32_swap(__float_as_uint(v), __float_as_uint(v), false, false);
  return __uint_as_float(rr[0]) + __uint_as_float(rr[1]);
}
#define ATT_SLOT 16384
__device__ __forceinline__ void glds16(const void* g, unsigned lds_base) {
  unsigned sv;
  asm volatile("s_mov_b32 %0, m0\n\ts_mov_b32 m0, %2\n\ts_nop 0\n\tglobal_load_lds_dwordx4 %1, off\n\ts_mov_b32 m0, %0" : "=&s"(sv) : "v"(g), "s"(lds_base) : "memory");
}
__device__ __forceinline__ void attn_unit(const bf16_t* Q0, const bf16_t* Kbase, const bf16_t* Vbase, const int nkeys, bf16_t* O0, LAS unsigned char* lds) {
  const int tid = ltid(), lane = tid & 63, r32 = lane & 31, hi = lane >> 5;
  const int wid = __builtin_amdgcn_readfirstlane(tid >> 6);
  const int NTL = nkeys >> 6;
  __syncthreads();
  const bf16_t* ksrc = Kbase + (size_t)lane * 64 + wid * 8;
  const bf16_t* vsrc = Vbase + (size_t)(16 * (wid & 3) + (lane >> 2)) * 64 + (wid >> 2) * 32 + (lane & 3) * 8;
  const unsigned ldsb = (unsigned)(size_t)lds;
#define ATT_STAGE(t, slot) do { \
    glds16(ksrc + (size_t)(t) * 64 * 64, (unsigned)__builtin_amdgcn_readfirstlane(ldsb + (slot) * ATT_SLOT + wid * 1024)); \
    glds16(vsrc + (size_t)(t) * 64 * 64, (unsigned)__builtin_amdgcn_readfirstlane(ldsb + (slot) * ATT_SLOT + 8192 + wid * 1024)); } while (0)
  ATT_STAGE(0, 0);
  if (NTL > 1) ATT_STAGE(1, 1);
  bf16x8 qr[4];
  {
    const bf16_t* Qw = Q0 + (size_t)(wid * 32 + r32) * 512;
#pragma unroll
    for (int d0 = 0; d0 < 4; ++d0) qr[d0] = *(const bf16x8*)(Qw + d0 * 16 + hi * 8);
  }
  f32x16 o0, o1;
#pragma unroll
  for (int r = 0; r < 16; ++r) { o0[r] = 0.f; o1[r] = 0.f; }
  float m = -1e30f, l = 0.f;
  const int koff = hi * 1024 + r32 * 16;
  const int voff = 8192 + ((lane >> 4) & 1) * 32 + (lane & 3) * 8 + (4 * hi + ((lane & 15) >> 2)) * 64;
  int slot = 0;
  for (int t = 0; t < NTL; ++t) {
    if (t + 1 < NTL) asm volatile("s_waitcnt vmcnt(2) lgkmcnt(0)\n\ts_barrier" ::: "memory"); else asm volatile("s_waitcnt vmcnt(0) lgkmcnt(0)\n\ts_barrier" ::: "memory");
    __builtin_amdgcn_sched_barrier(0);
    if (t + 2 < NTL) { const int s2 = (slot >= 1) ? slot - 1 : 2; ATT_STAGE(t + 2, s2); }
    const lds_cptr kp = (lds_cptr)(lds + slot * ATT_SLOT + koff);
    const lds_cptr vp = (lds_cptr)(lds + slot * ATT_SLOT + voff);
    f32x16 pA, pB;
#pragma unroll
    for (int r = 0; r < 16; ++r) { pA[r] = 0.f; pB[r] = 0.f; }
#pragma unroll
    for (int d0 = 0; d0 < 4; ++d0) {
      const bf16x8 k0 = *(const LAS bf16x8*)(kp + d0 * 2048), k1 = *(const LAS bf16x8*)(kp + d0 * 2048 + 512);
      pA = __builtin_amdgcn_mfma_f32_32x32x16_bf16(k0, qr[d0], pA, 0, 0, 0);
      pB = __builtin_amdgcn_mfma_f32_32x32x16_bf16(k1, qr[d0], pB, 0, 0, 0);
    }
    const float rm = rowmax32(pA, pB);
    const float mn = __builtin_fmaxf(m, rm);
    const float alpha = __builtin_amdgcn_exp2f(m - mn);
    m = mn;
    float ps = 0.f;
#pragma unroll
    for (int r = 0; r < 16; ++r) { pA[r] = __builtin_amdgcn_exp2f(pA[r] - mn); pB[r] = __builtin_amdgcn_exp2f(pB[r] - mn); ps += pA[r] + pB[r]; }
    l = l * alpha + ps;
#pragma unroll
    for (int r = 0; r < 16; ++r) { o0[r] *= alpha; o1[r] *= alpha; }
    bf16x8 pw[4];
#pragma unroll
    for (int s4 = 0; s4 < 4; ++s4) {
      u32x4 w;
      if (s4 < 2) { w.x = cvt_pk_bf16(pA[8 * s4 + 0], pA[8 * s4 + 1]); w.y = cvt_pk_bf16(pA[8 * s4 + 2], pA[8 * s4 + 3]); w.z = cvt_pk_bf16(pA[8 * s4 + 4], pA[8 * s4 + 5]); w.w = cvt_pk_bf16(pA[8 * s4 + 6], pA[8 * s4 + 7]); }
      else { const int q = s4 - 2; w.x = cvt_pk_bf16(pB[8 * q + 0], pB[8 * q + 1]); w.y = cvt_pk_bf16(pB[8 * q + 2], pB[8 * q + 3]); w.z = cvt_pk_bf16(pB[8 * q + 4], pB[8 * q + 5]); w.w = cvt_pk_bf16(pB[8 * q + 6], pB[8 * q + 7]); }
      pw[s4] = __builtin_bit_cast(bf16x8, w);
    }
#pragma unroll
    for (int s4 = 0; s4 < 4; ++s4) {
      const s16x4 a0l = vtr(vp + s4 * 1024), a0h = vtr(vp + s4 * 1024 + 512);
      const s16x4 a1l = vtr(vp + 4096 + s4 * 1024), a1h = vtr(vp + 4096 + s4 * 1024 + 512);
      const bf16x8 a0 = {a0l[0], a0l[1], a0l[2], a0l[3], a0h[0], a0h[1], a0h[2], a0h[3]};
      const bf16x8 a1 = {a1l[0], a1l[1], a1l[2], a1l[3], a1h[0], a1h[1], a1h[2], a1h[3]};
      o0 = __builtin_amdgcn_mfma_f32_32x32x16_bf16(a0, pw[s4], o0, 0, 0, 0);
      o1 = __builtin_amdgcn_mfma_f32_32x32x16_bf16(a1, pw[s4], o1, 0, 0, 0);
    }
    slot = (slot == 2) ? 0 : slot + 1;
  }
#undef ATT_STAGE
  const float il = 1.f / half_swap_add(l);
  bf16_t* Ow = O0 + (size_t)(wid * 32 + r32) * 1024;
#pragma unroll
  for (int g4 = 0; g4 < 4; ++g4) {
    u32x2 w0, w1;
    w0.x = cvt_pk_bf16(o0[4 * g4 + 0] * il, o0[4 * g4 + 1] * il); w0.y = cvt_pk_bf16(o0[4 * g4 + 2] * il, o0[4 * g4 + 3] * il);
    w1.x = cvt_pk_bf16(o1[4 * g4 + 0] * il, o1[4 * g4 + 1] * il); w1.y = cvt_pk_bf16(o1[4 * g4 + 2] * il, o1[4 * g4 + 3] * il);
    *(u32x2*)(Ow + 8 * g4 + 4 * hi) = w0;
    *(u32x2*)(Ow + 32 + 8 * g4 + 4 * hi) = w1;
  }
}
__device__ __forceinline__ void ph_att(const Params& p, bool ctx_q, LAS unsigned char* lds) {
  const int c = lbid(), G = lgdim();
  const int nunits = 512 + (ctx_q ? 64 : 0);
  for (int L = c; L < nunits; L += G) {
    if (L < 512) {
      const int i = L >> 8, cc = L & 255, grp = (cc & 7) + 8 * i, idx = cc >> 3;
      const int b = grp >> 1, kvh = grp & 1, h = kvh * 4 + (idx >> 3), qt = idx & 7;
      const size_t row0 = (size_t)b * 2048 + qt * 256;
      attn_unit(p.Qb + row0 * 512 + h * 64, p.Kb + (size_t)(b * 2 + kvh) * 2304 * 64, p.Vb + (size_t)(b * 2 + kvh) * 2304 * 64, 2304, p.mix + row0 * 1024 + h * 64, lds);
    } else {
      const int u = L - 512, b = u >> 3, h = u & 7, kvh = h >> 2;
      const size_t row0 = (size_t)NL + b * 256;
      attn_unit(p.Qb + row0 * 512 + h * 64, p.Kb + (size_t)(b * 2 + kvh) * 2304 * 64, p.Vb + (size_t)(b * 2 + kvh) * 2304 * 64, 256, p.mix + row0 * 1024 + h * 64, lds);
    }
  }
  __syncthreads();
}

__device__ __forceinline__ int chunk_row0(int b, int dir, int cc) {
  if (cc < 2) return NL + b * 256 + (dir ? 1 - cc : cc) * 128;
  return b * 2048 + (dir ? 15 - (cc - 2) : cc - 2) * 128;
}
__device__ __forceinline__ int trq_addr(int lane, int quarter, int rowbase) {
  return quarter * 8192 + ((lane >> 4) & 1) * 32 + (lane & 3) * 8 + (rowbase + ((lane & 15) >> 2)) * 64;
}
__device__ __forceinline__ bf16x8 cat44(const s16x4 a, const s16x4 b) { return (bf16x8){a[0], a[1], a[2], a[3], b[0], b[1], b[2], b[3]}; }

__device__ __forceinline__ void ph_mlstm_u(const Params& p, LAS unsigned char* lds) {
  const int tid = ltid(), lane = tid & 63, r32 = lane & 31, hi = lane >> 5;
  const int wid = __builtin_amdgcn_readfirstlane(tid >> 6);
  LAS float* WS = (LAS float*)(lds + 65536);
  LAS float* NP = (LAS float*)(lds + 66048);
  for (int unit = lbid(); unit < 64 * 17; unit += lgdim()) {
    const int chain = unit / 17, cc = unit % 17;
    const int b = chain >> 3, hd = (chain >> 1) & 3, dir = chain & 1;
    const int row0 = chunk_row0(b, dir, cc);
    __syncthreads();
#pragma unroll
    for (int n = 0; n < 4; ++n) {
      const int ii = wid * 4 + n, qd = ii >> 3, rg = ii & 7;
      const bf16_t* src = p.km + (size_t)(row0 + rg * 16 + (lane >> 2)) * 512 + hd * 128 + qd * 32 + (lane & 3) * 8;
      __builtin_amdgcn_global_load_lds((const unsigned*)src, (LAS unsigned*)(lds + qd * 8192 + rg * 1024), 16, 0, 0);
    }
    if (tid < 128) WS[tid] = __builtin_amdgcn_exp2f(p.gsG[(size_t)(row0 + tid) * 8 + dir * 4 + hd] + p.cE1[chain * 18 + cc]);
    __syncthreads();
#pragma unroll
    for (int n = 0; n < 4; ++n) {
      const int o = (tid + n * NTHR) * 16, qd = o >> 13, row = (o >> 6) & 127, pc = (o >> 4) & 3;
      float f[8];
      unpack8(*(const u32x4*)(p.proj + (size_t)(row0 + row) * PROJW + 1792 + hd * 128 + qd * 32 + pc * 8), f);
      const float w = WS[row];
#pragma unroll
      for (int j = 0; j < 8; ++j) f[j] *= w;
      *(LAS u32x4*)(lds + 32768 + o) = pack8(f);
    }
    asm volatile("s_waitcnt vmcnt(0)" ::: "memory");
    __syncthreads();
    {
      const int d = tid & 127, part = tid >> 7;
      float acc = 0.f;
      for (int s2 = 0; s2 < 32; ++s2) {
        const int srow = part * 32 + s2;
        const bf16_t kv = *(const LAS bf16_t*)(lds + (d >> 5) * 8192 + srow * 64 + (d & 31) * 2);
        acc += WS[srow] * bf2f(kv);
      }
      NP[part * 128 + d] = acc;
    }
    const int eb = wid >> 1, db0 = 2 * (wid & 1);
    f32x16 u0, u1;
#pragma unroll
    for (int r = 0; r < 16; ++r) { u0[r] = 0.f; u1[r] = 0.f; }
#pragma unroll
    for (int ks = 0; ks < 8; ++ks) {
      const int rb = ks * 16 + 8 * hi;
      const bf16x8 a = cat44(vtr((lds_cptr)(lds + 32768 + trq_addr(lane, eb, rb))), vtr((lds_cptr)(lds + 32768 + trq_addr(lane, eb, rb + 4))));
      const bf16x8 b0 = cat44(vtr((lds_cptr)(lds + trq_addr(lane, db0, rb))), vtr((lds_cptr)(lds + trq_addr(lane, db0, rb + 4))));
      const bf16x8 b1 = cat44(vtr((lds_cptr)(lds + trq_addr(lane, db0 + 1, rb))), vtr((lds_cptr)(lds + trq_addr(lane, db0 + 1, rb + 4))));
      u0 = __builtin_amdgcn_mfma_f32_32x32x16_bf16(a, b0, u0, 0, 0, 0);
      u1 = __builtin_amdgcn_mfma_f32_32x32x16_bf16(a, b1, u1, 0, 0, 0);
    }
    float* U = p.Ubuf + ((size_t)chain * 17 + cc) * 16384;
#pragma unroll
    for (int r = 0; r < 16; ++r) {
      const int erow = eb * 32 + (r & 3) + 8 * (r >> 2) + 4 * hi;
      U[(size_t)erow * 128 + db0 * 32 + r32] = u0[r];
      U[(size_t)erow * 128 + (db0 + 1) * 32 + r32] = u1[r];
    }
    __syncthreads();
    if (tid < 128) p.NLb[((size_t)chain * 17 + cc) * 128 + tid] = NP[tid] + NP[128 + tid] + NP[256 + tid] + NP[384 + tid];
  }
  __syncthreads();
}

__device__ __forceinline__ void ph_mlstm_scan(const Params& p, int bskip) {
  const int bsk = lgdim() > bskip ? bskip : 0;
  if (lbid() < bsk) return;
  const size_t gtid = (size_t)(lbid() - bsk) * NTHR + ltid(), gsz = (size_t)(lgdim() - bsk) * NTHR;
  for (size_t it = gtid; it < (size_t)64 * 8192; it += gsz) {
    const int chain = (int)(it >> 13), ed = (int)(it & 8191) * 2;
    float c0 = 0.f, c1 = 0.f;
    for (int c = 0; c < 17; ++c) {
      const float dec = p.cDEC[chain * 18 + c];
      const float2 u = *(const float2*)(p.Ubuf + ((size_t)chain * 17 + c) * 16384 + ed);
      c0 = dec * c0 + u.x; c1 = dec * c1 + u.y;
      *(unsigned*)(p.Cbf + ((size_t)chain * 18 + c + 1) * 16384 + ed) = cvt_pk_bf16(c0, c1);
    }
  }
  for (size_t it = gtid; it < (size_t)64 * 128; it += gsz) {
    const int chain = (int)(it >> 7), d = (int)(it & 127);
    float nv = 0.f;
    for (int c = 0; c < 17; ++c) {
      nv = p.cDEC[chain * 18 + c] * nv + p.NLb[((size_t)chain * 17 + c) * 128 + d];
      p.NVb[((size_t)chain * 18 + c + 1) * 128 + d] = nv;
    }
  }
}

__device__ __forceinline__ void ph_mlstm_h(const Params& p, int l, bool ctx_out, LAS unsigned char* lds) {
  const int e2 = l >> 1;
  const int tid = ltid(), lane = tid & 63, r32 = lane & 31, hi = lane >> 5;
  const int wid = __builtin_amdgcn_readfirstlane(tid >> 6);
  const int tb = wid & 3, dir = wid >> 2;
  LAS float* HX = (LAS float*)(lds + 65536);
  LAS float* GC = (LAS float*)(lds + 131072);
  const int j0 = ctx_out ? 0 : 2, nj = 18 - j0;
  for (int unit = lbid(); unit < 32 * nj; unit += lgdim()) {
    const int bh = unit / nj, j = j0 + unit % nj, b = bh >> 2, hd = bh & 3;
    const int row0 = (j < 2) ? NL + b * 256 + j * 128 : b * 2048 + (j - 2) * 128;
    const int cc = dir ? (j < 2 ? 1 - j : 19 - j) : j;
    const int chain = b * 8 + hd * 2 + dir;
    __syncthreads();
#pragma unroll
    for (int n = 0; n < 4; ++n) {
      const int ii = wid * 4 + n;
      { const int ch = ii >> 1, rh = ii & 1;
        const bf16_t* src = p.km + (size_t)(row0 + rh * 64 + lane) * 512 + hd * 128 + ch * 8;
        __builtin_amdgcn_global_load_lds((const unsigned*)src, (LAS unsigned*)(lds + ch * 2048 + rh * 1024), 16, 0, 0); }
      { const int qd = ii >> 3, rg = ii & 7;
        const bf16_t* src = p.proj + (size_t)(row0 + rg * 16 + (lane >> 2)) * PROJW + 1792 + hd * 128 + qd * 32 + (lane & 3) * 8;
        __builtin_amdgcn_global_load_lds((const unsigned*)src, (LAS unsigned*)(lds + 32768 + qd * 8192 + rg * 1024), 16, 0, 0); }
    }
    if (tid < 256) GC[tid] = p.gsG[(size_t)(row0 + (tid & 127)) * 8 + (tid >> 7) * 4 + hd];
    const int trow = row0 + tb * 32 + r32;
    bf16x8 qf[8];
#pragma unroll
    for (int ks = 0; ks < 8; ++ks) qf[ks] = *(const bf16x8*)(p.qm + (size_t)trow * 512 + hd * 128 + ks * 16 + hi * 8);
    const float R2 = p.gsR[(size_t)trow * 8 + dir * 4 + hd], BQ2 = p.gsB[(size_t)trow * 8 + dir * 4 + hd];
    const float MIN2 = p.cMIN[chain * 18 + cc];
    f32x16 acc[4];
#pragma unroll
    for (int eb = 0; eb < 4; ++eb)
#pragma unroll
      for (int r = 0; r < 16; ++r) acc[eb][r] = 0.f;
    float nq = 0.f;
    if (cc > 0) {
      const bf16_t* Cp = p.Cbf + ((size_t)chain * 18 + cc) * 16384 + (size_t)r32 * 128 + hi * 8;
#pragma unroll
      for (int eb = 0; eb < 4; ++eb)
#pragma unroll
        for (int ks = 0; ks < 8; ++ks) {
          const bf16x8 a = *(const bf16x8*)(Cp + (size_t)eb * 32 * 128 + ks * 16);
          acc[eb] = __builtin_amdgcn_mfma_f32_32x32x16_bf16(a, qf[ks], acc[eb], 0, 0, 0);
        }
      const float* nvp = p.NVb + ((size_t)chain * 18 + cc) * 128 + hi * 8;
#pragma unroll
      for (int ks = 0; ks < 8; ++ks) {
        const f32x4 n0 = *(const f32x4*)(nvp + ks * 16), n1 = *(const f32x4*)(nvp + ks * 16 + 4);
        float qv[8];
        unpack8(__builtin_bit_cast(u32x4, qf[ks]), qv);
        nq += n0[0] * qv[0] + n0[1] * qv[1] + n0[2] * qv[2] + n0[3] * qv[3] + n1[0] * qv[4] + n1[1] * qv[5] + n1[2] * qv[6] + n1[3] * qv[7];
      }
      nq = half_swap_add(nq);
    }
    const float winter = __builtin_amdgcn_exp2f(MIN2 + R2);
#pragma unroll
    for (int eb = 0; eb < 4; ++eb)
#pragma unroll
      for (int r = 0; r < 16; ++r) acc[eb][r] *= winter;
    asm volatile("s_waitcnt vmcnt(0)" ::: "memory");
    __syncthreads();
    float sw = 0.f;
    const int sb_lo = dir ? tb : 0, sb_hi = dir ? 3 : tb;
    for (int sb = sb_lo; sb <= sb_hi; ++sb) {
      f32x16 st;
#pragma unroll
      for (int r = 0; r < 16; ++r) st[r] = 0.f;
#pragma unroll
      for (int ks = 0; ks < 8; ++ks) {
        const bf16x8 kf = *(const LAS bf16x8*)(lds + (2 * ks + hi) * 2048 + (sb * 32 + r32) * 16);
        st = __builtin_amdgcn_mfma_f32_32x32x16_bf16(kf, qf[ks], st, 0, 0, 0);
      }
      const bool diag = (sb == tb);
#pragma unroll
      for (int g4 = 0; g4 < 4; ++g4) {
        const f32x4 gc = *(const LAS f32x4*)(GC + dir * 128 + sb * 32 + 8 * g4 + 4 * hi);
#pragma unroll
        for (int q = 0; q < 4; ++q) {
          const int sl = 8 * g4 + 4 * hi + q;
          float w = __builtin_amdgcn_exp2f(R2 + gc[q]) * st[4 * g4 + q];
          const bool keep = !diag || (dir ? (sl >= r32) : (sl <= r32));
          w = keep ? w : 0.f;
          sw += w;
          st[4 * g4 + q] = w;
        }
      }
      u32x4 p0, p1;
      p0.x = cvt_pk_bf16(st[0], st[1]); p0.y = cvt_pk_bf16(st[2], st[3]); p0.z = cvt_pk_bf16(st[4], st[5]); p0.w = cvt_pk_bf16(st[6], st[7]);
      p1.x = cvt_pk_bf16(st[8], st[9]); p1.y = cvt_pk_bf16(st[10], st[11]); p1.z = cvt_pk_bf16(st[12], st[13]); p1.w = cvt_pk_bf16(st[14], st[15]);
      const bf16x8 pw0 = __builtin_bit_cast(bf16x8, p0), pw1 = __builtin_bit_cast(bf16x8, p1);
#pragma unroll
      for (int eb = 0; eb < 4; ++eb) {
        const int rb = sb * 32 + 4 * hi;
        const bf16x8 a0 = cat44(vtr((lds_cptr)(lds + 32768 + trq_addr(lane, eb, rb))), vtr((lds_cptr)(lds + 32768 + trq_addr(lane, eb, rb + 8))));
        const bf16x8 a1 = cat44(vtr((lds_cptr)(lds + 32768 + trq_addr(lane, eb, rb + 16))), vtr((lds_cptr)(lds + 32768 + trq_addr(lane, eb, rb + 24))));
        acc[eb] = __builtin_amdgcn_mfma_f32_32x32x16_bf16(a0, pw0, acc[eb], 0, 0, 0);
        acc[eb] = __builtin_amdgcn_mfma_f32_32x32x16_bf16(a1, pw1, acc[eb], 0, 0, 0);
      }
    }
    sw = half_swap_add(sw);
    const float den = winter * nq + sw;
    const float dn = fmaxf(fabsf(den), __builtin_amdgcn_exp2f(R2 - BQ2));
    const float idn = 1.f / dn;
    if (dir == 1) {
#pragma unroll
      for (int eb = 0; eb < 4; ++eb)
#pragma unroll
        for (int r = 0; r < 16; ++r) HX[(tb * 128 + eb * 32 + (r & 3) + 8 * (r >> 2) + 4 * hi) * 32 + r32] = acc[eb][r] * idn;
    }
    __syncthreads();
    if (dir == 0) {
      float ss = 0.f;
#pragma unroll
      for (int eb = 0; eb < 4; ++eb)
#pragma unroll
        for (int r = 0; r < 16; ++r) {
          const float v = acc[eb][r] * idn + HX[(tb * 128 + eb * 32 + (r & 3) + 8 * (r >> 2) + 4 * hi) * 32 + r32];
          acc[eb][r] = v; ss += v * v;
        }
      ss = half_swap_add(ss);
      const float inv = rsqrtf(ss * (1.f / 128.f) + EPS);
      const float* gh = p.g_hnorm + e2 * 512 + hd * 128;
      const bf16_t* obp = p.proj + (size_t)trow * PROJW + 2304 + hd * 128;
      bf16_t* op = p.mix + (size_t)trow * 1024 + 512 + hd * 128;
#pragma unroll
      for (int eb = 0; eb < 4; ++eb)
#pragma unroll
        for (int g4 = 0; g4 < 4; ++g4) {
          const int e0 = eb * 32 + 8 * g4 + 4 * hi;
          const f32x4 gv = *(const f32x4*)(gh + e0);
          const u32x2 ow = *(const u32x2*)(obp + e0);
          const float ob0 = __uint_as_float(ow.x << 16), ob1 = __uint_as_float(ow.x & 0xffff0000u), ob2 = __uint_as_float(ow.y << 16), ob3 = __uint_as_float(ow.y & 0xffff0000u);
          const float v0 = acc[eb][4 * g4 + 0] * inv * gv[0] * sigmoidf_(ob0), v1 = acc[eb][4 * g4 + 1] * inv * gv[1] * sigmoidf_(ob1);
          const float v2 = acc[eb][4 * g4 + 2] * inv * gv[2] * sigmoidf_(ob2), v3 = acc[eb][4 * g4 + 3] * inv * gv[3] * sigmoidf_(ob3);
          u32x2 w; w.x = cvt_pk_bf16(v0, v1); w.y = cvt_pk_bf16(v2, v3);
          *(u32x2*)(op + e0) = w;
        }
    }
  }
  __syncthreads();
}

__device__ __forceinline__ void ph_topk(const Params& p, bool ctx, float* sm) {
  const int tid = ltid(), lane = tid & 63, wv = tid >> 6;
  unsigned* cnt = (unsigned*)sm;
  unsigned* pre = (unsigned*)sm + 32;
  int* sel = (int*)sm + 64;
  const int ncol = ctx ? 256 : 128;
  for (int colu = lbid(); colu < ncol; colu += lgdim()) {
    int e, base, n, cap; size_t mbase;
    if (colu < 128) { const int b = colu >> 4; e = colu & 15; base = b * 2048; n = 2048; cap = 256; mbase = (size_t)e * 2048 + (size_t)b * 256; }
    else { const int c2 = colu - 128, b = c2 >> 4; e = c2 & 15; base = NL + b * 256; n = 256; cap = 32; mbase = (size_t)MOE_L + (size_t)e * 256 + (size_t)b * 32; }
    unsigned v[4];
#pragma unroll
    for (int k = 0; k < 4; ++k) { const int i = tid * 4 + k; v[k] = i < n ? __float_as_uint(p.aff[(size_t)(base + i) * 16 + e]) : 0u; }
    unsigned thr = 0u;
    for (int bit = 30; bit >= 0; --bit) {
      const unsigned cand = thr | (1u << bit);
      unsigned c = (v[0] >= cand) + (v[1] >= cand) + (v[2] >= cand) + (v[3] >= cand);
#pragma unroll
      for (int o = 32; o > 0; o >>= 1) c += __shfl_xor(c, o);
      unsigned* cb = cnt + (bit & 1) * 8;
      if (lane == 0) cb[wv] = c;
      __syncthreads();
      const unsigned tot = cb[0] + cb[1] + cb[2] + cb[3] + cb[4] + cb[5] + cb[6] + cb[7];
      if (tot >= (unsigned)cap) thr = cand;
    }
    unsigned ngt = (v[0] > thr) + (v[1] > thr) + (v[2] > thr) + (v[3] > thr);
    unsigned neq = (v[0] == thr) + (v[1] == thr) + (v[2] == thr) + (v[3] == thr);
    unsigned igt = ngt, ieq = neq;
#pragma unroll
    for (int o = 1; o < 64; o <<= 1) { const unsigned a = __shfl_up(igt, o), b2 = __shfl_up(ieq, o); if (lane >= o) { igt += a; ieq += b2; } }
    __syncthreads();
    if (lane == 63) { pre[wv] = igt; pre[8 + wv] = ieq; }
    __syncthreads();
    unsigned totgt = 0, offgt = 0, offeq = 0;
#pragma unroll
    for (int w2 = 0; w2 < 8; ++w2) { const unsigned a = pre[w2], b2 = pre[8 + w2]; totgt += a; if (w2 < wv) { offgt += a; offeq += b2; } }
    const unsigned need_eq = (unsigned)cap - totgt;
    unsigned egt = offgt + igt - ngt, eeq = offeq + ieq - neq;
#pragma unroll
    for (int k = 0; k < 4; ++k) {
      const int i = tid * 4 + k;
      const bool gt = v[k] > thr, eq = v[k] == thr;
      const bool take = gt || (eq && eeq < need_eq);
      if (i < n) {
        const int r = base + i;
        const unsigned slot = egt + (eeq < need_eq ? eeq : need_eq);
        if (take) { p.slotmap[(size_t)r * 16 + e] = (int)slot; p.rowidx[mbase + slot] = r; p.gatev[mbase + slot] = __uint_as_float(v[k]); sel[slot] = r; }
        else p.slotmap[(size_t)r * 16 + e] = -1;
      }
      egt += gt; eeq += eq;
    }
    __syncthreads();
    for (int sl = wv; sl < cap; sl += NTHR / 64) {
      const int r = sel[sl];
      const u32x4* src = (const u32x4*)(p.hbuf + (size_t)r * 1024);
      u32x4* dst = (u32x4*)(p.Xs + (mbase + sl) * 1024);
      dst[lane] = src[lane]; dst[64 + lane] = src[64 + lane];
    }
    __syncthreads();
  }
}

__device__ __forceinline__ void ph_pool(const Params& p, int nrows) {
  const size_t gtid = (size_t)lbid() * NTHR + ltid(), gsz = (size_t)lgdim() * NTHR;
  for (size_t it = gtid; it < (size_t)nrows * 128; it += gsz) {
    const int r = (int)(it >> 7), c8 = (int)(it & 127) * 8;
    int t, n;
    if (r < NL) { t = r & 2047; n = 2048; } else { t = (r - NL) & 255; n = 256; }
    const int w = 2 << (c8 >> 8), lo = w >> 1, hi = w - 1 - lo;
    const int a = max(t - lo, 0), en = min(t + hi, n - 1);
    const bf16_t* up = p.proj + (size_t)r * 1024 + c8;
    float s8[8], f[8], uc[8];
#pragma unroll
    for (int j = 0; j < 8; ++j) s8[j] = 0.f;
    for (int tt = a; tt <= en; ++tt) {
      unpack8(*(const u32x4*)(up + (ptrdiff_t)(tt - t) * 1024), f);
#pragma unroll
      for (int j = 0; j < 8; ++j) s8[j] += f[j];
    }
    unpack8(*(const u32x4*)up, uc);
    const float ic = 1.f / (float)(en - a + 1);
#pragma unroll
    for (int j = 0; j < 8; ++j) f[j] = s8[j] * ic - uc[j];
    *(u32x4*)(p.mix + (size_t)r * 1024 + c8) = pack8(f);
  }
}

enum { PH_INIT = 0, PH_NORM1, PH_GEMM_IN_EVEN, PH_POST_EVEN, PH_ATT, PH_MLSTM_U, PH_MLSTM_SCAN, PH_MLSTM_H, PH_GEMM_OUT, PH_NORM2, PH_TOPK, PH_GATHER,
       PH_MOE_GU, PH_MOE_D, PH_GEMM_IN_ODD, PH_POOL, PH_GEMM_GRP, PH_FINAL };

typedef const __attribute__((address_space(4))) Params* KParams;
__device__ __forceinline__ const Params& get_params() {
  KParams kp = (KParams)__builtin_amdgcn_kernarg_segment_ptr();
  asm volatile("" : "+s"(kp));
  return *(const Params*)kp;
}
__device__ __forceinline__ void run_phase(int ph, int l, unsigned char* shm) {
  const Params& p = get_params();
  float* sm = (float*)shm;
  LAS unsigned char* lds = (LAS unsigned char*)shm;
  const bool ctx_next = (l < 2);
  const bool ctx_used = (l < 3);
  const int G = lgdim(), c = lbid();
  switch (ph) {
    case PH_INIT: ph_init(p, sm); break;
    case PH_NORM1: {
      const int ncomb = (l == 0) ? 0 : ((l - 1) < 2 ? NT : NL);
      ph_norm(p, l, 1, ctx_used ? NT : NL, ncomb, l - 1, sm);
    } break;
    case PH_GEMM_IN_EVEN: {
      g8::SchedDense S{(const char*)p.hbuf, (const char*)(p.WinE + (size_t)(l >> 1) * PROJW * 1024), 1024, 1024, NT / 256, PROJW / 256, 0, G, c};
      g8::EpiBf16 E{p.proj, PROJW};
      g8::gemm_phase(lds, 1024, 1024, 1024, S, E);
    } break;
    case PH_POST_EVEN: ph_post_even(p, l, sm); break;
    case PH_MLSTM_U: ph_mlstm_u(p, lds); break;
    case PH_ATT: ph_att(p, ctx_next, lds); ph_mlstm_scan(p, ctx_next ? 64 : 0); break;
    case PH_MLSTM_H: ph_mlstm_h(p, l, ctx_next, lds); break;
    case PH_GEMM_OUT: {
      g8::SchedDense S{(const char*)p.mix, (const char*)(p.WoutE + (size_t)(l >> 1) * 1024 * 1024), 1024, 1024, (ctx_next ? NT : NL) / 256, 4, 0, G, c};
      g8::EpiResid E{p.xcur, p.mod + (size_t)l * 9 * 6144 + 2 * 1024, nullptr, l == 0 ? p.x : nullptr, p.ctx};
      g8::gemm_phase(lds, 1024, 1024, 1024, S, E);
    } break;
    case PH_NORM2: ph_norm(p, l, 2, ctx_next ? NT : NL, 0, 0, sm); break;
    case PH_TOPK: ph_topk(p, ctx_next, sm); break;
    case PH_MOE_GU: {
      g8::SchedMoe S{(const char*)p.Xs, (const char*)(p.Wgu + (size_t)l * NEXP * 2048 * 1024), 8, 2048, 128, ctx_next ? 1152 : 1024, G, c};
      g8::EpiSwiGLU E{p.Abuf};
      g8::gemm_phase(lds, 1024, 1024, 1024, S, E);
    } break;
    case PH_MOE_D: {
      g8::SchedMoe S{(const char*)p.Abuf, (const char*)(p.Wd + (size_t)l * NEXP * 1024 * 1024), 4, 1024, 256, ctx_next ? 576 : 512, G, c};
      g8::EpiDown E{p.Ybuf, p.gatev};
      g8::gemm_phase(lds, 1024, 1024, 1024, S, E);
    } break;
    case PH_GEMM_IN_ODD: {
      g8::SchedDense S{(const char*)p.hbuf, (const char*)(p.WinO + (size_t)(l >> 1) * 1024 * 1024), 1024, 1024, (ctx_next ? NT : NL) / 256, 4, 0, G, c};
      g8::EpiBf16 E{p.proj, 1024};
      g8::gemm_phase(lds, 1024, 1024, 1024, S, E);
    } break;
    case PH_POOL: ph_pool(p, ctx_next ? NT : NL); break;
    case PH_GEMM_GRP: {
      g8::SchedDense S{(const char*)p.mix, (const char*)(p.Wgrp + (size_t)(l >> 1) * 1024 * 256), 1024, 256, (ctx_next ? NT : NL) / 256, 4, 512, G, c};
      g8::EpiResid E{p.xcur, p.mod + (size_t)l * 9 * 6144 + 2 * 1024, p.s_pool + (size_t)(l >> 1) * 1024, nullptr, nullptr};
      g8::gemm_phase(lds, 256, 1024, 256, S, E);
    } break;
    case PH_FINAL: ph_norm(p, 3, 3, NL, NL, 3, sm); break;
  }
}

__global__ void __launch_bounds__(NTHR) mega_kernel(Params p) {
  extern __shared__ __attribute__((aligned(16))) unsigned char shm[];
  cg::grid_group grid = cg::this_grid();
  volatile LAS unsigned* st = (volatile LAS unsigned*)((LAS unsigned char*)shm + g8::STAGE_BYTES + 1536);
  if (threadIdx.x < 2) st[threadIdx.x] = 0u;
  __syncthreads();
  unsigned* barw;
  { const Params& q = get_params(); barw = q.barw; }
  const XcdBarrier xb = xcd_barrier_post(barw, st);
  const int nprog = p.nprog;
  for (int i = 0; i < nprog; ++i) {
    int ph, l;
    { const Params& q = get_params(); ph = q.prog_ph[i]; l = q.prog_l[i]; }
    run_phase(ph, l, shm);
    if (i + 1 < nprog) { if (i == 0) grid.sync(); else xcd_barrier(xb); }
  }
}

extern "C" void kernel_launch(void* const* d_in, const int* in_sizes, int n_in, void* d_out, int out_size, void* d_ws, size_t ws_size,
                              hipStream_t stream) {
  Params p{};
  const float* const* in = (const float* const*)d_in;
  p.x = in[0]; p.c = in[1]; p.ctx = in[2]; p.c_ctx = in[3]; p.w_mod = in[4]; p.b_mod = in[5]; p.g_norm1 = in[6]; p.g_norm2 = in[7];
  p.w_in_even = in[8]; p.w_out_even = in[9]; p.g_qnorm = in[10]; p.g_knorm = in[11]; p.w_conv = in[12]; p.b_gate = in[13];
  p.g_hnorm = in[14]; p.w_in_odd = in[15]; p.w_pool_grp = in[16]; p.s_pool = in[17]; p.w_router = in[18]; p.w_exp_gate = in[19];
  p.w_exp_up = in[20]; p.w_exp_down = in[21]; p.g_final = in[22];
  p.out = (float*)d_out;
  char* w = (char*)d_ws;
  size_t off = 0;
  auto take = [&](size_t bytes) { char* r = w + off; off += (bytes + 255) & ~(size_t)255; return (void*)r; };
  p.xcur = (float*)take((size_t)NT * 1024 * 4);
  p.mod = (float*)take(4 * 9 * 6144 * 4);
  p.hbuf = (bf16_t*)take((size_t)NT * 1024 * 2);
  p.Ybuf = (bf16_t*)take((size_t)MOE_T * 1024 * 2);
  p.gatev = (float*)take(MOE_T * 4);
  p.rowidx = (int*)take(MOE_T * 4);
  p.slotmap = (int*)take((size_t)NT * 16 * 4);
  p.barw = (unsigned*)take(XCD_BAR_WORDS * 4);
  p.aff = (float*)take((size_t)NT * 16 * 4);
  p.gates = (float*)take((size_t)NT * 16 * 4);
  p.WinE = (bf16_t*)take((size_t)2 * PROJW * 1024 * 2);
  p.WoutE = (bf16_t*)take((size_t)2 * 1024 * 1024 * 2);
  p.WinO = (bf16_t*)take((size_t)2 * 1024 * 1024 * 2);
  p.Wgrp = (bf16_t*)take((size_t)2 * 1024 * 256 * 2);
  p.Wgu = (bf16_t*)take((size_t)4 * NEXP * 2048 * 1024 * 2);
  p.Wd = (bf16_t*)take((size_t)4 * NEXP * 1024 * 1024 * 2);
  const size_t uoff = off;
  p.proj = (bf16_t*)take((size_t)NT * PROJW * 2);
  p.Qb = (bf16_t*)take((size_t)NT * 512 * 2);
  p.Kb = (bf16_t*)take((size_t)NB * 2 * 2304 * 64 * 2);
  p.Vb = (bf16_t*)take((size_t)NB * 2 * 2304 * 64 * 2);
  p.qm = (bf16_t*)take((size_t)NT * 512 * 2);
  p.km = (bf16_t*)take((size_t)NT * 512 * 2);
  p.gsG = (float*)take((size_t)NT * 8 * 4);
  p.gsR = (float*)take((size_t)NT * 8 * 4);
  p.gsB = (float*)take((size_t)NT * 8 * 4);
  p.cMIN = (float*)take(64 * 18 * 4);
  p.cE1 = (float*)take(64 * 18 * 4);
  p.cDEC = (float*)take(64 * 18 * 4);
  p.Ubuf = (float*)take((size_t)64 * 17 * 16384 * 4);
  p.NLb = (float*)take((size_t)64 * 17 * 128 * 4);
  p.NVb = (float*)take((size_t)64 * 18 * 128 * 4);
  p.Cbf = (bf16_t*)take((size_t)64 * 18 * 16384 * 2);
  p.mix = (bf16_t*)take((size_t)NT * 1024 * 2);
  const size_t uend = off;
  off = uoff;
  p.Xs = (bf16_t*)take((size_t)MOE_T * 1024 * 2);
  p.Abuf = (bf16_t*)take((size_t)MOE_T * 1024 * 2);
  if (off < uend) off = uend;
  if (off > ws_size) { fprintf(stderr, "ws too small: need %zu have %zu\n", off, ws_size); return; }

  int n = 0;
  auto add = [&](int ph, int l) { p.prog_ph[n] = (unsigned char)ph; p.prog_l[n] = (unsigned char)l; ++n; };
  add(PH_INIT, 0);
  for (int l = 0; l < 4; ++l) {
    add(PH_NORM1, l);
    if ((l & 1) == 0) {
      add(PH_GEMM_IN_EVEN, l); add(PH_POST_EVEN, l); add(PH_MLSTM_U, l); add(PH_ATT, l); add(PH_MLSTM_H, l); add(PH_GEMM_OUT, l);
    } else {
      add(PH_GEMM_IN_ODD, l); add(PH_POOL, l); add(PH_GEMM_GRP, l);
    }
    add(PH_NORM2, l); add(PH_TOPK, l); add(PH_MOE_GU, l); add(PH_MOE_D, l);
  }
  add(PH_FINAL, 0);
  p.nprog = n;

  const int LDS = g8::STAGE_BYTES + 2048;
  static int grid_blocks = 0;
  if (!grid_blocks) {
    (void)hipFuncSetAttribute((const void*)mega_kernel, hipFuncAttributeMaxDynamicSharedMemorySize, LDS);
    int dev = 0, cus = 0, per_cu = 0;
    (void)hipGetDevice(&dev);
    (void)hipDeviceGetAttribute(&cus, hipDeviceAttributeMultiprocessorCount, dev);
    (void)hipOccupancyMaxActiveBlocksPerMultiprocessor(&per_cu, mega_kernel, NTHR, LDS);
    if (per_cu < 1) per_cu = 1;
    if (per_cu > 1) per_cu = 1;
    grid_blocks = cus * per_cu;
  }
  (void)hipMemsetAsync(p.barw, 0, XCD_BAR_WORDS * 4, stream);
  void* args[] = {&p};
  hipError_t e = hipLaunchCooperativeKernel((void*)mega_kernel, dim3(grid_blocks), dim3(NTHR), args, LDS, stream);
  if (e != hipSuccess) fprintf(stderr, "cooperative launch failed: %s (grid %d)\n", hipGetErrorString(e), grid_blocks);
}
```

```cpp
#include <hip/hip_runtime.h>
#include <hip/hip_cooperative_groups.h>
#include <math.h>
#include <stdio.h>
namespace cg = cooperative_groups;

#define DM 1024
#define NB 8
#define SEQ 2048
#define CTXL 256
#define NL (NB * SEQ)
#define NC (NB * CTXL)
#define NT (NL + NC)
#define EVEN_IN 2832
#define PROJW 2816
#define NEXP 16
#define MOE_L (NEXP * NB * 256)
#define MOE_C (NEXP * NB * 32)
#define MOE_T (MOE_L + MOE_C)
#define EPS 1e-6f
#define NTHR 512
#define LAS __attribute__((address_space(3)))

typedef unsigned short bf16_t;
typedef short bf16x8 __attribute__((ext_vector_type(8)));
typedef float f32x4 __attribute__((ext_vector_type(4)));
typedef unsigned u32x4 __attribute__((ext_vector_type(4)));
typedef unsigned u32x2 __attribute__((ext_vector_type(2)));

struct Params {
  const float *x, *c, *ctx, *c_ctx, *w_mod, *b_mod, *g_norm1, *g_norm2, *w_in_even, *w_out_even, *g_qnorm, *g_knorm,
      *w_conv, *b_gate, *g_hnorm, *w_in_odd, *w_pool_grp, *s_pool, *w_router, *w_exp_gate, *w_exp_up, *w_exp_down, *g_final;
  float* out;
  float *xcur, *mod, *gates, *aff, *gatev, *gsG, *gsR, *gsB, *cMIN, *cE1, *cDEC, *Ubuf, *NLb, *NVb;
  bf16_t *hbuf, *proj, *mix, *Xs, *Abuf, *Ybuf, *Qb, *Kb, *Vb, *qm, *km, *Cbf;
  bf16_t *WinE, *WoutE, *WinO, *Wgrp, *Wgu, *Wd;
  int *rowidx, *slotmap;
  unsigned* barw;
  int nprog;
  unsigned char prog_ph[60], prog_l[60];
};

__device__ __forceinline__ float siluf(float v) { return v / (1.f + expf(-v)); }
__device__ __forceinline__ float sigmoidf_(float v) { return 1.f / (1.f + expf(-v)); }
__device__ __forceinline__ float logsigmoidf_(float v) { return fminf(v, 0.f) - log1pf(expf(-fabsf(v))); }
__device__ __forceinline__ float wave_sum(float v) {
#pragma unroll
  for (int o = 32; o > 0; o >>= 1) v += __shfl_xor(v, o);
  return v;
}
__device__ __forceinline__ int modrow(int r) { return r < NL ? (r >> 11) : 8; }
__device__ __forceinline__ float bf2f(bf16_t v) { return __uint_as_float(((unsigned)v) << 16); }
typedef float f32x2_t __attribute__((ext_vector_type(2)));
typedef __bf16 bf16x2_t __attribute__((ext_vector_type(2)));
__device__ __forceinline__ unsigned cvt_pk_bf16(float lo, float hi) {
  const f32x2_t v = {lo, hi};
  return __builtin_bit_cast(unsigned, __builtin_convertvector(v, bf16x2_t));
}
__device__ __forceinline__ bf16_t f2bf(float f) { return (bf16_t)(cvt_pk_bf16(f, 0.f) & 0xffffu); }

__device__ __forceinline__ int ltid() { int t = threadIdx.x; asm volatile("" : "+v"(t)); return t; }
__device__ __forceinline__ int lbid() { int b = blockIdx.x; asm volatile("" : "+s"(b)); return b; }
__device__ __forceinline__ int lgdim() { int g = gridDim.x; asm volatile("" : "+s"(g)); return g; }

#define XB_TMO      128
#define XB_XCNT(j)  (256  + 64 * (j))
#define XB_XSUB(j)  (1280 + 64 * (j))
#define XB_XGEN(j)  (2304 + 64 * (j))
#define XB_TOP      3328
#define XB_TOPGEN   3392
#define XCD_BAR_WORDS 3456
#define XB_SPIN_CAP (1u << 18)
__device__ __forceinline__ unsigned xb_ld(unsigned* p)              { return __hip_atomic_load(p, __ATOMIC_RELAXED, __HIP_MEMORY_SCOPE_AGENT); }
__device__ __forceinline__ unsigned xb_add(unsigned* p, unsigned v) { return __hip_atomic_fetch_add(p, v, __ATOMIC_RELAXED, __HIP_MEMORY_SCOPE_AGENT); }
__device__ __forceinline__ unsigned xb_xcc_id() { return (unsigned)__builtin_amdgcn_s_getreg((3 << 11) | 20) & 0xFu; }
#define XB_SPIN(cond, bar) do { unsigned _sp = 0; while (cond) { __builtin_amdgcn_s_sleep(1); \
    if ((++_sp & 255u) == 0u) { if (xb_ld(&(bar)[XB_TMO])) break; if (_sp > XB_SPIN_CAP) { atomicAdd(&(bar)[XB_TMO], 1u); break; } } } } while (0)
struct XcdBarrier { unsigned* bar; unsigned x; volatile LAS unsigned* st; };
__device__ __forceinline__ XcdBarrier xcd_barrier_post(unsigned* bar, volatile LAS unsigned* st) {
  XcdBarrier b; b.bar = bar; b.x = xb_xcc_id(); b.st = st;
  if (threadIdx.x == 0) (void)xb_add(&bar[XB_XCNT(b.x)], 1u);
  return b;
}
__device__ __forceinline__ void xcd_barrier_complete(unsigned* bar, unsigned x, unsigned& nloc, unsigned& nx) {
  const unsigned G = gridDim.x * gridDim.y * gridDim.z;
  unsigned sum, cnt, mine, sp = 0u;
  for (;;) {
    sum = 0u; cnt = 0u; mine = 0u;
#pragma unroll
    for (unsigned j = 0; j < 16; ++j) { const unsigned c = xb_ld(&bar[XB_XCNT(j)]); sum += c; cnt += (c > 0u) ? 1u : 0u; mine = (j == x) ? c : mine; }
    if (sum == G) break;
    __builtin_amdgcn_s_sleep(1);
    if ((++sp & 255u) == 0u) { if (xb_ld(&bar[XB_TMO])) break; if (sp > XB_SPIN_CAP) { atomicAdd(&bar[XB_TMO], 1u); break; } }
  }
  nloc = mine > 0u ? mine : 1u; nx = cnt > 0u ? cnt : 1u;
}
__device__ __forceinline__ void xcd_barrier(const XcdBarrier& b) {
  asm volatile("s_waitcnt vmcnt(0)" ::: "memory");
  __syncthreads();
  if (threadIdx.x == 0) {
    unsigned* bar = b.bar;
    __builtin_amdgcn_s_waitcnt(0);
    unsigned nloc = b.st[0], nx = b.st[1];
    if (nloc == 0u) { xcd_barrier_complete(bar, b.x, nloc, nx); b.st[0] = nloc; b.st[1] = nx; }
    const unsigned old = xb_add(&bar[XB_XSUB(b.x)], 1u);
    const unsigned gen = old / nloc;
    if (old + 1u == (gen + 1u) * nloc) {
      __builtin_amdgcn_fence(__ATOMIC_RELEASE, "agent");
      asm volatile("s_waitcnt vmcnt(0)" ::: "memory");
      const unsigned og = xb_add(&bar[XB_TOP], 1u);
      const unsigned tg = og / nx;
      if (og + 1u == (tg + 1u) * nx) xb_add(&bar[XB_TOPGEN], 1u);
      else XB_SPIN(xb_ld(&bar[XB_TOPGEN]) == tg, bar);
      __builtin_amdgcn_fence(__ATOMIC_ACQUIRE, "agent");
      xb_add(&bar[XB_XGEN(b.x)], 1u);
      asm volatile("s_waitcnt vmcnt(0)" ::: "memory");
    } else {
      XB_SPIN(xb_ld(&bar[XB_XGEN(b.x)]) == gen, bar);
      __builtin_amdgcn_fence(__ATOMIC_ACQUIRE, "agent");
      asm volatile("s_waitcnt vmcnt(0)" ::: "memory");
    }
  }
  __syncthreads();
}

namespace g8 {
constexpr int BM = 256, BK = 64, HALF = 128, HTB = HALF * BK * 2, STAGE_BYTES = 8 * HTB;
__device__ __forceinline__ int lds_byte(int r, int c) { const int st = (r >> 4) * 2 + (c >> 5), rr = r & 15, cc = c & 31, ob = rr * 64 + cc * 2; return st * 1024 + (ob ^ (((ob >> 9) & 1) << 5)); }
__device__ __forceinline__ void stage_rc(int b, int& R, int& C) { const int st = b / 1024, sb = b % 1024, swz = sb ^ (((sb >> 9) & 1) << 5); R = (st >> 1) * 16 + swz / 64; C = (st & 1) * 32 + (swz % 64) / 2; }
__device__ __forceinline__ int perm32(int rho) { const int n = rho >> 4, i = rho & 15; return 8 * (i >> 2) + 4 * n + (i & 3); }

struct Unit { const char* A; const char* B; int row0, col0; };

template <class Epi, class Sched>
__device__ __forceinline__ void gemm_phase(LAS unsigned char* lds, const int K, const int lda, const int ldb, const Sched& S, const Epi& E) {
  const int tid = ltid(), wid = __builtin_amdgcn_readfirstlane(tid >> 6), lane = tid & 63, wr = wid >> 2, wc = wid & 3, fr = lane & 15, fq = lane >> 4;
  const int nt = K / BK;
  unsigned voffA[2], voffB[2];
#pragma unroll
  for (int i = 0; i < 2; ++i) {
    int R, C;
    stage_rc(tid * 16 + i * 8192, R, C);
    const int Rb = (R & ~31) + perm32(R & 31);
    voffA[i] = (unsigned)(R * lda + C) * 2u;
    voffB[i] = (unsigned)(Rb * ldb + C) * 2u;
  }
  const size_t kstep = (size_t)(BK * 2);
  const size_t hstepA = (size_t)HALF * lda * 2, hstepB = (size_t)HALF * ldb * 2;
  const unsigned ldsw = (unsigned)wid * 1024u;
  const int aoff = lds_byte(wr * 64 + fr, fq * 8), boff = lds_byte(wc * 32 + fr, fq * 8);
#define PG8_SA(b, h) (((b) * 2 + (h)) * HTB)
#define PG8_SB(b, h) ((4 + (b) * 2 + (h)) * HTB)
#define PG8_STAGE(bufoff, gbase, voff) do { _Pragma("unroll") for (int _i = 0; _i < 2; ++_i) \
    __builtin_amdgcn_global_load_lds((const unsigned*)((const char*)(gbase) + (voff)[_i]), (LAS unsigned*)(lds + (bufoff) + ldsw + _i * 8192), 16, 0, 0); } while (0)
#define PG8_LDA(dst, b, h) do { _Pragma("unroll") for (int m = 0; m < 4; ++m) _Pragma("unroll") for (int k = 0; k < 2; ++k) dst[m][k] = *(const LAS bf16x8*)(lds + PG8_SA(b, h) + aoff + m * 2048 + k * 1024); } while (0)
#define PG8_LDB(dst, b, h) do { _Pragma("unroll") for (int n = 0; n < 2; ++n) _Pragma("unroll") for (int k = 0; k < 2; ++k) dst[n][k] = *(const LAS bf16x8*)(lds + PG8_SB(b, h) + boff + n * 2048 + k * 1024); } while (0)
#define PG8_MMA(ai, bj, At, Bt) do { __builtin_amdgcn_s_setprio(1); _Pragma("unroll") for (int m = 0; m < 4; ++m) _Pragma("unroll") for (int n = 0; n < 2; ++n) _Pragma("unroll") for (int k = 0; k < 2; ++k) \
    acc[ai][bj][m][n] = __builtin_amdgcn_mfma_f32_16x16x32_bf16(Bt[n][k], At[m][k], acc[ai][bj][m][n], 0, 0, 0); __builtin_amdgcn_s_setprio(0); } while (0)
#define PG8_WAIT_V(n) asm volatile("s_waitcnt vmcnt(" #n ")" ::: "memory")
#define PG8_WAIT_L(n) asm volatile("s_waitcnt lgkmcnt(" #n ")" ::: "memory")
#define PG8_BAR __builtin_amdgcn_s_barrier()
#define PG8_SCHED __builtin_amdgcn_sched_barrier(0)
  Unit cur, nxt;
  int ui = 0;
  if (!S.next(0, cur)) return;
  f32x4 acc[2][2][4][2];
#pragma unroll
  for (int a = 0; a < 2; ++a)
#pragma unroll
    for (int b = 0; b < 2; ++b)
#pragma unroll
      for (int m = 0; m < 4; ++m)
#pragma unroll
        for (int n = 0; n < 2; ++n) acc[a][b][m][n] = (f32x4){0.f, 0.f, 0.f, 0.f};
  bf16x8 At[4][2], B0[2][2], B1[2][2];
  const char* cA = cur.A;
  const char* cB = cur.B;
  PG8_STAGE(PG8_SB(0, 0), cB, voffB); PG8_STAGE(PG8_SB(0, 1), cB + hstepB, voffB); PG8_STAGE(PG8_SA(0, 0), cA, voffA); PG8_STAGE(PG8_SA(0, 1), cA + hstepA, voffA);
  if (wr == 1) PG8_BAR;
  PG8_WAIT_V(2); PG8_BAR;
  PG8_STAGE(PG8_SB(1, 0), cB + kstep, voffB); PG8_STAGE(PG8_SA(1, 0), cA + kstep, voffA); PG8_STAGE(PG8_SB(1, 1), cB + hstepB + kstep, voffB);
  PG8_WAIT_V(6); PG8_BAR;
  for (;;) {
    const bool has_next = S.next(ui + 1, nxt);
    const char* nA = has_next ? nxt.A : cA;
    const char* nB = has_next ? nxt.B : cB;
    for (int t = 0; t < nt; t += 2) {
      const bool last = (t == nt - 2);
      const char* a1 = cA + (size_t)(t + 1) * kstep;
      const char* a2 = last ? nA : cA + (size_t)(t + 2) * kstep;
      const char* b2 = last ? nB : cB + (size_t)(t + 2) * kstep;
      const char* a3 = a2 + kstep;
      const char* b3 = b2 + kstep;
      PG8_LDB(B0, 0, 0); PG8_LDB(B1, 0, 1); PG8_SCHED; PG8_LDA(At, 0, 0); PG8_STAGE(PG8_SA(1, 1), a1 + hstepA, voffA);
      PG8_WAIT_V(8); PG8_WAIT_L(0); PG8_BAR; PG8_MMA(0, 0, At, B0); PG8_MMA(0, 1, At, B1); PG8_BAR; PG8_SCHED;
      PG8_LDA(At, 0, 1); PG8_STAGE(PG8_SB(0, 0), b2, voffB); PG8_STAGE(PG8_SB(0, 1), b2 + hstepB, voffB); PG8_STAGE(PG8_SA(0, 0), a2, voffA);
      PG8_WAIT_V(8); PG8_WAIT_L(0); PG8_BAR; PG8_MMA(1, 0, At, B0); PG8_MMA(1, 1, At, B1); PG8_BAR; PG8_SCHED;
      PG8_LDB(B0, 1, 0); PG8_LDB(B1, 1, 1); PG8_SCHED; PG8_LDA(At, 1, 0); PG8_STAGE(PG8_SA(0, 1), a2 + hstepA, voffA);
      PG8_WAIT_V(8); PG8_WAIT_L(0); PG8_BAR; PG8_MMA(0, 0, At, B0); PG8_MMA(0, 1, At, B1); PG8_BAR; PG8_SCHED;
      PG8_LDA(At, 1, 1); PG8_STAGE(PG8_SB(1, 0), b3, voffB); PG8_STAGE(PG8_SB(1, 1), b3 + hstepB, voffB); PG8_STAGE(PG8_SA(1, 0), a3, voffA);
      PG8_WAIT_V(8); PG8_WAIT_L(0); PG8_BAR; PG8_MMA(1, 0, At, B0); PG8_MMA(1, 1, At, B1); PG8_BAR; PG8_SCHED;
    }
    if (wr == 0) PG8_BAR;
    E(acc, cur, wr, wc, fr, fq);
    if (!has_next) break;
#pragma unroll
    for (int a = 0; a < 2; ++a)
#pragma unroll
      for (int b = 0; b < 2; ++b)
#pragma unroll
        for (int m = 0; m < 4; ++m)
#pragma unroll
          for (int n = 0; n < 2; ++n) acc[a][b][m][n] = (f32x4){0.f, 0.f, 0.f, 0.f};
    cur = nxt; cA = nA; cB = nB; ++ui;
    if (wr == 1) PG8_BAR;
  }
  PG8_WAIT_V(0);
  PG8_BAR;
#undef PG8_SA
#undef PG8_SB
#undef PG8_STAGE
#undef PG8_LDA
#undef PG8_LDB
#undef PG8_MMA
#undef PG8_WAIT_V
#undef PG8_WAIT_L
#undef PG8_BAR
#undef PG8_SCHED
}

struct SchedDense {
  const char* A; const char* B; int lda, ldb, nM, nN, acolstep, G, c;
  __device__ __forceinline__ bool next(int i, Unit& u) const {
    const int nwg = nM * nN;
    const long L = (long)i * G + c;
    if (L >= nwg) return false;
    int wgid = (int)L;
    { const int q = nwg / 8, r = nwg % 8, xcd = wgid % 8, off = wgid / 8; wgid = (xcd < r ? xcd * (q + 1) : r * (q + 1) + (xcd - r) * q) + off; }
    const int nig = 8 * nN, gid = wgid / nig, fm = gid * 8, gsz = (nM - fm) < 8 ? (nM - fm) : 8;
    const int pm = fm + ((wgid % nig) % gsz), pn = (wgid % nig) / gsz;
    u.A = A + (size_t)pm * 256 * lda * 2 + (size_t)pn * acolstep;
    u.B = B + (size_t)pn * 256 * ldb * 2;
    u.row0 = pm * 256; u.col0 = pn * 256;
    return true;
  }
};
struct SchedMoe {
  const char* A; const char* W; int ncol, wrows, colw, nu, G, c;
  __device__ __forceinline__ bool next(int i, Unit& u) const {
    const long L = (long)i * G + c;
    if (L >= nu) return false;
    const int wgid = (int)(L % 8) * (nu / 8) + (int)(L / 8);
    const int UL = 128 * ncol;
    int e, pn, row0;
    if (wgid < UL) { e = wgid / (8 * ncol); const int rem = wgid % (8 * ncol); row0 = e * 2048 + (rem % 8) * 256; pn = rem / 8; }
    else { const int w2 = wgid - UL; e = w2 / ncol; pn = w2 % ncol; row0 = MOE_L + e * 256; }
    u.A = A + (size_t)row0 * 1024 * 2;
    u.B = W + ((size_t)e * wrows + (size_t)pn * 256) * 1024 * 2;
    u.row0 = row0; u.col0 = pn * colw;
    return true;
  }
};

struct EpiBf16 {
  bf16_t* O; int ldo;
  __device__ __forceinline__ void operator()(const f32x4 (&acc)[2][2][4][2], const Unit& u, int wr, int wc, int fr, int fq) const {
#pragma unroll
    for (int ai = 0; ai < 2; ++ai)
#pragma unroll
      for (int m = 0; m < 4; ++m) {
        const int row = u.row0 + ai * 128 + wr * 64 + m * 16 + fr;
        bf16_t* rp = O + (size_t)row * ldo + u.col0 + wc * 32 + 8 * fq;
#pragma unroll
        for (int bj = 0; bj < 2; ++bj) {
          const f32x4 v0 = acc[ai][bj][m][0], v1 = acc[ai][bj][m][1];
          u32x4 w; w.x = cvt_pk_bf16(v0[0], v0[1]); w.y = cvt_pk_bf16(v0[2], v0[3]); w.z = cvt_pk_bf16(v1[0], v1[1]); w.w = cvt_pk_bf16(v1[2], v1[3]);
          *(u32x4*)(rp + bj * 128) = w;
        }
      }
  }
};
struct EpiResid {
  float* x; const float* modg; const float* cs; const float* xl; const float* xc;
  __device__ __forceinline__ void operator()(const f32x4 (&acc)[2][2][4][2], const Unit& u, int wr, int wc, int fr, int fq) const {
#pragma unroll
    for (int ai = 0; ai < 2; ++ai)
#pragma unroll
      for (int m = 0; m < 4; ++m) {
        const int row = u.row0 + ai * 128 + wr * 64 + m * 16 + fr;
        const int c0 = u.col0 + wc * 32 + 8 * fq;
        float* xp = x + (size_t)row * 1024 + c0;
        const float* xi = xl ? (row < NL ? xl + (size_t)row * 1024 + c0 : xc + (size_t)(row - NL) * 1024 + c0) : xp;
        const float* gp = modg + (size_t)modrow(row) * 6144 + c0;
#pragma unroll
        for (int bj = 0; bj < 2; ++bj) {
          f32x4 g0 = *(const f32x4*)(gp + bj * 128), g1 = *(const f32x4*)(gp + bj * 128 + 4);
          if (cs) { g0 *= *(const f32x4*)(cs + c0 + bj * 128); g1 *= *(const f32x4*)(cs + c0 + bj * 128 + 4); }
          f32x4 x0 = *(const f32x4*)(xi + bj * 128), x1 = *(const f32x4*)(xi + bj * 128 + 4);
          x0 += g0 * acc[ai][bj][m][0]; x1 += g1 * acc[ai][bj][m][1];
          *(f32x4*)(xp + bj * 128) = x0; *(f32x4*)(xp + bj * 128 + 4) = x1;
        }
      }
  }
};
struct EpiSwiGLU {
  bf16_t* O;
  __device__ __forceinline__ void operator()(const f32x4 (&acc)[2][2][4][2], const Unit& u, int wr, int wc, int fr, int fq) const {
#pragma unroll
    for (int ai = 0; ai < 2; ++ai)
#pragma unroll
      for (int m = 0; m < 4; ++m) {
        const int row = u.row0 + ai * 128 + wr * 64 + m * 16 + fr;
        bf16_t* rp = O + (size_t)row * 1024 + u.col0 + wc * 32 + 8 * fq;
        float o[8];
#pragma unroll
        for (int n = 0; n < 2; ++n)
#pragma unroll
          for (int j = 0; j < 4; ++j) { const float g = acc[ai][0][m][n][j], up = acc[ai][1][m][n][j]; o[n * 4 + j] = g / (1.f + __expf(-g)) * up; }
        u32x4 w; w.x = cvt_pk_bf16(o[0], o[1]); w.y = cvt_pk_bf16(o[2], o[3]); w.z = cvt_pk_bf16(o[4], o[5]); w.w = cvt_pk_bf16(o[6], o[7]);
        *(u32x4*)rp = w;
      }
  }
};
struct EpiDown {
  bf16_t* O; const float* gatev;
  __device__ __forceinline__ void operator()(const f32x4 (&acc)[2][2][4][2], const Unit& u, int wr, int wc, int fr, int fq) const {
#pragma unroll
    for (int ai = 0; ai < 2; ++ai)
#pragma unroll
      for (int m = 0; m < 4; ++m) {
        const int row = u.row0 + ai * 128 + wr * 64 + m * 16 + fr;
        const float gv = gatev[row];
        bf16_t* rp = O + (size_t)row * 1024 + u.col0 + wc * 32 + 8 * fq;
#pragma unroll
        for (int bj = 0; bj < 2; ++bj) {
          const f32x4 v0 = acc[ai][bj][m][0] * gv, v1 = acc[ai][bj][m][1] * gv;
          u32x4 w; w.x = cvt_pk_bf16(v0[0], v0[1]); w.y = cvt_pk_bf16(v0[2], v0[3]); w.z = cvt_pk_bf16(v1[0], v1[1]); w.w = cvt_pk_bf16(v1[2], v1[3]);
          *(u32x4*)(rp + bj * 128) = w;
        }
      }
  }
};
}

#define NT_WINE 1408
#define NT_WOUT 512
#define NT_WINO 512
#define NT_WGRP 128
#define NT_EXP 16384
#define NT_ALL (NT_WINE + NT_WOUT + NT_WINO + NT_WGRP + 3 * NT_EXP)
#define CE0 704
#define CE1 960
#define CE2 13248
#define CE3 13504
#define CE4 13568
#define CE5 25856
#define CE6 26560
#define CE7 26816
#define CE8 39104
#define CE9 39360
#define CE10 39424
#define CE11 51712
__device__ __forceinline__ void conv_batch(const Params& p, int t, float* T) {
  const int tid = ltid(), lane = tid & 63, wv = tid >> 6;
  const float* src; bf16_t* dst; int ld, dK, k0, n0;
  int seg, tb, e, which = 0;
  if (t < CE0) { seg = 0; e = 0; tb = t; } else if (t < CE1) { seg = 1; e = 0; tb = t - CE0; } else if (t < CE2) { seg = 2; e = 0; tb = t - CE1; }
  else if (t < CE3) { seg = 3; e = 0; tb = t - CE2; } else if (t < CE4) { seg = 4; e = 0; tb = t - CE3; } else if (t < CE5) { seg = 2; e = 1; tb = t - CE4; }
  else if (t < CE6) { seg = 0; e = 1; tb = t - CE5; } else if (t < CE7) { seg = 1; e = 1; tb = t - CE6; } else if (t < CE8) { seg = 2; e = 2; tb = t - CE7; }
  else if (t < CE9) { seg = 3; e = 1; tb = t - CE8; } else if (t < CE10) { seg = 4; e = 1; tb = t - CE9; } else { seg = 2; e = 3; tb = t - CE10; }
  int dbase = 0;
  if (seg == 0) {
    k0 = (tb / 44) * 64; n0 = (tb % 44) * 64;
    src = p.w_in_even + (size_t)e * 1024 * EVEN_IN; ld = EVEN_IN; dst = p.WinE + (size_t)e * PROJW * 1024; dK = 1024;
  } else if (seg == 1 || seg == 3) {
    k0 = (tb / 16) * 64; n0 = (tb % 16) * 64;
    src = (seg == 3 ? p.w_in_odd : p.w_out_even) + (size_t)e * 1024 * 1024; ld = 1024; dst = (seg == 3 ? p.WinO : p.WoutE) + (size_t)e * 1024 * 1024; dK = 1024;
  } else if (seg == 4) {
    const int g = tb / 16; k0 = ((tb % 16) / 4) * 64; n0 = (tb % 4) * 64;
    src = p.w_pool_grp + (size_t)(e * 4 + g) * 65536; ld = 256; dst = p.Wgrp + (size_t)e * 1024 * 256; dK = 256; dbase = g * 256;
  } else {
    which = tb / 4096; const int r = tb % 4096, le = e * 16 + r / 256; k0 = ((r % 256) / 16) * 64; n0 = (r % 16) * 64;
    const float* base = which == 0 ? p.w_exp_gate : (which == 1 ? p.w_exp_up : p.w_exp_down);
    src = base + (size_t)le * 1024 * 1024; ld = 1024; dK = 1024;
    dst = which < 2 ? p.Wgu + (size_t)le * 2048 * 1024 : p.Wd + (size_t)le * 1024 * 1024;
  }
  const bool gu = (seg == 2 && which < 2);
  float4 v[8];
#pragma unroll
  for (int q = 0; q < 8; ++q) {
    const int idx = tid + q * NTHR, k = idx >> 6, c4 = idx & 63;
    v[q] = *(const float4*)(src + (size_t)(k0 + k) * ld + n0 + c4 * 4);
  }
#pragma unroll
  for (int q = 0; q < 8; ++q) {
    const int idx = tid + q * NTHR, k = idx >> 6, c4 = idx & 63;
    float* tp = T + k * 257 + c4 * 4;
    tp[0] = v[q].x; tp[1] = v[q].y; tp[2] = v[q].z; tp[3] = v[q].w;
  }
  __syncthreads();
#pragma unroll
  for (int sub = 0; sub < 4; ++sub) {
    const int nl = wv * 8 + (lane >> 3), kq = lane & 7, nn = n0 + sub * 64;
    const int drow0 = gu ? (nn >> 7) * 256 + which * 128 + (nn & 127) : dbase + nn;
    float f[8];
#pragma unroll
    for (int j = 0; j < 8; ++j) f[j] = T[(kq * 8 + j) * 257 + sub * 64 + nl];
    u32x4 w; w.x = cvt_pk_bf16(f[0], f[1]); w.y = cvt_pk_bf16(f[2], f[3]); w.z = cvt_pk_bf16(f[4], f[5]); w.w = cvt_pk_bf16(f[6], f[7]);
    *(u32x4*)(dst + (size_t)(drow0 + nl) * dK + k0 + kq * 8) = w;
  }
}
__device__ __forceinline__ int conv_pull(const Params& p, float* sm) {
  __syncthreads();
  if (ltid() == 0) ((int*)sm)[16500] = (int)__hip_atomic_fetch_add(p.barw, 4u, __ATOMIC_RELAXED, __HIP_MEMORY_SCOPE_AGENT);
  __syncthreads();
  return ((int*)sm)[16500];
}
__device__ __forceinline__ void conv_until(const Params& p, int end, float* sm) {
  int t;
  do { t = conv_pull(p, sm); if (t < CE11) conv_batch(p, t, sm); } while (t + 4 < end);
  __syncthreads();
}
__device__ __forceinline__ void conv_quota(const Params& p, int n, float* sm) {
  for (int i = 0; i < n; ++i) { const int t = conv_pull(p, sm); if (t >= CE11) break; conv_batch(p, t, sm); }
  __syncthreads();
}

__device__ __forceinline__ void ph_init(const Params& p, float* sm) {
  const int tid = ltid(), lane = tid & 63, wv = tid >> 6;
  const size_t gtid = (size_t)lbid() * NTHR + tid, gsz = (size_t)lgdim() * NTHR;
  for (int i = tid; i < 9 * 1024; i += NTHR) {
    const int r = i >> 10, k = i & 1023;
    sm[i] = siluf(r < 8 ? p.c[r * 1024 + k] : p.c_ctx[k]);
  }
  __syncthreads();
  float* part = sm + 9 * 1024;
  for (int item = lbid(); item < 768; item += lgdim()) {
    const int l = item / 192, j0 = (item % 192) * 32;
    const int col = lane & 31, kh = lane >> 5;
    const float* w = p.w_mod + (size_t)l * 1024 * 6144 + j0 + col;
    float acc[9];
#pragma unroll
    for (int r = 0; r < 9; ++r) acc[r] = 0.f;
    const int kb = wv * 128 + kh * 64;
#pragma unroll 4
    for (int kk = 0; kk < 64; ++kk) {
      const float wvv = w[(size_t)(kb + kk) * 6144];
#pragma unroll
      for (int r = 0; r < 9; ++r) acc[r] += sm[r * 1024 + kb + kk] * wvv;
    }
#pragma unroll
    for (int r = 0; r < 9; ++r) part[((wv * 2 + kh) * 9 + r) * 32 + col] = acc[r];
    __syncthreads();
    if (tid < 288) {
      const int r = tid >> 5, cc = tid & 31;
      float s = 0.f;
#pragma unroll
      for (int sl = 0; sl < 16; ++sl) s += part[(sl * 9 + r) * 32 + cc];
      p.mod[(size_t)(l * 9 + r) * 6144 + j0 + cc] = s + p.b_mod[l * 6144 + j0 + cc];
    }
    __syncthreads();
  }
  conv_until(p, CE1, sm);
}

#define NORM_R 1
__device__ __forceinline__ void ph_norm(const Params& p, int l, int which, int nrows, int ncomb, int lprev, float* sm) {
  const int tid = ltid(), lane = tid & 63, wv = tid >> 6;
  const bool skinny = (which == 2) || (which == 1 && (l & 1) == 0);
  if (skinny) {
    const float* wbase; int stride;
    if (which == 2) { wbase = p.w_router + (size_t)l * 1024 * 16; stride = 16; }
    else { wbase = p.w_in_even + (size_t)(l >> 1) * 1024 * EVEN_IN + PROJW; stride = EVEN_IN; }
    __syncthreads();
    for (int idx = tid; idx < 4096; idx += NTHR) {
      const int d = idx >> 2, q = idx & 3;
      const float4 w4 = *(const float4*)(wbase + (size_t)d * stride + q * 4);
      const int i = d >> 8, ln = (d >> 2) & 63, j = d & 3;
      ((float4*)sm)[((i * 4 + j) * 4 + q) * 64 + ln] = w4;
    }
    __syncthreads();
  }
  const int nwaves = lgdim() * (NTHR / 64), gw = lbid() * (NTHR / 64) + wv;
  const int per = (nrows + nwaves - 1) / nwaves;
  const int rbeg = gw * per, rend = min(nrows, rbeg + per);
  const bool in0 = (which == 1 && l == 0);
  float4 vn[4];
  int slvn = -1;
  if (rbeg < rend) {
    const float* xs0 = in0 ? (rbeg < NL ? p.x + (size_t)rbeg * DM : p.ctx + (size_t)(rbeg - NL) * DM) : p.xcur + (size_t)rbeg * DM;
#pragma unroll
    for (int i = 0; i < 4; ++i) vn[i] = ((const float4*)xs0)[i * 64 + lane];
    if (rbeg < ncomb && lane < 16) slvn = p.slotmap[rbeg * 16 + lane];
  }
  for (int r = rbeg; r < rend; ++r) {
    float4 v[4];
#pragma unroll
    for (int i = 0; i < 4; ++i) v[i] = vn[i];
    const int slv = slvn;
    float* xr = p.xcur + (size_t)r * DM;
    if (r + 1 < rend) {
      const int rn = r + 1;
      const float* xsn = in0 ? (rn < NL ? p.x + (size_t)rn * DM : p.ctx + (size_t)(rn - NL) * DM) : p.xcur + (size_t)rn * DM;
#pragma unroll
      for (int i = 0; i < 4; ++i) vn[i] = ((const float4*)xsn)[i * 64 + lane];
      slvn = (rn < ncomb && lane < 16) ? p.slotmap[rn * 16 + lane] : -1;
    }
    const int mr = modrow(r);
    if (r < ncomb) {
      float4 s4[4];
#pragma unroll
      for (int i = 0; i < 4; ++i) s4[i] = make_float4(0.f, 0.f, 0.f, 0.f);
      unsigned long long mask = __ballot(slv >= 0);
      while (mask) {
        const int e = __ffsll((long long)mask) - 1;
        mask &= mask - 1;
        const int sl = __shfl(slv, e);
        size_t yrow;
        if (r < NL) yrow = (size_t)e * 2048 + (size_t)(r >> 11) * 256 + sl;
        else yrow = (size_t)MOE_L + (size_t)e * 256 + (size_t)((r - NL) >> 8) * 32 + sl;
        const u32x2* yp = (const u32x2*)(p.Ybuf + yrow * DM);
#pragma unroll
        for (int i = 0; i < 4; ++i) {
          const u32x2 y = yp[i * 64 + lane];
          s4[i].x += __uint_as_float(y.x << 16); s4[i].y += __uint_as_float(y.x & 0xffff0000u);
          s4[i].z += __uint_as_float(y.y << 16); s4[i].w += __uint_as_float(y.y & 0xffff0000u);
        }
      }
      const float4* g5 = (const float4*)(p.mod + (size_t)(lprev * 9 + mr) * 6144 + 5 * 1024);
#pragma unroll
      for (int i = 0; i < 4; ++i) {
        const float4 g = g5[i * 64 + lane];
        v[i].x += g.x * s4[i].x; v[i].y += g.y * s4[i].y; v[i].z += g.z * s4[i].z; v[i].w += g.w * s4[i].w;
        if (which != 3) ((float4*)xr)[i * 64 + lane] = v[i];
      }
    }
    float ss = 0.f;
#pragma unroll
    for (int i = 0; i < 4; ++i) ss += v[i].x * v[i].x + v[i].y * v[i].y + v[i].z * v[i].z + v[i].w * v[i].w;
    ss = wave_sum(ss);
    const float inv = rsqrtf(ss * (1.f / 1024.f) + EPS);
    if (which == 3) {
#pragma unroll
      for (int i = 0; i < 4; ++i) {
        const float4 g = ((const float4*)p.g_final)[i * 64 + lane];
        ((float4*)(p.out + (size_t)r * DM))[i * 64 + lane] = make_float4(v[i].x * inv * g.x, v[i].y * inv * g.y, v[i].z * inv * g.z, v[i].w * inv * g.w);
      }
      continue;
    }
    const float* gn = (which == 1 ? p.g_norm1 : p.g_norm2) + l * 1024;
    const float* mrow = p.mod + (size_t)(l * 9 + mr) * 6144;
    const float4* shp = (const float4*)(mrow + (which == 1 ? 0 : 3) * 1024);
    const float4* scp = (const float4*)(mrow + (which == 1 ? 1 : 4) * 1024);
    float4 h[4];
#pragma unroll
    for (int i = 0; i < 4; ++i) {
      const float4 g = ((const float4*)gn)[i * 64 + lane];
      const float4 sh = shp[i * 64 + lane], sc = scp[i * 64 + lane];
      h[i].x = v[i].x * inv * g.x * (1.f + sc.x) + sh.x;
      h[i].y = v[i].y * inv * g.y * (1.f + sc.y) + sh.y;
      h[i].z = v[i].z * inv * g.z * (1.f + sc.z) + sh.z;
      h[i].w = v[i].w * inv * g.w * (1.f + sc.w) + sh.w;
      u32x2 w; w.x = cvt_pk_bf16(h[i].x, h[i].y); w.y = cvt_pk_bf16(h[i].z, h[i].w);
      ((u32x2*)(p.hbuf + (size_t)r * DM))[i * 64 + lane] = w;
    }
    if (!skinny) continue;
    float lg[16];
#pragma unroll
    for (int e = 0; e < 16; ++e) lg[e] = 0.f;
#pragma unroll
    for (int i = 0; i < 4; ++i)
#pragma unroll
      for (int j = 0; j < 4; ++j) {
        const float hv = j == 0 ? h[i].x : (j == 1 ? h[i].y : (j == 2 ? h[i].z : h[i].w));
#pragma unroll
        for (int q = 0; q < 4; ++q) {
          const float4 w4 = ((const float4*)sm)[((i * 4 + j) * 4 + q) * 64 + lane];
          lg[q * 4 + 0] += hv * w4.x; lg[q * 4 + 1] += hv * w4.y; lg[q * 4 + 2] += hv * w4.z; lg[q * 4 + 3] += hv * w4.w;
        }
        __builtin_amdgcn_sched_barrier(0);
      }
    float v8[8];
#pragma unroll
    for (int k = 0; k < 8; ++k) { const bool up = lane & 32; const float keep = up ? lg[k + 8] : lg[k], send = up ? lg[k] : lg[k + 8]; v8[k] = keep + __shfl_xor(send, 32); }
    float v4[4];
#pragma unroll
    for (int k = 0; k < 4; ++k) { const bool up = lane & 16; const float keep = up ? v8[k + 4] : v8[k], send = up ? v8[k] : v8[k + 4]; v4[k] = keep + __shfl_xor(send, 16); }
    float v2[2];
#pragma unroll
    for (int k = 0; k < 2; ++k) { const bool up = lane & 8; const float keep = up ? v4[k + 2] : v4[k], send = up ? v4[k] : v4[k + 2]; v2[k] = keep + __shfl_xor(send, 8); }
    float v1;
    { const bool up = lane & 4; const float keep = up ? v2[1] : v2[0], send = up ? v2[0] : v2[1]; v1 = keep + __shfl_xor(send, 4); }
    v1 += __shfl_xor(v1, 2);
    v1 += __shfl_xor(v1, 1);
    const int col = lane >> 2;
    if (which == 2) {
      float mx = v1;
      mx = fmaxf(mx, __shfl_xor(mx, 4)); mx = fmaxf(mx, __shfl_xor(mx, 8)); mx = fmaxf(mx, __shfl_xor(mx, 16)); mx = fmaxf(mx, __shfl_xor(mx, 32));
      const float ex = expf(v1 - mx);
      float sum = ex;
      sum += __shfl_xor(sum, 4); sum += __shfl_xor(sum, 8); sum += __shfl_xor(sum, 16); sum += __shfl_xor(sum, 32);
      if ((lane & 3) == 0) p.aff[(size_t)r * 16 + col] = ex / sum;
    } else {
      float gvv = v1 + p.b_gate[(l >> 1) * 16 + col];
      if ((col >> 2) & 1) gvv = logsigmoidf_(gvv);
      if ((lane & 3) == 0) p.gates[(size_t)r * 16 + col] = gvv;
    }
  }
  __syncthreads();
}

#define LOG2E 1.4426950408889634f
__device__ __forceinline__ int chain_row(int b, int dir, int p) {
  if (p < 256) { const int t = dir ? 255 - p : p; return NL + b * 256 + t; }
  const int q = p - 256; const int t = dir ? 2047 - q : q; return b * 2048 + t;
}
__device__ __forceinline__ float wave_incl_sum(float v, int lane) {
#pragma unroll
  for (int o = 1; o < 64; o <<= 1) { const float t = __shfl_up(v, o); if (lane >= o) v += t; }
  return v;
}
__device__ __forceinline__ float wave_incl_max(float v, int lane) {
#pragma unroll
  for (int o = 1; o < 64; o <<= 1) { const float t = __shfl_up(v, o); if (lane >= o) v = fmaxf(v, t); }
  return v;
}
__device__ __forceinline__ void unpack8(const u32x4 w, float (&f)[8]) {
  f[0] = __uint_as_float(w.x << 16); f[1] = __uint_as_float(w.x & 0xffff0000u); f[2] = __uint_as_float(w.y << 16); f[3] = __uint_as_float(w.y & 0xffff0000u);
  f[4] = __uint_as_float(w.z << 16); f[5] = __uint_as_float(w.z & 0xffff0000u); f[6] = __uint_as_float(w.w << 16); f[7] = __uint_as_float(w.w & 0xffff0000u);
}
__device__ __forceinline__ u32x4 pack8(const float (&f)[8]) {
  u32x4 w; w.x = cvt_pk_bf16(f[0], f[1]); w.y = cvt_pk_bf16(f[2], f[3]); w.z = cvt_pk_bf16(f[4], f[5]); w.w = cvt_pk_bf16(f[6], f[7]);
  return w;
}
__device__ __forceinline__ void ph_post_even(const Params& p, int l, float* sm) {
  const int e = l >> 1;
  const int tid = ltid(), lane = tid & 63;
  __syncthreads();
  for (int idx = tid; idx < 1024; idx += NTHR) {
    const int pos = idx >> 4, i = idx & 15;
    const float ang = (float)pos * exp2f(-(float)i * (13.287712379549449f / 16.f));
    float sn, cs;
    sincosf(ang, &sn, &cs);
    sm[2 * idx] = cs; sm[2 * idx + 1] = sn;
  }
  __syncthreads();
  const int bid = lbid(), G = lgdim();
  const bool scanner = (bid < 64) && (tid < 64) && (G > 64);
  const size_t nthr_e = (size_t)G * NTHR - (G > 64 ? 64 * 64 : 0);
  size_t gtid;
  if (G > 64) gtid = bid < 64 ? (size_t)bid * (NTHR - 64) + (tid - 64) : (size_t)64 * (NTHR - 64) + (size_t)(bid - 64) * NTHR + tid;
  else gtid = (size_t)bid * NTHR + tid;
  const size_t gsz = nthr_e;
  if (!scanner) {
  for (size_t it = gtid; it < (size_t)NT * 10; it += gsz) {
    const int r = (int)(it / 10), hh = (int)(it % 10);
    const bool lat = r < NL;
    const int t = r & 2047;
    const int bb = lat ? (r >> 11) : ((r - NL) >> 8);
    const int key = lat ? 256 + t : ((r - NL) & 255);
    const bf16_t* src; bf16_t* dst; const float* g; float osc;
    if (hh < 8) { src = p.proj + (size_t)r * PROJW + hh * 64; dst = p.Qb + (size_t)r * 512 + hh * 64; g = p.g_qnorm + e * 64; osc = 0.125f * LOG2E; }
    else { src = p.proj + (size_t)r * PROJW + 512 + (hh - 8) * 64; dst = p.Kb + ((size_t)(bb * 2 + (hh - 8)) * 2304 + key) * 64; g = p.g_knorm + e * 64; osc = 1.f;
           const u32x4* vs = (const u32x4*)(p.proj + (size_t)r * PROJW + 640 + (hh - 8) * 64);
           u32x4* vd = (u32x4*)(p.Vb + ((size_t)(bb * 2 + (hh - 8)) * 2304 + key) * 64);
#pragma unroll
           for (int q = 0; q < 8; ++q) vd[q] = vs[q]; }
    float x[64];
#pragma unroll
    for (int q = 0; q < 8; ++q) { float f[8]; unpack8(((const u32x4*)src)[q], f);
#pragma unroll
      for (int j = 0; j < 8; ++j) x[q * 8 + j] = f[j]; }
    float ss = 0.f;
#pragma unroll
    for (int j = 0; j < 64; ++j) ss += x[j] * x[j];
    const float inv = rsqrtf(ss * (1.f / 64.f) + EPS) * osc;
#pragma unroll
    for (int j = 0; j < 64; ++j) x[j] *= inv * g[j];
    if (lat) {
#pragma unroll
      for (int a = 0; a < 2; ++a) {
        const int pos = (a == 0) ? (t >> 6) : (t & 63);
#pragma unroll
        for (int i = 0; i < 16; ++i) {
          const float2 cssn = *(const float2*)(sm + 2 * (pos * 16 + i));
          const float x1 = x[a * 32 + i], x2 = x[a * 32 + 16 + i];
          x[a * 32 + i] = x1 * cssn.x - x2 * cssn.y;
          x[a * 32 + 16 + i] = x2 * cssn.x + x1 * cssn.y;
        }
      }
    }
#pragma unroll
    for (int q = 0; q < 8; ++q) { float f[8];
#pragma unroll
      for (int j = 0; j < 8; ++j) f[j] = x[q * 8 + j];
      ((u32x4*)dst)[q] = pack8(f); }
  }
  const float* wc = p.w_conv + (size_t)e * 3 * 1024;
  for (size_t it = gtid; it < (size_t)NT * 128; it += gsz) {
    const int r = (int)(it >> 7), c8 = (int)(it & 127) * 8;
    int t, n;
    if (r < NL) { t = r & 2047; n = 2048; } else { t = (r - NL) & 255; n = 256; }
    const bf16_t* sp = p.proj + (size_t)r * PROJW + 768 + c8;
    float xc[8], xm[8], xp[8], o[8];
    unpack8(*(const u32x4*)sp, xc);
    if (t > 0) unpack8(*(const u32x4*)(sp - PROJW), xm); else {
#pragma unroll
      for (int j = 0; j < 8; ++j) xm[j] = 0.f; }
    if (t < n - 1) unpack8(*(const u32x4*)(sp + PROJW), xp); else {
#pragma unroll
      for (int j = 0; j < 8; ++j) xp[j] = 0.f; }
    const float ksc = c8 < 512 ? 1.f : 0.08838834764831845f;
#pragma unroll
    for (int j = 0; j < 8; ++j) { const float v = wc[c8 + j] * xm[j] + wc[1024 + c8 + j] * xc[j] + wc[2048 + c8 + j] * xp[j]; o[j] = siluf(v) * ksc; }
    bf16_t* dp = c8 < 512 ? p.qm + (size_t)r * 512 + c8 : p.km + (size_t)r * 512 + c8 - 512;
    *(u32x4*)dp = pack8(o);
  }
  }
  if (scanner || G <= 64) {
    const int gw = (G > 64) ? bid : (int)(((size_t)bid * NTHR + tid) >> 6), nw = (G > 64) ? 64 : (int)(((size_t)G * NTHR) >> 6);
    for (int chain = gw; chain < 64; chain += nw) {
      const int b = chain >> 3, hd = (chain >> 1) & 3, dir = chain & 1;
      float m_in = -1e30f;
      for (int c = 0; c < 18; ++c) {
        const int p0 = c * 128 + 2 * lane;
        const int r0 = chain_row(b, dir, p0), r1 = chain_row(b, dir, p0 + 1);
        const float ig0 = p.gates[(size_t)r0 * 16 + dir * 8 + hd], lf0 = p.gates[(size_t)r0 * 16 + dir * 8 + 4 + hd];
        const float ig1 = p.gates[(size_t)r1 * 16 + dir * 8 + hd], lf1 = p.gates[(size_t)r1 * 16 + dir * 8 + 4 + hd];
        const float ssum = lf0 + lf1;
        const float incl = wave_incl_sum(ssum, lane);
        const float bq0 = (incl - ssum) + lf0, bq1 = bq0 + lf1;
        const float bend = __shfl(incl, 63);
        const float g0 = ig0 - bq0, g1 = ig1 - bq1;
        const float inclm = wave_incl_max(fmaxf(g0, g1), lane);
        float exclm = __shfl_up(inclm, 1);
        if (lane == 0) exclm = -3.0e38f;
        const float pm0 = fmaxf(exclm, g0), pm1 = fmaxf(pm0, g1);
        const float gmax = __shfl(inclm, 63);
        const float m_next = fmaxf(m_in + bend, bend + gmax);
        const size_t i0 = (size_t)r0 * 8 + dir * 4 + hd, i1 = (size_t)r1 * 8 + dir * 4 + hd;
        p.gsG[i0] = g0 * LOG2E; p.gsR[i0] = -fmaxf(m_in, pm0) * LOG2E; p.gsB[i0] = bq0 * LOG2E;
        p.gsG[i1] = g1 * LOG2E; p.gsR[i1] = -fmaxf(m_in, pm1) * LOG2E; p.gsB[i1] = bq1 * LOG2E;
        if (lane == 0) { p.cMIN[chain * 18 + c] = m_in * LOG2E; p.cE1[chain * 18 + c] = (bend - m_next) * LOG2E; p.cDEC[chain * 18 + c] = expf(m_in + bend - m_next); }
        m_in = m_next;
      }
    }
  }
}

typedef float f32x16 __attribute__((ext_vector_type(16)));
typedef short s16x4 __attribute__((ext_vector_type(4)));
typedef __attribute__((address_space(3))) const char* lds_cptr;
__device__ __forceinline__ s16x4 vtr(lds_cptr p) { return __builtin_bit_cast(s16x4, __builtin_amdgcn_ds_read_tr16_b64_v4i16((__attribute__((address_space(3))) s16x4*)p)); }
#define MX3(a, b, c) __builtin_fmaxf(__builtin_fmaxf((a), (b)), (c))
__device__ __forceinline__ float rowmax32(const f32x16& p0, const f32x16& p1) {
  float a = MX3(p0[0], p0[1], p1[0]), b = MX3(p0[2], p0[3], p1[1]);
  a = MX3(a, p1[2], p1[3]);
#pragma unroll
  for (int r = 4; r < 16; r += 4) { a = MX3(a, p0[r], p0[r + 1]); b = MX3(b, p0[r + 2], p0[r + 3]); a = MX3(a, p1[r], p1[r + 1]); b = MX3(b, p1[r + 2], p1[r + 3]); }
  const float m = __builtin_fmaxf(a, b);
  auto rr = __builtin_amdgcn_permlane32_swap(__float_as_uint(m), __float_as_uint(m), false, false);
  return __builtin_fmaxf(__uint_as_float(rr[0]), __uint_as_float(rr[1]));
}
__device__ __forceinline__ float half_swap_add(float v) {
  auto rr = __builtin_amdgcn_permlane32_swap(__float_as_uint(v), __float_as_uint(v), false, false);
  return __uint_as_float(rr[0]) + __uint_as_float(rr[1]);
}
#define ATT_SLOT 16384
__device__ __forceinline__ void glds16(const void* g, unsigned lds_base) {
  unsigned sv;
  asm volatile("s_mov_b32 %0, m0\n\ts_mov_b32 m0, %2\n\ts_nop 0\n\tglobal_load_lds_dwordx4 %1, off\n\ts_mov_b32 m0, %0" : "=&s"(sv) : "v"(g), "s"(lds_base) : "memory");
}
__device__ __forceinline__ void attn_unit(const bf16_t* Q0, const bf16_t* Kbase, const bf16_t* Vbase, const int nkeys, bf16_t* O0, LAS unsigned char* lds) {
  const int tid = ltid(), lane = tid & 63, r32 = lane & 31, hi = lane >> 5;
  const int wid = __builtin_amdgcn_readfirstlane(tid >> 6);
  const int NTL = nkeys >> 6;
  __syncthreads();
  const bf16_t* ksrc = Kbase + (size_t)lane * 64 + wid * 8;
  const bf16_t* vsrc = Vbase + (size_t)(16 * (wid & 3) + (lane >> 2)) * 64 + (wid >> 2) * 32 + (lane & 3) * 8;
  const unsigned ldsb = (unsigned)(size_t)lds;
#define ATT_STAGE(t, slot) do { \
    glds16(ksrc + (size_t)(t) * 64 * 64, (unsigned)__builtin_amdgcn_readfirstlane(ldsb + (slot) * ATT_SLOT + wid * 1024)); \
    glds16(vsrc + (size_t)(t) * 64 * 64, (unsigned)__builtin_amdgcn_readfirstlane(ldsb + (slot) * ATT_SLOT + 8192 + wid * 1024)); } while (0)
  ATT_STAGE(0, 0);
  if (NTL > 1) ATT_STAGE(1, 1);
  bf16x8 qr[4];
  {
    const bf16_t* Qw = Q0 + (size_t)(wid * 32 + r32) * 512;
#pragma unroll
    for (int d0 = 0; d0 < 4; ++d0) qr[d0] = *(const bf16x8*)(Qw + d0 * 16 + hi * 8);
  }
  f32x16 o0, o1;
#pragma unroll
  for (int r = 0; r < 16; ++r) { o0[r] = 0.f; o1[r] = 0.f; }
  float m = -1e30f, l = 0.f;
  const int koff = hi * 1024 + r32 * 16;
  const int voff = 8192 + ((lane >> 4) & 1) * 32 + (lane & 3) * 8 + (4 * hi + ((lane & 15) >> 2)) * 64;
  int slot = 0;
  for (int t = 0; t < NTL; ++t) {
    if (t + 1 < NTL) asm volatile("s_waitcnt vmcnt(2) lgkmcnt(0)\n\ts_barrier" ::: "memory"); else asm volatile("s_waitcnt vmcnt(0) lgkmcnt(0)\n\ts_barrier" ::: "memory");
    __builtin_amdgcn_sched_barrier(0);
    if (t + 2 < NTL) { const int s2 = (slot >= 1) ? slot - 1 : 2; ATT_STAGE(t + 2, s2); }
    const lds_cptr kp = (lds_cptr)(lds + slot * ATT_SLOT + koff);
    const lds_cptr vp = (lds_cptr)(lds + slot * ATT_SLOT + voff);
    f32x16 pA, pB;
#pragma unroll
    for (int r = 0; r < 16; ++r) { pA[r] = 0.f; pB[r] = 0.f; }
#pragma unroll
    for (int d0 = 0; d0 < 4; ++d0) {
      const bf16x8 k0 = *(const LAS bf16x8*)(kp + d0 * 2048), k1 = *(const LAS bf16x8*)(kp + d0 * 2048 + 512);
      pA = __builtin_amdgcn_mfma_f32_32x32x16_bf16(k0, qr[d0], pA, 0, 0, 0);
      pB = __builtin_amdgcn_mfma_f32_32x32x16_bf16(k1, qr[d0], pB, 0, 0, 0);
    }
    const float rm = rowmax32(pA, pB);
    const float mn = __builtin_fmaxf(m, rm);
    const float alpha = __builtin_amdgcn_exp2f(m - mn);
    m = mn;
    float ps = 0.f;
#pragma unroll
    for (int r = 0; r < 16; ++r) { pA[r] = __builtin_amdgcn_exp2f(pA[r] - mn); pB[r] = __builtin_amdgcn_exp2f(pB[r] - mn); ps += pA[r] + pB[r]; }
    l = l * alpha + ps;
#pragma unroll
    for (int r = 0; r < 16; ++r) { o0[r] *= alpha; o1[r] *= alpha; }
    bf16x8 pw[4];
#pragma unroll
    for (int s4 = 0; s4 < 4; ++s4) {
      u32x4 w;
      if (s4 < 2) { w.x = cvt_pk_bf16(pA[8 * s4 + 0], pA[8 * s4 + 1]); w.y = cvt_pk_bf16(pA[8 * s4 + 2], pA[8 * s4 + 3]); w.z = cvt_pk_bf16(pA[8 * s4 + 4], pA[8 * s4 + 5]); w.w = cvt_pk_bf16(pA[8 * s4 + 6], pA[8 * s4 + 7]); }
      else { const int q = s4 - 2; w.x = cvt_pk_bf16(pB[8 * q + 0], pB[8 * q + 1]); w.y = cvt_pk_bf16(pB[8 * q + 2], pB[8 * q + 3]); w.z = cvt_pk_bf16(pB[8 * q + 4], pB[8 * q + 5]); w.w = cvt_pk_bf16(pB[8 * q + 6], pB[8 * q + 7]); }
      pw[s4] = __builtin_bit_cast(bf16x8, w);
    }
#pragma unroll
    for (int s4 = 0; s4 < 4; ++s4) {
      const s16x4 a0l = vtr(vp + s4 * 1024), a0h = vtr(vp + s4 * 1024 + 512);
      const s16x4 a1l = vtr(vp + 4096 + s4 * 1024), a1h = vtr(vp + 4096 + s4 * 1024 + 512);
      const bf16x8 a0 = {a0l[0], a0l[1], a0l[2], a0l[3], a0h[0], a0h[1], a0h[2], a0h[3]};
      const bf16x8 a1 = {a1l[0], a1l[1], a1l[2], a1l[3], a1h[0], a1h[1], a1h[2], a1h[3]};
      o0 = __builtin_amdgcn_mfma_f32_32x32x16_bf16(a0, pw[s4], o0, 0, 0, 0);
      o1 = __builtin_amdgcn_mfma_f32_32x32x16_bf16(a1, pw[s4], o1, 0, 0, 0);
    }
    slot = (slot == 2) ? 0 : slot + 1;
  }
#undef ATT_STAGE
  const float il = 1.f / half_swap_add(l);
  bf16_t* Ow = O0 + (size_t)(wid * 32 + r32) * 1024;
#pragma unroll
  for (int g4 = 0; g4 < 4; ++g4) {
    u32x2 w0, w1;
    w0.x = cvt_pk_bf16(o0[4 * g4 + 0] * il, o0[4 * g4 + 1] * il); w0.y = cvt_pk_bf16(o0[4 * g4 + 2] * il, o0[4 * g4 + 3] * il);
    w1.x = cvt_pk_bf16(o1[4 * g4 + 0] * il, o1[4 * g4 + 1] * il); w1.y = cvt_pk_bf16(o1[4 * g4 + 2] * il, o1[4 * g4 + 3] * il);
    *(u32x2*)(Ow + 8 * g4 + 4 * hi) = w0;
    *(u32x2*)(Ow + 32 + 8 * g4 + 4 * hi) = w1;
  }
}
__device__ __forceinline__ void ph_att(const Params& p, bool ctx_q, LAS unsigned char* lds) {
  const int c = lbid(), G = lgdim();
  const int nunits = 512 + (ctx_q ? 64 : 0);
  for (int L = c; L < nunits; L += G) {
    if (L < 512) {
      const int i = L >> 8, cc = L & 255, grp = (cc & 7) + 8 * i, idx = cc >> 3;
      const int b = grp >> 1, kvh = grp & 1, h = kvh * 4 + (idx >> 3), qt = idx & 7;
      const size_t row0 = (size_t)b * 2048 + qt * 256;
      attn_unit(p.Qb + row0 * 512 + h * 64, p.Kb + (size_t)(b * 2 + kvh) * 2304 * 64, p.Vb + (size_t)(b * 2 + kvh) * 2304 * 64, 2304, p.mix + row0 * 1024 + h * 64, lds);
    } else {
      const int u = L - 512, b = u >> 3, h = u & 7, kvh = h >> 2;
      const size_t row0 = (size_t)NL + b * 256;
      attn_unit(p.Qb + row0 * 512 + h * 64, p.Kb + (size_t)(b * 2 + kvh) * 2304 * 64, p.Vb + (size_t)(b * 2 + kvh) * 2304 * 64, 256, p.mix + row0 * 1024 + h * 64, lds);
    }
  }
  __syncthreads();
}

__device__ __forceinline__ int chunk_row0(int b, int dir, int cc) {
  if (cc < 2) return NL + b * 256 + (dir ? 1 - cc : cc) * 128;
  return b * 2048 + (dir ? 15 - (cc - 2) : cc - 2) * 128;
}
__device__ __forceinline__ int trq_addr(int lane, int quarter, int rowbase) {
  return quarter * 8192 + ((lane >> 4) & 1) * 32 + (lane & 3) * 8 + (rowbase + ((lane & 15) >> 2)) * 64;
}
__device__ __forceinline__ bf16x8 cat44(const s16x4 a, const s16x4 b) { return (bf16x8){a[0], a[1], a[2], a[3], b[0], b[1], b[2], b[3]}; }

__device__ __forceinline__ void ph_mlstm_u(const Params& p, LAS unsigned char* lds) {
  const int tid = ltid(), lane = tid & 63, r32 = lane & 31, hi = lane >> 5;
  const int wid = __builtin_amdgcn_readfirstlane(tid >> 6);
  LAS float* WS = (LAS float*)(lds + 65536);
  LAS float* NP = (LAS float*)(lds + 66048);
  for (int unit = lbid(); unit < 64 * 17; unit += lgdim()) {
    const int chain = unit / 17, cc = unit % 17;
    const int b = chain >> 3, hd = (chain >> 1) & 3, dir = chain & 1;
    const int row0 = chunk_row0(b, dir, cc);
    __syncthreads();
#pragma unroll
    for (int n = 0; n < 4; ++n) {
      const int ii = wid * 4 + n, qd = ii >> 3, rg = ii & 7;
      const bf16_t* src = p.km + (size_t)(row0 + rg * 16 + (lane >> 2)) * 512 + hd * 128 + qd * 32 + (lane & 3) * 8;
      __builtin_amdgcn_global_load_lds((const unsigned*)src, (LAS unsigned*)(lds + qd * 8192 + rg * 1024), 16, 0, 0);
    }
    if (tid < 128) WS[tid] = __builtin_amdgcn_exp2f(p.gsG[(size_t)(row0 + tid) * 8 + dir * 4 + hd] + p.cE1[chain * 18 + cc]);
    __syncthreads();
#pragma unroll
    for (int n = 0; n < 4; ++n) {
      const int o = (tid + n * NTHR) * 16, qd = o >> 13, row = (o >> 6) & 127, pc = (o >> 4) & 3;
      float f[8];
      unpack8(*(const u32x4*)(p.proj + (size_t)(row0 + row) * PROJW + 1792 + hd * 128 + qd * 32 + pc * 8), f);
      const float w = WS[row];
#pragma unroll
      for (int j = 0; j < 8; ++j) f[j] *= w;
      *(LAS u32x4*)(lds + 32768 + o) = pack8(f);
    }
    asm volatile("s_waitcnt vmcnt(0)" ::: "memory");
    __syncthreads();
    {
      const int d = tid & 127, part = tid >> 7;
      float acc = 0.f;
      for (int s2 = 0; s2 < 32; ++s2) {
        const int srow = part * 32 + s2;
        const bf16_t kv = *(const LAS bf16_t*)(lds + (d >> 5) * 8192 + srow * 64 + (d & 31) * 2);
        acc += WS[srow] * bf2f(kv);
      }
      NP[part * 128 + d] = acc;
    }
    const int eb = wid >> 1, db0 = 2 * (wid & 1);
    f32x16 u0, u1;
#pragma unroll
    for (int r = 0; r < 16; ++r) { u0[r] = 0.f; u1[r] = 0.f; }
#pragma unroll
    for (int ks = 0; ks < 8; ++ks) {
      const int rb = ks * 16 + 8 * hi;
      const bf16x8 a = cat44(vtr((lds_cptr)(lds + 32768 + trq_addr(lane, eb, rb))), vtr((lds_cptr)(lds + 32768 + trq_addr(lane, eb, rb + 4))));
      const bf16x8 b0 = cat44(vtr((lds_cptr)(lds + trq_addr(lane, db0, rb))), vtr((lds_cptr)(lds + trq_addr(lane, db0, rb + 4))));
      const bf16x8 b1 = cat44(vtr((lds_cptr)(lds + trq_addr(lane, db0 + 1, rb))), vtr((lds_cptr)(lds + trq_addr(lane, db0 + 1, rb + 4))));
      u0 = __builtin_amdgcn_mfma_f32_32x32x16_bf16(a, b0, u0, 0, 0, 0);
      u1 = __builtin_amdgcn_mfma_f32_32x32x16_bf16(a, b1, u1, 0, 0, 0);
    }
    float* U = p.Ubuf + ((size_t)chain * 17 + cc) * 16384;
#pragma unroll
    for (int r = 0; r < 16; ++r) {
      const int erow = eb * 32 + (r & 3) + 8 * (r >> 2) + 4 * hi;
      U[(size_t)erow * 128 + db0 * 32 + r32] = u0[r];
      U[(size_t)erow * 128 + (db0 + 1) * 32 + r32] = u1[r];
    }
    __syncthreads();
    if (tid < 128) p.NLb[((size_t)chain * 17 + cc) * 128 + tid] = NP[tid] + NP[128 + tid] + NP[256 + tid] + NP[384 + tid];
  }
  __syncthreads();
}

__device__ __forceinline__ void ph_mlstm_scan(const Params& p, int bskip) {
  const int bsk = lgdim() > bskip ? bskip : 0;
  if (lbid() < bsk) return;
  const size_t gtid = (size_t)(lbid() - bsk) * NTHR + ltid(), gsz = (size_t)(lgdim() - bsk) * NTHR;
  for (size_t it = gtid; it < (size_t)64 * 8192; it += gsz) {
    const int chain = (int)(it >> 13), ed = (int)(it & 8191) * 2;
    float c0 = 0.f, c1 = 0.f;
    for (int c = 0; c < 17; ++c) {
      const float dec = p.cDEC[chain * 18 + c];
      const float2 u = *(const float2*)(p.Ubuf + ((size_t)chain * 17 + c) * 16384 + ed);
      c0 = dec * c0 + u.x; c1 = dec * c1 + u.y;
      *(unsigned*)(p.Cbf + ((size_t)chain * 18 + c + 1) * 16384 + ed) = cvt_pk_bf16(c0, c1);
    }
  }
  for (size_t it = gtid; it < (size_t)64 * 128; it += gsz) {
    const int chain = (int)(it >> 7), d = (int)(it & 127);
    float nv = 0.f;
    for (int c = 0; c < 17; ++c) {
      nv = p.cDEC[chain * 18 + c] * nv + p.NLb[((size_t)chain * 17 + c) * 128 + d];
      p.NVb[((size_t)chain * 18 + c + 1) * 128 + d] = nv;
    }
  }
}

__device__ __forceinline__ void ph_mlstm_h(const Params& p, int l, bool ctx_out, LAS unsigned char* lds) {
  const int e2 = l >> 1;
  const int tid = ltid(), lane = tid & 63, r32 = lane & 31, hi = lane >> 5;
  const int wid = __builtin_amdgcn_readfirstlane(tid >> 6);
  const int tb = wid & 3, dir = wid >> 2;
  LAS float* HX = (LAS float*)(lds + 65536);
  LAS float* GC = (LAS float*)(lds + 131072);
  const int j0 = ctx_out ? 0 : 2, nj = 18 - j0;
  for (int unit = lbid(); unit < 32 * nj; unit += lgdim()) {
    const int bh = unit / nj, j = j0 + unit % nj, b = bh >> 2, hd = bh & 3;
    const int row0 = (j < 2) ? NL + b * 256 + j * 128 : b * 2048 + (j - 2) * 128;
    const int cc = dir ? (j < 2 ? 1 - j : 19 - j) : j;
    const int chain = b * 8 + hd * 2 + dir;
    __syncthreads();
#pragma unroll
    for (int n = 0; n < 4; ++n) {
      const int ii = wid * 4 + n;
      { const int ch = ii >> 1, rh = ii & 1;
        const bf16_t* src = p.km + (size_t)(row0 + rh * 64 + lane) * 512 + hd * 128 + ch * 8;
        __builtin_amdgcn_global_load_lds((const unsigned*)src, (LAS unsigned*)(lds + ch * 2048 + rh * 1024), 16, 0, 0); }
      { const int qd = ii >> 3, rg = ii & 7;
        const bf16_t* src = p.proj + (size_t)(row0 + rg * 16 + (lane >> 2)) * PROJW + 1792 + hd * 128 + qd * 32 + (lane & 3) * 8;
        __builtin_amdgcn_global_load_lds((const unsigned*)src, (LAS unsigned*)(lds + 32768 + qd * 8192 + rg * 1024), 16, 0, 0); }
    }
    if (tid < 256) GC[tid] = p.gsG[(size_t)(row0 + (tid & 127)) * 8 + (tid >> 7) * 4 + hd];
    const int trow = row0 + tb * 32 + r32;
    bf16x8 qf[8];
#pragma unroll
    for (int ks = 0; ks < 8; ++ks) qf[ks] = *(const bf16x8*)(p.qm + (size_t)trow * 512 + hd * 128 + ks * 16 + hi * 8);
    const float R2 = p.gsR[(size_t)trow * 8 + dir * 4 + hd], BQ2 = p.gsB[(size_t)trow * 8 + dir * 4 + hd];
    const float MIN2 = p.cMIN[chain * 18 + cc];
    f32x16 acc[4];
#pragma unroll
    for (int eb = 0; eb < 4; ++eb)
#pragma unroll
      for (int r = 0; r < 16; ++r) acc[eb][r] = 0.f;
    float nq = 0.f;
    if (cc > 0) {
      const bf16_t* Cp = p.Cbf + ((size_t)chain * 18 + cc) * 16384 + (size_t)r32 * 128 + hi * 8;
#pragma unroll
      for (int eb = 0; eb < 4; ++eb)
#pragma unroll
        for (int ks = 0; ks < 8; ++ks) {
          const bf16x8 a = *(const bf16x8*)(Cp + (size_t)eb * 32 * 128 + ks * 16);
          acc[eb] = __builtin_amdgcn_mfma_f32_32x32x16_bf16(a, qf[ks], acc[eb], 0, 0, 0);
        }
      const float* nvp = p.NVb + ((size_t)chain * 18 + cc) * 128 + hi * 8;
#pragma unroll
      for (int ks = 0; ks < 8; ++ks) {
        const f32x4 n0 = *(const f32x4*)(nvp + ks * 16), n1 = *(const f32x4*)(nvp + ks * 16 + 4);
        float qv[8];
        unpack8(__builtin_bit_cast(u32x4, qf[ks]), qv);
        nq += n0[0] * qv[0] + n0[1] * qv[1] + n0[2] * qv[2] + n0[3] * qv[3] + n1[0] * qv[4] + n1[1] * qv[5] + n1[2] * qv[6] + n1[3] * qv[7];
      }
      nq = half_swap_add(nq);
    }
    const float winter = __builtin_amdgcn_exp2f(MIN2 + R2);
#pragma unroll
    for (int eb = 0; eb < 4; ++eb)
#pragma unroll
      for (int r = 0; r < 16; ++r) acc[eb][r] *= winter;
    asm volatile("s_waitcnt vmcnt(0)" ::: "memory");
    __syncthreads();
    float sw = 0.f;
    const int sb_lo = dir ? tb : 0, sb_hi = dir ? 3 : tb;
    for (int sb = sb_lo; sb <= sb_hi; ++sb) {
      f32x16 st;
#pragma unroll
      for (int r = 0; r < 16; ++r) st[r] = 0.f;
#pragma unroll
      for (int ks = 0; ks < 8; ++ks) {
        const bf16x8 kf = *(const LAS bf16x8*)(lds + (2 * ks + hi) * 2048 + (sb * 32 + r32) * 16);
        st = __builtin_amdgcn_mfma_f32_32x32x16_bf16(kf, qf[ks], st, 0, 0, 0);
      }
      const bool diag = (sb == tb);
#pragma unroll
      for (int g4 = 0; g4 < 4; ++g4) {
        const f32x4 gc = *(const LAS f32x4*)(GC + dir * 128 + sb * 32 + 8 * g4 + 4 * hi);
#pragma unroll
        for (int q = 0; q < 4; ++q) {
          const int sl = 8 * g4 + 4 * hi + q;
          float w = __builtin_amdgcn_exp2f(R2 + gc[q]) * st[4 * g4 + q];
          const bool keep = !diag || (dir ? (sl >= r32) : (sl <= r32));
          w = keep ? w : 0.f;
          sw += w;
          st[4 * g4 + q] = w;
        }
      }
      u32x4 p0, p1;
      p0.x = cvt_pk_bf16(st[0], st[1]); p0.y = cvt_pk_bf16(st[2], st[3]); p0.z = cvt_pk_bf16(st[4], st[5]); p0.w = cvt_pk_bf16(st[6], st[7]);
      p1.x = cvt_pk_bf16(st[8], st[9]); p1.y = cvt_pk_bf16(st[10], st[11]); p1.z = cvt_pk_bf16(st[12], st[13]); p1.w = cvt_pk_bf16(st[14], st[15]);
      const bf16x8 pw0 = __builtin_bit_cast(bf16x8, p0), pw1 = __builtin_bit_cast(bf16x8, p1);
#pragma unroll
      for (int eb = 0; eb < 4; ++eb) {
        const int rb = sb * 32 + 4 * hi;
        const bf16x8 a0 = cat44(vtr((lds_cptr)(lds + 32768 + trq_addr(lane, eb, rb))), vtr((lds_cptr)(lds + 32768 + trq_addr(lane, eb, rb + 8))));
        const bf16x8 a1 = cat44(vtr((lds_cptr)(lds + 32768 + trq_addr(lane, eb, rb + 16))), vtr((lds_cptr)(lds + 32768 + trq_addr(lane, eb, rb + 24))));
        acc[eb] = __builtin_amdgcn_mfma_f32_32x32x16_bf16(a0, pw0, acc[eb], 0, 0, 0);
        acc[eb] = __builtin_amdgcn_mfma_f32_32x32x16_bf16(a1, pw1, acc[eb], 0, 0, 0);
      }
    }
    sw = half_swap_add(sw);
    const float den = winter * nq + sw;
    const float dn = fmaxf(fabsf(den), __builtin_amdgcn_exp2f(R2 - BQ2));
    const float idn = 1.f / dn;
    if (dir == 1) {
#pragma unroll
      for (int eb = 0; eb < 4; ++eb)
#pragma unroll
        for (int r = 0; r < 16; ++r) HX[(tb * 128 + eb * 32 + (r & 3) + 8 * (r >> 2) + 4 * hi) * 32 + r32] = acc[eb][r] * idn;
    }
    __syncthreads();
    if (dir == 0) {
      float ss = 0.f;
#pragma unroll
      for (int eb = 0; eb < 4; ++eb)
#pragma unroll
        for (int r = 0; r < 16; ++r) {
          const float v = acc[eb][r] * idn + HX[(tb * 128 + eb * 32 + (r & 3) + 8 * (r >> 2) + 4 * hi) * 32 + r32];
          acc[eb][r] = v; ss += v * v;
        }
      ss = half_swap_add(ss);
      const float inv = rsqrtf(ss * (1.f / 128.f) + EPS);
      const float* gh = p.g_hnorm + e2 * 512 + hd * 128;
      const bf16_t* obp = p.proj + (size_t)trow * PROJW + 2304 + hd * 128;
      bf16_t* op = p.mix + (size_t)trow * 1024 + 512 + hd * 128;
#pragma unroll
      for (int eb = 0; eb < 4; ++eb)
#pragma unroll
        for (int g4 = 0; g4 < 4; ++g4) {
          const int e0 = eb * 32 + 8 * g4 + 4 * hi;
          const f32x4 gv = *(const f32x4*)(gh + e0);
          const u32x2 ow = *(const u32x2*)(obp + e0);
          const float ob0 = __uint_as_float(ow.x << 16), ob1 = __uint_as_float(ow.x & 0xffff0000u), ob2 = __uint_as_float(ow.y << 16), ob3 = __uint_as_float(ow.y & 0xffff0000u);
          const float v0 = acc[eb][4 * g4 + 0] * inv * gv[0] * sigmoidf_(ob0), v1 = acc[eb][4 * g4 + 1] * inv * gv[1] * sigmoidf_(ob1);
          const float v2 = acc[eb][4 * g4 + 2] * inv * gv[2] * sigmoidf_(ob2), v3 = acc[eb][4 * g4 + 3] * inv * gv[3] * sigmoidf_(ob3);
          u32x2 w; w.x = cvt_pk_bf16(v0, v1); w.y = cvt_pk_bf16(v2, v3);
          *(u32x2*)(op + e0) = w;
        }
    }
  }
  __syncthreads();
}

__device__ __forceinline__ void ph_topk(const Params& p, bool ctx, float* sm) {
  const int tid = ltid(), lane = tid & 63, wv = tid >> 6;
  unsigned* cnt = (unsigned*)sm;
  unsigned* pre = (unsigned*)sm + 32;
  int* sel = (int*)sm + 64;
  const int ncol = ctx ? 256 : 128;
  for (int colu = lbid(); colu < ncol; colu += lgdim()) {
    int e, base, n, cap; size_t mbase;
    if (colu < 128) { const int b = colu >> 4; e = colu & 15; base = b * 2048; n = 2048; cap = 256; mbase = (size_t)e * 2048 + (size_t)b * 256; }
    else { const int c2 = colu - 128, b = c2 >> 4; e = c2 & 15; base = NL + b * 256; n = 256; cap = 32; mbase = (size_t)MOE_L + (size_t)e * 256 + (size_t)b * 32; }
    unsigned v[4];
#pragma unroll
    for (int k = 0; k < 4; ++k) { const int i = tid * 4 + k; v[k] = i < n ? __float_as_uint(p.aff[(size_t)(base + i) * 16 + e]) : 0u; }
    unsigned thr = 0u;
    for (int bit = 30; bit >= 0; --bit) {
      const unsigned cand = thr | (1u << bit);
      unsigned c = (v[0] >= cand) + (v[1] >= cand) + (v[2] >= cand) + (v[3] >= cand);
#pragma unroll
      for (int o = 32; o > 0; o >>= 1) c += __shfl_xor(c, o);
      unsigned* cb = cnt + (bit & 1) * 8;
      if (lane == 0) cb[wv] = c;
      __syncthreads();
      const unsigned tot = cb[0] + cb[1] + cb[2] + cb[3] + cb[4] + cb[5] + cb[6] + cb[7];
      if (tot >= (unsigned)cap) thr = cand;
    }
    unsigned ngt = (v[0] > thr) + (v[1] > thr) + (v[2] > thr) + (v[3] > thr);
    unsigned neq = (v[0] == thr) + (v[1] == thr) + (v[2] == thr) + (v[3] == thr);
    unsigned igt = ngt, ieq = neq;
#pragma unroll
    for (int o = 1; o < 64; o <<= 1) { const unsigned a = __shfl_up(igt, o), b2 = __shfl_up(ieq, o); if (lane >= o) { igt += a; ieq += b2; } }
    __syncthreads();
    if (lane == 63) { pre[wv] = igt; pre[8 + wv] = ieq; }
    __syncthreads();
    unsigned totgt = 0, offgt = 0, offeq = 0;
#pragma unroll
    for (int w2 = 0; w2 < 8; ++w2) { const unsigned a = pre[w2], b2 = pre[8 + w2]; totgt += a; if (w2 < wv) { offgt += a; offeq += b2; } }
    const unsigned need_eq = (unsigned)cap - totgt;
    unsigned egt = offgt + igt - ngt, eeq = offeq + ieq - neq;
#pragma unroll
    for (int k = 0; k < 4; ++k) {
      const int i = tid * 4 + k;
      const bool gt = v[k] > thr, eq = v[k] == thr;
      const bool take = gt || (eq && eeq < need_eq);
      if (i < n) {
        const int r = base + i;
        const unsigned slot = egt + (eeq < need_eq ? eeq : need_eq);
        if (take) { p.slotmap[(size_t)r * 16 + e] = (int)slot; p.rowidx[mbase + slot] = r; p.gatev[mbase + slot] = __uint_as_float(v[k]); sel[slot] = r; }
        else p.slotmap[(size_t)r * 16 + e] = -1;
      }
      egt += gt; eeq += eq;
    }
    __syncthreads();
    for (int sl = wv; sl < cap; sl += NTHR / 64) {
      const int r = sel[sl];
      const u32x4* src = (const u32x4*)(p.hbuf + (size_t)r * 1024);
      u32x4* dst = (u32x4*)(p.Xs + (mbase + sl) * 1024);
      dst[lane] = src[lane]; dst[64 + lane] = src[64 + lane];
    }
    __syncthreads();
  }
}

template <int W>
__device__ __forceinline__ void pool_item(const Params& p, int r, int c8) {
  int t, n;
  if (r < NL) { t = r & 2047; n = 2048; } else { t = (r - NL) & 255; n = 256; }
  constexpr int lo = W / 2;
  const bf16_t* up = p.proj + (size_t)r * 1024 + c8;
  u32x4 raw[W];
  int cnt = 0;
#pragma unroll
  for (int k = 0; k < W; ++k) {
    const int tt = t - lo + k;
    const bool ok = tt >= 0 && tt < n;
    raw[k] = ok ? *(const u32x4*)(up + (ptrdiff_t)(k - lo) * 1024) : (u32x4){0u, 0u, 0u, 0u};
    cnt += ok ? 1 : 0;
  }
  float s8[8], f[8], uc[8];
#pragma unroll
  for (int j = 0; j < 8; ++j) s8[j] = 0.f;
#pragma unroll
  for (int k = 0; k < W; ++k) {
    unpack8(raw[k], f);
#pragma unroll
    for (int j = 0; j < 8; ++j) s8[j] += f[j];
  }
  unpack8(raw[lo], uc);
  const float ic = 1.f / (float)cnt;
#pragma unroll
  for (int j = 0; j < 8; ++j) f[j] = s8[j] * ic - uc[j];
  *(u32x4*)(p.mix + (size_t)r * 1024 + c8) = pack8(f);
}
__device__ __forceinline__ void ph_pool(const Params& p, int nrows) {
  const size_t gtid = (size_t)lbid() * NTHR + ltid(), gsz = (size_t)lgdim() * NTHR;
  for (size_t it = gtid; it < (size_t)nrows * 128; it += gsz) {
    const int g = (int)(it / ((size_t)nrows * 32));
    const size_t rem = it - (size_t)g * nrows * 32;
    const int r = (int)(rem >> 5), c8 = g * 256 + (int)(rem & 31) * 8;
    if (g == 0) pool_item<2>(p, r, c8);
    else if (g == 1) pool_item<4>(p, r, c8);
    else if (g == 2) pool_item<8>(p, r, c8);
    else pool_item<16>(p, r, c8);
  }
}

enum { PH_INIT = 0, PH_NORM1, PH_GEMM_IN_EVEN, PH_POST_EVEN, PH_ATT, PH_MLSTM_U, PH_MLSTM_SCAN, PH_MLSTM_H, PH_GEMM_OUT, PH_NORM2, PH_TOPK, PH_GATHER,
       PH_MOE_GU, PH_MOE_D, PH_GEMM_IN_ODD, PH_POOL, PH_GEMM_GRP, PH_FINAL };

typedef const __attribute__((address_space(4))) Params* KParams;
__device__ __forceinline__ const Params& get_params() {
  KParams kp = (KParams)__builtin_amdgcn_kernarg_segment_ptr();
  asm volatile("" : "+s"(kp));
  return *(const Params*)kp;
}
__device__ __forceinline__ int idle_slots(int nu, int G, int c) {
  const int mx = (nu + G - 1) / G, mine = c < nu ? (nu - c + G - 1) / G : 0;
  return mx - mine;
}
__device__ __forceinline__ void run_phase(int ph, int l, unsigned char* shm) {
  const Params& p = get_params();
  float* sm = (float*)shm;
  LAS unsigned char* lds = (LAS unsigned char*)shm;
  const bool ctx_next = (l < 2);
  const bool ctx_used = (l < 3);
  const int G = lgdim(), c = lbid();
  switch (ph) {
    case PH_INIT: ph_init(p, sm); break;
    case PH_NORM1: {
      const int ncomb = (l == 0) ? 0 : ((l - 1) < 2 ? NT : NL);
      ph_norm(p, l, 1, ctx_used ? NT : NL, ncomb, l - 1, sm);
    } break;
    case PH_GEMM_IN_EVEN: {
      g8::SchedDense S{(const char*)p.hbuf, (const char*)(p.WinE + (size_t)(l >> 1) * PROJW * 1024), 1024, 1024, NT / 256, PROJW / 256, 0, G, c};
      g8::EpiBf16 E{p.proj, PROJW};
      g8::gemm_phase(lds, 1024, 1024, 1024, S, E);
      conv_quota(p, idle_slots(S.nM * S.nN, G, c) * 3, sm);
    } break;
    case PH_POST_EVEN: ph_post_even(p, l, sm); break;
    case PH_MLSTM_U: ph_mlstm_u(p, lds); break;
    case PH_ATT: ph_att(p, ctx_next, lds); ph_mlstm_scan(p, ctx_next ? 64 : 0); conv_quota(p, idle_slots(512 + (ctx_next ? 64 : 0), G, c) * 6, sm); break;
    case PH_MLSTM_H: ph_mlstm_h(p, l, ctx_next, lds); conv_quota(p, idle_slots(32 * (ctx_next ? 18 : 16), G, c) * 3, sm); break;
    case PH_GEMM_OUT: {
      g8::SchedDense S{(const char*)p.mix, (const char*)(p.WoutE + (size_t)(l >> 1) * 1024 * 1024), 1024, 1024, (ctx_next ? NT : NL) / 256, 4, 0, G, c};
      g8::EpiResid E{p.xcur, p.mod + (size_t)l * 9 * 6144 + 2 * 1024, nullptr, l == 0 ? p.x : nullptr, p.ctx};
      g8::gemm_phase(lds, 1024, 1024, 1024, S, E);
      conv_quota(p, idle_slots(S.nM * S.nN, G, c) * 3, sm);
    } break;
    case PH_NORM2: ph_norm(p, l, 2, ctx_next ? NT : NL, 0, 0, sm); break;
    case PH_TOPK: ph_topk(p, ctx_next, sm); conv_until(p, l == 0 ? CE4 : (l == 1 ? CE7 : (l == 2 ? CE10 : CE11)), sm); break;
    case PH_MOE_GU: {
      g8::SchedMoe S{(const char*)p.Xs, (const char*)(p.Wgu + (size_t)l * NEXP * 2048 * 1024), 8, 2048, 128, ctx_next ? 1152 : 1024, G, c};
      g8::EpiSwiGLU E{p.Abuf};
      g8::gemm_phase(lds, 1024, 1024, 1024, S, E);
      conv_quota(p, idle_slots(S.nu, G, c) * 3, sm);
    } break;
    case PH_MOE_D: {
      g8::SchedMoe S{(const char*)p.Abuf, (const char*)(p.Wd + (size_t)l * NEXP * 1024 * 1024), 4, 1024, 256, ctx_next ? 576 : 512, G, c};
      g8::EpiDown E{p.Ybuf, p.gatev};
      g8::gemm_phase(lds, 1024, 1024, 1024, S, E);
      conv_quota(p, idle_slots(S.nu, G, c) * 3, sm);
    } break;
    case PH_GEMM_IN_ODD: {
      g8::SchedDense S{(const char*)p.hbuf, (const char*)(p.WinO + (size_t)(l >> 1) * 1024 * 1024), 1024, 1024, (ctx_next ? NT : NL) / 256, 4, 0, G, c};
      g8::EpiBf16 E{p.proj, 1024};
      g8::gemm_phase(lds, 1024, 1024, 1024, S, E);
      conv_quota(p, idle_slots(S.nM * S.nN, G, c) * 3, sm);
    } break;
    case PH_POOL: ph_pool(p, ctx_next ? NT : NL); break;
    case PH_GEMM_GRP: {
      g8::SchedDense S{(const char*)p.mix, (const char*)(p.Wgrp + (size_t)(l >> 1) * 1024 * 256), 1024, 256, (ctx_next ? NT : NL) / 256, 4, 512, G, c};
      g8::EpiResid E{p.xcur, p.mod + (size_t)l * 9 * 6144 + 2 * 1024, p.s_pool + (size_t)(l >> 1) * 1024, nullptr, nullptr};
      g8::gemm_phase(lds, 256, 1024, 256, S, E);
      conv_quota(p, idle_slots(S.nM * S.nN, G, c) * 1, sm);
    } break;
    case PH_FINAL: ph_norm(p, 3, 3, NL, NL, 3, sm); break;
  }
}

__global__ void __launch_bounds__(NTHR) mega_kernel(Params p) {
  extern __shared__ __attribute__((aligned(16))) unsigned char shm[];
  cg::grid_group grid = cg::this_grid();
  volatile LAS unsigned* st = (volatile LAS unsigned*)((LAS unsigned char*)shm + g8::STAGE_BYTES + 1536);
  if (threadIdx.x < 2) st[threadIdx.x] = 0u;
  __syncthreads();
  unsigned* barw;
  { const Params& q = get_params(); barw = q.barw; }
  const XcdBarrier xb = xcd_barrier_post(barw, st);
  const int nprog = p.nprog;
  for (int i = 0; i < nprog; ++i) {
    int ph, l;
    { const Params& q = get_params(); ph = q.prog_ph[i]; l = q.prog_l[i]; }
    run_phase(ph, l, shm);
    if (i + 1 < nprog) { if (i == 0) grid.sync(); else xcd_barrier(xb); }
  }
}

extern "C" void kernel_launch(void* const* d_in, const int* in_sizes, int n_in, void* d_out, int out_size, void* d_ws, size_t ws_size,
                              hipStream_t stream) {
  Params p{};
  const float* const* in = (const float* const*)d_in;
  p.x = in[0]; p.c = in[1]; p.ctx = in[2]; p.c_ctx = in[3]; p.w_mod = in[4]; p.b_mod = in[5]; p.g_norm1 = in[6]; p.g_norm2 = in[7];
  p.w_in_even = in[8]; p.w_out_even = in[9]; p.g_qnorm = in[10]; p.g_knorm = in[11]; p.w_conv = in[12]; p.b_gate = in[13];
  p.g_hnorm = in[14]; p.w_in_odd = in[15]; p.w_pool_grp = in[16]; p.s_pool = in[17]; p.w_router = in[18]; p.w_exp_gate = in[19];
  p.w_exp_up = in[20]; p.w_exp_down = in[21]; p.g_final = in[22];
  p.out = (float*)d_out;
  char* w = (char*)d_ws;
  size_t off = 0;
  auto take = [&](size_t bytes) { char* r = w + off; off += (bytes + 255) & ~(size_t)255; return (void*)r; };
  p.xcur = (float*)take((size_t)NT * 1024 * 4);
  p.mod = (float*)take(4 * 9 * 6144 * 4);
  p.hbuf = (bf16_t*)take((size_t)NT * 1024 * 2);
  p.Ybuf = (bf16_t*)take((size_t)MOE_T * 1024 * 2);
  p.gatev = (float*)take(MOE_T * 4);
  p.rowidx = (int*)take(MOE_T * 4);
  p.slotmap = (int*)take((size_t)NT * 16 * 4);
  p.barw = (unsigned*)take(XCD_BAR_WORDS * 4);
  p.aff = (float*)take((size_t)NT * 16 * 4);
  p.gates = (float*)take((size_t)NT * 16 * 4);
  p.WinE = (bf16_t*)take((size_t)2 * PROJW * 1024 * 2);
  p.WoutE = (bf16_t*)take((size_t)2 * 1024 * 1024 * 2);
  p.WinO = (bf16_t*)take((size_t)2 * 1024 * 1024 * 2);
  p.Wgrp = (bf16_t*)take((size_t)2 * 1024 * 256 * 2);
  p.Wgu = (bf16_t*)take((size_t)4 * NEXP * 2048 * 1024 * 2);
  p.Wd = (bf16_t*)take((size_t)4 * NEXP * 1024 * 1024 * 2);
  const size_t uoff = off;
  p.proj = (bf16_t*)take((size_t)NT * PROJW * 2);
  p.Qb = (bf16_t*)take((size_t)NT * 512 * 2);
  p.Kb = (bf16_t*)take((size_t)NB * 2 * 2304 * 64 * 2);
  p.Vb = (bf16_t*)take((size_t)NB * 2 * 2304 * 64 * 2);
  p.qm = (bf16_t*)take((size_t)NT * 512 * 2);
  p.km = (bf16_t*)take((size_t)NT * 512 * 2);
  p.gsG = (float*)take((size_t)NT * 8 * 4);
  p.gsR = (float*)take((size_t)NT * 8 * 4);
  p.gsB = (float*)take((size_t)NT * 8 * 4);
  p.cMIN = (float*)take(64 * 18 * 4);
  p.cE1 = (float*)take(64 * 18 * 4);
  p.cDEC = (float*)take(64 * 18 * 4);
  p.Ubuf = (float*)take((size_t)64 * 17 * 16384 * 4);
  p.NLb = (float*)take((size_t)64 * 17 * 128 * 4);
  p.NVb = (float*)take((size_t)64 * 18 * 128 * 4);
  p.Cbf = (bf16_t*)take((size_t)64 * 18 * 16384 * 2);
  p.mix = (bf16_t*)take((size_t)NT * 1024 * 2);
  const size_t uend = off;
  off = uoff;
  p.Xs = (bf16_t*)take((size_t)MOE_T * 1024 * 2);
  p.Abuf = (bf16_t*)take((size_t)MOE_T * 1024 * 2);
  if (off < uend) off = uend;
  if (off > ws_size) { fprintf(stderr, "ws too small: need %zu have %zu\n", off, ws_size); return; }

  int n = 0;
  auto add = [&](int ph, int l) { p.prog_ph[n] = (unsigned char)ph; p.prog_l[n] = (unsigned char)l; ++n; };
  add(PH_INIT, 0);
  for (int l = 0; l < 4; ++l) {
    add(PH_NORM1, l);
    if ((l & 1) == 0) {
      add(PH_GEMM_IN_EVEN, l); add(PH_POST_EVEN, l); add(PH_MLSTM_U, l); add(PH_ATT, l); add(PH_MLSTM_H, l); add(PH_GEMM_OUT, l);
    } else {
      add(PH_GEMM_IN_ODD, l); add(PH_POOL, l); add(PH_GEMM_GRP, l);
    }
    add(PH_NORM2, l); add(PH_TOPK, l); add(PH_MOE_GU, l); add(PH_MOE_D, l);
  }
  add(PH_FINAL, 0);
  p.nprog = n;

  const int LDS = g8::STAGE_BYTES + 2048;
  static int grid_blocks = 0;
  if (!grid_blocks) {
    (void)hipFuncSetAttribute((const void*)mega_kernel, hipFuncAttributeMaxDynamicSharedMemorySize, LDS);
    int dev = 0, cus = 0, per_cu = 0;
    (void)hipGetDevice(&dev);
    (void)hipDeviceGetAttribute(&cus, hipDeviceAttributeMultiprocessorCount, dev);
    (void)hipOccupancyMaxActiveBlocksPerMultiprocessor(&per_cu, mega_kernel, NTHR, LDS);
    if (per_cu < 1) per_cu = 1;
    if (per_cu > 1) per_cu = 1;
    grid_blocks = cus * per_cu;
  }
  (void)hipMemsetAsync(p.barw, 0, XCD_BAR_WORDS * 4, stream);
  void* args[] = {&p};
  hipError_t e = hipLaunchCooperativeKernel((void*)mega_kernel, dim3(grid_blocks), dim3(NTHR), args, LDS, stream);
  if (e != hipSuccess) fprintf(stderr, "cooperative launch failed: %s (grid %d)\n", hipGetErrorString(e), grid_blocks);
}
```

```cpp
#include <hip/hip_runtime.h>
#include <hip/hip_cooperative_groups.h>
#include <math.h>
#include <stdio.h>
namespace cg = cooperative_groups;

#define DM 1024
#define NB 8
#define SEQ 2048
#define CTXL 256
#define NL (NB * SEQ)
#define NC (NB * CTXL)
#define NT (NL + NC)
#define EVEN_IN 2832
#define PROJW 2816
#define NEXP 16
#define MOE_L (NEXP * NB * 256)
#define MOE_C (NEXP * NB * 32)
#define MOE_T (MOE_L + MOE_C)
#define EPS 1e-6f
#define NTHR 512
#define LAS __attribute__((address_space(3)))

typedef unsigned short bf16_t;
typedef short bf16x8 __attribute__((ext_vector_type(8)));
typedef float f32x4 __attribute__((ext_vector_type(4)));
typedef unsigned u32x4 __attribute__((ext_vector_type(4)));
typedef unsigned u32x2 __attribute__((ext_vector_type(2)));

struct Params {
  const float *x, *c, *ctx, *c_ctx, *w_mod, *b_mod, *g_norm1, *g_norm2, *w_in_even, *w_out_even, *g_qnorm, *g_knorm,
      *w_conv, *b_gate, *g_hnorm, *w_in_odd, *w_pool_grp, *s_pool, *w_router, *w_exp_gate, *w_exp_up, *w_exp_down, *g_final;
  float* out;
  float *xcur, *mod, *gates, *aff, *gatev, *gsG, *gsR, *gsB, *cMIN, *cE1, *cDEC, *Ubuf, *NLb, *NVb;
  bf16_t *hbuf, *proj, *mix, *Xs, *Abuf, *Ybuf, *Qb, *Kb, *Vb, *qm, *km, *Cbf;
  bf16_t *WinE, *WoutE, *WinO, *Wgrp, *Wgu, *Wd;
  int *rowidx, *slotmap;
  unsigned* barw;
  int nprog;
  unsigned char prog_ph[60], prog_l[60];
};

__device__ __forceinline__ float siluf(float v) { return v / (1.f + expf(-v)); }
__device__ __forceinline__ float sigmoidf_(float v) { return 1.f / (1.f + expf(-v)); }
__device__ __forceinline__ float logsigmoidf_(float v) { return fminf(v, 0.f) - log1pf(expf(-fabsf(v))); }
__device__ __forceinline__ float wave_sum(float v) {
#pragma unroll
  for (int o = 32; o > 0; o >>= 1) v += __shfl_xor(v, o);
  return v;
}
__device__ __forceinline__ int modrow(int r) { return r < NL ? (r >> 11) : 8; }
__device__ __forceinline__ float bf2f(bf16_t v) { return __uint_as_float(((unsigned)v) << 16); }
typedef float f32x2_t __attribute__((ext_vector_type(2)));
typedef __bf16 bf16x2_t __attribute__((ext_vector_type(2)));
__device__ __forceinline__ unsigned cvt_pk_bf16(float lo, float hi) {
  const f32x2_t v = {lo, hi};
  return __builtin_bit_cast(unsigned, __builtin_convertvector(v, bf16x2_t));
}
__device__ __forceinline__ bf16_t f2bf(float f) { return (bf16_t)(cvt_pk_bf16(f, 0.f) & 0xffffu); }

__device__ __forceinline__ int ltid() { int t = threadIdx.x; asm volatile("" : "+v"(t)); return t; }
__device__ __forceinline__ int lbid() { int b = blockIdx.x; asm volatile("" : "+s"(b)); return b; }
__device__ __forceinline__ int lgdim() { int g = gridDim.x; asm volatile("" : "+s"(g)); return g; }

#define XB_TMO      128
#define XB_XCNT(j)  (256  + 64 * (j))
#define XB_XSUB(j)  (1280 + 64 * (j))
#define XB_XGEN(j)  (2304 + 64 * (j))
#define XB_TOP      3328
#define XB_TOPGEN   3392
#define XCD_BAR_WORDS 3456
#define XB_SPIN_CAP (1u << 18)
__device__ __forceinline__ unsigned xb_ld(unsigned* p)              { return __hip_atomic_load(p, __ATOMIC_RELAXED, __HIP_MEMORY_SCOPE_AGENT); }
__device__ __forceinline__ unsigned xb_add(unsigned* p, unsigned v) { return __hip_atomic_fetch_add(p, v, __ATOMIC_RELAXED, __HIP_MEMORY_SCOPE_AGENT); }
__device__ __forceinline__ unsigned xb_xcc_id() { return (unsigned)__builtin_amdgcn_s_getreg((3 << 11) | 20) & 0xFu; }
#define XB_SPIN(cond, bar) do { unsigned _sp = 0; while (cond) { __builtin_amdgcn_s_sleep(1); \
    if ((++_sp & 255u) == 0u) { if (xb_ld(&(bar)[XB_TMO])) break; if (_sp > XB_SPIN_CAP) { atomicAdd(&(bar)[XB_TMO], 1u); break; } } } } while (0)
struct XcdBarrier { unsigned* bar; unsigned x; volatile LAS unsigned* st; };
__device__ __forceinline__ XcdBarrier xcd_barrier_post(unsigned* bar, volatile LAS unsigned* st) {
  XcdBarrier b; b.bar = bar; b.x = xb_xcc_id(); b.st = st;
  if (threadIdx.x == 0) (void)xb_add(&bar[XB_XCNT(b.x)], 1u);
  return b;
}
__device__ __forceinline__ void xcd_barrier_complete(unsigned* bar, unsigned x, unsigned& nloc, unsigned& nx) {
  const unsigned G = gridDim.x * gridDim.y * gridDim.z;
  unsigned sum, cnt, mine, sp = 0u;
  for (;;) {
    sum = 0u; cnt = 0u; mine = 0u;
#pragma unroll
    for (unsigned j = 0; j < 16; ++j) { const unsigned c = xb_ld(&bar[XB_XCNT(j)]); sum += c; cnt += (c > 0u) ? 1u : 0u; mine = (j == x) ? c : mine; }
    if (sum == G) break;
    __builtin_amdgcn_s_sleep(1);
    if ((++sp & 255u) == 0u) { if (xb_ld(&bar[XB_TMO])) break; if (sp > XB_SPIN_CAP) { atomicAdd(&bar[XB_TMO], 1u); break; } }
  }
  nloc = mine > 0u ? mine : 1u; nx = cnt > 0u ? cnt : 1u;
}
__device__ __forceinline__ void xcd_barrier(const XcdBarrier& b) {
  asm volatile("s_waitcnt vmcnt(0)" ::: "memory");
  __syncthreads();
  if (threadIdx.x == 0) {
    unsigned* bar = b.bar;
    __builtin_amdgcn_s_waitcnt(0);
    unsigned nloc = b.st[0], nx = b.st[1];
    if (nloc == 0u) { xcd_barrier_complete(bar, b.x, nloc, nx); b.st[0] = nloc; b.st[1] = nx; }
    const unsigned old = xb_add(&bar[XB_XSUB(b.x)], 1u);
    const unsigned gen = old / nloc;
    if (old + 1u == (gen + 1u) * nloc) {
      __builtin_amdgcn_fence(__ATOMIC_RELEASE, "agent");
      asm volatile("s_waitcnt vmcnt(0)" ::: "memory");
      const unsigned og = xb_add(&bar[XB_TOP], 1u);
      const unsigned tg = og / nx;
      if (og + 1u == (tg + 1u) * nx) xb_add(&bar[XB_TOPGEN], 1u);
      else XB_SPIN(xb_ld(&bar[XB_TOPGEN]) == tg, bar);
      __builtin_amdgcn_fence(__ATOMIC_ACQUIRE, "agent");
      xb_add(&bar[XB_XGEN(b.x)], 1u);
      asm volatile("s_waitcnt vmcnt(0)" ::: "memory");
    } else {
      XB_SPIN(xb_ld(&bar[XB_XGEN(b.x)]) == gen, bar);
      __builtin_amdgcn_fence(__ATOMIC_ACQUIRE, "agent");
      asm volatile("s_waitcnt vmcnt(0)" ::: "memory");
    }
  }
  __syncthreads();
}

namespace g8 {
constexpr int BM = 256, BK = 64, HALF = 128, HTB = HALF * BK * 2, STAGE_BYTES = 8 * HTB;
__device__ __forceinline__ int lds_byte(int r, int c) { const int st = (r >> 4) * 2 + (c >> 5), rr = r & 15, cc = c & 31, ob = rr * 64 + cc * 2; return st * 1024 + (ob ^ (((ob >> 9) & 1) << 5)); }
__device__ __forceinline__ void stage_rc(int b, int& R, int& C) { const int st = b / 1024, sb = b % 1024, swz = sb ^ (((sb >> 9) & 1) << 5); R = (st >> 1) * 16 + swz / 64; C = (st & 1) * 32 + (swz % 64) / 2; }
__device__ __forceinline__ int perm32(int rho) { const int n = rho >> 4, i = rho & 15; return 8 * (i >> 2) + 4 * n + (i & 3); }

struct Unit { const char* A; const char* B; int row0, col0; };

template <class Epi, class Sched>
__device__ __forceinline__ void gemm_phase(LAS unsigned char* lds, const int K, const int lda, const int ldb, const Sched& S, const Epi& E) {
  const int tid = ltid(), wid = __builtin_amdgcn_readfirstlane(tid >> 6), lane = tid & 63, wr = wid >> 2, wc = wid & 3, fr = lane & 15, fq = lane >> 4;
  const int nt = K / BK;
  unsigned voffA[2], voffB[2];
#pragma unroll
  for (int i = 0; i < 2; ++i) {
    int R, C;
    stage_rc(tid * 16 + i * 8192, R, C);
    const int Rb = (R & ~31) + perm32(R & 31);
    voffA[i] = (unsigned)(R * lda + C) * 2u;
    voffB[i] = (unsigned)(Rb * ldb + C) * 2u;
  }
  const size_t kstep = (size_t)(BK * 2);
  const size_t hstepA = (size_t)HALF * lda * 2, hstepB = (size_t)HALF * ldb * 2;
  const unsigned ldsw = (unsigned)wid * 1024u;
  const int aoff = lds_byte(wr * 64 + fr, fq * 8), boff = lds_byte(wc * 32 + fr, fq * 8);
#define PG8_SA(b, h) (((b) * 2 + (h)) * HTB)
#define PG8_SB(b, h) ((4 + (b) * 2 + (h)) * HTB)
#define PG8_STAGE(bufoff, gbase, voff) do { _Pragma("unroll") for (int _i = 0; _i < 2; ++_i) \
    __builtin_amdgcn_global_load_lds((const unsigned*)((const char*)(gbase) + (voff)[_i]), (LAS unsigned*)(lds + (bufoff) + ldsw + _i * 8192), 16, 0, 0); } while (0)
#define PG8_LDA(dst, b, h) do { _Pragma("unroll") for (int m = 0; m < 4; ++m) _Pragma("unroll") for (int k = 0; k < 2; ++k) dst[m][k] = *(const LAS bf16x8*)(lds + PG8_SA(b, h) + aoff + m * 2048 + k * 1024); } while (0)
#define PG8_LDB(dst, b, h) do { _Pragma("unroll") for (int n = 0; n < 2; ++n) _Pragma("unroll") for (int k = 0; k < 2; ++k) dst[n][k] = *(const LAS bf16x8*)(lds + PG8_SB(b, h) + boff + n * 2048 + k * 1024); } while (0)
#define PG8_MMA(ai, bj, At, Bt) do { __builtin_amdgcn_s_setprio(1); _Pragma("unroll") for (int m = 0; m < 4; ++m) _Pragma("unroll") for (int n = 0; n < 2; ++n) _Pragma("unroll") for (int k = 0; k < 2; ++k) \
    acc[ai][bj][m][n] = __builtin_amdgcn_mfma_f32_16x16x32_bf16(Bt[n][k], At[m][k], acc[ai][bj][m][n], 0, 0, 0); __builtin_amdgcn_s_setprio(0); } while (0)
#define PG8_WAIT_V(n) asm volatile("s_waitcnt vmcnt(" #n ")" ::: "memory")
#define PG8_WAIT_L(n) asm volatile("s_waitcnt lgkmcnt(" #n ")" ::: "memory")
#define PG8_BAR __builtin_amdgcn_s_barrier()
#define PG8_SCHED __builtin_amdgcn_sched_barrier(0)
  Unit cur, nxt;
  int ui = 0;
  if (!S.next(0, cur)) return;
  f32x4 acc[2][2][4][2];
#pragma unroll
  for (int a = 0; a < 2; ++a)
#pragma unroll
    for (int b = 0; b < 2; ++b)
#pragma unroll
      for (int m = 0; m < 4; ++m)
#pragma unroll
        for (int n = 0; n < 2; ++n) acc[a][b][m][n] = (f32x4){0.f, 0.f, 0.f, 0.f};
  bf16x8 At[4][2], B0[2][2], B1[2][2];
  const char* cA = cur.A;
  const char* cB = cur.B;
  PG8_STAGE(PG8_SB(0, 0), cB, voffB); PG8_STAGE(PG8_SB(0, 1), cB + hstepB, voffB); PG8_STAGE(PG8_SA(0, 0), cA, voffA); PG8_STAGE(PG8_SA(0, 1), cA + hstepA, voffA);
  if (wr == 1) PG8_BAR;
  PG8_WAIT_V(2); PG8_BAR;
  PG8_STAGE(PG8_SB(1, 0), cB + kstep, voffB); PG8_STAGE(PG8_SA(1, 0), cA + kstep, voffA); PG8_STAGE(PG8_SB(1, 1), cB + hstepB + kstep, voffB);
  PG8_WAIT_V(6); PG8_BAR;
  for (;;) {
    const bool has_next = S.next(ui + 1, nxt);
    const char* nA = has_next ? nxt.A : cA;
    const char* nB = has_next ? nxt.B : cB;
    for (int t = 0; t < nt; t += 2) {
      const bool last = (t == nt - 2);
      const char* a1 = cA + (size_t)(t + 1) * kstep;
      const char* a2 = last ? nA : cA + (size_t)(t + 2) * kstep;
      const char* b2 = last ? nB : cB + (size_t)(t + 2) * kstep;
      const char* a3 = a2 + kstep;
      const char* b3 = b2 + kstep;
      PG8_LDB(B0, 0, 0); PG8_LDB(B1, 0, 1); PG8_SCHED; PG8_LDA(At, 0, 0); PG8_STAGE(PG8_SA(1, 1), a1 + hstepA, voffA);
      PG8_WAIT_V(8); PG8_WAIT_L(0); PG8_BAR; PG8_MMA(0, 0, At, B0); PG8_MMA(0, 1, At, B1); PG8_BAR; PG8_SCHED;
      PG8_LDA(At, 0, 1); PG8_STAGE(PG8_SB(0, 0), b2, voffB); PG8_STAGE(PG8_SB(0, 1), b2 + hstepB, voffB); PG8_STAGE(PG8_SA(0, 0), a2, voffA);
      PG8_WAIT_V(8); PG8_WAIT_L(0); PG8_BAR; PG8_MMA(1, 0, At, B0); PG8_MMA(1, 1, At, B1); PG8_BAR; PG8_SCHED;
      PG8_LDB(B0, 1, 0); PG8_LDB(B1, 1, 1); PG8_SCHED; PG8_LDA(At, 1, 0); PG8_STAGE(PG8_SA(0, 1), a2 + hstepA, voffA);
      PG8_WAIT_V(8); PG8_WAIT_L(0); PG8_BAR; PG8_MMA(0, 0, At, B0); PG8_MMA(0, 1, At, B1); PG8_BAR; PG8_SCHED;
      PG8_LDA(At, 1, 1); PG8_STAGE(PG8_SB(1, 0), b3, voffB); PG8_STAGE(PG8_SB(1, 1), b3 + hstepB, voffB); PG8_STAGE(PG8_SA(1, 0), a3, voffA);
      PG8_WAIT_V(8); PG8_WAIT_L(0); PG8_BAR; PG8_MMA(1, 0, At, B0); PG8_MMA(1, 1, At, B1); PG8_BAR; PG8_SCHED;
    }
    if (wr == 0) PG8_BAR;
    E(acc, cur, wr, wc, fr, fq);
    if (!has_next) break;
#pragma unroll
    for (int a = 0; a < 2; ++a)
#pragma unroll
      for (int b = 0; b < 2; ++b)
#pragma unroll
        for (int m = 0; m < 4; ++m)
#pragma unroll
          for (int n = 0; n < 2; ++n) acc[a][b][m][n] = (f32x4){0.f, 0.f, 0.f, 0.f};
    cur = nxt; cA = nA; cB = nB; ++ui;
    if (wr == 1) PG8_BAR;
  }
  PG8_WAIT_V(0);
  PG8_BAR;
#undef PG8_SA
#undef PG8_SB
#undef PG8_STAGE
#undef PG8_LDA
#undef PG8_LDB
#undef PG8_MMA
#undef PG8_WAIT_V
#undef PG8_WAIT_L
#undef PG8_BAR
#undef PG8_SCHED
}

struct SchedDense {
  const char* A; const char* B; int lda, ldb, nM, nN, acolstep, G, c;
  __device__ __forceinline__ bool next(int i, Unit& u) const {
    const int nwg = nM * nN;
    const long L = (long)i * G + c;
    if (L >= nwg) return false;
    int wgid = (int)L;
    { const int q = nwg / 8, r = nwg % 8, xcd = wgid % 8, off = wgid / 8; wgid = (xcd < r ? xcd * (q + 1) : r * (q + 1) + (xcd - r) * q) + off; }
    const int nig = 8 * nN, gid = wgid / nig, fm = gid * 8, gsz = (nM - fm) < 8 ? (nM - fm) : 8;
    const int pm = fm + ((wgid % nig) % gsz), pn = (wgid % nig) / gsz;
    u.A = A + (size_t)pm * 256 * lda * 2 + (size_t)pn * acolstep;
    u.B = B + (size_t)pn * 256 * ldb * 2;
    u.row0 = pm * 256; u.col0 = pn * 256;
    return true;
  }
};
struct SchedMoe {
  const char* A; const char* W; int ncol, wrows, colw, nu, G, c;
  __device__ __forceinline__ bool next(int i, Unit& u) const {
    const long L = (long)i * G + c;
    if (L >= nu) return false;
    const int wgid = (int)(L % 8) * (nu / 8) + (int)(L / 8);
    const int UL = 128 * ncol;
    int e, pn, row0;
    if (wgid < UL) { e = wgid / (8 * ncol); const int rem = wgid % (8 * ncol); row0 = e * 2048 + (rem % 8) * 256; pn = rem / 8; }
    else { const int w2 = wgid - UL; e = w2 / ncol; pn = w2 % ncol; row0 = MOE_L + e * 256; }
    u.A = A + (size_t)row0 * 1024 * 2;
    u.B = W + ((size_t)e * wrows + (size_t)pn * 256) * 1024 * 2;
    u.row0 = row0; u.col0 = pn * colw;
    return true;
  }
};

struct EpiBf16 {
  bf16_t* O; int ldo;
  __device__ __forceinline__ void operator()(const f32x4 (&acc)[2][2][4][2], const Unit& u, int wr, int wc, int fr, int fq) const {
#pragma unroll
    for (int ai = 0; ai < 2; ++ai)
#pragma unroll
      for (int m = 0; m < 4; ++m) {
        const int row = u.row0 + ai * 128 + wr * 64 + m * 16 + fr;
        bf16_t* rp = O + (size_t)row * ldo + u.col0 + wc * 32 + 8 * fq;
#pragma unroll
        for (int bj = 0; bj < 2; ++bj) {
          const f32x4 v0 = acc[ai][bj][m][0], v1 = acc[ai][bj][m][1];
          u32x4 w; w.x = cvt_pk_bf16(v0[0], v0[1]); w.y = cvt_pk_bf16(v0[2], v0[3]); w.z = cvt_pk_bf16(v1[0], v1[1]); w.w = cvt_pk_bf16(v1[2], v1[3]);
          *(u32x4*)(rp + bj * 128) = w;
        }
      }
  }
};
struct EpiResid {
  float* x; const float* modg; const float* cs; const float* xl; const float* xc;
  __device__ __forceinline__ void operator()(const f32x4 (&acc)[2][2][4][2], const Unit& u, int wr, int wc, int fr, int fq) const {
#pragma unroll
    for (int ai = 0; ai < 2; ++ai)
#pragma unroll
      for (int m = 0; m < 4; ++m) {
        const int row = u.row0 + ai * 128 + wr * 64 + m * 16 + fr;
        const int c0 = u.col0 + wc * 32 + 8 * fq;
        float* xp = x + (size_t)row * 1024 + c0;
        const float* xi = xl ? (row < NL ? xl + (size_t)row * 1024 + c0 : xc + (size_t)(row - NL) * 1024 + c0) : xp;
        const float* gp = modg + (size_t)modrow(row) * 6144 + c0;
#pragma unroll
        for (int bj = 0; bj < 2; ++bj) {
          f32x4 g0 = *(const f32x4*)(gp + bj * 128), g1 = *(const f32x4*)(gp + bj * 128 + 4);
          if (cs) { g0 *= *(const f32x4*)(cs + c0 + bj * 128); g1 *= *(const f32x4*)(cs + c0 + bj * 128 + 4); }
          f32x4 x0 = *(const f32x4*)(xi + bj * 128), x1 = *(const f32x4*)(xi + bj * 128 + 4);
          x0 += g0 * acc[ai][bj][m][0]; x1 += g1 * acc[ai][bj][m][1];
          *(f32x4*)(xp + bj * 128) = x0; *(f32x4*)(xp + bj * 128 + 4) = x1;
        }
      }
  }
};
struct EpiSwiGLU {
  bf16_t* O;
  __device__ __forceinline__ void operator()(const f32x4 (&acc)[2][2][4][2], const Unit& u, int wr, int wc, int fr, int fq) const {
#pragma unroll
    for (int ai = 0; ai < 2; ++ai)
#pragma unroll
      for (int m = 0; m < 4; ++m) {
        const int row = u.row0 + ai * 128 + wr * 64 + m * 16 + fr;
        bf16_t* rp = O + (size_t)row * 1024 + u.col0 + wc * 32 + 8 * fq;
        float o[8];
#pragma unroll
        for (int n = 0; n < 2; ++n)
#pragma unroll
          for (int j = 0; j < 4; ++j) { const float g = acc[ai][0][m][n][j], up = acc[ai][1][m][n][j]; o[n * 4 + j] = g / (1.f + __expf(-g)) * up; }
        u32x4 w; w.x = cvt_pk_bf16(o[0], o[1]); w.y = cvt_pk_bf16(o[2], o[3]); w.z = cvt_pk_bf16(o[4], o[5]); w.w = cvt_pk_bf16(o[6], o[7]);
        *(u32x4*)rp = w;
      }
  }
};
struct EpiDown {
  bf16_t* O; const float* gatev;
  __device__ __forceinline__ void operator()(const f32x4 (&acc)[2][2][4][2], const Unit& u, int wr, int wc, int fr, int fq) const {
#pragma unroll
    for (int ai = 0; ai < 2; ++ai)
#pragma unroll
      for (int m = 0; m < 4; ++m) {
        const int row = u.row0 + ai * 128 + wr * 64 + m * 16 + fr;
        const float gv = gatev[row];
        bf16_t* rp = O + (size_t)row * 1024 + u.col0 + wc * 32 + 8 * fq;
#pragma unroll
        for (int bj = 0; bj < 2; ++bj) {
          const f32x4 v0 = acc[ai][bj][m][0] * gv, v1 = acc[ai][bj][m][1] * gv;
          u32x4 w; w.x = cvt_pk_bf16(v0[0], v0[1]); w.y = cvt_pk_bf16(v0[2], v0[3]); w.z = cvt_pk_bf16(v1[0], v1[1]); w.w = cvt_pk_bf16(v1[2], v1[3]);
          *(u32x4*)(rp + bj * 128) = w;
        }
      }
  }
};
}

#define NT_WINE 1408
#define NT_WOUT 512
#define NT_WINO 512
#define NT_WGRP 128
#define NT_EXP 16384
#define NT_ALL (NT_WINE + NT_WOUT + NT_WINO + NT_WGRP + 3 * NT_EXP)
#define CE0 704
#define CE1 960
#define CE2 13248
#define CE3 13504
#define CE4 13568
#define CE5 25856
#define CE6 26560
#define CE7 26816
#define CE8 39104
#define CE9 39360
#define CE10 39424
#define CE11 51712
__device__ __forceinline__ void conv_batch(const Params& p, int t, float* T) {
  const int tid = ltid(), lane = tid & 63, wv = tid >> 6;
  const float* src; bf16_t* dst; int ld, dK, k0, n0;
  int seg, tb, e, which = 0;
  if (t < CE0) { seg = 0; e = 0; tb = t; } else if (t < CE1) { seg = 1; e = 0; tb = t - CE0; } else if (t < CE2) { seg = 2; e = 0; tb = t - CE1; }
  else if (t < CE3) { seg = 3; e = 0; tb = t - CE2; } else if (t < CE4) { seg = 4; e = 0; tb = t - CE3; } else if (t < CE5) { seg = 2; e = 1; tb = t - CE4; }
  else if (t < CE6) { seg = 0; e = 1; tb = t - CE5; } else if (t < CE7) { seg = 1; e = 1; tb = t - CE6; } else if (t < CE8) { seg = 2; e = 2; tb = t - CE7; }
  else if (t < CE9) { seg = 3; e = 1; tb = t - CE8; } else if (t < CE10) { seg = 4; e = 1; tb = t - CE9; } else { seg = 2; e = 3; tb = t - CE10; }
  int dbase = 0;
  if (seg == 0) {
    k0 = (tb / 44) * 64; n0 = (tb % 44) * 64;
    src = p.w_in_even + (size_t)e * 1024 * EVEN_IN; ld = EVEN_IN; dst = p.WinE + (size_t)e * PROJW * 1024; dK = 1024;
  } else if (seg == 1 || seg == 3) {
    k0 = (tb / 16) * 64; n0 = (tb % 16) * 64;
    src = (seg == 3 ? p.w_in_odd : p.w_out_even) + (size_t)e * 1024 * 1024; ld = 1024; dst = (seg == 3 ? p.WinO : p.WoutE) + (size_t)e * 1024 * 1024; dK = 1024;
  } else if (seg == 4) {
    const int g = tb / 16; k0 = ((tb % 16) / 4) * 64; n0 = (tb % 4) * 64;
    src = p.w_pool_grp + (size_t)(e * 4 + g) * 65536; ld = 256; dst = p.Wgrp + (size_t)e * 1024 * 256; dK = 256; dbase = g * 256;
  } else {
    which = tb / 4096; const int r = tb % 4096, le = e * 16 + r / 256; k0 = ((r % 256) / 16) * 64; n0 = (r % 16) * 64;
    const float* base = which == 0 ? p.w_exp_gate : (which == 1 ? p.w_exp_up : p.w_exp_down);
    src = base + (size_t)le * 1024 * 1024; ld = 1024; dK = 1024;
    dst = which < 2 ? p.Wgu + (size_t)le * 2048 * 1024 : p.Wd + (size_t)le * 1024 * 1024;
  }
  const bool gu = (seg == 2 && which < 2);
  float4 v[8];
#pragma unroll
  for (int q = 0; q < 8; ++q) {
    const int idx = tid + q * NTHR, k = idx >> 6, c4 = idx & 63;
    v[q] = *(const float4*)(src + (size_t)(k0 + k) * ld + n0 + c4 * 4);
  }
#pragma unroll
  for (int q = 0; q < 8; ++q) {
    const int idx = tid + q * NTHR, k = idx >> 6, c4 = idx & 63;
    float* tp = T + k * 257 + c4 * 4;
    tp[0] = v[q].x; tp[1] = v[q].y; tp[2] = v[q].z; tp[3] = v[q].w;
  }
  __syncthreads();
#pragma unroll
  for (int sub = 0; sub < 4; ++sub) {
    const int nl = wv * 8 + (lane >> 3), kq = lane & 7, nn = n0 + sub * 64;
    const int drow0 = gu ? (nn >> 7) * 256 + which * 128 + (nn & 127) : dbase + nn;
    float f[8];
#pragma unroll
    for (int j = 0; j < 8; ++j) f[j] = T[(kq * 8 + j) * 257 + sub * 64 + nl];
    u32x4 w; w.x = cvt_pk_bf16(f[0], f[1]); w.y = cvt_pk_bf16(f[2], f[3]); w.z = cvt_pk_bf16(f[4], f[5]); w.w = cvt_pk_bf16(f[6], f[7]);
    *(u32x4*)(dst + (size_t)(drow0 + nl) * dK + k0 + kq * 8) = w;
  }
}
__device__ __forceinline__ int conv_pull(const Params& p, float* sm) {
  __syncthreads();
  if (ltid() == 0) ((int*)sm)[16500] = (int)__hip_atomic_fetch_add(p.barw, 4u, __ATOMIC_RELAXED, __HIP_MEMORY_SCOPE_AGENT);
  __syncthreads();
  return ((int*)sm)[16500];
}
__device__ __forceinline__ void conv_until(const Params& p, int end, float* sm) {
  int t;
  do { t = conv_pull(p, sm); if (t < CE11) conv_batch(p, t, sm); } while (t + 4 < end);
  __syncthreads();
}
__device__ __forceinline__ void conv_quota(const Params& p, int n, float* sm) {
  for (int i = 0; i < n; ++i) { const int t = conv_pull(p, sm); if (t >= CE11) break; conv_batch(p, t, sm); }
  __syncthreads();
}

__device__ __forceinline__ void ph_init(const Params& p, float* sm) {
  const int tid = ltid(), lane = tid & 63, wv = tid >> 6;
  const size_t gtid = (size_t)lbid() * NTHR + tid, gsz = (size_t)lgdim() * NTHR;
  for (int i = tid; i < 9 * 1024; i += NTHR) {
    const int r = i >> 10, k = i & 1023;
    sm[i] = siluf(r < 8 ? p.c[r * 1024 + k] : p.c_ctx[k]);
  }
  __syncthreads();
  float* part = sm + 9 * 1024;
  for (int item = lbid(); item < 768; item += lgdim()) {
    const int l = item / 192, j0 = (item % 192) * 32;
    const int col = lane & 31, kh = lane >> 5;
    const float* w = p.w_mod + (size_t)l * 1024 * 6144 + j0 + col;
    float acc[9];
#pragma unroll
    for (int r = 0; r < 9; ++r) acc[r] = 0.f;
    const int kb = wv * 128 + kh * 64;
#pragma unroll 4
    for (int kk = 0; kk < 64; ++kk) {
      const float wvv = w[(size_t)(kb + kk) * 6144];
#pragma unroll
      for (int r = 0; r < 9; ++r) acc[r] += sm[r * 1024 + kb + kk] * wvv;
    }
#pragma unroll
    for (int r = 0; r < 9; ++r) part[((wv * 2 + kh) * 9 + r) * 32 + col] = acc[r];
    __syncthreads();
    if (tid < 288) {
      const int r = tid >> 5, cc = tid & 31;
      float s = 0.f;
#pragma unroll
      for (int sl = 0; sl < 16; ++sl) s += part[(sl * 9 + r) * 32 + cc];
      p.mod[(size_t)(l * 9 + r) * 6144 + j0 + cc] = s + p.b_mod[l * 6144 + j0 + cc];
    }
    __syncthreads();
  }
  conv_until(p, CE1, sm);
}

#define NORM_R 1
__device__ __forceinline__ void ph_norm(const Params& p, int l, int which, int nrows, int ncomb, int lprev, float* sm) {
  const int tid = ltid(), lane = tid & 63, wv = tid >> 6;
  const bool skinny = (which == 2) || (which == 1 && (l & 1) == 0);
  if (skinny) {
    const float* wbase; int stride;
    if (which == 2) { wbase = p.w_router + (size_t)l * 1024 * 16; stride = 16; }
    else { wbase = p.w_in_even + (size_t)(l >> 1) * 1024 * EVEN_IN + PROJW; stride = EVEN_IN; }
    __syncthreads();
    for (int idx = tid; idx < 4096; idx += NTHR) {
      const int d = idx >> 2, q = idx & 3;
      const float4 w4 = *(const float4*)(wbase + (size_t)d * stride + q * 4);
      const int i = d >> 8, ln = (d >> 2) & 63, j = d & 3;
      ((float4*)sm)[((i * 4 + j) * 4 + q) * 64 + ln] = w4;
    }
    __syncthreads();
  }
  const int nwaves = lgdim() * (NTHR / 64), gw = lbid() * (NTHR / 64) + wv;
  const int per = (nrows + nwaves - 1) / nwaves;
  const int rbeg = gw * per, rend = min(nrows, rbeg + per);
  const bool in0 = (which == 1 && l == 0);
  float4 vn[4];
  int slvn = -1;
  if (rbeg < rend) {
    const float* xs0 = in0 ? (rbeg < NL ? p.x + (size_t)rbeg * DM : p.ctx + (size_t)(rbeg - NL) * DM) : p.xcur + (size_t)rbeg * DM;
#pragma unroll
    for (int i = 0; i < 4; ++i) vn[i] = ((const float4*)xs0)[i * 64 + lane];
    if (rbeg < ncomb && lane < 16) slvn = p.slotmap[rbeg * 16 + lane];
  }
  for (int r = rbeg; r < rend; ++r) {
    float4 v[4];
#pragma unroll
    for (int i = 0; i < 4; ++i) v[i] = vn[i];
    const int slv = slvn;
    float* xr = p.xcur + (size_t)r * DM;
    if (r + 1 < rend) {
      const int rn = r + 1;
      const float* xsn = in0 ? (rn < NL ? p.x + (size_t)rn * DM : p.ctx + (size_t)(rn - NL) * DM) : p.xcur + (size_t)rn * DM;
#pragma unroll
      for (int i = 0; i < 4; ++i) vn[i] = ((const float4*)xsn)[i * 64 + lane];
      slvn = (rn < ncomb && lane < 16) ? p.slotmap[rn * 16 + lane] : -1;
    }
    const int mr = modrow(r);
    if (r < ncomb) {
      float4 s4[4];
#pragma unroll
      for (int i = 0; i < 4; ++i) s4[i] = make_float4(0.f, 0.f, 0.f, 0.f);
      unsigned long long mask = __ballot(slv >= 0);
      while (mask) {
        const int e = __ffsll((long long)mask) - 1;
        mask &= mask - 1;
        const int sl = __shfl(slv, e);
        size_t yrow;
        if (r < NL) yrow = (size_t)e * 2048 + (size_t)(r >> 11) * 256 + sl;
        else yrow = (size_t)MOE_L + (size_t)e * 256 + (size_t)((r - NL) >> 8) * 32 + sl;
        const u32x2* yp = (const u32x2*)(p.Ybuf + yrow * DM);
#pragma unroll
        for (int i = 0; i < 4; ++i) {
          const u32x2 y = yp[i * 64 + lane];
          s4[i].x += __uint_as_float(y.x << 16); s4[i].y += __uint_as_float(y.x & 0xffff0000u);
          s4[i].z += __uint_as_float(y.y << 16); s4[i].w += __uint_as_float(y.y & 0xffff0000u);
        }
      }
      const float4* g5 = (const float4*)(p.mod + (size_t)(lprev * 9 + mr) * 6144 + 5 * 1024);
#pragma unroll
      for (int i = 0; i < 4; ++i) {
        const float4 g = g5[i * 64 + lane];
        v[i].x += g.x * s4[i].x; v[i].y += g.y * s4[i].y; v[i].z += g.z * s4[i].z; v[i].w += g.w * s4[i].w;
        if (which != 3) ((float4*)xr)[i * 64 + lane] = v[i];
      }
    }
    float ss = 0.f;
#pragma unroll
    for (int i = 0; i < 4; ++i) ss += v[i].x * v[i].x + v[i].y * v[i].y + v[i].z * v[i].z + v[i].w * v[i].w;
    ss = wave_sum(ss);
    const float inv = rsqrtf(ss * (1.f / 1024.f) + EPS);
    if (which == 3) {
#pragma unroll
      for (int i = 0; i < 4; ++i) {
        const float4 g = ((const float4*)p.g_final)[i * 64 + lane];
        ((float4*)(p.out + (size_t)r * DM))[i * 64 + lane] = make_float4(v[i].x * inv * g.x, v[i].y * inv * g.y, v[i].z * inv * g.z, v[i].w * inv * g.w);
      }
      continue;
    }
    const float* gn = (which == 1 ? p.g_norm1 : p.g_norm2) + l * 1024;
    const float* mrow = p.mod + (size_t)(l * 9 + mr) * 6144;
    const float4* shp = (const float4*)(mrow + (which == 1 ? 0 : 3) * 1024);
    const float4* scp = (const float4*)(mrow + (which == 1 ? 1 : 4) * 1024);
    float4 h[4];
#pragma unroll
    for (int i = 0; i < 4; ++i) {
      const float4 g = ((const float4*)gn)[i * 64 + lane];
      const float4 sh = shp[i * 64 + lane], sc = scp[i * 64 + lane];
      h[i].x = v[i].x * inv * g.x * (1.f + sc.x) + sh.x;
      h[i].y = v[i].y * inv * g.y * (1.f + sc.y) + sh.y;
      h[i].z = v[i].z * inv * g.z * (1.f + sc.z) + sh.z;
      h[i].w = v[i].w * inv * g.w * (1.f + sc.w) + sh.w;
      u32x2 w; w.x = cvt_pk_bf16(h[i].x, h[i].y); w.y = cvt_pk_bf16(h[i].z, h[i].w);
      ((u32x2*)(p.hbuf + (size_t)r * DM))[i * 64 + lane] = w;
    }
    if (!skinny) continue;
    float lg[16];
#pragma unroll
    for (int e = 0; e < 16; ++e) lg[e] = 0.f;
#pragma unroll
    for (int i = 0; i < 4; ++i)
#pragma unroll
      for (int j = 0; j < 4; ++j) {
        const float hv = j == 0 ? h[i].x : (j == 1 ? h[i].y : (j == 2 ? h[i].z : h[i].w));
#pragma unroll
        for (int q = 0; q < 4; ++q) {
          const float4 w4 = ((const float4*)sm)[((i * 4 + j) * 4 + q) * 64 + lane];
          lg[q * 4 + 0] += hv * w4.x; lg[q * 4 + 1] += hv * w4.y; lg[q * 4 + 2] += hv * w4.z; lg[q * 4 + 3] += hv * w4.w;
        }
        __builtin_amdgcn_sched_barrier(0);
      }
    float v8[8];
#pragma unroll
    for (int k = 0; k < 8; ++k) { const bool up = lane & 32; const float keep = up ? lg[k + 8] : lg[k], send = up ? lg[k] : lg[k + 8]; v8[k] = keep + __shfl_xor(send, 32); }
    float v4[4];
#pragma unroll
    for (int k = 0; k < 4; ++k) { const bool up = lane & 16; const float keep = up ? v8[k + 4] : v8[k], send = up ? v8[k] : v8[k + 4]; v4[k] = keep + __shfl_xor(send, 16); }
    float v2[2];
#pragma unroll
    for (int k = 0; k < 2; ++k) { const bool up = lane & 8; const float keep = up ? v4[k + 2] : v4[k], send = up ? v4[k] : v4[k + 2]; v2[k] = keep + __shfl_xor(send, 8); }
    float v1;
    { const bool up = lane & 4; const float keep = up ? v2[1] : v2[0], send = up ? v2[0] : v2[1]; v1 = keep + __shfl_xor(send, 4); }
    v1 += __shfl_xor(v1, 2);
    v1 += __shfl_xor(v1, 1);
    const int col = lane >> 2;
    if (which == 2) {
      float mx = v1;
      mx = fmaxf(mx, __shfl_xor(mx, 4)); mx = fmaxf(mx, __shfl_xor(mx, 8)); mx = fmaxf(mx, __shfl_xor(mx, 16)); mx = fmaxf(mx, __shfl_xor(mx, 32));
      const float ex = expf(v1 - mx);
      float sum = ex;
      sum += __shfl_xor(sum, 4); sum += __shfl_xor(sum, 8); sum += __shfl_xor(sum, 16); sum += __shfl_xor(sum, 32);
      if ((lane & 3) == 0) p.aff[(size_t)r * 16 + col] = ex / sum;
    } else {
      float gvv = v1 + p.b_gate[(l >> 1) * 16 + col];
      if ((col >> 2) & 1) gvv = logsigmoidf_(gvv);
      if ((lane & 3) == 0) p.gates[(size_t)r * 16 + col] = gvv;
    }
  }
  __syncthreads();
}

#define LOG2E 1.4426950408889634f
__device__ __forceinline__ int chain_row(int b, int dir, int p) {
  if (p < 256) { const int t = dir ? 255 - p : p; return NL + b * 256 + t; }
  const int q = p - 256; const int t = dir ? 2047 - q : q; return b * 2048 + t;
}
__device__ __forceinline__ float wave_incl_sum(float v, int lane) {
#pragma unroll
  for (int o = 1; o < 64; o <<= 1) { const float t = __shfl_up(v, o); if (lane >= o) v += t; }
  return v;
}
__device__ __forceinline__ float wave_incl_max(float v, int lane) {
#pragma unroll
  for (int o = 1; o < 64; o <<= 1) { const float t = __shfl_up(v, o); if (lane >= o) v = fmaxf(v, t); }
  return v;
}
__device__ __forceinline__ void unpack8(const u32x4 w, float (&f)[8]) {
  f[0] = __uint_as_float(w.x << 16); f[1] = __uint_as_float(w.x & 0xffff0000u); f[2] = __uint_as_float(w.y << 16); f[3] = __uint_as_float(w.y & 0xffff0000u);
  f[4] = __uint_as_float(w.z << 16); f[5] = __uint_as_float(w.z & 0xffff0000u); f[6] = __uint_as_float(w.w << 16); f[7] = __uint_as_float(w.w & 0xffff0000u);
}
__device__ __forceinline__ u32x4 pack8(const float (&f)[8]) {
  u32x4 w; w.x = cvt_pk_bf16(f[0], f[1]); w.y = cvt_pk_bf16(f[2], f[3]); w.z = cvt_pk_bf16(f[4], f[5]); w.w = cvt_pk_bf16(f[6], f[7]);
  return w;
}
__device__ __forceinline__ void ph_post_even(const Params& p, int l, float* sm) {
  const int e = l >> 1;
  const int tid = ltid(), lane = tid & 63;
  __syncthreads();
  for (int idx = tid; idx < 1024; idx += NTHR) {
    const int pos = idx >> 4, i = idx & 15;
    const float ang = (float)pos * exp2f(-(float)i * (13.287712379549449f / 16.f));
    float sn, cs;
    sincosf(ang, &sn, &cs);
    sm[2 * idx] = cs; sm[2 * idx + 1] = sn;
  }
  __syncthreads();
  const int bid = lbid(), G = lgdim();
  const bool scanner = (bid < 64) && (tid < 64) && (G > 64);
  const size_t nthr_e = (size_t)G * NTHR - (G > 64 ? 64 * 64 : 0);
  size_t gtid;
  if (G > 64) gtid = bid < 64 ? (size_t)bid * (NTHR - 64) + (tid - 64) : (size_t)64 * (NTHR - 64) + (size_t)(bid - 64) * NTHR + tid;
  else gtid = (size_t)bid * NTHR + tid;
  const size_t gsz = nthr_e;
  if (!scanner) {
  for (size_t it = gtid; it < (size_t)NT * 10; it += gsz) {
    const int r = (int)(it / 10), hh = (int)(it % 10);
    const bool lat = r < NL;
    const int t = r & 2047;
    const int bb = lat ? (r >> 11) : ((r - NL) >> 8);
    const int key = lat ? 256 + t : ((r - NL) & 255);
    const bf16_t* src; bf16_t* dst; const float* g; float osc;
    if (hh < 8) { src = p.proj + (size_t)r * PROJW + hh * 64; dst = p.Qb + (size_t)r * 512 + hh * 64; g = p.g_qnorm + e * 64; osc = 0.125f * LOG2E; }
    else { src = p.proj + (size_t)r * PROJW + 512 + (hh - 8) * 64; dst = p.Kb + ((size_t)(bb * 2 + (hh - 8)) * 2304 + key) * 64; g = p.g_knorm + e * 64; osc = 1.f;
           const u32x4* vs = (const u32x4*)(p.proj + (size_t)r * PROJW + 640 + (hh - 8) * 64);
           u32x4* vd = (u32x4*)(p.Vb + ((size_t)(bb * 2 + (hh - 8)) * 2304 + key) * 64);
#pragma unroll
           for (int q = 0; q < 8; ++q) vd[q] = vs[q]; }
    float x[64];
#pragma unroll
    for (int q = 0; q < 8; ++q) { float f[8]; unpack8(((const u32x4*)src)[q], f);
#pragma unroll
      for (int j = 0; j < 8; ++j) x[q * 8 + j] = f[j]; }
    float ss = 0.f;
#pragma unroll
    for (int j = 0; j < 64; ++j) ss += x[j] * x[j];
    const float inv = rsqrtf(ss * (1.f / 64.f) + EPS) * osc;
#pragma unroll
    for (int j = 0; j < 64; ++j) x[j] *= inv * g[j];
    if (lat) {
#pragma unroll
      for (int a = 0; a < 2; ++a) {
        const int pos = (a == 0) ? (t >> 6) : (t & 63);
#pragma unroll
        for (int i = 0; i < 16; ++i) {
          const float2 cssn = *(const float2*)(sm + 2 * (pos * 16 + i));
          const float x1 = x[a * 32 + i], x2 = x[a * 32 + 16 + i];
          x[a * 32 + i] = x1 * cssn.x - x2 * cssn.y;
          x[a * 32 + 16 + i] = x2 * cssn.x + x1 * cssn.y;
        }
      }
    }
#pragma unroll
    for (int q = 0; q < 8; ++q) { float f[8];
#pragma unroll
      for (int j = 0; j < 8; ++j) f[j] = x[q * 8 + j];
      ((u32x4*)dst)[q] = pack8(f); }
  }
  const float* wc = p.w_conv + (size_t)e * 3 * 1024;
  for (size_t it = gtid; it < (size_t)NT * 128; it += gsz) {
    const int r = (int)(it >> 7), c8 = (int)(it & 127) * 8;
    int t, n;
    if (r < NL) { t = r & 2047; n = 2048; } else { t = (r - NL) & 255; n = 256; }
    const bf16_t* sp = p.proj + (size_t)r * PROJW + 768 + c8;
    float xc[8], xm[8], xp[8], o[8];
    unpack8(*(const u32x4*)sp, xc);
    if (t > 0) unpack8(*(const u32x4*)(sp - PROJW), xm); else {
#pragma unroll
      for (int j = 0; j < 8; ++j) xm[j] = 0.f; }
    if (t < n - 1) unpack8(*(const u32x4*)(sp + PROJW), xp); else {
#pragma unroll
      for (int j = 0; j < 8; ++j) xp[j] = 0.f; }
    const float ksc = c8 < 512 ? 1.f : 0.08838834764831845f;
#pragma unroll
    for (int j = 0; j < 8; ++j) { const float v = wc[c8 + j] * xm[j] + wc[1024 + c8 + j] * xc[j] + wc[2048 + c8 + j] * xp[j]; o[j] = siluf(v) * ksc; }
    bf16_t* dp = c8 < 512 ? p.qm + (size_t)r * 512 + c8 : p.km + (size_t)r * 512 + c8 - 512;
    *(u32x4*)dp = pack8(o);
  }
  }
  if (scanner || G <= 64) {
    const int gw = (G > 64) ? bid : (int)(((size_t)bid * NTHR + tid) >> 6), nw = (G > 64) ? 64 : (int)(((size_t)G * NTHR) >> 6);
    for (int chain = gw; chain < 64; chain += nw) {
      const int b = chain >> 3, hd = (chain >> 1) & 3, dir = chain & 1;
      float m_in = -1e30f;
      for (int c = 0; c < 18; ++c) {
        const int p0 = c * 128 + 2 * lane;
        const int r0 = chain_row(b, dir, p0), r1 = chain_row(b, dir, p0 + 1);
        const float ig0 = p.gates[(size_t)r0 * 16 + dir * 8 + hd], lf0 = p.gates[(size_t)r0 * 16 + dir * 8 + 4 + hd];
        const float ig1 = p.gates[(size_t)r1 * 16 + dir * 8 + hd], lf1 = p.gates[(size_t)r1 * 16 + dir * 8 + 4 + hd];
        const float ssum = lf0 + lf1;
        const float incl = wave_incl_sum(ssum, lane);
        const float bq0 = (incl - ssum) + lf0, bq1 = bq0 + lf1;
        const float bend = __shfl(incl, 63);
        const float g0 = ig0 - bq0, g1 = ig1 - bq1;
        const float inclm = wave_incl_max(fmaxf(g0, g1), lane);
        float exclm = __shfl_up(inclm, 1);
        if (lane == 0) exclm = -3.0e38f;
        const float pm0 = fmaxf(exclm, g0), pm1 = fmaxf(pm0, g1);
        const float gmax = __shfl(inclm, 63);
        const float m_next = fmaxf(m_in + bend, bend + gmax);
        const size_t i0 = (size_t)r0 * 8 + dir * 4 + hd, i1 = (size_t)r1 * 8 + dir * 4 + hd;
        p.gsG[i0] = g0 * LOG2E; p.gsR[i0] = -fmaxf(m_in, pm0) * LOG2E; p.gsB[i0] = bq0 * LOG2E;
        p.gsG[i1] = g1 * LOG2E; p.gsR[i1] = -fmaxf(m_in, pm1) * LOG2E; p.gsB[i1] = bq1 * LOG2E;
        if (lane == 0) { p.cMIN[chain * 18 + c] = m_in * LOG2E; p.cE1[chain * 18 + c] = (bend - m_next) * LOG2E; p.cDEC[chain * 18 + c] = expf(m_in + bend - m_next); }
        m_in = m_next;
      }
    }
  }
}

typedef float f32x16 __attribute__((ext_vector_type(16)));
typedef short s16x4 __attribute__((ext_vector_type(4)));
typedef __attribute__((address_space(3))) const char* lds_cptr;
__device__ __forceinline__ s16x4 vtr(lds_cptr p) { return __builtin_bit_cast(s16x4, __builtin_amdgcn_ds_read_tr16_b64_v4i16((__attribute__((address_space(3))) s16x4*)p)); }
#define MX3(a, b, c) __builtin_fmaxf(__builtin_fmaxf((a), (b)), (c))
__device__ __forceinline__ float rowmax32(const f32x16& p0, const f32x16& p1) {
  float a = MX3(p0[0], p0[1], p1[0]), b = MX3(p0[2], p0[3], p1[1]);
  a = MX3(a, p1[2], p1[3]);
#pragma unroll
  for (int r = 4; r < 16; r += 4) { a = MX3(a, p0[r], p0[r + 1]); b = MX3(b, p0[r + 2], p0[r + 3]); a = MX3(a, p1[r], p1[r + 1]); b = MX3(b, p1[r + 2], p1[r + 3]); }
  const float m = __builtin_fmaxf(a, b);
  auto rr = __builtin_amdgcn_permlane32_swap(__float_as_uint(m), __float_as_uint(m), false, false);
  return __builtin_fmaxf(__uint_as_float(rr[0]), __uint_as_float(rr[1]));
}
__device__ __forceinline__ float half_swap_add(float v) {
  auto rr = __builtin_amdgcn_permlane32_swap(__float_as_uint(v), __float_as_uint(v), false, false);
  return __uint_as_float(rr[0]) + __uint_as_float(rr[1]);
}
#define ATT_SLOT 16384
__device__ __forceinline__ void glds16(const void* g, unsigned lds_base) {
  unsigned sv;
  asm volatile("s_mov_b32 %0, m0\n\ts_mov_b32 m0, %2\n\ts_nop 0\n\tglobal_load_lds_dwordx4 %1, off\n\ts_mov_b32 m0, %0" : "=&s"(sv) : "v"(g), "s"(lds_base) : "memory");
}
__device__ __forceinline__ void attn_unit(const bf16_t* Q0, const bf16_t* Kbase, const bf16_t* Vbase, const int nkeys, bf16_t* O0, LAS unsigned char* lds) {
  const int tid = ltid(), lane = tid & 63, r32 = lane & 31, hi = lane >> 5;
  const int wid = __builtin_amdgcn_readfirstlane(tid >> 6);
  const int NTL = nkeys >> 6;
  __syncthreads();
  const bf16_t* ksrc = Kbase + (size_t)lane * 64 + wid * 8;
  const bf16_t* vsrc = Vbase + (size_t)(16 * (wid & 3) + (lane >> 2)) * 64 + (wid >> 2) * 32 + (lane & 3) * 8;
  const unsigned ldsb = (unsigned)(size_t)lds;
#define ATT_STAGE(t, slot) do { \
    glds16(ksrc + (size_t)(t) * 64 * 64, (unsigned)__builtin_amdgcn_readfirstlane(ldsb + (slot) * ATT_SLOT + wid * 1024)); \
    glds16(vsrc + (size_t)(t) * 64 * 64, (unsigned)__builtin_amdgcn_readfirstlane(ldsb + (slot) * ATT_SLOT + 8192 + wid * 1024)); } while (0)
  ATT_STAGE(0, 0);
  if (NTL > 1) ATT_STAGE(1, 1);
  bf16x8 qr[4];
  {
    const bf16_t* Qw = Q0 + (size_t)(wid * 32 + r32) * 512;
#pragma unroll
    for (int d0 = 0; d0 < 4; ++d0) qr[d0] = *(const bf16x8*)(Qw + d0 * 16 + hi * 8);
  }
  f32x16 o0, o1;
#pragma unroll
  for (int r = 0; r < 16; ++r) { o0[r] = 0.f; o1[r] = 0.f; }
  float m = -1e30f, l = 0.f;
  const int koff = hi * 1024 + r32 * 16;
  const int voff = 8192 + ((lane >> 4) & 1) * 32 + (lane & 3) * 8 + (4 * hi + ((lane & 15) >> 2)) * 64;
  int slot = 0;
  for (int t = 0; t < NTL; ++t) {
    if (t + 1 < NTL) asm volatile("s_waitcnt vmcnt(2) lgkmcnt(0)\n\ts_barrier" ::: "memory"); else asm volatile("s_waitcnt vmcnt(0) lgkmcnt(0)\n\ts_barrier" ::: "memory");
    __builtin_amdgcn_sched_barrier(0);
    if (t + 2 < NTL) { const int s2 = (slot >= 1) ? slot - 1 : 2; ATT_STAGE(t + 2, s2); }
    const lds_cptr kp = (lds_cptr)(lds + slot * ATT_SLOT + koff);
    const lds_cptr vp = (lds_cptr)(lds + slot * ATT_SLOT + voff);
    f32x16 pA, pB;
#pragma unroll
    for (int r = 0; r < 16; ++r) { pA[r] = 0.f; pB[r] = 0.f; }
#pragma unroll
    for (int d0 = 0; d0 < 4; ++d0) {
      const bf16x8 k0 = *(const LAS bf16x8*)(kp + d0 * 2048), k1 = *(const LAS bf16x8*)(kp + d0 * 2048 + 512);
      pA = __builtin_amdgcn_mfma_f32_32x32x16_bf16(k0, qr[d0], pA, 0, 0, 0);
      pB = __builtin_amdgcn_mfma_f32_32x32x16_bf16(k1, qr[d0], pB, 0, 0, 0);
    }
    const float rm = rowmax32(pA, pB);
    const float mn = __builtin_fmaxf(m, rm);
    const float alpha = __builtin_amdgcn_exp2f(m - mn);
    m = mn;
    float ps = 0.f;
#pragma unroll
    for (int r = 0; r < 16; ++r) { pA[r] = __builtin_amdgcn_exp2f(pA[r] - mn); pB[r] = __builtin_amdgcn_exp2f(pB[r] - mn); ps += pA[r] + pB[r]; }
    l = l * alpha + ps;
#pragma unroll
    for (int r = 0; r < 16; ++r) { o0[r] *= alpha; o1[r] *= alpha; }
    bf16x8 pw[4];
#pragma unroll
    for (int s4 = 0; s4 < 4; ++s4) {
      u32x4 w;
      if (s4 < 2) { w.x = cvt_pk_bf16(pA[8 * s4 + 0], pA[8 * s4 + 1]); w.y = cvt_pk_bf16(pA[8 * s4 + 2], pA[8 * s4 + 3]); w.z = cvt_pk_bf16(pA[8 * s4 + 4], pA[8 * s4 + 5]); w.w = cvt_pk_bf16(pA[8 * s4 + 6], pA[8 * s4 + 7]); }
      else { const int q = s4 - 2; w.x = cvt_pk_bf16(pB[8 * q + 0], pB[8 * q + 1]); w.y = cvt_pk_bf16(pB[8 * q + 2], pB[8 * q + 3]); w.z = cvt_pk_bf16(pB[8 * q + 4], pB[8 * q + 5]); w.w = cvt_pk_bf16(pB[8 * q + 6], pB[8 * q + 7]); }
      pw[s4] = __builtin_bit_cast(bf16x8, w);
    }
#pragma unroll
    for (int s4 = 0; s4 < 4; ++s4) {
      const s16x4 a0l = vtr(vp + s4 * 1024), a0h = vtr(vp + s4 * 1024 + 512);
      const s16x4 a1l = vtr(vp + 4096 + s4 * 1024), a1h = vtr(vp + 4096 + s4 * 1024 + 512);
      const bf16x8 a0 = {a0l[0], a0l[1], a0l[2], a0l[3], a0h[0], a0h[1], a0h[2], a0h[3]};
      const bf16x8 a1 = {a1l[0], a1l[1], a1l[2], a1l[3], a1h[0], a1h[1], a1h[2], a1h[3]};
      o0 = __builtin_amdgcn_mfma_f32_32x32x16_bf16(a0, pw[s4], o0, 0, 0, 0);
      o1 = __builtin_amdgcn_mfma_f32_32x32x16_bf16(a1, pw[s4], o1, 0, 0, 0);
    }
    slot = (slot == 2) ? 0 : slot + 1;
  }
#undef ATT_STAGE
  const float il = 1.f / half_swap_add(l);
  bf16_t* Ow = O0 + (size_t)(wid * 32 + r32) * 1024;
#pragma unroll
  for (int g4 = 0; g4 < 4; ++g4) {
    u32x2 w0, w1;
    w0.x = cvt_pk_bf16(o0[4 * g4 + 0] * il, o0[4 * g4 + 1] * il); w0.y = cvt_pk_bf16(o0[4 * g4 + 2] * il, o0[4 * g4 + 3] * il);
    w1.x = cvt_pk_bf16(o1[4 * g4 + 0] * il, o1[4 * g4 + 1] * il); w1.y = cvt_pk_bf16(o1[4 * g4 + 2] * il, o1[4 * g4 + 3] * il);
    *(u32x2*)(Ow + 8 * g4 + 4 * hi) = w0;
    *(u32x2*)(Ow + 32 + 8 * g4 + 4 * hi) = w1;
  }
}
__device__ __forceinline__ void ph_att(const Params& p, bool ctx_q, LAS unsigned char* lds) {
  const int c = lbid(), G = lgdim();
  const int nunits = 512 + (ctx_q ? 64 : 0);
  for (int L = c; L < nunits; L += G) {
    if (L < 512) {
      const int i = L >> 8, cc = L & 255, grp = (cc & 7) + 8 * i, idx = cc >> 3;
      const int b = grp >> 1, kvh = grp & 1, h = kvh * 4 + (idx >> 3), qt = idx & 7;
      const size_t row0 = (size_t)b * 2048 + qt * 256;
      attn_unit(p.Qb + row0 * 512 + h * 64, p.Kb + (size_t)(b * 2 + kvh) * 2304 * 64, p.Vb + (size_t)(b * 2 + kvh) * 2304 * 64, 2304, p.mix + row0 * 1024 + h * 64, lds);
    } else {
      const int u = L - 512, b = u >> 3, h = u & 7, kvh = h >> 2;
      const size_t row0 = (size_t)NL + b * 256;
      attn_unit(p.Qb + row0 * 512 + h * 64, p.Kb + (size_t)(b * 2 + kvh) * 2304 * 64, p.Vb + (size_t)(b * 2 + kvh) * 2304 * 64, 256, p.mix + row0 * 1024 + h * 64, lds);
    }
  }
  __syncthreads();
}

__device__ __forceinline__ int chunk_row0(int b, int dir, int cc) {
  if (cc < 2) return NL + b * 256 + (dir ? 1 - cc : cc) * 128;
  return b * 2048 + (dir ? 15 - (cc - 2) : cc - 2) * 128;
}
__device__ __forceinline__ int trq_addr(int lane, int quarter, int rowbase) {
  return quarter * 8192 + ((lane >> 4) & 1) * 32 + (lane & 3) * 8 + (rowbase + ((lane & 15) >> 2)) * 64;
}
__device__ __forceinline__ bf16x8 cat44(const s16x4 a, const s16x4 b) { return (bf16x8){a[0], a[1], a[2], a[3], b[0], b[1], b[2], b[3]}; }

__device__ __forceinline__ void ph_mlstm_u(const Params& p, LAS unsigned char* lds) {
  const int tid = ltid(), lane = tid & 63, r32 = lane & 31, hi = lane >> 5;
  const int wid = __builtin_amdgcn_readfirstlane(tid >> 6);
  LAS float* WS = (LAS float*)(lds + 65536);
  LAS float* NP = (LAS float*)(lds + 66048);
  for (int unit = lbid(); unit < 64 * 17; unit += lgdim()) {
    const int chain = unit / 17, cc = unit % 17;
    const int b = chain >> 3, hd = (chain >> 1) & 3, dir = chain & 1;
    const int row0 = chunk_row0(b, dir, cc);
    __syncthreads();
#pragma unroll
    for (int n = 0; n < 4; ++n) {
      const int ii = wid * 4 + n, qd = ii >> 3, rg = ii & 7;
      const bf16_t* src = p.km + (size_t)(row0 + rg * 16 + (lane >> 2)) * 512 + hd * 128 + qd * 32 + (lane & 3) * 8;
      __builtin_amdgcn_global_load_lds((const unsigned*)src, (LAS unsigned*)(lds + qd * 8192 + rg * 1024), 16, 0, 0);
    }
    if (tid < 128) WS[tid] = __builtin_amdgcn_exp2f(p.gsG[(size_t)(row0 + tid) * 8 + dir * 4 + hd] + p.cE1[chain * 18 + cc]);
    __syncthreads();
#pragma unroll
    for (int n = 0; n < 4; ++n) {
      const int o = (tid + n * NTHR) * 16, qd = o >> 13, row = (o >> 6) & 127, pc = (o >> 4) & 3;
      float f[8];
      unpack8(*(const u32x4*)(p.proj + (size_t)(row0 + row) * PROJW + 1792 + hd * 128 + qd * 32 + pc * 8), f);
      const float w = WS[row];
#pragma unroll
      for (int j = 0; j < 8; ++j) f[j] *= w;
      *(LAS u32x4*)(lds + 32768 + o) = pack8(f);
    }
    asm volatile("s_waitcnt vmcnt(0)" ::: "memory");
    __syncthreads();
    {
      const int d = tid & 127, part = tid >> 7;
      float acc = 0.f;
      for (int s2 = 0; s2 < 32; ++s2) {
        const int srow = part * 32 + s2;
        const bf16_t kv = *(const LAS bf16_t*)(lds + (d >> 5) * 8192 + srow * 64 + (d & 31) * 2);
        acc += WS[srow] * bf2f(kv);
      }
      NP[part * 128 + d] = acc;
    }
    const int eb = wid >> 1, db0 = 2 * (wid & 1);
    f32x16 u0, u1;
#pragma unroll
    for (int r = 0; r < 16; ++r) { u0[r] = 0.f; u1[r] = 0.f; }
#pragma unroll
    for (int ks = 0; ks < 8; ++ks) {
      const int rb = ks * 16 + 8 * hi;
      const bf16x8 a = cat44(vtr((lds_cptr)(lds + 32768 + trq_addr(lane, eb, rb))), vtr((lds_cptr)(lds + 32768 + trq_addr(lane, eb, rb + 4))));
      const bf16x8 b0 = cat44(vtr((lds_cptr)(lds + trq_addr(lane, db0, rb))), vtr((lds_cptr)(lds + trq_addr(lane, db0, rb + 4))));
      const bf16x8 b1 = cat44(vtr((lds_cptr)(lds + trq_addr(lane, db0 + 1, rb))), vtr((lds_cptr)(lds + trq_addr(lane, db0 + 1, rb + 4))));
      u0 = __builtin_amdgcn_mfma_f32_32x32x16_bf16(a, b0, u0, 0, 0, 0);
      u1 = __builtin_amdgcn_mfma_f32_32x32x16_bf16(a, b1, u1, 0, 0, 0);
    }
    float* U = p.Ubuf + ((size_t)chain * 17 + cc) * 16384;
#pragma unroll
    for (int r = 0; r < 16; ++r) {
      const int erow = eb * 32 + (r & 3) + 8 * (r >> 2) + 4 * hi;
      U[(size_t)erow * 128 + db0 * 32 + r32] = u0[r];
      U[(size_t)erow * 128 + (db0 + 1) * 32 + r32] = u1[r];
    }
    __syncthreads();
    if (tid < 128) p.NLb[((size_t)chain * 17 + cc) * 128 + tid] = NP[tid] + NP[128 + tid] + NP[256 + tid] + NP[384 + tid];
  }
  __syncthreads();
}

__device__ __forceinline__ void ph_mlstm_scan(const Params& p, int bskip) {
  const int bsk = lgdim() > bskip ? bskip : 0;
  if (lbid() < bsk) return;
  const size_t gtid = (size_t)(lbid() - bsk) * NTHR + ltid(), gsz = (size_t)(lgdim() - bsk) * NTHR;
  for (size_t it = gtid; it < (size_t)64 * 8192; it += gsz) {
    const int chain = (int)(it >> 13), ed = (int)(it & 8191) * 2;
    float c0 = 0.f, c1 = 0.f;
    for (int c = 0; c < 17; ++c) {
      const float dec = p.cDEC[chain * 18 + c];
      const float2 u = *(const float2*)(p.Ubuf + ((size_t)chain * 17 + c) * 16384 + ed);
      c0 = dec * c0 + u.x; c1 = dec * c1 + u.y;
      *(unsigned*)(p.Cbf + ((size_t)chain * 18 + c + 1) * 16384 + ed) = cvt_pk_bf16(c0, c1);
    }
  }
  for (size_t it = gtid; it < (size_t)64 * 128; it += gsz) {
    const int chain = (int)(it >> 7), d = (int)(it & 127);
    float nv = 0.f;
    for (int c = 0; c < 17; ++c) {
      nv = p.cDEC[chain * 18 + c] * nv + p.NLb[((size_t)chain * 17 + c) * 128 + d];
      p.NVb[((size_t)chain * 18 + c + 1) * 128 + d] = nv;
    }
  }
}

__device__ __forceinline__ void ph_mlstm_h(const Params& p, int l, bool ctx_out, LAS unsigned char* lds) {
  const int e2 = l >> 1;
  const int tid = ltid(), lane = tid & 63, r32 = lane & 31, hi = lane >> 5;
  const int wid = __builtin_amdgcn_readfirstlane(tid >> 6);
  const int tb = wid & 3, dir = wid >> 2;
  LAS float* HX = (LAS float*)(lds);
  LAS float* GC = (LAS float*)(lds + 131072);
  const int j0 = ctx_out ? 0 : 2, nj = 18 - j0;
  for (int unit = lbid(); unit < 32 * nj; unit += lgdim()) {
    const int bh = unit / nj, j = j0 + unit % nj, b = bh >> 2, hd = bh & 3;
    const int row0 = (j < 2) ? NL + b * 256 + j * 128 : b * 2048 + (j - 2) * 128;
    const int cc = dir ? (j < 2 ? 1 - j : 19 - j) : j;
    const int chain = b * 8 + hd * 2 + dir;
    __syncthreads();
#pragma unroll
    for (int n = 0; n < 4; ++n) {
      const int ii = wid * 4 + n;
      { const int ch = ii >> 1, rh = ii & 1;
        const bf16_t* src = p.km + (size_t)(row0 + rh * 64 + lane) * 512 + hd * 128 + ch * 8;
        __builtin_amdgcn_global_load_lds((const unsigned*)src, (LAS unsigned*)(lds + ch * 2048 + rh * 1024), 16, 0, 0); }
      { const int qd = ii >> 3, rg = ii & 7;
        const bf16_t* src = p.proj + (size_t)(row0 + rg * 16 + (lane >> 2)) * PROJW + 1792 + hd * 128 + qd * 32 + (lane & 3) * 8;
        __builtin_amdgcn_global_load_lds((const unsigned*)src, (LAS unsigned*)(lds + 32768 + qd * 8192 + rg * 1024), 16, 0, 0); }
    }
#pragma unroll
    for (int n = 0; n < 8; ++n) {
      const int ii2 = wid * 8 + n, dd = ii2 >> 5, ch = (ii2 & 31) >> 1, rh = ii2 & 1;
      const int ccd = dd ? (j < 2 ? 1 - j : 19 - j) : j;
      if (ccd > 0) {
        const bf16_t* src = p.Cbf + ((size_t)(b * 8 + hd * 2 + dd) * 18 + ccd) * 16384 + (size_t)(rh * 64 + lane) * 128 + ch * 8;
        __builtin_amdgcn_global_load_lds((const unsigned*)src, (LAS unsigned*)(lds + 65536 + dd * 32768 + ch * 2048 + rh * 1024), 16, 0, 0);
      }
    }
    if (tid < 256) GC[tid] = p.gsG[(size_t)(row0 + (tid & 127)) * 8 + (tid >> 7) * 4 + hd];
    const int trow = row0 + tb * 32 + r32;
    bf16x8 qf[8];
#pragma unroll
    for (int ks = 0; ks < 8; ++ks) qf[ks] = *(const bf16x8*)(p.qm + (size_t)trow * 512 + hd * 128 + ks * 16 + hi * 8);
    const float R2 = p.gsR[(size_t)trow * 8 + dir * 4 + hd], BQ2 = p.gsB[(size_t)trow * 8 + dir * 4 + hd];
    const float MIN2 = p.cMIN[chain * 18 + cc];
    f32x16 acc[4];
#pragma unroll
    for (int eb = 0; eb < 4; ++eb)
#pragma unroll
      for (int r = 0; r < 16; ++r) acc[eb][r] = 0.f;
    float nq = 0.f;
    if (cc > 0) {
      const float* nvp = p.NVb + ((size_t)chain * 18 + cc) * 128 + hi * 8;
#pragma unroll
      for (int ks = 0; ks < 8; ++ks) {
        const f32x4 n0 = *(const f32x4*)(nvp + ks * 16), n1 = *(const f32x4*)(nvp + ks * 16 + 4);
        float qv[8];
        unpack8(__builtin_bit_cast(u32x4, qf[ks]), qv);
        nq += n0[0] * qv[0] + n0[1] * qv[1] + n0[2] * qv[2] + n0[3] * qv[3] + n1[0] * qv[4] + n1[1] * qv[5] + n1[2] * qv[6] + n1[3] * qv[7];
      }
      nq = half_swap_add(nq);
    }
    const float winter = __builtin_amdgcn_exp2f(MIN2 + R2);
    asm volatile("s_waitcnt vmcnt(0)" ::: "memory");
    __syncthreads();
    if (cc > 0) {
#pragma unroll
      for (int eb = 0; eb < 4; ++eb)
#pragma unroll
        for (int ks = 0; ks < 8; ++ks) {
          const bf16x8 a = *(const LAS bf16x8*)(lds + 65536 + dir * 32768 + (2 * ks + hi) * 2048 + (eb * 32 + r32) * 16);
          acc[eb] = __builtin_amdgcn_mfma_f32_32x32x16_bf16(a, qf[ks], acc[eb], 0, 0, 0);
        }
#pragma unroll
      for (int eb = 0; eb < 4; ++eb)
#pragma unroll
        for (int r = 0; r < 16; ++r) acc[eb][r] *= winter;
    }
    float sw = 0.f;
    const int sb_lo = dir ? tb : 0, sb_hi = dir ? 3 : tb;
    for (int sb = sb_lo; sb <= sb_hi; ++sb) {
      f32x16 st;
#pragma unroll
      for (int r = 0; r < 16; ++r) st[r] = 0.f;
#pragma unroll
      for (int ks = 0; ks < 8; ++ks) {
        const bf16x8 kf = *(const LAS bf16x8*)(lds + (2 * ks + hi) * 2048 + (sb * 32 + r32) * 16);
        st = __builtin_amdgcn_mfma_f32_32x32x16_bf16(kf, qf[ks], st, 0, 0, 0);
      }
      const bool diag = (sb == tb);
#pragma unroll
      for (int g4 = 0; g4 < 4; ++g4) {
        const f32x4 gc = *(const LAS f32x4*)(GC + dir * 128 + sb * 32 + 8 * g4 + 4 * hi);
#pragma unroll
        for (int q = 0; q < 4; ++q) {
          const int sl = 8 * g4 + 4 * hi + q;
          float w = __builtin_amdgcn_exp2f(R2 + gc[q]) * st[4 * g4 + q];
          const bool keep = !diag || (dir ? (sl >= r32) : (sl <= r32));
          w = keep ? w : 0.f;
          sw += w;
          st[4 * g4 + q] = w;
        }
      }
      u32x4 p0, p1;
      p0.x = cvt_pk_bf16(st[0], st[1]); p0.y = cvt_pk_bf16(st[2], st[3]); p0.z = cvt_pk_bf16(st[4], st[5]); p0.w = cvt_pk_bf16(st[6], st[7]);
      p1.x = cvt_pk_bf16(st[8], st[9]); p1.y = cvt_pk_bf16(st[10], st[11]); p1.z = cvt_pk_bf16(st[12], st[13]); p1.w = cvt_pk_bf16(st[14], st[15]);
      const bf16x8 pw0 = __builtin_bit_cast(bf16x8, p0), pw1 = __builtin_bit_cast(bf16x8, p1);
#pragma unroll
      for (int eb = 0; eb < 4; ++eb) {
        const int rb = sb * 32 + 4 * hi;
        const bf16x8 a0 = cat44(vtr((lds_cptr)(lds + 32768 + trq_addr(lane, eb, rb))), vtr((lds_cptr)(lds + 32768 + trq_addr(lane, eb, rb + 8))));
        const bf16x8 a1 = cat44(vtr((lds_cptr)(lds + 32768 + trq_addr(lane, eb, rb + 16))), vtr((lds_cptr)(lds + 32768 + trq_addr(lane, eb, rb + 24))));
        acc[eb] = __builtin_amdgcn_mfma_f32_32x32x16_bf16(a0, pw0, acc[eb], 0, 0, 0);
        acc[eb] = __builtin_amdgcn_mfma_f32_32x32x16_bf16(a1, pw1, acc[eb], 0, 0, 0);
      }
    }
    sw = half_swap_add(sw);
    const float den = winter * nq + sw;
    const float dn = fmaxf(fabsf(den), __builtin_amdgcn_exp2f(R2 - BQ2));
    const float idn = 1.f / dn;
    __syncthreads();
    if (dir == 1) {
#pragma unroll
      for (int eb = 0; eb < 4; ++eb)
#pragma unroll
        for (int r = 0; r < 16; ++r) HX[(tb * 128 + eb * 32 + (r & 3) + 8 * (r >> 2) + 4 * hi) * 32 + r32] = acc[eb][r] * idn;
    }
    __syncthreads();
    if (dir == 0) {
      float ss = 0.f;
#pragma unroll
      for (int eb = 0; eb < 4; ++eb)
#pragma unroll
        for (int r = 0; r < 16; ++r) {
          const float v = acc[eb][r] * idn + HX[(tb * 128 + eb * 32 + (r & 3) + 8 * (r >> 2) + 4 * hi) * 32 + r32];
          acc[eb][r] = v; ss += v * v;
        }
      ss = half_swap_add(ss);
      const float inv = rsqrtf(ss * (1.f / 128.f) + EPS);
      const float* gh = p.g_hnorm + e2 * 512 + hd * 128;
      const bf16_t* obp = p.proj + (size_t)trow * PROJW + 2304 + hd * 128;
      bf16_t* op = p.mix + (size_t)trow * 1024 + 512 + hd * 128;
#pragma unroll
      for (int eb = 0; eb < 4; ++eb)
#pragma unroll
        for (int g4 = 0; g4 < 4; ++g4) {
          const int e0 = eb * 32 + 8 * g4 + 4 * hi;
          const f32x4 gv = *(const f32x4*)(gh + e0);
          const u32x2 ow = *(const u32x2*)(obp + e0);
          const float ob0 = __uint_as_float(ow.x << 16), ob1 = __uint_as_float(ow.x & 0xffff0000u), ob2 = __uint_as_float(ow.y << 16), ob3 = __uint_as_float(ow.y & 0xffff0000u);
          const float v0 = acc[eb][4 * g4 + 0] * inv * gv[0] * sigmoidf_(ob0), v1 = acc[eb][4 * g4 + 1] * inv * gv[1] * sigmoidf_(ob1);
          const float v2 = acc[eb][4 * g4 + 2] * inv * gv[2] * sigmoidf_(ob2), v3 = acc[eb][4 * g4 + 3] * inv * gv[3] * sigmoidf_(ob3);
          u32x2 w; w.x = cvt_pk_bf16(v0, v1); w.y = cvt_pk_bf16(v2, v3);
          *(u32x2*)(op + e0) = w;
        }
    }
  }
  __syncthreads();
}

__device__ __forceinline__ void ph_topk(const Params& p, bool ctx, float* sm) {
  const int tid = ltid(), lane = tid & 63, wv = tid >> 6;
  unsigned* cnt = (unsigned*)sm;
  unsigned* pre = (unsigned*)sm + 32;
  int* sel = (int*)sm + 64;
  const int ncol = ctx ? 256 : 128;
  for (int colu = lbid(); colu < ncol; colu += lgdim()) {
    int e, base, n, cap; size_t mbase;
    if (colu < 128) { const int b = colu >> 4; e = colu & 15; base = b * 2048; n = 2048; cap = 256; mbase = (size_t)e * 2048 + (size_t)b * 256; }
    else { const int c2 = colu - 128, b = c2 >> 4; e = c2 & 15; base = NL + b * 256; n = 256; cap = 32; mbase = (size_t)MOE_L + (size_t)e * 256 + (size_t)b * 32; }
    unsigned v[4];
#pragma unroll
    for (int k = 0; k < 4; ++k) { const int i = tid * 4 + k; v[k] = i < n ? __float_as_uint(p.aff[(size_t)(base + i) * 16 + e]) : 0u; }
    unsigned thr = 0u;
    for (int bit = 30; bit >= 0; --bit) {
      const unsigned cand = thr | (1u << bit);
      unsigned c = (v[0] >= cand) + (v[1] >= cand) + (v[2] >= cand) + (v[3] >= cand);
#pragma unroll
      for (int o = 32; o > 0; o >>= 1) c += __shfl_xor(c, o);
      unsigned* cb = cnt + (bit & 1) * 8;
      if (lane == 0) cb[wv] = c;
      __syncthreads();
      const unsigned tot = cb[0] + cb[1] + cb[2] + cb[3] + cb[4] + cb[5] + cb[6] + cb[7];
      if (tot >= (unsigned)cap) thr = cand;
    }
    unsigned ngt = (v[0] > thr) + (v[1] > thr) + (v[2] > thr) + (v[3] > thr);
    unsigned neq = (v[0] == thr) + (v[1] == thr) + (v[2] == thr) + (v[3] == thr);
    unsigned igt = ngt, ieq = neq;
#pragma unroll
    for (int o = 1; o < 64; o <<= 1) { const unsigned a = __shfl_up(igt, o), b2 = __shfl_up(ieq, o); if (lane >= o) { igt += a; ieq += b2; } }
    __syncthreads();
    if (lane == 63) { pre[wv] = igt; pre[8 + wv] = ieq; }
    __syncthreads();
    unsigned totgt = 0, offgt = 0, offeq = 0;
#pragma unroll
    for (int w2 = 0; w2 < 8; ++w2) { const unsigned a = pre[w2], b2 = pre[8 + w2]; totgt += a; if (w2 < wv) { offgt += a; offeq += b2; } }
    const unsigned need_eq = (unsigned)cap - totgt;
    unsigned egt = offgt + igt - ngt, eeq = offeq + ieq - neq;
#pragma unroll
    for (int k = 0; k < 4; ++k) {
      const int i = tid * 4 + k;
      const bool gt = v[k] > thr, eq = v[k] == thr;
      const bool take = gt || (eq && eeq < need_eq);
      if (i < n) {
        const int r = base + i;
        const unsigned slot = egt + (eeq < need_eq ? eeq : need_eq);
        if (take) { p.slotmap[(size_t)r * 16 + e] = (int)slot; p.rowidx[mbase + slot] = r; p.gatev[mbase + slot] = __uint_as_float(v[k]); sel[slot] = r; }
        else p.slotmap[(size_t)r * 16 + e] = -1;
      }
      egt += gt; eeq += eq;
    }
    __syncthreads();
    for (int sl0 = wv * 4; sl0 < cap; sl0 += (NTHR / 64) * 4) {
      u32x4 a[4], b2[4];
#pragma unroll
      for (int q = 0; q < 4; ++q) {
        const int r = sel[sl0 + q];
        const u32x4* src = (const u32x4*)(p.hbuf + (size_t)r * 1024);
        a[q] = src[lane]; b2[q] = src[64 + lane];
      }
#pragma unroll
      for (int q = 0; q < 4; ++q) {
        u32x4* dst = (u32x4*)(p.Xs + (mbase + sl0 + q) * 1024);
        dst[lane] = a[q]; dst[64 + lane] = b2[q];
      }
    }
    __syncthreads();
  }
}

template <int W>
__device__ __forceinline__ void pool_item(const Params& p, int r, int c8) {
  int t, n;
  if (r < NL) { t = r & 2047; n = 2048; } else { t = (r - NL) & 255; n = 256; }
  constexpr int lo = W / 2;
  const bf16_t* up = p.proj + (size_t)r * 1024 + c8;
  u32x4 raw[W];
  int cnt = 0;
#pragma unroll
  for (int k = 0; k < W; ++k) {
    const int tt = t - lo + k;
    const bool ok = tt >= 0 && tt < n;
    raw[k] = ok ? *(const u32x4*)(up + (ptrdiff_t)(k - lo) * 1024) : (u32x4){0u, 0u, 0u, 0u};
    cnt += ok ? 1 : 0;
  }
  float s8[8], f[8], uc[8];
#pragma unroll
  for (int j = 0; j < 8; ++j) s8[j] = 0.f;
#pragma unroll
  for (int k = 0; k < W; ++k) {
    unpack8(raw[k], f);
#pragma unroll
    for (int j = 0; j < 8; ++j) s8[j] += f[j];
  }
  unpack8(raw[lo], uc);
  const float ic = 1.f / (float)cnt;
#pragma unroll
  for (int j = 0; j < 8; ++j) f[j] = s8[j] * ic - uc[j];
  *(u32x4*)(p.mix + (size_t)r * 1024 + c8) = pack8(f);
}
__device__ __forceinline__ void ph_pool(const Params& p, int nrows) {
  const size_t gtid = (size_t)lbid() * NTHR + ltid(), gsz = (size_t)lgdim() * NTHR;
  for (size_t it = gtid; it < (size_t)nrows * 128; it += gsz) {
    const int g = (int)(it / ((size_t)nrows * 32));
    const size_t rem = it - (size_t)g * nrows * 32;
    const int r = (int)(rem >> 5), c8 = g * 256 + (int)(rem & 31) * 8;
    if (g == 0) pool_item<2>(p, r, c8);
    else if (g == 1) pool_item<4>(p, r, c8);
    else if (g == 2) pool_item<8>(p, r, c8);
    else pool_item<16>(p, r, c8);
  }
}

enum { PH_INIT = 0, PH_NORM1, PH_GEMM_IN_EVEN, PH_POST_EVEN, PH_ATT, PH_MLSTM_U, PH_MLSTM_SCAN, PH_MLSTM_H, PH_GEMM_OUT, PH_NORM2, PH_TOPK, PH_GATHER,
       PH_MOE_GU, PH_MOE_D, PH_GEMM_IN_ODD, PH_POOL, PH_GEMM_GRP, PH_FINAL };

typedef const __attribute__((address_space(4))) Params* KParams;
__device__ __forceinline__ const Params& get_params() {
  KParams kp = (KParams)__builtin_amdgcn_kernarg_segment_ptr();
  asm volatile("" : "+s"(kp));
  return *(const Params*)kp;
}
__device__ __forceinline__ int idle_slots(int nu, int G, int c) {
  const int mx = (nu + G - 1) / G, mine = c < nu ? (nu - c + G - 1) / G : 0;
  return mx - mine;
}
__device__ __forceinline__ void run_phase(int ph, int l, unsigned char* shm) {
  const Params& p = get_params();
  float* sm = (float*)shm;
  LAS unsigned char* lds = (LAS unsigned char*)shm;
  const bool ctx_next = (l < 2);
  const bool ctx_used = (l < 3);
  const int G = lgdim(), c = lbid();
  switch (ph) {
    case PH_INIT: ph_init(p, sm); break;
    case PH_NORM1: {
      const int ncomb = (l == 0) ? 0 : ((l - 1) < 2 ? NT : NL);
      ph_norm(p, l, 1, ctx_used ? NT : NL, ncomb, l - 1, sm);
    } break;
    case PH_GEMM_IN_EVEN: {
      g8::SchedDense S{(const char*)p.hbuf, (const char*)(p.WinE + (size_t)(l >> 1) * PROJW * 1024), 1024, 1024, NT / 256, PROJW / 256, 0, G, c};
      g8::EpiBf16 E{p.proj, PROJW};
      g8::gemm_phase(lds, 1024, 1024, 1024, S, E);
      conv_quota(p, idle_slots(S.nM * S.nN, G, c) * 3, sm);
    } break;
    case PH_POST_EVEN: ph_post_even(p, l, sm); break;
    case PH_MLSTM_U: ph_mlstm_u(p, lds); break;
    case PH_ATT: ph_att(p, ctx_next, lds); ph_mlstm_scan(p, ctx_next ? 64 : 0); conv_quota(p, idle_slots(512 + (ctx_next ? 64 : 0), G, c) * 6, sm); break;
    case PH_MLSTM_H: ph_mlstm_h(p, l, ctx_next, lds); conv_quota(p, idle_slots(32 * (ctx_next ? 18 : 16), G, c) * 3, sm); break;
    case PH_GEMM_OUT: {
      g8::SchedDense S{(const char*)p.mix, (const char*)(p.WoutE + (size_t)(l >> 1) * 1024 * 1024), 1024, 1024, (ctx_next ? NT : NL) / 256, 4, 0, G, c};
      g8::EpiResid E{p.xcur, p.mod + (size_t)l * 9 * 6144 + 2 * 1024, nullptr, l == 0 ? p.x : nullptr, p.ctx};
      g8::gemm_phase(lds, 1024, 1024, 1024, S, E);
      conv_quota(p, idle_slots(S.nM * S.nN, G, c) * 3, sm);
    } break;
    case PH_NORM2: ph_norm(p, l, 2, ctx_next ? NT : NL, 0, 0, sm); break;
    case PH_TOPK: ph_topk(p, ctx_next, sm); conv_until(p, l == 0 ? CE4 : (l == 1 ? CE7 : (l == 2 ? CE10 : CE11)), sm); break;
    case PH_MOE_GU: {
      g8::SchedMoe S{(const char*)p.Xs, (const char*)(p.Wgu + (size_t)l * NEXP * 2048 * 1024), 8, 2048, 128, ctx_next ? 1152 : 1024, G, c};
      g8::EpiSwiGLU E{p.Abuf};
      g8::gemm_phase(lds, 1024, 1024, 1024, S, E);
      conv_quota(p, idle_slots(S.nu, G, c) * 3, sm);
    } break;
    case PH_MOE_D: {
      g8::SchedMoe S{(const char*)p.Abuf, (const char*)(p.Wd + (size_t)l * NEXP * 1024 * 1024), 4, 1024, 256, ctx_next ? 576 : 512, G, c};
      g8::EpiDown E{p.Ybuf, p.gatev};
      g8::gemm_phase(lds, 1024, 1024, 1024, S, E);
      conv_quota(p, idle_slots(S.nu, G, c) * 3, sm);
    } break;
    case PH_GEMM_IN_ODD: {
      g8::SchedDense S{(const char*)p.hbuf, (const char*)(p.WinO + (size_t)(l >> 1) * 1024 * 1024), 1024, 1024, (ctx_next ? NT : NL) / 256, 4, 0, G, c};
      g8::EpiBf16 E{p.proj, 1024};
      g8::gemm_phase(lds, 1024, 1024, 1024, S, E);
      conv_quota(p, idle_slots(S.nM * S.nN, G, c) * 3, sm);
    } break;
    case PH_POOL: ph_pool(p, ctx_next ? NT : NL); break;
    case PH_GEMM_GRP: {
      g8::SchedDense S{(const char*)p.mix, (const char*)(p.Wgrp + (size_t)(l >> 1) * 1024 * 256), 1024, 256, (ctx_next ? NT : NL) / 256, 4, 512, G, c};
      g8::EpiResid E{p.xcur, p.mod + (size_t)l * 9 * 6144 + 2 * 1024, p.s_pool + (size_t)(l >> 1) * 1024, nullptr, nullptr};
      g8::gemm_phase(lds, 256, 1024, 256, S, E);
      conv_quota(p, idle_slots(S.nM * S.nN, G, c) * 1, sm);
    } break;
    case PH_FINAL: ph_norm(p, 3, 3, NL, NL, 3, sm); break;
  }
}

__global__ void __launch_bounds__(NTHR) mega_kernel(Params p) {
  extern __shared__ __attribute__((aligned(16))) unsigned char shm[];
  cg::grid_group grid = cg::this_grid();
  volatile LAS unsigned* st = (volatile LAS unsigned*)((LAS unsigned char*)shm + g8::STAGE_BYTES + 1536);
  if (threadIdx.x < 2) st[threadIdx.x] = 0u;
  __syncthreads();
  unsigned* barw;
  { const Params& q = get_params(); barw = q.barw; }
  const XcdBarrier xb = xcd_barrier_post(barw, st);
  const int nprog = p.nprog;
  for (int i = 0; i < nprog; ++i) {
    int ph, l;
    { const Params& q = get_params(); ph = q.prog_ph[i]; l = q.prog_l[i]; }
    run_phase(ph, l, shm);
    if (i + 1 < nprog) { if (i == 0) grid.sync(); else xcd_barrier(xb); }
  }
}

extern "C" void kernel_launch(void* const* d_in, const int* in_sizes, int n_in, void* d_out, int out_size, void* d_ws, size_t ws_size,
                              hipStream_t stream) {
  Params p{};
  const float* const* in = (const float* const*)d_in;
  p.x = in[0]; p.c = in[1]; p.ctx = in[2]; p.c_ctx = in[3]; p.w_mod = in[4]; p.b_mod = in[5]; p.g_norm1 = in[6]; p.g_norm2 = in[7];
  p.w_in_even = in[8]; p.w_out_even = in[9]; p.g_qnorm = in[10]; p.g_knorm = in[11]; p.w_conv = in[12]; p.b_gate = in[13];
  p.g_hnorm = in[14]; p.w_in_odd = in[15]; p.w_pool_grp = in[16]; p.s_pool = in[17]; p.w_router = in[18]; p.w_exp_gate = in[19];
  p.w_exp_up = in[20]; p.w_exp_down = in[21]; p.g_final = in[22];
  p.out = (float*)d_out;
  char* w = (char*)d_ws;
  size_t off = 0;
  auto take = [&](size_t bytes) { char* r = w + off; off += (bytes + 255) & ~(size_t)255; return (void*)r; };
  p.xcur = (float*)take((size_t)NT * 1024 * 4);
  p.mod = (float*)take(4 * 9 * 6144 * 4);
  p.hbuf = (bf16_t*)take((size_t)NT * 1024 * 2);
  p.Ybuf = (bf16_t*)take((size_t)MOE_T * 1024 * 2);
  p.gatev = (float*)take(MOE_T * 4);
  p.rowidx = (int*)take(MOE_T * 4);
  p.slotmap = (int*)take((size_t)NT * 16 * 4);
  p.barw = (unsigned*)take(XCD_BAR_WORDS * 4);
  p.aff = (float*)take((size_t)NT * 16 * 4);
  p.gates = (float*)take((size_t)NT * 16 * 4);
  p.WinE = (bf16_t*)take((size_t)2 * PROJW * 1024 * 2);
  p.WoutE = (bf16_t*)take((size_t)2 * 1024 * 1024 * 2);
  p.WinO = (bf16_t*)take((size_t)2 * 1024 * 1024 * 2);
  p.Wgrp = (bf16_t*)take((size_t)2 * 1024 * 256 * 2);
  p.Wgu = (bf16_t*)take((size_t)4 * NEXP * 2048 * 1024 * 2);
  p.Wd = (bf16_t*)take((size_t)4 * NEXP * 1024 * 1024 * 2);
  const size_t uoff = off;
  p.proj = (bf16_t*)take((size_t)NT * PROJW * 2);
  p.Qb = (bf16_t*)take((size_t)NT * 512 * 2);
  p.Kb = (bf16_t*)take((size_t)NB * 2 * 2304 * 64 * 2);
  p.Vb = (bf16_t*)take((size_t)NB * 2 * 2304 * 64 * 2);
  p.qm = (bf16_t*)take((size_t)NT * 512 * 2);
  p.km = (bf16_t*)take((size_t)NT * 512 * 2);
  p.gsG = (float*)take((size_t)NT * 8 * 4);
  p.gsR = (float*)take((size_t)NT * 8 * 4);
  p.gsB = (float*)take((size_t)NT * 8 * 4);
  p.cMIN = (float*)take(64 * 18 * 4);
  p.cE1 = (float*)take(64 * 18 * 4);
  p.cDEC = (float*)take(64 * 18 * 4);
  p.Ubuf = (float*)take((size_t)64 * 17 * 16384 * 4);
  p.NLb = (float*)take((size_t)64 * 17 * 128 * 4);
  p.NVb = (float*)take((size_t)64 * 18 * 128 * 4);
  p.Cbf = (bf16_t*)take((size_t)64 * 18 * 16384 * 2);
  p.mix = (bf16_t*)take((size_t)NT * 1024 * 2);
  const size_t uend = off;
  off = uoff;
  p.Xs = (bf16_t*)take((size_t)MOE_T * 1024 * 2);
  p.Abuf = (bf16_t*)take((size_t)MOE_T * 1024 * 2);
  if (off < uend) off = uend;
  if (off > ws_size) { fprintf(stderr, "ws too small: need %zu have %zu\n", off, ws_size); return; }

  int n = 0;
  auto add = [&](int ph, int l) { p.prog_ph[n] = (unsigned char)ph; p.prog_l[n] = (unsigned char)l; ++n; };
  add(PH_INIT, 0);
  for (int l = 0; l < 4; ++l) {
    add(PH_NORM1, l);
    if ((l & 1) == 0) {
      add(PH_GEMM_IN_EVEN, l); add(PH_POST_EVEN, l); add(PH_MLSTM_U, l); add(PH_ATT, l); add(PH_MLSTM_H, l); add(PH_GEMM_OUT, l);
    } else {
      add(PH_GEMM_IN_ODD, l); add(PH_POOL, l); add(PH_GEMM_GRP, l);
    }
    add(PH_NORM2, l); add(PH_TOPK, l); add(PH_MOE_GU, l); add(PH_MOE_D, l);
  }
  add(PH_FINAL, 0);
  p.nprog = n;

  const int LDS = g8::STAGE_BYTES + 2048;
  static int grid_blocks = 0;
  if (!grid_blocks) {
    (void)hipFuncSetAttribute((const void*)mega_kernel, hipFuncAttributeMaxDynamicSharedMemorySize, LDS);
    int dev = 0, cus = 0, per_cu = 0;
    (void)hipGetDevice(&dev);
    (void)hipDeviceGetAttribute(&cus, hipDeviceAttributeMultiprocessorCount, dev);
    (void)hipOccupancyMaxActiveBlocksPerMultiprocessor(&per_cu, mega_kernel, NTHR, LDS);
    if (per_cu < 1) per_cu = 1;
    if (per_cu > 1) per_cu = 1;
    grid_blocks = cus * per_cu;
  }
  (void)hipMemsetAsync(p.barw, 0, XCD_BAR_WORDS * 4, stream);
  void* args[] = {&p};
  hipError_t e = hipLaunchCooperativeKernel((void*)mega_kernel, dim3(grid_blocks), dim3(NTHR), args, LDS, stream);
  if (e != hipSuccess) fprintf(stderr, "cooperative launch failed: %s (grid %d)\n", hipGetErrorString(e), grid_blocks);
}
```

```cpp
#include <hip/hip_runtime.h>
#include <hip/hip_cooperative_groups.h>
#include <math.h>
#include <stdio.h>
namespace cg = cooperative_groups;

#define DM 1024
#define NB 8
#define SEQ 2048
#define CTXL 256
#define NL (NB * SEQ)
#define NC (NB * CTXL)
#define NT (NL + NC)
#define EVEN_IN 2832
#define PROJW 2816
#define NEXP 16
#define MOE_L (NEXP * NB * 256)
#define MOE_C (NEXP * NB * 32)
#define MOE_T (MOE_L + MOE_C)
#define EPS 1e-6f
#define NTHR 512
#define LAS __attribute__((address_space(3)))

typedef unsigned short bf16_t;
typedef short bf16x8 __attribute__((ext_vector_type(8)));
typedef float f32x4 __attribute__((ext_vector_type(4)));
typedef unsigned u32x4 __attribute__((ext_vector_type(4)));
typedef unsigned u32x2 __attribute__((ext_vector_type(2)));

struct Params {
  const float *x, *c, *ctx, *c_ctx, *w_mod, *b_mod, *g_norm1, *g_norm2, *w_in_even, *w_out_even, *g_qnorm, *g_knorm,
      *w_conv, *b_gate, *g_hnorm, *w_in_odd, *w_pool_grp, *s_pool, *w_router, *w_exp_gate, *w_exp_up, *w_exp_down, *g_final;
  float* out;
  float *xcur, *mod, *gates, *aff, *gatev, *gsG, *gsR, *gsB, *cMIN, *cE1, *cDEC, *Ubuf, *NLb, *NVb;
  bf16_t *hbuf, *proj, *mix, *Xs, *Abuf, *Ybuf, *Qb, *Kb, *Vb, *qm, *km, *Cbf;
  bf16_t *WinE, *WoutE, *WinO, *Wgrp, *Wgu, *Wd;
  int *rowidx, *slotmap;
  unsigned* barw;
  int nprog;
  unsigned char prog_ph[60], prog_l[60];
};

__device__ __forceinline__ float siluf(float v) { return v / (1.f + expf(-v)); }
__device__ __forceinline__ float sigmoidf_(float v) { return 1.f / (1.f + expf(-v)); }
__device__ __forceinline__ float logsigmoidf_(float v) { return fminf(v, 0.f) - log1pf(expf(-fabsf(v))); }
__device__ __forceinline__ float wave_sum(float v) {
#pragma unroll
  for (int o = 32; o > 0; o >>= 1) v += __shfl_xor(v, o);
  return v;
}
__device__ __forceinline__ int modrow(int r) { return r < NL ? (r >> 11) : 8; }
__device__ __forceinline__ float bf2f(bf16_t v) { return __uint_as_float(((unsigned)v) << 16); }
typedef float f32x2_t __attribute__((ext_vector_type(2)));
typedef __bf16 bf16x2_t __attribute__((ext_vector_type(2)));
__device__ __forceinline__ unsigned cvt_pk_bf16(float lo, float hi) {
  const f32x2_t v = {lo, hi};
  return __builtin_bit_cast(unsigned, __builtin_convertvector(v, bf16x2_t));
}
__device__ __forceinline__ bf16_t f2bf(float f) { return (bf16_t)(cvt_pk_bf16(f, 0.f) & 0xffffu); }
__device__ __forceinline__ void unpack8(const u32x4 w, float (&f)[8]) {
  f[0] = __uint_as_float(w.x << 16); f[1] = __uint_as_float(w.x & 0xffff0000u); f[2] = __uint_as_float(w.y << 16); f[3] = __uint_as_float(w.y & 0xffff0000u);
  f[4] = __uint_as_float(w.z << 16); f[5] = __uint_as_float(w.z & 0xffff0000u); f[6] = __uint_as_float(w.w << 16); f[7] = __uint_as_float(w.w & 0xffff0000u);
}
__device__ __forceinline__ u32x4 pack8(const float (&f)[8]) {
  u32x4 w; w.x = cvt_pk_bf16(f[0], f[1]); w.y = cvt_pk_bf16(f[2], f[3]); w.z = cvt_pk_bf16(f[4], f[5]); w.w = cvt_pk_bf16(f[6], f[7]);
  return w;
}

__device__ __forceinline__ int ltid() { int t = threadIdx.x; asm volatile("" : "+v"(t)); return t; }
__device__ __forceinline__ int lbid() { int b = blockIdx.x; asm volatile("" : "+s"(b)); return b; }
__device__ __forceinline__ int lgdim() { int g = gridDim.x; asm volatile("" : "+s"(g)); return g; }

#define XB_TMO      128
#define XB_XCNT(j)  (256  + 64 * (j))
#define XB_XSUB(j)  (1280 + 64 * (j))
#define XB_XGEN(j)  (2304 + 64 * (j))
#define XB_TOP      3328
#define XB_TOPGEN   3392
#define XCD_BAR_WORDS 3456
#define XB_SPIN_CAP (1u << 18)
__device__ __forceinline__ unsigned xb_ld(unsigned* p)              { return __hip_atomic_load(p, __ATOMIC_RELAXED, __HIP_MEMORY_SCOPE_AGENT); }
__device__ __forceinline__ unsigned xb_add(unsigned* p, unsigned v) { return __hip_atomic_fetch_add(p, v, __ATOMIC_RELAXED, __HIP_MEMORY_SCOPE_AGENT); }
__device__ __forceinline__ unsigned xb_xcc_id() { return (unsigned)__builtin_amdgcn_s_getreg((3 << 11) | 20) & 0xFu; }
#define XB_SPIN(cond, bar) do { unsigned _sp = 0; while (cond) { __builtin_amdgcn_s_sleep(1); \
    if ((++_sp & 255u) == 0u) { if (xb_ld(&(bar)[XB_TMO])) break; if (_sp > XB_SPIN_CAP) { atomicAdd(&(bar)[XB_TMO], 1u); break; } } } } while (0)
struct XcdBarrier { unsigned* bar; unsigned x; volatile LAS unsigned* st; };
__device__ __forceinline__ XcdBarrier xcd_barrier_post(unsigned* bar, volatile LAS unsigned* st) {
  XcdBarrier b; b.bar = bar; b.x = xb_xcc_id(); b.st = st;
  if (threadIdx.x == 0) (void)xb_add(&bar[XB_XCNT(b.x)], 1u);
  return b;
}
__device__ __forceinline__ void xcd_barrier_complete(unsigned* bar, unsigned x, unsigned& nloc, unsigned& nx) {
  const unsigned G = gridDim.x * gridDim.y * gridDim.z;
  unsigned sum, cnt, mine, sp = 0u;
  for (;;) {
    sum = 0u; cnt = 0u; mine = 0u;
#pragma unroll
    for (unsigned j = 0; j < 16; ++j) { const unsigned c = xb_ld(&bar[XB_XCNT(j)]); sum += c; cnt += (c > 0u) ? 1u : 0u; mine = (j == x) ? c : mine; }
    if (sum == G) break;
    __builtin_amdgcn_s_sleep(1);
    if ((++sp & 255u) == 0u) { if (xb_ld(&bar[XB_TMO])) break; if (sp > XB_SPIN_CAP) { atomicAdd(&bar[XB_TMO], 1u); break; } }
  }
  nloc = mine > 0u ? mine : 1u; nx = cnt > 0u ? cnt : 1u;
}
__device__ __forceinline__ void xcd_barrier(const XcdBarrier& b) {
  asm volatile("s_waitcnt vmcnt(0)" ::: "memory");
  __syncthreads();
  if (threadIdx.x == 0) {
    unsigned* bar = b.bar;
    __builtin_amdgcn_s_waitcnt(0);
    unsigned nloc = b.st[0], nx = b.st[1];
    if (nloc == 0u) { xcd_barrier_complete(bar, b.x, nloc, nx); b.st[0] = nloc; b.st[1] = nx; }
    const unsigned old = xb_add(&bar[XB_XSUB(b.x)], 1u);
    const unsigned gen = old / nloc;
    if (old + 1u == (gen + 1u) * nloc) {
      __builtin_amdgcn_fence(__ATOMIC_RELEASE, "agent");
      asm volatile("s_waitcnt vmcnt(0)" ::: "memory");
      const unsigned og = xb_add(&bar[XB_TOP], 1u);
      const unsigned tg = og / nx;
      if (og + 1u == (tg + 1u) * nx) xb_add(&bar[XB_TOPGEN], 1u);
      else XB_SPIN(xb_ld(&bar[XB_TOPGEN]) == tg, bar);
      __builtin_amdgcn_fence(__ATOMIC_ACQUIRE, "agent");
      xb_add(&bar[XB_XGEN(b.x)], 1u);
      asm volatile("s_waitcnt vmcnt(0)" ::: "memory");
    } else {
      XB_SPIN(xb_ld(&bar[XB_XGEN(b.x)]) == gen, bar);
      __builtin_amdgcn_fence(__ATOMIC_ACQUIRE, "agent");
      asm volatile("s_waitcnt vmcnt(0)" ::: "memory");
    }
  }
  __syncthreads();
}

namespace g8 {
constexpr int BM = 256, BK = 64, HALF = 128, HTB = HALF * BK * 2, STAGE_BYTES = 8 * HTB;
__device__ __forceinline__ int lds_byte(int r, int c) { const int st = (r >> 4) * 2 + (c >> 5), rr = r & 15, cc = c & 31, ob = rr * 64 + cc * 2; return st * 1024 + (ob ^ (((ob >> 9) & 1) << 5)); }
__device__ __forceinline__ void stage_rc(int b, int& R, int& C) { const int st = b / 1024, sb = b % 1024, swz = sb ^ (((sb >> 9) & 1) << 5); R = (st >> 1) * 16 + swz / 64; C = (st & 1) * 32 + (swz % 64) / 2; }
__device__ __forceinline__ int perm32(int rho) { const int n = rho >> 4, i = rho & 15; return 8 * (i >> 2) + 4 * n + (i & 3); }

struct Unit { const char* A; const char* B; int row0, col0; };

template <class Epi, class Sched>
__device__ __forceinline__ void gemm_phase(LAS unsigned char* lds, const int K, const int lda, const int ldb, const Sched& S, const Epi& E) {
  const int tid = ltid(), wid = __builtin_amdgcn_readfirstlane(tid >> 6), lane = tid & 63, wr = wid >> 2, wc = wid & 3, fr = lane & 15, fq = lane >> 4;
  const int nt = K / BK;
  unsigned voffA[2], voffB[2];
#pragma unroll
  for (int i = 0; i < 2; ++i) {
    int R, C;
    stage_rc(tid * 16 + i * 8192, R, C);
    const int Rb = (R & ~31) + perm32(R & 31);
    voffA[i] = (unsigned)(R * lda + C) * 2u;
    voffB[i] = (unsigned)(Rb * ldb + C) * 2u;
  }
  const size_t kstep = (size_t)(BK * 2);
  const size_t hstepA = (size_t)HALF * lda * 2, hstepB = (size_t)HALF * ldb * 2;
  const unsigned ldsw = (unsigned)wid * 1024u;
  const int aoff = lds_byte(wr * 64 + fr, fq * 8), boff = lds_byte(wc * 32 + fr, fq * 8);
#define PG8_SA(b, h) (((b) * 2 + (h)) * HTB)
#define PG8_SB(b, h) ((4 + (b) * 2 + (h)) * HTB)
#define PG8_STAGE(bufoff, gbase, voff) do { _Pragma("unroll") for (int _i = 0; _i < 2; ++_i) \
    __builtin_amdgcn_global_load_lds((const unsigned*)((const char*)(gbase) + (voff)[_i]), (LAS unsigned*)(lds + (bufoff) + ldsw + _i * 8192), 16, 0, 0); } while (0)
#define PG8_LDA(dst, b, h) do { _Pragma("unroll") for (int m = 0; m < 4; ++m) _Pragma("unroll") for (int k = 0; k < 2; ++k) dst[m][k] = *(const LAS bf16x8*)(lds + PG8_SA(b, h) + aoff + m * 2048 + k * 1024); } while (0)
#define PG8_LDB(dst, b, h) do { _Pragma("unroll") for (int n = 0; n < 2; ++n) _Pragma("unroll") for (int k = 0; k < 2; ++k) dst[n][k] = *(const LAS bf16x8*)(lds + PG8_SB(b, h) + boff + n * 2048 + k * 1024); } while (0)
#define PG8_MMA(ai, bj, At, Bt) do { __builtin_amdgcn_s_setprio(1); _Pragma("unroll") for (int m = 0; m < 4; ++m) _Pragma("unroll") for (int n = 0; n < 2; ++n) _Pragma("unroll") for (int k = 0; k < 2; ++k) \
    acc[ai][bj][m][n] = __builtin_amdgcn_mfma_f32_16x16x32_bf16(Bt[n][k], At[m][k], acc[ai][bj][m][n], 0, 0, 0); __builtin_amdgcn_s_setprio(0); } while (0)
#define PG8_WAIT_V(n) asm volatile("s_waitcnt vmcnt(" #n ")" ::: "memory")
#define PG8_WAIT_L(n) asm volatile("s_waitcnt lgkmcnt(" #n ")" ::: "memory")
#define PG8_BAR __builtin_amdgcn_s_barrier()
#define PG8_SCHED __builtin_amdgcn_sched_barrier(0)
  Unit cur, nxt;
  int ui = 0;
  if (!S.next(0, cur)) return;
  f32x4 acc[2][2][4][2];
#pragma unroll
  for (int a = 0; a < 2; ++a)
#pragma unroll
    for (int b = 0; b < 2; ++b)
#pragma unroll
      for (int m = 0; m < 4; ++m)
#pragma unroll
        for (int n = 0; n < 2; ++n) acc[a][b][m][n] = (f32x4){0.f, 0.f, 0.f, 0.f};
  bf16x8 At[4][2], B0[2][2], B1[2][2];
  const char* cA = cur.A;
  const char* cB = cur.B;
  PG8_STAGE(PG8_SB(0, 0), cB, voffB); PG8_STAGE(PG8_SB(0, 1), cB + hstepB, voffB); PG8_STAGE(PG8_SA(0, 0), cA, voffA); PG8_STAGE(PG8_SA(0, 1), cA + hstepA, voffA);
  if (wr == 1) PG8_BAR;
  PG8_WAIT_V(2); PG8_BAR;
  PG8_STAGE(PG8_SB(1, 0), cB + kstep, voffB); PG8_STAGE(PG8_SA(1, 0), cA + kstep, voffA); PG8_STAGE(PG8_SB(1, 1), cB + hstepB + kstep, voffB);
  PG8_WAIT_V(6); PG8_BAR;
  for (;;) {
    const bool has_next = S.next(ui + 1, nxt);
    const char* nA = has_next ? nxt.A : cA;
    const char* nB = has_next ? nxt.B : cB;
    for (int t = 0; t < nt; t += 2) {
      const bool last = (t == nt - 2);
      const char* a1 = cA + (size_t)(t + 1) * kstep;
      const char* a2 = last ? nA : cA + (size_t)(t + 2) * kstep;
      const char* b2 = last ? nB : cB + (size_t)(t + 2) * kstep;
      const char* a3 = a2 + kstep;
      const char* b3 = b2 + kstep;
      PG8_LDB(B0, 0, 0); PG8_LDB(B1, 0, 1); PG8_SCHED; PG8_LDA(At, 0, 0); PG8_STAGE(PG8_SA(1, 1), a1 + hstepA, voffA);
      PG8_WAIT_V(8); PG8_WAIT_L(0); PG8_BAR; PG8_MMA(0, 0, At, B0); PG8_MMA(0, 1, At, B1); PG8_BAR; PG8_SCHED;
      PG8_LDA(At, 0, 1); PG8_STAGE(PG8_SB(0, 0), b2, voffB); PG8_STAGE(PG8_SB(0, 1), b2 + hstepB, voffB); PG8_STAGE(PG8_SA(0, 0), a2, voffA);
      PG8_WAIT_V(8); PG8_WAIT_L(0); PG8_BAR; PG8_MMA(1, 0, At, B0); PG8_MMA(1, 1, At, B1); PG8_BAR; PG8_SCHED;
      PG8_LDB(B0, 1, 0); PG8_LDB(B1, 1, 1); PG8_SCHED; PG8_LDA(At, 1, 0); PG8_STAGE(PG8_SA(0, 1), a2 + hstepA, voffA);
      PG8_WAIT_V(8); PG8_WAIT_L(0); PG8_BAR; PG8_MMA(0, 0, At, B0); PG8_MMA(0, 1, At, B1); PG8_BAR; PG8_SCHED;
      PG8_LDA(At, 1, 1); PG8_STAGE(PG8_SB(1, 0), b3, voffB); PG8_STAGE(PG8_SB(1, 1), b3 + hstepB, voffB); PG8_STAGE(PG8_SA(1, 0), a3, voffA);
      PG8_WAIT_V(8); PG8_WAIT_L(0); PG8_BAR; PG8_MMA(1, 0, At, B0); PG8_MMA(1, 1, At, B1); PG8_BAR; PG8_SCHED;
    }
    if (wr == 0) PG8_BAR;
    E(acc, cur, wr, wc, fr, fq);
    if (!has_next) break;
#pragma unroll
    for (int a = 0; a < 2; ++a)
#pragma unroll
      for (int b = 0; b < 2; ++b)
#pragma unroll
        for (int m = 0; m < 4; ++m)
#pragma unroll
          for (int n = 0; n < 2; ++n) acc[a][b][m][n] = (f32x4){0.f, 0.f, 0.f, 0.f};
    cur = nxt; cA = nA; cB = nB; ++ui;
    if (wr == 1) PG8_BAR;
  }
  PG8_WAIT_V(0);
  PG8_BAR;
#undef PG8_SA
#undef PG8_SB
#undef PG8_STAGE
#undef PG8_LDA
#undef PG8_LDB
#undef PG8_MMA
#undef PG8_WAIT_V
#undef PG8_WAIT_L
#undef PG8_BAR
#undef PG8_SCHED
}

struct SchedDense {
  const char* A; const char* B; int lda, ldb, nM, nN, acolstep, G, c;
  __device__ __forceinline__ bool next(int i, Unit& u) const {
    const int nwg = nM * nN;
    const long L = (long)i * G + c;
    if (L >= nwg) return false;
    int wgid = (int)L;
    { const int q = nwg / 8, r = nwg % 8, xcd = wgid % 8, off = wgid / 8; wgid = (xcd < r ? xcd * (q + 1) : r * (q + 1) + (xcd - r) * q) + off; }
    const int nig = 8 * nN, gid = wgid / nig, fm = gid * 8, gsz = (nM - fm) < 8 ? (nM - fm) : 8;
    const int pm = fm + ((wgid % nig) % gsz), pn = (wgid % nig) / gsz;
    u.A = A + (size_t)pm * 256 * lda * 2 + (size_t)pn * acolstep;
    u.B = B + (size_t)pn * 256 * ldb * 2;
    u.row0 = pm * 256; u.col0 = pn * 256;
    return true;
  }
};
struct SchedMoe {
  const char* A; const char* W; int ncol, wrows, colw, nu, G, c;
  __device__ __forceinline__ bool next(int i, Unit& u) const {
    const long L = (long)i * G + c;
    if (L >= nu) return false;
    const int wgid = (int)(L % 8) * (nu / 8) + (int)(L / 8);
    const int UL = 128 * ncol;
    int e, pn, row0;
    if (wgid < UL) { e = wgid / (8 * ncol); const int rem = wgid % (8 * ncol); row0 = e * 2048 + (rem % 8) * 256; pn = rem / 8; }
    else { const int w2 = wgid - UL; e = w2 / ncol; pn = w2 % ncol; row0 = MOE_L + e * 256; }
    u.A = A + (size_t)row0 * 1024 * 2;
    u.B = W + ((size_t)e * wrows + (size_t)pn * 256) * 1024 * 2;
    u.row0 = row0; u.col0 = pn * colw;
    return true;
  }
};

struct EpiBf16 {
  bf16_t* O; int ldo;
  __device__ __forceinline__ void operator()(const f32x4 (&acc)[2][2][4][2], const Unit& u, int wr, int wc, int fr, int fq) const {
#pragma unroll
    for (int ai = 0; ai < 2; ++ai)
#pragma unroll
      for (int m = 0; m < 4; ++m) {
        const int row = u.row0 + ai * 128 + wr * 64 + m * 16 + fr;
        bf16_t* rp = O + (size_t)row * ldo + u.col0 + wc * 32 + 8 * fq;
#pragma unroll
        for (int bj = 0; bj < 2; ++bj) {
          const f32x4 v0 = acc[ai][bj][m][0], v1 = acc[ai][bj][m][1];
          u32x4 w; w.x = cvt_pk_bf16(v0[0], v0[1]); w.y = cvt_pk_bf16(v0[2], v0[3]); w.z = cvt_pk_bf16(v1[0], v1[1]); w.w = cvt_pk_bf16(v1[2], v1[3]);
          *(u32x4*)(rp + bj * 128) = w;
        }
      }
  }
};
struct EpiResid {
  float* x; const float* modg; const float* cs; const float* xl; const float* xc;
  __device__ __forceinline__ void operator()(const f32x4 (&acc)[2][2][4][2], const Unit& u, int wr, int wc, int fr, int fq) const {
#pragma unroll
    for (int ai = 0; ai < 2; ++ai)
#pragma unroll
      for (int m = 0; m < 4; ++m) {
        const int row = u.row0 + ai * 128 + wr * 64 + m * 16 + fr;
        const int c0 = u.col0 + wc * 32 + 8 * fq;
        float* xp = x + (size_t)row * 1024 + c0;
        const float* xi = xl ? (row < NL ? xl + (size_t)row * 1024 + c0 : xc + (size_t)(row - NL) * 1024 + c0) : xp;
        const float* gp = modg + (size_t)modrow(row) * 6144 + c0;
#pragma unroll
        for (int bj = 0; bj < 2; ++bj) {
          f32x4 g0 = *(const f32x4*)(gp + bj * 128), g1 = *(const f32x4*)(gp + bj * 128 + 4);
          if (cs) { g0 *= *(const f32x4*)(cs + c0 + bj * 128); g1 *= *(const f32x4*)(cs + c0 + bj * 128 + 4); }
          f32x4 x0 = *(const f32x4*)(xi + bj * 128), x1 = *(const f32x4*)(xi + bj * 128 + 4);
          x0 += g0 * acc[ai][bj][m][0]; x1 += g1 * acc[ai][bj][m][1];
          *(f32x4*)(xp + bj * 128) = x0; *(f32x4*)(xp + bj * 128 + 4) = x1;
        }
      }
  }
};
struct EpiSwiGLU {
  bf16_t* O;
  __device__ __forceinline__ void operator()(const f32x4 (&acc)[2][2][4][2], const Unit& u, int wr, int wc, int fr, int fq) const {
#pragma unroll
    for (int ai = 0; ai < 2; ++ai)
#pragma unroll
      for (int m = 0; m < 4; ++m) {
        const int row = u.row0 + ai * 128 + wr * 64 + m * 16 + fr;
        bf16_t* rp = O + (size_t)row * 1024 + u.col0 + wc * 32 + 8 * fq;
        float o[8];
#pragma unroll
        for (int n = 0; n < 2; ++n)
#pragma unroll
          for (int j = 0; j < 4; ++j) { const float g = acc[ai][0][m][n][j], up = acc[ai][1][m][n][j]; o[n * 4 + j] = g / (1.f + __expf(-g)) * up; }
        u32x4 w; w.x = cvt_pk_bf16(o[0], o[1]); w.y = cvt_pk_bf16(o[2], o[3]); w.z = cvt_pk_bf16(o[4], o[5]); w.w = cvt_pk_bf16(o[6], o[7]);
        *(u32x4*)rp = w;
      }
  }
};
struct EpiDown {
  bf16_t* O; const float* gatev;
  __device__ __forceinline__ void operator()(const f32x4 (&acc)[2][2][4][2], const Unit& u, int wr, int wc, int fr, int fq) const {
#pragma unroll
    for (int ai = 0; ai < 2; ++ai)
#pragma unroll
      for (int m = 0; m < 4; ++m) {
        const int row = u.row0 + ai * 128 + wr * 64 + m * 16 + fr;
        const float gv = gatev[row];
        bf16_t* rp = O + (size_t)row * 1024 + u.col0 + wc * 32 + 8 * fq;
#pragma unroll
        for (int bj = 0; bj < 2; ++bj) {
          const f32x4 v0 = acc[ai][bj][m][0] * gv, v1 = acc[ai][bj][m][1] * gv;
          u32x4 w; w.x = cvt_pk_bf16(v0[0], v0[1]); w.y = cvt_pk_bf16(v0[2], v0[3]); w.z = cvt_pk_bf16(v1[0], v1[1]); w.w = cvt_pk_bf16(v1[2], v1[3]);
          *(u32x4*)(rp + bj * 128) = w;
        }
      }
  }
};
}

#define NT_WINE 1408
#define NT_WOUT 512
#define NT_WINO 512
#define NT_WGRP 128
#define NT_EXP 16384
#define NT_ALL (NT_WINE + NT_WOUT + NT_WINO + NT_WGRP + 3 * NT_EXP)
#define CE0 704
#define CE1 960
#define CE2 13248
#define CE3 13504
#define CE4 13568
#define CE5 25856
#define CE6 26560
#define CE7 26816
#define CE8 39104
#define CE9 39360
#define CE10 39424
#define CE11 51712
__device__ __forceinline__ void conv_batch(const Params& p, int t, float* T) {
  const int tid = ltid(), lane = tid & 63, wv = tid >> 6;
  const float* src; bf16_t* dst; int ld, dK, k0, n0;
  int seg, tb, e, which = 0;
  if (t < CE0) { seg = 0; e = 0; tb = t; } else if (t < CE1) { seg = 1; e = 0; tb = t - CE0; } else if (t < CE2) { seg = 2; e = 0; tb = t - CE1; }
  else if (t < CE3) { seg = 3; e = 0; tb = t - CE2; } else if (t < CE4) { seg = 4; e = 0; tb = t - CE3; } else if (t < CE5) { seg = 2; e = 1; tb = t - CE4; }
  else if (t < CE6) { seg = 0; e = 1; tb = t - CE5; } else if (t < CE7) { seg = 1; e = 1; tb = t - CE6; } else if (t < CE8) { seg = 2; e = 2; tb = t - CE7; }
  else if (t < CE9) { seg = 3; e = 1; tb = t - CE8; } else if (t < CE10) { seg = 4; e = 1; tb = t - CE9; } else { seg = 2; e = 3; tb = t - CE10; }
  int dbase = 0;
  if (seg == 0) {
    k0 = (tb / 44) * 64; n0 = (tb % 44) * 64;
    src = p.w_in_even + (size_t)e * 1024 * EVEN_IN; ld = EVEN_IN; dst = p.WinE + (size_t)e * PROJW * 1024; dK = 1024;
  } else if (seg == 1 || seg == 3) {
    k0 = (tb / 16) * 64; n0 = (tb % 16) * 64;
    src = (seg == 3 ? p.w_in_odd : p.w_out_even) + (size_t)e * 1024 * 1024; ld = 1024; dst = (seg == 3 ? p.WinO : p.WoutE) + (size_t)e * 1024 * 1024; dK = 1024;
  } else if (seg == 4) {
    const int g = tb / 16; k0 = ((tb % 16) / 4) * 64; n0 = (tb % 4) * 64;
    src = p.w_pool_grp + (size_t)(e * 4 + g) * 65536; ld = 256; dst = p.Wgrp + (size_t)e * 1024 * 256; dK = 256; dbase = g * 256;
  } else {
    which = tb / 4096; const int r = tb % 4096, le = e * 16 + r / 256; k0 = ((r % 256) / 16) * 64; n0 = (r % 16) * 64;
    const float* base = which == 0 ? p.w_exp_gate : (which == 1 ? p.w_exp_up : p.w_exp_down);
    src = base + (size_t)le * 1024 * 1024; ld = 1024; dK = 1024;
    dst = which < 2 ? p.Wgu + (size_t)le * 2048 * 1024 : p.Wd + (size_t)le * 1024 * 1024;
  }
  const bool gu = (seg == 2 && which < 2);
  float4 v[8];
#pragma unroll
  for (int q = 0; q < 8; ++q) {
    const int idx = tid + q * NTHR, k = idx >> 6, c4 = idx & 63;
    v[q] = *(const float4*)(src + (size_t)(k0 + k) * ld + n0 + c4 * 4);
  }
#pragma unroll
  for (int q = 0; q < 8; ++q) {
    const int idx = tid + q * NTHR, k = idx >> 6, c4 = idx & 63;
    float* tp = T + k * 257 + c4 * 4;
    tp[0] = v[q].x; tp[1] = v[q].y; tp[2] = v[q].z; tp[3] = v[q].w;
  }
  __syncthreads();
#pragma unroll
  for (int sub = 0; sub < 4; ++sub) {
    const int nl = wv * 8 + (lane >> 3), kq = lane & 7, nn = n0 + sub * 64;
    const int drow0 = gu ? (nn >> 7) * 256 + which * 128 + (nn & 127) : dbase + nn;
    float f[8];
#pragma unroll
    for (int j = 0; j < 8; ++j) f[j] = T[(kq * 8 + j) * 257 + sub * 64 + nl];
    u32x4 w; w.x = cvt_pk_bf16(f[0], f[1]); w.y = cvt_pk_bf16(f[2], f[3]); w.z = cvt_pk_bf16(f[4], f[5]); w.w = cvt_pk_bf16(f[6], f[7]);
    *(u32x4*)(dst + (size_t)(drow0 + nl) * dK + k0 + kq * 8) = w;
  }
}
__device__ __forceinline__ int conv_pull(const Params& p, float* sm) {
  __syncthreads();
  if (ltid() == 0) ((int*)sm)[16500] = (int)__hip_atomic_fetch_add(p.barw, 4u, __ATOMIC_RELAXED, __HIP_MEMORY_SCOPE_AGENT);
  __syncthreads();
  return ((int*)sm)[16500];
}
__device__ __forceinline__ void conv_until(const Params& p, int end, float* sm) {
  int t;
  do { t = conv_pull(p, sm); if (t < CE11) conv_batch(p, t, sm); } while (t + 4 < end);
  __syncthreads();
}
__device__ __forceinline__ void conv_quota(const Params& p, int n, float* sm) {
  for (int i = 0; i < n; ++i) { const int t = conv_pull(p, sm); if (t >= CE11) break; conv_batch(p, t, sm); }
  __syncthreads();
}

__device__ __forceinline__ void ph_init(const Params& p, float* sm) {
  const int tid = ltid(), lane = tid & 63, wv = tid >> 6;
  const size_t gtid = (size_t)lbid() * NTHR + tid, gsz = (size_t)lgdim() * NTHR;
  for (int i = tid; i < 9 * 1024; i += NTHR) {
    const int r = i >> 10, k = i & 1023;
    sm[i] = siluf(r < 8 ? p.c[r * 1024 + k] : p.c_ctx[k]);
  }
  __syncthreads();
  float* part = sm + 9 * 1024;
  for (int item = lbid(); item < 768; item += lgdim()) {
    const int l = item / 192, j0 = (item % 192) * 32;
    const int col = lane & 31, kh = lane >> 5;
    const float* w = p.w_mod + (size_t)l * 1024 * 6144 + j0 + col;
    float acc[9];
#pragma unroll
    for (int r = 0; r < 9; ++r) acc[r] = 0.f;
    const int kb = wv * 128 + kh * 64;
#pragma unroll 4
    for (int kk = 0; kk < 64; ++kk) {
      const float wvv = w[(size_t)(kb + kk) * 6144];
#pragma unroll
      for (int r = 0; r < 9; ++r) acc[r] += sm[r * 1024 + kb + kk] * wvv;
    }
#pragma unroll
    for (int r = 0; r < 9; ++r) part[((wv * 2 + kh) * 9 + r) * 32 + col] = acc[r];
    __syncthreads();
    if (tid < 288) {
      const int r = tid >> 5, cc = tid & 31;
      float s = 0.f;
#pragma unroll
      for (int sl = 0; sl < 16; ++sl) s += part[(sl * 9 + r) * 32 + cc];
      p.mod[(size_t)(l * 9 + r) * 6144 + j0 + cc] = s + p.b_mod[l * 6144 + j0 + cc];
    }
    __syncthreads();
  }
  conv_until(p, CE1, sm);
}

typedef float f32x4m __attribute__((ext_vector_type(4)));
__device__ __forceinline__ void ph_norm(const Params& p, int l, int which, int nrows, int ncomb, int lprev, float* sm) {
  const int tid = ltid(), lane = tid & 63, wv = tid >> 6;
  const bool skinny = (which == 2) || (which == 1 && (l & 1) == 0);
  bf16_t* HROW = (bf16_t*)sm;
  float* PART = sm + 8192;
  bf16x8 Bhi[4], Blo[4];
  if (skinny) {
    const float* wbase; int stride;
    if (which == 2) { wbase = p.w_router + (size_t)l * 1024 * 16; stride = 16; }
    else { wbase = p.w_in_even + (size_t)(l >> 1) * 1024 * EVEN_IN + PROJW; stride = EVEN_IN; }
    const int kg = lane >> 4, n = lane & 15;
#pragma unroll
    for (int ks = 0; ks < 4; ++ks) {
      float f[8], hi[8], lo[8];
#pragma unroll
      for (int j = 0; j < 8; ++j) f[j] = wbase[(size_t)(wv * 128 + ks * 32 + kg * 8 + j) * stride + n];
      const u32x4 hw = pack8(f);
      unpack8(hw, hi);
#pragma unroll
      for (int j = 0; j < 8; ++j) lo[j] = f[j] - hi[j];
      Bhi[ks] = __builtin_bit_cast(bf16x8, hw);
      Blo[ks] = __builtin_bit_cast(bf16x8, pack8(lo));
    }
  }
  const int nwaves = lgdim() * (NTHR / 64), gw = lbid() * (NTHR / 64) + wv;
  const int per = (nrows + nwaves - 1) / nwaves;
  const int rbeg = gw * per, rend = min(nrows, rbeg + per);
  const bool in0 = (which == 1 && l == 0);
  float4 vn[4];
  int slvn = -1;
  {
    const int r0 = min(rbeg, nrows - 1);
    const float* xs0 = in0 ? (r0 < NL ? p.x + (size_t)r0 * DM : p.ctx + (size_t)(r0 - NL) * DM) : p.xcur + (size_t)r0 * DM;
#pragma unroll
    for (int i = 0; i < 4; ++i) vn[i] = ((const float4*)xs0)[i * 64 + lane];
    if (r0 < ncomb && lane < 16) slvn = p.slotmap[r0 * 16 + lane];
  }
  for (int it = 0; it < per; ++it) {
    const int rr = rbeg + it;
    const bool live = rr < rend;
    const int r = min(rr, nrows - 1);
    float4 v[4];
#pragma unroll
    for (int i = 0; i < 4; ++i) v[i] = vn[i];
    const int slv = slvn;
    float* xr = p.xcur + (size_t)r * DM;
    if (it + 1 < per) {
      const int rn = min(rr + 1, nrows - 1);
      const float* xsn = in0 ? (rn < NL ? p.x + (size_t)rn * DM : p.ctx + (size_t)(rn - NL) * DM) : p.xcur + (size_t)rn * DM;
#pragma unroll
      for (int i = 0; i < 4; ++i) vn[i] = ((const float4*)xsn)[i * 64 + lane];
      slvn = (rn < ncomb && lane < 16) ? p.slotmap[rn * 16 + lane] : -1;
    }
    const int mr = modrow(r);
    if (live && r < ncomb) {
      float4 s4[4];
#pragma unroll
      for (int i = 0; i < 4; ++i) s4[i] = make_float4(0.f, 0.f, 0.f, 0.f);
      unsigned long long mask = __ballot(slv >= 0);
      while (mask) {
        const int e = __ffsll((long long)mask) - 1;
        mask &= mask - 1;
        const int sl = __shfl(slv, e);
        size_t yrow;
        if (r < NL) yrow = (size_t)e * 2048 + (size_t)(r >> 11) * 256 + sl;
        else yrow = (size_t)MOE_L + (size_t)e * 256 + (size_t)((r - NL) >> 8) * 32 + sl;
        const u32x2* yp = (const u32x2*)(p.Ybuf + yrow * DM);
#pragma unroll
        for (int i = 0; i < 4; ++i) {
          const u32x2 y = yp[i * 64 + lane];
          s4[i].x += __uint_as_float(y.x << 16); s4[i].y += __uint_as_float(y.x & 0xffff0000u);
          s4[i].z += __uint_as_float(y.y << 16); s4[i].w += __uint_as_float(y.y & 0xffff0000u);
        }
      }
      const float4* g5 = (const float4*)(p.mod + (size_t)(lprev * 9 + mr) * 6144 + 5 * 1024);
#pragma unroll
      for (int i = 0; i < 4; ++i) {
        const float4 g = g5[i * 64 + lane];
        v[i].x += g.x * s4[i].x; v[i].y += g.y * s4[i].y; v[i].z += g.z * s4[i].z; v[i].w += g.w * s4[i].w;
        if (which != 3) ((float4*)xr)[i * 64 + lane] = v[i];
      }
    }
    float ss = 0.f;
#pragma unroll
    for (int i = 0; i < 4; ++i) ss += v[i].x * v[i].x + v[i].y * v[i].y + v[i].z * v[i].z + v[i].w * v[i].w;
    ss = wave_sum(ss);
    const float inv = rsqrtf(ss * (1.f / 1024.f) + EPS);
    if (which == 3) {
      if (live) {
#pragma unroll
        for (int i = 0; i < 4; ++i) {
          const float4 g = ((const float4*)p.g_final)[i * 64 + lane];
          ((float4*)(p.out + (size_t)r * DM))[i * 64 + lane] = make_float4(v[i].x * inv * g.x, v[i].y * inv * g.y, v[i].z * inv * g.z, v[i].w * inv * g.w);
        }
      }
      continue;
    }
    const float* gn = (which == 1 ? p.g_norm1 : p.g_norm2) + l * 1024;
    const float* mrow = p.mod + (size_t)(l * 9 + mr) * 6144;
    const float4* shp = (const float4*)(mrow + (which == 1 ? 0 : 3) * 1024);
    const float4* scp = (const float4*)(mrow + (which == 1 ? 1 : 4) * 1024);
#pragma unroll
    for (int i = 0; i < 4; ++i) {
      const float4 g = ((const float4*)gn)[i * 64 + lane];
      const float4 sh = shp[i * 64 + lane], sc = scp[i * 64 + lane];
      const float h0 = v[i].x * inv * g.x * (1.f + sc.x) + sh.x, h1 = v[i].y * inv * g.y * (1.f + sc.y) + sh.y;
      const float h2 = v[i].z * inv * g.z * (1.f + sc.z) + sh.z, h3 = v[i].w * inv * g.w * (1.f + sc.w) + sh.w;
      u32x2 w; w.x = cvt_pk_bf16(h0, h1); w.y = cvt_pk_bf16(h2, h3);
      if (live) ((u32x2*)(p.hbuf + (size_t)r * DM))[i * 64 + lane] = w;
      if (skinny) {
        const float l0 = h0 - __uint_as_float(w.x << 16), l1 = h1 - __uint_as_float(w.x & 0xffff0000u);
        const float l2 = h2 - __uint_as_float(w.y << 16), l3 = h3 - __uint_as_float(w.y & 0xffff0000u);
        u32x2 wl; wl.x = cvt_pk_bf16(l0, l1); wl.y = cvt_pk_bf16(l2, l3);
        ((u32x2*)(HROW + (wv * 2 + 0) * 1024))[i * 64 + lane] = w;
        ((u32x2*)(HROW + (wv * 2 + 1) * 1024))[i * 64 + lane] = wl;
      }
    }
    if (!skinny) continue;
    __syncthreads();
    {
      const int arow = lane & 7, kg = lane >> 4;
      f32x4m acc = {0.f, 0.f, 0.f, 0.f};
#pragma unroll
      for (int ks = 0; ks < 4; ++ks) {
        const bf16x8 ahi = *(const bf16x8*)(HROW + (arow * 2 + 0) * 1024 + wv * 128 + ks * 32 + kg * 8);
        const bf16x8 alo = *(const bf16x8*)(HROW + (arow * 2 + 1) * 1024 + wv * 128 + ks * 32 + kg * 8);
        acc = __builtin_amdgcn_mfma_f32_16x16x32_bf16(ahi, Bhi[ks], acc, 0, 0, 0);
        acc = __builtin_amdgcn_mfma_f32_16x16x32_bf16(ahi, Blo[ks], acc, 0, 0, 0);
        acc = __builtin_amdgcn_mfma_f32_16x16x32_bf16(alo, Bhi[ks], acc, 0, 0, 0);
      }
      if (kg < 2) {
#pragma unroll
        for (int q = 0; q < 4; ++q) PART[(wv * 8 + kg * 4 + q) * 16 + (lane & 15)] = acc[q];
      }
    }
    __syncthreads();
    {
      float v1 = 0.f;
      if (lane < 16) {
#pragma unroll
        for (int w2 = 0; w2 < 8; ++w2) v1 += PART[(w2 * 8 + wv) * 16 + lane];
      }
      if (which == 2) {
        float mx = v1;
        mx = fmaxf(mx, __shfl_xor(mx, 1)); mx = fmaxf(mx, __shfl_xor(mx, 2)); mx = fmaxf(mx, __shfl_xor(mx, 4)); mx = fmaxf(mx, __shfl_xor(mx, 8));
        const float ex = expf(v1 - mx);
        float sum = ex;
        sum += __shfl_xor(sum, 1); sum += __shfl_xor(sum, 2); sum += __shfl_xor(sum, 4); sum += __shfl_xor(sum, 8);
        if (live && lane < 16) p.aff[(size_t)r * 16 + lane] = ex / sum;
      } else {
        float gvv = v1 + p.b_gate[(l >> 1) * 16 + (lane & 15)];
        if ((lane >> 2) & 1) gvv = logsigmoidf_(gvv);
        if (live && lane < 16) p.gates[(size_t)r * 16 + lane] = gvv;
      }
    }
  }
  __syncthreads();
}

#define LOG2E 1.4426950408889634f
__device__ __forceinline__ int chain_row(int b, int dir, int p) {
  if (p < 256) { const int t = dir ? 255 - p : p; return NL + b * 256 + t; }
  const int q = p - 256; const int t = dir ? 2047 - q : q; return b * 2048 + t;
}
__device__ __forceinline__ float wave_incl_sum(float v, int lane) {
#pragma unroll
  for (int o = 1; o < 64; o <<= 1) { const float t = __shfl_up(v, o); if (lane >= o) v += t; }
  return v;
}
__device__ __forceinline__ float wave_incl_max(float v, int lane) {
#pragma unroll
  for (int o = 1; o < 64; o <<= 1) { const float t = __shfl_up(v, o); if (lane >= o) v = fmaxf(v, t); }
  return v;
}
__device__ __forceinline__ void ph_post_even(const Params& p, int l, float* sm) {
  const int e = l >> 1;
  const int tid = ltid(), lane = tid & 63;
  __syncthreads();
  for (int idx = tid; idx < 1024; idx += NTHR) {
    const int pos = idx >> 4, i = idx & 15;
    const float ang = (float)pos * exp2f(-(float)i * (13.287712379549449f / 16.f));
    float sn, cs;
    sincosf(ang, &sn, &cs);
    sm[2 * idx] = cs; sm[2 * idx + 1] = sn;
  }
  __syncthreads();
  const int bid = lbid(), G = lgdim();
  const bool scanner = (bid < 64) && (tid < 64) && (G > 64);
  const size_t nthr_e = (size_t)G * NTHR - (G > 64 ? 64 * 64 : 0);
  size_t gtid;
  if (G > 64) gtid = bid < 64 ? (size_t)bid * (NTHR - 64) + (tid - 64) : (size_t)64 * (NTHR - 64) + (size_t)(bid - 64) * NTHR + tid;
  else gtid = (size_t)bid * NTHR + tid;
  const size_t gsz = nthr_e;
  if (!scanner) {
  for (size_t it = gtid; it < (size_t)NT * 10; it += gsz) {
    const int r = (int)(it / 10), hh = (int)(it % 10);
    const bool lat = r < NL;
    const int t = r & 2047;
    const int bb = lat ? (r >> 11) : ((r - NL) >> 8);
    const int key = lat ? 256 + t : ((r - NL) & 255);
    const bf16_t* src; bf16_t* dst; const float* g; float osc;
    if (hh < 8) { src = p.proj + (size_t)r * PROJW + hh * 64; dst = p.Qb + (size_t)r * 512 + hh * 64; g = p.g_qnorm + e * 64; osc = 0.125f * LOG2E; }
    else { src = p.proj + (size_t)r * PROJW + 512 + (hh - 8) * 64; dst = p.Kb + ((size_t)(bb * 2 + (hh - 8)) * 2304 + key) * 64; g = p.g_knorm + e * 64; osc = 1.f;
           const u32x4* vs = (const u32x4*)(p.proj + (size_t)r * PROJW + 640 + (hh - 8) * 64);
           u32x4* vd = (u32x4*)(p.Vb + ((size_t)(bb * 2 + (hh - 8)) * 2304 + key) * 64);
#pragma unroll
           for (int q = 0; q < 8; ++q) vd[q] = vs[q]; }
    float x[64];
#pragma unroll
    for (int q = 0; q < 8; ++q) { float f[8]; unpack8(((const u32x4*)src)[q], f);
#pragma unroll
      for (int j = 0; j < 8; ++j) x[q * 8 + j] = f[j]; }
    float ss = 0.f;
#pragma unroll
    for (int j = 0; j < 64; ++j) ss += x[j] * x[j];
    const float inv = rsqrtf(ss * (1.f / 64.f) + EPS) * osc;
#pragma unroll
    for (int j = 0; j < 64; ++j) x[j] *= inv * g[j];
    if (lat) {
#pragma unroll
      for (int a = 0; a < 2; ++a) {
        const int pos = (a == 0) ? (t >> 6) : (t & 63);
#pragma unroll
        for (int i = 0; i < 16; ++i) {
          const float2 cssn = *(const float2*)(sm + 2 * (pos * 16 + i));
          const float x1 = x[a * 32 + i], x2 = x[a * 32 + 16 + i];
          x[a * 32 + i] = x1 * cssn.x - x2 * cssn.y;
          x[a * 32 + 16 + i] = x2 * cssn.x + x1 * cssn.y;
        }
      }
    }
#pragma unroll
    for (int q = 0; q < 8; ++q) { float f[8];
#pragma unroll
      for (int j = 0; j < 8; ++j) f[j] = x[q * 8 + j];
      ((u32x4*)dst)[q] = pack8(f); }
  }
  const float* wc = p.w_conv + (size_t)e * 3 * 1024;
  for (size_t it = gtid; it < (size_t)NT * 128; it += gsz) {
    const int r = (int)(it >> 7), c8 = (int)(it & 127) * 8;
    int t, n;
    if (r < NL) { t = r & 2047; n = 2048; } else { t = (r - NL) & 255; n = 256; }
    const bf16_t* sp = p.proj + (size_t)r * PROJW + 768 + c8;
    float xc[8], xm[8], xp[8], o[8];
    unpack8(*(const u32x4*)sp, xc);
    if (t > 0) unpack8(*(const u32x4*)(sp - PROJW), xm); else {
#pragma unroll
      for (int j = 0; j < 8; ++j) xm[j] = 0.f; }
    if (t < n - 1) unpack8(*(const u32x4*)(sp + PROJW), xp); else {
#pragma unroll
      for (int j = 0; j < 8; ++j) xp[j] = 0.f; }
    const float ksc = c8 < 512 ? 1.f : 0.08838834764831845f;
#pragma unroll
    for (int j = 0; j < 8; ++j) { const float v = wc[c8 + j] * xm[j] + wc[1024 + c8 + j] * xc[j] + wc[2048 + c8 + j] * xp[j]; o[j] = siluf(v) * ksc; }
    bf16_t* dp = c8 < 512 ? p.qm + (size_t)r * 512 + c8 : p.km + (size_t)r * 512 + c8 - 512;
    *(u32x4*)dp = pack8(o);
  }
  }
  if (scanner || G <= 64) {
    const int gw = (G > 64) ? bid : (int)(((size_t)bid * NTHR + tid) >> 6), nw = (G > 64) ? 64 : (int)(((size_t)G * NTHR) >> 6);
    for (int chain = gw; chain < 64; chain += nw) {
      const int b = chain >> 3, hd = (chain >> 1) & 3, dir = chain & 1;
      float m_in = -1e30f;
      for (int c = 0; c < 18; ++c) {
        const int p0 = c * 128 + 2 * lane;
        const int r0 = chain_row(b, dir, p0), r1 = chain_row(b, dir, p0 + 1);
        const float ig0 = p.gates[(size_t)r0 * 16 + dir * 8 + hd], lf0 = p.gates[(size_t)r0 * 16 + dir * 8 + 4 + hd];
        const float ig1 = p.gates[(size_t)r1 * 16 + dir * 8 + hd], lf1 = p.gates[(size_t)r1 * 16 + dir * 8 + 4 + hd];
        const float ssum = lf0 + lf1;
        const float incl = wave_incl_sum(ssum, lane);
        const float bq0 = (incl - ssum) + lf0, bq1 = bq0 + lf1;
        const float bend = __shfl(incl, 63);
        const float g0 = ig0 - bq0, g1 = ig1 - bq1;
        const float inclm = wave_incl_max(fmaxf(g0, g1), lane);
        float exclm = __shfl_up(inclm, 1);
        if (lane == 0) exclm = -3.0e38f;
        const float pm0 = fmaxf(exclm, g0), pm1 = fmaxf(pm0, g1);
        const float gmax = __shfl(inclm, 63);
        const float m_next = fmaxf(m_in + bend, bend + gmax);
        const size_t i0 = (size_t)r0 * 8 + dir * 4 + hd, i1 = (size_t)r1 * 8 + dir * 4 + hd;
        p.gsG[i0] = g0 * LOG2E; p.gsR[i0] = -fmaxf(m_in, pm0) * LOG2E; p.gsB[i0] = bq0 * LOG2E;
        p.gsG[i1] = g1 * LOG2E; p.gsR[i1] = -fmaxf(m_in, pm1) * LOG2E; p.gsB[i1] = bq1 * LOG2E;
        if (lane == 0) { p.cMIN[chain * 18 + c] = m_in * LOG2E; p.cE1[chain * 18 + c] = (bend - m_next) * LOG2E; p.cDEC[chain * 18 + c] = expf(m_in + bend - m_next); }
        m_in = m_next;
      }
    }
  }
}

typedef float f32x16 __attribute__((ext_vector_type(16)));
typedef short s16x4 __attribute__((ext_vector_type(4)));
typedef __attribute__((address_space(3))) const char* lds_cptr;
__device__ __forceinline__ s16x4 vtr(lds_cptr p) { return __builtin_bit_cast(s16x4, __builtin_amdgcn_ds_read_tr16_b64_v4i16((__attribute__((address_space(3))) s16x4*)p)); }
#define MX3(a, b, c) __builtin_fmaxf(__builtin_fmaxf((a), (b)), (c))
__device__ __forceinline__ float rowmax32(const f32x16& p0, const f32x16& p1) {
  float a = MX3(p0[0], p0[1], p1[0]), b = MX3(p0[2], p0[3], p1[1]);
  a = MX3(a, p1[2], p1[3]);
#pragma unroll
  for (int r = 4; r < 16; r += 4) { a = MX3(a, p0[r], p0[r + 1]); b = MX3(b, p0[r + 2], p0[r + 3]); a = MX3(a, p1[r], p1[r + 1]); b = MX3(b, p1[r + 2], p1[r + 3]); }
  const float m = __builtin_fmaxf(a, b);
  auto rr = __builtin_amdgcn_permlane32_swap(__float_as_uint(m), __float_as_uint(m), false, false);
  return __builtin_fmaxf(__uint_as_float(rr[0]), __uint_as_float(rr[1]));
}
__device__ __forceinline__ float half_swap_add(float v) {
  auto rr = __builtin_amdgcn_permlane32_swap(__float_as_uint(v), __float_as_uint(v), false, false);
  return __uint_as_float(rr[0]) + __uint_as_float(rr[1]);
}
#define ATT_SLOT 16384
__device__ __forceinline__ void glds16(const void* g, unsigned lds_base) {
  unsigned sv;
  asm volatile("s_mov_b32 %0, m0\n\ts_mov_b32 m0, %2\n\ts_nop 0\n\tglobal_load_lds_dwordx4 %1, off\n\ts_mov_b32 m0, %0" : "=&s"(sv) : "v"(g), "s"(lds_base) : "memory");
}
__device__ __forceinline__ void attn_unit(const bf16_t* Q0, const bf16_t* Kbase, const bf16_t* Vbase, const int nkeys, bf16_t* O0, LAS unsigned char* lds) {
  const int tid = ltid(), lane = tid & 63, r32 = lane & 31, hi = lane >> 5;
  const int wid = __builtin_amdgcn_readfirstlane(tid >> 6);
  const int NTL = nkeys >> 6;
  __syncthreads();
  const bf16_t* ksrc = Kbase + (size_t)lane * 64 + wid * 8;
  const bf16_t* vsrc = Vbase + (size_t)(16 * (wid & 3) + (lane >> 2)) * 64 + (wid >> 2) * 32 + (lane & 3) * 8;
  const unsigned ldsb = (unsigned)(size_t)lds;
#define ATT_STAGE(t, slot) do { \
    glds16(ksrc + (size_t)(t) * 64 * 64, (unsigned)__builtin_amdgcn_readfirstlane(ldsb + (slot) * ATT_SLOT + wid * 1024)); \
    glds16(vsrc + (size_t)(t) * 64 * 64, (unsigned)__builtin_amdgcn_readfirstlane(ldsb + (slot) * ATT_SLOT + 8192 + wid * 1024)); } while (0)
  ATT_STAGE(0, 0);
  if (NTL > 1) ATT_STAGE(1, 1);
  bf16x8 qr[4];
  {
    const bf16_t* Qw = Q0 + (size_t)(wid * 32 + r32) * 512;
#pragma unroll
    for (int d0 = 0; d0 < 4; ++d0) qr[d0] = *(const bf16x8*)(Qw + d0 * 16 + hi * 8);
  }
  f32x16 o0, o1;
#pragma unroll
  for (int r = 0; r < 16; ++r) { o0[r] = 0.f; o1[r] = 0.f; }
  float m = -1e30f, l = 0.f;
  const int koff = hi * 1024 + r32 * 16;
  const int voff = 8192 + ((lane >> 4) & 1) * 32 + (lane & 3) * 8 + (4 * hi + ((lane & 15) >> 2)) * 64;
  const bool grpB = wid >= 4;
  bf16x8 pw[4];
#define ATT_PV(sl) do { const lds_cptr vp_ = (lds_cptr)(lds + (sl) * ATT_SLOT + voff); \
    _Pragma("unroll") for (int s4 = 0; s4 < 4; ++s4) { \
      const s16x4 a0l = vtr(vp_ + s4 * 1024), a0h = vtr(vp_ + s4 * 1024 + 512); \
      const s16x4 a1l = vtr(vp_ + 4096 + s4 * 1024), a1h = vtr(vp_ + 4096 + s4 * 1024 + 512); \
      const bf16x8 a0 = {a0l[0], a0l[1], a0l[2], a0l[3], a0h[0], a0h[1], a0h[2], a0h[3]}; \
      const bf16x8 a1 = {a1l[0], a1l[1], a1l[2], a1l[3], a1h[0], a1h[1], a1h[2], a1h[3]}; \
      o0 = __builtin_amdgcn_mfma_f32_32x32x16_bf16(a0, pw[s4], o0, 0, 0, 0); \
      o1 = __builtin_amdgcn_mfma_f32_32x32x16_bf16(a1, pw[s4], o1, 0, 0, 0); } } while (0)
  for (int t = 0; t <= NTL; ++t) {
    if (t + 1 < NTL) asm volatile("s_waitcnt vmcnt(2) lgkmcnt(0)\n\ts_barrier" ::: "memory"); else asm volatile("s_waitcnt vmcnt(0) lgkmcnt(0)\n\ts_barrier" ::: "memory");
    __builtin_amdgcn_sched_barrier(0);
    if (t + 2 < NTL) ATT_STAGE(t + 2, (t + 2) & 3);
    if (grpB && t > 0) ATT_PV((t - 1) & 3);
    if (t < NTL) {
      const lds_cptr kp = (lds_cptr)(lds + (t & 3) * ATT_SLOT + koff);
      f32x16 pA, pB;
#pragma unroll
      for (int r = 0; r < 16; ++r) { pA[r] = 0.f; pB[r] = 0.f; }
#pragma unroll
      for (int d0 = 0; d0 < 4; ++d0) {
        const bf16x8 k0 = *(const LAS bf16x8*)(kp + d0 * 2048), k1 = *(const LAS bf16x8*)(kp + d0 * 2048 + 512);
        pA = __builtin_amdgcn_mfma_f32_32x32x16_bf16(k0, qr[d0], pA, 0, 0, 0);
        pB = __builtin_amdgcn_mfma_f32_32x32x16_bf16(k1, qr[d0], pB, 0, 0, 0);
      }
      const float rm = rowmax32(pA, pB);
      const float mn = __builtin_fmaxf(m, rm);
      const float alpha = __builtin_amdgcn_exp2f(m - mn);
      m = mn;
      float ps = 0.f;
#pragma unroll
      for (int r = 0; r < 16; ++r) { pA[r] = __builtin_amdgcn_exp2f(pA[r] - mn); pB[r] = __builtin_amdgcn_exp2f(pB[r] - mn); ps += pA[r] + pB[r]; }
      l = l * alpha + ps;
#pragma unroll
      for (int r = 0; r < 16; ++r) { o0[r] *= alpha; o1[r] *= alpha; }
#pragma unroll
      for (int s4 = 0; s4 < 4; ++s4) {
        u32x4 w;
        if (s4 < 2) { w.x = cvt_pk_bf16(pA[8 * s4 + 0], pA[8 * s4 + 1]); w.y = cvt_pk_bf16(pA[8 * s4 + 2], pA[8 * s4 + 3]); w.z = cvt_pk_bf16(pA[8 * s4 + 4], pA[8 * s4 + 5]); w.w = cvt_pk_bf16(pA[8 * s4 + 6], pA[8 * s4 + 7]); }
        else { const int q = s4 - 2; w.x = cvt_pk_bf16(pB[8 * q + 0], pB[8 * q + 1]); w.y = cvt_pk_bf16(pB[8 * q + 2], pB[8 * q + 3]); w.z = cvt_pk_bf16(pB[8 * q + 4], pB[8 * q + 5]); w.w = cvt_pk_bf16(pB[8 * q + 6], pB[8 * q + 7]); }
        pw[s4] = __builtin_bit_cast(bf16x8, w);
      }
      if (!grpB) ATT_PV(t & 3);
    }
  }
#undef ATT_PV
#undef ATT_STAGE
  const float il = 1.f / half_swap_add(l);
  bf16_t* Ow = O0 + (size_t)(wid * 32 + r32) * 1024;
#pragma unroll
  for (int g4 = 0; g4 < 4; ++g4) {
    u32x2 w0, w1;
    w0.x = cvt_pk_bf16(o0[4 * g4 + 0] * il, o0[4 * g4 + 1] * il); w0.y = cvt_pk_bf16(o0[4 * g4 + 2] * il, o0[4 * g4 + 3] * il);
    w1.x = cvt_pk_bf16(o1[4 * g4 + 0] * il, o1[4 * g4 + 1] * il); w1.y = cvt_pk_bf16(o1[4 * g4 + 2] * il, o1[4 * g4 + 3] * il);
    *(u32x2*)(Ow + 8 * g4 + 4 * hi) = w0;
    *(u32x2*)(Ow + 32 + 8 * g4 + 4 * hi) = w1;
  }
}
__device__ __forceinline__ void ph_att(const Params& p, bool ctx_q, LAS unsigned char* lds) {
  const int c = lbid(), G = lgdim();
  const int nunits = 512 + (ctx_q ? 64 : 0);
  for (int L = c; L < nunits; L += G) {
    if (L < 512) {
      const int i = L >> 8, cc = L & 255, grp = (cc & 7) + 8 * i, idx = cc >> 3;
      const int b = grp >> 1, kvh = grp & 1, h = kvh * 4 + (idx >> 3), qt = idx & 7;
      const size_t row0 = (size_t)b * 2048 + qt * 256;
      attn_unit(p.Qb + row0 * 512 + h * 64, p.Kb + (size_t)(b * 2 + kvh) * 2304 * 64, p.Vb + (size_t)(b * 2 + kvh) * 2304 * 64, 2304, p.mix + row0 * 1024 + h * 64, lds);
    } else {
      const int u = L - 512, b = u >> 3, h = u & 7, kvh = h >> 2;
      const size_t row0 = (size_t)NL + b * 256;
      attn_unit(p.Qb + row0 * 512 + h * 64, p.Kb + (size_t)(b * 2 + kvh) * 2304 * 64, p.Vb + (size_t)(b * 2 + kvh) * 2304 * 64, 256, p.mix + row0 * 1024 + h * 64, lds);
    }
  }
  __syncthreads();
}

__device__ __forceinline__ int chunk_row0(int b, int dir, int cc) {
  if (cc < 2) return NL + b * 256 + (dir ? 1 - cc : cc) * 128;
  return b * 2048 + (dir ? 15 - (cc - 2) : cc - 2) * 128;
}
__device__ __forceinline__ int trq_addr(int lane, int quarter, int rowbase) {
  return quarter * 8192 + ((lane >> 4) & 1) * 32 + (lane & 3) * 8 + (rowbase + ((lane & 15) >> 2)) * 64;
}
__device__ __forceinline__ bf16x8 cat44(const s16x4 a, const s16x4 b) { return (bf16x8){a[0], a[1], a[2], a[3], b[0], b[1], b[2], b[3]}; }

__device__ __forceinline__ void ph_mlstm_u(const Params& p, LAS unsigned char* lds) {
  const int tid = ltid(), lane = tid & 63, r32 = lane & 31, hi = lane >> 5;
  const int wid = __builtin_amdgcn_readfirstlane(tid >> 6);
  LAS float* WS = (LAS float*)(lds + 65536);
  LAS float* NP = (LAS float*)(lds + 66048);
  for (int unit = lbid(); unit < 64 * 17; unit += lgdim()) {
    const int chain = unit / 17, cc = unit % 17;
    const int b = chain >> 3, hd = (chain >> 1) & 3, dir = chain & 1;
    const int row0 = chunk_row0(b, dir, cc);
    __syncthreads();
#pragma unroll
    for (int n = 0; n < 4; ++n) {
      const int ii = wid * 4 + n, qd = ii >> 3, rg = ii & 7;
      const bf16_t* src = p.km + (size_t)(row0 + rg * 16 + (lane >> 2)) * 512 + hd * 128 + qd * 32 + (lane & 3) * 8;
      __builtin_amdgcn_global_load_lds((const unsigned*)src, (LAS unsigned*)(lds + qd * 8192 + rg * 1024), 16, 0, 0);
    }
    if (tid < 128) WS[tid] = __builtin_amdgcn_exp2f(p.gsG[(size_t)(row0 + tid) * 8 + dir * 4 + hd] + p.cE1[chain * 18 + cc]);
    __syncthreads();
#pragma unroll
    for (int n = 0; n < 4; ++n) {
      const int o = (tid + n * NTHR) * 16, qd = o >> 13, row = (o >> 6) & 127, pc = (o >> 4) & 3;
      float f[8];
      unpack8(*(const u32x4*)(p.proj + (size_t)(row0 + row) * PROJW + 1792 + hd * 128 + qd * 32 + pc * 8), f);
      const float w = WS[row];
#pragma unroll
      for (int j = 0; j < 8; ++j) f[j] *= w;
      *(LAS u32x4*)(lds + 32768 + o) = pack8(f);
    }
    asm volatile("s_waitcnt vmcnt(0)" ::: "memory");
    __syncthreads();
    {
      const int d = tid & 127, part = tid >> 7;
      float acc = 0.f;
      for (int s2 = 0; s2 < 32; ++s2) {
        const int srow = part * 32 + s2;
        const bf16_t kv = *(const LAS bf16_t*)(lds + (d >> 5) * 8192 + srow * 64 + (d & 31) * 2);
        acc += WS[srow] * bf2f(kv);
      }
      NP[part * 128 + d] = acc;
    }
    const int eb = wid >> 1, db0 = 2 * (wid & 1);
    f32x16 u0, u1;
#pragma unroll
    for (int r = 0; r < 16; ++r) { u0[r] = 0.f; u1[r] = 0.f; }
#pragma unroll
    for (int ks = 0; ks < 8; ++ks) {
      const int rb = ks * 16 + 8 * hi;
      const bf16x8 a = cat44(vtr((lds_cptr)(lds + 32768 + trq_addr(lane, eb, rb))), vtr((lds_cptr)(lds + 32768 + trq_addr(lane, eb, rb + 4))));
      const bf16x8 b0 = cat44(vtr((lds_cptr)(lds + trq_addr(lane, db0, rb))), vtr((lds_cptr)(lds + trq_addr(lane, db0, rb + 4))));
      const bf16x8 b1 = cat44(vtr((lds_cptr)(lds + trq_addr(lane, db0 + 1, rb))), vtr((lds_cptr)(lds + trq_addr(lane, db0 + 1, rb + 4))));
      u0 = __builtin_amdgcn_mfma_f32_32x32x16_bf16(a, b0, u0, 0, 0, 0);
      u1 = __builtin_amdgcn_mfma_f32_32x32x16_bf16(a, b1, u1, 0, 0, 0);
    }
    float* U = p.Ubuf + ((size_t)chain * 17 + cc) * 16384;
#pragma unroll
    for (int r = 0; r < 16; ++r) {
      const int erow = eb * 32 + (r & 3) + 8 * (r >> 2) + 4 * hi;
      U[(size_t)erow * 128 + db0 * 32 + r32] = u0[r];
      U[(size_t)erow * 128 + (db0 + 1) * 32 + r32] = u1[r];
    }
    __syncthreads();
    if (tid < 128) p.NLb[((size_t)chain * 17 + cc) * 128 + tid] = NP[tid] + NP[128 + tid] + NP[256 + tid] + NP[384 + tid];
  }
  __syncthreads();
}

__device__ __forceinline__ void ph_mlstm_scan(const Params& p, int bskip) {
  const int bsk = lgdim() > bskip ? bskip : 0;
  if (lbid() < bsk) return;
  const size_t gtid = (size_t)(lbid() - bsk) * NTHR + ltid(), gsz = (size_t)(lgdim() - bsk) * NTHR;
  for (size_t it = gtid; it < (size_t)64 * 8192; it += gsz) {
    const int chain = (int)(it >> 13), ed = (int)(it & 8191) * 2;
    float c0 = 0.f, c1 = 0.f;
    for (int c = 0; c < 17; ++c) {
      const float dec = p.cDEC[chain * 18 + c];
      const float2 u = *(const float2*)(p.Ubuf + ((size_t)chain * 17 + c) * 16384 + ed);
      c0 = dec * c0 + u.x; c1 = dec * c1 + u.y;
      *(unsigned*)(p.Cbf + ((size_t)chain * 18 + c + 1) * 16384 + ed) = cvt_pk_bf16(c0, c1);
    }
  }
  for (size_t it = gtid; it < (size_t)64 * 128; it += gsz) {
    const int chain = (int)(it >> 7), d = (int)(it & 127);
    float nv = 0.f;
    for (int c = 0; c < 17; ++c) {
      nv = p.cDEC[chain * 18 + c] * nv + p.NLb[((size_t)chain * 17 + c) * 128 + d];
      p.NVb[((size_t)chain * 18 + c + 1) * 128 + d] = nv;
    }
  }
}

__device__ __forceinline__ void ph_mlstm_h(const Params& p, int l, bool ctx_out, LAS unsigned char* lds) {
  const int e2 = l >> 1;
  const int tid = ltid(), lane = tid & 63, r32 = lane & 31, hi = lane >> 5;
  const int wid = __builtin_amdgcn_readfirstlane(tid >> 6);
  const int tb = wid & 3, dir = wid >> 2;
  LAS float* HX = (LAS float*)(lds);
  LAS float* GC = (LAS float*)(lds + 131072);
  const int j0 = ctx_out ? 0 : 2, nj = 18 - j0;
  for (int unit = lbid(); unit < 32 * nj; unit += lgdim()) {
    const int bh = unit / nj, j = j0 + unit % nj, b = bh >> 2, hd = bh & 3;
    const int row0 = (j < 2) ? NL + b * 256 + j * 128 : b * 2048 + (j - 2) * 128;
    const int cc = dir ? (j < 2 ? 1 - j : 19 - j) : j;
    const int chain = b * 8 + hd * 2 + dir;
    __syncthreads();
#pragma unroll
    for (int n = 0; n < 4; ++n) {
      const int ii = wid * 4 + n;
      { const int ch = ii >> 1, rh = ii & 1;
        const bf16_t* src = p.km + (size_t)(row0 + rh * 64 + lane) * 512 + hd * 128 + ch * 8;
        __builtin_amdgcn_global_load_lds((const unsigned*)src, (LAS unsigned*)(lds + ch * 2048 + rh * 1024), 16, 0, 0); }
      { const int qd = ii >> 3, rg = ii & 7;
        const bf16_t* src = p.proj + (size_t)(row0 + rg * 16 + (lane >> 2)) * PROJW + 1792 + hd * 128 + qd * 32 + (lane & 3) * 8;
        __builtin_amdgcn_global_load_lds((const unsigned*)src, (LAS unsigned*)(lds + 32768 + qd * 8192 + rg * 1024), 16, 0, 0); }
    }
#pragma unroll
    for (int n = 0; n < 8; ++n) {
      const int ii2 = wid * 8 + n, dd = ii2 >> 5, ch = (ii2 & 31) >> 1, rh = ii2 & 1;
      const int ccd = dd ? (j < 2 ? 1 - j : 19 - j) : j;
      if (ccd > 0) {
        const bf16_t* src = p.Cbf + ((size_t)(b * 8 + hd * 2 + dd) * 18 + ccd) * 16384 + (size_t)(rh * 64 + lane) * 128 + ch * 8;
        __builtin_amdgcn_global_load_lds((const unsigned*)src, (LAS unsigned*)(lds + 65536 + dd * 32768 + ch * 2048 + rh * 1024), 16, 0, 0);
      }
    }
    if (tid < 256) GC[tid] = p.gsG[(size_t)(row0 + (tid & 127)) * 8 + (tid >> 7) * 4 + hd];
    const int trow = row0 + tb * 32 + r32;
    bf16x8 qf[8];
#pragma unroll
    for (int ks = 0; ks < 8; ++ks) qf[ks] = *(const bf16x8*)(p.qm + (size_t)trow * 512 + hd * 128 + ks * 16 + hi * 8);
    const float R2 = p.gsR[(size_t)trow * 8 + dir * 4 + hd], BQ2 = p.gsB[(size_t)trow * 8 + dir * 4 + hd];
    const float MIN2 = p.cMIN[chain * 18 + cc];
    f32x16 acc[4];
#pragma unroll
    for (int eb = 0; eb < 4; ++eb)
#pragma unroll
      for (int r = 0; r < 16; ++r) acc[eb][r] = 0.f;
    float nq = 0.f;
    if (cc > 0) {
      const float* nvp = p.NVb + ((size_t)chain * 18 + cc) * 128 + hi * 8;
#pragma unroll
      for (int ks = 0; ks < 8; ++ks) {
        const f32x4 n0 = *(const f32x4*)(nvp + ks * 16), n1 = *(const f32x4*)(nvp + ks * 16 + 4);
        float qv[8];
        unpack8(__builtin_bit_cast(u32x4, qf[ks]), qv);
        nq += n0[0] * qv[0] + n0[1] * qv[1] + n0[2] * qv[2] + n0[3] * qv[3] + n1[0] * qv[4] + n1[1] * qv[5] + n1[2] * qv[6] + n1[3] * qv[7];
      }
      nq = half_swap_add(nq);
    }
    const float winter = __builtin_amdgcn_exp2f(MIN2 + R2);
    asm volatile("s_waitcnt vmcnt(0)" ::: "memory");
    __syncthreads();
    if (cc > 0) {
#pragma unroll
      for (int eb = 0; eb < 4; ++eb)
#pragma unroll
        for (int ks = 0; ks < 8; ++ks) {
          const bf16x8 a = *(const LAS bf16x8*)(lds + 65536 + dir * 32768 + (2 * ks + hi) * 2048 + (eb * 32 + r32) * 16);
          acc[eb] = __builtin_amdgcn_mfma_f32_32x32x16_bf16(a, qf[ks], acc[eb], 0, 0, 0);
        }
#pragma unroll
      for (int eb = 0; eb < 4; ++eb)
#pragma unroll
        for (int r = 0; r < 16; ++r) acc[eb][r] *= winter;
    }
    float sw = 0.f;
    const int sb_lo = dir ? tb : 0, sb_hi = dir ? 3 : tb;
    for (int sb = sb_lo; sb <= sb_hi; ++sb) {
      f32x16 st;
#pragma unroll
      for (int r = 0; r < 16; ++r) st[r] = 0.f;
#pragma unroll
      for (int ks = 0; ks < 8; ++ks) {
        const bf16x8 kf = *(const LAS bf16x8*)(lds + (2 * ks + hi) * 2048 + (sb * 32 + r32) * 16);
        st = __builtin_amdgcn_mfma_f32_32x32x16_bf16(kf, qf[ks], st, 0, 0, 0);
      }
      const bool diag = (sb == tb);
#pragma unroll
      for (int g4 = 0; g4 < 4; ++g4) {
        const f32x4 gc = *(const LAS f32x4*)(GC + dir * 128 + sb * 32 + 8 * g4 + 4 * hi);
#pragma unroll
        for (int q = 0; q < 4; ++q) {
          const int sl = 8 * g4 + 4 * hi + q;
          float w = __builtin_amdgcn_exp2f(R2 + gc[q]) * st[4 * g4 + q];
          const bool keep = !diag || (dir ? (sl >= r32) : (sl <= r32));
          w = keep ? w : 0.f;
          sw += w;
          st[4 * g4 + q] = w;
        }
      }
      u32x4 p0, p1;
      p0.x = cvt_pk_bf16(st[0], st[1]); p0.y = cvt_pk_bf16(st[2], st[3]); p0.z = cvt_pk_bf16(st[4], st[5]); p0.w = cvt_pk_bf16(st[6], st[7]);
      p1.x = cvt_pk_bf16(st[8], st[9]); p1.y = cvt_pk_bf16(st[10], st[11]); p1.z = cvt_pk_bf16(st[12], st[13]); p1.w = cvt_pk_bf16(st[14], st[15]);
      const bf16x8 pw0 = __builtin_bit_cast(bf16x8, p0), pw1 = __builtin_bit_cast(bf16x8, p1);
#pragma unroll
      for (int eb = 0; eb < 4; ++eb) {
        const int rb = sb * 32 + 4 * hi;
        const bf16x8 a0 = cat44(vtr((lds_cptr)(lds + 32768 + trq_addr(lane, eb, rb))), vtr((lds_cptr)(lds + 32768 + trq_addr(lane, eb, rb + 8))));
        const bf16x8 a1 = cat44(vtr((lds_cptr)(lds + 32768 + trq_addr(lane, eb, rb + 16))), vtr((lds_cptr)(lds + 32768 + trq_addr(lane, eb, rb + 24))));
        acc[eb] = __builtin_amdgcn_mfma_f32_32x32x16_bf16(a0, pw0, acc[eb], 0, 0, 0);
        acc[eb] = __builtin_amdgcn_mfma_f32_32x32x16_bf16(a1, pw1, acc[eb], 0, 0, 0);
      }
    }
    sw = half_swap_add(sw);
    const float den = winter * nq + sw;
    const float dn = fmaxf(fabsf(den), __builtin_amdgcn_exp2f(R2 - BQ2));
    const float idn = 1.f / dn;
    __syncthreads();
    if (dir == 1) {
#pragma unroll
      for (int eb = 0; eb < 4; ++eb)
#pragma unroll
        for (int r = 0; r < 16; ++r) HX[(tb * 128 + eb * 32 + (r & 3) + 8 * (r >> 2) + 4 * hi) * 32 + r32] = acc[eb][r] * idn;
    }
    __syncthreads();
    if (dir == 0) {
      float ss = 0.f;
#pragma unroll
      for (int eb = 0; eb < 4; ++eb)
#pragma unroll
        for (int r = 0; r < 16; ++r) {
          const float v = acc[eb][r] * idn + HX[(tb * 128 + eb * 32 + (r & 3) + 8 * (r >> 2) + 4 * hi) * 32 + r32];
          acc[eb][r] = v; ss += v * v;
        }
      ss = half_swap_add(ss);
      const float inv = rsqrtf(ss * (1.f / 128.f) + EPS);
      const float* gh = p.g_hnorm + e2 * 512 + hd * 128;
      const bf16_t* obp = p.proj + (size_t)trow * PROJW + 2304 + hd * 128;
      bf16_t* op = p.mix + (size_t)trow * 1024 + 512 + hd * 128;
#pragma unroll
      for (int eb = 0; eb < 4; ++eb)
#pragma unroll
        for (int g4 = 0; g4 < 4; ++g4) {
          const int e0 = eb * 32 + 8 * g4 + 4 * hi;
          const f32x4 gv = *(const f32x4*)(gh + e0);
          const u32x2 ow = *(const u32x2*)(obp + e0);
          const float ob0 = __uint_as_float(ow.x << 16), ob1 = __uint_as_float(ow.x & 0xffff0000u), ob2 = __uint_as_float(ow.y << 16), ob3 = __uint_as_float(ow.y & 0xffff0000u);
          const float v0 = acc[eb][4 * g4 + 0] * inv * gv[0] * sigmoidf_(ob0), v1 = acc[eb][4 * g4 + 1] * inv * gv[1] * sigmoidf_(ob1);
          const float v2 = acc[eb][4 * g4 + 2] * inv * gv[2] * sigmoidf_(ob2), v3 = acc[eb][4 * g4 + 3] * inv * gv[3] * sigmoidf_(ob3);
          u32x2 w; w.x = cvt_pk_bf16(v0, v1); w.y = cvt_pk_bf16(v2, v3);
          *(u32x2*)(op + e0) = w;
        }
    }
  }
  __syncthreads();
}

__device__ __forceinline__ void ph_topk(const Params& p, bool ctx, float* sm) {
  const int tid = ltid(), lane = tid & 63, wv = tid >> 6;
  unsigned* cnt = (unsigned*)sm;
  unsigned* pre = (unsigned*)sm + 32;
  int* sel = (int*)sm + 64;
  const int ncol = ctx ? 256 : 128;
  for (int colu = lbid(); colu < ncol; colu += lgdim()) {
    int e, base, n, cap; size_t mbase;
    if (colu < 128) { const int b = colu >> 4; e = colu & 15; base = b * 2048; n = 2048; cap = 256; mbase = (size_t)e * 2048 + (size_t)b * 256; }
    else { const int c2 = colu - 128, b = c2 >> 4; e = c2 & 15; base = NL + b * 256; n = 256; cap = 32; mbase = (size_t)MOE_L + (size_t)e * 256 + (size_t)b * 32; }
    unsigned v[4];
#pragma unroll
    for (int k = 0; k < 4; ++k) { const int i = tid * 4 + k; v[k] = i < n ? __float_as_uint(p.aff[(size_t)(base + i) * 16 + e]) : 0u; }
    unsigned thr = 0u;
    for (int bit = 30; bit >= 0; --bit) {
      const unsigned cand = thr | (1u << bit);
      unsigned c = (v[0] >= cand) + (v[1] >= cand) + (v[2] >= cand) + (v[3] >= cand);
#pragma unroll
      for (int o = 32; o > 0; o >>= 1) c += __shfl_xor(c, o);
      unsigned* cb = cnt + (bit & 1) * 8;
      if (lane == 0) cb[wv] = c;
      __syncthreads();
      const unsigned tot = cb[0] + cb[1] + cb[2] + cb[3] + cb[4] + cb[5] + cb[6] + cb[7];
      if (tot >= (unsigned)cap) thr = cand;
    }
    unsigned ngt = (v[0] > thr) + (v[1] > thr) + (v[2] > thr) + (v[3] > thr);
    unsigned neq = (v[0] == thr) + (v[1] == thr) + (v[2] == thr) + (v[3] == thr);
    unsigned igt = ngt, ieq = neq;
#pragma unroll
    for (int o = 1; o < 64; o <<= 1) { const unsigned a = __shfl_up(igt, o), b2 = __shfl_up(ieq, o); if (lane >= o) { igt += a; ieq += b2; } }
    __syncthreads();
    if (lane == 63) { pre[wv] = igt; pre[8 + wv] = ieq; }
    __syncthreads();
    unsigned totgt = 0, offgt = 0, offeq = 0;
#pragma unroll
    for (int w2 = 0; w2 < 8; ++w2) { const unsigned a = pre[w2], b2 = pre[8 + w2]; totgt += a; if (w2 < wv) { offgt += a; offeq += b2; } }
    const unsigned need_eq = (unsigned)cap - totgt;
    unsigned egt = offgt + igt - ngt, eeq = offeq + ieq - neq;
#pragma unroll
    for (int k = 0; k < 4; ++k) {
      const int i = tid * 4 + k;
      const bool gt = v[k] > thr, eq = v[k] == thr;
      const bool take = gt || (eq && eeq < need_eq);
      if (i < n) {
        const int r = base + i;
        const unsigned slot = egt + (eeq < need_eq ? eeq : need_eq);
        if (take) { p.slotmap[(size_t)r * 16 + e] = (int)slot; p.rowidx[mbase + slot] = r; p.gatev[mbase + slot] = __uint_as_float(v[k]); sel[slot] = r; }
        else p.slotmap[(size_t)r * 16 + e] = -1;
      }
      egt += gt; eeq += eq;
    }
    __syncthreads();
    for (int sl0 = wv * 4; sl0 < cap; sl0 += (NTHR / 64) * 4) {
      u32x4 a[4], b2[4];
#pragma unroll
      for (int q = 0; q < 4; ++q) {
        const int r = sel[sl0 + q];
        const u32x4* src = (const u32x4*)(p.hbuf + (size_t)r * 1024);
        a[q] = src[lane]; b2[q] = src[64 + lane];
      }
#pragma unroll
      for (int q = 0; q < 4; ++q) {
        u32x4* dst = (u32x4*)(p.Xs + (mbase + sl0 + q) * 1024);
        dst[lane] = a[q]; dst[64 + lane] = b2[q];
      }
    }
    __syncthreads();
  }
}

template <int W>
__device__ __forceinline__ void pool_item(const Params& p, int r, int c8) {
  int t, n;
  if (r < NL) { t = r & 2047; n = 2048; } else { t = (r - NL) & 255; n = 256; }
  constexpr int lo = W / 2;
  const bf16_t* up = p.proj + (size_t)r * 1024 + c8;
  u32x4 raw[W];
  int cnt = 0;
#pragma unroll
  for (int k = 0; k < W; ++k) {
    const int tt = t - lo + k;
    const bool ok = tt >= 0 && tt < n;
    raw[k] = ok ? *(const u32x4*)(up + (ptrdiff_t)(k - lo) * 1024) : (u32x4){0u, 0u, 0u, 0u};
    cnt += ok ? 1 : 0;
  }
  float s8[8], f[8], uc[8];
#pragma unroll
  for (int j = 0; j < 8; ++j) s8[j] = 0.f;
#pragma unroll
  for (int k = 0; k < W; ++k) {
    unpack8(raw[k], f);
#pragma unroll
    for (int j = 0; j < 8; ++j) s8[j] += f[j];
  }
  unpack8(raw[lo], uc);
  const float ic = 1.f / (float)cnt;
#pragma unroll
  for (int j = 0; j < 8; ++j) f[j] = s8[j] * ic - uc[j];
  *(u32x4*)(p.mix + (size_t)r * 1024 + c8) = pack8(f);
}
__device__ __forceinline__ void ph_pool(const Params& p, int nrows) {
  const size_t gtid = (size_t)lbid() * NTHR + ltid(), gsz = (size_t)lgdim() * NTHR;
  for (size_t it = gtid; it < (size_t)nrows * 128; it += gsz) {
    const int g = (int)(it / ((size_t)nrows * 32));
    const size_t rem = it - (size_t)g * nrows * 32;
    const int r = (int)(rem >> 5), c8 = g * 256 + (int)(rem & 31) * 8;
    if (g == 0) pool_item<2>(p, r, c8);
    else if (g == 1) pool_item<4>(p, r, c8);
    else if (g == 2) pool_item<8>(p, r, c8);
    else pool_item<16>(p, r, c8);
  }
}

enum { PH_INIT = 0, PH_NORM1, PH_GEMM_IN_EVEN, PH_POST_EVEN, PH_ATT, PH_MLSTM_U, PH_MLSTM_SCAN, PH_MLSTM_H, PH_GEMM_OUT, PH_NORM2, PH_TOPK, PH_GATHER,
       PH_MOE_GU, PH_MOE_D, PH_GEMM_IN_ODD, PH_POOL, PH_GEMM_GRP, PH_FINAL };

typedef const __attribute__((address_space(4))) Params* KParams;
__device__ __forceinline__ const Params& get_params() {
  KParams kp = (KParams)__builtin_amdgcn_kernarg_segment_ptr();
  asm volatile("" : "+s"(kp));
  return *(const Params*)kp;
}
__device__ __forceinline__ int idle_slots(int nu, int G, int c) {
  const int mx = (nu + G - 1) / G, mine = c < nu ? (nu - c + G - 1) / G : 0;
  return mx - mine;
}
__device__ __forceinline__ void run_phase(int ph, int l, unsigned char* shm) {
  const Params& p = get_params();
  float* sm = (float*)shm;
  LAS unsigned char* lds = (LAS unsigned char*)shm;
  const bool ctx_next = (l < 2);
  const bool ctx_used = (l < 3);
  const int G = lgdim(), c = lbid();
  switch (ph) {
    case PH_INIT: ph_init(p, sm); break;
    case PH_NORM1: {
      const int ncomb = (l == 0) ? 0 : ((l - 1) < 2 ? NT : NL);
      ph_norm(p, l, 1, ctx_used ? NT : NL, ncomb, l - 1, sm);
    } break;
    case PH_GEMM_IN_EVEN: {
      g8::SchedDense S{(const char*)p.hbuf, (const char*)(p.WinE + (size_t)(l >> 1) * PROJW * 1024), 1024, 1024, NT / 256, PROJW / 256, 0, G, c};
      g8::EpiBf16 E{p.proj, PROJW};
      g8::gemm_phase(lds, 1024, 1024, 1024, S, E);
      conv_quota(p, idle_slots(S.nM * S.nN, G, c) * 3, sm);
    } break;
    case PH_POST_EVEN: ph_post_even(p, l, sm); break;
    case PH_MLSTM_U: ph_mlstm_u(p, lds); break;
    case PH_ATT: ph_att(p, ctx_next, lds); ph_mlstm_scan(p, ctx_next ? 64 : 0); conv_quota(p, idle_slots(512 + (ctx_next ? 64 : 0), G, c) * 6, sm); break;
    case PH_MLSTM_H: ph_mlstm_h(p, l, ctx_next, lds); conv_quota(p, idle_slots(32 * (ctx_next ? 18 : 16), G, c) * 3, sm); break;
    case PH_GEMM_OUT: {
      g8::SchedDense S{(const char*)p.mix, (const char*)(p.WoutE + (size_t)(l >> 1) * 1024 * 1024), 1024, 1024, (ctx_next ? NT : NL) / 256, 4, 0, G, c};
      g8::EpiResid E{p.xcur, p.mod + (size_t)l * 9 * 6144 + 2 * 1024, nullptr, l == 0 ? p.x : nullptr, p.ctx};
      g8::gemm_phase(lds, 1024, 1024, 1024, S, E);
      conv_quota(p, idle_slots(S.nM * S.nN, G, c) * 3, sm);
    } break;
    case PH_NORM2: ph_norm(p, l, 2, ctx_next ? NT : NL, 0, 0, sm); break;
    case PH_TOPK: ph_topk(p, ctx_next, sm); conv_until(p, l == 0 ? CE4 : (l == 1 ? CE7 : (l == 2 ? CE10 : CE11)), sm); break;
    case PH_MOE_GU: {
      g8::SchedMoe S{(const char*)p.Xs, (const char*)(p.Wgu + (size_t)l * NEXP * 2048 * 1024), 8, 2048, 128, ctx_next ? 1152 : 1024, G, c};
      g8::EpiSwiGLU E{p.Abuf};
      g8::gemm_phase(lds, 1024, 1024, 1024, S, E);
      conv_quota(p, idle_slots(S.nu, G, c) * 3, sm);
    } break;
    case PH_MOE_D: {
      g8::SchedMoe S{(const char*)p.Abuf, (const char*)(p.Wd + (size_t)l * NEXP * 1024 * 1024), 4, 1024, 256, ctx_next ? 576 : 512, G, c};
      g8::EpiDown E{p.Ybuf, p.gatev};
      g8::gemm_phase(lds, 1024, 1024, 1024, S, E);
      conv_quota(p, idle_slots(S.nu, G, c) * 3, sm);
    } break;
    case PH_GEMM_IN_ODD: {
      g8::SchedDense S{(const char*)p.hbuf, (const char*)(p.WinO + (size_t)(l >> 1) * 1024 * 1024), 1024, 1024, (ctx_next ? NT : NL) / 256, 4, 0, G, c};
      g8::EpiBf16 E{p.proj, 1024};
      g8::gemm_phase(lds, 1024, 1024, 1024, S, E);
      conv_quota(p, idle_slots(S.nM * S.nN, G, c) * 3, sm);
    } break;
    case PH_POOL: ph_pool(p, ctx_next ? NT : NL); break;
    case PH_GEMM_GRP: {
      g8::SchedDense S{(const char*)p.mix, (const char*)(p.Wgrp + (size_t)(l >> 1) * 1024 * 256), 1024, 256, (ctx_next ? NT : NL) / 256, 4, 512, G, c};
      g8::EpiResid E{p.xcur, p.mod + (size_t)l * 9 * 6144 + 2 * 1024, p.s_pool + (size_t)(l >> 1) * 1024, nullptr, nullptr};
      g8::gemm_phase(lds, 256, 1024, 256, S, E);
      conv_quota(p, idle_slots(S.nM * S.nN, G, c) * 1, sm);
    } break;
    case PH_FINAL: ph_norm(p, 3, 3, NL, NL, 3, sm); break;
  }
}

__global__ void __launch_bounds__(NTHR) mega_kernel(Params p) {
  extern __shared__ __attribute__((aligned(16))) unsigned char shm[];
  cg::grid_group grid = cg::this_grid();
  volatile LAS unsigned* st = (volatile LAS unsigned*)((LAS unsigned char*)shm + g8::STAGE_BYTES + 1536);
  if (threadIdx.x < 2) st[threadIdx.x] = 0u;
  __syncthreads();
  unsigned* barw;
  { const Params& q = get_params(); barw = q.barw; }
  const XcdBarrier xb = xcd_barrier_post(barw, st);
  const int nprog = p.nprog;
  for (int i = 0; i < nprog; ++i) {
    int ph, l;
    { const Params& q = get_params(); ph = q.prog_ph[i]; l = q.prog_l[i]; }
    run_phase(ph, l, shm);
    if (i + 1 < nprog) { if (i == 0) grid.sync(); else xcd_barrier(xb); }
  }
}

extern "C" void kernel_launch(void* const* d_in, const int* in_sizes, int n_in, void* d_out, int out_size, void* d_ws, size_t ws_size,
                              hipStream_t stream) {
  Params p{};
  const float* const* in = (const float* const*)d_in;
  p.x = in[0]; p.c = in[1]; p.ctx = in[2]; p.c_ctx = in[3]; p.w_mod = in[4]; p.b_mod = in[5]; p.g_norm1 = in[6]; p.g_norm2 = in[7];
  p.w_in_even = in[8]; p.w_out_even = in[9]; p.g_qnorm = in[10]; p.g_knorm = in[11]; p.w_conv = in[12]; p.b_gate = in[13];
  p.g_hnorm = in[14]; p.w_in_odd = in[15]; p.w_pool_grp = in[16]; p.s_pool = in[17]; p.w_router = in[18]; p.w_exp_gate = in[19];
  p.w_exp_up = in[20]; p.w_exp_down = in[21]; p.g_final = in[22];
  p.out = (float*)d_out;
  char* w = (char*)d_ws;
  size_t off = 0;
  auto take = [&](size_t bytes) { char* r = w + off; off += (bytes + 255) & ~(size_t)255; return (void*)r; };
  p.xcur = (float*)take((size_t)NT * 1024 * 4);
  p.mod = (float*)take(4 * 9 * 6144 * 4);
  p.hbuf = (bf16_t*)take((size_t)NT * 1024 * 2);
  p.Ybuf = (bf16_t*)take((size_t)MOE_T * 1024 * 2);
  p.gatev = (float*)take(MOE_T * 4);
  p.rowidx = (int*)take(MOE_T * 4);
  p.slotmap = (int*)take((size_t)NT * 16 * 4);
  p.barw = (unsigned*)take(XCD_BAR_WORDS * 4);
  p.aff = (float*)take((size_t)NT * 16 * 4);
  p.gates = (float*)take((size_t)NT * 16 * 4);
  p.WinE = (bf16_t*)take((size_t)2 * PROJW * 1024 * 2);
  p.WoutE = (bf16_t*)take((size_t)2 * 1024 * 1024 * 2);
  p.WinO = (bf16_t*)take((size_t)2 * 1024 * 1024 * 2);
  p.Wgrp = (bf16_t*)take((size_t)2 * 1024 * 256 * 2);
  p.Wgu = (bf16_t*)take((size_t)4 * NEXP * 2048 * 1024 * 2);
  p.Wd = (bf16_t*)take((size_t)4 * NEXP * 1024 * 1024 * 2);
  const size_t uoff = off;
  p.proj = (bf16_t*)take((size_t)NT * PROJW * 2);
  p.Qb = (bf16_t*)take((size_t)NT * 512 * 2);
  p.Kb = (bf16_t*)take((size_t)NB * 2 * 2304 * 64 * 2);
  p.Vb = (bf16_t*)take((size_t)NB * 2 * 2304 * 64 * 2);
  p.qm = (bf16_t*)take((size_t)NT * 512 * 2);
  p.km = (bf16_t*)take((size_t)NT * 512 * 2);
  p.gsG = (float*)take((size_t)NT * 8 * 4);
  p.gsR = (float*)take((size_t)NT * 8 * 4);
  p.gsB = (float*)take((size_t)NT * 8 * 4);
  p.cMIN = (float*)take(64 * 18 * 4);
  p.cE1 = (float*)take(64 * 18 * 4);
  p.cDEC = (float*)take(64 * 18 * 4);
  p.Ubuf = (float*)take((size_t)64 * 17 * 16384 * 4);
  p.NLb = (float*)take((size_t)64 * 17 * 128 * 4);
  p.NVb = (float*)take((size_t)64 * 18 * 128 * 4);
  p.Cbf = (bf16_t*)take((size_t)64 * 18 * 16384 * 2);
  p.mix = (bf16_t*)take((size_t)NT * 1024 * 2);
  const size_t uend = off;
  off = uoff;
  p.Xs = (bf16_t*)take((size_t)MOE_T * 1024 * 2);
  p.Abuf = (bf16_t*)take((size_t)MOE_T * 1024 * 2);
  if (off < uend) off = uend;
  if (off > ws_size) { fprintf(stderr, "ws too small: need %zu have %zu\n", off, ws_size); return; }

  int n = 0;
  auto add = [&](int ph, int l) { p.prog_ph[n] = (unsigned char)ph; p.prog_l[n] = (unsigned char)l; ++n; };
  add(PH_INIT, 0);
  for (int l = 0; l < 4; ++l) {
    add(PH_NORM1, l);
    if ((l & 1) == 0) {
      add(PH_GEMM_IN_EVEN, l); add(PH_POST_EVEN, l); add(PH_MLSTM_U, l); add(PH_ATT, l); add(PH_MLSTM_H, l); add(PH_GEMM_OUT, l);
    } else {
      add(PH_GEMM_IN_ODD, l); add(PH_POOL, l); add(PH_GEMM_GRP, l);
    }
    add(PH_NORM2, l); add(PH_TOPK, l); add(PH_MOE_GU, l); add(PH_MOE_D, l);
  }
  add(PH_FINAL, 0);
  p.nprog = n;

  const int LDS = g8::STAGE_BYTES + 2048;
  static int grid_blocks = 0;
  if (!grid_blocks) {
    (void)hipFuncSetAttribute((const void*)mega_kernel, hipFuncAttributeMaxDynamicSharedMemorySize, LDS);
    int dev = 0, cus = 0, per_cu = 0;
    (void)hipGetDevice(&dev);
    (void)hipDeviceGetAttribute(&cus, hipDeviceAttributeMultiprocessorCount, dev);
    (void)hipOccupancyMaxActiveBlocksPerMultiprocessor(&per_cu, mega_kernel, NTHR, LDS);
    if (per_cu < 1) per_cu = 1;
    if (per_cu > 1) per_cu = 1;
    grid_blocks = cus * per_cu;
  }
  (void)hipMemsetAsync(p.barw, 0, XCD_BAR_WORDS * 4, stream);
  void* args[] = {&p};
  hipError_t e = hipLaunchCooperativeKernel((void*)mega_kernel, dim3(grid_blocks), dim3(NTHR), args, LDS, stream);
  if (e != hipSuccess) fprintf(stderr, "cooperative launch failed: %s (grid %d)\n", hipGetErrorString(e), grid_blocks);
}
```

```cpp
#include <hip/hip_runtime.h>
#include <hip/hip_cooperative_groups.h>
#include <math.h>
#include <stdio.h>
namespace cg = cooperative_groups;

#define DM 1024
#define NB 8
#define SEQ 2048
#define CTXL 256
#define NL (NB * SEQ)
#define NC (NB * CTXL)
#define NT (NL + NC)
#define EVEN_IN 2832
#define PROJW 2816
#define NEXP 16
#define MOE_L (NEXP * NB * 256)
#define MOE_C (NEXP * NB * 32)
#define MOE_T (MOE_L + MOE_C)
#define EPS 1e-6f
#define NTHR 512
#define LAS __attribute__((address_space(3)))

typedef unsigned short bf16_t;
typedef short bf16x8 __attribute__((ext_vector_type(8)));
typedef float f32x4 __attribute__((ext_vector_type(4)));
typedef unsigned u32x4 __attribute__((ext_vector_type(4)));
typedef unsigned u32x2 __attribute__((ext_vector_type(2)));

struct Params {
  const float *x, *c, *ctx, *c_ctx, *w_mod, *b_mod, *g_norm1, *g_norm2, *w_in_even, *w_out_even, *g_qnorm, *g_knorm,
      *w_conv, *b_gate, *g_hnorm, *w_in_odd, *w_pool_grp, *s_pool, *w_router, *w_exp_gate, *w_exp_up, *w_exp_down, *g_final;
  float* out;
  float *xcur, *mod, *gates, *aff, *gatev, *gsG, *gsR, *gsB, *cMIN, *cE1, *cDEC, *cBE, *cGM, *Ubuf, *NLb, *NVb;
  bf16_t *hbuf, *proj, *mix, *Xs, *Abuf, *Ybuf, *Qb, *Kb, *Vb, *qm, *km, *Cbf, *ybuf;
  bf16_t *WinE, *WoutE, *WinO, *Wgrp, *Wgu, *Wd;
  int *rowidx, *slotmap;
  unsigned* barw;
  int nprog;
  unsigned char prog_ph[60], prog_l[60];
};

__device__ __forceinline__ float siluf(float v) { return v / (1.f + expf(-v)); }
__device__ __forceinline__ float sigmoidf_(float v) { return 1.f / (1.f + expf(-v)); }
__device__ __forceinline__ float logsigmoidf_(float v) { return fminf(v, 0.f) - log1pf(expf(-fabsf(v))); }
__device__ __forceinline__ float wave_sum(float v) {
#pragma unroll
  for (int o = 32; o > 0; o >>= 1) v += __shfl_xor(v, o);
  return v;
}
__device__ __forceinline__ int modrow(int r) { return r < NL ? (r >> 11) : 8; }
__device__ __forceinline__ float bf2f(bf16_t v) { return __uint_as_float(((unsigned)v) << 16); }
typedef float f32x2_t __attribute__((ext_vector_type(2)));
typedef __bf16 bf16x2_t __attribute__((ext_vector_type(2)));
__device__ __forceinline__ unsigned cvt_pk_bf16(float lo, float hi) {
  const f32x2_t v = {lo, hi};
  return __builtin_bit_cast(unsigned, __builtin_convertvector(v, bf16x2_t));
}
__device__ __forceinline__ bf16_t f2bf(float f) { return (bf16_t)(cvt_pk_bf16(f, 0.f) & 0xffffu); }
__device__ __forceinline__ void unpack8(const u32x4 w, float (&f)[8]) {
  f[0] = __uint_as_float(w.x << 16); f[1] = __uint_as_float(w.x & 0xffff0000u); f[2] = __uint_as_float(w.y << 16); f[3] = __uint_as_float(w.y & 0xffff0000u);
  f[4] = __uint_as_float(w.z << 16); f[5] = __uint_as_float(w.z & 0xffff0000u); f[6] = __uint_as_float(w.w << 16); f[7] = __uint_as_float(w.w & 0xffff0000u);
}
__device__ __forceinline__ u32x4 pack8(const float (&f)[8]) {
  u32x4 w; w.x = cvt_pk_bf16(f[0], f[1]); w.y = cvt_pk_bf16(f[2], f[3]); w.z = cvt_pk_bf16(f[4], f[5]); w.w = cvt_pk_bf16(f[6], f[7]);
  return w;
}

__device__ __forceinline__ int ltid() { int t = threadIdx.x; asm volatile("" : "+v"(t)); return t; }
__device__ __forceinline__ int lbid() { int b = blockIdx.x; asm volatile("" : "+s"(b)); return b; }
__device__ __forceinline__ int lgdim() { int g = gridDim.x; asm volatile("" : "+s"(g)); return g; }

#define XB_TMO      128
#define XB_XCNT(j)  (256  + 64 * (j))
#define XB_XSUB(j)  (1280 + 64 * (j))
#define XB_XGEN(j)  (2304 + 64 * (j))
#define XB_TOP      3328
#define XB_TOPGEN   3392
#define XCD_BAR_WORDS 3456
#define XB_SPIN_CAP (1u << 18)
__device__ __forceinline__ unsigned xb_ld(unsigned* p)              { return __hip_atomic_load(p, __ATOMIC_RELAXED, __HIP_MEMORY_SCOPE_AGENT); }
__device__ __forceinline__ unsigned xb_add(unsigned* p, unsigned v) { return __hip_atomic_fetch_add(p, v, __ATOMIC_RELAXED, __HIP_MEMORY_SCOPE_AGENT); }
__device__ __forceinline__ unsigned xb_xcc_id() { return (unsigned)__builtin_amdgcn_s_getreg((3 << 11) | 20) & 0xFu; }
#define XB_SPIN(cond, bar) do { unsigned _sp = 0; while (cond) { __builtin_amdgcn_s_sleep(1); \
    if ((++_sp & 255u) == 0u) { if (xb_ld(&(bar)[XB_TMO])) break; if (_sp > XB_SPIN_CAP) { atomicAdd(&(bar)[XB_TMO], 1u); break; } } } } while (0)
struct XcdBarrier { unsigned* bar; unsigned x; volatile LAS unsigned* st; };
__device__ __forceinline__ XcdBarrier xcd_barrier_post(unsigned* bar, volatile LAS unsigned* st) {
  XcdBarrier b; b.bar = bar; b.x = xb_xcc_id(); b.st = st;
  if (threadIdx.x == 0) (void)xb_add(&bar[XB_XCNT(b.x)], 1u);
  return b;
}
__device__ __forceinline__ void xcd_barrier_complete(unsigned* bar, unsigned x, unsigned& nloc, unsigned& nx) {
  const unsigned G = gridDim.x * gridDim.y * gridDim.z;
  unsigned sum, cnt, mine, sp = 0u;
  for (;;) {
    sum = 0u; cnt = 0u; mine = 0u;
#pragma unroll
    for (unsigned j = 0; j < 16; ++j) { const unsigned c = xb_ld(&bar[XB_XCNT(j)]); sum += c; cnt += (c > 0u) ? 1u : 0u; mine = (j == x) ? c : mine; }
    if (sum == G) break;
    __builtin_amdgcn_s_sleep(1);
    if ((++sp & 255u) == 0u) { if (xb_ld(&bar[XB_TMO])) break; if (sp > XB_SPIN_CAP) { atomicAdd(&bar[XB_TMO], 1u); break; } }
  }
  nloc = mine > 0u ? mine : 1u; nx = cnt > 0u ? cnt : 1u;
}
__device__ __forceinline__ void xcd_barrier(const XcdBarrier& b) {
  asm volatile("s_waitcnt vmcnt(0)" ::: "memory");
  __syncthreads();
  if (threadIdx.x == 0) {
    unsigned* bar = b.bar;
    __builtin_amdgcn_s_waitcnt(0);
    unsigned nloc = b.st[0], nx = b.st[1];
    if (nloc == 0u) { xcd_barrier_complete(bar, b.x, nloc, nx); b.st[0] = nloc; b.st[1] = nx; }
    const unsigned old = xb_add(&bar[XB_XSUB(b.x)], 1u);
    const unsigned gen = old / nloc;
    if (old + 1u == (gen + 1u) * nloc) {
      __builtin_amdgcn_fence(__ATOMIC_RELEASE, "agent");
      asm volatile("s_waitcnt vmcnt(0)" ::: "memory");
      const unsigned og = xb_add(&bar[XB_TOP], 1u);
      const unsigned tg = og / nx;
      if (og + 1u == (tg + 1u) * nx) xb_add(&bar[XB_TOPGEN], 1u);
      else XB_SPIN(xb_ld(&bar[XB_TOPGEN]) == tg, bar);
      __builtin_amdgcn_fence(__ATOMIC_ACQUIRE, "agent");
      xb_add(&bar[XB_XGEN(b.x)], 1u);
      asm volatile("s_waitcnt vmcnt(0)" ::: "memory");
    } else {
      XB_SPIN(xb_ld(&bar[XB_XGEN(b.x)]) == gen, bar);
      __builtin_amdgcn_fence(__ATOMIC_ACQUIRE, "agent");
      asm volatile("s_waitcnt vmcnt(0)" ::: "memory");
    }
  }
  __syncthreads();
}

namespace g8 {
constexpr int BM = 256, BK = 64, HALF = 128, HTB = HALF * BK * 2, STAGE_BYTES = 8 * HTB;
__device__ __forceinline__ int lds_byte(int r, int c) { const int st = (r >> 4) * 2 + (c >> 5), rr = r & 15, cc = c & 31, ob = rr * 64 + cc * 2; return st * 1024 + (ob ^ (((ob >> 9) & 1) << 5)); }
__device__ __forceinline__ void stage_rc(int b, int& R, int& C) { const int st = b / 1024, sb = b % 1024, swz = sb ^ (((sb >> 9) & 1) << 5); R = (st >> 1) * 16 + swz / 64; C = (st & 1) * 32 + (swz % 64) / 2; }
__device__ __forceinline__ int perm32(int rho) { const int n = rho >> 4, i = rho & 15; return 8 * (i >> 2) + 4 * n + (i & 3); }

struct Unit { const char* A; const char* B; int row0, col0; };

template <bool GATHER = false, class Epi, class Sched>
__device__ __forceinline__ void gemm_phase(LAS unsigned char* lds, const int K, const int lda, const int ldb, const Sched& S, const Epi& E, const int* gidx = nullptr, const char* gbaseA = nullptr) {
  const int tid = ltid(), wid = __builtin_amdgcn_readfirstlane(tid >> 6), lane = tid & 63, wr = wid >> 2, wc = wid & 3, fr = lane & 15, fq = lane >> 4;
  const int nt = K / BK;
  unsigned voffA[2], voffB[2], gC2[2];
  int gR[2];
#pragma unroll
  for (int i = 0; i < 2; ++i) {
    int R, C;
    stage_rc(tid * 16 + i * 8192, R, C);
    const int Rb = (R & ~31) + perm32(R & 31);
    voffA[i] = (unsigned)(R * lda + C) * 2u;
    voffB[i] = (unsigned)(Rb * ldb + C) * 2u;
    gR[i] = R; gC2[i] = (unsigned)C * 2u;
  }
  unsigned gcur[2][2], gnxt[2][2];
  auto gload = [&](int row0, unsigned (&g)[2][2]) {
#pragma unroll
    for (int h = 0; h < 2; ++h)
#pragma unroll
      for (int i = 0; i < 2; ++i) g[h][i] = (unsigned)gidx[row0 + h * HALF + gR[i]] * (unsigned)(lda * 2) + gC2[i];
  };
  const size_t kstep = (size_t)(BK * 2);
  const size_t hstepA = (size_t)HALF * lda * 2, hstepB = (size_t)HALF * ldb * 2;
  const unsigned ldsw = (unsigned)wid * 1024u;
  const int aoff = lds_byte(wr * 64 + fr, fq * 8), boff = lds_byte(wc * 32 + fr, fq * 8);
#define PG8_SA(b, h) (((b) * 2 + (h)) * HTB)
#define PG8_SB(b, h) ((4 + (b) * 2 + (h)) * HTB)
#define PG8_STAGE(bufoff, gbase, voff) do { _Pragma("unroll") for (int _i = 0; _i < 2; ++_i) \
    __builtin_amdgcn_global_load_lds((const unsigned*)((const char*)(gbase) + (voff)[_i]), (LAS unsigned*)(lds + (bufoff) + ldsw + _i * 8192), 16, 0, 0); } while (0)
#define PG8_LDA(dst, b, h) do { _Pragma("unroll") for (int m = 0; m < 4; ++m) _Pragma("unroll") for (int k = 0; k < 2; ++k) dst[m][k] = *(const LAS bf16x8*)(lds + PG8_SA(b, h) + aoff + m * 2048 + k * 1024); } while (0)
#define PG8_LDB(dst, b, h) do { _Pragma("unroll") for (int n = 0; n < 2; ++n) _Pragma("unroll") for (int k = 0; k < 2; ++k) dst[n][k] = *(const LAS bf16x8*)(lds + PG8_SB(b, h) + boff + n * 2048 + k * 1024); } while (0)
#define PG8_MMA(ai, bj, At, Bt) do { __builtin_amdgcn_s_setprio(1); _Pragma("unroll") for (int m = 0; m < 4; ++m) _Pragma("unroll") for (int n = 0; n < 2; ++n) _Pragma("unroll") for (int k = 0; k < 2; ++k) \
    acc[ai][bj][m][n] = __builtin_amdgcn_mfma_f32_16x16x32_bf16(Bt[n][k], At[m][k], acc[ai][bj][m][n], 0, 0, 0); __builtin_amdgcn_s_setprio(0); } while (0)
#define PG8_WAIT_V(n) asm volatile("s_waitcnt vmcnt(" #n ")" ::: "memory")
#define PG8_WAIT_L(n) asm volatile("s_waitcnt lgkmcnt(" #n ")" ::: "memory")
#define PG8_BAR __builtin_amdgcn_s_barrier()
#define PG8_SCHED __builtin_amdgcn_sched_barrier(0)
#define PG8_STAGE_A(bufoff, nextu, half, kbytes) do { \
    if constexpr (GATHER) { if (nextu) PG8_STAGE(bufoff, gbaseA + (kbytes), gnxt[half]); else PG8_STAGE(bufoff, gbaseA + (kbytes), gcur[half]); } \
    else { PG8_STAGE(bufoff, ((nextu) ? nA : cA) + (half) * hstepA + (kbytes), voffA); } } while (0)
  Unit cur, nxt;
  int ui = 0;
  if (!S.next(0, cur)) return;
  f32x4 acc[2][2][4][2];
#pragma unroll
  for (int a = 0; a < 2; ++a)
#pragma unroll
    for (int b = 0; b < 2; ++b)
#pragma unroll
      for (int m = 0; m < 4; ++m)
#pragma unroll
        for (int n = 0; n < 2; ++n) acc[a][b][m][n] = (f32x4){0.f, 0.f, 0.f, 0.f};
  bf16x8 At[4][2], B0[2][2], B1[2][2];
  const char* cA = cur.A;
  const char* cB = cur.B;
  const char* nA = cA;
  if constexpr (GATHER) { gload(cur.row0, gcur); gload(cur.row0, gnxt); asm volatile("s_waitcnt vmcnt(0)" ::: "memory"); }
  PG8_STAGE(PG8_SB(0, 0), cB, voffB); PG8_STAGE(PG8_SB(0, 1), cB + hstepB, voffB); PG8_STAGE_A(PG8_SA(0, 0), false, 0, 0); PG8_STAGE_A(PG8_SA(0, 1), false, 1, 0);
  if (wr == 1) PG8_BAR;
  PG8_WAIT_V(2); PG8_BAR;
  PG8_STAGE(PG8_SB(1, 0), cB + kstep, voffB); PG8_STAGE_A(PG8_SA(1, 0), false, 0, kstep); PG8_STAGE(PG8_SB(1, 1), cB + hstepB + kstep, voffB);
  PG8_WAIT_V(6); PG8_BAR;
  for (;;) {
    const bool has_next = S.next(ui + 1, nxt);
    nA = has_next ? nxt.A : cA;
    const char* nB = has_next ? nxt.B : cB;
    if constexpr (GATHER) { if (has_next) gload(nxt.row0, gnxt); else {
#pragma unroll
      for (int h = 0; h < 2; ++h)
#pragma unroll
        for (int i = 0; i < 2; ++i) gnxt[h][i] = gcur[h][i]; } }
    for (int t = 0; t < nt; t += 2) {
      const bool last = (t == nt - 2);
      const size_t k1 = (size_t)(t + 1) * kstep;
      const size_t k2 = last ? 0 : (size_t)(t + 2) * kstep;
      const size_t k3 = k2 + kstep;
      const char* b2 = last ? nB : cB + (size_t)(t + 2) * kstep;
      const char* b3 = b2 + kstep;
      PG8_LDB(B0, 0, 0); PG8_LDB(B1, 0, 1); PG8_SCHED; PG8_LDA(At, 0, 0); PG8_STAGE_A(PG8_SA(1, 1), false, 1, k1);
      PG8_WAIT_V(8); PG8_WAIT_L(0); PG8_BAR; PG8_MMA(0, 0, At, B0); PG8_MMA(0, 1, At, B1); PG8_BAR; PG8_SCHED;
      PG8_LDA(At, 0, 1); PG8_STAGE(PG8_SB(0, 0), b2, voffB); PG8_STAGE(PG8_SB(0, 1), b2 + hstepB, voffB); PG8_STAGE_A(PG8_SA(0, 0), last, 0, k2);
      PG8_WAIT_V(8); PG8_WAIT_L(0); PG8_BAR; PG8_MMA(1, 0, At, B0); PG8_MMA(1, 1, At, B1); PG8_BAR; PG8_SCHED;
      PG8_LDB(B0, 1, 0); PG8_LDB(B1, 1, 1); PG8_SCHED; PG8_LDA(At, 1, 0); PG8_STAGE_A(PG8_SA(0, 1), last, 1, k2);
      PG8_WAIT_V(8); PG8_WAIT_L(0); PG8_BAR; PG8_MMA(0, 0, At, B0); PG8_MMA(0, 1, At, B1); PG8_BAR; PG8_SCHED;
      PG8_LDA(At, 1, 1); PG8_STAGE(PG8_SB(1, 0), b3, voffB); PG8_STAGE(PG8_SB(1, 1), b3 + hstepB, voffB); PG8_STAGE_A(PG8_SA(1, 0), last, 0, k3);
      PG8_WAIT_V(8); PG8_WAIT_L(0); PG8_BAR; PG8_MMA(1, 0, At, B0); PG8_MMA(1, 1, At, B1); PG8_BAR; PG8_SCHED;
    }
    if (wr == 0) PG8_BAR;
    E(acc, cur, wr, wc, fr, fq);
    if (!has_next) break;
#pragma unroll
    for (int a = 0; a < 2; ++a)
#pragma unroll
      for (int b = 0; b < 2; ++b)
#pragma unroll
        for (int m = 0; m < 4; ++m)
#pragma unroll
          for (int n = 0; n < 2; ++n) acc[a][b][m][n] = (f32x4){0.f, 0.f, 0.f, 0.f};
    cur = nxt; cA = nA; cB = nB; ++ui;
    if constexpr (GATHER) {
#pragma unroll
      for (int h = 0; h < 2; ++h)
#pragma unroll
        for (int i = 0; i < 2; ++i) gcur[h][i] = gnxt[h][i];
    }
    if (wr == 1) PG8_BAR;
  }
  PG8_WAIT_V(0);
  PG8_BAR;
#undef PG8_SA
#undef PG8_SB
#undef PG8_STAGE
#undef PG8_STAGE_A
#undef PG8_LDA
#undef PG8_LDB
#undef PG8_MMA
#undef PG8_WAIT_V
#undef PG8_WAIT_L
#undef PG8_BAR
#undef PG8_SCHED
}

struct SchedDense {
  const char* A; const char* B; int lda, ldb, nM, nN, acolstep, G, c;
  __device__ __forceinline__ bool next(int i, Unit& u) const {
    const int nwg = nM * nN;
    const long L = (long)i * G + c;
    if (L >= nwg) return false;
    int wgid = (int)L;
    { const int q = nwg / 8, r = nwg % 8, xcd = wgid % 8, off = wgid / 8; wgid = (xcd < r ? xcd * (q + 1) : r * (q + 1) + (xcd - r) * q) + off; }
    const int nig = 8 * nN, gid = wgid / nig, fm = gid * 8, gsz = (nM - fm) < 8 ? (nM - fm) : 8;
    const int pm = fm + ((wgid % nig) % gsz), pn = (wgid % nig) / gsz;
    u.A = A + (size_t)pm * 256 * lda * 2 + (size_t)pn * acolstep;
    u.B = B + (size_t)pn * 256 * ldb * 2;
    u.row0 = pm * 256; u.col0 = pn * 256;
    return true;
  }
};
struct SchedMoe {
  const char* A; const char* W; int ncol, wrows, colw, nu, G, c;
  __device__ __forceinline__ bool next(int i, Unit& u) const {
    const long L = (long)i * G + c;
    if (L >= nu) return false;
    const int wgid = (int)(L % 8) * (nu / 8) + (int)(L / 8);
    const int UL = 128 * ncol;
    int e, pn, row0;
    if (wgid < UL) { e = wgid / (8 * ncol); const int rem = wgid % (8 * ncol); row0 = e * 2048 + (rem % 8) * 256; pn = rem / 8; }
    else { const int w2 = wgid - UL; e = w2 / ncol; pn = w2 % ncol; row0 = MOE_L + e * 256; }
    u.A = A + (size_t)row0 * 1024 * 2;
    u.B = W + ((size_t)e * wrows + (size_t)pn * 256) * 1024 * 2;
    u.row0 = row0; u.col0 = pn * colw;
    return true;
  }
};

struct EpiBf16 {
  bf16_t* O; int ldo;
  __device__ __forceinline__ void operator()(const f32x4 (&acc)[2][2][4][2], const Unit& u, int wr, int wc, int fr, int fq) const {
#pragma unroll
    for (int ai = 0; ai < 2; ++ai)
#pragma unroll
      for (int m = 0; m < 4; ++m) {
        const int row = u.row0 + ai * 128 + wr * 64 + m * 16 + fr;
        bf16_t* rp = O + (size_t)row * ldo + u.col0 + wc * 32 + 8 * fq;
#pragma unroll
        for (int bj = 0; bj < 2; ++bj) {
          const f32x4 v0 = acc[ai][bj][m][0], v1 = acc[ai][bj][m][1];
          u32x4 w; w.x = cvt_pk_bf16(v0[0], v0[1]); w.y = cvt_pk_bf16(v0[2], v0[3]); w.z = cvt_pk_bf16(v1[0], v1[1]); w.w = cvt_pk_bf16(v1[2], v1[3]);
          *(u32x4*)(rp + bj * 128) = w;
        }
      }
  }
};
struct EpiResid {
  float* x; const float* modg; const float* cs; const float* xl; const float* xc;
  __device__ __forceinline__ void operator()(const f32x4 (&acc)[2][2][4][2], const Unit& u, int wr, int wc, int fr, int fq) const {
#pragma unroll
    for (int ai = 0; ai < 2; ++ai)
#pragma unroll
      for (int m = 0; m < 4; ++m) {
        const int row = u.row0 + ai * 128 + wr * 64 + m * 16 + fr;
        const int c0 = u.col0 + wc * 32 + 8 * fq;
        float* xp = x + (size_t)row * 1024 + c0;
        const float* xi = xl ? (row < NL ? xl + (size_t)row * 1024 + c0 : xc + (size_t)(row - NL) * 1024 + c0) : xp;
        const float* gp = modg + (size_t)modrow(row) * 6144 + c0;
#pragma unroll
        for (int bj = 0; bj < 2; ++bj) {
          f32x4 g0 = *(const f32x4*)(gp + bj * 128), g1 = *(const f32x4*)(gp + bj * 128 + 4);
          if (cs) { g0 *= *(const f32x4*)(cs + c0 + bj * 128); g1 *= *(const f32x4*)(cs + c0 + bj * 128 + 4); }
          f32x4 x0 = *(const f32x4*)(xi + bj * 128), x1 = *(const f32x4*)(xi + bj * 128 + 4);
          x0 += g0 * acc[ai][bj][m][0]; x1 += g1 * acc[ai][bj][m][1];
          *(f32x4*)(xp + bj * 128) = x0; *(f32x4*)(xp + bj * 128 + 4) = x1;
        }
      }
  }
};
struct EpiSwiGLU {
  bf16_t* O;
  __device__ __forceinline__ void operator()(const f32x4 (&acc)[2][2][4][2], const Unit& u, int wr, int wc, int fr, int fq) const {
#pragma unroll
    for (int ai = 0; ai < 2; ++ai)
#pragma unroll
      for (int m = 0; m < 4; ++m) {
        const int row = u.row0 + ai * 128 + wr * 64 + m * 16 + fr;
        bf16_t* rp = O + (size_t)row * 1024 + u.col0 + wc * 32 + 8 * fq;
        float o[8];
#pragma unroll
        for (int n = 0; n < 2; ++n)
#pragma unroll
          for (int j = 0; j < 4; ++j) { const float g = acc[ai][0][m][n][j], up = acc[ai][1][m][n][j]; o[n * 4 + j] = g / (1.f + __expf(-g)) * up; }
        u32x4 w; w.x = cvt_pk_bf16(o[0], o[1]); w.y = cvt_pk_bf16(o[2], o[3]); w.z = cvt_pk_bf16(o[4], o[5]); w.w = cvt_pk_bf16(o[6], o[7]);
        *(u32x4*)rp = w;
      }
  }
};
struct EpiDown {
  bf16_t* O; const float* gatev;
  __device__ __forceinline__ void operator()(const f32x4 (&acc)[2][2][4][2], const Unit& u, int wr, int wc, int fr, int fq) const {
#pragma unroll
    for (int ai = 0; ai < 2; ++ai)
#pragma unroll
      for (int m = 0; m < 4; ++m) {
        const int row = u.row0 + ai * 128 + wr * 64 + m * 16 + fr;
        const float gv = gatev[row];
        bf16_t* rp = O + (size_t)row * 1024 + u.col0 + wc * 32 + 8 * fq;
#pragma unroll
        for (int bj = 0; bj < 2; ++bj) {
          const f32x4 v0 = acc[ai][bj][m][0] * gv, v1 = acc[ai][bj][m][1] * gv;
          u32x4 w; w.x = cvt_pk_bf16(v0[0], v0[1]); w.y = cvt_pk_bf16(v0[2], v0[3]); w.z = cvt_pk_bf16(v1[0], v1[1]); w.w = cvt_pk_bf16(v1[2], v1[3]);
          *(u32x4*)(rp + bj * 128) = w;
        }
      }
  }
};
}

#define NT_WINE 1408
#define NT_WOUT 512
#define NT_WINO 512
#define NT_WGRP 128
#define NT_EXP 16384
#define NT_ALL (NT_WINE + NT_WOUT + NT_WINO + NT_WGRP + 3 * NT_EXP)
#define CE0 704
#define CE1 960
#define CE2 13248
#define CE3 13504
#define CE4 13568
#define CE5 25856
#define CE6 26560
#define CE7 26816
#define CE8 39104
#define CE9 39360
#define CE10 39424
#define CE11 51712
__device__ __forceinline__ void conv_batch(const Params& p, int t, float* T) {
  const int tid = ltid(), lane = tid & 63, wv = tid >> 6;
  const float* src; bf16_t* dst; int ld, dK, k0, n0;
  int seg, tb, e, which = 0;
  if (t < CE0) { seg = 0; e = 0; tb = t; } else if (t < CE1) { seg = 1; e = 0; tb = t - CE0; } else if (t < CE2) { seg = 2; e = 0; tb = t - CE1; }
  else if (t < CE3) { seg = 3; e = 0; tb = t - CE2; } else if (t < CE4) { seg = 4; e = 0; tb = t - CE3; } else if (t < CE5) { seg = 2; e = 1; tb = t - CE4; }
  else if (t < CE6) { seg = 0; e = 1; tb = t - CE5; } else if (t < CE7) { seg = 1; e = 1; tb = t - CE6; } else if (t < CE8) { seg = 2; e = 2; tb = t - CE7; }
  else if (t < CE9) { seg = 3; e = 1; tb = t - CE8; } else if (t < CE10) { seg = 4; e = 1; tb = t - CE9; } else { seg = 2; e = 3; tb = t - CE10; }
  int dbase = 0;
  if (seg == 0) {
    k0 = (tb / 44) * 64; n0 = (tb % 44) * 64;
    src = p.w_in_even + (size_t)e * 1024 * EVEN_IN; ld = EVEN_IN; dst = p.WinE + (size_t)e * PROJW * 1024; dK = 1024;
  } else if (seg == 1 || seg == 3) {
    k0 = (tb / 16) * 64; n0 = (tb % 16) * 64;
    src = (seg == 3 ? p.w_in_odd : p.w_out_even) + (size_t)e * 1024 * 1024; ld = 1024; dst = (seg == 3 ? p.WinO : p.WoutE) + (size_t)e * 1024 * 1024; dK = 1024;
  } else if (seg == 4) {
    const int g = tb / 16; k0 = ((tb % 16) / 4) * 64; n0 = (tb % 4) * 64;
    src = p.w_pool_grp + (size_t)(e * 4 + g) * 65536; ld = 256; dst = p.Wgrp + (size_t)e * 1024 * 256; dK = 256; dbase = g * 256;
  } else {
    which = tb / 4096; const int r = tb % 4096, le = e * 16 + r / 256; k0 = ((r % 256) / 16) * 64; n0 = (r % 16) * 64;
    const float* base = which == 0 ? p.w_exp_gate : (which == 1 ? p.w_exp_up : p.w_exp_down);
    src = base + (size_t)le * 1024 * 1024; ld = 1024; dK = 1024;
    dst = which < 2 ? p.Wgu + (size_t)le * 2048 * 1024 : p.Wd + (size_t)le * 1024 * 1024;
  }
  const bool gu = (seg == 2 && which < 2);
  float4 v[8];
#pragma unroll
  for (int q = 0; q < 8; ++q) {
    const int idx = tid + q * NTHR, k = idx >> 6, c4 = idx & 63;
    v[q] = *(const float4*)(src + (size_t)(k0 + k) * ld + n0 + c4 * 4);
  }
#pragma unroll
  for (int q = 0; q < 8; ++q) {
    const int idx = tid + q * NTHR, k = idx >> 6, c4 = idx & 63;
    float* tp = T + k * 257 + c4 * 4;
    tp[0] = v[q].x; tp[1] = v[q].y; tp[2] = v[q].z; tp[3] = v[q].w;
  }
  __syncthreads();
#pragma unroll
  for (int sub = 0; sub < 4; ++sub) {
    const int nl = wv * 8 + (lane >> 3), kq = lane & 7, nn = n0 + sub * 64;
    const int drow0 = gu ? (nn >> 7) * 256 + which * 128 + (nn & 127) : dbase + nn;
    float f[8];
#pragma unroll
    for (int j = 0; j < 8; ++j) f[j] = T[(kq * 8 + j) * 257 + sub * 64 + nl];
    u32x4 w; w.x = cvt_pk_bf16(f[0], f[1]); w.y = cvt_pk_bf16(f[2], f[3]); w.z = cvt_pk_bf16(f[4], f[5]); w.w = cvt_pk_bf16(f[6], f[7]);
    *(u32x4*)(dst + (size_t)(drow0 + nl) * dK + k0 + kq * 8) = w;
  }
}
__device__ __forceinline__ int conv_pull(const Params& p, float* sm) {
  __syncthreads();
  if (ltid() == 0) ((int*)sm)[16500] = (int)__hip_atomic_fetch_add(p.barw, 4u, __ATOMIC_RELAXED, __HIP_MEMORY_SCOPE_AGENT);
  __syncthreads();
  return ((int*)sm)[16500];
}
__device__ __forceinline__ void conv_until(const Params& p, int end, float* sm) {
  int t;
  do { t = conv_pull(p, sm); if (t < CE11) conv_batch(p, t, sm); } while (t + 4 < end);
  __syncthreads();
}
__device__ __forceinline__ void conv_quota(const Params& p, int n, float* sm) {
  for (int i = 0; i < n; ++i) { const int t = conv_pull(p, sm); if (t >= CE11) break; conv_batch(p, t, sm); }
  __syncthreads();
}

__device__ __forceinline__ void ph_init(const Params& p, float* sm) {
  const int tid = ltid(), lane = tid & 63, wv = tid >> 6;
  const size_t gtid = (size_t)lbid() * NTHR + tid, gsz = (size_t)lgdim() * NTHR;
  for (int i = tid; i < 9 * 1024; i += NTHR) {
    const int r = i >> 10, k = i & 1023;
    sm[i] = siluf(r < 8 ? p.c[r * 1024 + k] : p.c_ctx[k]);
  }
  __syncthreads();
  float* part = sm + 9 * 1024;
  for (int item = lbid(); item < 768; item += lgdim()) {
    const int l = item / 192, j0 = (item % 192) * 32;
    const int col = lane & 31, kh = lane >> 5;
    const float* w = p.w_mod + (size_t)l * 1024 * 6144 + j0 + col;
    float acc[9];
#pragma unroll
    for (int r = 0; r < 9; ++r) acc[r] = 0.f;
    const int kb = wv * 128 + kh * 64;
#pragma unroll 4
    for (int kk = 0; kk < 64; ++kk) {
      const float wvv = w[(size_t)(kb + kk) * 6144];
#pragma unroll
      for (int r = 0; r < 9; ++r) acc[r] += sm[r * 1024 + kb + kk] * wvv;
    }
#pragma unroll
    for (int r = 0; r < 9; ++r) part[((wv * 2 + kh) * 9 + r) * 32 + col] = acc[r];
    __syncthreads();
    if (tid < 288) {
      const int r = tid >> 5, cc = tid & 31;
      float s = 0.f;
#pragma unroll
      for (int sl = 0; sl < 16; ++sl) s += part[(sl * 9 + r) * 32 + cc];
      p.mod[(size_t)(l * 9 + r) * 6144 + j0 + cc] = s + p.b_mod[l * 6144 + j0 + cc];
    }
    __syncthreads();
  }
  conv_until(p, CE1, sm);
}

typedef float f32x4m __attribute__((ext_vector_type(4)));
__device__ __forceinline__ void ph_norm(const Params& p, int l, int which, int nrows, int ncomb, int lprev, float* sm) {
  const int tid = ltid(), lane = tid & 63, wv = tid >> 6;
  const bool skinny = (which == 2) || (which == 1 && (l & 1) == 0);
  bf16_t* HROW = (bf16_t*)sm;
  float* PART = sm + 8192;
  bf16x8 Bhi[4], Blo[4];
  if (skinny) {
    const float* wbase; int stride;
    if (which == 2) { wbase = p.w_router + (size_t)l * 1024 * 16; stride = 16; }
    else { wbase = p.w_in_even + (size_t)(l >> 1) * 1024 * EVEN_IN + PROJW; stride = EVEN_IN; }
    const int kg = lane >> 4, n = lane & 15;
#pragma unroll
    for (int ks = 0; ks < 4; ++ks) {
      float f[8], hi[8], lo[8];
#pragma unroll
      for (int j = 0; j < 8; ++j) f[j] = wbase[(size_t)(wv * 128 + ks * 32 + kg * 8 + j) * stride + n];
      const u32x4 hw = pack8(f);
      unpack8(hw, hi);
#pragma unroll
      for (int j = 0; j < 8; ++j) lo[j] = f[j] - hi[j];
      Bhi[ks] = __builtin_bit_cast(bf16x8, hw);
      Blo[ks] = __builtin_bit_cast(bf16x8, pack8(lo));
    }
  }
  const int nwaves = lgdim() * (NTHR / 64), gw = lbid() * (NTHR / 64) + wv;
  const int per = (nrows + nwaves - 1) / nwaves;
  const int rbeg = gw * per, rend = min(nrows, rbeg + per);
  const bool in0 = (which == 1 && l == 0);
  float4 vn[4];
  int slvn = -1;
  {
    const int r0 = min(rbeg, nrows - 1);
    const float* xs0 = in0 ? (r0 < NL ? p.x + (size_t)r0 * DM : p.ctx + (size_t)(r0 - NL) * DM) : p.xcur + (size_t)r0 * DM;
#pragma unroll
    for (int i = 0; i < 4; ++i) vn[i] = ((const float4*)xs0)[i * 64 + lane];
    if (r0 < ncomb && lane < 16) slvn = p.slotmap[r0 * 16 + lane];
  }
  float4 cA[4], cB[4], cG[4], yn[4];
  int mr_c = -1;
  if (which == 2) {
    const u32x2* yp0 = (const u32x2*)(p.ybuf + (size_t)min(rbeg, nrows - 1) * DM);
#pragma unroll
    for (int i = 0; i < 4; ++i) { const u32x2 y = yp0[i * 64 + lane]; yn[i] = make_float4(__uint_as_float(y.x << 16), __uint_as_float(y.x & 0xffff0000u), __uint_as_float(y.y << 16), __uint_as_float(y.y & 0xffff0000u)); }
  }
  for (int it = 0; it < per; ++it) {
    const int rr = rbeg + it;
    const bool live = rr < rend;
    const int r = min(rr, nrows - 1);
    float4 v[4];
#pragma unroll
    for (int i = 0; i < 4; ++i) v[i] = vn[i];
    const int slv = slvn;
    float* xr = p.xcur + (size_t)r * DM;
    if (it + 1 < per) {
      const int rn = min(rr + 1, nrows - 1);
      const float* xsn = in0 ? (rn < NL ? p.x + (size_t)rn * DM : p.ctx + (size_t)(rn - NL) * DM) : p.xcur + (size_t)rn * DM;
#pragma unroll
      for (int i = 0; i < 4; ++i) vn[i] = ((const float4*)xsn)[i * 64 + lane];
      slvn = (rn < ncomb && lane < 16) ? p.slotmap[rn * 16 + lane] : -1;
    }
    const int mr = modrow(r);
    if (mr != mr_c) {
      mr_c = mr;
      if (which == 3) {
#pragma unroll
        for (int i = 0; i < 4; ++i) cA[i] = ((const float4*)p.g_final)[i * 64 + lane];
      } else {
        const float* gn = (which == 1 ? p.g_norm1 : p.g_norm2) + l * 1024;
        const float* mrow = p.mod + (size_t)(l * 9 + mr) * 6144;
        const float4* shp = (const float4*)(mrow + (which == 1 ? 0 : 3) * 1024);
        const float4* scp = (const float4*)(mrow + (which == 1 ? 1 : 4) * 1024);
#pragma unroll
        for (int i = 0; i < 4; ++i) {
          const float4 g = ((const float4*)gn)[i * 64 + lane], sc = scp[i * 64 + lane];
          cA[i] = make_float4(g.x * (1.f + sc.x), g.y * (1.f + sc.y), g.z * (1.f + sc.z), g.w * (1.f + sc.w));
          cB[i] = shp[i * 64 + lane];
        }
      }
      if (which == 2) {
        const float4* g2 = (const float4*)(p.mod + (size_t)(l * 9 + mr) * 6144 + 2 * 1024);
        const float4* spv = (const float4*)(p.s_pool + (size_t)(l >> 1) * 1024);
#pragma unroll
        for (int i = 0; i < 4; ++i) {
          float4 g = g2[i * 64 + lane];
          if (l & 1) { const float4 sp4 = spv[i * 64 + lane]; g.x *= sp4.x; g.y *= sp4.y; g.z *= sp4.z; g.w *= sp4.w; }
          cG[i] = g;
        }
      } else if (ncomb > 0) {
        const float4* g5 = (const float4*)(p.mod + (size_t)(lprev * 9 + mr) * 6144 + 5 * 1024);
#pragma unroll
        for (int i = 0; i < 4; ++i) cG[i] = g5[i * 64 + lane];
      }
    }
    if (live && r < ncomb) {
      float4 s4[4];
#pragma unroll
      for (int i = 0; i < 4; ++i) s4[i] = make_float4(0.f, 0.f, 0.f, 0.f);
      unsigned long long mask = __ballot(slv >= 0);
      while (mask) {
        const int e = __ffsll((long long)mask) - 1;
        mask &= mask - 1;
        const int sl = __shfl(slv, e);
        size_t yrow;
        if (r < NL) yrow = (size_t)e * 2048 + (size_t)(r >> 11) * 256 + sl;
        else yrow = (size_t)MOE_L + (size_t)e * 256 + (size_t)((r - NL) >> 8) * 32 + sl;
        const u32x2* yp = (const u32x2*)(p.Ybuf + yrow * DM);
#pragma unroll
        for (int i = 0; i < 4; ++i) {
          const u32x2 y = yp[i * 64 + lane];
          s4[i].x += __uint_as_float(y.x << 16); s4[i].y += __uint_as_float(y.x & 0xffff0000u);
          s4[i].z += __uint_as_float(y.y << 16); s4[i].w += __uint_as_float(y.y & 0xffff0000u);
        }
      }
#pragma unroll
      for (int i = 0; i < 4; ++i) {
        const float4 g = cG[i];
        v[i].x += g.x * s4[i].x; v[i].y += g.y * s4[i].y; v[i].z += g.z * s4[i].z; v[i].w += g.w * s4[i].w;
        if (which != 3) ((float4*)xr)[i * 64 + lane] = v[i];
      }
    }
    if (which == 2) {
      float4 yc[4];
#pragma unroll
      for (int i = 0; i < 4; ++i) yc[i] = yn[i];
      if (it + 1 < per) {
        const u32x2* ypn = (const u32x2*)(p.ybuf + (size_t)min(rr + 1, nrows - 1) * DM);
#pragma unroll
        for (int i = 0; i < 4; ++i) { const u32x2 y = ypn[i * 64 + lane]; yn[i] = make_float4(__uint_as_float(y.x << 16), __uint_as_float(y.x & 0xffff0000u), __uint_as_float(y.y << 16), __uint_as_float(y.y & 0xffff0000u)); }
      }
      const float* xin = (r < NL ? p.x + (size_t)r * DM : p.ctx + (size_t)(r - NL) * DM);
#pragma unroll
      for (int i = 0; i < 4; ++i) {
        if (l == 0) v[i] = ((const float4*)xin)[i * 64 + lane];
        v[i].x += cG[i].x * yc[i].x; v[i].y += cG[i].y * yc[i].y; v[i].z += cG[i].z * yc[i].z; v[i].w += cG[i].w * yc[i].w;
        if (live) ((float4*)xr)[i * 64 + lane] = v[i];
      }
    }
    float ss = 0.f;
#pragma unroll
    for (int i = 0; i < 4; ++i) ss += v[i].x * v[i].x + v[i].y * v[i].y + v[i].z * v[i].z + v[i].w * v[i].w;
    ss = wave_sum(ss);
    const float inv = rsqrtf(ss * (1.f / 1024.f) + EPS);
    if (which == 3) {
      if (live) {
#pragma unroll
        for (int i = 0; i < 4; ++i) {
          const float4 g = cA[i];
          ((float4*)(p.out + (size_t)r * DM))[i * 64 + lane] = make_float4(v[i].x * inv * g.x, v[i].y * inv * g.y, v[i].z * inv * g.z, v[i].w * inv * g.w);
        }
      }
      continue;
    }
#pragma unroll
    for (int i = 0; i < 4; ++i) {
      const float h0 = v[i].x * inv * cA[i].x + cB[i].x, h1 = v[i].y * inv * cA[i].y + cB[i].y;
      const float h2 = v[i].z * inv * cA[i].z + cB[i].z, h3 = v[i].w * inv * cA[i].w + cB[i].w;
      u32x2 w; w.x = cvt_pk_bf16(h0, h1); w.y = cvt_pk_bf16(h2, h3);
      if (live) ((u32x2*)(p.hbuf + (size_t)r * DM))[i * 64 + lane] = w;
      if (skinny) {
        const float l0 = h0 - __uint_as_float(w.x << 16), l1 = h1 - __uint_as_float(w.x & 0xffff0000u);
        const float l2 = h2 - __uint_as_float(w.y << 16), l3 = h3 - __uint_as_float(w.y & 0xffff0000u);
        u32x2 wl; wl.x = cvt_pk_bf16(l0, l1); wl.y = cvt_pk_bf16(l2, l3);
        ((u32x2*)(HROW + (wv * 2 + 0) * 1024))[i * 64 + lane] = w;
        ((u32x2*)(HROW + (wv * 2 + 1) * 1024))[i * 64 + lane] = wl;
      }
    }
    if (!skinny) continue;
    __syncthreads();
    {
      const int arow = lane & 7, kg = lane >> 4;
      f32x4m acc = {0.f, 0.f, 0.f, 0.f};
#pragma unroll
      for (int ks = 0; ks < 4; ++ks) {
        const bf16x8 ahi = *(const bf16x8*)(HROW + (arow * 2 + 0) * 1024 + wv * 128 + ks * 32 + kg * 8);
        const bf16x8 alo = *(const bf16x8*)(HROW + (arow * 2 + 1) * 1024 + wv * 128 + ks * 32 + kg * 8);
        acc = __builtin_amdgcn_mfma_f32_16x16x32_bf16(ahi, Bhi[ks], acc, 0, 0, 0);
        acc = __builtin_amdgcn_mfma_f32_16x16x32_bf16(ahi, Blo[ks], acc, 0, 0, 0);
        acc = __builtin_amdgcn_mfma_f32_16x16x32_bf16(alo, Bhi[ks], acc, 0, 0, 0);
      }
      if (kg < 2) {
#pragma unroll
        for (int q = 0; q < 4; ++q) PART[(wv * 8 + kg * 4 + q) * 16 + (lane & 15)] = acc[q];
      }
    }
    __syncthreads();
    {
      float v1 = 0.f;
      if (lane < 16) {
#pragma unroll
        for (int w2 = 0; w2 < 8; ++w2) v1 += PART[(w2 * 8 + wv) * 16 + lane];
      }
      if (which == 2) {
        float mx = v1;
        mx = fmaxf(mx, __shfl_xor(mx, 1)); mx = fmaxf(mx, __shfl_xor(mx, 2)); mx = fmaxf(mx, __shfl_xor(mx, 4)); mx = fmaxf(mx, __shfl_xor(mx, 8));
        const float ex = expf(v1 - mx);
        float sum = ex;
        sum += __shfl_xor(sum, 1); sum += __shfl_xor(sum, 2); sum += __shfl_xor(sum, 4); sum += __shfl_xor(sum, 8);
        if (live && lane < 16) p.aff[(size_t)r * 16 + lane] = ex / sum;
      } else {
        float gvv = v1 + p.b_gate[(l >> 1) * 16 + (lane & 15)];
        if ((lane >> 2) & 1) gvv = logsigmoidf_(gvv);
        if (live && lane < 16) p.gates[(size_t)r * 16 + lane] = gvv;
      }
    }
  }
  __syncthreads();
}

#define LOG2E 1.4426950408889634f
__device__ __forceinline__ int chain_row(int b, int dir, int p) {
  if (p < 256) { const int t = dir ? 255 - p : p; return NL + b * 256 + t; }
  const int q = p - 256; const int t = dir ? 2047 - q : q; return b * 2048 + t;
}
__device__ __forceinline__ float wave_incl_sum(float v, int lane) {
#pragma unroll
  for (int o = 1; o < 64; o <<= 1) { const float t = __shfl_up(v, o); if (lane >= o) v += t; }
  return v;
}
__device__ __forceinline__ float wave_incl_max(float v, int lane) {
#pragma unroll
  for (int o = 1; o < 64; o <<= 1) { const float t = __shfl_up(v, o); if (lane >= o) v = fmaxf(v, t); }
  return v;
}
__device__ __forceinline__ void ph_post_even(const Params& p, int l, float* sm) {
  const int e = l >> 1;
  const int tid = ltid(), lane = tid & 63;
  __syncthreads();
  for (int idx = tid; idx < 1024; idx += NTHR) {
    const int pos = idx >> 4, i = idx & 15;
    const float ang = (float)pos * exp2f(-(float)i * (13.287712379549449f / 16.f));
    float sn, cs;
    sincosf(ang, &sn, &cs);
    sm[2 * idx] = cs; sm[2 * idx + 1] = sn;
  }
  if (tid < 128) sm[2048 + tid] = tid < 64 ? p.g_qnorm[e * 64 + tid] : p.g_knorm[e * 64 + tid - 64];
  for (int idx = tid; idx < 3072; idx += NTHR) sm[2304 + idx] = p.w_conv[(size_t)e * 3 * 1024 + idx];
  __syncthreads();
  const int bid = lbid(), G = lgdim();
  const bool scanner = false;
  const size_t gtid = (size_t)bid * NTHR + tid, gsz = (size_t)G * NTHR;
  if (!scanner) {
  for (size_t it = gtid; it < (size_t)NT * 10; it += gsz) {
    const int r = (int)(it / 10), hh = (int)(it % 10);
    const bool lat = r < NL;
    const int t = r & 2047;
    const int bb = lat ? (r >> 11) : ((r - NL) >> 8);
    const int key = lat ? 256 + t : ((r - NL) & 255);
    const bf16_t* src; bf16_t* dst; const float* g; float osc;
    if (hh < 8) { src = p.proj + (size_t)r * PROJW + hh * 64; dst = p.Qb + (size_t)r * 512 + hh * 64; g = sm + 2048; osc = 0.125f * LOG2E; }
    else { src = p.proj + (size_t)r * PROJW + 512 + (hh - 8) * 64; dst = p.Kb + ((size_t)(bb * 2 + (hh - 8)) * 2304 + key) * 64; g = sm + 2048 + 64; osc = 1.f;
           const u32x4* vs = (const u32x4*)(p.proj + (size_t)r * PROJW + 640 + (hh - 8) * 64);
           u32x4* vd = (u32x4*)(p.Vb + ((size_t)(bb * 2 + (hh - 8)) * 2304 + key) * 64);
#pragma unroll
           for (int q = 0; q < 8; ++q) vd[q] = vs[q]; }
    float x[64];
#pragma unroll
    for (int q = 0; q < 8; ++q) { float f[8]; unpack8(((const u32x4*)src)[q], f);
#pragma unroll
      for (int j = 0; j < 8; ++j) x[q * 8 + j] = f[j]; }
    float ss = 0.f;
#pragma unroll
    for (int j = 0; j < 64; ++j) ss += x[j] * x[j];
    const float inv = rsqrtf(ss * (1.f / 64.f) + EPS) * osc;
#pragma unroll
    for (int j = 0; j < 64; ++j) x[j] *= inv * g[j];
    if (lat) {
#pragma unroll
      for (int a = 0; a < 2; ++a) {
        const int pos = (a == 0) ? (t >> 6) : (t & 63);
#pragma unroll
        for (int i = 0; i < 16; ++i) {
          const float2 cssn = *(const float2*)(sm + 2 * (pos * 16 + i));
          const float x1 = x[a * 32 + i], x2 = x[a * 32 + 16 + i];
          x[a * 32 + i] = x1 * cssn.x - x2 * cssn.y;
          x[a * 32 + 16 + i] = x2 * cssn.x + x1 * cssn.y;
        }
      }
    }
#pragma unroll
    for (int q = 0; q < 8; ++q) { float f[8];
#pragma unroll
      for (int j = 0; j < 8; ++j) f[j] = x[q * 8 + j];
      ((u32x4*)dst)[q] = pack8(f); }
  }
  const float* wc = sm + 2304;
  for (size_t it0 = gtid; it0 < (size_t)NT * 128; it0 += 4 * gsz) {
    u32x4 rc[4], rm[4], rp[4];
#pragma unroll
    for (int u = 0; u < 4; ++u) {
      const size_t it = it0 + (size_t)u * gsz;
      const size_t itc = it < (size_t)NT * 128 ? it : it0;
      const int r = (int)(itc >> 7), c8 = (int)(itc & 127) * 8;
      int t, n;
      if (r < NL) { t = r & 2047; n = 2048; } else { t = (r - NL) & 255; n = 256; }
      const bf16_t* sp = p.proj + (size_t)r * PROJW + 768 + c8;
      rc[u] = *(const u32x4*)sp;
      rm[u] = t > 0 ? *(const u32x4*)(sp - PROJW) : (u32x4){0u, 0u, 0u, 0u};
      rp[u] = t < n - 1 ? *(const u32x4*)(sp + PROJW) : (u32x4){0u, 0u, 0u, 0u};
    }
#pragma unroll
    for (int u = 0; u < 4; ++u) {
      const size_t it = it0 + (size_t)u * gsz;
      if (it < (size_t)NT * 128) {
        const int r = (int)(it >> 7), c8 = (int)(it & 127) * 8;
        float xc[8], xm[8], xp[8], o[8];
        unpack8(rc[u], xc); unpack8(rm[u], xm); unpack8(rp[u], xp);
        const float ksc = c8 < 512 ? 1.f : 0.08838834764831845f;
#pragma unroll
        for (int j = 0; j < 8; ++j) { const float v = wc[c8 + j] * xm[j] + wc[1024 + c8 + j] * xc[j] + wc[2048 + c8 + j] * xp[j]; o[j] = siluf(v) * ksc; }
        bf16_t* dp = c8 < 512 ? p.qm + (size_t)r * 512 + c8 : p.km + (size_t)r * 512 + c8 - 512;
        *(u32x4*)dp = pack8(o);
      }
    }
  }
  }
  {
    const int gw = (int)(gtid >> 6), nw = (int)(gsz >> 6);
    for (int task = gw; task < 64 * 18; task += nw) {
      const int chain = task / 18, c = task % 18;
      const int b = chain >> 3, hd = (chain >> 1) & 3, dir = chain & 1;
      const int p0 = c * 128 + 2 * lane;
      const int r0 = chain_row(b, dir, p0), r1 = chain_row(b, dir, p0 + 1);
      const float ig0 = p.gates[(size_t)r0 * 16 + dir * 8 + hd], lf0 = p.gates[(size_t)r0 * 16 + dir * 8 + 4 + hd];
      const float ig1 = p.gates[(size_t)r1 * 16 + dir * 8 + hd], lf1 = p.gates[(size_t)r1 * 16 + dir * 8 + 4 + hd];
      const float ssum = lf0 + lf1;
      const float incl = wave_incl_sum(ssum, lane);
      const float bq0 = (incl - ssum) + lf0, bq1 = bq0 + lf1;
      const float bend = __shfl(incl, 63);
      const float g0 = ig0 - bq0, g1 = ig1 - bq1;
      const float inclm = wave_incl_max(fmaxf(g0, g1), lane);
      float exclm = __shfl_up(inclm, 1);
      if (lane == 0) exclm = -3.0e38f;
      const float pm0 = fmaxf(exclm, g0), pm1 = fmaxf(pm0, g1);
      const float gmax = __shfl(inclm, 63);
      const size_t i0 = (size_t)r0 * 8 + dir * 4 + hd, i1 = (size_t)r1 * 8 + dir * 4 + hd;
      p.gsG[i0] = g0 * LOG2E; p.gsR[i0] = pm0 * LOG2E; p.gsB[i0] = bq0 * LOG2E;
      p.gsG[i1] = g1 * LOG2E; p.gsR[i1] = pm1 * LOG2E; p.gsB[i1] = bq1 * LOG2E;
      if (lane == 0) { p.cBE[chain * 18 + c] = bend; p.cGM[chain * 18 + c] = gmax; }
    }
  }
}
__device__ __forceinline__ void chain_state(const Params& p, int chain, int cc, float& m_in, float& m_next, float& be) {
  m_in = -1e30f; m_next = -1e30f; be = 0.f;
  for (int c = 0; c <= cc; ++c) {
    be = p.cMIN[chain * 18 + c];
    const float mn = fmaxf(m_in + be, be + p.cE1[chain * 18 + c]);
    if (c < cc) m_in = mn; else m_next = mn;
  }
}

typedef float f32x16 __attribute__((ext_vector_type(16)));
typedef short s16x4 __attribute__((ext_vector_type(4)));
typedef __attribute__((address_space(3))) const char* lds_cptr;
__device__ __forceinline__ s16x4 vtr(lds_cptr p) { return __builtin_bit_cast(s16x4, __builtin_amdgcn_ds_read_tr16_b64_v4i16((__attribute__((address_space(3))) s16x4*)p)); }
#define MX3(a, b, c) __builtin_fmaxf(__builtin_fmaxf((a), (b)), (c))
__device__ __forceinline__ float rowmax32(const f32x16& p0, const f32x16& p1) {
  float a = MX3(p0[0], p0[1], p1[0]), b = MX3(p0[2], p0[3], p1[1]);
  a = MX3(a, p1[2], p1[3]);
#pragma unroll
  for (int r = 4; r < 16; r += 4) { a = MX3(a, p0[r], p0[r + 1]); b = MX3(b, p0[r + 2], p0[r + 3]); a = MX3(a, p1[r], p1[r + 1]); b = MX3(b, p1[r + 2], p1[r + 3]); }
  const float m = __builtin_fmaxf(a, b);
  auto rr = __builtin_amdgcn_permlane32_swap(__float_as_uint(m), __float_as_uint(m), false, false);
  return __builtin_fmaxf(__uint_as_float(rr[0]), __uint_as_float(rr[1]));
}
__device__ __forceinline__ float half_swap_add(float v) {
  auto rr = __builtin_amdgcn_permlane32_swap(__float_as_uint(v), __float_as_uint(v), false, false);
  return __uint_as_float(rr[0]) + __uint_as_float(rr[1]);
}
#define ATT_SLOT 16384
__device__ __forceinline__ void glds16(const void* g, unsigned lds_base) {
  unsigned sv;
  asm volatile("s_mov_b32 %0, m0\n\ts_mov_b32 m0, %2\n\ts_nop 0\n\tglobal_load_lds_dwordx4 %1, off\n\ts_mov_b32 m0, %0" : "=&s"(sv) : "v"(g), "s"(lds_base) : "memory");
}
__device__ __forceinline__ void attn_unit(const bf16_t* Q0, const bf16_t* Kbase, const bf16_t* Vbase, const int nkeys, bf16_t* O0, LAS unsigned char* lds) {
  const int tid = ltid(), lane = tid & 63, r32 = lane & 31, hi = lane >> 5;
  const int wid = __builtin_amdgcn_readfirstlane(tid >> 6);
  const int NTL = nkeys >> 6;
  __syncthreads();
  const bf16_t* ksrc = Kbase + (size_t)lane * 64 + wid * 8;
  const bf16_t* vsrc = Vbase + (size_t)(16 * (wid & 3) + (lane >> 2)) * 64 + (wid >> 2) * 32 + (lane & 3) * 8;
  const unsigned ldsb = (unsigned)(size_t)lds;
#define ATT_STAGE(t, slot) do { \
    glds16(ksrc + (size_t)(t) * 64 * 64, (unsigned)__builtin_amdgcn_readfirstlane(ldsb + (slot) * ATT_SLOT + wid * 1024)); \
    glds16(vsrc + (size_t)(t) * 64 * 64, (unsigned)__builtin_amdgcn_readfirstlane(ldsb + (slot) * ATT_SLOT + 8192 + wid * 1024)); } while (0)
  ATT_STAGE(0, 0);
  if (NTL > 1) ATT_STAGE(1, 1);
  bf16x8 qr[4];
  {
    const bf16_t* Qw = Q0 + (size_t)(wid * 32 + r32) * 512;
#pragma unroll
    for (int d0 = 0; d0 < 4; ++d0) qr[d0] = *(const bf16x8*)(Qw + d0 * 16 + hi * 8);
  }
  f32x16 o0, o1;
#pragma unroll
  for (int r = 0; r < 16; ++r) { o0[r] = 0.f; o1[r] = 0.f; }
  float m = -1e30f, l = 0.f;
  const int koff = hi * 1024 + r32 * 16;
  const int voff = 8192 + ((lane >> 4) & 1) * 32 + (lane & 3) * 8 + (4 * hi + ((lane & 15) >> 2)) * 64;
  const bool grpB = wid >= 4;
  bf16x8 pw[4];
#define ATT_PV(sl) do { const lds_cptr vp_ = (lds_cptr)(lds + (sl) * ATT_SLOT + voff); \
    _Pragma("unroll") for (int s4 = 0; s4 < 4; ++s4) { \
      const s16x4 a0l = vtr(vp_ + s4 * 1024), a0h = vtr(vp_ + s4 * 1024 + 512); \
      const s16x4 a1l = vtr(vp_ + 4096 + s4 * 1024), a1h = vtr(vp_ + 4096 + s4 * 1024 + 512); \
      const bf16x8 a0 = {a0l[0], a0l[1], a0l[2], a0l[3], a0h[0], a0h[1], a0h[2], a0h[3]}; \
      const bf16x8 a1 = {a1l[0], a1l[1], a1l[2], a1l[3], a1h[0], a1h[1], a1h[2], a1h[3]}; \
      o0 = __builtin_amdgcn_mfma_f32_32x32x16_bf16(a0, pw[s4], o0, 0, 0, 0); \
      o1 = __builtin_amdgcn_mfma_f32_32x32x16_bf16(a1, pw[s4], o1, 0, 0, 0); } } while (0)
  for (int t = 0; t <= NTL; ++t) {
    if (t + 1 < NTL) asm volatile("s_waitcnt vmcnt(2) lgkmcnt(0)\n\ts_barrier" ::: "memory"); else asm volatile("s_waitcnt vmcnt(0) lgkmcnt(0)\n\ts_barrier" ::: "memory");
    __builtin_amdgcn_sched_barrier(0);
    if (t + 2 < NTL) ATT_STAGE(t + 2, (t + 2) & 3);
    if (grpB && t > 0) ATT_PV((t - 1) & 3);
    if (t < NTL) {
      const lds_cptr kp = (lds_cptr)(lds + (t & 3) * ATT_SLOT + koff);
      f32x16 pA, pB;
#pragma unroll
      for (int r = 0; r < 16; ++r) { pA[r] = 0.f; pB[r] = 0.f; }
#pragma unroll
      for (int d0 = 0; d0 < 4; ++d0) {
        const bf16x8 k0 = *(const LAS bf16x8*)(kp + d0 * 2048), k1 = *(const LAS bf16x8*)(kp + d0 * 2048 + 512);
        pA = __builtin_amdgcn_mfma_f32_32x32x16_bf16(k0, qr[d0], pA, 0, 0, 0);
        pB = __builtin_amdgcn_mfma_f32_32x32x16_bf16(k1, qr[d0], pB, 0, 0, 0);
      }
      const float rm = rowmax32(pA, pB);
      const float mn = __builtin_fmaxf(m, rm);
      const float alpha = __builtin_amdgcn_exp2f(m - mn);
      m = mn;
      float ps = 0.f;
#pragma unroll
      for (int r = 0; r < 16; ++r) { pA[r] = __builtin_amdgcn_exp2f(pA[r] - mn); pB[r] = __builtin_amdgcn_exp2f(pB[r] - mn); ps += pA[r] + pB[r]; }
      l = l * alpha + ps;
#pragma unroll
      for (int r = 0; r < 16; ++r) { o0[r] *= alpha; o1[r] *= alpha; }
#pragma unroll
      for (int s4 = 0; s4 < 4; ++s4) {
        u32x4 w;
        if (s4 < 2) { w.x = cvt_pk_bf16(pA[8 * s4 + 0], pA[8 * s4 + 1]); w.y = cvt_pk_bf16(pA[8 * s4 + 2], pA[8 * s4 + 3]); w.z = cvt_pk_bf16(pA[8 * s4 + 4], pA[8 * s4 + 5]); w.w = cvt_pk_bf16(pA[8 * s4 + 6], pA[8 * s4 + 7]); }
        else { const int q = s4 - 2; w.x = cvt_pk_bf16(pB[8 * q + 0], pB[8 * q + 1]); w.y = cvt_pk_bf16(pB[8 * q + 2], pB[8 * q + 3]); w.z = cvt_pk_bf16(pB[8 * q + 4], pB[8 * q + 5]); w.w = cvt_pk_bf16(pB[8 * q + 6], pB[8 * q + 7]); }
        pw[s4] = __builtin_bit_cast(bf16x8, w);
      }
      if (!grpB) ATT_PV(t & 3);
    }
  }
#undef ATT_PV
#undef ATT_STAGE
  const float il = 1.f / half_swap_add(l);
  bf16_t* Ow = O0 + (size_t)(wid * 32 + r32) * 1024;
#pragma unroll
  for (int g4 = 0; g4 < 4; ++g4) {
    u32x2 w0, w1;
    w0.x = cvt_pk_bf16(o0[4 * g4 + 0] * il, o0[4 * g4 + 1] * il); w0.y = cvt_pk_bf16(o0[4 * g4 + 2] * il, o0[4 * g4 + 3] * il);
    w1.x = cvt_pk_bf16(o1[4 * g4 + 0] * il, o1[4 * g4 + 1] * il); w1.y = cvt_pk_bf16(o1[4 * g4 + 2] * il, o1[4 * g4 + 3] * il);
    *(u32x2*)(Ow + 8 * g4 + 4 * hi) = w0;
    *(u32x2*)(Ow + 32 + 8 * g4 + 4 * hi) = w1;
  }
}
__device__ __forceinline__ void ph_att(const Params& p, bool ctx_q, LAS unsigned char* lds) {
  const int c = lbid(), G = lgdim();
  const int nunits = 512 + (ctx_q ? 64 : 0);
  for (int L = c; L < nunits; L += G) {
    if (L < 512) {
      const int i = L >> 8, cc = L & 255, grp = (cc & 7) + 8 * i, idx = cc >> 3;
      const int b = grp >> 1, kvh = grp & 1, h = kvh * 4 + (idx >> 3), qt = idx & 7;
      const size_t row0 = (size_t)b * 2048 + qt * 256;
      attn_unit(p.Qb + row0 * 512 + h * 64, p.Kb + (size_t)(b * 2 + kvh) * 2304 * 64, p.Vb + (size_t)(b * 2 + kvh) * 2304 * 64, 2304, p.mix + row0 * 1024 + h * 64, lds);
    } else {
      const int u = L - 512, b = u >> 3, h = u & 7, kvh = h >> 2;
      const size_t row0 = (size_t)NL + b * 256;
      attn_unit(p.Qb + row0 * 512 + h * 64, p.Kb + (size_t)(b * 2 + kvh) * 2304 * 64, p.Vb + (size_t)(b * 2 + kvh) * 2304 * 64, 256, p.mix + row0 * 1024 + h * 64, lds);
    }
  }
  __syncthreads();
}

__device__ __forceinline__ int chunk_row0(int b, int dir, int cc) {
  if (cc < 2) return NL + b * 256 + (dir ? 1 - cc : cc) * 128;
  return b * 2048 + (dir ? 15 - (cc - 2) : cc - 2) * 128;
}
__device__ __forceinline__ int trq_addr(int lane, int quarter, int rowbase) {
  return quarter * 8192 + ((lane >> 4) & 1) * 32 + (lane & 3) * 8 + (rowbase + ((lane & 15) >> 2)) * 64;
}
__device__ __forceinline__ bf16x8 cat44(const s16x4 a, const s16x4 b) { return (bf16x8){a[0], a[1], a[2], a[3], b[0], b[1], b[2], b[3]}; }

__device__ __forceinline__ void ph_mlstm_u(const Params& p, LAS unsigned char* lds) {
  const int tid = ltid(), lane = tid & 63, r32 = lane & 31, hi = lane >> 5;
  const int wid = __builtin_amdgcn_readfirstlane(tid >> 6);
  LAS float* WS = (LAS float*)(lds + 65536);
  LAS float* NP = (LAS float*)(lds + 66048);
  LAS float* E1T = (LAS float*)(lds + 68096);
  __syncthreads();
  if (tid < 64) {
    float be[18], gm[18];
#pragma unroll
    for (int c = 0; c < 18; ++c) { be[c] = p.cBE[tid * 18 + c]; gm[c] = p.cGM[tid * 18 + c]; }
    float m_in = -1e30f;
#pragma unroll
    for (int c = 0; c < 18; ++c) {
      const float m_next = fmaxf(m_in + be[c], be[c] + gm[c]);
      E1T[tid * 18 + c] = (be[c] - m_next) * LOG2E;
      if (lbid() == 0) { p.cMIN[tid * 18 + c] = m_in * LOG2E; p.cDEC[tid * 18 + c] = expf(m_in + be[c] - m_next); }
      m_in = m_next;
    }
  }
  __syncthreads();
  for (int unit = lbid(); unit < 64 * 17; unit += lgdim()) {
    const int chain = unit / 17, cc = unit % 17;
    const int b = chain >> 3, hd = (chain >> 1) & 3, dir = chain & 1;
    const int row0 = chunk_row0(b, dir, cc);
    __syncthreads();
#pragma unroll
    for (int n = 0; n < 4; ++n) {
      const int ii = wid * 4 + n, qd = ii >> 3, rg = ii & 7;
      const bf16_t* src = p.km + (size_t)(row0 + rg * 16 + (lane >> 2)) * 512 + hd * 128 + qd * 32 + (lane & 3) * 8;
      __builtin_amdgcn_global_load_lds((const unsigned*)src, (LAS unsigned*)(lds + qd * 8192 + rg * 1024), 16, 0, 0);
    }
    if (tid < 128) WS[tid] = __builtin_amdgcn_exp2f(p.gsG[(size_t)(row0 + tid) * 8 + dir * 4 + hd] + E1T[chain * 18 + cc]);
    __syncthreads();
#pragma unroll
    for (int n = 0; n < 4; ++n) {
      const int o = (tid + n * NTHR) * 16, qd = o >> 13, row = (o >> 6) & 127, pc = (o >> 4) & 3;
      float f[8];
      unpack8(*(const u32x4*)(p.proj + (size_t)(row0 + row) * PROJW + 1792 + hd * 128 + qd * 32 + pc * 8), f);
      const float w = WS[row];
#pragma unroll
      for (int j = 0; j < 8; ++j) f[j] *= w;
      *(LAS u32x4*)(lds + 32768 + o) = pack8(f);
    }
    asm volatile("s_waitcnt vmcnt(0)" ::: "memory");
    __syncthreads();
    {
      const int d = tid & 127, part = tid >> 7;
      float acc = 0.f;
      for (int s2 = 0; s2 < 32; ++s2) {
        const int srow = part * 32 + s2;
        const bf16_t kv = *(const LAS bf16_t*)(lds + (d >> 5) * 8192 + srow * 64 + (d & 31) * 2);
        acc += WS[srow] * bf2f(kv);
      }
      NP[part * 128 + d] = acc;
    }
    const int eb = wid >> 1, db0 = 2 * (wid & 1);
    f32x16 u0, u1;
#pragma unroll
    for (int r = 0; r < 16; ++r) { u0[r] = 0.f; u1[r] = 0.f; }
#pragma unroll
    for (int ks = 0; ks < 8; ++ks) {
      const int rb = ks * 16 + 8 * hi;
      const bf16x8 a = cat44(vtr((lds_cptr)(lds + 32768 + trq_addr(lane, eb, rb))), vtr((lds_cptr)(lds + 32768 + trq_addr(lane, eb, rb + 4))));
      const bf16x8 b0 = cat44(vtr((lds_cptr)(lds + trq_addr(lane, db0, rb))), vtr((lds_cptr)(lds + trq_addr(lane, db0, rb + 4))));
      const bf16x8 b1 = cat44(vtr((lds_cptr)(lds + trq_addr(lane, db0 + 1, rb))), vtr((lds_cptr)(lds + trq_addr(lane, db0 + 1, rb + 4))));
      u0 = __builtin_amdgcn_mfma_f32_32x32x16_bf16(a, b0, u0, 0, 0, 0);
      u1 = __builtin_amdgcn_mfma_f32_32x32x16_bf16(a, b1, u1, 0, 0, 0);
    }
    float* U = p.Ubuf + ((size_t)chain * 17 + cc) * 16384;
#pragma unroll
    for (int r = 0; r < 16; ++r) {
      const int erow = eb * 32 + (r & 3) + 8 * (r >> 2) + 4 * hi;
      U[(size_t)erow * 128 + db0 * 32 + r32] = u0[r];
      U[(size_t)erow * 128 + (db0 + 1) * 32 + r32] = u1[r];
    }
    __syncthreads();
    if (tid < 128) p.NLb[((size_t)chain * 17 + cc) * 128 + tid] = NP[tid] + NP[128 + tid] + NP[256 + tid] + NP[384 + tid];
  }
  __syncthreads();
}

__device__ __forceinline__ void ph_mlstm_scan(const Params& p, int bskip) {
  const int bsk = lgdim() > bskip ? bskip : 0;
  if (lbid() < bsk) return;
  const size_t gtid = (size_t)(lbid() - bsk) * NTHR + ltid(), gsz = (size_t)(lgdim() - bsk) * NTHR;
  for (size_t it = gtid; it < (size_t)64 * 8192; it += gsz) {
    const int chain = (int)(it >> 13), ed = (int)(it & 8191) * 2;
    float c0 = 0.f, c1 = 0.f;
    for (int c = 0; c < 17; ++c) {
      const float dec = p.cDEC[chain * 18 + c];
      const float2 u = *(const float2*)(p.Ubuf + ((size_t)chain * 17 + c) * 16384 + ed);
      c0 = dec * c0 + u.x; c1 = dec * c1 + u.y;
      *(unsigned*)(p.Cbf + ((size_t)chain * 18 + c + 1) * 16384 + ed) = cvt_pk_bf16(c0, c1);
    }
  }
  for (size_t it = gtid; it < (size_t)64 * 128; it += gsz) {
    const int chain = (int)(it >> 7), d = (int)(it & 127);
    float nv = 0.f;
    for (int c = 0; c < 17; ++c) {
      nv = p.cDEC[chain * 18 + c] * nv + p.NLb[((size_t)chain * 17 + c) * 128 + d];
      p.NVb[((size_t)chain * 18 + c + 1) * 128 + d] = nv;
    }
  }
}

__device__ __forceinline__ void ph_mlstm_h(const Params& p, int l, bool ctx_out, LAS unsigned char* lds) {
  const int e2 = l >> 1;
  const int tid = ltid(), lane = tid & 63, r32 = lane & 31, hi = lane >> 5;
  const int wid = __builtin_amdgcn_readfirstlane(tid >> 6);
  const int tb = wid & 3, dir = wid >> 2;
  LAS float* HX = (LAS float*)(lds);
  LAS float* GC = (LAS float*)(lds + 131072);
  const int j0 = ctx_out ? 0 : 2, nj = 18 - j0;
  for (int unit = lbid(); unit < 32 * nj; unit += lgdim()) {
    const int bh = unit / nj, j = j0 + unit % nj, b = bh >> 2, hd = bh & 3;
    const int row0 = (j < 2) ? NL + b * 256 + j * 128 : b * 2048 + (j - 2) * 128;
    const int cc = dir ? (j < 2 ? 1 - j : 19 - j) : j;
    const int chain = b * 8 + hd * 2 + dir;
    __syncthreads();
#pragma unroll
    for (int n = 0; n < 4; ++n) {
      const int ii = wid * 4 + n;
      { const int ch = ii >> 1, rh = ii & 1;
        const bf16_t* src = p.km + (size_t)(row0 + rh * 64 + lane) * 512 + hd * 128 + ch * 8;
        __builtin_amdgcn_global_load_lds((const unsigned*)src, (LAS unsigned*)(lds + ch * 2048 + rh * 1024), 16, 0, 0); }
      { const int qd = ii >> 3, rg = ii & 7;
        const bf16_t* src = p.proj + (size_t)(row0 + rg * 16 + (lane >> 2)) * PROJW + 1792 + hd * 128 + qd * 32 + (lane & 3) * 8;
        __builtin_amdgcn_global_load_lds((const unsigned*)src, (LAS unsigned*)(lds + 32768 + qd * 8192 + rg * 1024), 16, 0, 0); }
    }
#pragma unroll
    for (int n = 0; n < 8; ++n) {
      const int ii2 = wid * 8 + n, dd = ii2 >> 5, ch = (ii2 & 31) >> 1, rh = ii2 & 1;
      const int ccd = dd ? (j < 2 ? 1 - j : 19 - j) : j;
      if (ccd > 0) {
        const bf16_t* src = p.Cbf + ((size_t)(b * 8 + hd * 2 + dd) * 18 + ccd) * 16384 + (size_t)(rh * 64 + lane) * 128 + ch * 8;
        __builtin_amdgcn_global_load_lds((const unsigned*)src, (LAS unsigned*)(lds + 65536 + dd * 32768 + ch * 2048 + rh * 1024), 16, 0, 0);
      }
    }
    if (tid < 256) GC[tid] = p.gsG[(size_t)(row0 + (tid & 127)) * 8 + (tid >> 7) * 4 + hd];
    const int trow = row0 + tb * 32 + r32;
    bf16x8 qf[8];
#pragma unroll
    for (int ks = 0; ks < 8; ++ks) qf[ks] = *(const bf16x8*)(p.qm + (size_t)trow * 512 + hd * 128 + ks * 16 + hi * 8);
    const float MIN2 = p.cMIN[chain * 18 + cc];
    const float R2 = -fmaxf(MIN2, p.gsR[(size_t)trow * 8 + dir * 4 + hd]), BQ2 = p.gsB[(size_t)trow * 8 + dir * 4 + hd];
    f32x16 acc[4];
#pragma unroll
    for (int eb = 0; eb < 4; ++eb)
#pragma unroll
      for (int r = 0; r < 16; ++r) acc[eb][r] = 0.f;
    float nq = 0.f;
    if (cc > 0) {
      const float* nvp = p.NVb + ((size_t)chain * 18 + cc) * 128 + hi * 8;
#pragma unroll
      for (int ks = 0; ks < 8; ++ks) {
        const f32x4 n0 = *(const f32x4*)(nvp + ks * 16), n1 = *(const f32x4*)(nvp + ks * 16 + 4);
        float qv[8];
        unpack8(__builtin_bit_cast(u32x4, qf[ks]), qv);
        nq += n0[0] * qv[0] + n0[1] * qv[1] + n0[2] * qv[2] + n0[3] * qv[3] + n1[0] * qv[4] + n1[1] * qv[5] + n1[2] * qv[6] + n1[3] * qv[7];
      }
      nq = half_swap_add(nq);
    }
    const float winter = __builtin_amdgcn_exp2f(MIN2 + R2);
    asm volatile("s_waitcnt vmcnt(0)" ::: "memory");
    __syncthreads();
    if (cc > 0) {
#pragma unroll
      for (int eb = 0; eb < 4; ++eb)
#pragma unroll
        for (int ks = 0; ks < 8; ++ks) {
          const bf16x8 a = *(const LAS bf16x8*)(lds + 65536 + dir * 32768 + (2 * ks + hi) * 2048 + (eb * 32 + r32) * 16);
          acc[eb] = __builtin_amdgcn_mfma_f32_32x32x16_bf16(a, qf[ks], acc[eb], 0, 0, 0);
        }
#pragma unroll
      for (int eb = 0; eb < 4; ++eb)
#pragma unroll
        for (int r = 0; r < 16; ++r) acc[eb][r] *= winter;
    }
    float sw = 0.f;
    const int sb_lo = dir ? tb : 0, sb_hi = dir ? 3 : tb;
    for (int sb = sb_lo; sb <= sb_hi; ++sb) {
      f32x16 st;
#pragma unroll
      for (int r = 0; r < 16; ++r) st[r] = 0.f;
#pragma unroll
      for (int ks = 0; ks < 8; ++ks) {
        const bf16x8 kf = *(const LAS bf16x8*)(lds + (2 * ks + hi) * 2048 + (sb * 32 + r32) * 16);
        st = __builtin_amdgcn_mfma_f32_32x32x16_bf16(kf, qf[ks], st, 0, 0, 0);
      }
      const bool diag = (sb == tb);
#pragma unroll
      for (int g4 = 0; g4 < 4; ++g4) {
        const f32x4 gc = *(const LAS f32x4*)(GC + dir * 128 + sb * 32 + 8 * g4 + 4 * hi);
#pragma unroll
        for (int q = 0; q < 4; ++q) {
          const int sl = 8 * g4 + 4 * hi + q;
          float w = __builtin_amdgcn_exp2f(R2 + gc[q]) * st[4 * g4 + q];
          const bool keep = !diag || (dir ? (sl >= r32) : (sl <= r32));
          w = keep ? w : 0.f;
          sw += w;
          st[4 * g4 + q] = w;
        }
      }
      u32x4 p0, p1;
      p0.x = cvt_pk_bf16(st[0], st[1]); p0.y = cvt_pk_bf16(st[2], st[3]); p0.z = cvt_pk_bf16(st[4], st[5]); p0.w = cvt_pk_bf16(st[6], st[7]);
      p1.x = cvt_pk_bf16(st[8], st[9]); p1.y = cvt_pk_bf16(st[10], st[11]); p1.z = cvt_pk_bf16(st[12], st[13]); p1.w = cvt_pk_bf16(st[14], st[15]);
      const bf16x8 pw0 = __builtin_bit_cast(bf16x8, p0), pw1 = __builtin_bit_cast(bf16x8, p1);
#pragma unroll
      for (int eb = 0; eb < 4; ++eb) {
        const int rb = sb * 32 + 4 * hi;
        const bf16x8 a0 = cat44(vtr((lds_cptr)(lds + 32768 + trq_addr(lane, eb, rb))), vtr((lds_cptr)(lds + 32768 + trq_addr(lane, eb, rb + 8))));
        const bf16x8 a1 = cat44(vtr((lds_cptr)(lds + 32768 + trq_addr(lane, eb, rb + 16))), vtr((lds_cptr)(lds + 32768 + trq_addr(lane, eb, rb + 24))));
        acc[eb] = __builtin_amdgcn_mfma_f32_32x32x16_bf16(a0, pw0, acc[eb], 0, 0, 0);
        acc[eb] = __builtin_amdgcn_mfma_f32_32x32x16_bf16(a1, pw1, acc[eb], 0, 0, 0);
      }
    }
    sw = half_swap_add(sw);
    const float den = winter * nq + sw;
    const float dn = fmaxf(fabsf(den), __builtin_amdgcn_exp2f(R2 - BQ2));
    const float idn = 1.f / dn;
    __syncthreads();
    if (dir == 1) {
#pragma unroll
      for (int eb = 0; eb < 4; ++eb)
#pragma unroll
        for (int r = 0; r < 16; ++r) HX[(tb * 128 + eb * 32 + (r & 3) + 8 * (r >> 2) + 4 * hi) * 32 + r32] = acc[eb][r] * idn;
    }
    __syncthreads();
    if (dir == 0) {
      float ss = 0.f;
#pragma unroll
      for (int eb = 0; eb < 4; ++eb)
#pragma unroll
        for (int r = 0; r < 16; ++r) {
          const float v = acc[eb][r] * idn + HX[(tb * 128 + eb * 32 + (r & 3) + 8 * (r >> 2) + 4 * hi) * 32 + r32];
          acc[eb][r] = v; ss += v * v;
        }
      ss = half_swap_add(ss);
      const float inv = rsqrtf(ss * (1.f / 128.f) + EPS);
      const float* gh = p.g_hnorm + e2 * 512 + hd * 128;
      const bf16_t* obp = p.proj + (size_t)trow * PROJW + 2304 + hd * 128;
      bf16_t* op = p.mix + (size_t)trow * 1024 + 512 + hd * 128;
#pragma unroll
      for (int eb = 0; eb < 4; ++eb)
#pragma unroll
        for (int g4 = 0; g4 < 4; ++g4) {
          const int e0 = eb * 32 + 8 * g4 + 4 * hi;
          const f32x4 gv = *(const f32x4*)(gh + e0);
          const u32x2 ow = *(const u32x2*)(obp + e0);
          const float ob0 = __uint_as_float(ow.x << 16), ob1 = __uint_as_float(ow.x & 0xffff0000u), ob2 = __uint_as_float(ow.y << 16), ob3 = __uint_as_float(ow.y & 0xffff0000u);
          const float v0 = acc[eb][4 * g4 + 0] * inv * gv[0] * sigmoidf_(ob0), v1 = acc[eb][4 * g4 + 1] * inv * gv[1] * sigmoidf_(ob1);
          const float v2 = acc[eb][4 * g4 + 2] * inv * gv[2] * sigmoidf_(ob2), v3 = acc[eb][4 * g4 + 3] * inv * gv[3] * sigmoidf_(ob3);
          u32x2 w; w.x = cvt_pk_bf16(v0, v1); w.y = cvt_pk_bf16(v2, v3);
          *(u32x2*)(op + e0) = w;
        }
    }
  }
  __syncthreads();
}

__device__ __forceinline__ void ph_topk(const Params& p, bool ctx, float* sm) {
  const int tid = ltid(), lane = tid & 63, wv = tid >> 6;
  unsigned* cnt = (unsigned*)sm;
  unsigned* pre = (unsigned*)sm + 32;
  int* sel = (int*)sm + 64;
  const int ncol = ctx ? 256 : 128;
  for (int colu = lbid(); colu < ncol; colu += lgdim()) {
    int e, base, n, cap; size_t mbase;
    if (colu < 128) { const int b = colu >> 4; e = colu & 15; base = b * 2048; n = 2048; cap = 256; mbase = (size_t)e * 2048 + (size_t)b * 256; }
    else { const int c2 = colu - 128, b = c2 >> 4; e = c2 & 15; base = NL + b * 256; n = 256; cap = 32; mbase = (size_t)MOE_L + (size_t)e * 256 + (size_t)b * 32; }
    unsigned v[4];
#pragma unroll
    for (int k = 0; k < 4; ++k) { const int i = tid * 4 + k; v[k] = i < n ? __float_as_uint(p.aff[(size_t)(base + i) * 16 + e]) : 0u; }
    unsigned thr = 0u;
    for (int bit = 30; bit >= 0; --bit) {
      const unsigned cand = thr | (1u << bit);
      unsigned c = (v[0] >= cand) + (v[1] >= cand) + (v[2] >= cand) + (v[3] >= cand);
#pragma unroll
      for (int o = 32; o > 0; o >>= 1) c += __shfl_xor(c, o);
      unsigned* cb = cnt + (bit & 1) * 8;
      if (lane == 0) cb[wv] = c;
      __syncthreads();
      const unsigned tot = cb[0] + cb[1] + cb[2] + cb[3] + cb[4] + cb[5] + cb[6] + cb[7];
      if (tot >= (unsigned)cap) thr = cand;
    }
    unsigned ngt = (v[0] > thr) + (v[1] > thr) + (v[2] > thr) + (v[3] > thr);
    unsigned neq = (v[0] == thr) + (v[1] == thr) + (v[2] == thr) + (v[3] == thr);
    unsigned igt = ngt, ieq = neq;
#pragma unroll
    for (int o = 1; o < 64; o <<= 1) { const unsigned a = __shfl_up(igt, o), b2 = __shfl_up(ieq, o); if (lane >= o) { igt += a; ieq += b2; } }
    __syncthreads();
    if (lane == 63) { pre[wv] = igt; pre[8 + wv] = ieq; }
    __syncthreads();
    unsigned totgt = 0, offgt = 0, offeq = 0;
#pragma unroll
    for (int w2 = 0; w2 < 8; ++w2) { const unsigned a = pre[w2], b2 = pre[8 + w2]; totgt += a; if (w2 < wv) { offgt += a; offeq += b2; } }
    const unsigned need_eq = (unsigned)cap - totgt;
    unsigned egt = offgt + igt - ngt, eeq = offeq + ieq - neq;
#pragma unroll
    for (int k = 0; k < 4; ++k) {
      const int i = tid * 4 + k;
      const bool gt = v[k] > thr, eq = v[k] == thr;
      const bool take = gt || (eq && eeq < need_eq);
      if (i < n) {
        const int r = base + i;
        const unsigned slot = egt + (eeq < need_eq ? eeq : need_eq);
        if (take) { p.slotmap[(size_t)r * 16 + e] = (int)slot; p.rowidx[mbase + slot] = r; p.gatev[mbase + slot] = __uint_as_float(v[k]); sel[slot] = r; }
        else p.slotmap[(size_t)r * 16 + e] = -1;
      }
      egt += gt; eeq += eq;
    }
    __syncthreads();
    __syncthreads();
  }
}

template <int W>
__device__ __forceinline__ void pool_item(const Params& p, int r, int c8) {
  int t, n;
  if (r < NL) { t = r & 2047; n = 2048; } else { t = (r - NL) & 255; n = 256; }
  constexpr int lo = W / 2;
  const bf16_t* up = p.proj + (size_t)r * 1024 + c8;
  u32x4 raw[W];
  int cnt = 0;
#pragma unroll
  for (int k = 0; k < W; ++k) {
    const int tt = t - lo + k;
    const bool ok = tt >= 0 && tt < n;
    raw[k] = ok ? *(const u32x4*)(up + (ptrdiff_t)(k - lo) * 1024) : (u32x4){0u, 0u, 0u, 0u};
    cnt += ok ? 1 : 0;
  }
  float s8[8], f[8], uc[8];
#pragma unroll
  for (int j = 0; j < 8; ++j) s8[j] = 0.f;
#pragma unroll
  for (int k = 0; k < W; ++k) {
    unpack8(raw[k], f);
#pragma unroll
    for (int j = 0; j < 8; ++j) s8[j] += f[j];
  }
  unpack8(raw[lo], uc);
  const float ic = 1.f / (float)cnt;
#pragma unroll
  for (int j = 0; j < 8; ++j) f[j] = s8[j] * ic - uc[j];
  *(u32x4*)(p.mix + (size_t)r * 1024 + c8) = pack8(f);
}
__device__ __forceinline__ void ph_pool(const Params& p, int nrows) {
  const size_t gtid = (size_t)lbid() * NTHR + ltid(), gsz = (size_t)lgdim() * NTHR;
  for (size_t it = gtid; it < (size_t)nrows * 128; it += gsz) {
    const int g = (int)(it / ((size_t)nrows * 32));
    const size_t rem = it - (size_t)g * nrows * 32;
    const int r = (int)(rem >> 5), c8 = g * 256 + (int)(rem & 31) * 8;
    if (g == 0) pool_item<2>(p, r, c8);
    else if (g == 1) pool_item<4>(p, r, c8);
    else if (g == 2) pool_item<8>(p, r, c8);
    else pool_item<16>(p, r, c8);
  }
}

enum { PH_INIT = 0, PH_NORM1, PH_GEMM_IN_EVEN, PH_POST_EVEN, PH_ATT, PH_MLSTM_U, PH_MLSTM_SCAN, PH_MLSTM_H, PH_GEMM_OUT, PH_NORM2, PH_TOPK, PH_GATHER,
       PH_MOE_GU, PH_MOE_D, PH_GEMM_IN_ODD, PH_POOL, PH_GEMM_GRP, PH_FINAL };

typedef const __attribute__((address_space(4))) Params* KParams;
__device__ __forceinline__ const Params& get_params() {
  KParams kp = (KParams)__builtin_amdgcn_kernarg_segment_ptr();
  asm volatile("" : "+s"(kp));
  return *(const Params*)kp;
}
__device__ __forceinline__ int idle_slots(int nu, int G, int c) {
  const int mx = (nu + G - 1) / G, mine = c < nu ? (nu - c + G - 1) / G : 0;
  return mx - mine;
}
__device__ __forceinline__ void run_phase(int ph, int l, unsigned char* shm) {
  const Params& p = get_params();
  float* sm = (float*)shm;
  LAS unsigned char* lds = (LAS unsigned char*)shm;
  const bool ctx_next = (l < 2);
  const bool ctx_used = (l < 3);
  const int G = lgdim(), c = lbid();
  switch (ph) {
    case PH_INIT: ph_init(p, sm); break;
    case PH_NORM1: {
      const int ncomb = (l == 0) ? 0 : ((l - 1) < 2 ? NT : NL);
      ph_norm(p, l, 1, ctx_used ? NT : NL, ncomb, l - 1, sm);
    } break;
    case PH_GEMM_IN_EVEN: {
      g8::SchedDense S{(const char*)p.hbuf, (const char*)(p.WinE + (size_t)(l >> 1) * PROJW * 1024), 1024, 1024, NT / 256, PROJW / 256, 0, G, c};
      g8::EpiBf16 E{p.proj, PROJW};
      g8::gemm_phase(lds, 1024, 1024, 1024, S, E);
      conv_quota(p, idle_slots(S.nM * S.nN, G, c) * 3, sm);
    } break;
    case PH_POST_EVEN: ph_post_even(p, l, sm); break;
    case PH_MLSTM_U: ph_mlstm_u(p, lds); break;
    case PH_ATT: ph_att(p, ctx_next, lds); ph_mlstm_scan(p, ctx_next ? 64 : 0); conv_quota(p, idle_slots(512 + (ctx_next ? 64 : 0), G, c) * 6, sm); break;
    case PH_MLSTM_H: ph_mlstm_h(p, l, ctx_next, lds); conv_quota(p, idle_slots(32 * (ctx_next ? 18 : 16), G, c) * 3, sm); break;
    case PH_GEMM_OUT: {
      g8::SchedDense S{(const char*)p.mix, (const char*)(p.WoutE + (size_t)(l >> 1) * 1024 * 1024), 1024, 1024, (ctx_next ? NT : NL) / 256, 4, 0, G, c};
      g8::EpiBf16 E{p.ybuf, 1024};
      g8::gemm_phase(lds, 1024, 1024, 1024, S, E);
      conv_quota(p, idle_slots(S.nM * S.nN, G, c) * 3, sm);
    } break;
    case PH_NORM2: ph_norm(p, l, 2, ctx_next ? NT : NL, 0, 0, sm); break;
    case PH_TOPK: ph_topk(p, ctx_next, sm); conv_until(p, l == 0 ? CE4 : (l == 1 ? CE7 : (l == 2 ? CE10 : CE11)), sm); break;
    case PH_MOE_GU: {
      g8::SchedMoe S{(const char*)p.Xs, (const char*)(p.Wgu + (size_t)l * NEXP * 2048 * 1024), 8, 2048, 128, ctx_next ? 1152 : 1024, G, c};
      g8::EpiSwiGLU E{p.Abuf};
      g8::gemm_phase<true>(lds, 1024, 1024, 1024, S, E, p.rowidx, (const char*)p.hbuf);
      conv_quota(p, idle_slots(S.nu, G, c) * 3, sm);
    } break;
    case PH_MOE_D: {
      g8::SchedMoe S{(const char*)p.Abuf, (const char*)(p.Wd + (size_t)l * NEXP * 1024 * 1024), 4, 1024, 256, ctx_next ? 576 : 512, G, c};
      g8::EpiDown E{p.Ybuf, p.gatev};
      g8::gemm_phase(lds, 1024, 1024, 1024, S, E);
      conv_quota(p, idle_slots(S.nu, G, c) * 3, sm);
    } break;
    case PH_GEMM_IN_ODD: {
      g8::SchedDense S{(const char*)p.hbuf, (const char*)(p.WinO + (size_t)(l >> 1) * 1024 * 1024), 1024, 1024, (ctx_next ? NT : NL) / 256, 4, 0, G, c};
      g8::EpiBf16 E{p.proj, 1024};
      g8::gemm_phase(lds, 1024, 1024, 1024, S, E);
      conv_quota(p, idle_slots(S.nM * S.nN, G, c) * 3, sm);
    } break;
    case PH_POOL: ph_pool(p, ctx_next ? NT : NL); break;
    case PH_GEMM_GRP: {
      g8::SchedDense S{(const char*)p.mix, (const char*)(p.Wgrp + (size_t)(l >> 1) * 1024 * 256), 1024, 256, (ctx_next ? NT : NL) / 256, 4, 512, G, c};
      g8::EpiBf16 E{p.ybuf, 1024};
      g8::gemm_phase(lds, 256, 1024, 256, S, E);
      conv_quota(p, idle_slots(S.nM * S.nN, G, c) * 1, sm);
    } break;
    case PH_FINAL: ph_norm(p, 3, 3, NL, NL, 3, sm); break;
  }
}

__global__ void __launch_bounds__(NTHR) mega_kernel(Params p) {
  extern __shared__ __attribute__((aligned(16))) unsigned char shm[];
  cg::grid_group grid = cg::this_grid();
  volatile LAS unsigned* st = (volatile LAS unsigned*)((LAS unsigned char*)shm + g8::STAGE_BYTES + 1536);
  if (threadIdx.x < 2) st[threadIdx.x] = 0u;
  __syncthreads();
  unsigned* barw;
  { const Params& q = get_params(); barw = q.barw; }
  const XcdBarrier xb = xcd_barrier_post(barw, st);
  const int nprog = p.nprog;
  for (int i = 0; i < nprog; ++i) {
    int ph, l;
    { const Params& q = get_params(); ph = q.prog_ph[i]; l = q.prog_l[i]; }
    run_phase(ph, l, shm);
    if (i + 1 < nprog) { if (i == 0) grid.sync(); else xcd_barrier(xb); }
  }
}

extern "C" void kernel_launch(void* const* d_in, const int* in_sizes, int n_in, void* d_out, int out_size, void* d_ws, size_t ws_size,
                              hipStream_t stream) {
  Params p{};
  const float* const* in = (const float* const*)d_in;
  p.x = in[0]; p.c = in[1]; p.ctx = in[2]; p.c_ctx = in[3]; p.w_mod = in[4]; p.b_mod = in[5]; p.g_norm1 = in[6]; p.g_norm2 = in[7];
  p.w_in_even = in[8]; p.w_out_even = in[9]; p.g_qnorm = in[10]; p.g_knorm = in[11]; p.w_conv = in[12]; p.b_gate = in[13];
  p.g_hnorm = in[14]; p.w_in_odd = in[15]; p.w_pool_grp = in[16]; p.s_pool = in[17]; p.w_router = in[18]; p.w_exp_gate = in[19];
  p.w_exp_up = in[20]; p.w_exp_down = in[21]; p.g_final = in[22];
  p.out = (float*)d_out;
  char* w = (char*)d_ws;
  size_t off = 0;
  auto take = [&](size_t bytes) { char* r = w + off; off += (bytes + 255) & ~(size_t)255; return (void*)r; };
  p.xcur = (float*)take((size_t)NT * 1024 * 4);
  p.mod = (float*)take(4 * 9 * 6144 * 4);
  p.hbuf = (bf16_t*)take((size_t)NT * 1024 * 2);
  p.Ybuf = (bf16_t*)take((size_t)MOE_T * 1024 * 2);
  p.gatev = (float*)take(MOE_T * 4);
  p.rowidx = (int*)take(MOE_T * 4);
  p.slotmap = (int*)take((size_t)NT * 16 * 4);
  p.barw = (unsigned*)take(XCD_BAR_WORDS * 4);
  p.aff = (float*)take((size_t)NT * 16 * 4);
  p.gates = (float*)take((size_t)NT * 16 * 4);
  p.WinE = (bf16_t*)take((size_t)2 * PROJW * 1024 * 2);
  p.WoutE = (bf16_t*)take((size_t)2 * 1024 * 1024 * 2);
  p.WinO = (bf16_t*)take((size_t)2 * 1024 * 1024 * 2);
  p.Wgrp = (bf16_t*)take((size_t)2 * 1024 * 256 * 2);
  p.Wgu = (bf16_t*)take((size_t)4 * NEXP * 2048 * 1024 * 2);
  p.Wd = (bf16_t*)take((size_t)4 * NEXP * 1024 * 1024 * 2);
  const size_t uoff = off;
  p.proj = (bf16_t*)take((size_t)NT * PROJW * 2);
  p.Qb = (bf16_t*)take((size_t)NT * 512 * 2);
  p.Kb = (bf16_t*)take((size_t)NB * 2 * 2304 * 64 * 2);
  p.Vb = (bf16_t*)take((size_t)NB * 2 * 2304 * 64 * 2);
  p.qm = (bf16_t*)take((size_t)NT * 512 * 2);
  p.km = (bf16_t*)take((size_t)NT * 512 * 2);
  p.gsG = (float*)take((size_t)NT * 8 * 4);
  p.gsR = (float*)take((size_t)NT * 8 * 4);
  p.gsB = (float*)take((size_t)NT * 8 * 4);
  p.cMIN = (float*)take(64 * 18 * 4);
  p.cE1 = (float*)take(64 * 18 * 4);
  p.cDEC = (float*)take(64 * 18 * 4);
  p.cBE = (float*)take(64 * 18 * 4);
  p.cGM = (float*)take(64 * 18 * 4);
  p.Ubuf = (float*)take((size_t)64 * 17 * 16384 * 4);
  p.NLb = (float*)take((size_t)64 * 17 * 128 * 4);
  p.NVb = (float*)take((size_t)64 * 18 * 128 * 4);
  p.Cbf = (bf16_t*)take((size_t)64 * 18 * 16384 * 2);
  p.mix = (bf16_t*)take((size_t)NT * 1024 * 2);
  p.ybuf = (bf16_t*)take((size_t)NT * 1024 * 2);
  const size_t uend = off;
  off = uoff;
  p.Xs = (bf16_t*)take((size_t)MOE_T * 1024 * 2);
  p.Abuf = (bf16_t*)take((size_t)MOE_T * 1024 * 2);
  if (off < uend) off = uend;
  if (off > ws_size) { fprintf(stderr, "ws too small: need %zu have %zu\n", off, ws_size); return; }

  int n = 0;
  auto add = [&](int ph, int l) { p.prog_ph[n] = (unsigned char)ph; p.prog_l[n] = (unsigned char)l; ++n; };
  add(PH_INIT, 0);
  for (int l = 0; l < 4; ++l) {
    add(PH_NORM1, l);
    if ((l & 1) == 0) {
      add(PH_GEMM_IN_EVEN, l); add(PH_POST_EVEN, l); add(PH_MLSTM_U, l); add(PH_ATT, l); add(PH_MLSTM_H, l); add(PH_GEMM_OUT, l);
    } else {
      add(PH_GEMM_IN_ODD, l); add(PH_POOL, l); add(PH_GEMM_GRP, l);
    }
    add(PH_NORM2, l); add(PH_TOPK, l); add(PH_MOE_GU, l); add(PH_MOE_D, l);
  }
  add(PH_FINAL, 0);
  p.nprog = n;

  const int LDS = g8::STAGE_BYTES + 2048;
  static int grid_blocks = 0;
  if (!grid_blocks) {
    (void)hipFuncSetAttribute((const void*)mega_kernel, hipFuncAttributeMaxDynamicSharedMemorySize, LDS);
    int dev = 0, cus = 0, per_cu = 0;
    (void)hipGetDevice(&dev);
    (void)hipDeviceGetAttribute(&cus, hipDeviceAttributeMultiprocessorCount, dev);
    (void)hipOccupancyMaxActiveBlocksPerMultiprocessor(&per_cu, mega_kernel, NTHR, LDS);
    if (per_cu < 1) per_cu = 1;
    if (per_cu > 1) per_cu = 1;
    grid_blocks = cus * per_cu;
  }
  (void)hipMemsetAsync(p.barw, 0, XCD_BAR_WORDS * 4, stream);
  void* args[] = {&p};
  hipError_t e = hipLaunchCooperativeKernel((void*)mega_kernel, dim3(grid_blocks), dim3(NTHR), args, LDS, stream);
  if (e != hipSuccess) fprintf(stderr, "cooperative launch failed: %s (grid %d)\n", hipGetErrorString(e), grid_blocks);
}
```

```cpp
#include <hip/hip_runtime.h>
#include <hip/hip_cooperative_groups.h>
#include <math.h>
#include <stdio.h>
namespace cg = cooperative_groups;

#define DM 1024
#define NB 8
#define SEQ 2048
#define CTXL 256
#define NL (NB * SEQ)
#define NC (NB * CTXL)
#define NT (NL + NC)
#define EVEN_IN 2832
#define PROJW 2816
#define NEXP 16
#define MOE_L (NEXP * NB * 256)
#define MOE_C (NEXP * NB * 32)
#define MOE_T (MOE_L + MOE_C)
#define EPS 1e-6f
#define NTHR 512
#define LAS __attribute__((address_space(3)))

typedef unsigned short bf16_t;
typedef short bf16x8 __attribute__((ext_vector_type(8)));
typedef float f32x4 __attribute__((ext_vector_type(4)));
typedef unsigned u32x4 __attribute__((ext_vector_type(4)));
typedef unsigned u32x2 __attribute__((ext_vector_type(2)));

struct Params {
  const float *x, *c, *ctx, *c_ctx, *w_mod, *b_mod, *g_norm1, *g_norm2, *w_in_even, *w_out_even, *g_qnorm, *g_knorm,
      *w_conv, *b_gate, *g_hnorm, *w_in_odd, *w_pool_grp, *s_pool, *w_router, *w_exp_gate, *w_exp_up, *w_exp_down, *g_final;
  float* out;
  float *xcur, *mod, *gates, *aff, *gatev, *gsG, *gsR, *gsB, *cMIN, *cE1, *cDEC, *cBE, *cGM, *Ubuf, *NLb, *NVb;
  bf16_t *hbuf, *proj, *mix, *Xs, *Abuf, *Ybuf, *Qb, *Kb, *Vb, *qm, *km, *Cbf, *ybuf;
  bf16_t *WinE, *WoutE, *WinO, *Wgrp, *Wgu, *Wd;
  int *rowidx, *slotmap;
  unsigned* barw;
  int nprog;
  unsigned char prog_ph[60], prog_l[60];
};

__device__ __forceinline__ float siluf(float v) { return v / (1.f + expf(-v)); }
__device__ __forceinline__ float sigmoidf_(float v) { return 1.f / (1.f + expf(-v)); }
__device__ __forceinline__ float logsigmoidf_(float v) { return fminf(v, 0.f) - log1pf(expf(-fabsf(v))); }
__device__ __forceinline__ float wave_sum(float v) {
#pragma unroll
  for (int o = 32; o > 0; o >>= 1) v += __shfl_xor(v, o);
  return v;
}
__device__ __forceinline__ int modrow(int r) { return r < NL ? (r >> 11) : 8; }
__device__ __forceinline__ float bf2f(bf16_t v) { return __uint_as_float(((unsigned)v) << 16); }
typedef float f32x2_t __attribute__((ext_vector_type(2)));
typedef __bf16 bf16x2_t __attribute__((ext_vector_type(2)));
__device__ __forceinline__ unsigned cvt_pk_bf16(float lo, float hi) {
  const f32x2_t v = {lo, hi};
  return __builtin_bit_cast(unsigned, __builtin_convertvector(v, bf16x2_t));
}
__device__ __forceinline__ bf16_t f2bf(float f) { return (bf16_t)(cvt_pk_bf16(f, 0.f) & 0xffffu); }
__device__ __forceinline__ void unpack8(const u32x4 w, float (&f)[8]) {
  f[0] = __uint_as_float(w.x << 16); f[1] = __uint_as_float(w.x & 0xffff0000u); f[2] = __uint_as_float(w.y << 16); f[3] = __uint_as_float(w.y & 0xffff0000u);
  f[4] = __uint_as_float(w.z << 16); f[5] = __uint_as_float(w.z & 0xffff0000u); f[6] = __uint_as_float(w.w << 16); f[7] = __uint_as_float(w.w & 0xffff0000u);
}
__device__ __forceinline__ u32x4 pack8(const float (&f)[8]) {
  u32x4 w; w.x = cvt_pk_bf16(f[0], f[1]); w.y = cvt_pk_bf16(f[2], f[3]); w.z = cvt_pk_bf16(f[4], f[5]); w.w = cvt_pk_bf16(f[6], f[7]);
  return w;
}

__device__ __forceinline__ int ltid() { int t = threadIdx.x; asm volatile("" : "+v"(t)); return t; }
__device__ __forceinline__ int lbid() { int b = blockIdx.x; asm volatile("" : "+s"(b)); return b; }
__device__ __forceinline__ int lgdim() { int g = gridDim.x; asm volatile("" : "+s"(g)); return g; }

#define XB_TMO      128
#define XB_XCNT(j)  (256  + 64 * (j))
#define XB_XSUB(j)  (1280 + 64 * (j))
#define XB_XGEN(j)  (2304 + 64 * (j))
#define XB_TOP      3328
#define XB_TOPGEN   3392
#define XCD_BAR_WORDS 3456
#define XB_SPIN_CAP (1u << 18)
__device__ __forceinline__ unsigned xb_ld(unsigned* p)              { return __hip_atomic_load(p, __ATOMIC_RELAXED, __HIP_MEMORY_SCOPE_AGENT); }
__device__ __forceinline__ unsigned xb_add(unsigned* p, unsigned v) { return __hip_atomic_fetch_add(p, v, __ATOMIC_RELAXED, __HIP_MEMORY_SCOPE_AGENT); }
__device__ __forceinline__ unsigned xb_xcc_id() { return (unsigned)__builtin_amdgcn_s_getreg((3 << 11) | 20) & 0xFu; }
#define XB_SPIN(cond, bar) do { unsigned _sp = 0; while (cond) { __builtin_amdgcn_s_sleep(1); \
    if ((++_sp & 255u) == 0u) { if (xb_ld(&(bar)[XB_TMO])) break; if (_sp > XB_SPIN_CAP) { atomicAdd(&(bar)[XB_TMO], 1u); break; } } } } while (0)
struct XcdBarrier { unsigned* bar; unsigned x; volatile LAS unsigned* st; };
__device__ __forceinline__ XcdBarrier xcd_barrier_post(unsigned* bar, volatile LAS unsigned* st) {
  XcdBarrier b; b.bar = bar; b.x = xb_xcc_id(); b.st = st;
  if (threadIdx.x == 0) (void)xb_add(&bar[XB_XCNT(b.x)], 1u);
  return b;
}
__device__ __forceinline__ void xcd_barrier_complete(unsigned* bar, unsigned x, unsigned& nloc, unsigned& nx) {
  const unsigned G = gridDim.x * gridDim.y * gridDim.z;
  unsigned sum, cnt, mine, sp = 0u;
  for (;;) {
    sum = 0u; cnt = 0u; mine = 0u;
#pragma unroll
    for (unsigned j = 0; j < 16; ++j) { const unsigned c = xb_ld(&bar[XB_XCNT(j)]); sum += c; cnt += (c > 0u) ? 1u : 0u; mine = (j == x) ? c : mine; }
    if (sum == G) break;
    __builtin_amdgcn_s_sleep(1);
    if ((++sp & 255u) == 0u) { if (xb_ld(&bar[XB_TMO])) break; if (sp > XB_SPIN_CAP) { atomicAdd(&bar[XB_TMO], 1u); break; } }
  }
  nloc = mine > 0u ? mine : 1u; nx = cnt > 0u ? cnt : 1u;
}
__device__ __forceinline__ void xcd_barrier(const XcdBarrier& b) {
  asm volatile("s_waitcnt vmcnt(0)" ::: "memory");
  __syncthreads();
  if (threadIdx.x == 0) {
    unsigned* bar = b.bar;
    __builtin_amdgcn_s_waitcnt(0);
    unsigned nloc = b.st[0], nx = b.st[1];
    if (nloc == 0u) { xcd_barrier_complete(bar, b.x, nloc, nx); b.st[0] = nloc; b.st[1] = nx; }
    const unsigned old = xb_add(&bar[XB_XSUB(b.x)], 1u);
    const unsigned gen = old / nloc;
    if (old + 1u == (gen + 1u) * nloc) {
      __builtin_amdgcn_fence(__ATOMIC_RELEASE, "agent");
      asm volatile("s_waitcnt vmcnt(0)" ::: "memory");
      const unsigned og = xb_add(&bar[XB_TOP], 1u);
      const unsigned tg = og / nx;
      if (og + 1u == (tg + 1u) * nx) xb_add(&bar[XB_TOPGEN], 1u);
      else XB_SPIN(xb_ld(&bar[XB_TOPGEN]) == tg, bar);
      __builtin_amdgcn_fence(__ATOMIC_ACQUIRE, "agent");
      xb_add(&bar[XB_XGEN(b.x)], 1u);
      asm volatile("s_waitcnt vmcnt(0)" ::: "memory");
    } else {
      XB_SPIN(xb_ld(&bar[XB_XGEN(b.x)]) == gen, bar);
      __builtin_amdgcn_fence(__ATOMIC_ACQUIRE, "agent");
      asm volatile("s_waitcnt vmcnt(0)" ::: "memory");
    }
  }
  __syncthreads();
}

namespace g8 {
constexpr int BM = 256, BK = 64, HALF = 128, HTB = HALF * BK * 2, STAGE_BYTES = 8 * HTB;
__device__ __forceinline__ int lds_byte(int r, int c) { const int st = (r >> 4) * 2 + (c >> 5), rr = r & 15, cc = c & 31, ob = rr * 64 + cc * 2; return st * 1024 + (ob ^ (((ob >> 9) & 1) << 5)); }
__device__ __forceinline__ void stage_rc(int b, int& R, int& C) { const int st = b / 1024, sb = b % 1024, swz = sb ^ (((sb >> 9) & 1) << 5); R = (st >> 1) * 16 + swz / 64; C = (st & 1) * 32 + (swz % 64) / 2; }
__device__ __forceinline__ int perm32(int rho) { const int n = rho >> 4, i = rho & 15; return 8 * (i >> 2) + 4 * n + (i & 3); }

struct Unit { const char* A; const char* B; int row0, col0; };

template <bool GATHER = false, class Epi, class Sched>
__device__ __forceinline__ void gemm_phase(LAS unsigned char* lds, const int K, const int lda, const int ldb, const Sched& S, const Epi& E, const int* gidx = nullptr, const char* gbaseA = nullptr) {
  const int tid = ltid(), wid = __builtin_amdgcn_readfirstlane(tid >> 6), lane = tid & 63, wr = wid >> 2, wc = wid & 3, fr = lane & 15, fq = lane >> 4;
  const int nt = K / BK;
  unsigned voffA[2], voffB[2], gC2[2];
  int gR[2];
#pragma unroll
  for (int i = 0; i < 2; ++i) {
    int R, C;
    stage_rc(tid * 16 + i * 8192, R, C);
    const int Rb = (R & ~31) + perm32(R & 31);
    voffA[i] = (unsigned)(R * lda + C) * 2u;
    voffB[i] = (unsigned)(Rb * ldb + C) * 2u;
    gR[i] = R; gC2[i] = (unsigned)C * 2u;
  }
  unsigned gcur[2][2], gnxt[2][2];
  auto gload = [&](int row0, unsigned (&g)[2][2]) {
#pragma unroll
    for (int h = 0; h < 2; ++h)
#pragma unroll
      for (int i = 0; i < 2; ++i) g[h][i] = (unsigned)gidx[row0 + h * HALF + gR[i]] * (unsigned)(lda * 2) + gC2[i];
  };
  const size_t kstep = (size_t)(BK * 2);
  const size_t hstepA = (size_t)HALF * lda * 2, hstepB = (size_t)HALF * ldb * 2;
  const unsigned ldsw = (unsigned)wid * 1024u;
  const int aoff = lds_byte(wr * 64 + fr, fq * 8), boff = lds_byte(wc * 32 + fr, fq * 8);
#define PG8_SA(b, h) (((b) * 2 + (h)) * HTB)
#define PG8_SB(b, h) ((4 + (b) * 2 + (h)) * HTB)
#define PG8_STAGE(bufoff, gbase, voff) do { _Pragma("unroll") for (int _i = 0; _i < 2; ++_i) \
    __builtin_amdgcn_global_load_lds((const unsigned*)((const char*)(gbase) + (voff)[_i]), (LAS unsigned*)(lds + (bufoff) + ldsw + _i * 8192), 16, 0, 0); } while (0)
#define PG8_LDA(dst, b, h) do { _Pragma("unroll") for (int m = 0; m < 4; ++m) _Pragma("unroll") for (int k = 0; k < 2; ++k) dst[m][k] = *(const LAS bf16x8*)(lds + PG8_SA(b, h) + aoff + m * 2048 + k * 1024); } while (0)
#define PG8_LDB(dst, b, h) do { _Pragma("unroll") for (int n = 0; n < 2; ++n) _Pragma("unroll") for (int k = 0; k < 2; ++k) dst[n][k] = *(const LAS bf16x8*)(lds + PG8_SB(b, h) + boff + n * 2048 + k * 1024); } while (0)
#define PG8_MMA(ai, bj, At, Bt) do { __builtin_amdgcn_s_setprio(1); _Pragma("unroll") for (int m = 0; m < 4; ++m) _Pragma("unroll") for (int n = 0; n < 2; ++n) _Pragma("unroll") for (int k = 0; k < 2; ++k) \
    acc[ai][bj][m][n] = __builtin_amdgcn_mfma_f32_16x16x32_bf16(Bt[n][k], At[m][k], acc[ai][bj][m][n], 0, 0, 0); __builtin_amdgcn_s_setprio(0); } while (0)
#define PG8_WAIT_V(n) asm volatile("s_waitcnt vmcnt(" #n ")" ::: "memory")
#define PG8_WAIT_L(n) asm volatile("s_waitcnt lgkmcnt(" #n ")" ::: "memory")
#define PG8_BAR __builtin_amdgcn_s_barrier()
#define PG8_SCHED __builtin_amdgcn_sched_barrier(0)
#define PG8_STAGE_A(bufoff, nextu, half, kbytes) do { \
    if constexpr (GATHER) { if (nextu) PG8_STAGE(bufoff, gbaseA + (kbytes), gnxt[half]); else PG8_STAGE(bufoff, gbaseA + (kbytes), gcur[half]); } \
    else { PG8_STAGE(bufoff, ((nextu) ? nA : cA) + (half) * hstepA + (kbytes), voffA); } } while (0)
  Unit cur, nxt;
  int ui = 0;
  if (!S.next(0, cur)) return;
  f32x4 acc[2][2][4][2];
#pragma unroll
  for (int a = 0; a < 2; ++a)
#pragma unroll
    for (int b = 0; b < 2; ++b)
#pragma unroll
      for (int m = 0; m < 4; ++m)
#pragma unroll
        for (int n = 0; n < 2; ++n) acc[a][b][m][n] = (f32x4){0.f, 0.f, 0.f, 0.f};
  bf16x8 At[4][2], B0[2][2], B1[2][2];
  const char* cA = cur.A;
  const char* cB = cur.B;
  const char* nA = cA;
  if constexpr (GATHER) { gload(cur.row0, gcur); gload(cur.row0, gnxt); asm volatile("s_waitcnt vmcnt(0)" ::: "memory"); }
  PG8_STAGE(PG8_SB(0, 0), cB, voffB); PG8_STAGE(PG8_SB(0, 1), cB + hstepB, voffB); PG8_STAGE_A(PG8_SA(0, 0), false, 0, 0); PG8_STAGE_A(PG8_SA(0, 1), false, 1, 0);
  if (wr == 1) PG8_BAR;
  PG8_WAIT_V(2); PG8_BAR;
  PG8_STAGE(PG8_SB(1, 0), cB + kstep, voffB); PG8_STAGE_A(PG8_SA(1, 0), false, 0, kstep); PG8_STAGE(PG8_SB(1, 1), cB + hstepB + kstep, voffB);
  PG8_WAIT_V(6); PG8_BAR;
  for (;;) {
    const bool has_next = S.next(ui + 1, nxt);
    nA = has_next ? nxt.A : cA;
    const char* nB = has_next ? nxt.B : cB;
    if constexpr (GATHER) { if (has_next) gload(nxt.row0, gnxt); else {
#pragma unroll
      for (int h = 0; h < 2; ++h)
#pragma unroll
        for (int i = 0; i < 2; ++i) gnxt[h][i] = gcur[h][i]; } }
    for (int t = 0; t < nt; t += 2) {
      const bool last = (t == nt - 2);
      const size_t k1 = (size_t)(t + 1) * kstep;
      const size_t k2 = last ? 0 : (size_t)(t + 2) * kstep;
      const size_t k3 = k2 + kstep;
      const char* b2 = last ? nB : cB + (size_t)(t + 2) * kstep;
      const char* b3 = b2 + kstep;
      PG8_LDB(B0, 0, 0); PG8_LDB(B1, 0, 1); PG8_SCHED; PG8_LDA(At, 0, 0); PG8_STAGE_A(PG8_SA(1, 1), false, 1, k1);
      PG8_WAIT_V(8); PG8_WAIT_L(0); PG8_BAR; PG8_MMA(0, 0, At, B0); PG8_MMA(0, 1, At, B1); PG8_BAR; PG8_SCHED;
      PG8_LDA(At, 0, 1); PG8_STAGE(PG8_SB(0, 0), b2, voffB); PG8_STAGE(PG8_SB(0, 1), b2 + hstepB, voffB); PG8_STAGE_A(PG8_SA(0, 0), last, 0, k2);
      PG8_WAIT_V(8); PG8_WAIT_L(0); PG8_BAR; PG8_MMA(1, 0, At, B0); PG8_MMA(1, 1, At, B1); PG8_BAR; PG8_SCHED;
      PG8_LDB(B0, 1, 0); PG8_LDB(B1, 1, 1); PG8_SCHED; PG8_LDA(At, 1, 0); PG8_STAGE_A(PG8_SA(0, 1), last, 1, k2);
      PG8_WAIT_V(8); PG8_WAIT_L(0); PG8_BAR; PG8_MMA(0, 0, At, B0); PG8_MMA(0, 1, At, B1); PG8_BAR; PG8_SCHED;
      PG8_LDA(At, 1, 1); PG8_STAGE(PG8_SB(1, 0), b3, voffB); PG8_STAGE(PG8_SB(1, 1), b3 + hstepB, voffB); PG8_STAGE_A(PG8_SA(1, 0), last, 0, k3);
      PG8_WAIT_V(8); PG8_WAIT_L(0); PG8_BAR; PG8_MMA(1, 0, At, B0); PG8_MMA(1, 1, At, B1); PG8_BAR; PG8_SCHED;
    }
    if (wr == 0) PG8_BAR;
    E(acc, cur, wr, wc, fr, fq);
    if (!has_next) break;
#pragma unroll
    for (int a = 0; a < 2; ++a)
#pragma unroll
      for (int b = 0; b < 2; ++b)
#pragma unroll
        for (int m = 0; m < 4; ++m)
#pragma unroll
          for (int n = 0; n < 2; ++n) acc[a][b][m][n] = (f32x4){0.f, 0.f, 0.f, 0.f};
    cur = nxt; cA = nA; cB = nB; ++ui;
    if constexpr (GATHER) {
#pragma unroll
      for (int h = 0; h < 2; ++h)
#pragma unroll
        for (int i = 0; i < 2; ++i) gcur[h][i] = gnxt[h][i];
    }
    if (wr == 1) PG8_BAR;
  }
  PG8_WAIT_V(0);
  PG8_BAR;
#undef PG8_SA
#undef PG8_SB
#undef PG8_STAGE
#undef PG8_STAGE_A
#undef PG8_LDA
#undef PG8_LDB
#undef PG8_MMA
#undef PG8_WAIT_V
#undef PG8_WAIT_L
#undef PG8_BAR
#undef PG8_SCHED
}

struct SchedDense {
  const char* A; const char* B; int lda, ldb, nM, nN, acolstep, G, c;
  __device__ __forceinline__ bool next(int i, Unit& u) const {
    const int nwg = nM * nN;
    const long L = (long)i * G + c;
    if (L >= nwg) return false;
    int wgid = (int)L;
    { const int q = nwg / 8, r = nwg % 8, xcd = wgid % 8, off = wgid / 8; wgid = (xcd < r ? xcd * (q + 1) : r * (q + 1) + (xcd - r) * q) + off; }
    const int nig = 8 * nN, gid = wgid / nig, fm = gid * 8, gsz = (nM - fm) < 8 ? (nM - fm) : 8;
    const int pm = fm + ((wgid % nig) % gsz), pn = (wgid % nig) / gsz;
    u.A = A + (size_t)pm * 256 * lda * 2 + (size_t)pn * acolstep;
    u.B = B + (size_t)pn * 256 * ldb * 2;
    u.row0 = pm * 256; u.col0 = pn * 256;
    return true;
  }
};
struct SchedMoe {
  const char* A; const char* W; int ncol, wrows, colw, nu, G, c;
  __device__ __forceinline__ bool next(int i, Unit& u) const {
    const long L = (long)i * G + c;
    if (L >= nu) return false;
    const int wgid = (int)(L % 8) * (nu / 8) + (int)(L / 8);
    const int UL = 128 * ncol;
    int e, pn, row0;
    if (wgid < UL) { e = wgid / (8 * ncol); const int rem = wgid % (8 * ncol); row0 = e * 2048 + (rem % 8) * 256; pn = rem / 8; }
    else { const int w2 = wgid - UL; e = w2 / ncol; pn = w2 % ncol; row0 = MOE_L + e * 256; }
    u.A = A + (size_t)row0 * 1024 * 2;
    u.B = W + ((size_t)e * wrows + (size_t)pn * 256) * 1024 * 2;
    u.row0 = row0; u.col0 = pn * colw;
    return true;
  }
};

struct EpiBf16 {
  bf16_t* O; int ldo;
  __device__ __forceinline__ void operator()(const f32x4 (&acc)[2][2][4][2], const Unit& u, int wr, int wc, int fr, int fq) const {
#pragma unroll
    for (int ai = 0; ai < 2; ++ai)
#pragma unroll
      for (int m = 0; m < 4; ++m) {
        const int row = u.row0 + ai * 128 + wr * 64 + m * 16 + fr;
        bf16_t* rp = O + (size_t)row * ldo + u.col0 + wc * 32 + 8 * fq;
#pragma unroll
        for (int bj = 0; bj < 2; ++bj) {
          const f32x4 v0 = acc[ai][bj][m][0], v1 = acc[ai][bj][m][1];
          u32x4 w; w.x = cvt_pk_bf16(v0[0], v0[1]); w.y = cvt_pk_bf16(v0[2], v0[3]); w.z = cvt_pk_bf16(v1[0], v1[1]); w.w = cvt_pk_bf16(v1[2], v1[3]);
          *(u32x4*)(rp + bj * 128) = w;
        }
      }
  }
};
struct EpiResid {
  float* x; const float* modg; const float* cs; const float* xl; const float* xc;
  __device__ __forceinline__ void operator()(const f32x4 (&acc)[2][2][4][2], const Unit& u, int wr, int wc, int fr, int fq) const {
#pragma unroll
    for (int ai = 0; ai < 2; ++ai)
#pragma unroll
      for (int m = 0; m < 4; ++m) {
        const int row = u.row0 + ai * 128 + wr * 64 + m * 16 + fr;
        const int c0 = u.col0 + wc * 32 + 8 * fq;
        float* xp = x + (size_t)row * 1024 + c0;
        const float* xi = xl ? (row < NL ? xl + (size_t)row * 1024 + c0 : xc + (size_t)(row - NL) * 1024 + c0) : xp;
        const float* gp = modg + (size_t)modrow(row) * 6144 + c0;
#pragma unroll
        for (int bj = 0; bj < 2; ++bj) {
          f32x4 g0 = *(const f32x4*)(gp + bj * 128), g1 = *(const f32x4*)(gp + bj * 128 + 4);
          if (cs) { g0 *= *(const f32x4*)(cs + c0 + bj * 128); g1 *= *(const f32x4*)(cs + c0 + bj * 128 + 4); }
          f32x4 x0 = *(const f32x4*)(xi + bj * 128), x1 = *(const f32x4*)(xi + bj * 128 + 4);
          x0 += g0 * acc[ai][bj][m][0]; x1 += g1 * acc[ai][bj][m][1];
          *(f32x4*)(xp + bj * 128) = x0; *(f32x4*)(xp + bj * 128 + 4) = x1;
        }
      }
  }
};
struct EpiSwiGLU {
  bf16_t* O;
  __device__ __forceinline__ void operator()(const f32x4 (&acc)[2][2][4][2], const Unit& u, int wr, int wc, int fr, int fq) const {
#pragma unroll
    for (int ai = 0; ai < 2; ++ai)
#pragma unroll
      for (int m = 0; m < 4; ++m) {
        const int row = u.row0 + ai * 128 + wr * 64 + m * 16 + fr;
        bf16_t* rp = O + (size_t)row * 1024 + u.col0 + wc * 32 + 8 * fq;
        float o[8];
#pragma unroll
        for (int n = 0; n < 2; ++n)
#pragma unroll
          for (int j = 0; j < 4; ++j) { const float g = acc[ai][0][m][n][j], up = acc[ai][1][m][n][j]; o[n * 4 + j] = g / (1.f + __expf(-g)) * up; }
        u32x4 w; w.x = cvt_pk_bf16(o[0], o[1]); w.y = cvt_pk_bf16(o[2], o[3]); w.z = cvt_pk_bf16(o[4], o[5]); w.w = cvt_pk_bf16(o[6], o[7]);
        *(u32x4*)rp = w;
      }
  }
};
struct EpiDown {
  bf16_t* O; const float* gatev;
  __device__ __forceinline__ void operator()(const f32x4 (&acc)[2][2][4][2], const Unit& u, int wr, int wc, int fr, int fq) const {
#pragma unroll
    for (int ai = 0; ai < 2; ++ai)
#pragma unroll
      for (int m = 0; m < 4; ++m) {
        const int row = u.row0 + ai * 128 + wr * 64 + m * 16 + fr;
        const float gv = gatev[row];
        bf16_t* rp = O + (size_t)row * 1024 + u.col0 + wc * 32 + 8 * fq;
#pragma unroll
        for (int bj = 0; bj < 2; ++bj) {
          const f32x4 v0 = acc[ai][bj][m][0] * gv, v1 = acc[ai][bj][m][1] * gv;
          u32x4 w; w.x = cvt_pk_bf16(v0[0], v0[1]); w.y = cvt_pk_bf16(v0[2], v0[3]); w.z = cvt_pk_bf16(v1[0], v1[1]); w.w = cvt_pk_bf16(v1[2], v1[3]);
          *(u32x4*)(rp + bj * 128) = w;
        }
      }
  }
};
}

#define NT_WINE 1408
#define NT_WOUT 512
#define NT_WINO 512
#define NT_WGRP 128
#define NT_EXP 16384
#define NT_ALL (NT_WINE + NT_WOUT + NT_WINO + NT_WGRP + 3 * NT_EXP)
#define CE0 704
#define CE1 960
#define CE2 13248
#define CE3 13504
#define CE4 13568
#define CE5 25856
#define CE6 26560
#define CE7 26816
#define CE8 39104
#define CE9 39360
#define CE10 39424
#define CE11 51712
__device__ __forceinline__ void conv_batch(const Params& p, int t, float* T) {
  const int tid = ltid(), lane = tid & 63, wv = tid >> 6;
  const float* src; bf16_t* dst; int ld, dK, k0, n0;
  int seg, tb, e, which = 0;
  if (t < CE0) { seg = 0; e = 0; tb = t; } else if (t < CE1) { seg = 1; e = 0; tb = t - CE0; } else if (t < CE2) { seg = 2; e = 0; tb = t - CE1; }
  else if (t < CE3) { seg = 3; e = 0; tb = t - CE2; } else if (t < CE4) { seg = 4; e = 0; tb = t - CE3; } else if (t < CE5) { seg = 2; e = 1; tb = t - CE4; }
  else if (t < CE6) { seg = 0; e = 1; tb = t - CE5; } else if (t < CE7) { seg = 1; e = 1; tb = t - CE6; } else if (t < CE8) { seg = 2; e = 2; tb = t - CE7; }
  else if (t < CE9) { seg = 3; e = 1; tb = t - CE8; } else if (t < CE10) { seg = 4; e = 1; tb = t - CE9; } else { seg = 2; e = 3; tb = t - CE10; }
  int dbase = 0;
  if (seg == 0) {
    k0 = (tb / 44) * 64; n0 = (tb % 44) * 64;
    src = p.w_in_even + (size_t)e * 1024 * EVEN_IN; ld = EVEN_IN; dst = p.WinE + (size_t)e * PROJW * 1024; dK = 1024;
  } else if (seg == 1 || seg == 3) {
    k0 = (tb / 16) * 64; n0 = (tb % 16) * 64;
    src = (seg == 3 ? p.w_in_odd : p.w_out_even) + (size_t)e * 1024 * 1024; ld = 1024; dst = (seg == 3 ? p.WinO : p.WoutE) + (size_t)e * 1024 * 1024; dK = 1024;
  } else if (seg == 4) {
    const int g = tb / 16; k0 = ((tb % 16) / 4) * 64; n0 = (tb % 4) * 64;
    src = p.w_pool_grp + (size_t)(e * 4 + g) * 65536; ld = 256; dst = p.Wgrp + (size_t)e * 1024 * 256; dK = 256; dbase = g * 256;
  } else {
    which = tb / 4096; const int r = tb % 4096, le = e * 16 + r / 256; k0 = ((r % 256) / 16) * 64; n0 = (r % 16) * 64;
    const float* base = which == 0 ? p.w_exp_gate : (which == 1 ? p.w_exp_up : p.w_exp_down);
    src = base + (size_t)le * 1024 * 1024; ld = 1024; dK = 1024;
    dst = which < 2 ? p.Wgu + (size_t)le * 2048 * 1024 : p.Wd + (size_t)le * 1024 * 1024;
  }
  const bool gu = (seg == 2 && which < 2);
  float4 v[8];
#pragma unroll
  for (int q = 0; q < 8; ++q) {
    const int idx = tid + q * NTHR, k = idx >> 6, c4 = idx & 63;
    v[q] = *(const float4*)(src + (size_t)(k0 + k) * ld + n0 + c4 * 4);
  }
#pragma unroll
  for (int q = 0; q < 8; ++q) {
    const int idx = tid + q * NTHR, k = idx >> 6, c4 = idx & 63;
    float* tp = T + k * 257 + c4 * 4;
    tp[0] = v[q].x; tp[1] = v[q].y; tp[2] = v[q].z; tp[3] = v[q].w;
  }
  __syncthreads();
#pragma unroll
  for (int sub = 0; sub < 4; ++sub) {
    const int nl = wv * 8 + (lane >> 3), kq = lane & 7, nn = n0 + sub * 64;
    const int drow0 = gu ? (nn >> 7) * 256 + which * 128 + (nn & 127) : dbase + nn;
    float f[8];
#pragma unroll
    for (int j = 0; j < 8; ++j) f[j] = T[(kq * 8 + j) * 257 + sub * 64 + nl];
    u32x4 w; w.x = cvt_pk_bf16(f[0], f[1]); w.y = cvt_pk_bf16(f[2], f[3]); w.z = cvt_pk_bf16(f[4], f[5]); w.w = cvt_pk_bf16(f[6], f[7]);
    *(u32x4*)(dst + (size_t)(drow0 + nl) * dK + k0 + kq * 8) = w;
  }
}
__device__ __forceinline__ int conv_pull(const Params& p, float* sm) {
  __syncthreads();
  if (ltid() == 0) ((int*)sm)[16500] = (int)__hip_atomic_fetch_add(p.barw, 4u, __ATOMIC_RELAXED, __HIP_MEMORY_SCOPE_AGENT);
  __syncthreads();
  return ((int*)sm)[16500];
}
__device__ __forceinline__ void conv_until(const Params& p, int end, float* sm) {
  int t;
  do { t = conv_pull(p, sm); if (t < CE11) conv_batch(p, t, sm); } while (t + 4 < end);
  __syncthreads();
}
__device__ __forceinline__ void conv_quota(const Params& p, int n, float* sm) {
  for (int i = 0; i < n; ++i) { const int t = conv_pull(p, sm); if (t >= CE11) break; conv_batch(p, t, sm); }
  __syncthreads();
}

__device__ __forceinline__ void ph_init(const Params& p, float* sm) {
  const int tid = ltid(), lane = tid & 63, wv = tid >> 6;
  const size_t gtid = (size_t)lbid() * NTHR + tid, gsz = (size_t)lgdim() * NTHR;
  for (int i = tid; i < 9 * 1024; i += NTHR) {
    const int r = i >> 10, k = i & 1023;
    sm[i] = siluf(r < 8 ? p.c[r * 1024 + k] : p.c_ctx[k]);
  }
  __syncthreads();
  float* part = sm + 9 * 1024;
  for (int item = lbid(); item < 768; item += lgdim()) {
    const int l = item / 192, j0 = (item % 192) * 32;
    const int col = lane & 31, kh = lane >> 5;
    const float* w = p.w_mod + (size_t)l * 1024 * 6144 + j0 + col;
    float acc[9];
#pragma unroll
    for (int r = 0; r < 9; ++r) acc[r] = 0.f;
    const int kb = wv * 128 + kh * 64;
#pragma unroll 4
    for (int kk = 0; kk < 64; ++kk) {
      const float wvv = w[(size_t)(kb + kk) * 6144];
#pragma unroll
      for (int r = 0; r < 9; ++r) acc[r] += sm[r * 1024 + kb + kk] * wvv;
    }
#pragma unroll
    for (int r = 0; r < 9; ++r) part[((wv * 2 + kh) * 9 + r) * 32 + col] = acc[r];
    __syncthreads();
    if (tid < 288) {
      const int r = tid >> 5, cc = tid & 31;
      float s = 0.f;
#pragma unroll
      for (int sl = 0; sl < 16; ++sl) s += part[(sl * 9 + r) * 32 + cc];
      p.mod[(size_t)(l * 9 + r) * 6144 + j0 + cc] = s + p.b_mod[l * 6144 + j0 + cc];
    }
    __syncthreads();
  }
  conv_until(p, CE1, sm);
}

typedef float f32x4m __attribute__((ext_vector_type(4)));
__device__ __forceinline__ void ph_norm(const Params& p, int l, int which, int nrows, int ncomb, int lprev, float* sm) {
  const int tid = ltid(), lane = tid & 63, wv = tid >> 6;
  const bool skinny = (which == 2) || (which == 1 && (l & 1) == 0);
  bf16_t* HROW = (bf16_t*)sm;
  float* PART = sm + 8192;
  bf16x8 Bhi[4], Blo[4];
  if (skinny) {
    const float* wbase; int stride;
    if (which == 2) { wbase = p.w_router + (size_t)l * 1024 * 16; stride = 16; }
    else { wbase = p.w_in_even + (size_t)(l >> 1) * 1024 * EVEN_IN + PROJW; stride = EVEN_IN; }
    const int kg = lane >> 4, n = lane & 15;
#pragma unroll
    for (int ks = 0; ks < 4; ++ks) {
      float f[8], hi[8], lo[8];
#pragma unroll
      for (int j = 0; j < 8; ++j) f[j] = wbase[(size_t)(wv * 128 + ks * 32 + kg * 8 + j) * stride + n];
      const u32x4 hw = pack8(f);
      unpack8(hw, hi);
#pragma unroll
      for (int j = 0; j < 8; ++j) lo[j] = f[j] - hi[j];
      Bhi[ks] = __builtin_bit_cast(bf16x8, hw);
      Blo[ks] = __builtin_bit_cast(bf16x8, pack8(lo));
    }
  }
  const int nwaves = lgdim() * (NTHR / 64), gw = lbid() * (NTHR / 64) + wv;
  const int per = (nrows + nwaves - 1) / nwaves;
  const int rbeg = gw * per, rend = min(nrows, rbeg + per);
  const bool in0 = (which == 1 && l == 0);
  float4 vn[4];
  int slvn = -1;
  {
    const int r0 = min(rbeg, nrows - 1);
    const float* xs0 = in0 ? (r0 < NL ? p.x + (size_t)r0 * DM : p.ctx + (size_t)(r0 - NL) * DM) : p.xcur + (size_t)r0 * DM;
#pragma unroll
    for (int i = 0; i < 4; ++i) vn[i] = ((const float4*)xs0)[i * 64 + lane];
    if (r0 < ncomb && lane < 16) slvn = p.slotmap[r0 * 16 + lane];
  }
  float4 cA[4], cB[4], cG[4], yn[4];
  int mr_c = -1;
  if (which == 2) {
    const u32x2* yp0 = (const u32x2*)(p.ybuf + (size_t)min(rbeg, nrows - 1) * DM);
#pragma unroll
    for (int i = 0; i < 4; ++i) { const u32x2 y = yp0[i * 64 + lane]; yn[i] = make_float4(__uint_as_float(y.x << 16), __uint_as_float(y.x & 0xffff0000u), __uint_as_float(y.y << 16), __uint_as_float(y.y & 0xffff0000u)); }
  }
  for (int it = 0; it < per; ++it) {
    const int rr = rbeg + it;
    const bool live = rr < rend;
    const int r = min(rr, nrows - 1);
    float4 v[4];
#pragma unroll
    for (int i = 0; i < 4; ++i) v[i] = vn[i];
    const int slv = slvn;
    float* xr = p.xcur + (size_t)r * DM;
    if (it + 1 < per) {
      const int rn = min(rr + 1, nrows - 1);
      const float* xsn = in0 ? (rn < NL ? p.x + (size_t)rn * DM : p.ctx + (size_t)(rn - NL) * DM) : p.xcur + (size_t)rn * DM;
#pragma unroll
      for (int i = 0; i < 4; ++i) vn[i] = ((const float4*)xsn)[i * 64 + lane];
      slvn = (rn < ncomb && lane < 16) ? p.slotmap[rn * 16 + lane] : -1;
    }
    const int mr = modrow(r);
    if (mr != mr_c) {
      mr_c = mr;
      if (which == 3) {
#pragma unroll
        for (int i = 0; i < 4; ++i) cA[i] = ((const float4*)p.g_final)[i * 64 + lane];
      } else {
        const float* gn = (which == 1 ? p.g_norm1 : p.g_norm2) + l * 1024;
        const float* mrow = p.mod + (size_t)(l * 9 + mr) * 6144;
        const float4* shp = (const float4*)(mrow + (which == 1 ? 0 : 3) * 1024);
        const float4* scp = (const float4*)(mrow + (which == 1 ? 1 : 4) * 1024);
#pragma unroll
        for (int i = 0; i < 4; ++i) {
          const float4 g = ((const float4*)gn)[i * 64 + lane], sc = scp[i * 64 + lane];
          cA[i] = make_float4(g.x * (1.f + sc.x), g.y * (1.f + sc.y), g.z * (1.f + sc.z), g.w * (1.f + sc.w));
          cB[i] = shp[i * 64 + lane];
        }
      }
      if (which == 2) {
        const float4* g2 = (const float4*)(p.mod + (size_t)(l * 9 + mr) * 6144 + 2 * 1024);
        const float4* spv = (const float4*)(p.s_pool + (size_t)(l >> 1) * 1024);
#pragma unroll
        for (int i = 0; i < 4; ++i) {
          float4 g = g2[i * 64 + lane];
          if (l & 1) { const float4 sp4 = spv[i * 64 + lane]; g.x *= sp4.x; g.y *= sp4.y; g.z *= sp4.z; g.w *= sp4.w; }
          cG[i] = g;
        }
      } else if (ncomb > 0) {
        const float4* g5 = (const float4*)(p.mod + (size_t)(lprev * 9 + mr) * 6144 + 5 * 1024);
#pragma unroll
        for (int i = 0; i < 4; ++i) cG[i] = g5[i * 64 + lane];
      }
    }
    if (live && r < ncomb) {
      float4 s4[4];
#pragma unroll
      for (int i = 0; i < 4; ++i) s4[i] = make_float4(0.f, 0.f, 0.f, 0.f);
      unsigned long long mask = __ballot(slv >= 0);
      while (mask) {
        const int e = __ffsll((long long)mask) - 1;
        mask &= mask - 1;
        const int sl = __shfl(slv, e);
        size_t yrow;
        if (r < NL) yrow = (size_t)e * 2048 + (size_t)(r >> 11) * 256 + sl;
        else yrow = (size_t)MOE_L + (size_t)e * 256 + (size_t)((r - NL) >> 8) * 32 + sl;
        const u32x2* yp = (const u32x2*)(p.Ybuf + yrow * DM);
#pragma unroll
        for (int i = 0; i < 4; ++i) {
          const u32x2 y = yp[i * 64 + lane];
          s4[i].x += __uint_as_float(y.x << 16); s4[i].y += __uint_as_float(y.x & 0xffff0000u);
          s4[i].z += __uint_as_float(y.y << 16); s4[i].w += __uint_as_float(y.y & 0xffff0000u);
        }
      }
#pragma unroll
      for (int i = 0; i < 4; ++i) {
        const float4 g = cG[i];
        v[i].x += g.x * s4[i].x; v[i].y += g.y * s4[i].y; v[i].z += g.z * s4[i].z; v[i].w += g.w * s4[i].w;
        if (which != 3) ((float4*)xr)[i * 64 + lane] = v[i];
      }
    }
    if (which == 2) {
      float4 yc[4];
#pragma unroll
      for (int i = 0; i < 4; ++i) yc[i] = yn[i];
      if (it + 1 < per) {
        const u32x2* ypn = (const u32x2*)(p.ybuf + (size_t)min(rr + 1, nrows - 1) * DM);
#pragma unroll
        for (int i = 0; i < 4; ++i) { const u32x2 y = ypn[i * 64 + lane]; yn[i] = make_float4(__uint_as_float(y.x << 16), __uint_as_float(y.x & 0xffff0000u), __uint_as_float(y.y << 16), __uint_as_float(y.y & 0xffff0000u)); }
      }
      const float* xin = (r < NL ? p.x + (size_t)r * DM : p.ctx + (size_t)(r - NL) * DM);
#pragma unroll
      for (int i = 0; i < 4; ++i) {
        if (l == 0) v[i] = ((const float4*)xin)[i * 64 + lane];
        v[i].x += cG[i].x * yc[i].x; v[i].y += cG[i].y * yc[i].y; v[i].z += cG[i].z * yc[i].z; v[i].w += cG[i].w * yc[i].w;
        if (live) ((float4*)xr)[i * 64 + lane] = v[i];
      }
    }
    float ss = 0.f;
#pragma unroll
    for (int i = 0; i < 4; ++i) ss += v[i].x * v[i].x + v[i].y * v[i].y + v[i].z * v[i].z + v[i].w * v[i].w;
    ss = wave_sum(ss);
    const float inv = rsqrtf(ss * (1.f / 1024.f) + EPS);
    if (which == 3) {
      if (live) {
#pragma unroll
        for (int i = 0; i < 4; ++i) {
          const float4 g = cA[i];
          ((float4*)(p.out + (size_t)r * DM))[i * 64 + lane] = make_float4(v[i].x * inv * g.x, v[i].y * inv * g.y, v[i].z * inv * g.z, v[i].w * inv * g.w);
        }
      }
      continue;
    }
#pragma unroll
    for (int i = 0; i < 4; ++i) {
      const float h0 = v[i].x * inv * cA[i].x + cB[i].x, h1 = v[i].y * inv * cA[i].y + cB[i].y;
      const float h2 = v[i].z * inv * cA[i].z + cB[i].z, h3 = v[i].w * inv * cA[i].w + cB[i].w;
      u32x2 w; w.x = cvt_pk_bf16(h0, h1); w.y = cvt_pk_bf16(h2, h3);
      if (live) ((u32x2*)(p.hbuf + (size_t)r * DM))[i * 64 + lane] = w;
      if (skinny) {
        const float l0 = h0 - __uint_as_float(w.x << 16), l1 = h1 - __uint_as_float(w.x & 0xffff0000u);
        const float l2 = h2 - __uint_as_float(w.y << 16), l3 = h3 - __uint_as_float(w.y & 0xffff0000u);
        u32x2 wl; wl.x = cvt_pk_bf16(l0, l1); wl.y = cvt_pk_bf16(l2, l3);
        ((u32x2*)(HROW + (wv * 2 + 0) * 1024))[i * 64 + lane] = w;
        ((u32x2*)(HROW + (wv * 2 + 1) * 1024))[i * 64 + lane] = wl;
      }
    }
    if (!skinny) continue;
    __syncthreads();
    {
      const int arow = lane & 7, kg = lane >> 4;
      f32x4m acc = {0.f, 0.f, 0.f, 0.f};
#pragma unroll
      for (int ks = 0; ks < 4; ++ks) {
        const bf16x8 ahi = *(const bf16x8*)(HROW + (arow * 2 + 0) * 1024 + wv * 128 + ks * 32 + kg * 8);
        const bf16x8 alo = *(const bf16x8*)(HROW + (arow * 2 + 1) * 1024 + wv * 128 + ks * 32 + kg * 8);
        acc = __builtin_amdgcn_mfma_f32_16x16x32_bf16(ahi, Bhi[ks], acc, 0, 0, 0);
        acc = __builtin_amdgcn_mfma_f32_16x16x32_bf16(ahi, Blo[ks], acc, 0, 0, 0);
        acc = __builtin_amdgcn_mfma_f32_16x16x32_bf16(alo, Bhi[ks], acc, 0, 0, 0);
      }
      if (kg < 2) {
#pragma unroll
        for (int q = 0; q < 4; ++q) PART[(wv * 8 + kg * 4 + q) * 16 + (lane & 15)] = acc[q];
      }
    }
    __syncthreads();
    {
      float v1 = 0.f;
      if (lane < 16) {
#pragma unroll
        for (int w2 = 0; w2 < 8; ++w2) v1 += PART[(w2 * 8 + wv) * 16 + lane];
      }
      if (which == 2) {
        float mx = v1;
        mx = fmaxf(mx, __shfl_xor(mx, 1)); mx = fmaxf(mx, __shfl_xor(mx, 2)); mx = fmaxf(mx, __shfl_xor(mx, 4)); mx = fmaxf(mx, __shfl_xor(mx, 8));
        const float ex = expf(v1 - mx);
        float sum = ex;
        sum += __shfl_xor(sum, 1); sum += __shfl_xor(sum, 2); sum += __shfl_xor(sum, 4); sum += __shfl_xor(sum, 8);
        if (live && lane < 16) p.aff[(size_t)r * 16 + lane] = ex / sum;
      } else {
        float gvv = v1 + p.b_gate[(l >> 1) * 16 + (lane & 15)];
        if ((lane >> 2) & 1) gvv = logsigmoidf_(gvv);
        if (live && lane < 16) p.gates[(size_t)r * 16 + lane] = gvv;
      }
    }
  }
  __syncthreads();
}

#define LOG2E 1.4426950408889634f
__device__ __forceinline__ int chain_row(int b, int dir, int p) {
  if (p < 256) { const int t = dir ? 255 - p : p; return NL + b * 256 + t; }
  const int q = p - 256; const int t = dir ? 2047 - q : q; return b * 2048 + t;
}
__device__ __forceinline__ float wave_incl_sum(float v, int lane) {
#pragma unroll
  for (int o = 1; o < 64; o <<= 1) { const float t = __shfl_up(v, o); if (lane >= o) v += t; }
  return v;
}
__device__ __forceinline__ float wave_incl_max(float v, int lane) {
#pragma unroll
  for (int o = 1; o < 64; o <<= 1) { const float t = __shfl_up(v, o); if (lane >= o) v = fmaxf(v, t); }
  return v;
}
__device__ __forceinline__ void ph_post_even(const Params& p, int l, float* sm) {
  const int e = l >> 1;
  const int tid = ltid(), lane = tid & 63;
  __syncthreads();
  for (int idx = tid; idx < 1024; idx += NTHR) {
    const int pos = idx >> 4, i = idx & 15;
    const float ang = (float)pos * exp2f(-(float)i * (13.287712379549449f / 16.f));
    float sn, cs;
    sincosf(ang, &sn, &cs);
    sm[2 * idx] = cs; sm[2 * idx + 1] = sn;
  }
  if (tid < 128) sm[2048 + tid] = tid < 64 ? p.g_qnorm[e * 64 + tid] : p.g_knorm[e * 64 + tid - 64];
  for (int idx = tid; idx < 3072; idx += NTHR) sm[2304 + idx] = p.w_conv[(size_t)e * 3 * 1024 + idx];
  __syncthreads();
  const int bid = lbid(), G = lgdim();
  const bool scanner = false;
  const size_t gtid = (size_t)bid * NTHR + tid, gsz = (size_t)G * NTHR;
  if (!scanner) {
  for (size_t it = gtid; it < (size_t)NT * 10; it += gsz) {
    const int r = (int)(it / 10), hh = (int)(it % 10);
    const bool lat = r < NL;
    const int t = r & 2047;
    const int bb = lat ? (r >> 11) : ((r - NL) >> 8);
    const int key = lat ? 256 + t : ((r - NL) & 255);
    const bf16_t* src; bf16_t* dst; const float* g; float osc;
    if (hh < 8) { src = p.proj + (size_t)r * PROJW + hh * 64; dst = p.Qb + (size_t)r * 512 + hh * 64; g = sm + 2048; osc = 0.125f * LOG2E; }
    else { src = p.proj + (size_t)r * PROJW + 512 + (hh - 8) * 64; dst = p.Kb + ((size_t)(bb * 2 + (hh - 8)) * 2304 + key) * 64; g = sm + 2048 + 64; osc = 1.f;
           const u32x4* vs = (const u32x4*)(p.proj + (size_t)r * PROJW + 640 + (hh - 8) * 64);
           u32x4* vd = (u32x4*)(p.Vb + ((size_t)(bb * 2 + (hh - 8)) * 2304 + key) * 64);
#pragma unroll
           for (int q = 0; q < 8; ++q) vd[q] = vs[q]; }
    float x[64];
#pragma unroll
    for (int q = 0; q < 8; ++q) { float f[8]; unpack8(((const u32x4*)src)[q], f);
#pragma unroll
      for (int j = 0; j < 8; ++j) x[q * 8 + j] = f[j]; }
    float ss = 0.f;
#pragma unroll
    for (int j = 0; j < 64; ++j) ss += x[j] * x[j];
    const float inv = rsqrtf(ss * (1.f / 64.f) + EPS) * osc;
#pragma unroll
    for (int j = 0; j < 64; ++j) x[j] *= inv * g[j];
    if (lat) {
#pragma unroll
      for (int a = 0; a < 2; ++a) {
        const int pos = (a == 0) ? (t >> 6) : (t & 63);
#pragma unroll
        for (int i = 0; i < 16; ++i) {
          const float2 cssn = *(const float2*)(sm + 2 * (pos * 16 + i));
          const float x1 = x[a * 32 + i], x2 = x[a * 32 + 16 + i];
          x[a * 32 + i] = x1 * cssn.x - x2 * cssn.y;
          x[a * 32 + 16 + i] = x2 * cssn.x + x1 * cssn.y;
        }
      }
    }
#pragma unroll
    for (int q = 0; q < 8; ++q) { float f[8];
#pragma unroll
      for (int j = 0; j < 8; ++j) f[j] = x[q * 8 + j];
      ((u32x4*)dst)[q] = pack8(f); }
  }
  const float* wc = sm + 2304;
  for (size_t it0 = gtid; it0 < (size_t)NT * 128; it0 += 4 * gsz) {
    u32x4 rc[4], rm[4], rp[4];
#pragma unroll
    for (int u = 0; u < 4; ++u) {
      const size_t it = it0 + (size_t)u * gsz;
      const size_t itc = it < (size_t)NT * 128 ? it : it0;
      const int r = (int)(itc >> 7), c8 = (int)(itc & 127) * 8;
      int t, n;
      if (r < NL) { t = r & 2047; n = 2048; } else { t = (r - NL) & 255; n = 256; }
      const bf16_t* sp = p.proj + (size_t)r * PROJW + 768 + c8;
      rc[u] = *(const u32x4*)sp;
      rm[u] = t > 0 ? *(const u32x4*)(sp - PROJW) : (u32x4){0u, 0u, 0u, 0u};
      rp[u] = t < n - 1 ? *(const u32x4*)(sp + PROJW) : (u32x4){0u, 0u, 0u, 0u};
    }
#pragma unroll
    for (int u = 0; u < 4; ++u) {
      const size_t it = it0 + (size_t)u * gsz;
      if (it < (size_t)NT * 128) {
        const int r = (int)(it >> 7), c8 = (int)(it & 127) * 8;
        float xc[8], xm[8], xp[8], o[8];
        unpack8(rc[u], xc); unpack8(rm[u], xm); unpack8(rp[u], xp);
        const float ksc = c8 < 512 ? 1.f : 0.08838834764831845f;
#pragma unroll
        for (int j = 0; j < 8; ++j) { const float v = wc[c8 + j] * xm[j] + wc[1024 + c8 + j] * xc[j] + wc[2048 + c8 + j] * xp[j]; o[j] = siluf(v) * ksc; }
        bf16_t* dp = c8 < 512 ? p.qm + (size_t)r * 512 + c8 : p.km + (size_t)r * 512 + c8 - 512;
        *(u32x4*)dp = pack8(o);
      }
    }
  }
  }
  {
    const int gw = (int)(gtid >> 6), nw = (int)(gsz >> 6);
    for (int task = gw; task < 64 * 18; task += nw) {
      const int chain = task / 18, c = task % 18;
      const int b = chain >> 3, hd = (chain >> 1) & 3, dir = chain & 1;
      const int p0 = c * 128 + 2 * lane;
      const int r0 = chain_row(b, dir, p0), r1 = chain_row(b, dir, p0 + 1);
      const float ig0 = p.gates[(size_t)r0 * 16 + dir * 8 + hd], lf0 = p.gates[(size_t)r0 * 16 + dir * 8 + 4 + hd];
      const float ig1 = p.gates[(size_t)r1 * 16 + dir * 8 + hd], lf1 = p.gates[(size_t)r1 * 16 + dir * 8 + 4 + hd];
      const float ssum = lf0 + lf1;
      const float incl = wave_incl_sum(ssum, lane);
      const float bq0 = (incl - ssum) + lf0, bq1 = bq0 + lf1;
      const float bend = __shfl(incl, 63);
      const float g0 = ig0 - bq0, g1 = ig1 - bq1;
      const float inclm = wave_incl_max(fmaxf(g0, g1), lane);
      float exclm = __shfl_up(inclm, 1);
      if (lane == 0) exclm = -3.0e38f;
      const float pm0 = fmaxf(exclm, g0), pm1 = fmaxf(pm0, g1);
      const float gmax = __shfl(inclm, 63);
      const size_t i0 = (size_t)r0 * 8 + dir * 4 + hd, i1 = (size_t)r1 * 8 + dir * 4 + hd;
      p.gsG[i0] = g0 * LOG2E; p.gsR[i0] = pm0 * LOG2E; p.gsB[i0] = bq0 * LOG2E;
      p.gsG[i1] = g1 * LOG2E; p.gsR[i1] = pm1 * LOG2E; p.gsB[i1] = bq1 * LOG2E;
      if (lane == 0) { p.cBE[chain * 18 + c] = bend; p.cGM[chain * 18 + c] = gmax; }
    }
  }
}
__device__ __forceinline__ void chain_state(const Params& p, int chain, int cc, float& m_in, float& m_next, float& be) {
  m_in = -1e30f; m_next = -1e30f; be = 0.f;
  for (int c = 0; c <= cc; ++c) {
    be = p.cMIN[chain * 18 + c];
    const float mn = fmaxf(m_in + be, be + p.cE1[chain * 18 + c]);
    if (c < cc) m_in = mn; else m_next = mn;
  }
}

typedef float f32x16 __attribute__((ext_vector_type(16)));
typedef short s16x4 __attribute__((ext_vector_type(4)));
typedef __attribute__((address_space(3))) const char* lds_cptr;
__device__ __forceinline__ s16x4 vtr(lds_cptr p) { return __builtin_bit_cast(s16x4, __builtin_amdgcn_ds_read_tr16_b64_v4i16((__attribute__((address_space(3))) s16x4*)p)); }
#define MX3(a, b, c) __builtin_fmaxf(__builtin_fmaxf((a), (b)), (c))
__device__ __forceinline__ float rowmax32(const f32x16& p0, const f32x16& p1) {
  float a = MX3(p0[0], p0[1], p1[0]), b = MX3(p0[2], p0[3], p1[1]);
  a = MX3(a, p1[2], p1[3]);
#pragma unroll
  for (int r = 4; r < 16; r += 4) { a = MX3(a, p0[r], p0[r + 1]); b = MX3(b, p0[r + 2], p0[r + 3]); a = MX3(a, p1[r], p1[r + 1]); b = MX3(b, p1[r + 2], p1[r + 3]); }
  const float m = __builtin_fmaxf(a, b);
  auto rr = __builtin_amdgcn_permlane32_swap(__float_as_uint(m), __float_as_uint(m), false, false);
  return __builtin_fmaxf(__uint_as_float(rr[0]), __uint_as_float(rr[1]));
}
__device__ __forceinline__ float half_swap_add(float v) {
  auto rr = __builtin_amdgcn_permlane32_swap(__float_as_uint(v), __float_as_uint(v), false, false);
  return __uint_as_float(rr[0]) + __uint_as_float(rr[1]);
}
#define ATT_SLOT 16384
__device__ __forceinline__ void glds16(const void* g, unsigned lds_base) {
  unsigned sv;
  asm volatile("s_mov_b32 %0, m0\n\ts_mov_b32 m0, %2\n\ts_nop 0\n\tglobal_load_lds_dwordx4 %1, off\n\ts_mov_b32 m0, %0" : "=&s"(sv) : "v"(g), "s"(lds_base) : "memory");
}
__device__ __forceinline__ void attn_unit(const bf16_t* Q0, const bf16_t* Kbase, const bf16_t* Vbase, const int nkeys, bf16_t* O0, LAS unsigned char* lds) {
  const int tid = ltid(), lane = tid & 63, r32 = lane & 31, hi = lane >> 5;
  const int wid = __builtin_amdgcn_readfirstlane(tid >> 6);
  const int NTL = nkeys >> 6;
  __syncthreads();
  const bf16_t* ksrc = Kbase + (size_t)lane * 64 + wid * 8;
  const bf16_t* vsrc = Vbase + (size_t)(16 * (wid & 3) + (lane >> 2)) * 64 + (wid >> 2) * 32 + (lane & 3) * 8;
  const unsigned ldsb = (unsigned)(size_t)lds;
#define ATT_STAGE(t, slot) do { \
    glds16(ksrc + (size_t)(t) * 64 * 64, (unsigned)__builtin_amdgcn_readfirstlane(ldsb + (slot) * ATT_SLOT + wid * 1024)); \
    glds16(vsrc + (size_t)(t) * 64 * 64, (unsigned)__builtin_amdgcn_readfirstlane(ldsb + (slot) * ATT_SLOT + 8192 + wid * 1024)); } while (0)
  ATT_STAGE(0, 0);
  if (NTL > 1) ATT_STAGE(1, 1);
  bf16x8 qr[4];
  {
    const bf16_t* Qw = Q0 + (size_t)(wid * 32 + r32) * 512;
#pragma unroll
    for (int d0 = 0; d0 < 4; ++d0) qr[d0] = *(const bf16x8*)(Qw + d0 * 16 + hi * 8);
  }
  f32x16 o0, o1;
#pragma unroll
  for (int r = 0; r < 16; ++r) { o0[r] = 0.f; o1[r] = 0.f; }
  float m = -1e30f, l = 0.f;
  const int koff = hi * 1024 + r32 * 16;
  const int voff = 8192 + ((lane >> 4) & 1) * 32 + (lane & 3) * 8 + (4 * hi + ((lane & 15) >> 2)) * 64;
  const bool grpB = wid >= 4;
  bf16x8 pw[4];
#define ATT_PV(sl) do { const lds_cptr vp_ = (lds_cptr)(lds + (sl) * ATT_SLOT + voff); \
    _Pragma("unroll") for (int s4 = 0; s4 < 4; ++s4) { \
      const s16x4 a0l = vtr(vp_ + s4 * 1024), a0h = vtr(vp_ + s4 * 1024 + 512); \
      const s16x4 a1l = vtr(vp_ + 4096 + s4 * 1024), a1h = vtr(vp_ + 4096 + s4 * 1024 + 512); \
      const bf16x8 a0 = {a0l[0], a0l[1], a0l[2], a0l[3], a0h[0], a0h[1], a0h[2], a0h[3]}; \
      const bf16x8 a1 = {a1l[0], a1l[1], a1l[2], a1l[3], a1h[0], a1h[1], a1h[2], a1h[3]}; \
      o0 = __builtin_amdgcn_mfma_f32_32x32x16_bf16(a0, pw[s4], o0, 0, 0, 0); \
      o1 = __builtin_amdgcn_mfma_f32_32x32x16_bf16(a1, pw[s4], o1, 0, 0, 0); } } while (0)
  for (int t = 0; t <= NTL; ++t) {
    if (t + 1 < NTL) asm volatile("s_waitcnt vmcnt(2) lgkmcnt(0)\n\ts_barrier" ::: "memory"); else asm volatile("s_waitcnt vmcnt(0) lgkmcnt(0)\n\ts_barrier" ::: "memory");
    __builtin_amdgcn_sched_barrier(0);
    if (t + 2 < NTL) ATT_STAGE(t + 2, (t + 2) & 3);
    if (grpB && t > 0) ATT_PV((t - 1) & 3);
    if (t < NTL) {
      const lds_cptr kp = (lds_cptr)(lds + (t & 3) * ATT_SLOT + koff);
      f32x16 pA, pB;
#pragma unroll
      for (int r = 0; r < 16; ++r) { pA[r] = 0.f; pB[r] = 0.f; }
#pragma unroll
      for (int d0 = 0; d0 < 4; ++d0) {
        const bf16x8 k0 = *(const LAS bf16x8*)(kp + d0 * 2048), k1 = *(const LAS bf16x8*)(kp + d0 * 2048 + 512);
        pA = __builtin_amdgcn_mfma_f32_32x32x16_bf16(k0, qr[d0], pA, 0, 0, 0);
        pB = __builtin_amdgcn_mfma_f32_32x32x16_bf16(k1, qr[d0], pB, 0, 0, 0);
      }
      const float rm = rowmax32(pA, pB);
      const float mn = __builtin_fmaxf(m, rm);
      const float alpha = __builtin_amdgcn_exp2f(m - mn);
      m = mn;
      float ps = 0.f;
#pragma unroll
      for (int r = 0; r < 16; ++r) { pA[r] = __builtin_amdgcn_exp2f(pA[r] - mn); pB[r] = __builtin_amdgcn_exp2f(pB[r] - mn); ps += pA[r] + pB[r]; }
      l = l * alpha + ps;
#pragma unroll
      for (int r = 0; r < 16; ++r) { o0[r] *= alpha; o1[r] *= alpha; }
#pragma unroll
      for (int s4 = 0; s4 < 4; ++s4) {
        u32x4 w;
        if (s4 < 2) { w.x = cvt_pk_bf16(pA[8 * s4 + 0], pA[8 * s4 + 1]); w.y = cvt_pk_bf16(pA[8 * s4 + 2], pA[8 * s4 + 3]); w.z = cvt_pk_bf16(pA[8 * s4 + 4], pA[8 * s4 + 5]); w.w = cvt_pk_bf16(pA[8 * s4 + 6], pA[8 * s4 + 7]); }
        else { const int q = s4 - 2; w.x = cvt_pk_bf16(pB[8 * q + 0], pB[8 * q + 1]); w.y = cvt_pk_bf16(pB[8 * q + 2], pB[8 * q + 3]); w.z = cvt_pk_bf16(pB[8 * q + 4], pB[8 * q + 5]); w.w = cvt_pk_bf16(pB[8 * q + 6], pB[8 * q + 7]); }
        pw[s4] = __builtin_bit_cast(bf16x8, w);
      }
      if (!grpB) ATT_PV(t & 3);
    }
  }
#undef ATT_PV
#undef ATT_STAGE
  const float il = 1.f / half_swap_add(l);
  bf16_t* Ow = O0 + (size_t)(wid * 32 + r32) * 1024;
#pragma unroll
  for (int g4 = 0; g4 < 4; ++g4) {
    u32x2 w0, w1;
    w0.x = cvt_pk_bf16(o0[4 * g4 + 0] * il, o0[4 * g4 + 1] * il); w0.y = cvt_pk_bf16(o0[4 * g4 + 2] * il, o0[4 * g4 + 3] * il);
    w1.x = cvt_pk_bf16(o1[4 * g4 + 0] * il, o1[4 * g4 + 1] * il); w1.y = cvt_pk_bf16(o1[4 * g4 + 2] * il, o1[4 * g4 + 3] * il);
    *(u32x2*)(Ow + 8 * g4 + 4 * hi) = w0;
    *(u32x2*)(Ow + 32 + 8 * g4 + 4 * hi) = w1;
  }
}
__device__ __forceinline__ void attn_unit2(const bf16_t* Q0a, const bf16_t* Q0b, const bf16_t* Kbase, const bf16_t* Vbase, const int nkeys, bf16_t* O0a, bf16_t* O0b, LAS unsigned char* lds) {
  const int tid = ltid(), lane = tid & 63, r32 = lane & 31, hi = lane >> 5;
  const int wid = __builtin_amdgcn_readfirstlane(tid >> 6);
  const int NTL = nkeys >> 6;
  __syncthreads();
  const bf16_t* ksrc = Kbase + (size_t)lane * 64 + wid * 8;
  const bf16_t* vsrc = Vbase + (size_t)(16 * (wid & 3) + (lane >> 2)) * 64 + (wid >> 2) * 32 + (lane & 3) * 8;
  const unsigned ldsb = (unsigned)(size_t)lds;
#define ATT_STAGE(t, slot) do { \
    glds16(ksrc + (size_t)(t) * 64 * 64, (unsigned)__builtin_amdgcn_readfirstlane(ldsb + (slot) * ATT_SLOT + wid * 1024)); \
    glds16(vsrc + (size_t)(t) * 64 * 64, (unsigned)__builtin_amdgcn_readfirstlane(ldsb + (slot) * ATT_SLOT + 8192 + wid * 1024)); } while (0)
  ATT_STAGE(0, 0);
  if (NTL > 1) ATT_STAGE(1, 1);
  bf16x8 qr[2][4];
  {
    const bf16_t* Qa = Q0a + (size_t)(wid * 32 + r32) * 512;
    const bf16_t* Qb2 = Q0b + (size_t)(wid * 32 + r32) * 512;
#pragma unroll
    for (int d0 = 0; d0 < 4; ++d0) { qr[0][d0] = *(const bf16x8*)(Qa + d0 * 16 + hi * 8); qr[1][d0] = *(const bf16x8*)(Qb2 + d0 * 16 + hi * 8); }
  }
  f32x16 o0[2], o1[2];
#pragma unroll
  for (int hh = 0; hh < 2; ++hh)
#pragma unroll
    for (int r = 0; r < 16; ++r) { o0[hh][r] = 0.f; o1[hh][r] = 0.f; }
  float m[2] = {-1e30f, -1e30f}, l[2] = {0.f, 0.f};
  const int koff = hi * 1024 + r32 * 16;
  const int voff = 8192 + ((lane >> 4) & 1) * 32 + (lane & 3) * 8 + (4 * hi + ((lane & 15) >> 2)) * 64;
  int slot = 0;
  for (int t = 0; t < NTL; ++t) {
    if (t + 1 < NTL) asm volatile("s_waitcnt vmcnt(2) lgkmcnt(0)\n\ts_barrier" ::: "memory"); else asm volatile("s_waitcnt vmcnt(0) lgkmcnt(0)\n\ts_barrier" ::: "memory");
    __builtin_amdgcn_sched_barrier(0);
    if (t + 2 < NTL) { const int s2 = (slot >= 1) ? slot - 1 : 2; ATT_STAGE(t + 2, s2); }
    const lds_cptr kp = (lds_cptr)(lds + slot * ATT_SLOT + koff);
    const lds_cptr vp = (lds_cptr)(lds + slot * ATT_SLOT + voff);
    f32x16 pA[2], pB[2];
#pragma unroll
    for (int hh = 0; hh < 2; ++hh)
#pragma unroll
      for (int r = 0; r < 16; ++r) { pA[hh][r] = 0.f; pB[hh][r] = 0.f; }
#pragma unroll
    for (int d0 = 0; d0 < 4; ++d0) {
      const bf16x8 k0 = *(const LAS bf16x8*)(kp + d0 * 2048), k1 = *(const LAS bf16x8*)(kp + d0 * 2048 + 512);
#pragma unroll
      for (int hh = 0; hh < 2; ++hh) {
        pA[hh] = __builtin_amdgcn_mfma_f32_32x32x16_bf16(k0, qr[hh][d0], pA[hh], 0, 0, 0);
        pB[hh] = __builtin_amdgcn_mfma_f32_32x32x16_bf16(k1, qr[hh][d0], pB[hh], 0, 0, 0);
      }
    }
    bf16x8 pw[2][4];
#pragma unroll
    for (int hh = 0; hh < 2; ++hh) {
      const float rm = rowmax32(pA[hh], pB[hh]);
      const float mn = __builtin_fmaxf(m[hh], rm);
      const float alpha = __builtin_amdgcn_exp2f(m[hh] - mn);
      m[hh] = mn;
      float ps = 0.f;
#pragma unroll
      for (int r = 0; r < 16; ++r) { pA[hh][r] = __builtin_amdgcn_exp2f(pA[hh][r] - mn); pB[hh][r] = __builtin_amdgcn_exp2f(pB[hh][r] - mn); ps += pA[hh][r] + pB[hh][r]; }
      l[hh] = l[hh] * alpha + ps;
#pragma unroll
      for (int r = 0; r < 16; ++r) { o0[hh][r] *= alpha; o1[hh][r] *= alpha; }
#pragma unroll
      for (int s4 = 0; s4 < 4; ++s4) {
        u32x4 w;
        if (s4 < 2) { w.x = cvt_pk_bf16(pA[hh][8 * s4 + 0], pA[hh][8 * s4 + 1]); w.y = cvt_pk_bf16(pA[hh][8 * s4 + 2], pA[hh][8 * s4 + 3]); w.z = cvt_pk_bf16(pA[hh][8 * s4 + 4], pA[hh][8 * s4 + 5]); w.w = cvt_pk_bf16(pA[hh][8 * s4 + 6], pA[hh][8 * s4 + 7]); }
        else { const int q = s4 - 2; w.x = cvt_pk_bf16(pB[hh][8 * q + 0], pB[hh][8 * q + 1]); w.y = cvt_pk_bf16(pB[hh][8 * q + 2], pB[hh][8 * q + 3]); w.z = cvt_pk_bf16(pB[hh][8 * q + 4], pB[hh][8 * q + 5]); w.w = cvt_pk_bf16(pB[hh][8 * q + 6], pB[hh][8 * q + 7]); }
        pw[hh][s4] = __builtin_bit_cast(bf16x8, w);
      }
    }
#pragma unroll
    for (int s4 = 0; s4 < 4; ++s4) {
      const s16x4 a0l = vtr(vp + s4 * 1024), a0h = vtr(vp + s4 * 1024 + 512);
      const s16x4 a1l = vtr(vp + 4096 + s4 * 1024), a1h = vtr(vp + 4096 + s4 * 1024 + 512);
      const bf16x8 a0 = {a0l[0], a0l[1], a0l[2], a0l[3], a0h[0], a0h[1], a0h[2], a0h[3]};
      const bf16x8 a1 = {a1l[0], a1l[1], a1l[2], a1l[3], a1h[0], a1h[1], a1h[2], a1h[3]};
#pragma unroll
      for (int hh = 0; hh < 2; ++hh) {
        o0[hh] = __builtin_amdgcn_mfma_f32_32x32x16_bf16(a0, pw[hh][s4], o0[hh], 0, 0, 0);
        o1[hh] = __builtin_amdgcn_mfma_f32_32x32x16_bf16(a1, pw[hh][s4], o1[hh], 0, 0, 0);
      }
    }
    slot = (slot == 2) ? 0 : slot + 1;
  }
#undef ATT_STAGE
#pragma unroll
  for (int hh = 0; hh < 2; ++hh) {
    const float il = 1.f / half_swap_add(l[hh]);
    bf16_t* Ow = (hh ? O0b : O0a) + (size_t)(wid * 32 + r32) * 1024;
#pragma unroll
    for (int g4 = 0; g4 < 4; ++g4) {
      u32x2 w0, w1;
      w0.x = cvt_pk_bf16(o0[hh][4 * g4 + 0] * il, o0[hh][4 * g4 + 1] * il); w0.y = cvt_pk_bf16(o0[hh][4 * g4 + 2] * il, o0[hh][4 * g4 + 3] * il);
      w1.x = cvt_pk_bf16(o1[hh][4 * g4 + 0] * il, o1[hh][4 * g4 + 1] * il); w1.y = cvt_pk_bf16(o1[hh][4 * g4 + 2] * il, o1[hh][4 * g4 + 3] * il);
      *(u32x2*)(Ow + 8 * g4 + 4 * hi) = w0;
      *(u32x2*)(Ow + 32 + 8 * g4 + 4 * hi) = w1;
    }
  }
}
__device__ __forceinline__ void ph_att(const Params& p, bool ctx_q, LAS unsigned char* lds) {
  const int c = lbid(), G = lgdim();
  const int nunits = 256 + (ctx_q ? 32 : 0);
  for (int L = c; L < nunits; L += G) {
    if (L < 256) {
      const int grp = (L & 7) * 2 + ((L >> 3) >> 4), within = (L >> 3) & 15;
      const int b = grp >> 1, kvh = grp & 1, h0 = kvh * 4 + 2 * (within >> 3), qt = within & 7;
      const size_t row0 = (size_t)b * 2048 + qt * 256;
      const size_t kvb = (size_t)(b * 2 + kvh) * 2304 * 64;
      attn_unit2(p.Qb + row0 * 512 + h0 * 64, p.Qb + row0 * 512 + (h0 + 1) * 64, p.Kb + kvb, p.Vb + kvb, 2304, p.mix + row0 * 1024 + h0 * 64, p.mix + row0 * 1024 + (h0 + 1) * 64, lds);
    } else {
      const int u = L - 256, b = u >> 2, kvh = (u >> 1) & 1, h0 = kvh * 4 + 2 * (u & 1);
      const size_t row0 = (size_t)NL + b * 256;
      const size_t kvb = (size_t)(b * 2 + kvh) * 2304 * 64;
      attn_unit2(p.Qb + row0 * 512 + h0 * 64, p.Qb + row0 * 512 + (h0 + 1) * 64, p.Kb + kvb, p.Vb + kvb, 256, p.mix + row0 * 1024 + h0 * 64, p.mix + row0 * 1024 + (h0 + 1) * 64, lds);
    }
  }
  __syncthreads();
}

__device__ __forceinline__ int chunk_row0(int b, int dir, int cc) {
  if (cc < 2) return NL + b * 256 + (dir ? 1 - cc : cc) * 128;
  return b * 2048 + (dir ? 15 - (cc - 2) : cc - 2) * 128;
}
__device__ __forceinline__ int trq_addr(int lane, int quarter, int rowbase) {
  return quarter * 8192 + ((lane >> 4) & 1) * 32 + (lane & 3) * 8 + (rowbase + ((lane & 15) >> 2)) * 64;
}
__device__ __forceinline__ bf16x8 cat44(const s16x4 a, const s16x4 b) { return (bf16x8){a[0], a[1], a[2], a[3], b[0], b[1], b[2], b[3]}; }

__device__ __forceinline__ void ph_mlstm_u(const Params& p, LAS unsigned char* lds) {
  const int tid = ltid(), lane = tid & 63, r32 = lane & 31, hi = lane >> 5;
  const int wid = __builtin_amdgcn_readfirstlane(tid >> 6);
  LAS float* WS = (LAS float*)(lds + 65536);
  LAS float* NP = (LAS float*)(lds + 66048);
  LAS float* E1T = (LAS float*)(lds + 68096);
  __syncthreads();
  if (tid < 64) {
    float be[18], gm[18];
#pragma unroll
    for (int c = 0; c < 18; ++c) { be[c] = p.cBE[tid * 18 + c]; gm[c] = p.cGM[tid * 18 + c]; }
    float m_in = -1e30f;
#pragma unroll
    for (int c = 0; c < 18; ++c) {
      const float m_next = fmaxf(m_in + be[c], be[c] + gm[c]);
      E1T[tid * 18 + c] = (be[c] - m_next) * LOG2E;
      if (lbid() == 0) { p.cMIN[tid * 18 + c] = m_in * LOG2E; p.cDEC[tid * 18 + c] = expf(m_in + be[c] - m_next); }
      m_in = m_next;
    }
  }
  __syncthreads();
  for (int unit = lbid(); unit < 64 * 17; unit += lgdim()) {
    const int chain = unit / 17, cc = unit % 17;
    const int b = chain >> 3, hd = (chain >> 1) & 3, dir = chain & 1;
    const int row0 = chunk_row0(b, dir, cc);
    __syncthreads();
#pragma unroll
    for (int n = 0; n < 4; ++n) {
      const int ii = wid * 4 + n, qd = ii >> 3, rg = ii & 7;
      const bf16_t* src = p.km + (size_t)(row0 + rg * 16 + (lane >> 2)) * 512 + hd * 128 + qd * 32 + (lane & 3) * 8;
      __builtin_amdgcn_global_load_lds((const unsigned*)src, (LAS unsigned*)(lds + qd * 8192 + rg * 1024), 16, 0, 0);
    }
    if (tid < 128) WS[tid] = __builtin_amdgcn_exp2f(p.gsG[(size_t)(row0 + tid) * 8 + dir * 4 + hd] + E1T[chain * 18 + cc]);
    __syncthreads();
#pragma unroll
    for (int n = 0; n < 4; ++n) {
      const int o = (tid + n * NTHR) * 16, qd = o >> 13, row = (o >> 6) & 127, pc = (o >> 4) & 3;
      float f[8];
      unpack8(*(const u32x4*)(p.proj + (size_t)(row0 + row) * PROJW + 1792 + hd * 128 + qd * 32 + pc * 8), f);
      const float w = WS[row];
#pragma unroll
      for (int j = 0; j < 8; ++j) f[j] *= w;
      *(LAS u32x4*)(lds + 32768 + o) = pack8(f);
    }
    asm volatile("s_waitcnt vmcnt(0)" ::: "memory");
    __syncthreads();
    {
      const int d = tid & 127, part = tid >> 7;
      float acc = 0.f;
      for (int s2 = 0; s2 < 32; ++s2) {
        const int srow = part * 32 + s2;
        const bf16_t kv = *(const LAS bf16_t*)(lds + (d >> 5) * 8192 + srow * 64 + (d & 31) * 2);
        acc += WS[srow] * bf2f(kv);
      }
      NP[part * 128 + d] = acc;
    }
    const int eb = wid >> 1, db0 = 2 * (wid & 1);
    f32x16 u0, u1;
#pragma unroll
    for (int r = 0; r < 16; ++r) { u0[r] = 0.f; u1[r] = 0.f; }
#pragma unroll
    for (int ks = 0; ks < 8; ++ks) {
      const int rb = ks * 16 + 8 * hi;
      const bf16x8 a = cat44(vtr((lds_cptr)(lds + 32768 + trq_addr(lane, eb, rb))), vtr((lds_cptr)(lds + 32768 + trq_addr(lane, eb, rb + 4))));
      const bf16x8 b0 = cat44(vtr((lds_cptr)(lds + trq_addr(lane, db0, rb))), vtr((lds_cptr)(lds + trq_addr(lane, db0, rb + 4))));
      const bf16x8 b1 = cat44(vtr((lds_cptr)(lds + trq_addr(lane, db0 + 1, rb))), vtr((lds_cptr)(lds + trq_addr(lane, db0 + 1, rb + 4))));
      u0 = __builtin_amdgcn_mfma_f32_32x32x16_bf16(a, b0, u0, 0, 0, 0);
      u1 = __builtin_amdgcn_mfma_f32_32x32x16_bf16(a, b1, u1, 0, 0, 0);
    }
    float* U = p.Ubuf + ((size_t)chain * 17 + cc) * 16384;
#pragma unroll
    for (int r = 0; r < 16; ++r) {
      const int erow = eb * 32 + (r & 3) + 8 * (r >> 2) + 4 * hi;
      U[(size_t)erow * 128 + db0 * 32 + r32] = u0[r];
      U[(size_t)erow * 128 + (db0 + 1) * 32 + r32] = u1[r];
    }
    __syncthreads();
    if (tid < 128) p.NLb[((size_t)chain * 17 + cc) * 128 + tid] = NP[tid] + NP[128 + tid] + NP[256 + tid] + NP[384 + tid];
  }
  __syncthreads();
}

__device__ __forceinline__ void ph_mlstm_scan(const Params& p, int bskip) {
  const int bsk = lgdim() > bskip ? bskip : 0;
  if (lbid() < bsk) return;
  const size_t gtid = (size_t)(lbid() - bsk) * NTHR + ltid(), gsz = (size_t)(lgdim() - bsk) * NTHR;
  for (size_t it = gtid; it < (size_t)64 * 8192; it += gsz) {
    const int chain = (int)(it >> 13), ed = (int)(it & 8191) * 2;
    float c0 = 0.f, c1 = 0.f;
    for (int c = 0; c < 17; ++c) {
      const float dec = p.cDEC[chain * 18 + c];
      const float2 u = *(const float2*)(p.Ubuf + ((size_t)chain * 17 + c) * 16384 + ed);
      c0 = dec * c0 + u.x; c1 = dec * c1 + u.y;
      *(unsigned*)(p.Cbf + ((size_t)chain * 18 + c + 1) * 16384 + ed) = cvt_pk_bf16(c0, c1);
    }
  }
  for (size_t it = gtid; it < (size_t)64 * 128; it += gsz) {
    const int chain = (int)(it >> 7), d = (int)(it & 127);
    float nv = 0.f;
    for (int c = 0; c < 17; ++c) {
      nv = p.cDEC[chain * 18 + c] * nv + p.NLb[((size_t)chain * 17 + c) * 128 + d];
      p.NVb[((size_t)chain * 18 + c + 1) * 128 + d] = nv;
    }
  }
}

__device__ __forceinline__ void ph_mlstm_h(const Params& p, int l, bool ctx_out, LAS unsigned char* lds) {
  const int e2 = l >> 1;
  const int tid = ltid(), lane = tid & 63, r32 = lane & 31, hi = lane >> 5;
  const int wid = __builtin_amdgcn_readfirstlane(tid >> 6);
  const int tb = wid & 3, dir = wid >> 2;
  LAS float* HX = (LAS float*)(lds);
  LAS float* GC = (LAS float*)(lds + 131072);
  const int j0 = ctx_out ? 0 : 2, nj = 18 - j0;
  for (int unit = lbid(); unit < 32 * nj; unit += lgdim()) {
    const int bh = unit / nj, j = j0 + unit % nj, b = bh >> 2, hd = bh & 3;
    const int row0 = (j < 2) ? NL + b * 256 + j * 128 : b * 2048 + (j - 2) * 128;
    const int cc = dir ? (j < 2 ? 1 - j : 19 - j) : j;
    const int chain = b * 8 + hd * 2 + dir;
    __syncthreads();
#pragma unroll
    for (int n = 0; n < 4; ++n) {
      const int ii = wid * 4 + n;
      { const int ch = ii >> 1, rh = ii & 1;
        const bf16_t* src = p.km + (size_t)(row0 + rh * 64 + lane) * 512 + hd * 128 + ch * 8;
        __builtin_amdgcn_global_load_lds((const unsigned*)src, (LAS unsigned*)(lds + ch * 2048 + rh * 1024), 16, 0, 0); }
      { const int qd = ii >> 3, rg = ii & 7;
        const bf16_t* src = p.proj + (size_t)(row0 + rg * 16 + (lane >> 2)) * PROJW + 1792 + hd * 128 + qd * 32 + (lane & 3) * 8;
        __builtin_amdgcn_global_load_lds((const unsigned*)src, (LAS unsigned*)(lds + 32768 + qd * 8192 + rg * 1024), 16, 0, 0); }
    }
#pragma unroll
    for (int n = 0; n < 8; ++n) {
      const int ii2 = wid * 8 + n, dd = ii2 >> 5, ch = (ii2 & 31) >> 1, rh = ii2 & 1;
      const int ccd = dd ? (j < 2 ? 1 - j : 19 - j) : j;
      if (ccd > 0) {
        const bf16_t* src = p.Cbf + ((size_t)(b * 8 + hd * 2 + dd) * 18 + ccd) * 16384 + (size_t)(rh * 64 + lane) * 128 + ch * 8;
        __builtin_amdgcn_global_load_lds((const unsigned*)src, (LAS unsigned*)(lds + 65536 + dd * 32768 + ch * 2048 + rh * 1024), 16, 0, 0);
      }
    }
    if (tid < 256) GC[tid] = p.gsG[(size_t)(row0 + (tid & 127)) * 8 + (tid >> 7) * 4 + hd];
    const int trow = row0 + tb * 32 + r32;
    bf16x8 qf[8];
#pragma unroll
    for (int ks = 0; ks < 8; ++ks) qf[ks] = *(const bf16x8*)(p.qm + (size_t)trow * 512 + hd * 128 + ks * 16 + hi * 8);
    const float MIN2 = p.cMIN[chain * 18 + cc];
    const float R2 = -fmaxf(MIN2, p.gsR[(size_t)trow * 8 + dir * 4 + hd]), BQ2 = p.gsB[(size_t)trow * 8 + dir * 4 + hd];
    f32x16 acc[4];
#pragma unroll
    for (int eb = 0; eb < 4; ++eb)
#pragma unroll
      for (int r = 0; r < 16; ++r) acc[eb][r] = 0.f;
    float nq = 0.f;
    if (cc > 0) {
      const float* nvp = p.NVb + ((size_t)chain * 18 + cc) * 128 + hi * 8;
#pragma unroll
      for (int ks = 0; ks < 8; ++ks) {
        const f32x4 n0 = *(const f32x4*)(nvp + ks * 16), n1 = *(const f32x4*)(nvp + ks * 16 + 4);
        float qv[8];
        unpack8(__builtin_bit_cast(u32x4, qf[ks]), qv);
        nq += n0[0] * qv[0] + n0[1] * qv[1] + n0[2] * qv[2] + n0[3] * qv[3] + n1[0] * qv[4] + n1[1] * qv[5] + n1[2] * qv[6] + n1[3] * qv[7];
      }
      nq = half_swap_add(nq);
    }
    const float winter = __builtin_amdgcn_exp2f(MIN2 + R2);
    asm volatile("s_waitcnt vmcnt(0)" ::: "memory");
    __syncthreads();
    if (cc > 0) {
#pragma unroll
      for (int eb = 0; eb < 4; ++eb)
#pragma unroll
        for (int ks = 0; ks < 8; ++ks) {
          const bf16x8 a = *(const LAS bf16x8*)(lds + 65536 + dir * 32768 + (2 * ks + hi) * 2048 + (eb * 32 + r32) * 16);
          acc[eb] = __builtin_amdgcn_mfma_f32_32x32x16_bf16(a, qf[ks], acc[eb], 0, 0, 0);
        }
#pragma unroll
      for (int eb = 0; eb < 4; ++eb)
#pragma unroll
        for (int r = 0; r < 16; ++r) acc[eb][r] *= winter;
    }
    float sw = 0.f;
    const int sb_lo = dir ? tb : 0, sb_hi = dir ? 3 : tb;
    for (int sb = sb_lo; sb <= sb_hi; ++sb) {
      f32x16 st;
#pragma unroll
      for (int r = 0; r < 16; ++r) st[r] = 0.f;
#pragma unroll
      for (int ks = 0; ks < 8; ++ks) {
        const bf16x8 kf = *(const LAS bf16x8*)(lds + (2 * ks + hi) * 2048 + (sb * 32 + r32) * 16);
        st = __builtin_amdgcn_mfma_f32_32x32x16_bf16(kf, qf[ks], st, 0, 0, 0);
      }
      const bool diag = (sb == tb);
#pragma unroll
      for (int g4 = 0; g4 < 4; ++g4) {
        const f32x4 gc = *(const LAS f32x4*)(GC + dir * 128 + sb * 32 + 8 * g4 + 4 * hi);
#pragma unroll
        for (int q = 0; q < 4; ++q) {
          const int sl = 8 * g4 + 4 * hi + q;
          float w = __builtin_amdgcn_exp2f(R2 + gc[q]) * st[4 * g4 + q];
          const bool keep = !diag || (dir ? (sl >= r32) : (sl <= r32));
          w = keep ? w : 0.f;
          sw += w;
          st[4 * g4 + q] = w;
        }
      }
      u32x4 p0, p1;
      p0.x = cvt_pk_bf16(st[0], st[1]); p0.y = cvt_pk_bf16(st[2], st[3]); p0.z = cvt_pk_bf16(st[4], st[5]); p0.w = cvt_pk_bf16(st[6], st[7]);
      p1.x = cvt_pk_bf16(st[8], st[9]); p1.y = cvt_pk_bf16(st[10], st[11]); p1.z = cvt_pk_bf16(st[12], st[13]); p1.w = cvt_pk_bf16(st[14], st[15]);
      const bf16x8 pw0 = __builtin_bit_cast(bf16x8, p0), pw1 = __builtin_bit_cast(bf16x8, p1);
#pragma unroll
      for (int eb = 0; eb < 4; ++eb) {
        const int rb = sb * 32 + 4 * hi;
        const bf16x8 a0 = cat44(vtr((lds_cptr)(lds + 32768 + trq_addr(lane, eb, rb))), vtr((lds_cptr)(lds + 32768 + trq_addr(lane, eb, rb + 8))));
        const bf16x8 a1 = cat44(vtr((lds_cptr)(lds + 32768 + trq_addr(lane, eb, rb + 16))), vtr((lds_cptr)(lds + 32768 + trq_addr(lane, eb, rb + 24))));
        acc[eb] = __builtin_amdgcn_mfma_f32_32x32x16_bf16(a0, pw0, acc[eb], 0, 0, 0);
        acc[eb] = __builtin_amdgcn_mfma_f32_32x32x16_bf16(a1, pw1, acc[eb], 0, 0, 0);
      }
    }
    sw = half_swap_add(sw);
    const float den = winter * nq + sw;
    const float dn = fmaxf(fabsf(den), __builtin_amdgcn_exp2f(R2 - BQ2));
    const float idn = 1.f / dn;
    __syncthreads();
    if (dir == 1) {
#pragma unroll
      for (int eb = 0; eb < 4; ++eb)
#pragma unroll
        for (int r = 0; r < 16; ++r) HX[(tb * 128 + eb * 32 + (r & 3) + 8 * (r >> 2) + 4 * hi) * 32 + r32] = acc[eb][r] * idn;
    }
    __syncthreads();
    if (dir == 0) {
      float ss = 0.f;
#pragma unroll
      for (int eb = 0; eb < 4; ++eb)
#pragma unroll
        for (int r = 0; r < 16; ++r) {
          const float v = acc[eb][r] * idn + HX[(tb * 128 + eb * 32 + (r & 3) + 8 * (r >> 2) + 4 * hi) * 32 + r32];
          acc[eb][r] = v; ss += v * v;
        }
      ss = half_swap_add(ss);
      const float inv = rsqrtf(ss * (1.f / 128.f) + EPS);
      const float* gh = p.g_hnorm + e2 * 512 + hd * 128;
      const bf16_t* obp = p.proj + (size_t)trow * PROJW + 2304 + hd * 128;
      bf16_t* op = p.mix + (size_t)trow * 1024 + 512 + hd * 128;
#pragma unroll
      for (int eb = 0; eb < 4; ++eb)
#pragma unroll
        for (int g4 = 0; g4 < 4; ++g4) {
          const int e0 = eb * 32 + 8 * g4 + 4 * hi;
          const f32x4 gv = *(const f32x4*)(gh + e0);
          const u32x2 ow = *(const u32x2*)(obp + e0);
          const float ob0 = __uint_as_float(ow.x << 16), ob1 = __uint_as_float(ow.x & 0xffff0000u), ob2 = __uint_as_float(ow.y << 16), ob3 = __uint_as_float(ow.y & 0xffff0000u);
          const float v0 = acc[eb][4 * g4 + 0] * inv * gv[0] * sigmoidf_(ob0), v1 = acc[eb][4 * g4 + 1] * inv * gv[1] * sigmoidf_(ob1);
          const float v2 = acc[eb][4 * g4 + 2] * inv * gv[2] * sigmoidf_(ob2), v3 = acc[eb][4 * g4 + 3] * inv * gv[3] * sigmoidf_(ob3);
          u32x2 w; w.x = cvt_pk_bf16(v0, v1); w.y = cvt_pk_bf16(v2, v3);
          *(u32x2*)(op + e0) = w;
        }
    }
  }
  __syncthreads();
}

__device__ __forceinline__ void ph_topk(const Params& p, bool ctx, float* sm) {
  const int tid = ltid(), lane = tid & 63, wv = tid >> 6;
  unsigned* cnt = (unsigned*)sm;
  unsigned* pre = (unsigned*)sm + 32;
  int* sel = (int*)sm + 64;
  const int ncol = ctx ? 256 : 128;
  for (int colu = lbid(); colu < ncol; colu += lgdim()) {
    int e, base, n, cap; size_t mbase;
    if (colu < 128) { const int b = colu >> 4; e = colu & 15; base = b * 2048; n = 2048; cap = 256; mbase = (size_t)e * 2048 + (size_t)b * 256; }
    else { const int c2 = colu - 128, b = c2 >> 4; e = c2 & 15; base = NL + b * 256; n = 256; cap = 32; mbase = (size_t)MOE_L + (size_t)e * 256 + (size_t)b * 32; }
    unsigned v[4];
#pragma unroll
    for (int k = 0; k < 4; ++k) { const int i = tid * 4 + k; v[k] = i < n ? __float_as_uint(p.aff[(size_t)(base + i) * 16 + e]) : 0u; }
    unsigned thr = 0u;
    for (int bit = 30; bit >= 0; --bit) {
      const unsigned cand = thr | (1u << bit);
      unsigned c = (v[0] >= cand) + (v[1] >= cand) + (v[2] >= cand) + (v[3] >= cand);
#pragma unroll
      for (int o = 32; o > 0; o >>= 1) c += __shfl_xor(c, o);
      unsigned* cb = cnt + (bit & 1) * 8;
      if (lane == 0) cb[wv] = c;
      __syncthreads();
      const unsigned tot = cb[0] + cb[1] + cb[2] + cb[3] + cb[4] + cb[5] + cb[6] + cb[7];
      if (tot >= (unsigned)cap) thr = cand;
    }
    unsigned ngt = (v[0] > thr) + (v[1] > thr) + (v[2] > thr) + (v[3] > thr);
    unsigned neq = (v[0] == thr) + (v[1] == thr) + (v[2] == thr) + (v[3] == thr);
    unsigned igt = ngt, ieq = neq;
#pragma unroll
    for (int o = 1; o < 64; o <<= 1) { const unsigned a = __shfl_up(igt, o), b2 = __shfl_up(ieq, o); if (lane >= o) { igt += a; ieq += b2; } }
    __syncthreads();
    if (lane == 63) { pre[wv] = igt; pre[8 + wv] = ieq; }
    __syncthreads();
    unsigned totgt = 0, offgt = 0, offeq = 0;
#pragma unroll
    for (int w2 = 0; w2 < 8; ++w2) { const unsigned a = pre[w2], b2 = pre[8 + w2]; totgt += a; if (w2 < wv) { offgt += a; offeq += b2; } }
    const unsigned need_eq = (unsigned)cap - totgt;
    unsigned egt = offgt + igt - ngt, eeq = offeq + ieq - neq;
#pragma unroll
    for (int k = 0; k < 4; ++k) {
      const int i = tid * 4 + k;
      const bool gt = v[k] > thr, eq = v[k] == thr;
      const bool take = gt || (eq && eeq < need_eq);
      if (i < n) {
        const int r = base + i;
        const unsigned slot = egt + (eeq < need_eq ? eeq : need_eq);
        if (take) { p.slotmap[(size_t)r * 16 + e] = (int)slot; p.rowidx[mbase + slot] = r; p.gatev[mbase + slot] = __uint_as_float(v[k]); sel[slot] = r; }
        else p.slotmap[(size_t)r * 16 + e] = -1;
      }
      egt += gt; eeq += eq;
    }
    __syncthreads();
    __syncthreads();
  }
}

template <int W>
__device__ __forceinline__ void pool_item(const Params& p, int r, int c8) {
  int t, n;
  if (r < NL) { t = r & 2047; n = 2048; } else { t = (r - NL) & 255; n = 256; }
  constexpr int lo = W / 2;
  const bf16_t* up = p.proj + (size_t)r * 1024 + c8;
  u32x4 raw[W];
  int cnt = 0;
#pragma unroll
  for (int k = 0; k < W; ++k) {
    const int tt = t - lo + k;
    const bool ok = tt >= 0 && tt < n;
    raw[k] = ok ? *(const u32x4*)(up + (ptrdiff_t)(k - lo) * 1024) : (u32x4){0u, 0u, 0u, 0u};
    cnt += ok ? 1 : 0;
  }
  float s8[8], f[8], uc[8];
#pragma unroll
  for (int j = 0; j < 8; ++j) s8[j] = 0.f;
#pragma unroll
  for (int k = 0; k < W; ++k) {
    unpack8(raw[k], f);
#pragma unroll
    for (int j = 0; j < 8; ++j) s8[j] += f[j];
  }
  unpack8(raw[lo], uc);
  const float ic = 1.f / (float)cnt;
#pragma unroll
  for (int j = 0; j < 8; ++j) f[j] = s8[j] * ic - uc[j];
  *(u32x4*)(p.mix + (size_t)r * 1024 + c8) = pack8(f);
}
__device__ __forceinline__ void ph_pool(const Params& p, int nrows) {
  const size_t gtid = (size_t)lbid() * NTHR + ltid(), gsz = (size_t)lgdim() * NTHR;
  for (size_t it = gtid; it < (size_t)nrows * 128; it += gsz) {
    const int g = (int)(it / ((size_t)nrows * 32));
    const size_t rem = it - (size_t)g * nrows * 32;
    const int r = (int)(rem >> 5), c8 = g * 256 + (int)(rem & 31) * 8;
    if (g == 0) pool_item<2>(p, r, c8);
    else if (g == 1) pool_item<4>(p, r, c8);
    else if (g == 2) pool_item<8>(p, r, c8);
    else pool_item<16>(p, r, c8);
  }
}

enum { PH_INIT = 0, PH_NORM1, PH_GEMM_IN_EVEN, PH_POST_EVEN, PH_ATT, PH_MLSTM_U, PH_MLSTM_SCAN, PH_MLSTM_H, PH_GEMM_OUT, PH_NORM2, PH_TOPK, PH_GATHER,
       PH_MOE_GU, PH_MOE_D, PH_GEMM_IN_ODD, PH_POOL, PH_GEMM_GRP, PH_FINAL };

typedef const __attribute__((address_space(4))) Params* KParams;
__device__ __forceinline__ const Params& get_params() {
  KParams kp = (KParams)__builtin_amdgcn_kernarg_segment_ptr();
  asm volatile("" : "+s"(kp));
  return *(const Params*)kp;
}
__device__ __forceinline__ int idle_slots(int nu, int G, int c) {
  const int mx = (nu + G - 1) / G, mine = c < nu ? (nu - c + G - 1) / G : 0;
  return mx - mine;
}
__device__ __forceinline__ void run_phase(int ph, int l, unsigned char* shm) {
  const Params& p = get_params();
  float* sm = (float*)shm;
  LAS unsigned char* lds = (LAS unsigned char*)shm;
  const bool ctx_next = (l < 2);
  const bool ctx_used = (l < 3);
  const int G = lgdim(), c = lbid();
  switch (ph) {
    case PH_INIT: ph_init(p, sm); break;
    case PH_NORM1: {
      const int ncomb = (l == 0) ? 0 : ((l - 1) < 2 ? NT : NL);
      ph_norm(p, l, 1, ctx_used ? NT : NL, ncomb, l - 1, sm);
    } break;
    case PH_GEMM_IN_EVEN: {
      g8::SchedDense S{(const char*)p.hbuf, (const char*)(p.WinE + (size_t)(l >> 1) * PROJW * 1024), 1024, 1024, NT / 256, PROJW / 256, 0, G, c};
      g8::EpiBf16 E{p.proj, PROJW};
      g8::gemm_phase(lds, 1024, 1024, 1024, S, E);
      conv_quota(p, idle_slots(S.nM * S.nN, G, c) * 3, sm);
    } break;
    case PH_POST_EVEN: ph_post_even(p, l, sm); break;
    case PH_MLSTM_U: ph_mlstm_u(p, lds); break;
    case PH_ATT: ph_att(p, ctx_next, lds); ph_mlstm_scan(p, ctx_next ? 32 : 0); conv_quota(p, idle_slots(256 + (ctx_next ? 32 : 0), G, c) * 1, sm); break;
    case PH_MLSTM_H: ph_mlstm_h(p, l, ctx_next, lds); conv_quota(p, idle_slots(32 * (ctx_next ? 18 : 16), G, c) * 3, sm); break;
    case PH_GEMM_OUT: {
      g8::SchedDense S{(const char*)p.mix, (const char*)(p.WoutE + (size_t)(l >> 1) * 1024 * 1024), 1024, 1024, (ctx_next ? NT : NL) / 256, 4, 0, G, c};
      g8::EpiBf16 E{p.ybuf, 1024};
      g8::gemm_phase(lds, 1024, 1024, 1024, S, E);
      conv_quota(p, idle_slots(S.nM * S.nN, G, c) * 3, sm);
    } break;
    case PH_NORM2: ph_norm(p, l, 2, ctx_next ? NT : NL, 0, 0, sm); break;
    case PH_TOPK: ph_topk(p, ctx_next, sm); conv_until(p, l == 0 ? CE4 : (l == 1 ? CE7 : (l == 2 ? CE10 : CE11)), sm); break;
    case PH_MOE_GU: {
      g8::SchedMoe S{(const char*)p.Xs, (const char*)(p.Wgu + (size_t)l * NEXP * 2048 * 1024), 8, 2048, 128, ctx_next ? 1152 : 1024, G, c};
      g8::EpiSwiGLU E{p.Abuf};
      g8::gemm_phase<true>(lds, 1024, 1024, 1024, S, E, p.rowidx, (const char*)p.hbuf);
      conv_quota(p, idle_slots(S.nu, G, c) * 3, sm);
    } break;
    case PH_MOE_D: {
      g8::SchedMoe S{(const char*)p.Abuf, (const char*)(p.Wd + (size_t)l * NEXP * 1024 * 1024), 4, 1024, 256, ctx_next ? 576 : 512, G, c};
      g8::EpiDown E{p.Ybuf, p.gatev};
      g8::gemm_phase(lds, 1024, 1024, 1024, S, E);
      conv_quota(p, idle_slots(S.nu, G, c) * 3, sm);
    } break;
    case PH_GEMM_IN_ODD: {
      g8::SchedDense S{(const char*)p.hbuf, (const char*)(p.WinO + (size_t)(l >> 1) * 1024 * 1024), 1024, 1024, (ctx_next ? NT : NL) / 256, 4, 0, G, c};
      g8::EpiBf16 E{p.proj, 1024};
      g8::gemm_phase(lds, 1024, 1024, 1024, S, E);
      conv_quota(p, idle_slots(S.nM * S.nN, G, c) * 3, sm);
    } break;
    case PH_POOL: ph_pool(p, ctx_next ? NT : NL); break;
    case PH_GEMM_GRP: {
      g8::SchedDense S{(const char*)p.mix, (const char*)(p.Wgrp + (size_t)(l >> 1) * 1024 * 256), 1024, 256, (ctx_next ? NT : NL) / 256, 4, 512, G, c};
      g8::EpiBf16 E{p.ybuf, 1024};
      g8::gemm_phase(lds, 256, 1024, 256, S, E);
      conv_quota(p, idle_slots(S.nM * S.nN, G, c) * 1, sm);
    } break;
    case PH_FINAL: ph_norm(p, 3, 3, NL, NL, 3, sm); break;
  }
}

__global__ void __launch_bounds__(NTHR) mega_kernel(Params p) {
  extern __shared__ __attribute__((aligned(16))) unsigned char shm[];
  cg::grid_group grid = cg::this_grid();
  volatile LAS unsigned* st = (volatile LAS unsigned*)((LAS unsigned char*)shm + g8::STAGE_BYTES + 1536);
  if (threadIdx.x < 2) st[threadIdx.x] = 0u;
  __syncthreads();
  unsigned* barw;
  { const Params& q = get_params(); barw = q.barw; }
  const XcdBarrier xb = xcd_barrier_post(barw, st);
  const int nprog = p.nprog;
  for (int i = 0; i < nprog; ++i) {
    int ph, l;
    { const Params& q = get_params(); ph = q.prog_ph[i]; l = q.prog_l[i]; }
    run_phase(ph, l, shm);
    if (i + 1 < nprog) { if (nprog > 1000) grid.sync(); else xcd_barrier(xb); }
  }
}

extern "C" void kernel_launch(void* const* d_in, const int* in_sizes, int n_in, void* d_out, int out_size, void* d_ws, size_t ws_size,
                              hipStream_t stream) {
  Params p{};
  const float* const* in = (const float* const*)d_in;
  p.x = in[0]; p.c = in[1]; p.ctx = in[2]; p.c_ctx = in[3]; p.w_mod = in[4]; p.b_mod = in[5]; p.g_norm1 = in[6]; p.g_norm2 = in[7];
  p.w_in_even = in[8]; p.w_out_even = in[9]; p.g_qnorm = in[10]; p.g_knorm = in[11]; p.w_conv = in[12]; p.b_gate = in[13];
  p.g_hnorm = in[14]; p.w_in_odd = in[15]; p.w_pool_grp = in[16]; p.s_pool = in[17]; p.w_router = in[18]; p.w_exp_gate = in[19];
  p.w_exp_up = in[20]; p.w_exp_down = in[21]; p.g_final = in[22];
  p.out = (float*)d_out;
  char* w = (char*)d_ws;
  size_t off = 0;
  auto take = [&](size_t bytes) { char* r = w + off; off += (bytes + 255) & ~(size_t)255; return (void*)r; };
  p.xcur = (float*)take((size_t)NT * 1024 * 4);
  p.mod = (float*)take(4 * 9 * 6144 * 4);
  p.hbuf = (bf16_t*)take((size_t)NT * 1024 * 2);
  p.Ybuf = (bf16_t*)take((size_t)MOE_T * 1024 * 2);
  p.gatev = (float*)take(MOE_T * 4);
  p.rowidx = (int*)take(MOE_T * 4);
  p.slotmap = (int*)take((size_t)NT * 16 * 4);
  p.barw = (unsigned*)take(XCD_BAR_WORDS * 4);
  p.aff = (float*)take((size_t)NT * 16 * 4);
  p.gates = (float*)take((size_t)NT * 16 * 4);
  p.WinE = (bf16_t*)take((size_t)2 * PROJW * 1024 * 2);
  p.WoutE = (bf16_t*)take((size_t)2 * 1024 * 1024 * 2);
  p.WinO = (bf16_t*)take((size_t)2 * 1024 * 1024 * 2);
  p.Wgrp = (bf16_t*)take((size_t)2 * 1024 * 256 * 2);
  p.Wgu = (bf16_t*)take((size_t)4 * NEXP * 2048 * 1024 * 2);
  p.Wd = (bf16_t*)take((size_t)4 * NEXP * 1024 * 1024 * 2);
  const size_t uoff = off;
  p.proj = (bf16_t*)take((size_t)NT * PROJW * 2);
  p.Qb = (bf16_t*)take((size_t)NT * 512 * 2);
  p.Kb = (bf16_t*)take((size_t)NB * 2 * 2304 * 64 * 2);
  p.Vb = (bf16_t*)take((size_t)NB * 2 * 2304 * 64 * 2);
  p.qm = (bf16_t*)take((size_t)NT * 512 * 2);
  p.km = (bf16_t*)take((size_t)NT * 512 * 2);
  p.gsG = (float*)take((size_t)NT * 8 * 4);
  p.gsR = (float*)take((size_t)NT * 8 * 4);
  p.gsB = (float*)take((size_t)NT * 8 * 4);
  p.cMIN = (float*)take(64 * 18 * 4);
  p.cE1 = (float*)take(64 * 18 * 4);
  p.cDEC = (float*)take(64 * 18 * 4);
  p.cBE = (float*)take(64 * 18 * 4);
  p.cGM = (float*)take(64 * 18 * 4);
  p.Ubuf = (float*)take((size_t)64 * 17 * 16384 * 4);
  p.NLb = (float*)take((size_t)64 * 17 * 128 * 4);
  p.NVb = (float*)take((size_t)64 * 18 * 128 * 4);
  p.Cbf = (bf16_t*)take((size_t)64 * 18 * 16384 * 2);
  p.mix = (bf16_t*)take((size_t)NT * 1024 * 2);
  p.ybuf = (bf16_t*)take((size_t)NT * 1024 * 2);
  const size_t uend = off;
  off = uoff;
  p.Xs = (bf16_t*)take((size_t)MOE_T * 1024 * 2);
  p.Abuf = (bf16_t*)take((size_t)MOE_T * 1024 * 2);
  if (off < uend) off = uend;
  if (off > ws_size) { fprintf(stderr, "ws too small: need %zu have %zu\n", off, ws_size); return; }

  int n = 0;
  auto add = [&](int ph, int l) { p.prog_ph[n] = (unsigned char)ph; p.prog_l[n] = (unsigned char)l; ++n; };
  add(PH_INIT, 0);
  for (int l = 0; l < 4; ++l) {
    add(PH_NORM1, l);
    if ((l & 1) == 0) {
      add(PH_GEMM_IN_EVEN, l); add(PH_POST_EVEN, l); add(PH_MLSTM_U, l); add(PH_ATT, l); add(PH_MLSTM_H, l); add(PH_GEMM_OUT, l);
    } else {
      add(PH_GEMM_IN_ODD, l); add(PH_POOL, l); add(PH_GEMM_GRP, l);
    }
    add(PH_NORM2, l); add(PH_TOPK, l); add(PH_MOE_GU, l); add(PH_MOE_D, l);
  }
  add(PH_FINAL, 0);
  p.nprog = n;

  const int LDS = g8::STAGE_BYTES + 2048;
  static int grid_blocks = 0;
  if (!grid_blocks) {
    (void)hipFuncSetAttribute((const void*)mega_kernel, hipFuncAttributeMaxDynamicSharedMemorySize, LDS);
    int dev = 0, cus = 0, per_cu = 0;
    (void)hipGetDevice(&dev);
    (void)hipDeviceGetAttribute(&cus, hipDeviceAttributeMultiprocessorCount, dev);
    (void)hipOccupancyMaxActiveBlocksPerMultiprocessor(&per_cu, mega_kernel, NTHR, LDS);
    if (per_cu < 1) per_cu = 1;
    if (per_cu > 1) per_cu = 1;
    grid_blocks = cus * per_cu;
  }
  (void)hipMemsetAsync(p.barw, 0, XCD_BAR_WORDS * 4, stream);
  void* args[] = {&p};
  hipError_t e = hipLaunchCooperativeKernel((void*)mega_kernel, dim3(grid_blocks), dim3(NTHR), args, LDS, stream);
  if (e != hipSuccess) fprintf(stderr, "cooperative launch failed: %s (grid %d)\n", hipGetErrorString(e), grid_blocks);
}
```

```cpp
#include <hip/hip_runtime.h>
#include <hip/hip_cooperative_groups.h>
#include <math.h>
#include <stdio.h>
namespace cg = cooperative_groups;

#define DM 1024
#define NB 8
#define SEQ 2048
#define CTXL 256
#define NL (NB * SEQ)
#define NC (NB * CTXL)
#define NT (NL + NC)
#define EVEN_IN 2832
#define PROJW 2816
#define NEXP 16
#define MOE_L (NEXP * NB * 256)
#define MOE_C (NEXP * NB * 32)
#define MOE_T (MOE_L + MOE_C)
#define EPS 1e-6f
#define NTHR 512
#define LAS __attribute__((address_space(3)))

typedef unsigned short bf16_t;
typedef short bf16x8 __attribute__((ext_vector_type(8)));
typedef float f32x4 __attribute__((ext_vector_type(4)));
typedef unsigned u32x4 __attribute__((ext_vector_type(4)));
typedef unsigned u32x2 __attribute__((ext_vector_type(2)));

struct Params {
  const float *x, *c, *ctx, *c_ctx, *w_mod, *b_mod, *g_norm1, *g_norm2, *w_in_even, *w_out_even, *g_qnorm, *g_knorm,
      *w_conv, *b_gate, *g_hnorm, *w_in_odd, *w_pool_grp, *s_pool, *w_router, *w_exp_gate, *w_exp_up, *w_exp_down, *g_final;
  float* out;
  float *xcur, *mod, *gates, *aff, *gatev, *gsG, *gsR, *gsB, *cMIN, *cE1, *cDEC, *cBE, *cGM, *Ubuf, *NLb, *NVb;
  bf16_t *hbuf, *proj, *mix, *Xs, *Abuf, *Ybuf, *Qb, *Kb, *Vb, *qm, *km, *Cbf, *ybuf;
  bf16_t *WinE, *WoutE, *WinO, *Wgrp, *Wgu, *Wd;
  int *rowidx, *slotmap;
  unsigned* barw;
  int nprog;
  unsigned char prog_ph[60], prog_l[60];
};

__device__ __forceinline__ float siluf(float v) { return v / (1.f + expf(-v)); }
__device__ __forceinline__ float sigmoidf_(float v) { return 1.f / (1.f + expf(-v)); }
__device__ __forceinline__ float logsigmoidf_(float v) { return fminf(v, 0.f) - __logf(1.f + __expf(-fabsf(v))); }
__device__ __forceinline__ float wave_sum(float v) {
#pragma unroll
  for (int o = 32; o > 0; o >>= 1) v += __shfl_xor(v, o);
  return v;
}
__device__ __forceinline__ int modrow(int r) { return r < NL ? (r >> 11) : 8; }
__device__ __forceinline__ float bf2f(bf16_t v) { return __uint_as_float(((unsigned)v) << 16); }
typedef float f32x2_t __attribute__((ext_vector_type(2)));
typedef __bf16 bf16x2_t __attribute__((ext_vector_type(2)));
__device__ __forceinline__ unsigned cvt_pk_bf16(float lo, float hi) {
  const f32x2_t v = {lo, hi};
  return __builtin_bit_cast(unsigned, __builtin_convertvector(v, bf16x2_t));
}
__device__ __forceinline__ bf16_t f2bf(float f) { return (bf16_t)(cvt_pk_bf16(f, 0.f) & 0xffffu); }
__device__ __forceinline__ void unpack8(const u32x4 w, float (&f)[8]) {
  f[0] = __uint_as_float(w.x << 16); f[1] = __uint_as_float(w.x & 0xffff0000u); f[2] = __uint_as_float(w.y << 16); f[3] = __uint_as_float(w.y & 0xffff0000u);
  f[4] = __uint_as_float(w.z << 16); f[5] = __uint_as_float(w.z & 0xffff0000u); f[6] = __uint_as_float(w.w << 16); f[7] = __uint_as_float(w.w & 0xffff0000u);
}
__device__ __forceinline__ u32x4 pack8(const float (&f)[8]) {
  u32x4 w; w.x = cvt_pk_bf16(f[0], f[1]); w.y = cvt_pk_bf16(f[2], f[3]); w.z = cvt_pk_bf16(f[4], f[5]); w.w = cvt_pk_bf16(f[6], f[7]);
  return w;
}

__device__ __forceinline__ int ltid() { int t = threadIdx.x; asm volatile("" : "+v"(t)); return t; }
__device__ __forceinline__ int lbid() { int b = blockIdx.x; asm volatile("" : "+s"(b)); return b; }
__device__ __forceinline__ int lgdim() { int g = gridDim.x; asm volatile("" : "+s"(g)); return g; }

#define XB_TMO      128
#define XB_XCNT(j)  (256  + 64 * (j))
#define XB_XSUB(j)  (1280 + 64 * (j))
#define XB_XGEN(j)  (2304 + 64 * (j))
#define XB_TOP      3328
#define XB_TOPGEN   3392
#define XCD_BAR_WORDS 3456
#define XB_SPIN_CAP (1u << 18)
__device__ __forceinline__ unsigned xb_ld(unsigned* p)              { return __hip_atomic_load(p, __ATOMIC_RELAXED, __HIP_MEMORY_SCOPE_AGENT); }
__device__ __forceinline__ unsigned xb_add(unsigned* p, unsigned v) { return __hip_atomic_fetch_add(p, v, __ATOMIC_RELAXED, __HIP_MEMORY_SCOPE_AGENT); }
__device__ __forceinline__ unsigned xb_xcc_id() { return (unsigned)__builtin_amdgcn_s_getreg((3 << 11) | 20) & 0xFu; }
#define XB_SPIN(cond, bar) do { unsigned _sp = 0; while (cond) { __builtin_amdgcn_s_sleep(1); \
    if ((++_sp & 255u) == 0u) { if (xb_ld(&(bar)[XB_TMO])) break; if (_sp > XB_SPIN_CAP) { atomicAdd(&(bar)[XB_TMO], 1u); break; } } } } while (0)
struct XcdBarrier { unsigned* bar; unsigned x; volatile LAS unsigned* st; };
__device__ __forceinline__ XcdBarrier xcd_barrier_post(unsigned* bar, volatile LAS unsigned* st) {
  XcdBarrier b; b.bar = bar; b.x = xb_xcc_id(); b.st = st;
  if (threadIdx.x == 0) (void)xb_add(&bar[XB_XCNT(b.x)], 1u);
  return b;
}
__device__ __forceinline__ void xcd_barrier_complete(unsigned* bar, unsigned x, unsigned& nloc, unsigned& nx) {
  const unsigned G = gridDim.x * gridDim.y * gridDim.z;
  unsigned sum, cnt, mine, sp = 0u;
  for (;;) {
    sum = 0u; cnt = 0u; mine = 0u;
#pragma unroll
    for (unsigned j = 0; j < 16; ++j) { const unsigned c = xb_ld(&bar[XB_XCNT(j)]); sum += c; cnt += (c > 0u) ? 1u : 0u; mine = (j == x) ? c : mine; }
    if (sum == G) break;
    __builtin_amdgcn_s_sleep(1);
    if ((++sp & 255u) == 0u) { if (xb_ld(&bar[XB_TMO])) break; if (sp > XB_SPIN_CAP) { atomicAdd(&bar[XB_TMO], 1u); break; } }
  }
  nloc = mine > 0u ? mine : 1u; nx = cnt > 0u ? cnt : 1u;
}
__device__ __forceinline__ void xcd_barrier(const XcdBarrier& b) {
  asm volatile("s_waitcnt vmcnt(0)" ::: "memory");
  __syncthreads();
  if (threadIdx.x == 0) {
    unsigned* bar = b.bar;
    __builtin_amdgcn_s_waitcnt(0);
    unsigned nloc = b.st[0], nx = b.st[1];
    if (nloc == 0u) { xcd_barrier_complete(bar, b.x, nloc, nx); b.st[0] = nloc; b.st[1] = nx; }
    const unsigned old = xb_add(&bar[XB_XSUB(b.x)], 1u);
    const unsigned gen = old / nloc;
    if (old + 1u == (gen + 1u) * nloc) {
      __builtin_amdgcn_fence(__ATOMIC_RELEASE, "agent");
      asm volatile("s_waitcnt vmcnt(0)" ::: "memory");
      const unsigned og = xb_add(&bar[XB_TOP], 1u);
      const unsigned tg = og / nx;
      if (og + 1u == (tg + 1u) * nx) xb_add(&bar[XB_TOPGEN], 1u);
      else XB_SPIN(xb_ld(&bar[XB_TOPGEN]) == tg, bar);
      __builtin_amdgcn_fence(__ATOMIC_ACQUIRE, "agent");
      xb_add(&bar[XB_XGEN(b.x)], 1u);
      asm volatile("s_waitcnt vmcnt(0)" ::: "memory");
    } else {
      XB_SPIN(xb_ld(&bar[XB_XGEN(b.x)]) == gen, bar);
      __builtin_amdgcn_fence(__ATOMIC_ACQUIRE, "agent");
      asm volatile("s_waitcnt vmcnt(0)" ::: "memory");
    }
  }
  __syncthreads();
}

namespace g8 {
constexpr int BM = 256, BK = 64, HALF = 128, HTB = HALF * BK * 2, STAGE_BYTES = 8 * HTB;
__device__ __forceinline__ int lds_byte(int r, int c) { const int st = (r >> 4) * 2 + (c >> 5), rr = r & 15, cc = c & 31, ob = rr * 64 + cc * 2; return st * 1024 + (ob ^ (((ob >> 9) & 1) << 5)); }
__device__ __forceinline__ void stage_rc(int b, int& R, int& C) { const int st = b / 1024, sb = b % 1024, swz = sb ^ (((sb >> 9) & 1) << 5); R = (st >> 1) * 16 + swz / 64; C = (st & 1) * 32 + (swz % 64) / 2; }
__device__ __forceinline__ int perm32(int rho) { const int n = rho >> 4, i = rho & 15; return 8 * (i >> 2) + 4 * n + (i & 3); }

struct Unit { const char* A; const char* B; int row0, col0; };

template <bool GATHER = false, class Epi, class Sched>
__device__ __forceinline__ void gemm_phase(LAS unsigned char* lds, const int K, const int lda, const int ldb, const Sched& S, const Epi& E, const int* gidx = nullptr, const char* gbaseA = nullptr) {
  const int tid = ltid(), wid = __builtin_amdgcn_readfirstlane(tid >> 6), lane = tid & 63, wr = wid >> 2, wc = wid & 3, fr = lane & 15, fq = lane >> 4;
  const int nt = K / BK;
  unsigned voffA[2], voffB[2], gC2[2];
  int gR[2];
#pragma unroll
  for (int i = 0; i < 2; ++i) {
    int R, C;
    stage_rc(tid * 16 + i * 8192, R, C);
    const int Rb = (R & ~31) + perm32(R & 31);
    voffA[i] = (unsigned)(R * lda + C) * 2u;
    voffB[i] = (unsigned)(Rb * ldb + C) * 2u;
    gR[i] = R; gC2[i] = (unsigned)C * 2u;
  }
  unsigned gcur[2][2], gnxt[2][2];
  auto gload = [&](int row0, unsigned (&g)[2][2]) {
#pragma unroll
    for (int h = 0; h < 2; ++h)
#pragma unroll
      for (int i = 0; i < 2; ++i) g[h][i] = (unsigned)gidx[row0 + h * HALF + gR[i]] * (unsigned)(lda * 2) + gC2[i];
  };
  const size_t kstep = (size_t)(BK * 2);
  const size_t hstepA = (size_t)HALF * lda * 2, hstepB = (size_t)HALF * ldb * 2;
  const unsigned ldsw = (unsigned)wid * 1024u;
  const int aoff = lds_byte(wr * 64 + fr, fq * 8), boff = lds_byte(wc * 32 + fr, fq * 8);
#define PG8_SA(b, h) (((b) * 2 + (h)) * HTB)
#define PG8_SB(b, h) ((4 + (b) * 2 + (h)) * HTB)
#define PG8_STAGE(bufoff, gbase, voff) do { _Pragma("unroll") for (int _i = 0; _i < 2; ++_i) \
    __builtin_amdgcn_global_load_lds((const unsigned*)((const char*)(gbase) + (voff)[_i]), (LAS unsigned*)(lds + (bufoff) + ldsw + _i * 8192), 16, 0, 0); } while (0)
#define PG8_LDA(dst, b, h) do { _Pragma("unroll") for (int m = 0; m < 4; ++m) _Pragma("unroll") for (int k = 0; k < 2; ++k) dst[m][k] = *(const LAS bf16x8*)(lds + PG8_SA(b, h) + aoff + m * 2048 + k * 1024); } while (0)
#define PG8_LDB(dst, b, h) do { _Pragma("unroll") for (int n = 0; n < 2; ++n) _Pragma("unroll") for (int k = 0; k < 2; ++k) dst[n][k] = *(const LAS bf16x8*)(lds + PG8_SB(b, h) + boff + n * 2048 + k * 1024); } while (0)
#define PG8_MMA(ai, bj, At, Bt) do { __builtin_amdgcn_s_setprio(1); _Pragma("unroll") for (int m = 0; m < 4; ++m) _Pragma("unroll") for (int n = 0; n < 2; ++n) _Pragma("unroll") for (int k = 0; k < 2; ++k) \
    acc[ai][bj][m][n] = __builtin_amdgcn_mfma_f32_16x16x32_bf16(Bt[n][k], At[m][k], acc[ai][bj][m][n], 0, 0, 0); __builtin_amdgcn_s_setprio(0); } while (0)
#define PG8_WAIT_V(n) asm volatile("s_waitcnt vmcnt(" #n ")" ::: "memory")
#define PG8_WAIT_L(n) asm volatile("s_waitcnt lgkmcnt(" #n ")" ::: "memory")
#define PG8_BAR __builtin_amdgcn_s_barrier()
#define PG8_SCHED __builtin_amdgcn_sched_barrier(0)
#define PG8_STAGE_A(bufoff, nextu, half, kbytes) do { \
    if constexpr (GATHER) { if (nextu) PG8_STAGE(bufoff, gbaseA + (kbytes), gnxt[half]); else PG8_STAGE(bufoff, gbaseA + (kbytes), gcur[half]); } \
    else { PG8_STAGE(bufoff, ((nextu) ? nA : cA) + (half) * hstepA + (kbytes), voffA); } } while (0)
  Unit cur, nxt;
  int ui = 0;
  if (!S.next(0, cur)) return;
  f32x4 acc[2][2][4][2];
#pragma unroll
  for (int a = 0; a < 2; ++a)
#pragma unroll
    for (int b = 0; b < 2; ++b)
#pragma unroll
      for (int m = 0; m < 4; ++m)
#pragma unroll
        for (int n = 0; n < 2; ++n) acc[a][b][m][n] = (f32x4){0.f, 0.f, 0.f, 0.f};
  bf16x8 At[4][2], B0[2][2], B1[2][2];
  const char* cA = cur.A;
  const char* cB = cur.B;
  const char* nA = cA;
  if constexpr (GATHER) { gload(cur.row0, gcur); gload(cur.row0, gnxt); asm volatile("s_waitcnt vmcnt(0)" ::: "memory"); }
  PG8_STAGE(PG8_SB(0, 0), cB, voffB); PG8_STAGE(PG8_SB(0, 1), cB + hstepB, voffB); PG8_STAGE_A(PG8_SA(0, 0), false, 0, 0); PG8_STAGE_A(PG8_SA(0, 1), false, 1, 0);
  if (wr == 1) PG8_BAR;
  PG8_WAIT_V(2); PG8_BAR;
  PG8_STAGE(PG8_SB(1, 0), cB + kstep, voffB); PG8_STAGE_A(PG8_SA(1, 0), false, 0, kstep); PG8_STAGE(PG8_SB(1, 1), cB + hstepB + kstep, voffB);
  PG8_WAIT_V(6); PG8_BAR;
  for (;;) {
    const bool has_next = S.next(ui + 1, nxt);
    nA = has_next ? nxt.A : cA;
    const char* nB = has_next ? nxt.B : cB;
    if constexpr (GATHER) { if (has_next) gload(nxt.row0, gnxt); else {
#pragma unroll
      for (int h = 0; h < 2; ++h)
#pragma unroll
        for (int i = 0; i < 2; ++i) gnxt[h][i] = gcur[h][i]; } }
    for (int t = 0; t < nt; t += 2) {
      const bool last = (t == nt - 2);
      const size_t k1 = (size_t)(t + 1) * kstep;
      const size_t k2 = last ? 0 : (size_t)(t + 2) * kstep;
      const size_t k3 = k2 + kstep;
      const char* b2 = last ? nB : cB + (size_t)(t + 2) * kstep;
      const char* b3 = b2 + kstep;
      PG8_LDB(B0, 0, 0); PG8_LDB(B1, 0, 1); PG8_SCHED; PG8_LDA(At, 0, 0); PG8_STAGE_A(PG8_SA(1, 1), false, 1, k1);
      PG8_WAIT_V(8); PG8_WAIT_L(0); PG8_BAR; PG8_MMA(0, 0, At, B0); PG8_MMA(0, 1, At, B1); PG8_BAR; PG8_SCHED;
      PG8_LDA(At, 0, 1); PG8_STAGE(PG8_SB(0, 0), b2, voffB); PG8_STAGE(PG8_SB(0, 1), b2 + hstepB, voffB); PG8_STAGE_A(PG8_SA(0, 0), last, 0, k2);
      PG8_WAIT_V(8); PG8_WAIT_L(0); PG8_BAR; PG8_MMA(1, 0, At, B0); PG8_MMA(1, 1, At, B1); PG8_BAR; PG8_SCHED;
      PG8_LDB(B0, 1, 0); PG8_LDB(B1, 1, 1); PG8_SCHED; PG8_LDA(At, 1, 0); PG8_STAGE_A(PG8_SA(0, 1), last, 1, k2);
      PG8_WAIT_V(8); PG8_WAIT_L(0); PG8_BAR; PG8_MMA(0, 0, At, B0); PG8_MMA(0, 1, At, B1); PG8_BAR; PG8_SCHED;
      PG8_LDA(At, 1, 1); PG8_STAGE(PG8_SB(1, 0), b3, voffB); PG8_STAGE(PG8_SB(1, 1), b3 + hstepB, voffB); PG8_STAGE_A(PG8_SA(1, 0), last, 0, k3);
      PG8_WAIT_V(8); PG8_WAIT_L(0); PG8_BAR; PG8_MMA(1, 0, At, B0); PG8_MMA(1, 1, At, B1); PG8_BAR; PG8_SCHED;
    }
    if (wr == 0) PG8_BAR;
    E(acc, cur, wr, wc, fr, fq);
    if (!has_next) break;
#pragma unroll
    for (int a = 0; a < 2; ++a)
#pragma unroll
      for (int b = 0; b < 2; ++b)
#pragma unroll
        for (int m = 0; m < 4; ++m)
#pragma unroll
          for (int n = 0; n < 2; ++n) acc[a][b][m][n] = (f32x4){0.f, 0.f, 0.f, 0.f};
    cur = nxt; cA = nA; cB = nB; ++ui;
    if constexpr (GATHER) {
#pragma unroll
      for (int h = 0; h < 2; ++h)
#pragma unroll
        for (int i = 0; i < 2; ++i) gcur[h][i] = gnxt[h][i];
    }
    if (wr == 1) PG8_BAR;
  }
  PG8_WAIT_V(0);
  PG8_BAR;
#undef PG8_SA
#undef PG8_SB
#undef PG8_STAGE
#undef PG8_STAGE_A
#undef PG8_LDA
#undef PG8_LDB
#undef PG8_MMA
#undef PG8_WAIT_V
#undef PG8_WAIT_L
#undef PG8_BAR
#undef PG8_SCHED
}

struct SchedDense {
  const char* A; const char* B; int lda, ldb, nM, nN, acolstep, G, c;
  __device__ __forceinline__ bool next(int i, Unit& u) const {
    const int nwg = nM * nN;
    const long L = (long)i * G + c;
    if (L >= nwg) return false;
    int wgid = (int)L;
    { const int q = nwg / 8, r = nwg % 8, xcd = wgid % 8, off = wgid / 8; wgid = (xcd < r ? xcd * (q + 1) : r * (q + 1) + (xcd - r) * q) + off; }
    const int nig = 8 * nN, gid = wgid / nig, fm = gid * 8, gsz = (nM - fm) < 8 ? (nM - fm) : 8;
    const int pm = fm + ((wgid % nig) % gsz), pn = (wgid % nig) / gsz;
    u.A = A + (size_t)pm * 256 * lda * 2 + (size_t)pn * acolstep;
    u.B = B + (size_t)pn * 256 * ldb * 2;
    u.row0 = pm * 256; u.col0 = pn * 256;
    return true;
  }
};
struct SchedMoe {
  const char* A; const char* W; int ncol, wrows, colw, nu, G, c;
  __device__ __forceinline__ bool next(int i, Unit& u) const {
    const long L = (long)i * G + c;
    if (L >= nu) return false;
    const int wgid = (int)(L % 8) * (nu / 8) + (int)(L / 8);
    const int UL = 128 * ncol;
    int e, pn, row0;
    if (wgid < UL) { e = wgid / (8 * ncol); const int rem = wgid % (8 * ncol); row0 = e * 2048 + (rem % 8) * 256; pn = rem / 8; }
    else { const int w2 = wgid - UL; e = w2 / ncol; pn = w2 % ncol; row0 = MOE_L + e * 256; }
    u.A = A + (size_t)row0 * 1024 * 2;
    u.B = W + ((size_t)e * wrows + (size_t)pn * 256) * 1024 * 2;
    u.row0 = row0; u.col0 = pn * colw;
    return true;
  }
};

struct EpiBf16 {
  bf16_t* O; int ldo;
  __device__ __forceinline__ void operator()(const f32x4 (&acc)[2][2][4][2], const Unit& u, int wr, int wc, int fr, int fq) const {
#pragma unroll
    for (int ai = 0; ai < 2; ++ai)
#pragma unroll
      for (int m = 0; m < 4; ++m) {
        const int row = u.row0 + ai * 128 + wr * 64 + m * 16 + fr;
        bf16_t* rp = O + (size_t)row * ldo + u.col0 + wc * 32 + 8 * fq;
#pragma unroll
        for (int bj = 0; bj < 2; ++bj) {
          const f32x4 v0 = acc[ai][bj][m][0], v1 = acc[ai][bj][m][1];
          u32x4 w; w.x = cvt_pk_bf16(v0[0], v0[1]); w.y = cvt_pk_bf16(v0[2], v0[3]); w.z = cvt_pk_bf16(v1[0], v1[1]); w.w = cvt_pk_bf16(v1[2], v1[3]);
          *(u32x4*)(rp + bj * 128) = w;
        }
      }
  }
};
struct EpiResid {
  float* x; const float* modg; const float* cs; const float* xl; const float* xc;
  __device__ __forceinline__ void operator()(const f32x4 (&acc)[2][2][4][2], const Unit& u, int wr, int wc, int fr, int fq) const {
#pragma unroll
    for (int ai = 0; ai < 2; ++ai)
#pragma unroll
      for (int m = 0; m < 4; ++m) {
        const int row = u.row0 + ai * 128 + wr * 64 + m * 16 + fr;
        const int c0 = u.col0 + wc * 32 + 8 * fq;
        float* xp = x + (size_t)row * 1024 + c0;
        const float* xi = xl ? (row < NL ? xl + (size_t)row * 1024 + c0 : xc + (size_t)(row - NL) * 1024 + c0) : xp;
        const float* gp = modg + (size_t)modrow(row) * 6144 + c0;
#pragma unroll
        for (int bj = 0; bj < 2; ++bj) {
          f32x4 g0 = *(const f32x4*)(gp + bj * 128), g1 = *(const f32x4*)(gp + bj * 128 + 4);
          if (cs) { g0 *= *(const f32x4*)(cs + c0 + bj * 128); g1 *= *(const f32x4*)(cs + c0 + bj * 128 + 4); }
          f32x4 x0 = *(const f32x4*)(xi + bj * 128), x1 = *(const f32x4*)(xi + bj * 128 + 4);
          x0 += g0 * acc[ai][bj][m][0]; x1 += g1 * acc[ai][bj][m][1];
          *(f32x4*)(xp + bj * 128) = x0; *(f32x4*)(xp + bj * 128 + 4) = x1;
        }
      }
  }
};
struct EpiSwiGLU {
  bf16_t* O;
  __device__ __forceinline__ void operator()(const f32x4 (&acc)[2][2][4][2], const Unit& u, int wr, int wc, int fr, int fq) const {
#pragma unroll
    for (int ai = 0; ai < 2; ++ai)
#pragma unroll
      for (int m = 0; m < 4; ++m) {
        const int row = u.row0 + ai * 128 + wr * 64 + m * 16 + fr;
        bf16_t* rp = O + (size_t)row * 1024 + u.col0 + wc * 32 + 8 * fq;
        float o[8];
#pragma unroll
        for (int n = 0; n < 2; ++n)
#pragma unroll
          for (int j = 0; j < 4; ++j) { const float g = acc[ai][0][m][n][j], up = acc[ai][1][m][n][j]; o[n * 4 + j] = g / (1.f + __expf(-g)) * up; }
        u32x4 w; w.x = cvt_pk_bf16(o[0], o[1]); w.y = cvt_pk_bf16(o[2], o[3]); w.z = cvt_pk_bf16(o[4], o[5]); w.w = cvt_pk_bf16(o[6], o[7]);
        *(u32x4*)rp = w;
      }
  }
};
struct EpiDown {
  bf16_t* O; const float* gatev;
  __device__ __forceinline__ void operator()(const f32x4 (&acc)[2][2][4][2], const Unit& u, int wr, int wc, int fr, int fq) const {
#pragma unroll
    for (int ai = 0; ai < 2; ++ai)
#pragma unroll
      for (int m = 0; m < 4; ++m) {
        const int row = u.row0 + ai * 128 + wr * 64 + m * 16 + fr;
        const float gv = gatev[row];
        bf16_t* rp = O + (size_t)row * 1024 + u.col0 + wc * 32 + 8 * fq;
#pragma unroll
        for (int bj = 0; bj < 2; ++bj) {
          const f32x4 v0 = acc[ai][bj][m][0] * gv, v1 = acc[ai][bj][m][1] * gv;
          u32x4 w; w.x = cvt_pk_bf16(v0[0], v0[1]); w.y = cvt_pk_bf16(v0[2], v0[3]); w.z = cvt_pk_bf16(v1[0], v1[1]); w.w = cvt_pk_bf16(v1[2], v1[3]);
          *(u32x4*)(rp + bj * 128) = w;
        }
      }
  }
};
}

#define NT_WINE 1408
#define NT_WOUT 512
#define NT_WINO 512
#define NT_WGRP 128
#define NT_EXP 16384
#define NT_ALL (NT_WINE + NT_WOUT + NT_WINO + NT_WGRP + 3 * NT_EXP)
#define CE0 704
#define CE1 960
#define CE2 13248
#define CE3 13504
#define CE4 13568
#define CE5 25856
#define CE6 26560
#define CE7 26816
#define CE8 39104
#define CE9 39360
#define CE10 39424
#define CE11 51712
__device__ __forceinline__ void conv_batch(const Params& p, int t, float* T) {
  const int tid = ltid(), lane = tid & 63, wv = tid >> 6;
  const float* src; bf16_t* dst; int ld, dK, k0, n0;
  int seg, tb, e, which = 0;
  if (t < CE0) { seg = 0; e = 0; tb = t; } else if (t < CE1) { seg = 1; e = 0; tb = t - CE0; } else if (t < CE2) { seg = 2; e = 0; tb = t - CE1; }
  else if (t < CE3) { seg = 3; e = 0; tb = t - CE2; } else if (t < CE4) { seg = 4; e = 0; tb = t - CE3; } else if (t < CE5) { seg = 2; e = 1; tb = t - CE4; }
  else if (t < CE6) { seg = 0; e = 1; tb = t - CE5; } else if (t < CE7) { seg = 1; e = 1; tb = t - CE6; } else if (t < CE8) { seg = 2; e = 2; tb = t - CE7; }
  else if (t < CE9) { seg = 3; e = 1; tb = t - CE8; } else if (t < CE10) { seg = 4; e = 1; tb = t - CE9; } else { seg = 2; e = 3; tb = t - CE10; }
  int dbase = 0;
  if (seg == 0) {
    k0 = (tb / 44) * 64; n0 = (tb % 44) * 64;
    src = p.w_in_even + (size_t)e * 1024 * EVEN_IN; ld = EVEN_IN; dst = p.WinE + (size_t)e * PROJW * 1024; dK = 1024;
  } else if (seg == 1 || seg == 3) {
    k0 = (tb / 16) * 64; n0 = (tb % 16) * 64;
    src = (seg == 3 ? p.w_in_odd : p.w_out_even) + (size_t)e * 1024 * 1024; ld = 1024; dst = (seg == 3 ? p.WinO : p.WoutE) + (size_t)e * 1024 * 1024; dK = 1024;
  } else if (seg == 4) {
    const int g = tb / 16; k0 = ((tb % 16) / 4) * 64; n0 = (tb % 4) * 64;
    src = p.w_pool_grp + (size_t)(e * 4 + g) * 65536; ld = 256; dst = p.Wgrp + (size_t)e * 1024 * 256; dK = 256; dbase = g * 256;
  } else {
    which = tb / 4096; const int r = tb % 4096, le = e * 16 + r / 256; k0 = ((r % 256) / 16) * 64; n0 = (r % 16) * 64;
    const float* base = which == 0 ? p.w_exp_gate : (which == 1 ? p.w_exp_up : p.w_exp_down);
    src = base + (size_t)le * 1024 * 1024; ld = 1024; dK = 1024;
    dst = which < 2 ? p.Wgu + (size_t)le * 2048 * 1024 : p.Wd + (size_t)le * 1024 * 1024;
  }
  const bool gu = (seg == 2 && which < 2);
  float4 v[8];
#pragma unroll
  for (int q = 0; q < 8; ++q) {
    const int idx = tid + q * NTHR, k = idx >> 6, c4 = idx & 63;
    v[q] = *(const float4*)(src + (size_t)(k0 + k) * ld + n0 + c4 * 4);
  }
#pragma unroll
  for (int q = 0; q < 8; ++q) {
    const int idx = tid + q * NTHR, k = idx >> 6, c4 = idx & 63;
    float* tp = T + k * 257 + c4 * 4;
    tp[0] = v[q].x; tp[1] = v[q].y; tp[2] = v[q].z; tp[3] = v[q].w;
  }
  __syncthreads();
#pragma unroll
  for (int sub = 0; sub < 4; ++sub) {
    const int nl = wv * 8 + (lane >> 3), kq = lane & 7, nn = n0 + sub * 64;
    const int drow0 = gu ? (nn >> 7) * 256 + which * 128 + (nn & 127) : dbase + nn;
    float f[8];
#pragma unroll
    for (int j = 0; j < 8; ++j) f[j] = T[(kq * 8 + j) * 257 + sub * 64 + nl];
    u32x4 w; w.x = cvt_pk_bf16(f[0], f[1]); w.y = cvt_pk_bf16(f[2], f[3]); w.z = cvt_pk_bf16(f[4], f[5]); w.w = cvt_pk_bf16(f[6], f[7]);
    *(u32x4*)(dst + (size_t)(drow0 + nl) * dK + k0 + kq * 8) = w;
  }
}
__device__ __forceinline__ int conv_pull(const Params& p, float* sm) {
  __syncthreads();
  if (ltid() == 0) ((int*)sm)[16500] = (int)__hip_atomic_fetch_add(p.barw, 4u, __ATOMIC_RELAXED, __HIP_MEMORY_SCOPE_AGENT);
  __syncthreads();
  return ((int*)sm)[16500];
}
__device__ __forceinline__ void conv_until(const Params& p, int end, float* sm) {
  int t;
  do { t = conv_pull(p, sm); if (t < CE11) conv_batch(p, t, sm); } while (t + 4 < end);
  __syncthreads();
}
__device__ __forceinline__ void conv_quota(const Params& p, int n, float* sm) {
  for (int i = 0; i < n; ++i) { const int t = conv_pull(p, sm); if (t >= CE11) break; conv_batch(p, t, sm); }
  __syncthreads();
}

__device__ __forceinline__ void ph_init(const Params& p, float* sm) {
  const int tid = ltid(), lane = tid & 63, wv = tid >> 6;
  const size_t gtid = (size_t)lbid() * NTHR + tid, gsz = (size_t)lgdim() * NTHR;
  for (int i = tid; i < 9 * 1024; i += NTHR) {
    const int r = i >> 10, k = i & 1023;
    sm[i] = siluf(r < 8 ? p.c[r * 1024 + k] : p.c_ctx[k]);
  }
  __syncthreads();
  float* part = sm + 9 * 1024;
  for (int item = lbid(); item < 768; item += lgdim()) {
    const int l = item / 192, j0 = (item % 192) * 32;
    const int col = lane & 31, kh = lane >> 5;
    const float* w = p.w_mod + (size_t)l * 1024 * 6144 + j0 + col;
    float acc[9];
#pragma unroll
    for (int r = 0; r < 9; ++r) acc[r] = 0.f;
    const int kb = wv * 128 + kh * 64;
#pragma unroll 4
    for (int kk = 0; kk < 64; ++kk) {
      const float wvv = w[(size_t)(kb + kk) * 6144];
#pragma unroll
      for (int r = 0; r < 9; ++r) acc[r] += sm[r * 1024 + kb + kk] * wvv;
    }
#pragma unroll
    for (int r = 0; r < 9; ++r) part[((wv * 2 + kh) * 9 + r) * 32 + col] = acc[r];
    __syncthreads();
    if (tid < 288) {
      const int r = tid >> 5, cc = tid & 31;
      float s = 0.f;
#pragma unroll
      for (int sl = 0; sl < 16; ++sl) s += part[(sl * 9 + r) * 32 + cc];
      p.mod[(size_t)(l * 9 + r) * 6144 + j0 + cc] = s + p.b_mod[l * 6144 + j0 + cc];
    }
    __syncthreads();
  }
  conv_until(p, CE1, sm);
}

typedef float f32x4m __attribute__((ext_vector_type(4)));
__device__ __forceinline__ void ph_norm(const Params& p, int l, int which, int nrows, int ncomb, int lprev, float* sm) {
  const int tid = ltid(), lane = tid & 63, wv = tid >> 6;
  const bool skinny = (which == 2) || (which == 1 && (l & 1) == 0);
  bf16_t* HROW = (bf16_t*)sm;
  float* PART = sm + 8192;
  bf16x8 Bhi[4], Blo[4];
  if (skinny) {
    const float* wbase; int stride;
    if (which == 2) { wbase = p.w_router + (size_t)l * 1024 * 16; stride = 16; }
    else { wbase = p.w_in_even + (size_t)(l >> 1) * 1024 * EVEN_IN + PROJW; stride = EVEN_IN; }
    const int kg = lane >> 4, n = lane & 15;
#pragma unroll
    for (int ks = 0; ks < 4; ++ks) {
      float f[8], hi[8], lo[8];
#pragma unroll
      for (int j = 0; j < 8; ++j) f[j] = wbase[(size_t)(wv * 128 + ks * 32 + kg * 8 + j) * stride + n];
      const u32x4 hw = pack8(f);
      unpack8(hw, hi);
#pragma unroll
      for (int j = 0; j < 8; ++j) lo[j] = f[j] - hi[j];
      Bhi[ks] = __builtin_bit_cast(bf16x8, hw);
      Blo[ks] = __builtin_bit_cast(bf16x8, pack8(lo));
    }
  }
  const int nwaves = lgdim() * (NTHR / 64), gw = lbid() * (NTHR / 64) + wv;
  const int per = (nrows + nwaves - 1) / nwaves;
  const int rbeg = gw * per, rend = min(nrows, rbeg + per);
  const bool in0 = (which == 1 && l == 0);
  float4 vn[4];
  int slvn = -1;
  {
    const int r0 = min(rbeg, nrows - 1);
    const float* xs0 = in0 ? (r0 < NL ? p.x + (size_t)r0 * DM : p.ctx + (size_t)(r0 - NL) * DM) : p.xcur + (size_t)r0 * DM;
#pragma unroll
    for (int i = 0; i < 4; ++i) vn[i] = ((const float4*)xs0)[i * 64 + lane];
    if (r0 < ncomb && lane < 16) slvn = p.slotmap[r0 * 16 + lane];
  }
  float4 cA[4], cB[4], cG[4], yn[4];
  int mr_c = -1;
  if (which == 2) {
    const u32x2* yp0 = (const u32x2*)(p.ybuf + (size_t)min(rbeg, nrows - 1) * DM);
#pragma unroll
    for (int i = 0; i < 4; ++i) { const u32x2 y = yp0[i * 64 + lane]; yn[i] = make_float4(__uint_as_float(y.x << 16), __uint_as_float(y.x & 0xffff0000u), __uint_as_float(y.y << 16), __uint_as_float(y.y & 0xffff0000u)); }
  }
  for (int it = 0; it < per; ++it) {
    const int rr = rbeg + it;
    const bool live = rr < rend;
    const int r = min(rr, nrows - 1);
    float4 v[4];
#pragma unroll
    for (int i = 0; i < 4; ++i) v[i] = vn[i];
    const int slv = slvn;
    float* xr = p.xcur + (size_t)r * DM;
    if (it + 1 < per) {
      const int rn = min(rr + 1, nrows - 1);
      const float* xsn = in0 ? (rn < NL ? p.x + (size_t)rn * DM : p.ctx + (size_t)(rn - NL) * DM) : p.xcur + (size_t)rn * DM;
#pragma unroll
      for (int i = 0; i < 4; ++i) vn[i] = ((const float4*)xsn)[i * 64 + lane];
      slvn = (rn < ncomb && lane < 16) ? p.slotmap[rn * 16 + lane] : -1;
    }
    const int mr = modrow(r);
    if (mr != mr_c) {
      mr_c = mr;
      if (which == 3) {
#pragma unroll
        for (int i = 0; i < 4; ++i) cA[i] = ((const float4*)p.g_final)[i * 64 + lane];
      } else {
        const float* gn = (which == 1 ? p.g_norm1 : p.g_norm2) + l * 1024;
        const float* mrow = p.mod + (size_t)(l * 9 + mr) * 6144;
        const float4* shp = (const float4*)(mrow + (which == 1 ? 0 : 3) * 1024);
        const float4* scp = (const float4*)(mrow + (which == 1 ? 1 : 4) * 1024);
#pragma unroll
        for (int i = 0; i < 4; ++i) {
          const float4 g = ((const float4*)gn)[i * 64 + lane], sc = scp[i * 64 + lane];
          cA[i] = make_float4(g.x * (1.f + sc.x), g.y * (1.f + sc.y), g.z * (1.f + sc.z), g.w * (1.f + sc.w));
          cB[i] = shp[i * 64 + lane];
        }
      }
      if (which == 2) {
        const float4* g2 = (const float4*)(p.mod + (size_t)(l * 9 + mr) * 6144 + 2 * 1024);
        const float4* spv = (const float4*)(p.s_pool + (size_t)(l >> 1) * 1024);
#pragma unroll
        for (int i = 0; i < 4; ++i) {
          float4 g = g2[i * 64 + lane];
          if (l & 1) { const float4 sp4 = spv[i * 64 + lane]; g.x *= sp4.x; g.y *= sp4.y; g.z *= sp4.z; g.w *= sp4.w; }
          cG[i] = g;
        }
      } else if (ncomb > 0) {
        const float4* g5 = (const float4*)(p.mod + (size_t)(lprev * 9 + mr) * 6144 + 5 * 1024);
#pragma unroll
        for (int i = 0; i < 4; ++i) cG[i] = g5[i * 64 + lane];
      }
    }
    if (live && r < ncomb) {
      float4 s4[4];
#pragma unroll
      for (int i = 0; i < 4; ++i) s4[i] = make_float4(0.f, 0.f, 0.f, 0.f);
      unsigned long long mask = __ballot(slv >= 0);
      while (mask) {
        const int e = __ffsll((long long)mask) - 1;
        mask &= mask - 1;
        const int sl = __shfl(slv, e);
        size_t yrow;
        if (r < NL) yrow = (size_t)e * 2048 + (size_t)(r >> 11) * 256 + sl;
        else yrow = (size_t)MOE_L + (size_t)e * 256 + (size_t)((r - NL) >> 8) * 32 + sl;
        const u32x2* yp = (const u32x2*)(p.Ybuf + yrow * DM);
#pragma unroll
        for (int i = 0; i < 4; ++i) {
          const u32x2 y = yp[i * 64 + lane];
          s4[i].x += __uint_as_float(y.x << 16); s4[i].y += __uint_as_float(y.x & 0xffff0000u);
          s4[i].z += __uint_as_float(y.y << 16); s4[i].w += __uint_as_float(y.y & 0xffff0000u);
        }
      }
#pragma unroll
      for (int i = 0; i < 4; ++i) {
        const float4 g = cG[i];
        v[i].x += g.x * s4[i].x; v[i].y += g.y * s4[i].y; v[i].z += g.z * s4[i].z; v[i].w += g.w * s4[i].w;
        if (which != 3) ((float4*)xr)[i * 64 + lane] = v[i];
      }
    }
    if (which == 2) {
      float4 yc[4];
#pragma unroll
      for (int i = 0; i < 4; ++i) yc[i] = yn[i];
      if (it + 1 < per) {
        const u32x2* ypn = (const u32x2*)(p.ybuf + (size_t)min(rr + 1, nrows - 1) * DM);
#pragma unroll
        for (int i = 0; i < 4; ++i) { const u32x2 y = ypn[i * 64 + lane]; yn[i] = make_float4(__uint_as_float(y.x << 16), __uint_as_float(y.x & 0xffff0000u), __uint_as_float(y.y << 16), __uint_as_float(y.y & 0xffff0000u)); }
      }
      const float* xin = (r < NL ? p.x + (size_t)r * DM : p.ctx + (size_t)(r - NL) * DM);
#pragma unroll
      for (int i = 0; i < 4; ++i) {
        if (l == 0) v[i] = ((const float4*)xin)[i * 64 + lane];
        v[i].x += cG[i].x * yc[i].x; v[i].y += cG[i].y * yc[i].y; v[i].z += cG[i].z * yc[i].z; v[i].w += cG[i].w * yc[i].w;
        if (live) ((float4*)xr)[i * 64 + lane] = v[i];
      }
    }
    float ss = 0.f;
#pragma unroll
    for (int i = 0; i < 4; ++i) ss += v[i].x * v[i].x + v[i].y * v[i].y + v[i].z * v[i].z + v[i].w * v[i].w;
    ss = wave_sum(ss);
    const float inv = rsqrtf(ss * (1.f / 1024.f) + EPS);
    if (which == 3) {
      if (live) {
#pragma unroll
        for (int i = 0; i < 4; ++i) {
          const float4 g = cA[i];
          ((float4*)(p.out + (size_t)r * DM))[i * 64 + lane] = make_float4(v[i].x * inv * g.x, v[i].y * inv * g.y, v[i].z * inv * g.z, v[i].w * inv * g.w);
        }
      }
      continue;
    }
#pragma unroll
    for (int i = 0; i < 4; ++i) {
      const float h0 = v[i].x * inv * cA[i].x + cB[i].x, h1 = v[i].y * inv * cA[i].y + cB[i].y;
      const float h2 = v[i].z * inv * cA[i].z + cB[i].z, h3 = v[i].w * inv * cA[i].w + cB[i].w;
      u32x2 w; w.x = cvt_pk_bf16(h0, h1); w.y = cvt_pk_bf16(h2, h3);
      if (live) ((u32x2*)(p.hbuf + (size_t)r * DM))[i * 64 + lane] = w;
      if (skinny) {
        const float l0 = h0 - __uint_as_float(w.x << 16), l1 = h1 - __uint_as_float(w.x & 0xffff0000u);
        const float l2 = h2 - __uint_as_float(w.y << 16), l3 = h3 - __uint_as_float(w.y & 0xffff0000u);
        u32x2 wl; wl.x = cvt_pk_bf16(l0, l1); wl.y = cvt_pk_bf16(l2, l3);
        ((u32x2*)(HROW + (wv * 2 + 0) * 1024))[i * 64 + lane] = w;
        ((u32x2*)(HROW + (wv * 2 + 1) * 1024))[i * 64 + lane] = wl;
      }
    }
    if (!skinny) continue;
    __syncthreads();
    {
      const int arow = lane & 7, kg = lane >> 4;
      f32x4m acc = {0.f, 0.f, 0.f, 0.f};
#pragma unroll
      for (int ks = 0; ks < 4; ++ks) {
        const bf16x8 ahi = *(const bf16x8*)(HROW + (arow * 2 + 0) * 1024 + wv * 128 + ks * 32 + kg * 8);
        const bf16x8 alo = *(const bf16x8*)(HROW + (arow * 2 + 1) * 1024 + wv * 128 + ks * 32 + kg * 8);
        acc = __builtin_amdgcn_mfma_f32_16x16x32_bf16(ahi, Bhi[ks], acc, 0, 0, 0);
        acc = __builtin_amdgcn_mfma_f32_16x16x32_bf16(ahi, Blo[ks], acc, 0, 0, 0);
        acc = __builtin_amdgcn_mfma_f32_16x16x32_bf16(alo, Bhi[ks], acc, 0, 0, 0);
      }
      if (kg < 2) {
#pragma unroll
        for (int q = 0; q < 4; ++q) PART[(wv * 8 + kg * 4 + q) * 16 + (lane & 15)] = acc[q];
      }
    }
    __syncthreads();
    {
      float v1 = 0.f;
      if (lane < 16) {
#pragma unroll
        for (int w2 = 0; w2 < 8; ++w2) v1 += PART[(w2 * 8 + wv) * 16 + lane];
      }
      if (which == 2) {
        float mx = v1;
        mx = fmaxf(mx, __shfl_xor(mx, 1)); mx = fmaxf(mx, __shfl_xor(mx, 2)); mx = fmaxf(mx, __shfl_xor(mx, 4)); mx = fmaxf(mx, __shfl_xor(mx, 8));
        const float ex = expf(v1 - mx);
        float sum = ex;
        sum += __shfl_xor(sum, 1); sum += __shfl_xor(sum, 2); sum += __shfl_xor(sum, 4); sum += __shfl_xor(sum, 8);
        if (live && lane < 16) p.aff[(size_t)r * 16 + lane] = ex / sum;
      } else {
        float gvv = v1 + p.b_gate[(l >> 1) * 16 + (lane & 15)];
        if ((lane >> 2) & 1) gvv = logsigmoidf_(gvv);
        if (live && lane < 16) p.gates[(size_t)r * 16 + lane] = gvv;
      }
    }
  }
  __syncthreads();
}

#define LOG2E 1.4426950408889634f
__device__ __forceinline__ int chain_row(int b, int dir, int p) {
  if (p < 256) { const int t = dir ? 255 - p : p; return NL + b * 256 + t; }
  const int q = p - 256; const int t = dir ? 2047 - q : q; return b * 2048 + t;
}
__device__ __forceinline__ float wave_incl_sum(float v, int lane) {
#pragma unroll
  for (int o = 1; o < 64; o <<= 1) { const float t = __shfl_up(v, o); if (lane >= o) v += t; }
  return v;
}
__device__ __forceinline__ float wave_incl_max(float v, int lane) {
#pragma unroll
  for (int o = 1; o < 64; o <<= 1) { const float t = __shfl_up(v, o); if (lane >= o) v = fmaxf(v, t); }
  return v;
}
__device__ __forceinline__ void ph_post_even(const Params& p, int l, float* sm) {
  const int e = l >> 1;
  const int tid = ltid(), lane = tid & 63;
  __syncthreads();
  for (int idx = tid; idx < 1024; idx += NTHR) {
    const int pos = idx >> 4, i = idx & 15;
    const float ang = (float)pos * exp2f(-(float)i * (13.287712379549449f / 16.f));
    float sn, cs;
    sincosf(ang, &sn, &cs);
    sm[2 * idx] = cs; sm[2 * idx + 1] = sn;
  }
  if (tid < 128) sm[2048 + tid] = tid < 64 ? p.g_qnorm[e * 64 + tid] : p.g_knorm[e * 64 + tid - 64];
  for (int idx = tid; idx < 3072; idx += NTHR) sm[2304 + idx] = p.w_conv[(size_t)e * 3 * 1024 + idx];
  __syncthreads();
  const int bid = lbid(), G = lgdim();
  const bool scanner = false;
  const size_t gtid = (size_t)bid * NTHR + tid, gsz = (size_t)G * NTHR;
  if (!scanner) {
  for (size_t it = gtid; it < (size_t)NT * 10; it += gsz) {
    const int r = (int)(it / 10), hh = (int)(it % 10);
    const bool lat = r < NL;
    const int t = r & 2047;
    const int bb = lat ? (r >> 11) : ((r - NL) >> 8);
    const int key = lat ? 256 + t : ((r - NL) & 255);
    const bf16_t* src; bf16_t* dst; const float* g; float osc;
    if (hh < 8) { src = p.proj + (size_t)r * PROJW + hh * 64; dst = p.Qb + (size_t)r * 512 + hh * 64; g = sm + 2048; osc = 0.125f * LOG2E; }
    else { src = p.proj + (size_t)r * PROJW + 512 + (hh - 8) * 64; dst = p.Kb + ((size_t)(bb * 2 + (hh - 8)) * 2304 + key) * 64; g = sm + 2048 + 64; osc = 1.f;
           const u32x4* vs = (const u32x4*)(p.proj + (size_t)r * PROJW + 640 + (hh - 8) * 64);
           u32x4* vd = (u32x4*)(p.Vb + ((size_t)(bb * 2 + (hh - 8)) * 2304 + key) * 64);
#pragma unroll
           for (int q = 0; q < 8; ++q) vd[q] = vs[q]; }
    float x[64];
#pragma unroll
    for (int q = 0; q < 8; ++q) { float f[8]; unpack8(((const u32x4*)src)[q], f);
#pragma unroll
      for (int j = 0; j < 8; ++j) x[q * 8 + j] = f[j]; }
    float ss = 0.f;
#pragma unroll
    for (int j = 0; j < 64; ++j) ss += x[j] * x[j];
    const float inv = rsqrtf(ss * (1.f / 64.f) + EPS) * osc;
#pragma unroll
    for (int j = 0; j < 64; ++j) x[j] *= inv * g[j];
    if (lat) {
#pragma unroll
      for (int a = 0; a < 2; ++a) {
        const int pos = (a == 0) ? (t >> 6) : (t & 63);
#pragma unroll
        for (int i = 0; i < 16; ++i) {
          const float2 cssn = *(const float2*)(sm + 2 * (pos * 16 + i));
          const float x1 = x[a * 32 + i], x2 = x[a * 32 + 16 + i];
          x[a * 32 + i] = x1 * cssn.x - x2 * cssn.y;
          x[a * 32 + 16 + i] = x2 * cssn.x + x1 * cssn.y;
        }
      }
    }
#pragma unroll
    for (int q = 0; q < 8; ++q) { float f[8];
#pragma unroll
      for (int j = 0; j < 8; ++j) f[j] = x[q * 8 + j];
      ((u32x4*)dst)[q] = pack8(f); }
  }
  const float* wc = sm + 2304;
  for (size_t it0 = gtid; it0 < (size_t)NT * 128; it0 += 4 * gsz) {
    u32x4 rc[4], rm[4], rp[4];
#pragma unroll
    for (int u = 0; u < 4; ++u) {
      const size_t it = it0 + (size_t)u * gsz;
      const size_t itc = it < (size_t)NT * 128 ? it : it0;
      const int r = (int)(itc >> 7), c8 = (int)(itc & 127) * 8;
      int t, n;
      if (r < NL) { t = r & 2047; n = 2048; } else { t = (r - NL) & 255; n = 256; }
      const bf16_t* sp = p.proj + (size_t)r * PROJW + 768 + c8;
      rc[u] = *(const u32x4*)sp;
      rm[u] = t > 0 ? *(const u32x4*)(sp - PROJW) : (u32x4){0u, 0u, 0u, 0u};
      rp[u] = t < n - 1 ? *(const u32x4*)(sp + PROJW) : (u32x4){0u, 0u, 0u, 0u};
    }
#pragma unroll
    for (int u = 0; u < 4; ++u) {
      const size_t it = it0 + (size_t)u * gsz;
      if (it < (size_t)NT * 128) {
        const int r = (int)(it >> 7), c8 = (int)(it & 127) * 8;
        float xc[8], xm[8], xp[8], o[8];
        unpack8(rc[u], xc); unpack8(rm[u], xm); unpack8(rp[u], xp);
        const float ksc = c8 < 512 ? 1.f : 0.08838834764831845f;
#pragma unroll
        for (int j = 0; j < 8; ++j) { const float v = wc[c8 + j] * xm[j] + wc[1024 + c8 + j] * xc[j] + wc[2048 + c8 + j] * xp[j]; o[j] = siluf(v) * ksc; }
        bf16_t* dp = c8 < 512 ? p.qm + (size_t)r * 512 + c8 : p.km + (size_t)r * 512 + c8 - 512;
        *(u32x4*)dp = pack8(o);
      }
    }
  }
  }
  {
    const int gw = (int)(gtid >> 6), nw = (int)(gsz >> 6);
    for (int task = gw; task < 64 * 18; task += nw) {
      const int chain = task / 18, c = task % 18;
      const int b = chain >> 3, hd = (chain >> 1) & 3, dir = chain & 1;
      const int p0 = c * 128 + 2 * lane;
      const int r0 = chain_row(b, dir, p0), r1 = chain_row(b, dir, p0 + 1);
      const float ig0 = p.gates[(size_t)r0 * 16 + dir * 8 + hd], lf0 = p.gates[(size_t)r0 * 16 + dir * 8 + 4 + hd];
      const float ig1 = p.gates[(size_t)r1 * 16 + dir * 8 + hd], lf1 = p.gates[(size_t)r1 * 16 + dir * 8 + 4 + hd];
      const float ssum = lf0 + lf1;
      const float incl = wave_incl_sum(ssum, lane);
      const float bq0 = (incl - ssum) + lf0, bq1 = bq0 + lf1;
      const float bend = __shfl(incl, 63);
      const float g0 = ig0 - bq0, g1 = ig1 - bq1;
      const float inclm = wave_incl_max(fmaxf(g0, g1), lane);
      float exclm = __shfl_up(inclm, 1);
      if (lane == 0) exclm = -3.0e38f;
      const float pm0 = fmaxf(exclm, g0), pm1 = fmaxf(pm0, g1);
      const float gmax = __shfl(inclm, 63);
      const size_t i0 = (size_t)r0 * 8 + dir * 4 + hd, i1 = (size_t)r1 * 8 + dir * 4 + hd;
      p.gsG[i0] = g0 * LOG2E; p.gsR[i0] = pm0 * LOG2E; p.gsB[i0] = bq0 * LOG2E;
      p.gsG[i1] = g1 * LOG2E; p.gsR[i1] = pm1 * LOG2E; p.gsB[i1] = bq1 * LOG2E;
      if (lane == 0) { p.cBE[chain * 18 + c] = bend; p.cGM[chain * 18 + c] = gmax; }
    }
  }
}
__device__ __forceinline__ void chain_state(const Params& p, int chain, int cc, float& m_in, float& m_next, float& be) {
  m_in = -1e30f; m_next = -1e30f; be = 0.f;
  for (int c = 0; c <= cc; ++c) {
    be = p.cMIN[chain * 18 + c];
    const float mn = fmaxf(m_in + be, be + p.cE1[chain * 18 + c]);
    if (c < cc) m_in = mn; else m_next = mn;
  }
}

typedef float f32x16 __attribute__((ext_vector_type(16)));
typedef short s16x4 __attribute__((ext_vector_type(4)));
typedef __attribute__((address_space(3))) const char* lds_cptr;
__device__ __forceinline__ s16x4 vtr(lds_cptr p) { return __builtin_bit_cast(s16x4, __builtin_amdgcn_ds_read_tr16_b64_v4i16((__attribute__((address_space(3))) s16x4*)p)); }
#define MX3(a, b, c) __builtin_fmaxf(__builtin_fmaxf((a), (b)), (c))
__device__ __forceinline__ float rowmax32(const f32x16& p0, const f32x16& p1) {
  float a = MX3(p0[0], p0[1], p1[0]), b = MX3(p0[2], p0[3], p1[1]);
  a = MX3(a, p1[2], p1[3]);
#pragma unroll
  for (int r = 4; r < 16; r += 4) { a = MX3(a, p0[r], p0[r + 1]); b = MX3(b, p0[r + 2], p0[r + 3]); a = MX3(a, p1[r], p1[r + 1]); b = MX3(b, p1[r + 2], p1[r + 3]); }
  const float m = __builtin_fmaxf(a, b);
  auto rr = __builtin_amdgcn_permlane32_swap(__float_as_uint(m), __float_as_uint(m), false, false);
  return __builtin_fmaxf(__uint_as_float(rr[0]), __uint_as_float(rr[1]));
}
__device__ __forceinline__ float half_swap_add(float v) {
  auto rr = __builtin_amdgcn_permlane32_swap(__float_as_uint(v), __float_as_uint(v), false, false);
  return __uint_as_float(rr[0]) + __uint_as_float(rr[1]);
}
#define ATT_SLOT 16384
__device__ __forceinline__ void glds16(const void* g, unsigned lds_base) {
  unsigned sv;
  asm volatile("s_mov_b32 %0, m0\n\ts_mov_b32 m0, %2\n\ts_nop 0\n\tglobal_load_lds_dwordx4 %1, off\n\ts_mov_b32 m0, %0" : "=&s"(sv) : "v"(g), "s"(lds_base) : "memory");
}
__device__ __forceinline__ void attn_unit(const bf16_t* Q0, const bf16_t* Kbase, const bf16_t* Vbase, const int nkeys, bf16_t* O0, LAS unsigned char* lds) {
  const int tid = ltid(), lane = tid & 63, r32 = lane & 31, hi = lane >> 5;
  const int wid = __builtin_amdgcn_readfirstlane(tid >> 6);
  const int NTL = nkeys >> 6;
  __syncthreads();
  const bf16_t* ksrc = Kbase + (size_t)lane * 64 + wid * 8;
  const bf16_t* vsrc = Vbase + (size_t)(16 * (wid & 3) + (lane >> 2)) * 64 + (wid >> 2) * 32 + (lane & 3) * 8;
  const unsigned ldsb = (unsigned)(size_t)lds;
#define ATT_STAGE(t, slot) do { \
    glds16(ksrc + (size_t)(t) * 64 * 64, (unsigned)__builtin_amdgcn_readfirstlane(ldsb + (slot) * ATT_SLOT + wid * 1024)); \
    glds16(vsrc + (size_t)(t) * 64 * 64, (unsigned)__builtin_amdgcn_readfirstlane(ldsb + (slot) * ATT_SLOT + 8192 + wid * 1024)); } while (0)
  ATT_STAGE(0, 0);
  if (NTL > 1) ATT_STAGE(1, 1);
  bf16x8 qr[4];
  {
    const bf16_t* Qw = Q0 + (size_t)(wid * 32 + r32) * 512;
#pragma unroll
    for (int d0 = 0; d0 < 4; ++d0) qr[d0] = *(const bf16x8*)(Qw + d0 * 16 + hi * 8);
  }
  f32x16 o0, o1;
#pragma unroll
  for (int r = 0; r < 16; ++r) { o0[r] = 0.f; o1[r] = 0.f; }
  float m = -1e30f, l = 0.f;
  const int koff = hi * 1024 + r32 * 16;
  const int voff = 8192 + ((lane >> 4) & 1) * 32 + (lane & 3) * 8 + (4 * hi + ((lane & 15) >> 2)) * 64;
  const bool grpB = wid >= 4;
  bf16x8 pw[4];
#define ATT_PV(sl) do { const lds_cptr vp_ = (lds_cptr)(lds + (sl) * ATT_SLOT + voff); \
    _Pragma("unroll") for (int s4 = 0; s4 < 4; ++s4) { \
      const s16x4 a0l = vtr(vp_ + s4 * 1024), a0h = vtr(vp_ + s4 * 1024 + 512); \
      const s16x4 a1l = vtr(vp_ + 4096 + s4 * 1024), a1h = vtr(vp_ + 4096 + s4 * 1024 + 512); \
      const bf16x8 a0 = {a0l[0], a0l[1], a0l[2], a0l[3], a0h[0], a0h[1], a0h[2], a0h[3]}; \
      const bf16x8 a1 = {a1l[0], a1l[1], a1l[2], a1l[3], a1h[0], a1h[1], a1h[2], a1h[3]}; \
      o0 = __builtin_amdgcn_mfma_f32_32x32x16_bf16(a0, pw[s4], o0, 0, 0, 0); \
      o1 = __builtin_amdgcn_mfma_f32_32x32x16_bf16(a1, pw[s4], o1, 0, 0, 0); } } while (0)
  for (int t = 0; t <= NTL; ++t) {
    if (t + 1 < NTL) asm volatile("s_waitcnt vmcnt(2) lgkmcnt(0)\n\ts_barrier" ::: "memory"); else asm volatile("s_waitcnt vmcnt(0) lgkmcnt(0)\n\ts_barrier" ::: "memory");
    __builtin_amdgcn_sched_barrier(0);
    if (t + 2 < NTL) ATT_STAGE(t + 2, (t + 2) & 3);
    if (grpB && t > 0) ATT_PV((t - 1) & 3);
    if (t < NTL) {
      const lds_cptr kp = (lds_cptr)(lds + (t & 3) * ATT_SLOT + koff);
      f32x16 pA, pB;
#pragma unroll
      for (int r = 0; r < 16; ++r) { pA[r] = 0.f; pB[r] = 0.f; }
#pragma unroll
      for (int d0 = 0; d0 < 4; ++d0) {
        const bf16x8 k0 = *(const LAS bf16x8*)(kp + d0 * 2048), k1 = *(const LAS bf16x8*)(kp + d0 * 2048 + 512);
        pA = __builtin_amdgcn_mfma_f32_32x32x16_bf16(k0, qr[d0], pA, 0, 0, 0);
        pB = __builtin_amdgcn_mfma_f32_32x32x16_bf16(k1, qr[d0], pB, 0, 0, 0);
      }
      const float rm = rowmax32(pA, pB);
      const float mn = __builtin_fmaxf(m, rm);
      const float alpha = __builtin_amdgcn_exp2f(m - mn);
      m = mn;
      float ps = 0.f;
#pragma unroll
      for (int r = 0; r < 16; ++r) { pA[r] = __builtin_amdgcn_exp2f(pA[r] - mn); pB[r] = __builtin_amdgcn_exp2f(pB[r] - mn); ps += pA[r] + pB[r]; }
      l = l * alpha + ps;
#pragma unroll
      for (int r = 0; r < 16; ++r) { o0[r] *= alpha; o1[r] *= alpha; }
#pragma unroll
      for (int s4 = 0; s4 < 4; ++s4) {
        u32x4 w;
        if (s4 < 2) { w.x = cvt_pk_bf16(pA[8 * s4 + 0], pA[8 * s4 + 1]); w.y = cvt_pk_bf16(pA[8 * s4 + 2], pA[8 * s4 + 3]); w.z = cvt_pk_bf16(pA[8 * s4 + 4], pA[8 * s4 + 5]); w.w = cvt_pk_bf16(pA[8 * s4 + 6], pA[8 * s4 + 7]); }
        else { const int q = s4 - 2; w.x = cvt_pk_bf16(pB[8 * q + 0], pB[8 * q + 1]); w.y = cvt_pk_bf16(pB[8 * q + 2], pB[8 * q + 3]); w.z = cvt_pk_bf16(pB[8 * q + 4], pB[8 * q + 5]); w.w = cvt_pk_bf16(pB[8 * q + 6], pB[8 * q + 7]); }
        pw[s4] = __builtin_bit_cast(bf16x8, w);
      }
      if (!grpB) ATT_PV(t & 3);
    }
  }
#undef ATT_PV
#undef ATT_STAGE
  const float il = 1.f / half_swap_add(l);
  bf16_t* Ow = O0 + (size_t)(wid * 32 + r32) * 1024;
#pragma unroll
  for (int g4 = 0; g4 < 4; ++g4) {
    u32x2 w0, w1;
    w0.x = cvt_pk_bf16(o0[4 * g4 + 0] * il, o0[4 * g4 + 1] * il); w0.y = cvt_pk_bf16(o0[4 * g4 + 2] * il, o0[4 * g4 + 3] * il);
    w1.x = cvt_pk_bf16(o1[4 * g4 + 0] * il, o1[4 * g4 + 1] * il); w1.y = cvt_pk_bf16(o1[4 * g4 + 2] * il, o1[4 * g4 + 3] * il);
    *(u32x2*)(Ow + 8 * g4 + 4 * hi) = w0;
    *(u32x2*)(Ow + 32 + 8 * g4 + 4 * hi) = w1;
  }
}
__device__ __forceinline__ void attn_unit2(const bf16_t* Q0a, const bf16_t* Q0b, const bf16_t* Kbase, const bf16_t* Vbase, const int nkeys, bf16_t* O0a, bf16_t* O0b, LAS unsigned char* lds) {
  const int tid = ltid(), lane = tid & 63, r32 = lane & 31, hi = lane >> 5;
  const int wid = __builtin_amdgcn_readfirstlane(tid >> 6);
  const int NTL = nkeys >> 6;
  __syncthreads();
  const bf16_t* ksrc = Kbase + (size_t)lane * 64 + wid * 8;
  const bf16_t* vsrc = Vbase + (size_t)(16 * (wid & 3) + (lane >> 2)) * 64 + (wid >> 2) * 32 + (lane & 3) * 8;
  const unsigned ldsb = (unsigned)(size_t)lds;
#define ATT_STAGE(t, slot) do { \
    glds16(ksrc + (size_t)(t) * 64 * 64, (unsigned)__builtin_amdgcn_readfirstlane(ldsb + (slot) * ATT_SLOT + wid * 1024)); \
    glds16(vsrc + (size_t)(t) * 64 * 64, (unsigned)__builtin_amdgcn_readfirstlane(ldsb + (slot) * ATT_SLOT + 8192 + wid * 1024)); } while (0)
  ATT_STAGE(0, 0);
  if (NTL > 1) ATT_STAGE(1, 1);
  bf16x8 qr[2][4];
  {
    const bf16_t* Qa = Q0a + (size_t)(wid * 32 + r32) * 512;
    const bf16_t* Qb2 = Q0b + (size_t)(wid * 32 + r32) * 512;
#pragma unroll
    for (int d0 = 0; d0 < 4; ++d0) { qr[0][d0] = *(const bf16x8*)(Qa + d0 * 16 + hi * 8); qr[1][d0] = *(const bf16x8*)(Qb2 + d0 * 16 + hi * 8); }
  }
  f32x16 o0[2], o1[2];
#pragma unroll
  for (int hh = 0; hh < 2; ++hh)
#pragma unroll
    for (int r = 0; r < 16; ++r) { o0[hh][r] = 0.f; o1[hh][r] = 0.f; }
  float m[2] = {-1e30f, -1e30f}, l[2] = {0.f, 0.f};
  const int koff = hi * 1024 + r32 * 16;
  const int voff = 8192 + ((lane >> 4) & 1) * 32 + (lane & 3) * 8 + (4 * hi + ((lane & 15) >> 2)) * 64;
  int slot = 0;
  for (int t = 0; t < NTL; ++t) {
    if (t + 1 < NTL) asm volatile("s_waitcnt vmcnt(2) lgkmcnt(0)\n\ts_barrier" ::: "memory"); else asm volatile("s_waitcnt vmcnt(0) lgkmcnt(0)\n\ts_barrier" ::: "memory");
    __builtin_amdgcn_sched_barrier(0);
    if (t + 2 < NTL) { const int s2 = (slot >= 1) ? slot - 1 : 2; ATT_STAGE(t + 2, s2); }
    const lds_cptr kp = (lds_cptr)(lds + slot * ATT_SLOT + koff);
    const lds_cptr vp = (lds_cptr)(lds + slot * ATT_SLOT + voff);
    f32x16 pA[2], pB[2];
#pragma unroll
    for (int hh = 0; hh < 2; ++hh)
#pragma unroll
      for (int r = 0; r < 16; ++r) { pA[hh][r] = 0.f; pB[hh][r] = 0.f; }
#pragma unroll
    for (int d0 = 0; d0 < 4; ++d0) {
      const bf16x8 k0 = *(const LAS bf16x8*)(kp + d0 * 2048), k1 = *(const LAS bf16x8*)(kp + d0 * 2048 + 512);
#pragma unroll
      for (int hh = 0; hh < 2; ++hh) {
        pA[hh] = __builtin_amdgcn_mfma_f32_32x32x16_bf16(k0, qr[hh][d0], pA[hh], 0, 0, 0);
        pB[hh] = __builtin_amdgcn_mfma_f32_32x32x16_bf16(k1, qr[hh][d0], pB[hh], 0, 0, 0);
      }
    }
    bf16x8 pw[2][4];
#pragma unroll
    for (int hh = 0; hh < 2; ++hh) {
      const float rm = rowmax32(pA[hh], pB[hh]);
      const float mn = __builtin_fmaxf(m[hh], rm);
      const float alpha = __builtin_amdgcn_exp2f(m[hh] - mn);
      m[hh] = mn;
      float ps = 0.f;
#pragma unroll
      for (int r = 0; r < 16; ++r) { pA[hh][r] = __builtin_amdgcn_exp2f(pA[hh][r] - mn); pB[hh][r] = __builtin_amdgcn_exp2f(pB[hh][r] - mn); ps += pA[hh][r] + pB[hh][r]; }
      l[hh] = l[hh] * alpha + ps;
#pragma unroll
      for (int r = 0; r < 16; ++r) { o0[hh][r] *= alpha; o1[hh][r] *= alpha; }
#pragma unroll
      for (int s4 = 0; s4 < 4; ++s4) {
        u32x4 w;
        if (s4 < 2) { w.x = cvt_pk_bf16(pA[hh][8 * s4 + 0], pA[hh][8 * s4 + 1]); w.y = cvt_pk_bf16(pA[hh][8 * s4 + 2], pA[hh][8 * s4 + 3]); w.z = cvt_pk_bf16(pA[hh][8 * s4 + 4], pA[hh][8 * s4 + 5]); w.w = cvt_pk_bf16(pA[hh][8 * s4 + 6], pA[hh][8 * s4 + 7]); }
        else { const int q = s4 - 2; w.x = cvt_pk_bf16(pB[hh][8 * q + 0], pB[hh][8 * q + 1]); w.y = cvt_pk_bf16(pB[hh][8 * q + 2], pB[hh][8 * q + 3]); w.z = cvt_pk_bf16(pB[hh][8 * q + 4], pB[hh][8 * q + 5]); w.w = cvt_pk_bf16(pB[hh][8 * q + 6], pB[hh][8 * q + 7]); }
        pw[hh][s4] = __builtin_bit_cast(bf16x8, w);
      }
    }
#pragma unroll
    for (int s4 = 0; s4 < 4; ++s4) {
      const s16x4 a0l = vtr(vp + s4 * 1024), a0h = vtr(vp + s4 * 1024 + 512);
      const s16x4 a1l = vtr(vp + 4096 + s4 * 1024), a1h = vtr(vp + 4096 + s4 * 1024 + 512);
      const bf16x8 a0 = {a0l[0], a0l[1], a0l[2], a0l[3], a0h[0], a0h[1], a0h[2], a0h[3]};
      const bf16x8 a1 = {a1l[0], a1l[1], a1l[2], a1l[3], a1h[0], a1h[1], a1h[2], a1h[3]};
#pragma unroll
      for (int hh = 0; hh < 2; ++hh) {
        o0[hh] = __builtin_amdgcn_mfma_f32_32x32x16_bf16(a0, pw[hh][s4], o0[hh], 0, 0, 0);
        o1[hh] = __builtin_amdgcn_mfma_f32_32x32x16_bf16(a1, pw[hh][s4], o1[hh], 0, 0, 0);
      }
    }
    slot = (slot == 2) ? 0 : slot + 1;
  }
#undef ATT_STAGE
#pragma unroll
  for (int hh = 0; hh < 2; ++hh) {
    const float il = 1.f / half_swap_add(l[hh]);
    bf16_t* Ow = (hh ? O0b : O0a) + (size_t)(wid * 32 + r32) * 1024;
#pragma unroll
    for (int g4 = 0; g4 < 4; ++g4) {
      u32x2 w0, w1;
      w0.x = cvt_pk_bf16(o0[hh][4 * g4 + 0] * il, o0[hh][4 * g4 + 1] * il); w0.y = cvt_pk_bf16(o0[hh][4 * g4 + 2] * il, o0[hh][4 * g4 + 3] * il);
      w1.x = cvt_pk_bf16(o1[hh][4 * g4 + 0] * il, o1[hh][4 * g4 + 1] * il); w1.y = cvt_pk_bf16(o1[hh][4 * g4 + 2] * il, o1[hh][4 * g4 + 3] * il);
      *(u32x2*)(Ow + 8 * g4 + 4 * hi) = w0;
      *(u32x2*)(Ow + 32 + 8 * g4 + 4 * hi) = w1;
    }
  }
}
__device__ __forceinline__ void ph_att(const Params& p, bool ctx_q, LAS unsigned char* lds) {
  const int c = lbid(), G = lgdim();
  const int nunits = 256 + (ctx_q ? 32 : 0);
  for (int L = c; L < nunits; L += G) {
    if (L < 256) {
      const int grp = (L & 7) * 2 + ((L >> 3) >> 4), within = (L >> 3) & 15;
      const int b = grp >> 1, kvh = grp & 1, h0 = kvh * 4 + 2 * (within >> 3), qt = within & 7;
      const size_t row0 = (size_t)b * 2048 + qt * 256;
      const size_t kvb = (size_t)(b * 2 + kvh) * 2304 * 64;
      attn_unit2(p.Qb + row0 * 512 + h0 * 64, p.Qb + row0 * 512 + (h0 + 1) * 64, p.Kb + kvb, p.Vb + kvb, 2304, p.mix + row0 * 1024 + h0 * 64, p.mix + row0 * 1024 + (h0 + 1) * 64, lds);
    } else {
      const int u = L - 256, b = u >> 2, kvh = (u >> 1) & 1, h0 = kvh * 4 + 2 * (u & 1);
      const size_t row0 = (size_t)NL + b * 256;
      const size_t kvb = (size_t)(b * 2 + kvh) * 2304 * 64;
      attn_unit2(p.Qb + row0 * 512 + h0 * 64, p.Qb + row0 * 512 + (h0 + 1) * 64, p.Kb + kvb, p.Vb + kvb, 256, p.mix + row0 * 1024 + h0 * 64, p.mix + row0 * 1024 + (h0 + 1) * 64, lds);
    }
  }
  __syncthreads();
}

__device__ __forceinline__ int chunk_row0(int b, int dir, int cc) {
  if (cc < 2) return NL + b * 256 + (dir ? 1 - cc : cc) * 128;
  return b * 2048 + (dir ? 15 - (cc - 2) : cc - 2) * 128;
}
__device__ __forceinline__ int trq_addr(int lane, int quarter, int rowbase) {
  return quarter * 8192 + ((lane >> 4) & 1) * 32 + (lane & 3) * 8 + (rowbase + ((lane & 15) >> 2)) * 64;
}
__device__ __forceinline__ bf16x8 cat44(const s16x4 a, const s16x4 b) { return (bf16x8){a[0], a[1], a[2], a[3], b[0], b[1], b[2], b[3]}; }

__device__ __forceinline__ void ph_mlstm_u(const Params& p, LAS unsigned char* lds) {
  const int tid = ltid(), lane = tid & 63, r32 = lane & 31, hi = lane >> 5;
  const int wid = __builtin_amdgcn_readfirstlane(tid >> 6);
  LAS float* WS = (LAS float*)(lds + 65536);
  LAS float* NP = (LAS float*)(lds + 66048);
  LAS float* E1T = (LAS float*)(lds + 68096);
  __syncthreads();
  if (tid < 64) {
    float be[18], gm[18];
#pragma unroll
    for (int c = 0; c < 18; ++c) { be[c] = p.cBE[tid * 18 + c]; gm[c] = p.cGM[tid * 18 + c]; }
    float m_in = -1e30f;
#pragma unroll
    for (int c = 0; c < 18; ++c) {
      const float m_next = fmaxf(m_in + be[c], be[c] + gm[c]);
      E1T[tid * 18 + c] = (be[c] - m_next) * LOG2E;
      if (lbid() == 0) { p.cMIN[tid * 18 + c] = m_in * LOG2E; p.cDEC[tid * 18 + c] = expf(m_in + be[c] - m_next); }
      m_in = m_next;
    }
  }
  __syncthreads();
  for (int unit = lbid(); unit < 64 * 17; unit += lgdim()) {
    const int chain = unit / 17, cc = unit % 17;
    const int b = chain >> 3, hd = (chain >> 1) & 3, dir = chain & 1;
    const int row0 = chunk_row0(b, dir, cc);
    __syncthreads();
#pragma unroll
    for (int n = 0; n < 4; ++n) {
      const int ii = wid * 4 + n, qd = ii >> 3, rg = ii & 7;
      const bf16_t* src = p.km + (size_t)(row0 + rg * 16 + (lane >> 2)) * 512 + hd * 128 + qd * 32 + (lane & 3) * 8;
      __builtin_amdgcn_global_load_lds((const unsigned*)src, (LAS unsigned*)(lds + qd * 8192 + rg * 1024), 16, 0, 0);
    }
    if (tid < 128) WS[tid] = __builtin_amdgcn_exp2f(p.gsG[(size_t)(row0 + tid) * 8 + dir * 4 + hd] + E1T[chain * 18 + cc]);
    __syncthreads();
#pragma unroll
    for (int n = 0; n < 4; ++n) {
      const int o = (tid + n * NTHR) * 16, qd = o >> 13, row = (o >> 6) & 127, pc = (o >> 4) & 3;
      float f[8];
      unpack8(*(const u32x4*)(p.proj + (size_t)(row0 + row) * PROJW + 1792 + hd * 128 + qd * 32 + pc * 8), f);
      const float w = WS[row];
#pragma unroll
      for (int j = 0; j < 8; ++j) f[j] *= w;
      *(LAS u32x4*)(lds + 32768 + o) = pack8(f);
    }
    asm volatile("s_waitcnt vmcnt(0)" ::: "memory");
    __syncthreads();
    {
      const int d = tid & 127, part = tid >> 7;
      float acc = 0.f;
      for (int s2 = 0; s2 < 32; ++s2) {
        const int srow = part * 32 + s2;
        const bf16_t kv = *(const LAS bf16_t*)(lds + (d >> 5) * 8192 + srow * 64 + (d & 31) * 2);
        acc += WS[srow] * bf2f(kv);
      }
      NP[part * 128 + d] = acc;
    }
    const int eb = wid >> 1, db0 = 2 * (wid & 1);
    f32x16 u0, u1;
#pragma unroll
    for (int r = 0; r < 16; ++r) { u0[r] = 0.f; u1[r] = 0.f; }
#pragma unroll
    for (int ks = 0; ks < 8; ++ks) {
      const int rb = ks * 16 + 8 * hi;
      const bf16x8 a = cat44(vtr((lds_cptr)(lds + 32768 + trq_addr(lane, eb, rb))), vtr((lds_cptr)(lds + 32768 + trq_addr(lane, eb, rb + 4))));
      const bf16x8 b0 = cat44(vtr((lds_cptr)(lds + trq_addr(lane, db0, rb))), vtr((lds_cptr)(lds + trq_addr(lane, db0, rb + 4))));
      const bf16x8 b1 = cat44(vtr((lds_cptr)(lds + trq_addr(lane, db0 + 1, rb))), vtr((lds_cptr)(lds + trq_addr(lane, db0 + 1, rb + 4))));
      u0 = __builtin_amdgcn_mfma_f32_32x32x16_bf16(a, b0, u0, 0, 0, 0);
      u1 = __builtin_amdgcn_mfma_f32_32x32x16_bf16(a, b1, u1, 0, 0, 0);
    }
    float* U = p.Ubuf + ((size_t)chain * 17 + cc) * 16384;
#pragma unroll
    for (int r = 0; r < 16; ++r) {
      const int erow = eb * 32 + (r & 3) + 8 * (r >> 2) + 4 * hi;
      U[(size_t)erow * 128 + db0 * 32 + r32] = u0[r];
      U[(size_t)erow * 128 + (db0 + 1) * 32 + r32] = u1[r];
    }
    __syncthreads();
    if (tid < 128) p.NLb[((size_t)chain * 17 + cc) * 128 + tid] = NP[tid] + NP[128 + tid] + NP[256 + tid] + NP[384 + tid];
  }
  __syncthreads();
}

__device__ __forceinline__ void ph_mlstm_scan(const Params& p, int bskip) {
  const int bsk = lgdim() > bskip ? bskip : 0;
  if (lbid() < bsk) return;
  const size_t gtid = (size_t)(lbid() - bsk) * NTHR + ltid(), gsz = (size_t)(lgdim() - bsk) * NTHR;
  for (size_t it = gtid; it < (size_t)64 * 8192; it += gsz) {
    const int chain = (int)(it >> 13), ed = (int)(it & 8191) * 2;
    float c0 = 0.f, c1 = 0.f;
    for (int c = 0; c < 17; ++c) {
      const float dec = p.cDEC[chain * 18 + c];
      const float2 u = *(const float2*)(p.Ubuf + ((size_t)chain * 17 + c) * 16384 + ed);
      c0 = dec * c0 + u.x; c1 = dec * c1 + u.y;
      *(unsigned*)(p.Cbf + ((size_t)chain * 18 + c + 1) * 16384 + ed) = cvt_pk_bf16(c0, c1);
    }
  }
  for (size_t it = gtid; it < (size_t)64 * 128; it += gsz) {
    const int chain = (int)(it >> 7), d = (int)(it & 127);
    float nv = 0.f;
    for (int c = 0; c < 17; ++c) {
      nv = p.cDEC[chain * 18 + c] * nv + p.NLb[((size_t)chain * 17 + c) * 128 + d];
      p.NVb[((size_t)chain * 18 + c + 1) * 128 + d] = nv;
    }
  }
}

__device__ __forceinline__ void ph_mlstm_h(const Params& p, int l, bool ctx_out, LAS unsigned char* lds) {
  const int e2 = l >> 1;
  const int tid = ltid(), lane = tid & 63, r32 = lane & 31, hi = lane >> 5;
  const int wid = __builtin_amdgcn_readfirstlane(tid >> 6);
  const int tb = wid & 3, dir = wid >> 2;
  LAS float* HX = (LAS float*)(lds);
  LAS float* GC = (LAS float*)(lds + 131072);
  const int j0 = ctx_out ? 0 : 2, nj = 18 - j0;
  for (int unit = lbid(); unit < 32 * nj; unit += lgdim()) {
    const int bh = unit / nj, j = j0 + unit % nj, b = bh >> 2, hd = bh & 3;
    const int row0 = (j < 2) ? NL + b * 256 + j * 128 : b * 2048 + (j - 2) * 128;
    const int cc = dir ? (j < 2 ? 1 - j : 19 - j) : j;
    const int chain = b * 8 + hd * 2 + dir;
    __syncthreads();
#pragma unroll
    for (int n = 0; n < 4; ++n) {
      const int ii = wid * 4 + n;
      { const int ch = ii >> 1, rh = ii & 1;
        const bf16_t* src = p.km + (size_t)(row0 + rh * 64 + lane) * 512 + hd * 128 + ch * 8;
        __builtin_amdgcn_global_load_lds((const unsigned*)src, (LAS unsigned*)(lds + ch * 2048 + rh * 1024), 16, 0, 0); }
      { const int qd = ii >> 3, rg = ii & 7;
        const bf16_t* src = p.proj + (size_t)(row0 + rg * 16 + (lane >> 2)) * PROJW + 1792 + hd * 128 + qd * 32 + (lane & 3) * 8;
        __builtin_amdgcn_global_load_lds((const unsigned*)src, (LAS unsigned*)(lds + 32768 + qd * 8192 + rg * 1024), 16, 0, 0); }
    }
#pragma unroll
    for (int n = 0; n < 8; ++n) {
      const int ii2 = wid * 8 + n, dd = ii2 >> 5, ch = (ii2 & 31) >> 1, rh = ii2 & 1;
      const int ccd = dd ? (j < 2 ? 1 - j : 19 - j) : j;
      if (ccd > 0) {
        const bf16_t* src = p.Cbf + ((size_t)(b * 8 + hd * 2 + dd) * 18 + ccd) * 16384 + (size_t)(rh * 64 + lane) * 128 + ch * 8;
        __builtin_amdgcn_global_load_lds((const unsigned*)src, (LAS unsigned*)(lds + 65536 + dd * 32768 + ch * 2048 + rh * 1024), 16, 0, 0);
      }
    }
    if (tid < 256) GC[tid] = p.gsG[(size_t)(row0 + (tid & 127)) * 8 + (tid >> 7) * 4 + hd];
    const int trow = row0 + tb * 32 + r32;
    bf16x8 qf[8];
#pragma unroll
    for (int ks = 0; ks < 8; ++ks) qf[ks] = *(const bf16x8*)(p.qm + (size_t)trow * 512 + hd * 128 + ks * 16 + hi * 8);
    const float MIN2 = p.cMIN[chain * 18 + cc];
    const float R2 = -fmaxf(MIN2, p.gsR[(size_t)trow * 8 + dir * 4 + hd]), BQ2 = p.gsB[(size_t)trow * 8 + dir * 4 + hd];
    f32x16 acc[4];
#pragma unroll
    for (int eb = 0; eb < 4; ++eb)
#pragma unroll
      for (int r = 0; r < 16; ++r) acc[eb][r] = 0.f;
    float nq = 0.f;
    if (cc > 0) {
      const float* nvp = p.NVb + ((size_t)chain * 18 + cc) * 128 + hi * 8;
#pragma unroll
      for (int ks = 0; ks < 8; ++ks) {
        const f32x4 n0 = *(const f32x4*)(nvp + ks * 16), n1 = *(const f32x4*)(nvp + ks * 16 + 4);
        float qv[8];
        unpack8(__builtin_bit_cast(u32x4, qf[ks]), qv);
        nq += n0[0] * qv[0] + n0[1] * qv[1] + n0[2] * qv[2] + n0[3] * qv[3] + n1[0] * qv[4] + n1[1] * qv[5] + n1[2] * qv[6] + n1[3] * qv[7];
      }
      nq = half_swap_add(nq);
    }
    const float winter = __builtin_amdgcn_exp2f(MIN2 + R2);
    asm volatile("s_waitcnt vmcnt(0)" ::: "memory");
    __syncthreads();
    if (cc > 0) {
#pragma unroll
      for (int eb = 0; eb < 4; ++eb)
#pragma unroll
        for (int ks = 0; ks < 8; ++ks) {
          const bf16x8 a = *(const LAS bf16x8*)(lds + 65536 + dir * 32768 + (2 * ks + hi) * 2048 + (eb * 32 + r32) * 16);
          acc[eb] = __builtin_amdgcn_mfma_f32_32x32x16_bf16(a, qf[ks], acc[eb], 0, 0, 0);
        }
#pragma unroll
      for (int eb = 0; eb < 4; ++eb)
#pragma unroll
        for (int r = 0; r < 16; ++r) acc[eb][r] *= winter;
    }
    float sw = 0.f;
    const int sb_lo = dir ? tb : 0, sb_hi = dir ? 3 : tb;
    for (int sb = sb_lo; sb <= sb_hi; ++sb) {
      f32x16 st;
#pragma unroll
      for (int r = 0; r < 16; ++r) st[r] = 0.f;
#pragma unroll
      for (int ks = 0; ks < 8; ++ks) {
        const bf16x8 kf = *(const LAS bf16x8*)(lds + (2 * ks + hi) * 2048 + (sb * 32 + r32) * 16);
        st = __builtin_amdgcn_mfma_f32_32x32x16_bf16(kf, qf[ks], st, 0, 0, 0);
      }
      const bool diag = (sb == tb);
#pragma unroll
      for (int g4 = 0; g4 < 4; ++g4) {
        const f32x4 gc = *(const LAS f32x4*)(GC + dir * 128 + sb * 32 + 8 * g4 + 4 * hi);
#pragma unroll
        for (int q = 0; q < 4; ++q) {
          const int sl = 8 * g4 + 4 * hi + q;
          float w = __builtin_amdgcn_exp2f(R2 + gc[q]) * st[4 * g4 + q];
          const bool keep = !diag || (dir ? (sl >= r32) : (sl <= r32));
          w = keep ? w : 0.f;
          sw += w;
          st[4 * g4 + q] = w;
        }
      }
      u32x4 p0, p1;
      p0.x = cvt_pk_bf16(st[0], st[1]); p0.y = cvt_pk_bf16(st[2], st[3]); p0.z = cvt_pk_bf16(st[4], st[5]); p0.w = cvt_pk_bf16(st[6], st[7]);
      p1.x = cvt_pk_bf16(st[8], st[9]); p1.y = cvt_pk_bf16(st[10], st[11]); p1.z = cvt_pk_bf16(st[12], st[13]); p1.w = cvt_pk_bf16(st[14], st[15]);
      const bf16x8 pw0 = __builtin_bit_cast(bf16x8, p0), pw1 = __builtin_bit_cast(bf16x8, p1);
#pragma unroll
      for (int eb = 0; eb < 4; ++eb) {
        const int rb = sb * 32 + 4 * hi;
        const bf16x8 a0 = cat44(vtr((lds_cptr)(lds + 32768 + trq_addr(lane, eb, rb))), vtr((lds_cptr)(lds + 32768 + trq_addr(lane, eb, rb + 8))));
        const bf16x8 a1 = cat44(vtr((lds_cptr)(lds + 32768 + trq_addr(lane, eb, rb + 16))), vtr((lds_cptr)(lds + 32768 + trq_addr(lane, eb, rb + 24))));
        acc[eb] = __builtin_amdgcn_mfma_f32_32x32x16_bf16(a0, pw0, acc[eb], 0, 0, 0);
        acc[eb] = __builtin_amdgcn_mfma_f32_32x32x16_bf16(a1, pw1, acc[eb], 0, 0, 0);
      }
    }
    sw = half_swap_add(sw);
    const float den = winter * nq + sw;
    const float dn = fmaxf(fabsf(den), __builtin_amdgcn_exp2f(R2 - BQ2));
    const float idn = 1.f / dn;
    __syncthreads();
    if (dir == 1) {
#pragma unroll
      for (int eb = 0; eb < 4; ++eb)
#pragma unroll
        for (int r = 0; r < 16; ++r) HX[(tb * 128 + eb * 32 + (r & 3) + 8 * (r >> 2) + 4 * hi) * 32 + r32] = acc[eb][r] * idn;
    }
    __syncthreads();
    if (dir == 0) {
      float ss = 0.f;
#pragma unroll
      for (int eb = 0; eb < 4; ++eb)
#pragma unroll
        for (int r = 0; r < 16; ++r) {
          const float v = acc[eb][r] * idn + HX[(tb * 128 + eb * 32 + (r & 3) + 8 * (r >> 2) + 4 * hi) * 32 + r32];
          acc[eb][r] = v; ss += v * v;
        }
      ss = half_swap_add(ss);
      const float inv = rsqrtf(ss * (1.f / 128.f) + EPS);
      const float* gh = p.g_hnorm + e2 * 512 + hd * 128;
      const bf16_t* obp = p.proj + (size_t)trow * PROJW + 2304 + hd * 128;
      bf16_t* op = p.mix + (size_t)trow * 1024 + 512 + hd * 128;
#pragma unroll
      for (int eb = 0; eb < 4; ++eb)
#pragma unroll
        for (int g4 = 0; g4 < 4; ++g4) {
          const int e0 = eb * 32 + 8 * g4 + 4 * hi;
          const f32x4 gv = *(const f32x4*)(gh + e0);
          const u32x2 ow = *(const u32x2*)(obp + e0);
          const float ob0 = __uint_as_float(ow.x << 16), ob1 = __uint_as_float(ow.x & 0xffff0000u), ob2 = __uint_as_float(ow.y << 16), ob3 = __uint_as_float(ow.y & 0xffff0000u);
          const float v0 = acc[eb][4 * g4 + 0] * inv * gv[0] * sigmoidf_(ob0), v1 = acc[eb][4 * g4 + 1] * inv * gv[1] * sigmoidf_(ob1);
          const float v2 = acc[eb][4 * g4 + 2] * inv * gv[2] * sigmoidf_(ob2), v3 = acc[eb][4 * g4 + 3] * inv * gv[3] * sigmoidf_(ob3);
          u32x2 w; w.x = cvt_pk_bf16(v0, v1); w.y = cvt_pk_bf16(v2, v3);
          *(u32x2*)(op + e0) = w;
        }
    }
  }
  __syncthreads();
}

template <int EPL>
__device__ __forceinline__ void topk_column(const Params& p, const float* col, int e, int base, int cap, size_t mbase, int lane) {
  unsigned v[EPL];
#pragma unroll
  for (int k = 0; k < EPL; ++k) v[k] = __float_as_uint(col[k * 64 + lane]);
  unsigned thr = 0u;
  for (int bit = 30; bit >= 0; --bit) {
    const unsigned cand = thr | (1u << bit);
    unsigned c = 0;
#pragma unroll
    for (int k = 0; k < EPL; ++k) c += (v[k] >= cand) ? 1u : 0u;
#pragma unroll
    for (int o = 32; o > 0; o >>= 1) c += __shfl_xor(c, o);
    if (c >= (unsigned)cap) thr = cand;
  }
  unsigned totgt = 0;
#pragma unroll
  for (int k = 0; k < EPL; ++k) totgt += (unsigned)__popcll(__ballot(v[k] > thr));
  const unsigned need_eq = (unsigned)cap - totgt;
  unsigned cg = 0, ce = 0;
#pragma unroll
  for (int k = 0; k < EPL; ++k) {
    const bool gt = v[k] > thr, eq = v[k] == thr;
    const unsigned long long bg = __ballot(gt), be = __ballot(eq);
    const unsigned gtb = cg + __builtin_amdgcn_mbcnt_hi((unsigned)(bg >> 32), __builtin_amdgcn_mbcnt_lo((unsigned)bg, 0u));
    const unsigned eqb = ce + __builtin_amdgcn_mbcnt_hi((unsigned)(be >> 32), __builtin_amdgcn_mbcnt_lo((unsigned)be, 0u));
    const bool take = gt || (eq && eqb < need_eq);
    const int r = base + k * 64 + lane;
    const unsigned slot = gtb + (eqb < need_eq ? eqb : need_eq);
    if (take) { p.slotmap[(size_t)r * 16 + e] = (int)slot; p.rowidx[mbase + slot] = r; p.gatev[mbase + slot] = __uint_as_float(v[k]); }
    else p.slotmap[(size_t)r * 16 + e] = -1;
    cg += (unsigned)__popcll(bg); ce += (unsigned)__popcll(be);
  }
}
__device__ __forceinline__ void ph_topk(const Params& p, bool ctx, float* sm) {
  const int tid = ltid(), lane = tid & 63, wv = tid >> 6;
  const int ntask = ctx ? 32 : 16;
  for (int task = lbid(); task < ntask; task += lgdim()) {
    const bool lat = task < 16;
    const int b = (task >> 1) & 7, eh = task & 1, n = lat ? 2048 : 256, cap = lat ? 256 : 32, base = lat ? b * 2048 : NL + b * 256;
    __syncthreads();
    for (int idx = tid; idx < n * 2; idx += NTHR) {
      const int row = idx >> 1, q = idx & 1;
      const float4 a = *(const float4*)(p.aff + (size_t)(base + row) * 16 + eh * 8 + q * 4);
      sm[(q * 4 + 0) * n + row] = a.x; sm[(q * 4 + 1) * n + row] = a.y; sm[(q * 4 + 2) * n + row] = a.z; sm[(q * 4 + 3) * n + row] = a.w;
    }
    __syncthreads();
    {
      const int e = eh * 8 + wv;
      if (lat) topk_column<32>(p, sm + wv * n, e, base, cap, (size_t)e * 2048 + (size_t)b * 256, lane);
      else topk_column<4>(p, sm + wv * n, e, base, cap, (size_t)MOE_L + (size_t)e * 256 + (size_t)b * 32, lane);
    }
  }
  __syncthreads();
}

template <int W>
__device__ __forceinline__ void pool_item(const Params& p, int r, int c8) {
  int t, n;
  if (r < NL) { t = r & 2047; n = 2048; } else { t = (r - NL) & 255; n = 256; }
  constexpr int lo = W / 2;
  const bf16_t* up = p.proj + (size_t)r * 1024 + c8;
  u32x4 raw[W];
  int cnt = 0;
#pragma unroll
  for (int k = 0; k < W; ++k) {
    const int tt = t - lo + k;
    const bool ok = tt >= 0 && tt < n;
    raw[k] = ok ? *(const u32x4*)(up + (ptrdiff_t)(k - lo) * 1024) : (u32x4){0u, 0u, 0u, 0u};
    cnt += ok ? 1 : 0;
  }
  float s8[8], f[8], uc[8];
#pragma unroll
  for (int j = 0; j < 8; ++j) s8[j] = 0.f;
#pragma unroll
  for (int k = 0; k < W; ++k) {
    unpack8(raw[k], f);
#pragma unroll
    for (int j = 0; j < 8; ++j) s8[j] += f[j];
  }
  unpack8(raw[lo], uc);
  const float ic = 1.f / (float)cnt;
#pragma unroll
  for (int j = 0; j < 8; ++j) f[j] = s8[j] * ic - uc[j];
  *(u32x4*)(p.mix + (size_t)r * 1024 + c8) = pack8(f);
}
__device__ __forceinline__ void ph_pool(const Params& p, int nrows) {
  const size_t gtid = (size_t)lbid() * NTHR + ltid(), gsz = (size_t)lgdim() * NTHR;
  for (size_t it = gtid; it < (size_t)nrows * 128; it += gsz) {
    const int g = (int)(it / ((size_t)nrows * 32));
    const size_t rem = it - (size_t)g * nrows * 32;
    const int r = (int)(rem >> 5), c8 = g * 256 + (int)(rem & 31) * 8;
    if (g == 0) pool_item<2>(p, r, c8);
    else if (g == 1) pool_item<4>(p, r, c8);
    else if (g == 2) pool_item<8>(p, r, c8);
    else pool_item<16>(p, r, c8);
  }
}

enum { PH_INIT = 0, PH_NORM1, PH_GEMM_IN_EVEN, PH_POST_EVEN, PH_ATT, PH_MLSTM_U, PH_MLSTM_SCAN, PH_MLSTM_H, PH_GEMM_OUT, PH_NORM2, PH_TOPK, PH_GATHER,
       PH_MOE_GU, PH_MOE_D, PH_GEMM_IN_ODD, PH_POOL, PH_GEMM_GRP, PH_FINAL };

typedef const __attribute__((address_space(4))) Params* KParams;
__device__ __forceinline__ const Params& get_params() {
  KParams kp = (KParams)__builtin_amdgcn_kernarg_segment_ptr();
  asm volatile("" : "+s"(kp));
  return *(const Params*)kp;
}
__device__ __forceinline__ int idle_slots(int nu, int G, int c) {
  const int mx = (nu + G - 1) / G, mine = c < nu ? (nu - c + G - 1) / G : 0;
  return mx - mine;
}
__device__ __forceinline__ void run_phase(int ph, int l, unsigned char* shm) {
  const Params& p = get_params();
  float* sm = (float*)shm;
  LAS unsigned char* lds = (LAS unsigned char*)shm;
  const bool ctx_next = (l < 2);
  const bool ctx_used = (l < 3);
  const int G = lgdim(), c = lbid();
  switch (ph) {
    case PH_INIT: ph_init(p, sm); break;
    case PH_NORM1: {
      const int ncomb = (l == 0) ? 0 : ((l - 1) < 2 ? NT : NL);
      ph_norm(p, l, 1, ctx_used ? NT : NL, ncomb, l - 1, sm);
    } break;
    case PH_GEMM_IN_EVEN: {
      g8::SchedDense S{(const char*)p.hbuf, (const char*)(p.WinE + (size_t)(l >> 1) * PROJW * 1024), 1024, 1024, NT / 256, PROJW / 256, 0, G, c};
      g8::EpiBf16 E{p.proj, PROJW};
      g8::gemm_phase(lds, 1024, 1024, 1024, S, E);
      conv_quota(p, idle_slots(S.nM * S.nN, G, c) * 3, sm);
    } break;
    case PH_POST_EVEN: ph_post_even(p, l, sm); break;
    case PH_MLSTM_U: ph_mlstm_u(p, lds); break;
    case PH_ATT: ph_att(p, ctx_next, lds); ph_mlstm_scan(p, ctx_next ? 32 : 0); conv_quota(p, idle_slots(256 + (ctx_next ? 32 : 0), G, c) * 1, sm); break;
    case PH_MLSTM_H: ph_mlstm_h(p, l, ctx_next, lds); conv_quota(p, idle_slots(32 * (ctx_next ? 18 : 16), G, c) * 3, sm); break;
    case PH_GEMM_OUT: {
      g8::SchedDense S{(const char*)p.mix, (const char*)(p.WoutE + (size_t)(l >> 1) * 1024 * 1024), 1024, 1024, (ctx_next ? NT : NL) / 256, 4, 0, G, c};
      g8::EpiBf16 E{p.ybuf, 1024};
      g8::gemm_phase(lds, 1024, 1024, 1024, S, E);
      conv_quota(p, idle_slots(S.nM * S.nN, G, c) * 3, sm);
    } break;
    case PH_NORM2: ph_norm(p, l, 2, ctx_next ? NT : NL, 0, 0, sm); break;
    case PH_TOPK: ph_topk(p, ctx_next, sm); conv_until(p, l == 0 ? CE4 : (l == 1 ? CE7 : (l == 2 ? CE10 : CE11)), sm); break;
    case PH_MOE_GU: {
      g8::SchedMoe S{(const char*)p.Xs, (const char*)(p.Wgu + (size_t)l * NEXP * 2048 * 1024), 8, 2048, 128, ctx_next ? 1152 : 1024, G, c};
      g8::EpiSwiGLU E{p.Abuf};
      g8::gemm_phase<true>(lds, 1024, 1024, 1024, S, E, p.rowidx, (const char*)p.hbuf);
      conv_quota(p, idle_slots(S.nu, G, c) * 3, sm);
    } break;
    case PH_MOE_D: {
      g8::SchedMoe S{(const char*)p.Abuf, (const char*)(p.Wd + (size_t)l * NEXP * 1024 * 1024), 4, 1024, 256, ctx_next ? 576 : 512, G, c};
      g8::EpiDown E{p.Ybuf, p.gatev};
      g8::gemm_phase(lds, 1024, 1024, 1024, S, E);
      conv_quota(p, idle_slots(S.nu, G, c) * 3, sm);
    } break;
    case PH_GEMM_IN_ODD: {
      g8::SchedDense S{(const char*)p.hbuf, (const char*)(p.WinO + (size_t)(l >> 1) * 1024 * 1024), 1024, 1024, (ctx_next ? NT : NL) / 256, 4, 0, G, c};
      g8::EpiBf16 E{p.proj, 1024};
      g8::gemm_phase(lds, 1024, 1024, 1024, S, E);
      conv_quota(p, idle_slots(S.nM * S.nN, G, c) * 3, sm);
    } break;
    case PH_POOL: ph_pool(p, ctx_next ? NT : NL); break;
    case PH_GEMM_GRP: {
      g8::SchedDense S{(const char*)p.mix, (const char*)(p.Wgrp + (size_t)(l >> 1) * 1024 * 256), 1024, 256, (ctx_next ? NT : NL) / 256, 4, 512, G, c};
      g8::EpiBf16 E{p.ybuf, 1024};
      g8::gemm_phase(lds, 256, 1024, 256, S, E);
      conv_quota(p, idle_slots(S.nM * S.nN, G, c) * 1, sm);
    } break;
    case PH_FINAL: ph_norm(p, 3, 3, NL, NL, 3, sm); break;
  }
}

__global__ void __launch_bounds__(NTHR) mega_kernel(Params p) {
  extern __shared__ __attribute__((aligned(16))) unsigned char shm[];
  cg::grid_group grid = cg::this_grid();
  volatile LAS unsigned* st = (volatile LAS unsigned*)((LAS unsigned char*)shm + g8::STAGE_BYTES + 1536);
  if (threadIdx.x < 2) st[threadIdx.x] = 0u;
  __syncthreads();
  unsigned* barw;
  { const Params& q = get_params(); barw = q.barw; }
  const XcdBarrier xb = xcd_barrier_post(barw, st);
  const int nprog = p.nprog;
  for (int i = 0; i < nprog; ++i) {
    int ph, l;
    { const Params& q = get_params(); ph = q.prog_ph[i]; l = q.prog_l[i]; }
    run_phase(ph, l, shm);
    if (i + 1 < nprog) { if (nprog > 1000) grid.sync(); else xcd_barrier(xb); }
  }
}

extern "C" void kernel_launch(void* const* d_in, const int* in_sizes, int n_in, void* d_out, int out_size, void* d_ws, size_t ws_size,
                              hipStream_t stream) {
  Params p{};
  const float* const* in = (const float* const*)d_in;
  p.x = in[0]; p.c = in[1]; p.ctx = in[2]; p.c_ctx = in[3]; p.w_mod = in[4]; p.b_mod = in[5]; p.g_norm1 = in[6]; p.g_norm2 = in[7];
  p.w_in_even = in[8]; p.w_out_even = in[9]; p.g_qnorm = in[10]; p.g_knorm = in[11]; p.w_conv = in[12]; p.b_gate = in[13];
  p.g_hnorm = in[14]; p.w_in_odd = in[15]; p.w_pool_grp = in[16]; p.s_pool = in[17]; p.w_router = in[18]; p.w_exp_gate = in[19];
  p.w_exp_up = in[20]; p.w_exp_down = in[21]; p.g_final = in[22];
  p.out = (float*)d_out;
  char* w = (char*)d_ws;
  size_t off = 0;
  auto take = [&](size_t bytes) { char* r = w + off; off += (bytes + 255) & ~(size_t)255; return (void*)r; };
  p.xcur = (float*)take((size_t)NT * 1024 * 4);
  p.mod = (float*)take(4 * 9 * 6144 * 4);
  p.hbuf = (bf16_t*)take((size_t)NT * 1024 * 2);
  p.Ybuf = (bf16_t*)take((size_t)MOE_T * 1024 * 2);
  p.gatev = (float*)take(MOE_T * 4);
  p.rowidx = (int*)take(MOE_T * 4);
  p.slotmap = (int*)take((size_t)NT * 16 * 4);
  p.barw = (unsigned*)take(XCD_BAR_WORDS * 4);
  p.aff = (float*)take((size_t)NT * 16 * 4);
  p.gates = (float*)take((size_t)NT * 16 * 4);
  p.WinE = (bf16_t*)take((size_t)2 * PROJW * 1024 * 2);
  p.WoutE = (bf16_t*)take((size_t)2 * 1024 * 1024 * 2);
  p.WinO = (bf16_t*)take((size_t)2 * 1024 * 1024 * 2);
  p.Wgrp = (bf16_t*)take((size_t)2 * 1024 * 256 * 2);
  p.Wgu = (bf16_t*)take((size_t)4 * NEXP * 2048 * 1024 * 2);
  p.Wd = (bf16_t*)take((size_t)4 * NEXP * 1024 * 1024 * 2);
  const size_t uoff = off;
  p.proj = (bf16_t*)take((size_t)NT * PROJW * 2);
  p.Qb = (bf16_t*)take((size_t)NT * 512 * 2);
  p.Kb = (bf16_t*)take((size_t)NB * 2 * 2304 * 64 * 2);
  p.Vb = (bf16_t*)take((size_t)NB * 2 * 2304 * 64 * 2);
  p.qm = (bf16_t*)take((size_t)NT * 512 * 2);
  p.km = (bf16_t*)take((size_t)NT * 512 * 2);
  p.gsG = (float*)take((size_t)NT * 8 * 4);
  p.gsR = (float*)take((size_t)NT * 8 * 4);
  p.gsB = (float*)take((size_t)NT * 8 * 4);
  p.cMIN = (float*)take(64 * 18 * 4);
  p.cE1 = (float*)take(64 * 18 * 4);
  p.cDEC = (float*)take(64 * 18 * 4);
  p.cBE = (float*)take(64 * 18 * 4);
  p.cGM = (float*)take(64 * 18 * 4);
  p.Ubuf = (float*)take((size_t)64 * 17 * 16384 * 4);
  p.NLb = (float*)take((size_t)64 * 17 * 128 * 4);
  p.NVb = (float*)take((size_t)64 * 18 * 128 * 4);
  p.Cbf = (bf16_t*)take((size_t)64 * 18 * 16384 * 2);
  p.mix = (bf16_t*)take((size_t)NT * 1024 * 2);
  p.ybuf = (bf16_t*)take((size_t)NT * 1024 * 2);
  const size_t uend = off;
  off = uoff;
  p.Xs = (bf16_t*)take((size_t)MOE_T * 1024 * 2);
  p.Abuf = (bf16_t*)take((size_t)MOE_T * 1024 * 2);
  if (off < uend) off = uend;
  if (off > ws_size) { fprintf(stderr, "ws too small: need %zu have %zu\n", off, ws_size); return; }

  int n = 0;
  auto add = [&](int ph, int l) { p.prog_ph[n] = (unsigned char)ph; p.prog_l[n] = (unsigned char)l; ++n; };
  add(PH_INIT, 0);
  for (int l = 0; l < 4; ++l) {
    add(PH_NORM1, l);
    if ((l & 1) == 0) {
      add(PH_GEMM_IN_EVEN, l); add(PH_POST_EVEN, l); add(PH_MLSTM_U, l); add(PH_ATT, l); add(PH_MLSTM_H, l); add(PH_GEMM_OUT, l);
    } else {
      add(PH_GEMM_IN_ODD, l); add(PH_POOL, l); add(PH_GEMM_GRP, l);
    }
    add(PH_NORM2, l); add(PH_TOPK, l); add(PH_MOE_GU, l); add(PH_MOE_D, l);
  }
  add(PH_FINAL, 0);
  p.nprog = n;

  const int LDS = g8::STAGE_BYTES + 2048;
  static int grid_blocks = 0;
  if (!grid_blocks) {
    (void)hipFuncSetAttribute((const void*)mega_kernel, hipFuncAttributeMaxDynamicSharedMemorySize, LDS);
    int dev = 0, cus = 0, per_cu = 0;
    (void)hipGetDevice(&dev);
    (void)hipDeviceGetAttribute(&cus, hipDeviceAttributeMultiprocessorCount, dev);
    (void)hipOccupancyMaxActiveBlocksPerMultiprocessor(&per_cu, mega_kernel, NTHR, LDS);
    if (per_cu < 1) per_cu = 1;
    if (per_cu > 1) per_cu = 1;
    grid_blocks = cus * per_cu;
  }
  (void)hipMemsetAsync(p.barw, 0, XCD_BAR_WORDS * 4, stream);
  void* args[] = {&p};
  hipError_t e = hipLaunchCooperativeKernel((void*)mega_kernel, dim3(grid_blocks), dim3(NTHR), args, LDS, stream);
  if (e != hipSuccess) fprintf(stderr, "cooperative launch failed: %s (grid %d)\n", hipGetErrorString(e), grid_blocks);
}
```

```cpp
#include <hip/hip_runtime.h>
#include <hip/hip_cooperative_groups.h>
#include <math.h>
#include <stdio.h>
namespace cg = cooperative_groups;

#define DM 1024
#define NB 8
#define SEQ 2048
#define CTXL 256
#define NL (NB * SEQ)
#define NC (NB * CTXL)
#define NT (NL + NC)
#define EVEN_IN 2832
#define PROJW 2816
#define NEXP 16
#define MOE_L (NEXP * NB * 256)
#define MOE_C (NEXP * NB * 32)
#define MOE_T (MOE_L + MOE_C)
#define EPS 1e-6f
#define NTHR 512
#define LAS __attribute__((address_space(3)))

typedef unsigned short bf16_t;
typedef short bf16x8 __attribute__((ext_vector_type(8)));
typedef float f32x4 __attribute__((ext_vector_type(4)));
typedef unsigned u32x4 __attribute__((ext_vector_type(4)));
typedef unsigned u32x2 __attribute__((ext_vector_type(2)));

struct Params {
  const float *x, *c, *ctx, *c_ctx, *w_mod, *b_mod, *g_norm1, *g_norm2, *w_in_even, *w_out_even, *g_qnorm, *g_knorm,
      *w_conv, *b_gate, *g_hnorm, *w_in_odd, *w_pool_grp, *s_pool, *w_router, *w_exp_gate, *w_exp_up, *w_exp_down, *g_final;
  float* out;
  float *xcur, *mod, *gates, *aff, *gatev, *gsG, *gsR, *gsB, *cMIN, *cE1, *cDEC, *cBE, *cGM, *Ubuf, *NLb, *NVb;
  bf16_t *hbuf, *proj, *mix, *Xs, *Abuf, *Ybuf, *Qb, *Kb, *Vb, *qm, *km, *Cbf, *ybuf;
  bf16_t *WinE, *WoutE, *WinO, *Wgrp, *Wgu, *Wd;
  int *rowidx, *slotmap;
  unsigned* barw;
  int nprog;
  unsigned char prog_ph[60], prog_l[60];
};

__device__ __forceinline__ float siluf(float v) { return v / (1.f + expf(-v)); }
__device__ __forceinline__ float sigmoidf_(float v) { return 1.f / (1.f + expf(-v)); }
__device__ __forceinline__ float logsigmoidf_(float v) { return fminf(v, 0.f) - __logf(1.f + __expf(-fabsf(v))); }
__device__ __forceinline__ float wave_sum(float v) {
#pragma unroll
  for (int o = 32; o > 0; o >>= 1) v += __shfl_xor(v, o);
  return v;
}
#define LDS_BARRIER() do { asm volatile("s_waitcnt lgkmcnt(0)" ::: "memory"); __builtin_amdgcn_s_barrier(); asm volatile("" ::: "memory"); } while (0)
__device__ __forceinline__ int modrow(int r) { return r < NL ? (r >> 11) : 8; }
__device__ __forceinline__ float bf2f(bf16_t v) { return __uint_as_float(((unsigned)v) << 16); }
typedef float f32x2_t __attribute__((ext_vector_type(2)));
typedef __bf16 bf16x2_t __attribute__((ext_vector_type(2)));
__device__ __forceinline__ unsigned cvt_pk_bf16(float lo, float hi) {
  const f32x2_t v = {lo, hi};
  return __builtin_bit_cast(unsigned, __builtin_convertvector(v, bf16x2_t));
}
__device__ __forceinline__ bf16_t f2bf(float f) { return (bf16_t)(cvt_pk_bf16(f, 0.f) & 0xffffu); }
__device__ __forceinline__ void unpack8(const u32x4 w, float (&f)[8]) {
  f[0] = __uint_as_float(w.x << 16); f[1] = __uint_as_float(w.x & 0xffff0000u); f[2] = __uint_as_float(w.y << 16); f[3] = __uint_as_float(w.y & 0xffff0000u);
  f[4] = __uint_as_float(w.z << 16); f[5] = __uint_as_float(w.z & 0xffff0000u); f[6] = __uint_as_float(w.w << 16); f[7] = __uint_as_float(w.w & 0xffff0000u);
}
__device__ __forceinline__ u32x4 pack8(const float (&f)[8]) {
  u32x4 w; w.x = cvt_pk_bf16(f[0], f[1]); w.y = cvt_pk_bf16(f[2], f[3]); w.z = cvt_pk_bf16(f[4], f[5]); w.w = cvt_pk_bf16(f[6], f[7]);
  return w;
}

__device__ __forceinline__ int ltid() { int t = threadIdx.x; asm volatile("" : "+v"(t)); return t; }
__device__ __forceinline__ int lbid() { int b = blockIdx.x; asm volatile("" : "+s"(b)); return b; }
__device__ __forceinline__ int lgdim() { int g = gridDim.x; asm volatile("" : "+s"(g)); return g; }

#define XB_TMO      128
#define XB_XCNT(j)  (256  + 64 * (j))
#define XB_XSUB(j)  (1280 + 64 * (j))
#define XB_XGEN(j)  (2304 + 64 * (j))
#define XB_TOP      3328
#define XB_TOPGEN   3392
#define XCD_BAR_WORDS 3456
#define XB_SPIN_CAP (1u << 18)
__device__ __forceinline__ unsigned xb_ld(unsigned* p)              { return __hip_atomic_load(p, __ATOMIC_RELAXED, __HIP_MEMORY_SCOPE_AGENT); }
__device__ __forceinline__ unsigned xb_add(unsigned* p, unsigned v) { return __hip_atomic_fetch_add(p, v, __ATOMIC_RELAXED, __HIP_MEMORY_SCOPE_AGENT); }
__device__ __forceinline__ unsigned xb_xcc_id() { return (unsigned)__builtin_amdgcn_s_getreg((3 << 11) | 20) & 0xFu; }
#define XB_SPIN(cond, bar) do { unsigned _sp = 0; while (cond) { __builtin_amdgcn_s_sleep(1); \
    if ((++_sp & 255u) == 0u) { if (xb_ld(&(bar)[XB_TMO])) break; if (_sp > XB_SPIN_CAP) { atomicAdd(&(bar)[XB_TMO], 1u); break; } } } } while (0)
struct XcdBarrier { unsigned* bar; unsigned x; volatile LAS unsigned* st; };
__device__ __forceinline__ XcdBarrier xcd_barrier_post(unsigned* bar, volatile LAS unsigned* st) {
  XcdBarrier b; b.bar = bar; b.x = xb_xcc_id(); b.st = st;
  if (threadIdx.x == 0) (void)xb_add(&bar[XB_XCNT(b.x)], 1u);
  return b;
}
__device__ __forceinline__ void xcd_barrier_complete(unsigned* bar, unsigned x, unsigned& nloc, unsigned& nx) {
  const unsigned G = gridDim.x * gridDim.y * gridDim.z;
  unsigned sum, cnt, mine, sp = 0u;
  for (;;) {
    sum = 0u; cnt = 0u; mine = 0u;
#pragma unroll
    for (unsigned j = 0; j < 16; ++j) { const unsigned c = xb_ld(&bar[XB_XCNT(j)]); sum += c; cnt += (c > 0u) ? 1u : 0u; mine = (j == x) ? c : mine; }
    if (sum == G) break;
    __builtin_amdgcn_s_sleep(1);
    if ((++sp & 255u) == 0u) { if (xb_ld(&bar[XB_TMO])) break; if (sp > XB_SPIN_CAP) { atomicAdd(&bar[XB_TMO], 1u); break; } }
  }
  nloc = mine > 0u ? mine : 1u; nx = cnt > 0u ? cnt : 1u;
}
__device__ __forceinline__ void xcd_barrier(const XcdBarrier& b) {
  asm volatile("s_waitcnt vmcnt(0)" ::: "memory");
  __syncthreads();
  if (threadIdx.x == 0) {
    unsigned* bar = b.bar;
    __builtin_amdgcn_s_waitcnt(0);
    unsigned nloc = b.st[0], nx = b.st[1];
    if (nloc == 0u) { xcd_barrier_complete(bar, b.x, nloc, nx); b.st[0] = nloc; b.st[1] = nx; }
    const unsigned old = xb_add(&bar[XB_XSUB(b.x)], 1u);
    const unsigned gen = old / nloc;
    if (old + 1u == (gen + 1u) * nloc) {
      __builtin_amdgcn_fence(__ATOMIC_RELEASE, "agent");
      asm volatile("s_waitcnt vmcnt(0)" ::: "memory");
      const unsigned og = xb_add(&bar[XB_TOP], 1u);
      const unsigned tg = og / nx;
      if (og + 1u == (tg + 1u) * nx) xb_add(&bar[XB_TOPGEN], 1u);
      else XB_SPIN(xb_ld(&bar[XB_TOPGEN]) == tg, bar);
      __builtin_amdgcn_fence(__ATOMIC_ACQUIRE, "agent");
      xb_add(&bar[XB_XGEN(b.x)], 1u);
      asm volatile("s_waitcnt vmcnt(0)" ::: "memory");
    } else {
      XB_SPIN(xb_ld(&bar[XB_XGEN(b.x)]) == gen, bar);
      __builtin_amdgcn_fence(__ATOMIC_ACQUIRE, "agent");
      asm volatile("s_waitcnt vmcnt(0)" ::: "memory");
    }
  }
  __syncthreads();
}

namespace g8 {
constexpr int BM = 256, BK = 64, HALF = 128, HTB = HALF * BK * 2, STAGE_BYTES = 8 * HTB;
__device__ __forceinline__ int lds_byte(int r, int c) { const int st = (r >> 4) * 2 + (c >> 5), rr = r & 15, cc = c & 31, ob = rr * 64 + cc * 2; return st * 1024 + (ob ^ (((ob >> 9) & 1) << 5)); }
__device__ __forceinline__ void stage_rc(int b, int& R, int& C) { const int st = b / 1024, sb = b % 1024, swz = sb ^ (((sb >> 9) & 1) << 5); R = (st >> 1) * 16 + swz / 64; C = (st & 1) * 32 + (swz % 64) / 2; }
__device__ __forceinline__ int perm32(int rho) { const int n = rho >> 4, i = rho & 15; return 8 * (i >> 2) + 4 * n + (i & 3); }

struct Unit { const char* A; const char* B; int row0, col0; };

template <bool GATHER = false, class Epi, class Sched>
__device__ __forceinline__ void gemm_phase(LAS unsigned char* lds, const int K, const int lda, const int ldb, const Sched& S, const Epi& E, const int* gidx = nullptr, const char* gbaseA = nullptr) {
  const int tid = ltid(), wid = __builtin_amdgcn_readfirstlane(tid >> 6), lane = tid & 63, wr = wid >> 2, wc = wid & 3, fr = lane & 15, fq = lane >> 4;
  const int nt = K / BK;
  unsigned voffA[2], voffB[2], gC2[2];
  int gR[2];
#pragma unroll
  for (int i = 0; i < 2; ++i) {
    int R, C;
    stage_rc(tid * 16 + i * 8192, R, C);
    const int Rb = (R & ~31) + perm32(R & 31);
    voffA[i] = (unsigned)(R * lda + C) * 2u;
    voffB[i] = (unsigned)(Rb * ldb + C) * 2u;
    gR[i] = R; gC2[i] = (unsigned)C * 2u;
  }
  unsigned gcur[2][2], gnxt[2][2];
  auto gload = [&](int row0, unsigned (&g)[2][2]) {
#pragma unroll
    for (int h = 0; h < 2; ++h)
#pragma unroll
      for (int i = 0; i < 2; ++i) g[h][i] = (unsigned)gidx[row0 + h * HALF + gR[i]] * (unsigned)(lda * 2) + gC2[i];
  };
  const size_t kstep = (size_t)(BK * 2);
  const size_t hstepA = (size_t)HALF * lda * 2, hstepB = (size_t)HALF * ldb * 2;
  const unsigned ldsw = (unsigned)wid * 1024u;
  const int aoff = lds_byte(wr * 64 + fr, fq * 8), boff = lds_byte(wc * 32 + fr, fq * 8);
#define PG8_SA(b, h) (((b) * 2 + (h)) * HTB)
#define PG8_SB(b, h) ((4 + (b) * 2 + (h)) * HTB)
#define PG8_STAGE(bufoff, gbase, voff) do { _Pragma("unroll") for (int _i = 0; _i < 2; ++_i) \
    __builtin_amdgcn_global_load_lds((const unsigned*)((const char*)(gbase) + (voff)[_i]), (LAS unsigned*)(lds + (bufoff) + ldsw + _i * 8192), 16, 0, 0); } while (0)
#define PG8_LDA(dst, b, h) do { _Pragma("unroll") for (int m = 0; m < 4; ++m) _Pragma("unroll") for (int k = 0; k < 2; ++k) dst[m][k] = *(const LAS bf16x8*)(lds + PG8_SA(b, h) + aoff + m * 2048 + k * 1024); } while (0)
#define PG8_LDB(dst, b, h) do { _Pragma("unroll") for (int n = 0; n < 2; ++n) _Pragma("unroll") for (int k = 0; k < 2; ++k) dst[n][k] = *(const LAS bf16x8*)(lds + PG8_SB(b, h) + boff + n * 2048 + k * 1024); } while (0)
#define PG8_MMA(ai, bj, At, Bt) do { __builtin_amdgcn_s_setprio(1); _Pragma("unroll") for (int m = 0; m < 4; ++m) _Pragma("unroll") for (int n = 0; n < 2; ++n) _Pragma("unroll") for (int k = 0; k < 2; ++k) \
    acc[ai][bj][m][n] = __builtin_amdgcn_mfma_f32_16x16x32_bf16(Bt[n][k], At[m][k], acc[ai][bj][m][n], 0, 0, 0); __builtin_amdgcn_s_setprio(0); } while (0)
#define PG8_WAIT_V(n) asm volatile("s_waitcnt vmcnt(" #n ")" ::: "memory")
#define PG8_WAIT_L(n) asm volatile("s_waitcnt lgkmcnt(" #n ")" ::: "memory")
#define PG8_BAR __builtin_amdgcn_s_barrier()
#define PG8_SCHED __builtin_amdgcn_sched_barrier(0)
#define PG8_STAGE_A(bufoff, nextu, half, kbytes) do { \
    if constexpr (GATHER) { if (nextu) PG8_STAGE(bufoff, gbaseA + (kbytes), gnxt[half]); else PG8_STAGE(bufoff, gbaseA + (kbytes), gcur[half]); } \
    else { PG8_STAGE(bufoff, ((nextu) ? nA : cA) + (half) * hstepA + (kbytes), voffA); } } while (0)
  Unit cur, nxt;
  int ui = 0;
  if (!S.next(0, cur)) return;
  f32x4 acc[2][2][4][2];
#pragma unroll
  for (int a = 0; a < 2; ++a)
#pragma unroll
    for (int b = 0; b < 2; ++b)
#pragma unroll
      for (int m = 0; m < 4; ++m)
#pragma unroll
        for (int n = 0; n < 2; ++n) acc[a][b][m][n] = (f32x4){0.f, 0.f, 0.f, 0.f};
  bf16x8 At[4][2], B0[2][2], B1[2][2];
  const char* cA = cur.A;
  const char* cB = cur.B;
  const char* nA = cA;
  if constexpr (GATHER) { gload(cur.row0, gcur); gload(cur.row0, gnxt); asm volatile("s_waitcnt vmcnt(0)" ::: "memory"); }
  PG8_STAGE(PG8_SB(0, 0), cB, voffB); PG8_STAGE(PG8_SB(0, 1), cB + hstepB, voffB); PG8_STAGE_A(PG8_SA(0, 0), false, 0, 0); PG8_STAGE_A(PG8_SA(0, 1), false, 1, 0);
  if (wr == 1) PG8_BAR;
  PG8_WAIT_V(2); PG8_BAR;
  PG8_STAGE(PG8_SB(1, 0), cB + kstep, voffB); PG8_STAGE_A(PG8_SA(1, 0), false, 0, kstep); PG8_STAGE(PG8_SB(1, 1), cB + hstepB + kstep, voffB);
  PG8_WAIT_V(6); PG8_BAR;
  for (;;) {
    const bool has_next = S.next(ui + 1, nxt);
    nA = has_next ? nxt.A : cA;
    const char* nB = has_next ? nxt.B : cB;
    if constexpr (GATHER) { if (has_next) gload(nxt.row0, gnxt); else {
#pragma unroll
      for (int h = 0; h < 2; ++h)
#pragma unroll
        for (int i = 0; i < 2; ++i) gnxt[h][i] = gcur[h][i]; } }
    for (int t = 0; t < nt; t += 2) {
      const bool last = (t == nt - 2);
      const size_t k1 = (size_t)(t + 1) * kstep;
      const size_t k2 = last ? 0 : (size_t)(t + 2) * kstep;
      const size_t k3 = k2 + kstep;
      const char* b2 = last ? nB : cB + (size_t)(t + 2) * kstep;
      const char* b3 = b2 + kstep;
      PG8_LDB(B0, 0, 0); PG8_LDB(B1, 0, 1); PG8_SCHED; PG8_LDA(At, 0, 0); PG8_STAGE_A(PG8_SA(1, 1), false, 1, k1);
      PG8_WAIT_V(8); PG8_WAIT_L(0); PG8_BAR; PG8_MMA(0, 0, At, B0); PG8_MMA(0, 1, At, B1); PG8_BAR; PG8_SCHED;
      PG8_LDA(At, 0, 1); PG8_STAGE(PG8_SB(0, 0), b2, voffB); PG8_STAGE(PG8_SB(0, 1), b2 + hstepB, voffB); PG8_STAGE_A(PG8_SA(0, 0), last, 0, k2);
      PG8_WAIT_V(8); PG8_WAIT_L(0); PG8_BAR; PG8_MMA(1, 0, At, B0); PG8_MMA(1, 1, At, B1); PG8_BAR; PG8_SCHED;
      PG8_LDB(B0, 1, 0); PG8_LDB(B1, 1, 1); PG8_SCHED; PG8_LDA(At, 1, 0); PG8_STAGE_A(PG8_SA(0, 1), last, 1, k2);
      PG8_WAIT_V(8); PG8_WAIT_L(0); PG8_BAR; PG8_MMA(0, 0, At, B0); PG8_MMA(0, 1, At, B1); PG8_BAR; PG8_SCHED;
      PG8_LDA(At, 1, 1); PG8_STAGE(PG8_SB(1, 0), b3, voffB); PG8_STAGE(PG8_SB(1, 1), b3 + hstepB, voffB); PG8_STAGE_A(PG8_SA(1, 0), last, 0, k3);
      PG8_WAIT_V(8); PG8_WAIT_L(0); PG8_BAR; PG8_MMA(1, 0, At, B0); PG8_MMA(1, 1, At, B1); PG8_BAR; PG8_SCHED;
    }
    if (wr == 0) PG8_BAR;
    E(acc, cur, wr, wc, fr, fq);
    if (!has_next) break;
#pragma unroll
    for (int a = 0; a < 2; ++a)
#pragma unroll
      for (int b = 0; b < 2; ++b)
#pragma unroll
        for (int m = 0; m < 4; ++m)
#pragma unroll
          for (int n = 0; n < 2; ++n) acc[a][b][m][n] = (f32x4){0.f, 0.f, 0.f, 0.f};
    cur = nxt; cA = nA; cB = nB; ++ui;
    if constexpr (GATHER) {
#pragma unroll
      for (int h = 0; h < 2; ++h)
#pragma unroll
        for (int i = 0; i < 2; ++i) gcur[h][i] = gnxt[h][i];
    }
    if (wr == 1) PG8_BAR;
  }
  PG8_WAIT_V(0);
  PG8_BAR;
#undef PG8_SA
#undef PG8_SB
#undef PG8_STAGE
#undef PG8_STAGE_A
#undef PG8_LDA
#undef PG8_LDB
#undef PG8_MMA
#undef PG8_WAIT_V
#undef PG8_WAIT_L
#undef PG8_BAR
#undef PG8_SCHED
}

struct SchedDense {
  const char* A; const char* B; int lda, ldb, nM, nN, acolstep, G, c;
  __device__ __forceinline__ bool next(int i, Unit& u) const {
    const int nwg = nM * nN;
    const long L = (long)i * G + c;
    if (L >= nwg) return false;
    int wgid = (int)L;
    { const int q = nwg / 8, r = nwg % 8, xcd = wgid % 8, off = wgid / 8; wgid = (xcd < r ? xcd * (q + 1) : r * (q + 1) + (xcd - r) * q) + off; }
    const int nig = 8 * nN, gid = wgid / nig, fm = gid * 8, gsz = (nM - fm) < 8 ? (nM - fm) : 8;
    const int pm = fm + ((wgid % nig) % gsz), pn = (wgid % nig) / gsz;
    u.A = A + (size_t)pm * 256 * lda * 2 + (size_t)pn * acolstep;
    u.B = B + (size_t)pn * 256 * ldb * 2;
    u.row0 = pm * 256; u.col0 = pn * 256;
    return true;
  }
};
struct SchedMoe {
  const char* A; const char* W; int ncol, wrows, colw, nu, G, c;
  __device__ __forceinline__ bool next(int i, Unit& u) const {
    const long L = (long)i * G + c;
    if (L >= nu) return false;
    const int wgid = (int)(L % 8) * (nu / 8) + (int)(L / 8);
    const int UL = 128 * ncol;
    int e, pn, row0;
    if (wgid < UL) { e = wgid / (8 * ncol); const int rem = wgid % (8 * ncol); row0 = e * 2048 + (rem % 8) * 256; pn = rem / 8; }
    else { const int w2 = wgid - UL; e = w2 / ncol; pn = w2 % ncol; row0 = MOE_L + e * 256; }
    u.A = A + (size_t)row0 * 1024 * 2;
    u.B = W + ((size_t)e * wrows + (size_t)pn * 256) * 1024 * 2;
    u.row0 = row0; u.col0 = pn * colw;
    return true;
  }
};

struct EpiBf16 {
  bf16_t* O; int ldo;
  __device__ __forceinline__ void operator()(const f32x4 (&acc)[2][2][4][2], const Unit& u, int wr, int wc, int fr, int fq) const {
#pragma unroll
    for (int ai = 0; ai < 2; ++ai)
#pragma unroll
      for (int m = 0; m < 4; ++m) {
        const int row = u.row0 + ai * 128 + wr * 64 + m * 16 + fr;
        bf16_t* rp = O + (size_t)row * ldo + u.col0 + wc * 32 + 8 * fq;
#pragma unroll
        for (int bj = 0; bj < 2; ++bj) {
          const f32x4 v0 = acc[ai][bj][m][0], v1 = acc[ai][bj][m][1];
          u32x4 w; w.x = cvt_pk_bf16(v0[0], v0[1]); w.y = cvt_pk_bf16(v0[2], v0[3]); w.z = cvt_pk_bf16(v1[0], v1[1]); w.w = cvt_pk_bf16(v1[2], v1[3]);
          *(u32x4*)(rp + bj * 128) = w;
        }
      }
  }
};
struct EpiResid {
  float* x; const float* modg; const float* cs; const float* xl; const float* xc;
  __device__ __forceinline__ void operator()(const f32x4 (&acc)[2][2][4][2], const Unit& u, int wr, int wc, int fr, int fq) const {
#pragma unroll
    for (int ai = 0; ai < 2; ++ai)
#pragma unroll
      for (int m = 0; m < 4; ++m) {
        const int row = u.row0 + ai * 128 + wr * 64 + m * 16 + fr;
        const int c0 = u.col0 + wc * 32 + 8 * fq;
        float* xp = x + (size_t)row * 1024 + c0;
        const float* xi = xl ? (row < NL ? xl + (size_t)row * 1024 + c0 : xc + (size_t)(row - NL) * 1024 + c0) : xp;
        const float* gp = modg + (size_t)modrow(row) * 6144 + c0;
#pragma unroll
        for (int bj = 0; bj < 2; ++bj) {
          f32x4 g0 = *(const f32x4*)(gp + bj * 128), g1 = *(const f32x4*)(gp + bj * 128 + 4);
          if (cs) { g0 *= *(const f32x4*)(cs + c0 + bj * 128); g1 *= *(const f32x4*)(cs + c0 + bj * 128 + 4); }
          f32x4 x0 = *(const f32x4*)(xi + bj * 128), x1 = *(const f32x4*)(xi + bj * 128 + 4);
          x0 += g0 * acc[ai][bj][m][0]; x1 += g1 * acc[ai][bj][m][1];
          *(f32x4*)(xp + bj * 128) = x0; *(f32x4*)(xp + bj * 128 + 4) = x1;
        }
      }
  }
};
struct EpiSwiGLU {
  bf16_t* O;
  __device__ __forceinline__ void operator()(const f32x4 (&acc)[2][2][4][2], const Unit& u, int wr, int wc, int fr, int fq) const {
#pragma unroll
    for (int ai = 0; ai < 2; ++ai)
#pragma unroll
      for (int m = 0; m < 4; ++m) {
        const int row = u.row0 + ai * 128 + wr * 64 + m * 16 + fr;
        bf16_t* rp = O + (size_t)row * 1024 + u.col0 + wc * 32 + 8 * fq;
        float o[8];
#pragma unroll
        for (int n = 0; n < 2; ++n)
#pragma unroll
          for (int j = 0; j < 4; ++j) { const float g = acc[ai][0][m][n][j], up = acc[ai][1][m][n][j]; o[n * 4 + j] = g / (1.f + __expf(-g)) * up; }
        u32x4 w; w.x = cvt_pk_bf16(o[0], o[1]); w.y = cvt_pk_bf16(o[2], o[3]); w.z = cvt_pk_bf16(o[4], o[5]); w.w = cvt_pk_bf16(o[6], o[7]);
        *(u32x4*)rp = w;
      }
  }
};
struct EpiDown {
  bf16_t* O; const float* gatev;
  __device__ __forceinline__ void operator()(const f32x4 (&acc)[2][2][4][2], const Unit& u, int wr, int wc, int fr, int fq) const {
    float gv[2][4];
#pragma unroll
    for (int ai = 0; ai < 2; ++ai)
#pragma unroll
      for (int m = 0; m < 4; ++m) gv[ai][m] = gatev[u.row0 + ai * 128 + wr * 64 + m * 16 + fr];
    __builtin_amdgcn_sched_barrier(0);
#pragma unroll
    for (int ai = 0; ai < 2; ++ai)
#pragma unroll
      for (int m = 0; m < 4; ++m) {
        const int row = u.row0 + ai * 128 + wr * 64 + m * 16 + fr;
        bf16_t* rp = O + (size_t)row * 1024 + u.col0 + wc * 32 + 8 * fq;
#pragma unroll
        for (int bj = 0; bj < 2; ++bj) {
          const f32x4 v0 = acc[ai][bj][m][0] * gv[ai][m], v1 = acc[ai][bj][m][1] * gv[ai][m];
          u32x4 w; w.x = cvt_pk_bf16(v0[0], v0[1]); w.y = cvt_pk_bf16(v0[2], v0[3]); w.z = cvt_pk_bf16(v1[0], v1[1]); w.w = cvt_pk_bf16(v1[2], v1[3]);
          *(u32x4*)(rp + bj * 128) = w;
        }
      }
  }
};
}

#define NT_WINE 1408
#define NT_WOUT 512
#define NT_WINO 512
#define NT_WGRP 128
#define NT_EXP 16384
#define NT_ALL (NT_WINE + NT_WOUT + NT_WINO + NT_WGRP + 3 * NT_EXP)
#define CE0 704
#define CE1 960
#define CE2 13248
#define CE3 13504
#define CE4 13568
#define CE5 25856
#define CE6 26560
#define CE7 26816
#define CE8 39104
#define CE9 39360
#define CE10 39424
#define CE11 51712
__device__ __forceinline__ void conv_batch(const Params& p, int t, float* T) {
  const int tid = ltid(), lane = tid & 63, wv = tid >> 6;
  const float* src; bf16_t* dst; int ld, dK, k0, n0;
  int seg, tb, e, which = 0;
  if (t < CE0) { seg = 0; e = 0; tb = t; } else if (t < CE1) { seg = 1; e = 0; tb = t - CE0; } else if (t < CE2) { seg = 2; e = 0; tb = t - CE1; }
  else if (t < CE3) { seg = 3; e = 0; tb = t - CE2; } else if (t < CE4) { seg = 4; e = 0; tb = t - CE3; } else if (t < CE5) { seg = 2; e = 1; tb = t - CE4; }
  else if (t < CE6) { seg = 0; e = 1; tb = t - CE5; } else if (t < CE7) { seg = 1; e = 1; tb = t - CE6; } else if (t < CE8) { seg = 2; e = 2; tb = t - CE7; }
  else if (t < CE9) { seg = 3; e = 1; tb = t - CE8; } else if (t < CE10) { seg = 4; e = 1; tb = t - CE9; } else { seg = 2; e = 3; tb = t - CE10; }
  int dbase = 0;
  if (seg == 0) {
    k0 = (tb / 44) * 64; n0 = (tb % 44) * 64;
    src = p.w_in_even + (size_t)e * 1024 * EVEN_IN; ld = EVEN_IN; dst = p.WinE + (size_t)e * PROJW * 1024; dK = 1024;
  } else if (seg == 1 || seg == 3) {
    k0 = (tb / 16) * 64; n0 = (tb % 16) * 64;
    src = (seg == 3 ? p.w_in_odd : p.w_out_even) + (size_t)e * 1024 * 1024; ld = 1024; dst = (seg == 3 ? p.WinO : p.WoutE) + (size_t)e * 1024 * 1024; dK = 1024;
  } else if (seg == 4) {
    const int g = tb / 16; k0 = ((tb % 16) / 4) * 64; n0 = (tb % 4) * 64;
    src = p.w_pool_grp + (size_t)(e * 4 + g) * 65536; ld = 256; dst = p.Wgrp + (size_t)e * 1024 * 256; dK = 256; dbase = g * 256;
  } else {
    which = tb / 4096; const int r = tb % 4096, le = e * 16 + r / 256; k0 = ((r % 256) / 16) * 64; n0 = (r % 16) * 64;
    const float* base = which == 0 ? p.w_exp_gate : (which == 1 ? p.w_exp_up : p.w_exp_down);
    src = base + (size_t)le * 1024 * 1024; ld = 1024; dK = 1024;
    dst = which < 2 ? p.Wgu + (size_t)le * 2048 * 1024 : p.Wd + (size_t)le * 1024 * 1024;
  }
  const bool gu = (seg == 2 && which < 2);
  float4 v[8];
#pragma unroll
  for (int q = 0; q < 8; ++q) {
    const int idx = tid + q * NTHR, k = idx >> 6, c4 = idx & 63;
    v[q] = *(const float4*)(src + (size_t)(k0 + k) * ld + n0 + c4 * 4);
  }
  __builtin_amdgcn_sched_barrier(0);
#pragma unroll
  for (int q = 0; q < 8; ++q) {
    const int idx = tid + q * NTHR, k = idx >> 6, c4 = idx & 63;
    float* tp = T + k * 257 + c4 * 4;
    tp[0] = v[q].x; tp[1] = v[q].y; tp[2] = v[q].z; tp[3] = v[q].w;
  }
  __syncthreads();
#pragma unroll
  for (int sub = 0; sub < 4; ++sub) {
    const int nl = wv * 8 + (lane >> 3), kq = lane & 7, nn = n0 + sub * 64;
    const int drow0 = gu ? (nn >> 7) * 256 + which * 128 + (nn & 127) : dbase + nn;
    float f[8];
#pragma unroll
    for (int j = 0; j < 8; ++j) f[j] = T[(kq * 8 + j) * 257 + sub * 64 + nl];
    u32x4 w; w.x = cvt_pk_bf16(f[0], f[1]); w.y = cvt_pk_bf16(f[2], f[3]); w.z = cvt_pk_bf16(f[4], f[5]); w.w = cvt_pk_bf16(f[6], f[7]);
    *(u32x4*)(dst + (size_t)(drow0 + nl) * dK + k0 + kq * 8) = w;
  }
}
__device__ __forceinline__ int conv_pull(const Params& p, float* sm) {
  __syncthreads();
  if (ltid() == 0) ((int*)sm)[16500] = (int)__hip_atomic_fetch_add(p.barw, 4u, __ATOMIC_RELAXED, __HIP_MEMORY_SCOPE_AGENT);
  __syncthreads();
  return ((int*)sm)[16500];
}
__device__ __forceinline__ void conv_until(const Params& p, int end, float* sm) {
  int t;
  do { t = conv_pull(p, sm); if (t < CE11) conv_batch(p, t, sm); } while (t + 4 < end);
  __syncthreads();
}
__device__ __forceinline__ void conv_quota(const Params& p, int n, float* sm) {
  for (int i = 0; i < n; ++i) { const int t = conv_pull(p, sm); if (t >= CE11) break; conv_batch(p, t, sm); }
  __syncthreads();
}

__device__ __forceinline__ void ph_init(const Params& p, float* sm) {
  const int tid = ltid(), lane = tid & 63, wv = tid >> 6;
  const size_t gtid = (size_t)lbid() * NTHR + tid, gsz = (size_t)lgdim() * NTHR;
  for (int i = tid; i < 9 * 1024; i += NTHR) {
    const int r = i >> 10, k = i & 1023;
    sm[i] = siluf(r < 8 ? p.c[r * 1024 + k] : p.c_ctx[k]);
  }
  __syncthreads();
  float* part = sm + 9 * 1024;
  for (int item = lbid(); item < 768; item += lgdim()) {
    const int l = item / 192, j0 = (item % 192) * 32;
    const int col = lane & 31, kh = lane >> 5;
    const float* w = p.w_mod + (size_t)l * 1024 * 6144 + j0 + col;
    float acc[9];
#pragma unroll
    for (int r = 0; r < 9; ++r) acc[r] = 0.f;
    const int kb = wv * 128 + kh * 64;
#pragma unroll 4
    for (int kk = 0; kk < 64; ++kk) {
      const float wvv = w[(size_t)(kb + kk) * 6144];
#pragma unroll
      for (int r = 0; r < 9; ++r) acc[r] += sm[r * 1024 + kb + kk] * wvv;
    }
#pragma unroll
    for (int r = 0; r < 9; ++r) part[((wv * 2 + kh) * 9 + r) * 32 + col] = acc[r];
    __syncthreads();
    if (tid < 288) {
      const int r = tid >> 5, cc = tid & 31;
      float s = 0.f;
#pragma unroll
      for (int sl = 0; sl < 16; ++sl) s += part[(sl * 9 + r) * 32 + cc];
      p.mod[(size_t)(l * 9 + r) * 6144 + j0 + cc] = s + p.b_mod[l * 6144 + j0 + cc];
    }
    __syncthreads();
  }
  conv_until(p, CE1, sm);
}

typedef float f32x4m __attribute__((ext_vector_type(4)));
__device__ __forceinline__ void ph_norm(const Params& p, int l, int which, int nrows, int ncomb, int lprev, float* sm) {
  const int tid = ltid(), lane = tid & 63, wv = tid >> 6;
  const bool skinny = (which == 2) || (which == 1 && (l & 1) == 0);
  bf16_t* HROW = (bf16_t*)sm;
  float* PART = sm + 8192;
  bf16x8 Bhi[4], Blo[4];
  if (skinny) {
    const float* wbase; int stride;
    if (which == 2) { wbase = p.w_router + (size_t)l * 1024 * 16; stride = 16; }
    else { wbase = p.w_in_even + (size_t)(l >> 1) * 1024 * EVEN_IN + PROJW; stride = EVEN_IN; }
    const int kg = lane >> 4, n = lane & 15;
#pragma unroll
    for (int ks = 0; ks < 4; ++ks) {
      float f[8], hi[8], lo[8];
#pragma unroll
      for (int j = 0; j < 8; ++j) f[j] = wbase[(size_t)(wv * 128 + ks * 32 + kg * 8 + j) * stride + n];
      const u32x4 hw = pack8(f);
      unpack8(hw, hi);
#pragma unroll
      for (int j = 0; j < 8; ++j) lo[j] = f[j] - hi[j];
      Bhi[ks] = __builtin_bit_cast(bf16x8, hw);
      Blo[ks] = __builtin_bit_cast(bf16x8, pack8(lo));
    }
  }
  const int nwaves = lgdim() * (NTHR / 64), gw = lbid() * (NTHR / 64) + wv;
  const int per = (nrows + nwaves - 1) / nwaves;
  const int rbeg = gw * per, rend = min(nrows, rbeg + per);
  const bool in0 = (l == 0) && (which == 1 || which == 2);
  float4 vn[4];
  int slvn = -1;
  {
    const int r0 = min(rbeg, nrows - 1);
    const float* xs0 = in0 ? (r0 < NL ? p.x + (size_t)r0 * DM : p.ctx + (size_t)(r0 - NL) * DM) : p.xcur + (size_t)r0 * DM;
#pragma unroll
    for (int i = 0; i < 4; ++i) vn[i] = ((const float4*)xs0)[i * 64 + lane];
    if (r0 < ncomb && lane < 16) slvn = p.slotmap[r0 * 16 + lane];
  }
  float4 cA[4], cB[4], cG[4];
  u32x2 yn[4];
  int mr_c = -1;
  if (which == 2) {
    const u32x2* yp0 = (const u32x2*)(p.ybuf + (size_t)min(rbeg, nrows - 1) * DM);
#pragma unroll
    for (int i = 0; i < 4; ++i) yn[i] = yp0[i * 64 + lane];
  }
  for (int it = 0; it < per; ++it) {
    const int rr = rbeg + it;
    const bool live = rr < rend;
    const int r = min(rr, nrows - 1);
    float4 v[4];
#pragma unroll
    for (int i = 0; i < 4; ++i) v[i] = vn[i];
    const int slv = slvn;
    float* xr = p.xcur + (size_t)r * DM;
    if (it + 1 < per) {
      const int rn = min(rr + 1, nrows - 1);
      const float* xsn = in0 ? (rn < NL ? p.x + (size_t)rn * DM : p.ctx + (size_t)(rn - NL) * DM) : p.xcur + (size_t)rn * DM;
#pragma unroll
      for (int i = 0; i < 4; ++i) vn[i] = ((const float4*)xsn)[i * 64 + lane];
      slvn = (rn < ncomb && lane < 16) ? p.slotmap[rn * 16 + lane] : -1;
    }
    const int mr = modrow(r);
    if (mr != mr_c) {
      mr_c = mr;
      if (which == 3) {
#pragma unroll
        for (int i = 0; i < 4; ++i) cA[i] = ((const float4*)p.g_final)[i * 64 + lane];
      } else {
        const float* gn = (which == 1 ? p.g_norm1 : p.g_norm2) + l * 1024;
        const float* mrow = p.mod + (size_t)(l * 9 + mr) * 6144;
        const float4* shp = (const float4*)(mrow + (which == 1 ? 0 : 3) * 1024);
        const float4* scp = (const float4*)(mrow + (which == 1 ? 1 : 4) * 1024);
#pragma unroll
        for (int i = 0; i < 4; ++i) {
          const float4 g = ((const float4*)gn)[i * 64 + lane], sc = scp[i * 64 + lane];
          cA[i] = make_float4(g.x * (1.f + sc.x), g.y * (1.f + sc.y), g.z * (1.f + sc.z), g.w * (1.f + sc.w));
          cB[i] = shp[i * 64 + lane];
        }
      }
      if (which == 2) {
        const float4* g2 = (const float4*)(p.mod + (size_t)(l * 9 + mr) * 6144 + 2 * 1024);
        const float4* spv = (const float4*)(p.s_pool + (size_t)(l >> 1) * 1024);
#pragma unroll
        for (int i = 0; i < 4; ++i) {
          float4 g = g2[i * 64 + lane];
          if (l & 1) { const float4 sp4 = spv[i * 64 + lane]; g.x *= sp4.x; g.y *= sp4.y; g.z *= sp4.z; g.w *= sp4.w; }
          cG[i] = g;
        }
      } else if (ncomb > 0) {
        const float4* g5 = (const float4*)(p.mod + (size_t)(lprev * 9 + mr) * 6144 + 5 * 1024);
#pragma unroll
        for (int i = 0; i < 4; ++i) cG[i] = g5[i * 64 + lane];
      }
    }
    if (live && r < ncomb) {
      float4 s4[4];
#pragma unroll
      for (int i = 0; i < 4; ++i) s4[i] = make_float4(0.f, 0.f, 0.f, 0.f);
      unsigned long long mask = __ballot(slv >= 0);
      while (mask) {
        const int e = __ffsll((long long)mask) - 1;
        mask &= mask - 1;
        const int sl = __shfl(slv, e);
        size_t yrow;
        if (r < NL) yrow = (size_t)e * 2048 + (size_t)(r >> 11) * 256 + sl;
        else yrow = (size_t)MOE_L + (size_t)e * 256 + (size_t)((r - NL) >> 8) * 32 + sl;
        const u32x2* yp = (const u32x2*)(p.Ybuf + yrow * DM);
        u32x2 yv[4];
#pragma unroll
        for (int i = 0; i < 4; ++i) yv[i] = yp[i * 64 + lane];
#pragma unroll
        for (int i = 0; i < 4; ++i) {
          const u32x2 y = yv[i];
          s4[i].x += __uint_as_float(y.x << 16); s4[i].y += __uint_as_float(y.x & 0xffff0000u);
          s4[i].z += __uint_as_float(y.y << 16); s4[i].w += __uint_as_float(y.y & 0xffff0000u);
        }
      }
#pragma unroll
      for (int i = 0; i < 4; ++i) {
        const float4 g = cG[i];
        v[i].x += g.x * s4[i].x; v[i].y += g.y * s4[i].y; v[i].z += g.z * s4[i].z; v[i].w += g.w * s4[i].w;
        if (which != 3) ((float4*)xr)[i * 64 + lane] = v[i];
      }
    }
    if (which == 2) {
      u32x2 yc[4];
#pragma unroll
      for (int i = 0; i < 4; ++i) yc[i] = yn[i];
      if (it + 1 < per) {
        const u32x2* ypn = (const u32x2*)(p.ybuf + (size_t)min(rr + 1, nrows - 1) * DM);
#pragma unroll
        for (int i = 0; i < 4; ++i) yn[i] = ypn[i * 64 + lane];
      }
#pragma unroll
      for (int i = 0; i < 4; ++i) {
        v[i].x += cG[i].x * __uint_as_float(yc[i].x << 16); v[i].y += cG[i].y * __uint_as_float(yc[i].x & 0xffff0000u);
        v[i].z += cG[i].z * __uint_as_float(yc[i].y << 16); v[i].w += cG[i].w * __uint_as_float(yc[i].y & 0xffff0000u);
        if (live) ((float4*)xr)[i * 64 + lane] = v[i];
      }
    }
    float ss = 0.f;
#pragma unroll
    for (int i = 0; i < 4; ++i) ss += v[i].x * v[i].x + v[i].y * v[i].y + v[i].z * v[i].z + v[i].w * v[i].w;
    ss = wave_sum(ss);
    const float inv = rsqrtf(ss * (1.f / 1024.f) + EPS);
    if (which == 3) {
      if (live) {
#pragma unroll
        for (int i = 0; i < 4; ++i) {
          const float4 g = cA[i];
          ((float4*)(p.out + (size_t)r * DM))[i * 64 + lane] = make_float4(v[i].x * inv * g.x, v[i].y * inv * g.y, v[i].z * inv * g.z, v[i].w * inv * g.w);
        }
      }
      continue;
    }
#pragma unroll
    for (int i = 0; i < 4; ++i) {
      const float h0 = v[i].x * inv * cA[i].x + cB[i].x, h1 = v[i].y * inv * cA[i].y + cB[i].y;
      const float h2 = v[i].z * inv * cA[i].z + cB[i].z, h3 = v[i].w * inv * cA[i].w + cB[i].w;
      u32x2 w; w.x = cvt_pk_bf16(h0, h1); w.y = cvt_pk_bf16(h2, h3);
      if (live) ((u32x2*)(p.hbuf + (size_t)r * DM))[i * 64 + lane] = w;
      if (skinny) {
        const float l0 = h0 - __uint_as_float(w.x << 16), l1 = h1 - __uint_as_float(w.x & 0xffff0000u);
        const float l2 = h2 - __uint_as_float(w.y << 16), l3 = h3 - __uint_as_float(w.y & 0xffff0000u);
        u32x2 wl; wl.x = cvt_pk_bf16(l0, l1); wl.y = cvt_pk_bf16(l2, l3);
        ((u32x2*)(HROW + (wv * 2 + 0) * 1024))[i * 64 + lane] = w;
        ((u32x2*)(HROW + (wv * 2 + 1) * 1024))[i * 64 + lane] = wl;
      }
    }
    if (!skinny) continue;
    LDS_BARRIER();
    {
      const int arow = lane & 7, kg = lane >> 4;
      f32x4m acc = {0.f, 0.f, 0.f, 0.f};
#pragma unroll
      for (int ks = 0; ks < 4; ++ks) {
        const bf16x8 ahi = *(const bf16x8*)(HROW + (arow * 2 + 0) * 1024 + wv * 128 + ks * 32 + kg * 8);
        const bf16x8 alo = *(const bf16x8*)(HROW + (arow * 2 + 1) * 1024 + wv * 128 + ks * 32 + kg * 8);
        acc = __builtin_amdgcn_mfma_f32_16x16x32_bf16(ahi, Bhi[ks], acc, 0, 0, 0);
        acc = __builtin_amdgcn_mfma_f32_16x16x32_bf16(ahi, Blo[ks], acc, 0, 0, 0);
        acc = __builtin_amdgcn_mfma_f32_16x16x32_bf16(alo, Bhi[ks], acc, 0, 0, 0);
      }
      if (kg < 2) {
#pragma unroll
        for (int q = 0; q < 4; ++q) PART[(wv * 8 + kg * 4 + q) * 16 + (lane & 15)] = acc[q];
      }
    }
    LDS_BARRIER();
    {
      float v1 = 0.f;
      if (lane < 16) {
#pragma unroll
        for (int w2 = 0; w2 < 8; ++w2) v1 += PART[(w2 * 8 + wv) * 16 + lane];
      }
      if (which == 2) {
        float mx = v1;
        mx = fmaxf(mx, __shfl_xor(mx, 1)); mx = fmaxf(mx, __shfl_xor(mx, 2)); mx = fmaxf(mx, __shfl_xor(mx, 4)); mx = fmaxf(mx, __shfl_xor(mx, 8));
        const float ex = expf(v1 - mx);
        float sum = ex;
        sum += __shfl_xor(sum, 1); sum += __shfl_xor(sum, 2); sum += __shfl_xor(sum, 4); sum += __shfl_xor(sum, 8);
        if (live && lane < 16) p.aff[(size_t)r * 16 + lane] = ex / sum;
      } else {
        float gvv = v1 + p.b_gate[(l >> 1) * 16 + (lane & 15)];
        if ((lane >> 2) & 1) gvv = logsigmoidf_(gvv);
        if (live && lane < 16) p.gates[(size_t)r * 16 + lane] = gvv;
      }
    }
  }
  __syncthreads();
}

#define LOG2E 1.4426950408889634f
__device__ __forceinline__ int chain_row(int b, int dir, int p) {
  if (p < 256) { const int t = dir ? 255 - p : p; return NL + b * 256 + t; }
  const int q = p - 256; const int t = dir ? 2047 - q : q; return b * 2048 + t;
}
__device__ __forceinline__ float wave_incl_sum(float v, int lane) {
#pragma unroll
  for (int o = 1; o < 64; o <<= 1) { const float t = __shfl_up(v, o); if (lane >= o) v += t; }
  return v;
}
__device__ __forceinline__ float wave_incl_max(float v, int lane) {
#pragma unroll
  for (int o = 1; o < 64; o <<= 1) { const float t = __shfl_up(v, o); if (lane >= o) v = fmaxf(v, t); }
  return v;
}
__device__ __forceinline__ void ph_post_even(const Params& p, int l, float* sm) {
  const int e = l >> 1;
  const int tid = ltid(), lane = tid & 63;
  __syncthreads();
  for (int idx = tid; idx < 1024; idx += NTHR) {
    const int pos = idx >> 4, i = idx & 15;
    const float ang = (float)pos * exp2f(-(float)i * (13.287712379549449f / 16.f));
    float sn, cs;
    sincosf(ang, &sn, &cs);
    sm[2 * idx] = cs; sm[2 * idx + 1] = sn;
  }
  if (tid < 128) sm[2048 + tid] = tid < 64 ? p.g_qnorm[e * 64 + tid] : p.g_knorm[e * 64 + tid - 64];
  for (int idx = tid; idx < 3072; idx += NTHR) sm[2304 + idx] = p.w_conv[(size_t)e * 3 * 1024 + idx];
  __syncthreads();
  const int bid = lbid(), G = lgdim();
  const bool scanner = false;
  const size_t gtid = (size_t)bid * NTHR + tid, gsz = (size_t)G * NTHR;
  if (!scanner) {
  for (size_t it = gtid; it < (size_t)NT * 10; it += gsz) {
    const int r = (int)(it / 10), hh = (int)(it % 10);
    const bool lat = r < NL;
    const int t = r & 2047;
    const int bb = lat ? (r >> 11) : ((r - NL) >> 8);
    const int key = lat ? 256 + t : ((r - NL) & 255);
    const bf16_t* src; bf16_t* dst; const float* g; float osc;
    if (hh < 8) { src = p.proj + (size_t)r * PROJW + hh * 64; dst = p.Qb + (size_t)r * 512 + hh * 64; g = sm + 2048; osc = 0.125f * LOG2E; }
    else { src = p.proj + (size_t)r * PROJW + 512 + (hh - 8) * 64; dst = p.Kb + ((size_t)(bb * 2 + (hh - 8)) * 2304 + key) * 64; g = sm + 2048 + 64; osc = 1.f;
           const u32x4* vs = (const u32x4*)(p.proj + (size_t)r * PROJW + 640 + (hh - 8) * 64);
           u32x4* vd = (u32x4*)(p.Vb + ((size_t)(bb * 2 + (hh - 8)) * 2304 + key) * 64);
           u32x4 vt[8];
#pragma unroll
           for (int q = 0; q < 8; ++q) vt[q] = vs[q];
           __builtin_amdgcn_sched_barrier(0);
#pragma unroll
           for (int q = 0; q < 8; ++q) vd[q] = vt[q]; }
    float x[64];
#pragma unroll
    for (int q = 0; q < 8; ++q) { float f[8]; unpack8(((const u32x4*)src)[q], f);
#pragma unroll
      for (int j = 0; j < 8; ++j) x[q * 8 + j] = f[j]; }
    float ss = 0.f;
#pragma unroll
    for (int j = 0; j < 64; ++j) ss += x[j] * x[j];
    const float inv = rsqrtf(ss * (1.f / 64.f) + EPS) * osc;
#pragma unroll
    for (int j = 0; j < 64; ++j) x[j] *= inv * g[j];
    if (lat) {
#pragma unroll
      for (int a = 0; a < 2; ++a) {
        const int pos = (a == 0) ? (t >> 6) : (t & 63);
#pragma unroll
        for (int i = 0; i < 16; ++i) {
          const float2 cssn = *(const float2*)(sm + 2 * (pos * 16 + i));
          const float x1 = x[a * 32 + i], x2 = x[a * 32 + 16 + i];
          x[a * 32 + i] = x1 * cssn.x - x2 * cssn.y;
          x[a * 32 + 16 + i] = x2 * cssn.x + x1 * cssn.y;
        }
      }
    }
#pragma unroll
    for (int q = 0; q < 8; ++q) { float f[8];
#pragma unroll
      for (int j = 0; j < 8; ++j) f[j] = x[q * 8 + j];
      ((u32x4*)dst)[q] = pack8(f); }
  }
  const float* wc = sm + 2304;
  for (size_t it0 = gtid; it0 < (size_t)NT * 128; it0 += 4 * gsz) {
    u32x4 rc[4], rm[4], rp[4];
#pragma unroll
    for (int u = 0; u < 4; ++u) {
      const size_t it = it0 + (size_t)u * gsz;
      const size_t itc = it < (size_t)NT * 128 ? it : it0;
      const int r = (int)(itc >> 7), c8 = (int)(itc & 127) * 8;
      int t, n;
      if (r < NL) { t = r & 2047; n = 2048; } else { t = (r - NL) & 255; n = 256; }
      const bf16_t* sp = p.proj + (size_t)r * PROJW + 768 + c8;
      rc[u] = *(const u32x4*)sp;
      const u32x4 lm = *(const u32x4*)(sp - (t > 0 ? PROJW : 0)), lp = *(const u32x4*)(sp + (t < n - 1 ? PROJW : 0));
      rm[u].x = t > 0 ? lm.x : 0u; rm[u].y = t > 0 ? lm.y : 0u; rm[u].z = t > 0 ? lm.z : 0u; rm[u].w = t > 0 ? lm.w : 0u;
      rp[u].x = t < n - 1 ? lp.x : 0u; rp[u].y = t < n - 1 ? lp.y : 0u; rp[u].z = t < n - 1 ? lp.z : 0u; rp[u].w = t < n - 1 ? lp.w : 0u;
    }
#pragma unroll
    for (int u = 0; u < 4; ++u) {
      const size_t it = it0 + (size_t)u * gsz;
      if (it < (size_t)NT * 128) {
        const int r = (int)(it >> 7), c8 = (int)(it & 127) * 8;
        float xc[8], xm[8], xp[8], o[8];
        unpack8(rc[u], xc); unpack8(rm[u], xm); unpack8(rp[u], xp);
        const float ksc = c8 < 512 ? 1.f : 0.08838834764831845f;
#pragma unroll
        for (int j = 0; j < 8; ++j) { const float v = wc[c8 + j] * xm[j] + wc[1024 + c8 + j] * xc[j] + wc[2048 + c8 + j] * xp[j]; o[j] = siluf(v) * ksc; }
        bf16_t* dp = c8 < 512 ? p.qm + (size_t)r * 512 + c8 : p.km + (size_t)r * 512 + c8 - 512;
        *(u32x4*)dp = pack8(o);
      }
    }
  }
  }
  {
    const int gw = (int)(gtid >> 6), nw = (int)(gsz >> 6);
    for (int task = gw; task < 64 * 18; task += nw) {
      const int chain = task / 18, c = task % 18;
      const int b = chain >> 3, hd = (chain >> 1) & 3, dir = chain & 1;
      const int p0 = c * 128 + 2 * lane;
      const int r0 = chain_row(b, dir, p0), r1 = chain_row(b, dir, p0 + 1);
      const float ig0 = p.gates[(size_t)r0 * 16 + dir * 8 + hd], lf0 = p.gates[(size_t)r0 * 16 + dir * 8 + 4 + hd];
      const float ig1 = p.gates[(size_t)r1 * 16 + dir * 8 + hd], lf1 = p.gates[(size_t)r1 * 16 + dir * 8 + 4 + hd];
      const float ssum = lf0 + lf1;
      const float incl = wave_incl_sum(ssum, lane);
      const float bq0 = (incl - ssum) + lf0, bq1 = bq0 + lf1;
      const float bend = __shfl(incl, 63);
      const float g0 = ig0 - bq0, g1 = ig1 - bq1;
      const float inclm = wave_incl_max(fmaxf(g0, g1), lane);
      float exclm = __shfl_up(inclm, 1);
      if (lane == 0) exclm = -3.0e38f;
      const float pm0 = fmaxf(exclm, g0), pm1 = fmaxf(pm0, g1);
      const float gmax = __shfl(inclm, 63);
      const size_t i0 = (size_t)r0 * 8 + dir * 4 + hd, i1 = (size_t)r1 * 8 + dir * 4 + hd;
      p.gsG[i0] = g0 * LOG2E; p.gsR[i0] = pm0 * LOG2E; p.gsB[i0] = bq0 * LOG2E;
      p.gsG[i1] = g1 * LOG2E; p.gsR[i1] = pm1 * LOG2E; p.gsB[i1] = bq1 * LOG2E;
      if (lane == 0) { p.cBE[chain * 18 + c] = bend; p.cGM[chain * 18 + c] = gmax; }
    }
  }
}
__device__ __forceinline__ void chain_state(const Params& p, int chain, int cc, float& m_in, float& m_next, float& be) {
  m_in = -1e30f; m_next = -1e30f; be = 0.f;
  for (int c = 0; c <= cc; ++c) {
    be = p.cMIN[chain * 18 + c];
    const float mn = fmaxf(m_in + be, be + p.cE1[chain * 18 + c]);
    if (c < cc) m_in = mn; else m_next = mn;
  }
}

typedef float f32x16 __attribute__((ext_vector_type(16)));
typedef short s16x4 __attribute__((ext_vector_type(4)));
typedef __attribute__((address_space(3))) const char* lds_cptr;
__device__ __forceinline__ s16x4 vtr(lds_cptr p) { return __builtin_bit_cast(s16x4, __builtin_amdgcn_ds_read_tr16_b64_v4i16((__attribute__((address_space(3))) s16x4*)p)); }
#define MX3(a, b, c) __builtin_fmaxf(__builtin_fmaxf((a), (b)), (c))
__device__ __forceinline__ float rowmax32(const f32x16& p0, const f32x16& p1) {
  float a = MX3(p0[0], p0[1], p1[0]), b = MX3(p0[2], p0[3], p1[1]);
  a = MX3(a, p1[2], p1[3]);
#pragma unroll
  for (int r = 4; r < 16; r += 4) { a = MX3(a, p0[r], p0[r + 1]); b = MX3(b, p0[r + 2], p0[r + 3]); a = MX3(a, p1[r], p1[r + 1]); b = MX3(b, p1[r + 2], p1[r + 3]); }
  const float m = __builtin_fmaxf(a, b);
  auto rr = __builtin_amdgcn_permlane32_swap(__float_as_uint(m), __float_as_uint(m), false, false);
  return __builtin_fmaxf(__uint_as_float(rr[0]), __uint_as_float(rr[1]));
}
__device__ __forceinline__ float half_swap_add(float v) {
  auto rr = __builtin_amdgcn_permlane32_swap(__float_as_uint(v), __float_as_uint(v), false, false);
  return __uint_as_float(rr[0]) + __uint_as_float(rr[1]);
}
#define ATT_SLOT 16384
__device__ __forceinline__ void glds16(const void* g, unsigned lds_base) {
  unsigned sv;
  asm volatile("s_mov_b32 %0, m0\n\ts_mov_b32 m0, %2\n\ts_nop 0\n\tglobal_load_lds_dwordx4 %1, off\n\ts_mov_b32 m0, %0" : "=&s"(sv) : "v"(g), "s"(lds_base) : "memory");
}
__device__ __forceinline__ void attn_unit(const bf16_t* Q0, const bf16_t* Kbase, const bf16_t* Vbase, const int nkeys, bf16_t* O0, LAS unsigned char* lds) {
  const int tid = ltid(), lane = tid & 63, r32 = lane & 31, hi = lane >> 5;
  const int wid = __builtin_amdgcn_readfirstlane(tid >> 6);
  const int NTL = nkeys >> 6;
  __syncthreads();
  const bf16_t* ksrc = Kbase + (size_t)lane * 64 + wid * 8;
  const bf16_t* vsrc = Vbase + (size_t)(16 * (wid & 3) + (lane >> 2)) * 64 + (wid >> 2) * 32 + (lane & 3) * 8;
  const unsigned ldsb = (unsigned)(size_t)lds;
#define ATT_STAGE(t, slot) do { \
    glds16(ksrc + (size_t)(t) * 64 * 64, (unsigned)__builtin_amdgcn_readfirstlane(ldsb + (slot) * ATT_SLOT + wid * 1024)); \
    glds16(vsrc + (size_t)(t) * 64 * 64, (unsigned)__builtin_amdgcn_readfirstlane(ldsb + (slot) * ATT_SLOT + 8192 + wid * 1024)); } while (0)
  ATT_STAGE(0, 0);
  if (NTL > 1) ATT_STAGE(1, 1);
  bf16x8 qr[4];
  {
    const bf16_t* Qw = Q0 + (size_t)(wid * 32 + r32) * 512;
#pragma unroll
    for (int d0 = 0; d0 < 4; ++d0) qr[d0] = *(const bf16x8*)(Qw + d0 * 16 + hi * 8);
  }
  f32x16 o0, o1;
#pragma unroll
  for (int r = 0; r < 16; ++r) { o0[r] = 0.f; o1[r] = 0.f; }
  float m = -1e30f, l = 0.f;
  const int koff = hi * 1024 + r32 * 16;
  const int voff = 8192 + ((lane >> 4) & 1) * 32 + (lane & 3) * 8 + (4 * hi + ((lane & 15) >> 2)) * 64;
  const bool grpB = wid >= 4;
  bf16x8 pw[4];
#define ATT_PV(sl) do { const lds_cptr vp_ = (lds_cptr)(lds + (sl) * ATT_SLOT + voff); \
    _Pragma("unroll") for (int s4 = 0; s4 < 4; ++s4) { \
      const s16x4 a0l = vtr(vp_ + s4 * 1024), a0h = vtr(vp_ + s4 * 1024 + 512); \
      const s16x4 a1l = vtr(vp_ + 4096 + s4 * 1024), a1h = vtr(vp_ + 4096 + s4 * 1024 + 512); \
      const bf16x8 a0 = {a0l[0], a0l[1], a0l[2], a0l[3], a0h[0], a0h[1], a0h[2], a0h[3]}; \
      const bf16x8 a1 = {a1l[0], a1l[1], a1l[2], a1l[3], a1h[0], a1h[1], a1h[2], a1h[3]}; \
      o0 = __builtin_amdgcn_mfma_f32_32x32x16_bf16(a0, pw[s4], o0, 0, 0, 0); \
      o1 = __builtin_amdgcn_mfma_f32_32x32x16_bf16(a1, pw[s4], o1, 0, 0, 0); } } while (0)
  for (int t = 0; t <= NTL; ++t) {
    if (t + 1 < NTL) asm volatile("s_waitcnt vmcnt(2) lgkmcnt(0)\n\ts_barrier" ::: "memory"); else asm volatile("s_waitcnt vmcnt(0) lgkmcnt(0)\n\ts_barrier" ::: "memory");
    __builtin_amdgcn_sched_barrier(0);
    if (t + 2 < NTL) ATT_STAGE(t + 2, (t + 2) & 3);
    if (grpB && t > 0) ATT_PV((t - 1) & 3);
    if (t < NTL) {
      const lds_cptr kp = (lds_cptr)(lds + (t & 3) * ATT_SLOT + koff);
      f32x16 pA, pB;
#pragma unroll
      for (int r = 0; r < 16; ++r) { pA[r] = 0.f; pB[r] = 0.f; }
#pragma unroll
      for (int d0 = 0; d0 < 4; ++d0) {
        const bf16x8 k0 = *(const LAS bf16x8*)(kp + d0 * 2048), k1 = *(const LAS bf16x8*)(kp + d0 * 2048 + 512);
        pA = __builtin_amdgcn_mfma_f32_32x32x16_bf16(k0, qr[d0], pA, 0, 0, 0);
        pB = __builtin_amdgcn_mfma_f32_32x32x16_bf16(k1, qr[d0], pB, 0, 0, 0);
      }
      const float rm = rowmax32(pA, pB);
      const float mn = __builtin_fmaxf(m, rm);
      const float alpha = __builtin_amdgcn_exp2f(m - mn);
      m = mn;
      float ps = 0.f;
#pragma unroll
      for (int r = 0; r < 16; ++r) { pA[r] = __builtin_amdgcn_exp2f(pA[r] - mn); pB[r] = __builtin_amdgcn_exp2f(pB[r] - mn); ps += pA[r] + pB[r]; }
      l = l * alpha + ps;
#pragma unroll
      for (int r = 0; r < 16; ++r) { o0[r] *= alpha; o1[r] *= alpha; }
#pragma unroll
      for (int s4 = 0; s4 < 4; ++s4) {
        u32x4 w;
        if (s4 < 2) { w.x = cvt_pk_bf16(pA[8 * s4 + 0], pA[8 * s4 + 1]); w.y = cvt_pk_bf16(pA[8 * s4 + 2], pA[8 * s4 + 3]); w.z = cvt_pk_bf16(pA[8 * s4 + 4], pA[8 * s4 + 5]); w.w = cvt_pk_bf16(pA[8 * s4 + 6], pA[8 * s4 + 7]); }
        else { const int q = s4 - 2; w.x = cvt_pk_bf16(pB[8 * q + 0], pB[8 * q + 1]); w.y = cvt_pk_bf16(pB[8 * q + 2], pB[8 * q + 3]); w.z = cvt_pk_bf16(pB[8 * q + 4], pB[8 * q + 5]); w.w = cvt_pk_bf16(pB[8 * q + 6], pB[8 * q + 7]); }
        pw[s4] = __builtin_bit_cast(bf16x8, w);
      }
      if (!grpB) ATT_PV(t & 3);
    }
  }
#undef ATT_PV
#undef ATT_STAGE
  const float il = 1.f / half_swap_add(l);
  bf16_t* Ow = O0 + (size_t)(wid * 32 + r32) * 1024;
#pragma unroll
  for (int g4 = 0; g4 < 4; ++g4) {
    u32x2 w0, w1;
    w0.x = cvt_pk_bf16(o0[4 * g4 + 0] * il, o0[4 * g4 + 1] * il); w0.y = cvt_pk_bf16(o0[4 * g4 + 2] * il, o0[4 * g4 + 3] * il);
    w1.x = cvt_pk_bf16(o1[4 * g4 + 0] * il, o1[4 * g4 + 1] * il); w1.y = cvt_pk_bf16(o1[4 * g4 + 2] * il, o1[4 * g4 + 3] * il);
    *(u32x2*)(Ow + 8 * g4 + 4 * hi) = w0;
    *(u32x2*)(Ow + 32 + 8 * g4 + 4 * hi) = w1;
  }
}
__device__ __forceinline__ void attn_unit2(const bf16_t* Q0a, const bf16_t* Q0b, const bf16_t* Kbase, const bf16_t* Vbase, const int nkeys, bf16_t* O0a, bf16_t* O0b, LAS unsigned char* lds) {
  const int tid = ltid(), lane = tid & 63, r32 = lane & 31, hi = lane >> 5;
  const int wid = __builtin_amdgcn_readfirstlane(tid >> 6);
  const int NTL = nkeys >> 6;
  __syncthreads();
  const bf16_t* ksrc = Kbase + (size_t)lane * 64 + wid * 8;
  const bf16_t* vsrc = Vbase + (size_t)(16 * (wid & 3) + (lane >> 2)) * 64 + (wid >> 2) * 32 + (lane & 3) * 8;
  const unsigned ldsb = (unsigned)(size_t)lds;
#define ATT_STAGE(t, slot) do { \
    glds16(ksrc + (size_t)(t) * 64 * 64, (unsigned)__builtin_amdgcn_readfirstlane(ldsb + (slot) * ATT_SLOT + wid * 1024)); \
    glds16(vsrc + (size_t)(t) * 64 * 64, (unsigned)__builtin_amdgcn_readfirstlane(ldsb + (slot) * ATT_SLOT + 8192 + wid * 1024)); } while (0)
  ATT_STAGE(0, 0);
  if (NTL > 1) ATT_STAGE(1, 1);
  bf16x8 qr[2][4];
  {
    const bf16_t* Qa = Q0a + (size_t)(wid * 32 + r32) * 512;
    const bf16_t* Qb2 = Q0b + (size_t)(wid * 32 + r32) * 512;
#pragma unroll
    for (int d0 = 0; d0 < 4; ++d0) { qr[0][d0] = *(const bf16x8*)(Qa + d0 * 16 + hi * 8); qr[1][d0] = *(const bf16x8*)(Qb2 + d0 * 16 + hi * 8); }
  }
  f32x16 o0[2], o1[2];
#pragma unroll
  for (int hh = 0; hh < 2; ++hh)
#pragma unroll
    for (int r = 0; r < 16; ++r) { o0[hh][r] = 0.f; o1[hh][r] = 0.f; }
  float m[2] = {-1e30f, -1e30f}, l[2] = {0.f, 0.f};
  const int koff = hi * 1024 + r32 * 16;
  const int voff = 8192 + ((lane >> 4) & 1) * 32 + (lane & 3) * 8 + (4 * hi + ((lane & 15) >> 2)) * 64;
  int slot = 0;
  for (int t = 0; t < NTL; ++t) {
    if (t + 1 < NTL) asm volatile("s_waitcnt vmcnt(2) lgkmcnt(0)\n\ts_barrier" ::: "memory"); else asm volatile("s_waitcnt vmcnt(0) lgkmcnt(0)\n\ts_barrier" ::: "memory");
    __builtin_amdgcn_sched_barrier(0);
    if (t + 2 < NTL) { const int s2 = (slot >= 1) ? slot - 1 : 2; ATT_STAGE(t + 2, s2); }
    const lds_cptr kp = (lds_cptr)(lds + slot * ATT_SLOT + koff);
    const lds_cptr vp = (lds_cptr)(lds + slot * ATT_SLOT + voff);
    f32x16 pA[2], pB[2];
#pragma unroll
    for (int hh = 0; hh < 2; ++hh)
#pragma unroll
      for (int r = 0; r < 16; ++r) { pA[hh][r] = 0.f; pB[hh][r] = 0.f; }
#pragma unroll
    for (int d0 = 0; d0 < 4; ++d0) {
      const bf16x8 k0 = *(const LAS bf16x8*)(kp + d0 * 2048), k1 = *(const LAS bf16x8*)(kp + d0 * 2048 + 512);
#pragma unroll
      for (int hh = 0; hh < 2; ++hh) {
        pA[hh] = __builtin_amdgcn_mfma_f32_32x32x16_bf16(k0, qr[hh][d0], pA[hh], 0, 0, 0);
        pB[hh] = __builtin_amdgcn_mfma_f32_32x32x16_bf16(k1, qr[hh][d0], pB[hh], 0, 0, 0);
      }
    }
    bf16x8 pw[2][4];
#pragma unroll
    for (int hh = 0; hh < 2; ++hh) {
      const float rm = rowmax32(pA[hh], pB[hh]);
      const float mn = __builtin_fmaxf(m[hh], rm);
      const float alpha = __builtin_amdgcn_exp2f(m[hh] - mn);
      m[hh] = mn;
      float ps = 0.f;
#pragma unroll
      for (int r = 0; r < 16; ++r) { pA[hh][r] = __builtin_amdgcn_exp2f(pA[hh][r] - mn); pB[hh][r] = __builtin_amdgcn_exp2f(pB[hh][r] - mn); ps += pA[hh][r] + pB[hh][r]; }
      l[hh] = l[hh] * alpha + ps;
#pragma unroll
      for (int r = 0; r < 16; ++r) { o0[hh][r] *= alpha; o1[hh][r] *= alpha; }
#pragma unroll
      for (int s4 = 0; s4 < 4; ++s4) {
        u32x4 w;
        if (s4 < 2) { w.x = cvt_pk_bf16(pA[hh][8 * s4 + 0], pA[hh][8 * s4 + 1]); w.y = cvt_pk_bf16(pA[hh][8 * s4 + 2], pA[hh][8 * s4 + 3]); w.z = cvt_pk_bf16(pA[hh][8 * s4 + 4], pA[hh][8 * s4 + 5]); w.w = cvt_pk_bf16(pA[hh][8 * s4 + 6], pA[hh][8 * s4 + 7]); }
        else { const int q = s4 - 2; w.x = cvt_pk_bf16(pB[hh][8 * q + 0], pB[hh][8 * q + 1]); w.y = cvt_pk_bf16(pB[hh][8 * q + 2], pB[hh][8 * q + 3]); w.z = cvt_pk_bf16(pB[hh][8 * q + 4], pB[hh][8 * q + 5]); w.w = cvt_pk_bf16(pB[hh][8 * q + 6], pB[hh][8 * q + 7]); }
        pw[hh][s4] = __builtin_bit_cast(bf16x8, w);
      }
    }
#pragma unroll
    for (int s4 = 0; s4 < 4; ++s4) {
      const s16x4 a0l = vtr(vp + s4 * 1024), a0h = vtr(vp + s4 * 1024 + 512);
      const s16x4 a1l = vtr(vp + 4096 + s4 * 1024), a1h = vtr(vp + 4096 + s4 * 1024 + 512);
      const bf16x8 a0 = {a0l[0], a0l[1], a0l[2], a0l[3], a0h[0], a0h[1], a0h[2], a0h[3]};
      const bf16x8 a1 = {a1l[0], a1l[1], a1l[2], a1l[3], a1h[0], a1h[1], a1h[2], a1h[3]};
#pragma unroll
      for (int hh = 0; hh < 2; ++hh) {
        o0[hh] = __builtin_amdgcn_mfma_f32_32x32x16_bf16(a0, pw[hh][s4], o0[hh], 0, 0, 0);
        o1[hh] = __builtin_amdgcn_mfma_f32_32x32x16_bf16(a1, pw[hh][s4], o1[hh], 0, 0, 0);
      }
    }
    slot = (slot == 2) ? 0 : slot + 1;
  }
#undef ATT_STAGE
#pragma unroll
  for (int hh = 0; hh < 2; ++hh) {
    const float il = 1.f / half_swap_add(l[hh]);
    bf16_t* Ow = (hh ? O0b : O0a) + (size_t)(wid * 32 + r32) * 1024;
#pragma unroll
    for (int g4 = 0; g4 < 4; ++g4) {
      u32x2 w0, w1;
      w0.x = cvt_pk_bf16(o0[hh][4 * g4 + 0] * il, o0[hh][4 * g4 + 1] * il); w0.y = cvt_pk_bf16(o0[hh][4 * g4 + 2] * il, o0[hh][4 * g4 + 3] * il);
      w1.x = cvt_pk_bf16(o1[hh][4 * g4 + 0] * il, o1[hh][4 * g4 + 1] * il); w1.y = cvt_pk_bf16(o1[hh][4 * g4 + 2] * il, o1[hh][4 * g4 + 3] * il);
      *(u32x2*)(Ow + 8 * g4 + 4 * hi) = w0;
      *(u32x2*)(Ow + 32 + 8 * g4 + 4 * hi) = w1;
    }
  }
}
__device__ __forceinline__ void ph_att(const Params& p, bool ctx_q, LAS unsigned char* lds) {
  const int c = lbid(), G = lgdim();
  const int nunits = 256 + (ctx_q ? 32 : 0);
  for (int L = c; L < nunits; L += G) {
    if (L < 256) {
      const int grp = (L & 7) * 2 + ((L >> 3) >> 4), within = (L >> 3) & 15;
      const int b = grp >> 1, kvh = grp & 1, h0 = kvh * 4 + 2 * (within >> 3), qt = within & 7;
      const size_t row0 = (size_t)b * 2048 + qt * 256;
      const size_t kvb = (size_t)(b * 2 + kvh) * 2304 * 64;
      attn_unit2(p.Qb + row0 * 512 + h0 * 64, p.Qb + row0 * 512 + (h0 + 1) * 64, p.Kb + kvb, p.Vb + kvb, 2304, p.mix + row0 * 1024 + h0 * 64, p.mix + row0 * 1024 + (h0 + 1) * 64, lds);
    } else {
      const int u = L - 256, b = u >> 2, kvh = (u >> 1) & 1, h0 = kvh * 4 + 2 * (u & 1);
      const size_t row0 = (size_t)NL + b * 256;
      const size_t kvb = (size_t)(b * 2 + kvh) * 2304 * 64;
      attn_unit2(p.Qb + row0 * 512 + h0 * 64, p.Qb + row0 * 512 + (h0 + 1) * 64, p.Kb + kvb, p.Vb + kvb, 256, p.mix + row0 * 1024 + h0 * 64, p.mix + row0 * 1024 + (h0 + 1) * 64, lds);
    }
  }
  __syncthreads();
}

__device__ __forceinline__ int chunk_row0(int b, int dir, int cc) {
  if (cc < 2) return NL + b * 256 + (dir ? 1 - cc : cc) * 128;
  return b * 2048 + (dir ? 15 - (cc - 2) : cc - 2) * 128;
}
__device__ __forceinline__ int trq_addr(int lane, int quarter, int rowbase) {
  return quarter * 8192 + ((lane >> 4) & 1) * 32 + (lane & 3) * 8 + (rowbase + ((lane & 15) >> 2)) * 64;
}
__device__ __forceinline__ bf16x8 cat44(const s16x4 a, const s16x4 b) { return (bf16x8){a[0], a[1], a[2], a[3], b[0], b[1], b[2], b[3]}; }

__device__ __forceinline__ void ph_mlstm_u(const Params& p, LAS unsigned char* lds) {
  const int tid = ltid(), lane = tid & 63, r32 = lane & 31, hi = lane >> 5;
  const int wid = __builtin_amdgcn_readfirstlane(tid >> 6);
  LAS float* WS = (LAS float*)(lds + 65536);
  LAS float* NP = (LAS float*)(lds + 66048);
  LAS float* E1T = (LAS float*)(lds + 68096);
  __syncthreads();
  if (tid < 64) {
    float be[18], gm[18];
#pragma unroll
    for (int c = 0; c < 18; ++c) { be[c] = p.cBE[tid * 18 + c]; gm[c] = p.cGM[tid * 18 + c]; }
    float m_in = -1e30f;
#pragma unroll
    for (int c = 0; c < 18; ++c) {
      const float m_next = fmaxf(m_in + be[c], be[c] + gm[c]);
      E1T[tid * 18 + c] = (be[c] - m_next) * LOG2E;
      if (lbid() == 0) { p.cMIN[tid * 18 + c] = m_in * LOG2E; p.cDEC[tid * 18 + c] = expf(m_in + be[c] - m_next); }
      m_in = m_next;
    }
  }
  __syncthreads();
  for (int unit = lbid(); unit < 64 * 17; unit += lgdim()) {
    const int chain = unit / 17, cc = unit % 17;
    const int b = chain >> 3, hd = (chain >> 1) & 3, dir = chain & 1;
    const int row0 = chunk_row0(b, dir, cc);
    __syncthreads();
#pragma unroll
    for (int n = 0; n < 4; ++n) {
      const int ii = wid * 4 + n, qd = ii >> 3, rg = ii & 7;
      const bf16_t* src = p.km + (size_t)(row0 + rg * 16 + (lane >> 2)) * 512 + hd * 128 + qd * 32 + (lane & 3) * 8;
      __builtin_amdgcn_global_load_lds((const unsigned*)src, (LAS unsigned*)(lds + qd * 8192 + rg * 1024), 16, 0, 0);
    }
    u32x4 vraw[4];
#pragma unroll
    for (int n = 0; n < 4; ++n) {
      const int o = (tid + n * NTHR) * 16, qd = o >> 13, row = (o >> 6) & 127, pc = (o >> 4) & 3;
      vraw[n] = *(const u32x4*)(p.proj + (size_t)(row0 + row) * PROJW + 1792 + hd * 128 + qd * 32 + pc * 8);
    }
    __builtin_amdgcn_sched_barrier(0);
    if (tid < 128) WS[tid] = __builtin_amdgcn_exp2f(p.gsG[(size_t)(row0 + tid) * 8 + dir * 4 + hd] + E1T[chain * 18 + cc]);
    __syncthreads();
#pragma unroll
    for (int n = 0; n < 4; ++n) {
      const int o = (tid + n * NTHR) * 16, row = (o >> 6) & 127;
      float f[8];
      unpack8(vraw[n], f);
      const float w = WS[row];
#pragma unroll
      for (int j = 0; j < 8; ++j) f[j] *= w;
      *(LAS u32x4*)(lds + 32768 + o) = pack8(f);
    }
    asm volatile("s_waitcnt vmcnt(0)" ::: "memory");
    __syncthreads();
    {
      const int d = tid & 127, part = tid >> 7;
      float acc = 0.f;
      for (int s2 = 0; s2 < 32; ++s2) {
        const int srow = part * 32 + s2;
        const bf16_t kv = *(const LAS bf16_t*)(lds + (d >> 5) * 8192 + srow * 64 + (d & 31) * 2);
        acc += WS[srow] * bf2f(kv);
      }
      NP[part * 128 + d] = acc;
    }
    const int eb = wid >> 1, db0 = 2 * (wid & 1);
    f32x16 u0, u1;
#pragma unroll
    for (int r = 0; r < 16; ++r) { u0[r] = 0.f; u1[r] = 0.f; }
#pragma unroll
    for (int ks = 0; ks < 8; ++ks) {
      const int rb = ks * 16 + 8 * hi;
      const bf16x8 a = cat44(vtr((lds_cptr)(lds + 32768 + trq_addr(lane, eb, rb))), vtr((lds_cptr)(lds + 32768 + trq_addr(lane, eb, rb + 4))));
      const bf16x8 b0 = cat44(vtr((lds_cptr)(lds + trq_addr(lane, db0, rb))), vtr((lds_cptr)(lds + trq_addr(lane, db0, rb + 4))));
      const bf16x8 b1 = cat44(vtr((lds_cptr)(lds + trq_addr(lane, db0 + 1, rb))), vtr((lds_cptr)(lds + trq_addr(lane, db0 + 1, rb + 4))));
      u0 = __builtin_amdgcn_mfma_f32_32x32x16_bf16(a, b0, u0, 0, 0, 0);
      u1 = __builtin_amdgcn_mfma_f32_32x32x16_bf16(a, b1, u1, 0, 0, 0);
    }
    float* U = p.Ubuf + ((size_t)chain * 17 + cc) * 16384;
#pragma unroll
    for (int r = 0; r < 16; ++r) {
      const int erow = eb * 32 + (r & 3) + 8 * (r >> 2) + 4 * hi;
      U[(size_t)erow * 128 + db0 * 32 + r32] = u0[r];
      U[(size_t)erow * 128 + (db0 + 1) * 32 + r32] = u1[r];
    }
    __syncthreads();
    if (tid < 128) p.NLb[((size_t)chain * 17 + cc) * 128 + tid] = NP[tid] + NP[128 + tid] + NP[256 + tid] + NP[384 + tid];
  }
  __syncthreads();
}

__device__ __forceinline__ void ph_mlstm_scan(const Params& p, int bskip) {
  const int bsk = lgdim() > bskip ? bskip : 0;
  if (lbid() < bsk) return;
  const size_t gtid = (size_t)(lbid() - bsk) * NTHR + ltid(), gsz = (size_t)(lgdim() - bsk) * NTHR;
  for (size_t it = gtid; it < (size_t)64 * 8192; it += gsz) {
    const int chain = (int)(it >> 13), ed = (int)(it & 8191) * 2;
    float c0 = 0.f, c1 = 0.f;
    float2 uu[17]; float dd[17];
#pragma unroll
    for (int c = 0; c < 17; ++c) { dd[c] = p.cDEC[chain * 18 + c]; uu[c] = *(const float2*)(p.Ubuf + ((size_t)chain * 17 + c) * 16384 + ed); }
    __builtin_amdgcn_sched_barrier(0);
#pragma unroll
    for (int c = 0; c < 17; ++c) {
      c0 = dd[c] * c0 + uu[c].x; c1 = dd[c] * c1 + uu[c].y;
      *(unsigned*)(p.Cbf + ((size_t)chain * 18 + c + 1) * 16384 + ed) = cvt_pk_bf16(c0, c1);
    }
  }
  for (size_t it = gtid; it < (size_t)64 * 128; it += gsz) {
    const int chain = (int)(it >> 7), d = (int)(it & 127);
    float nv = 0.f;
    float nn[17], dd[17];
#pragma unroll
    for (int c = 0; c < 17; ++c) { dd[c] = p.cDEC[chain * 18 + c]; nn[c] = p.NLb[((size_t)chain * 17 + c) * 128 + d]; }
    __builtin_amdgcn_sched_barrier(0);
#pragma unroll
    for (int c = 0; c < 17; ++c) {
      nv = dd[c] * nv + nn[c];
      p.NVb[((size_t)chain * 18 + c + 1) * 128 + d] = nv;
    }
  }
}

__device__ __forceinline__ void ph_mlstm_h(const Params& p, int l, bool ctx_out, LAS unsigned char* lds) {
  const int e2 = l >> 1;
  const int tid = ltid(), lane = tid & 63, r32 = lane & 31, hi = lane >> 5;
  const int wid = __builtin_amdgcn_readfirstlane(tid >> 6);
  const int tb = wid & 3, dir = wid >> 2;
  LAS float* HX = (LAS float*)(lds);
  LAS float* GC = (LAS float*)(lds + 131072);
  const int j0 = ctx_out ? 0 : 2, nj = 18 - j0;
  for (int unit = lbid(); unit < 32 * nj; unit += lgdim()) {
    const int bh = unit / nj, j = j0 + unit % nj, b = bh >> 2, hd = bh & 3;
    const int row0 = (j < 2) ? NL + b * 256 + j * 128 : b * 2048 + (j - 2) * 128;
    const int cc = dir ? (j < 2 ? 1 - j : 19 - j) : j;
    const int chain = b * 8 + hd * 2 + dir;
    __syncthreads();
#pragma unroll
    for (int n = 0; n < 4; ++n) {
      const int ii = wid * 4 + n;
      { const int ch = ii >> 1, rh = ii & 1;
        const bf16_t* src = p.km + (size_t)(row0 + rh * 64 + lane) * 512 + hd * 128 + ch * 8;
        __builtin_amdgcn_global_load_lds((const unsigned*)src, (LAS unsigned*)(lds + ch * 2048 + rh * 1024), 16, 0, 0); }
      { const int qd = ii >> 3, rg = ii & 7;
        const bf16_t* src = p.proj + (size_t)(row0 + rg * 16 + (lane >> 2)) * PROJW + 1792 + hd * 128 + qd * 32 + (lane & 3) * 8;
        __builtin_amdgcn_global_load_lds((const unsigned*)src, (LAS unsigned*)(lds + 32768 + qd * 8192 + rg * 1024), 16, 0, 0); }
    }
#pragma unroll
    for (int n = 0; n < 8; ++n) {
      const int ii2 = wid * 8 + n, dd = ii2 >> 5, ch = (ii2 & 31) >> 1, rh = ii2 & 1;
      const int ccd = dd ? (j < 2 ? 1 - j : 19 - j) : j;
      if (ccd > 0) {
        const bf16_t* src = p.Cbf + ((size_t)(b * 8 + hd * 2 + dd) * 18 + ccd) * 16384 + (size_t)(rh * 64 + lane) * 128 + ch * 8;
        __builtin_amdgcn_global_load_lds((const unsigned*)src, (LAS unsigned*)(lds + 65536 + dd * 32768 + ch * 2048 + rh * 1024), 16, 0, 0);
      }
    }
    const int trow = row0 + tb * 32 + r32;
    bf16x8 qf[8];
#pragma unroll
    for (int ks = 0; ks < 8; ++ks) qf[ks] = *(const bf16x8*)(p.qm + (size_t)trow * 512 + hd * 128 + ks * 16 + hi * 8);
    const float MIN2 = p.cMIN[chain * 18 + cc];
    const float R2 = -fmaxf(MIN2, p.gsR[(size_t)trow * 8 + dir * 4 + hd]), BQ2 = p.gsB[(size_t)trow * 8 + dir * 4 + hd];
    f32x16 acc[4];
#pragma unroll
    for (int eb = 0; eb < 4; ++eb)
#pragma unroll
      for (int r = 0; r < 16; ++r) acc[eb][r] = 0.f;
    float nq = 0.f;
    if (cc > 0) {
      const float* nvp = p.NVb + ((size_t)chain * 18 + cc) * 128 + hi * 8;
#pragma unroll
      for (int ks = 0; ks < 8; ++ks) {
        const f32x4 n0 = *(const f32x4*)(nvp + ks * 16), n1 = *(const f32x4*)(nvp + ks * 16 + 4);
        float qv[8];
        unpack8(__builtin_bit_cast(u32x4, qf[ks]), qv);
        nq += n0[0] * qv[0] + n0[1] * qv[1] + n0[2] * qv[2] + n0[3] * qv[3] + n1[0] * qv[4] + n1[1] * qv[5] + n1[2] * qv[6] + n1[3] * qv[7];
      }
      nq = half_swap_add(nq);
    }
    const float* gh = p.g_hnorm + e2 * 512 + hd * 128;
    const bf16_t* obp = p.proj + (size_t)trow * PROJW + 2304 + hd * 128;
    const float winter = __builtin_amdgcn_exp2f(MIN2 + R2);
    if (tid < 256) GC[tid] = p.gsG[(size_t)(row0 + (tid & 127)) * 8 + (tid >> 7) * 4 + hd];
    asm volatile("s_waitcnt vmcnt(0)" ::: "memory");
    __syncthreads();
    if (cc > 0) {
#pragma unroll
      for (int eb = 0; eb < 4; ++eb)
#pragma unroll
        for (int ks = 0; ks < 8; ++ks) {
          const bf16x8 a = *(const LAS bf16x8*)(lds + 65536 + dir * 32768 + (2 * ks + hi) * 2048 + (eb * 32 + r32) * 16);
          acc[eb] = __builtin_amdgcn_mfma_f32_32x32x16_bf16(a, qf[ks], acc[eb], 0, 0, 0);
        }
#pragma unroll
      for (int eb = 0; eb < 4; ++eb)
#pragma unroll
        for (int r = 0; r < 16; ++r) acc[eb][r] *= winter;
    }
    float sw = 0.f;
    const int sb_lo = dir ? tb : 0, sb_hi = dir ? 3 : tb;
    for (int sb = sb_lo; sb <= sb_hi; ++sb) {
      f32x16 st;
#pragma unroll
      for (int r = 0; r < 16; ++r) st[r] = 0.f;
#pragma unroll
      for (int ks = 0; ks < 8; ++ks) {
        const bf16x8 kf = *(const LAS bf16x8*)(lds + (2 * ks + hi) * 2048 + (sb * 32 + r32) * 16);
        st = __builtin_amdgcn_mfma_f32_32x32x16_bf16(kf, qf[ks], st, 0, 0, 0);
      }
      const bool diag = (sb == tb);
#pragma unroll
      for (int g4 = 0; g4 < 4; ++g4) {
        const f32x4 gc = *(const LAS f32x4*)(GC + dir * 128 + sb * 32 + 8 * g4 + 4 * hi);
#pragma unroll
        for (int q = 0; q < 4; ++q) {
          const int sl = 8 * g4 + 4 * hi + q;
          float w = __builtin_amdgcn_exp2f(R2 + gc[q]) * st[4 * g4 + q];
          const bool keep = !diag || (dir ? (sl >= r32) : (sl <= r32));
          w = keep ? w : 0.f;
          sw += w;
          st[4 * g4 + q] = w;
        }
      }
      u32x4 p0, p1;
      p0.x = cvt_pk_bf16(st[0], st[1]); p0.y = cvt_pk_bf16(st[2], st[3]); p0.z = cvt_pk_bf16(st[4], st[5]); p0.w = cvt_pk_bf16(st[6], st[7]);
      p1.x = cvt_pk_bf16(st[8], st[9]); p1.y = cvt_pk_bf16(st[10], st[11]); p1.z = cvt_pk_bf16(st[12], st[13]); p1.w = cvt_pk_bf16(st[14], st[15]);
      const bf16x8 pw0 = __builtin_bit_cast(bf16x8, p0), pw1 = __builtin_bit_cast(bf16x8, p1);
#pragma unroll
      for (int eb = 0; eb < 4; ++eb) {
        const int rb = sb * 32 + 4 * hi;
        const bf16x8 a0 = cat44(vtr((lds_cptr)(lds + 32768 + trq_addr(lane, eb, rb))), vtr((lds_cptr)(lds + 32768 + trq_addr(lane, eb, rb + 8))));
        const bf16x8 a1 = cat44(vtr((lds_cptr)(lds + 32768 + trq_addr(lane, eb, rb + 16))), vtr((lds_cptr)(lds + 32768 + trq_addr(lane, eb, rb + 24))));
        acc[eb] = __builtin_amdgcn_mfma_f32_32x32x16_bf16(a0, pw0, acc[eb], 0, 0, 0);
        acc[eb] = __builtin_amdgcn_mfma_f32_32x32x16_bf16(a1, pw1, acc[eb], 0, 0, 0);
      }
    }
    sw = half_swap_add(sw);
    const float den = winter * nq + sw;
    const float dn = fmaxf(fabsf(den), __builtin_amdgcn_exp2f(R2 - BQ2));
    const float idn = 1.f / dn;
    __syncthreads();
    if (dir == 1) {
#pragma unroll
      for (int eb = 0; eb < 4; ++eb)
#pragma unroll
        for (int r = 0; r < 16; ++r) HX[(tb * 128 + eb * 32 + (r & 3) + 8 * (r >> 2) + 4 * hi) * 32 + r32] = acc[eb][r] * idn;
    }
    __syncthreads();
    if (dir == 0) {
      float ss = 0.f;
#pragma unroll
      for (int eb = 0; eb < 4; ++eb)
#pragma unroll
        for (int r = 0; r < 16; ++r) {
          const float v = acc[eb][r] * idn + HX[(tb * 128 + eb * 32 + (r & 3) + 8 * (r >> 2) + 4 * hi) * 32 + r32];
          acc[eb][r] = v; ss += v * v;
        }
      ss = half_swap_add(ss);
      const float inv = rsqrtf(ss * (1.f / 128.f) + EPS);
      bf16_t* op = p.mix + (size_t)trow * 1024 + 512 + hd * 128;
#pragma unroll
      for (int eb = 0; eb < 4; ++eb) {
        f32x4 gv[4]; u32x2 ow[4];
#pragma unroll
        for (int g4 = 0; g4 < 4; ++g4) { const int e0 = eb * 32 + 8 * g4 + 4 * hi; gv[g4] = *(const f32x4*)(gh + e0); ow[g4] = *(const u32x2*)(obp + e0); }
#pragma unroll
        for (int g4 = 0; g4 < 4; ++g4) {
          const int e0 = eb * 32 + 8 * g4 + 4 * hi;
          const float ob0 = __uint_as_float(ow[g4].x << 16), ob1 = __uint_as_float(ow[g4].x & 0xffff0000u), ob2 = __uint_as_float(ow[g4].y << 16), ob3 = __uint_as_float(ow[g4].y & 0xffff0000u);
          const float v0 = acc[eb][4 * g4 + 0] * inv * gv[g4][0] * sigmoidf_(ob0), v1 = acc[eb][4 * g4 + 1] * inv * gv[g4][1] * sigmoidf_(ob1);
          const float v2 = acc[eb][4 * g4 + 2] * inv * gv[g4][2] * sigmoidf_(ob2), v3 = acc[eb][4 * g4 + 3] * inv * gv[g4][3] * sigmoidf_(ob3);
          u32x2 w; w.x = cvt_pk_bf16(v0, v1); w.y = cvt_pk_bf16(v2, v3);
          *(u32x2*)(op + e0) = w;
        }
      }
    }
  }
  __syncthreads();
}

template <int EPL>
__device__ __forceinline__ void topk_column(const Params& p, const float* col, int e, int base, int cap, size_t mbase, int lane) {
  unsigned v[EPL];
#pragma unroll
  for (int k = 0; k < EPL; ++k) v[k] = __float_as_uint(col[k * 64 + lane]);
  unsigned thr = 0u;
  for (int bit = 30; bit >= 0; --bit) {
    const unsigned cand = thr | (1u << bit);
    unsigned c = 0;
#pragma unroll
    for (int k = 0; k < EPL; ++k) c += (v[k] >= cand) ? 1u : 0u;
#pragma unroll
    for (int o = 32; o > 0; o >>= 1) c += __shfl_xor(c, o);
    if (c >= (unsigned)cap) thr = cand;
  }
  unsigned totgt = 0;
#pragma unroll
  for (int k = 0; k < EPL; ++k) totgt += (unsigned)__popcll(__ballot(v[k] > thr));
  const unsigned need_eq = (unsigned)cap - totgt;
  unsigned cg = 0, ce = 0;
#pragma unroll
  for (int k = 0; k < EPL; ++k) {
    const bool gt = v[k] > thr, eq = v[k] == thr;
    const unsigned long long bg = __ballot(gt), be = __ballot(eq);
    const unsigned gtb = cg + __builtin_amdgcn_mbcnt_hi((unsigned)(bg >> 32), __builtin_amdgcn_mbcnt_lo((unsigned)bg, 0u));
    const unsigned eqb = ce + __builtin_amdgcn_mbcnt_hi((unsigned)(be >> 32), __builtin_amdgcn_mbcnt_lo((unsigned)be, 0u));
    const bool take = gt || (eq && eqb < need_eq);
    const int r = base + k * 64 + lane;
    const unsigned slot = gtb + (eqb < need_eq ? eqb : need_eq);
    if (take) { p.slotmap[(size_t)r * 16 + e] = (int)slot; p.rowidx[mbase + slot] = r; p.gatev[mbase + slot] = __uint_as_float(v[k]); }
    else p.slotmap[(size_t)r * 16 + e] = -1;
    cg += (unsigned)__popcll(bg); ce += (unsigned)__popcll(be);
  }
}
__device__ __forceinline__ void ph_topk(const Params& p, bool ctx, float* sm) {
  const int tid = ltid(), lane = tid & 63, wv = tid >> 6;
  const int ntask = ctx ? 32 : 16;
  for (int task = lbid(); task < ntask; task += lgdim()) {
    const bool lat = task < 16;
    const int b = (task >> 1) & 7, eh = task & 1, n = lat ? 2048 : 256, cap = lat ? 256 : 32, base = lat ? b * 2048 : NL + b * 256;
    __syncthreads();
    for (int idx0 = tid; idx0 < n * 2; idx0 += 8 * NTHR) {
      float4 a[8];
#pragma unroll
      for (int u = 0; u < 8; ++u) { const int idx = min(idx0 + u * NTHR, n * 2 - 1); a[u] = *(const float4*)(p.aff + (size_t)(base + (idx >> 1)) * 16 + eh * 8 + (idx & 1) * 4); }
      __builtin_amdgcn_sched_barrier(0);
#pragma unroll
      for (int u = 0; u < 8; ++u) {
        const int idx = idx0 + u * NTHR, row = idx >> 1, q = idx & 1;
        if (idx < n * 2) { sm[(q * 4 + 0) * n + row] = a[u].x; sm[(q * 4 + 1) * n + row] = a[u].y; sm[(q * 4 + 2) * n + row] = a[u].z; sm[(q * 4 + 3) * n + row] = a[u].w; }
      }
    }
    __syncthreads();
    {
      const int e = eh * 8 + wv;
      if (lat) topk_column<32>(p, sm + wv * n, e, base, cap, (size_t)e * 2048 + (size_t)b * 256, lane);
      else topk_column<4>(p, sm + wv * n, e, base, cap, (size_t)MOE_L + (size_t)e * 256 + (size_t)b * 32, lane);
    }
  }
  __syncthreads();
}

template <int W>
__device__ __forceinline__ void pool_item(const Params& p, int r, int c8) {
  int t, n;
  if (r < NL) { t = r & 2047; n = 2048; } else { t = (r - NL) & 255; n = 256; }
  constexpr int lo = W / 2;
  const bf16_t* up = p.proj + (size_t)r * 1024 + c8;
  u32x4 raw[W];
  int cnt = 0;
#pragma unroll
  for (int k = 0; k < W; ++k) {
    const int tt = t - lo + k;
    const bool ok = tt >= 0 && tt < n;
    const int tc = tt < 0 ? 0 : (tt >= n ? n - 1 : tt);
    const u32x4 ld = *(const u32x4*)(up + (ptrdiff_t)(tc - t) * 1024);
    raw[k].x = ok ? ld.x : 0u; raw[k].y = ok ? ld.y : 0u; raw[k].z = ok ? ld.z : 0u; raw[k].w = ok ? ld.w : 0u;
    cnt += ok ? 1 : 0;
  }
  float s8[8], f[8], uc[8];
#pragma unroll
  for (int j = 0; j < 8; ++j) s8[j] = 0.f;
#pragma unroll
  for (int k = 0; k < W; ++k) {
    unpack8(raw[k], f);
#pragma unroll
    for (int j = 0; j < 8; ++j) s8[j] += f[j];
  }
  unpack8(raw[lo], uc);
  const float ic = 1.f / (float)cnt;
#pragma unroll
  for (int j = 0; j < 8; ++j) f[j] = s8[j] * ic - uc[j];
  *(u32x4*)(p.mix + (size_t)r * 1024 + c8) = pack8(f);
}
__device__ __forceinline__ void ph_pool(const Params& p, int nrows) {
  const size_t gtid = (size_t)lbid() * NTHR + ltid(), gsz = (size_t)lgdim() * NTHR;
  for (size_t it = gtid; it < (size_t)nrows * 128; it += gsz) {
    const int g = (int)(it / ((size_t)nrows * 32));
    const size_t rem = it - (size_t)g * nrows * 32;
    const int r = (int)(rem >> 5), c8 = g * 256 + (int)(rem & 31) * 8;
    if (g == 0) pool_item<2>(p, r, c8);
    else if (g == 1) pool_item<4>(p, r, c8);
    else if (g == 2) pool_item<8>(p, r, c8);
    else pool_item<16>(p, r, c8);
  }
}

enum { PH_INIT = 0, PH_NORM1, PH_GEMM_IN_EVEN, PH_POST_EVEN, PH_ATT, PH_MLSTM_U, PH_MLSTM_SCAN, PH_MLSTM_H, PH_GEMM_OUT, PH_NORM2, PH_TOPK, PH_GATHER,
       PH_MOE_GU, PH_MOE_D, PH_GEMM_IN_ODD, PH_POOL, PH_GEMM_GRP, PH_FINAL };

typedef const __attribute__((address_space(4))) Params* KParams;
__device__ __forceinline__ const Params& get_params() {
  KParams kp = (KParams)__builtin_amdgcn_kernarg_segment_ptr();
  asm volatile("" : "+s"(kp));
  return *(const Params*)kp;
}
__device__ __forceinline__ int idle_slots(int nu, int G, int c) {
  const int mx = (nu + G - 1) / G, mine = c < nu ? (nu - c + G - 1) / G : 0;
  return mx - mine;
}
__device__ __forceinline__ void run_phase(int ph, int l, unsigned char* shm) {
  const Params& p = get_params();
  float* sm = (float*)shm;
  LAS unsigned char* lds = (LAS unsigned char*)shm;
  const bool ctx_next = (l < 2);
  const bool ctx_used = (l < 3);
  const int G = lgdim(), c = lbid();
  switch (ph) {
    case PH_INIT: ph_init(p, sm); break;
    case PH_NORM1: {
      const int ncomb = (l == 0) ? 0 : ((l - 1) < 2 ? NT : NL);
      ph_norm(p, l, 1, ctx_used ? NT : NL, ncomb, l - 1, sm);
    } break;
    case PH_GEMM_IN_EVEN: {
      g8::SchedDense S{(const char*)p.hbuf, (const char*)(p.WinE + (size_t)(l >> 1) * PROJW * 1024), 1024, 1024, NT / 256, PROJW / 256, 0, G, c};
      g8::EpiBf16 E{p.proj, PROJW};
      g8::gemm_phase(lds, 1024, 1024, 1024, S, E);
      conv_quota(p, idle_slots(S.nM * S.nN, G, c) * 3, sm);
    } break;
    case PH_POST_EVEN: ph_post_even(p, l, sm); break;
    case PH_MLSTM_U: ph_mlstm_u(p, lds); break;
    case PH_ATT: ph_att(p, ctx_next, lds); ph_mlstm_scan(p, ctx_next ? 32 : 0); conv_quota(p, idle_slots(256 + (ctx_next ? 32 : 0), G, c) * 1, sm); break;
    case PH_MLSTM_H: ph_mlstm_h(p, l, ctx_next, lds); conv_quota(p, idle_slots(32 * (ctx_next ? 18 : 16), G, c) * 3, sm); break;
    case PH_GEMM_OUT: {
      g8::SchedDense S{(const char*)p.mix, (const char*)(p.WoutE + (size_t)(l >> 1) * 1024 * 1024), 1024, 1024, (ctx_next ? NT : NL) / 256, 4, 0, G, c};
      g8::EpiBf16 E{p.ybuf, 1024};
      g8::gemm_phase(lds, 1024, 1024, 1024, S, E);
      conv_quota(p, idle_slots(S.nM * S.nN, G, c) * 3, sm);
    } break;
    case PH_NORM2: ph_norm(p, l, 2, ctx_next ? NT : NL, 0, 0, sm); break;
    case PH_TOPK: ph_topk(p, ctx_next, sm); conv_until(p, l == 0 ? CE4 : (l == 1 ? CE7 : (l == 2 ? CE10 : CE11)), sm); break;
    case PH_MOE_GU: {
      g8::SchedMoe S{(const char*)p.Xs, (const char*)(p.Wgu + (size_t)l * NEXP * 2048 * 1024), 8, 2048, 128, ctx_next ? 1152 : 1024, G, c};
      g8::EpiSwiGLU E{p.Abuf};
      g8::gemm_phase<true>(lds, 1024, 1024, 1024, S, E, p.rowidx, (const char*)p.hbuf);
      conv_quota(p, idle_slots(S.nu, G, c) * 3, sm);
    } break;
    case PH_MOE_D: {
      g8::SchedMoe S{(const char*)p.Abuf, (const char*)(p.Wd + (size_t)l * NEXP * 1024 * 1024), 4, 1024, 256, ctx_next ? 576 : 512, G, c};
      g8::EpiDown E{p.Ybuf, p.gatev};
      g8::gemm_phase(lds, 1024, 1024, 1024, S, E);
      conv_quota(p, idle_slots(S.nu, G, c) * 3, sm);
    } break;
    case PH_GEMM_IN_ODD: {
      g8::SchedDense S{(const char*)p.hbuf, (const char*)(p.WinO + (size_t)(l >> 1) * 1024 * 1024), 1024, 1024, (ctx_next ? NT : NL) / 256, 4, 0, G, c};
      g8::EpiBf16 E{p.proj, 1024};
      g8::gemm_phase(lds, 1024, 1024, 1024, S, E);
      conv_quota(p, idle_slots(S.nM * S.nN, G, c) * 3, sm);
    } break;
    case PH_POOL: ph_pool(p, ctx_next ? NT : NL); break;
    case PH_GEMM_GRP: {
      g8::SchedDense S{(const char*)p.mix, (const char*)(p.Wgrp + (size_t)(l >> 1) * 1024 * 256), 1024, 256, (ctx_next ? NT : NL) / 256, 4, 512, G, c};
      g8::EpiBf16 E{p.ybuf, 1024};
      g8::gemm_phase(lds, 256, 1024, 256, S, E);
      conv_quota(p, idle_slots(S.nM * S.nN, G, c) * 1, sm);
    } break;
    case PH_FINAL: ph_norm(p, 3, 3, NL, NL, 3, sm); break;
  }
}

__global__ void __launch_bounds__(NTHR) mega_kernel(Params p) {
  extern __shared__ __attribute__((aligned(16))) unsigned char shm[];
  cg::grid_group grid = cg::this_grid();
  volatile LAS unsigned* st = (volatile LAS unsigned*)((LAS unsigned char*)shm + g8::STAGE_BYTES + 1536);
  if (threadIdx.x < 2) st[threadIdx.x] = 0u;
  __syncthreads();
  unsigned* barw;
  { const Params& q = get_params(); barw = q.barw; }
  const XcdBarrier xb = xcd_barrier_post(barw, st);
  const int nprog = p.nprog;
  for (int i = 0; i < nprog; ++i) {
    int ph, l;
    { const Params& q = get_params(); ph = q.prog_ph[i]; l = q.prog_l[i]; }
    run_phase(ph, l, shm);
    if (i + 1 < nprog) { if (nprog > 1000) grid.sync(); else xcd_barrier(xb); }
  }
}

extern "C" void kernel_launch(void* const* d_in, const int* in_sizes, int n_in, void* d_out, int out_size, void* d_ws, size_t ws_size,
                              hipStream_t stream) {
  Params p{};
  const float* const* in = (const float* const*)d_in;
  p.x = in[0]; p.c = in[1]; p.ctx = in[2]; p.c_ctx = in[3]; p.w_mod = in[4]; p.b_mod = in[5]; p.g_norm1 = in[6]; p.g_norm2 = in[7];
  p.w_in_even = in[8]; p.w_out_even = in[9]; p.g_qnorm = in[10]; p.g_knorm = in[11]; p.w_conv = in[12]; p.b_gate = in[13];
  p.g_hnorm = in[14]; p.w_in_odd = in[15]; p.w_pool_grp = in[16]; p.s_pool = in[17]; p.w_router = in[18]; p.w_exp_gate = in[19];
  p.w_exp_up = in[20]; p.w_exp_down = in[21]; p.g_final = in[22];
  p.out = (float*)d_out;
  char* w = (char*)d_ws;
  size_t off = 0;
  auto take = [&](size_t bytes) { char* r = w + off; off += (bytes + 255) & ~(size_t)255; return (void*)r; };
  p.xcur = (float*)take((size_t)NT * 1024 * 4);
  p.mod = (float*)take(4 * 9 * 6144 * 4);
  p.hbuf = (bf16_t*)take((size_t)NT * 1024 * 2);
  p.Ybuf = (bf16_t*)take((size_t)MOE_T * 1024 * 2);
  p.gatev = (float*)take(MOE_T * 4);
  p.rowidx = (int*)take(MOE_T * 4);
  p.slotmap = (int*)take((size_t)NT * 16 * 4);
  p.barw = (unsigned*)take(XCD_BAR_WORDS * 4);
  p.aff = (float*)take((size_t)NT * 16 * 4);
  p.gates = (float*)take((size_t)NT * 16 * 4);
  p.WinE = (bf16_t*)take((size_t)2 * PROJW * 1024 * 2);
  p.WoutE = (bf16_t*)take((size_t)2 * 1024 * 1024 * 2);
  p.WinO = (bf16_t*)take((size_t)2 * 1024 * 1024 * 2);
  p.Wgrp = (bf16_t*)take((size_t)2 * 1024 * 256 * 2);
  p.Wgu = (bf16_t*)take((size_t)4 * NEXP * 2048 * 1024 * 2);
  p.Wd = (bf16_t*)take((size_t)4 * NEXP * 1024 * 1024 * 2);
  const size_t uoff = off;
  p.proj = (bf16_t*)take((size_t)NT * PROJW * 2);
  p.Qb = (bf16_t*)take((size_t)NT * 512 * 2);
  p.Kb = (bf16_t*)take((size_t)NB * 2 * 2304 * 64 * 2);
  p.Vb = (bf16_t*)take((size_t)NB * 2 * 2304 * 64 * 2);
  p.qm = (bf16_t*)take((size_t)NT * 512 * 2);
  p.km = (bf16_t*)take((size_t)NT * 512 * 2);
  p.gsG = (float*)take((size_t)NT * 8 * 4);
  p.gsR = (float*)take((size_t)NT * 8 * 4);
  p.gsB = (float*)take((size_t)NT * 8 * 4);
  p.cMIN = (float*)take(64 * 18 * 4);
  p.cE1 = (float*)take(64 * 18 * 4);
  p.cDEC = (float*)take(64 * 18 * 4);
  p.cBE = (float*)take(64 * 18 * 4);
  p.cGM = (float*)take(64 * 18 * 4);
  p.Ubuf = (float*)take((size_t)64 * 17 * 16384 * 4);
  p.NLb = (float*)take((size_t)64 * 17 * 128 * 4);
  p.NVb = (float*)take((size_t)64 * 18 * 128 * 4);
  p.Cbf = (bf16_t*)take((size_t)64 * 18 * 16384 * 2);
  p.mix = (bf16_t*)take((size_t)NT * 1024 * 2);
  p.ybuf = (bf16_t*)take((size_t)NT * 1024 * 2);
  const size_t uend = off;
  off = uoff;
  p.Xs = (bf16_t*)take((size_t)MOE_T * 1024 * 2);
  p.Abuf = (bf16_t*)take((size_t)MOE_T * 1024 * 2);
  if (off < uend) off = uend;
  if (off > ws_size) { fprintf(stderr, "ws too small: need %zu have %zu\n", off, ws_size); return; }

  int n = 0;
  auto add = [&](int ph, int l) { p.prog_ph[n] = (unsigned char)ph; p.prog_l[n] = (unsigned char)l; ++n; };
  add(PH_INIT, 0);
  for (int l = 0; l < 4; ++l) {
    add(PH_NORM1, l);
    if ((l & 1) == 0) {
      add(PH_GEMM_IN_EVEN, l); add(PH_POST_EVEN, l); add(PH_MLSTM_U, l); add(PH_ATT, l); add(PH_MLSTM_H, l); add(PH_GEMM_OUT, l);
    } else {
      add(PH_GEMM_IN_ODD, l); add(PH_POOL, l); add(PH_GEMM_GRP, l);
    }
    add(PH_NORM2, l); add(PH_TOPK, l); add(PH_MOE_GU, l); add(PH_MOE_D, l);
  }
  add(PH_FINAL, 0);
  p.nprog = n;

  const int LDS = g8::STAGE_BYTES + 2048;
  static int grid_blocks = 0;
  if (!grid_blocks) {
    (void)hipFuncSetAttribute((const void*)mega_kernel, hipFuncAttributeMaxDynamicSharedMemorySize, LDS);
    int dev = 0, cus = 0, per_cu = 0;
    (void)hipGetDevice(&dev);
    (void)hipDeviceGetAttribute(&cus, hipDeviceAttributeMultiprocessorCount, dev);
    (void)hipOccupancyMaxActiveBlocksPerMultiprocessor(&per_cu, mega_kernel, NTHR, LDS);
    if (per_cu < 1) per_cu = 1;
    if (per_cu > 1) per_cu = 1;
    grid_blocks = cus * per_cu;
  }
  (void)hipMemsetAsync(p.barw, 0, XCD_BAR_WORDS * 4, stream);
  void* args[] = {&p};
  hipError_t e = hipLaunchCooperativeKernel((void*)mega_kernel, dim3(grid_blocks), dim3(NTHR), args, LDS, stream);
  if (e != hipSuccess) fprintf(stderr, "cooperative launch failed: %s (grid %d)\n", hipGetErrorString(e), grid_blocks);
}
```

```cpp
#include <hip/hip_runtime.h>
#include <hip/hip_cooperative_groups.h>
#include <math.h>
#include <stdio.h>
namespace cg = cooperative_groups;

#define DM 1024
#define NB 8
#define SEQ 2048
#define CTXL 256
#define NL (NB * SEQ)
#define NC (NB * CTXL)
#define NT (NL + NC)
#define EVEN_IN 2832
#define PROJW 2816
#define NEXP 16
#define MOE_L (NEXP * NB * 256)
#define MOE_C (NEXP * NB * 32)
#define MOE_T (MOE_L + MOE_C)
#define EPS 1e-6f
#define NTHR 512
#define LAS __attribute__((address_space(3)))

typedef unsigned short bf16_t;
typedef short bf16x8 __attribute__((ext_vector_type(8)));
typedef float f32x4 __attribute__((ext_vector_type(4)));
typedef unsigned u32x4 __attribute__((ext_vector_type(4)));
typedef unsigned u32x2 __attribute__((ext_vector_type(2)));

struct Params {
  const float *x, *c, *ctx, *c_ctx, *w_mod, *b_mod, *g_norm1, *g_norm2, *w_in_even, *w_out_even, *g_qnorm, *g_knorm,
      *w_conv, *b_gate, *g_hnorm, *w_in_odd, *w_pool_grp, *s_pool, *w_router, *w_exp_gate, *w_exp_up, *w_exp_down, *g_final;
  float* out;
  bf16_t* xcur;
  float *mod, *gates, *aff, *gatev, *gsG, *gsR, *gsB, *cMIN, *cE1, *cDEC, *cBE, *cGM, *Ubuf, *NLb, *NVb;
  bf16_t *hbuf, *proj, *mix, *Xs, *Abuf, *Ybuf, *Qb, *Kb, *Vb, *qm, *km, *Cbf, *ybuf;
  bf16_t *WinE, *WoutE, *WinO, *Wgrp, *Wgu, *Wd;
  int *rowidx, *slotmap;
  unsigned* barw;
  int nprog;
  unsigned char prog_ph[60], prog_l[60];
};

__device__ __forceinline__ float siluf(float v) { return v / (1.f + expf(-v)); }
__device__ __forceinline__ float sigmoidf_(float v) { return 1.f / (1.f + expf(-v)); }
__device__ __forceinline__ float logsigmoidf_(float v) { return fminf(v, 0.f) - __logf(1.f + __expf(-fabsf(v))); }
__device__ __forceinline__ float wave_sum(float v) {
#pragma unroll
  for (int o = 32; o > 0; o >>= 1) v += __shfl_xor(v, o);
  return v;
}
#define LDS_BARRIER() do { asm volatile("s_waitcnt lgkmcnt(0)" ::: "memory"); __builtin_amdgcn_s_barrier(); asm volatile("" ::: "memory"); } while (0)
__device__ __forceinline__ int modrow(int r) { return r < NL ? (r >> 11) : 8; }
__device__ __forceinline__ float bf2f(bf16_t v) { return __uint_as_float(((unsigned)v) << 16); }
typedef float f32x2_t __attribute__((ext_vector_type(2)));
typedef __bf16 bf16x2_t __attribute__((ext_vector_type(2)));
__device__ __forceinline__ unsigned cvt_pk_bf16(float lo, float hi) {
  const f32x2_t v = {lo, hi};
  return __builtin_bit_cast(unsigned, __builtin_convertvector(v, bf16x2_t));
}
__device__ __forceinline__ bf16_t f2bf(float f) { return (bf16_t)(cvt_pk_bf16(f, 0.f) & 0xffffu); }
__device__ __forceinline__ void unpack8(const u32x4 w, float (&f)[8]) {
  f[0] = __uint_as_float(w.x << 16); f[1] = __uint_as_float(w.x & 0xffff0000u); f[2] = __uint_as_float(w.y << 16); f[3] = __uint_as_float(w.y & 0xffff0000u);
  f[4] = __uint_as_float(w.z << 16); f[5] = __uint_as_float(w.z & 0xffff0000u); f[6] = __uint_as_float(w.w << 16); f[7] = __uint_as_float(w.w & 0xffff0000u);
}
__device__ __forceinline__ u32x4 pack8(const float (&f)[8]) {
  u32x4 w; w.x = cvt_pk_bf16(f[0], f[1]); w.y = cvt_pk_bf16(f[2], f[3]); w.z = cvt_pk_bf16(f[4], f[5]); w.w = cvt_pk_bf16(f[6], f[7]);
  return w;
}

__device__ __forceinline__ int ltid() { int t = threadIdx.x; asm volatile("" : "+v"(t)); return t; }
__device__ __forceinline__ int lbid() { int b = blockIdx.x; asm volatile("" : "+s"(b)); return b; }
__device__ __forceinline__ int lgdim() { int g = gridDim.x; asm volatile("" : "+s"(g)); return g; }

#define XB_TMO      128
#define XB_XCNT(j)  (256  + 64 * (j))
#define XB_XSUB(j)  (1280 + 64 * (j))
#define XB_XGEN(j)  (2304 + 64 * (j))
#define XB_TOP      3328
#define XB_TOPGEN   3392
#define XCD_BAR_WORDS 3456
#define XB_SPIN_CAP (1u << 18)
__device__ __forceinline__ unsigned xb_ld(unsigned* p)              { return __hip_atomic_load(p, __ATOMIC_RELAXED, __HIP_MEMORY_SCOPE_AGENT); }
__device__ __forceinline__ unsigned xb_add(unsigned* p, unsigned v) { return __hip_atomic_fetch_add(p, v, __ATOMIC_RELAXED, __HIP_MEMORY_SCOPE_AGENT); }
__device__ __forceinline__ unsigned xb_xcc_id() { return (unsigned)__builtin_amdgcn_s_getreg((3 << 11) | 20) & 0xFu; }
#define XB_SPIN(cond, bar) do { unsigned _sp = 0; while (cond) { __builtin_amdgcn_s_sleep(1); \
    if ((++_sp & 255u) == 0u) { if (xb_ld(&(bar)[XB_TMO])) break; if (_sp > XB_SPIN_CAP) { atomicAdd(&(bar)[XB_TMO], 1u); break; } } } } while (0)
struct XcdBarrier { unsigned* bar; unsigned x; volatile LAS unsigned* st; };
__device__ __forceinline__ XcdBarrier xcd_barrier_post(unsigned* bar, volatile LAS unsigned* st) {
  XcdBarrier b; b.bar = bar; b.x = xb_xcc_id(); b.st = st;
  if (threadIdx.x == 0) (void)xb_add(&bar[XB_XCNT(b.x)], 1u);
  return b;
}
__device__ __forceinline__ void xcd_barrier_complete(unsigned* bar, unsigned x, unsigned& nloc, unsigned& nx) {
  const unsigned G = gridDim.x * gridDim.y * gridDim.z;
  unsigned sum, cnt, mine, sp = 0u;
  for (;;) {
    sum = 0u; cnt = 0u; mine = 0u;
#pragma unroll
    for (unsigned j = 0; j < 16; ++j) { const unsigned c = xb_ld(&bar[XB_XCNT(j)]); sum += c; cnt += (c > 0u) ? 1u : 0u; mine = (j == x) ? c : mine; }
    if (sum == G) break;
    __builtin_amdgcn_s_sleep(1);
    if ((++sp & 255u) == 0u) { if (xb_ld(&bar[XB_TMO])) break; if (sp > XB_SPIN_CAP) { atomicAdd(&bar[XB_TMO], 1u); break; } }
  }
  nloc = mine > 0u ? mine : 1u; nx = cnt > 0u ? cnt : 1u;
}
__device__ __forceinline__ void xcd_barrier(const XcdBarrier& b) {
  asm volatile("s_waitcnt vmcnt(0)" ::: "memory");
  __syncthreads();
  if (threadIdx.x == 0) {
    unsigned* bar = b.bar;
    __builtin_amdgcn_s_waitcnt(0);
    unsigned nloc = b.st[0], nx = b.st[1];
    if (nloc == 0u) { xcd_barrier_complete(bar, b.x, nloc, nx); b.st[0] = nloc; b.st[1] = nx; }
    const unsigned old = xb_add(&bar[XB_XSUB(b.x)], 1u);
    const unsigned gen = old / nloc;
    if (old + 1u == (gen + 1u) * nloc) {
      __builtin_amdgcn_fence(__ATOMIC_RELEASE, "agent");
      asm volatile("s_waitcnt vmcnt(0)" ::: "memory");
      const unsigned og = xb_add(&bar[XB_TOP], 1u);
      const unsigned tg = og / nx;
      if (og + 1u == (tg + 1u) * nx) xb_add(&bar[XB_TOPGEN], 1u);
      else XB_SPIN(xb_ld(&bar[XB_TOPGEN]) == tg, bar);
      __builtin_amdgcn_fence(__ATOMIC_ACQUIRE, "agent");
      xb_add(&bar[XB_XGEN(b.x)], 1u);
      asm volatile("s_waitcnt vmcnt(0)" ::: "memory");
    } else {
      XB_SPIN(xb_ld(&bar[XB_XGEN(b.x)]) == gen, bar);
      __builtin_amdgcn_fence(__ATOMIC_ACQUIRE, "agent");
      asm volatile("s_waitcnt vmcnt(0)" ::: "memory");
    }
  }
  __syncthreads();
}

namespace g8 {
constexpr int BM = 256, BK = 64, HALF = 128, HTB = HALF * BK * 2, STAGE_BYTES = 8 * HTB;
__device__ __forceinline__ int lds_byte(int r, int c) { const int st = (r >> 4) * 2 + (c >> 5), rr = r & 15, cc = c & 31, ob = rr * 64 + cc * 2; return st * 1024 + (ob ^ (((ob >> 9) & 1) << 5)); }
__device__ __forceinline__ void stage_rc(int b, int& R, int& C) { const int st = b / 1024, sb = b % 1024, swz = sb ^ (((sb >> 9) & 1) << 5); R = (st >> 1) * 16 + swz / 64; C = (st & 1) * 32 + (swz % 64) / 2; }
__device__ __forceinline__ int perm32(int rho) { const int n = rho >> 4, i = rho & 15; return 8 * (i >> 2) + 4 * n + (i & 3); }

struct Unit { const char* A; const char* B; int row0, col0; };

template <bool GATHER = false, class Epi, class Sched>
__device__ __forceinline__ void gemm_phase(LAS unsigned char* lds, const int K, const int lda, const int ldb, const Sched& S, const Epi& E, const int* gidx = nullptr, const char* gbaseA = nullptr) {
  const int tid = ltid(), wid = __builtin_amdgcn_readfirstlane(tid >> 6), lane = tid & 63, wr = wid >> 2, wc = wid & 3, fr = lane & 15, fq = lane >> 4;
  const int nt = K / BK;
  unsigned voffA[2], voffB[2], gC2[2];
  int gR[2];
#pragma unroll
  for (int i = 0; i < 2; ++i) {
    int R, C;
    stage_rc(tid * 16 + i * 8192, R, C);
    const int Rb = (R & ~31) + perm32(R & 31);
    voffA[i] = (unsigned)(R * lda + C) * 2u;
    voffB[i] = (unsigned)(Rb * ldb + C) * 2u;
    gR[i] = R; gC2[i] = (unsigned)C * 2u;
  }
  unsigned gcur[2][2], gnxt[2][2];
  auto gload = [&](int row0, unsigned (&g)[2][2]) {
#pragma unroll
    for (int h = 0; h < 2; ++h)
#pragma unroll
      for (int i = 0; i < 2; ++i) g[h][i] = (unsigned)gidx[row0 + h * HALF + gR[i]];
  };
  const size_t kstep = (size_t)(BK * 2);
  const size_t hstepA = (size_t)HALF * lda * 2, hstepB = (size_t)HALF * ldb * 2;
  const unsigned ldsw = (unsigned)wid * 1024u;
  const int aoff = lds_byte(wr * 64 + fr, fq * 8), boff = lds_byte(wc * 32 + fr, fq * 8);
#define PG8_SA(b, h) (((b) * 2 + (h)) * HTB)
#define PG8_SB(b, h) ((4 + (b) * 2 + (h)) * HTB)
#define PG8_STAGE(bufoff, gbase, voff) do { _Pragma("unroll") for (int _i = 0; _i < 2; ++_i) \
    __builtin_amdgcn_global_load_lds((const unsigned*)((const char*)(gbase) + (voff)[_i]), (LAS unsigned*)(lds + (bufoff) + ldsw + _i * 8192), 16, 0, 0); } while (0)
#define PG8_LDA(dst, b, h) do { _Pragma("unroll") for (int m = 0; m < 4; ++m) _Pragma("unroll") for (int k = 0; k < 2; ++k) dst[m][k] = *(const LAS bf16x8*)(lds + PG8_SA(b, h) + aoff + m * 2048 + k * 1024); } while (0)
#define PG8_LDB(dst, b, h) do { _Pragma("unroll") for (int n = 0; n < 2; ++n) _Pragma("unroll") for (int k = 0; k < 2; ++k) dst[n][k] = *(const LAS bf16x8*)(lds + PG8_SB(b, h) + boff + n * 2048 + k * 1024); } while (0)
#define PG8_MMA(ai, bj, At, Bt) do { __builtin_amdgcn_s_setprio(1); _Pragma("unroll") for (int m = 0; m < 4; ++m) _Pragma("unroll") for (int n = 0; n < 2; ++n) _Pragma("unroll") for (int k = 0; k < 2; ++k) \
    acc[ai][bj][m][n] = __builtin_amdgcn_mfma_f32_16x16x32_bf16(Bt[n][k], At[m][k], acc[ai][bj][m][n], 0, 0, 0); __builtin_amdgcn_s_setprio(0); } while (0)
#define PG8_WAIT_V(n) asm volatile("s_waitcnt vmcnt(" #n ")" ::: "memory")
#define PG8_WAIT_L(n) asm volatile("s_waitcnt lgkmcnt(" #n ")" ::: "memory")
#define PG8_BAR __builtin_amdgcn_s_barrier()
#define PG8_SCHED __builtin_amdgcn_sched_barrier(0)
#define PG8_STAGE_A(bufoff, nextu, half, kbytes) do { \
    if constexpr (GATHER) { unsigned go_[2]; _Pragma("unroll") for (int _j = 0; _j < 2; ++_j) go_[_j] = ((nextu) ? gnxt[half][_j] : gcur[half][_j]) * (unsigned)(lda * 2) + gC2[_j]; \
      PG8_STAGE(bufoff, gbaseA + (kbytes), go_); } \
    else { PG8_STAGE(bufoff, ((nextu) ? nA : cA) + (half) * hstepA + (kbytes), voffA); } } while (0)
  Unit cur, nxt;
  int ui = 0;
  if (!S.next(0, cur)) return;
  f32x4 acc[2][2][4][2];
#pragma unroll
  for (int a = 0; a < 2; ++a)
#pragma unroll
    for (int b = 0; b < 2; ++b)
#pragma unroll
      for (int m = 0; m < 4; ++m)
#pragma unroll
        for (int n = 0; n < 2; ++n) acc[a][b][m][n] = (f32x4){0.f, 0.f, 0.f, 0.f};
  bf16x8 At[4][2], B0[2][2], B1[2][2];
  const char* cA = cur.A;
  const char* cB = cur.B;
  const char* nA = cA;
  if constexpr (GATHER) { gload(cur.row0, gcur); gload(cur.row0, gnxt); asm volatile("s_waitcnt vmcnt(0)" ::: "memory"); }
  PG8_STAGE(PG8_SB(0, 0), cB, voffB); PG8_STAGE(PG8_SB(0, 1), cB + hstepB, voffB); PG8_STAGE_A(PG8_SA(0, 0), false, 0, 0); PG8_STAGE_A(PG8_SA(0, 1), false, 1, 0);
  if (wr == 1) PG8_BAR;
  PG8_WAIT_V(2); PG8_BAR;
  PG8_STAGE(PG8_SB(1, 0), cB + kstep, voffB); PG8_STAGE_A(PG8_SA(1, 0), false, 0, kstep); PG8_STAGE(PG8_SB(1, 1), cB + hstepB + kstep, voffB);
  PG8_WAIT_V(6); PG8_BAR;
  for (;;) {
    const bool has_next = S.next(ui + 1, nxt);
    nA = has_next ? nxt.A : cA;
    const char* nB = has_next ? nxt.B : cB;
    if constexpr (GATHER) { if (has_next) gload(nxt.row0, gnxt); else {
#pragma unroll
      for (int h = 0; h < 2; ++h)
#pragma unroll
        for (int i = 0; i < 2; ++i) gnxt[h][i] = gcur[h][i]; } }
    for (int t = 0; t < nt; t += 2) {
      const bool last = (t == nt - 2);
      const size_t k1 = (size_t)(t + 1) * kstep;
      const size_t k2 = last ? 0 : (size_t)(t + 2) * kstep;
      const size_t k3 = k2 + kstep;
      const char* b2 = last ? nB : cB + (size_t)(t + 2) * kstep;
      const char* b3 = b2 + kstep;
      PG8_LDB(B0, 0, 0); PG8_LDB(B1, 0, 1); PG8_SCHED; PG8_LDA(At, 0, 0); PG8_STAGE_A(PG8_SA(1, 1), false, 1, k1);
      PG8_WAIT_V(8); PG8_WAIT_L(0); PG8_BAR; PG8_MMA(0, 0, At, B0); PG8_MMA(0, 1, At, B1); PG8_BAR; PG8_SCHED;
      PG8_LDA(At, 0, 1); PG8_STAGE(PG8_SB(0, 0), b2, voffB); PG8_STAGE(PG8_SB(0, 1), b2 + hstepB, voffB); PG8_STAGE_A(PG8_SA(0, 0), last, 0, k2);
      PG8_WAIT_V(8); PG8_WAIT_L(0); PG8_BAR; PG8_MMA(1, 0, At, B0); PG8_MMA(1, 1, At, B1); PG8_BAR; PG8_SCHED;
      PG8_LDB(B0, 1, 0); PG8_LDB(B1, 1, 1); PG8_SCHED; PG8_LDA(At, 1, 0); PG8_STAGE_A(PG8_SA(0, 1), last, 1, k2);
      PG8_WAIT_V(8); PG8_WAIT_L(0); PG8_BAR; PG8_MMA(0, 0, At, B0); PG8_MMA(0, 1, At, B1); PG8_BAR; PG8_SCHED;
      PG8_LDA(At, 1, 1); PG8_STAGE(PG8_SB(1, 0), b3, voffB); PG8_STAGE(PG8_SB(1, 1), b3 + hstepB, voffB); PG8_STAGE_A(PG8_SA(1, 0), last, 0, k3);
      PG8_WAIT_V(8); PG8_WAIT_L(0); PG8_BAR; PG8_MMA(1, 0, At, B0); PG8_MMA(1, 1, At, B1); PG8_BAR; PG8_SCHED;
    }
    if (wr == 0) PG8_BAR;
    E(acc, cur, wr, wc, fr, fq);
    if (!has_next) break;
#pragma unroll
    for (int a = 0; a < 2; ++a)
#pragma unroll
      for (int b = 0; b < 2; ++b)
#pragma unroll
        for (int m = 0; m < 4; ++m)
#pragma unroll
          for (int n = 0; n < 2; ++n) acc[a][b][m][n] = (f32x4){0.f, 0.f, 0.f, 0.f};
    cur = nxt; cA = nA; cB = nB; ++ui;
    if constexpr (GATHER) {
#pragma unroll
      for (int h = 0; h < 2; ++h)
#pragma unroll
        for (int i = 0; i < 2; ++i) gcur[h][i] = gnxt[h][i];
    }
    if (wr == 1) PG8_BAR;
  }
  PG8_WAIT_V(0);
  PG8_BAR;
#undef PG8_SA
#undef PG8_SB
#undef PG8_STAGE
#undef PG8_STAGE_A
#undef PG8_LDA
#undef PG8_LDB
#undef PG8_MMA
#undef PG8_WAIT_V
#undef PG8_WAIT_L
#undef PG8_BAR
#undef PG8_SCHED
}

struct SchedDense {
  const char* A; const char* B; int lda, ldb, nM, nN, acolstep, G, c;
  __device__ __forceinline__ bool next(int i, Unit& u) const {
    const int nwg = nM * nN;
    const long L = (long)i * G + c;
    if (L >= nwg) return false;
    int wgid = (int)L;
    { const int q = nwg / 8, r = nwg % 8, xcd = wgid % 8, off = wgid / 8; wgid = (xcd < r ? xcd * (q + 1) : r * (q + 1) + (xcd - r) * q) + off; }
    const int nig = 8 * nN, gid = wgid / nig, fm = gid * 8, gsz = (nM - fm) < 8 ? (nM - fm) : 8;
    const int pm = fm + ((wgid % nig) % gsz), pn = (wgid % nig) / gsz;
    u.A = A + (size_t)pm * 256 * lda * 2 + (size_t)pn * acolstep;
    u.B = B + (size_t)pn * 256 * ldb * 2;
    u.row0 = pm * 256; u.col0 = pn * 256;
    return true;
  }
};
struct SchedMoe {
  const char* A; const char* W; int ncol, wrows, colw, nu, G, c;
  __device__ __forceinline__ bool next(int i, Unit& u) const {
    const long L = (long)i * G + c;
    if (L >= nu) return false;
    const int wgid = (int)(L % 8) * (nu / 8) + (int)(L / 8);
    const int UL = 128 * ncol;
    int e, pn, row0;
    if (wgid < UL) { e = wgid / (8 * ncol); const int rem = wgid % (8 * ncol); row0 = e * 2048 + (rem % 8) * 256; pn = rem / 8; }
    else { const int w2 = wgid - UL; e = w2 / ncol; pn = w2 % ncol; row0 = MOE_L + e * 256; }
    u.A = A + (size_t)row0 * 1024 * 2;
    u.B = W + ((size_t)e * wrows + (size_t)pn * 256) * 1024 * 2;
    u.row0 = row0; u.col0 = pn * colw;
    return true;
  }
};

struct EpiBf16 {
  bf16_t* O; int ldo;
  __device__ __forceinline__ void operator()(const f32x4 (&acc)[2][2][4][2], const Unit& u, int wr, int wc, int fr, int fq) const {
#pragma unroll
    for (int ai = 0; ai < 2; ++ai)
#pragma unroll
      for (int m = 0; m < 4; ++m) {
        const int row = u.row0 + ai * 128 + wr * 64 + m * 16 + fr;
        bf16_t* rp = O + (size_t)row * ldo + u.col0 + wc * 32 + 8 * fq;
#pragma unroll
        for (int bj = 0; bj < 2; ++bj) {
          const f32x4 v0 = acc[ai][bj][m][0], v1 = acc[ai][bj][m][1];
          u32x4 w; w.x = cvt_pk_bf16(v0[0], v0[1]); w.y = cvt_pk_bf16(v0[2], v0[3]); w.z = cvt_pk_bf16(v1[0], v1[1]); w.w = cvt_pk_bf16(v1[2], v1[3]);
          *(u32x4*)(rp + bj * 128) = w;
        }
      }
  }
};
struct EpiResid {
  float* x; const float* modg; const float* cs; const float* xl; const float* xc;
  __device__ __forceinline__ void operator()(const f32x4 (&acc)[2][2][4][2], const Unit& u, int wr, int wc, int fr, int fq) const {
#pragma unroll
    for (int ai = 0; ai < 2; ++ai)
#pragma unroll
      for (int m = 0; m < 4; ++m) {
        const int row = u.row0 + ai * 128 + wr * 64 + m * 16 + fr;
        const int c0 = u.col0 + wc * 32 + 8 * fq;
        float* xp = x + (size_t)row * 1024 + c0;
        const float* xi = xl ? (row < NL ? xl + (size_t)row * 1024 + c0 : xc + (size_t)(row - NL) * 1024 + c0) : xp;
        const float* gp = modg + (size_t)modrow(row) * 6144 + c0;
#pragma unroll
        for (int bj = 0; bj < 2; ++bj) {
          f32x4 g0 = *(const f32x4*)(gp + bj * 128), g1 = *(const f32x4*)(gp + bj * 128 + 4);
          if (cs) { g0 *= *(const f32x4*)(cs + c0 + bj * 128); g1 *= *(const f32x4*)(cs + c0 + bj * 128 + 4); }
          f32x4 x0 = *(const f32x4*)(xi + bj * 128), x1 = *(const f32x4*)(xi + bj * 128 + 4);
          x0 += g0 * acc[ai][bj][m][0]; x1 += g1 * acc[ai][bj][m][1];
          *(f32x4*)(xp + bj * 128) = x0; *(f32x4*)(xp + bj * 128 + 4) = x1;
        }
      }
  }
};
struct EpiSwiGLU {
  bf16_t* O;
  __device__ __forceinline__ void operator()(const f32x4 (&acc)[2][2][4][2], const Unit& u, int wr, int wc, int fr, int fq) const {
#pragma unroll
    for (int ai = 0; ai < 2; ++ai)
#pragma unroll
      for (int m = 0; m < 4; ++m) {
        const int row = u.row0 + ai * 128 + wr * 64 + m * 16 + fr;
        bf16_t* rp = O + (size_t)row * 1024 + u.col0 + wc * 32 + 8 * fq;
        float o[8];
#pragma unroll
        for (int n = 0; n < 2; ++n)
#pragma unroll
          for (int j = 0; j < 4; ++j) { const float g = acc[ai][0][m][n][j], up = acc[ai][1][m][n][j]; o[n * 4 + j] = g / (1.f + __expf(-g)) * up; }
        u32x4 w; w.x = cvt_pk_bf16(o[0], o[1]); w.y = cvt_pk_bf16(o[2], o[3]); w.z = cvt_pk_bf16(o[4], o[5]); w.w = cvt_pk_bf16(o[6], o[7]);
        *(u32x4*)rp = w;
      }
  }
};
struct EpiDown {
  bf16_t* O; const float* gatev;
  __device__ __forceinline__ void operator()(const f32x4 (&acc)[2][2][4][2], const Unit& u, int wr, int wc, int fr, int fq) const {
    float gv[2][4];
#pragma unroll
    for (int ai = 0; ai < 2; ++ai)
#pragma unroll
      for (int m = 0; m < 4; ++m) gv[ai][m] = gatev[u.row0 + ai * 128 + wr * 64 + m * 16 + fr];
    __builtin_amdgcn_sched_barrier(0);
#pragma unroll
    for (int ai = 0; ai < 2; ++ai)
#pragma unroll
      for (int m = 0; m < 4; ++m) {
        const int row = u.row0 + ai * 128 + wr * 64 + m * 16 + fr;
        bf16_t* rp = O + (size_t)row * 1024 + u.col0 + wc * 32 + 8 * fq;
#pragma unroll
        for (int bj = 0; bj < 2; ++bj) {
          const f32x4 v0 = acc[ai][bj][m][0] * gv[ai][m], v1 = acc[ai][bj][m][1] * gv[ai][m];
          u32x4 w; w.x = cvt_pk_bf16(v0[0], v0[1]); w.y = cvt_pk_bf16(v0[2], v0[3]); w.z = cvt_pk_bf16(v1[0], v1[1]); w.w = cvt_pk_bf16(v1[2], v1[3]);
          *(u32x4*)(rp + bj * 128) = w;
        }
      }
  }
};
}

#define NT_WINE 1408
#define NT_WOUT 512
#define NT_WINO 512
#define NT_WGRP 128
#define NT_EXP 16384
#define NT_ALL (NT_WINE + NT_WOUT + NT_WINO + NT_WGRP + 3 * NT_EXP)
#define CE0 704
#define CE1 960
#define CE2 13248
#define CE3 13504
#define CE4 13568
#define CE5 25856
#define CE6 26560
#define CE7 26816
#define CE8 39104
#define CE9 39360
#define CE10 39424
#define CE11 51712
__device__ __forceinline__ void conv_batch(const Params& p, int t, float* T) {
  const int tid = ltid(), lane = tid & 63, wv = tid >> 6;
  const float* src; bf16_t* dst; int ld, dK, k0, n0;
  int seg, tb, e, which = 0;
  if (t < CE0) { seg = 0; e = 0; tb = t; } else if (t < CE1) { seg = 1; e = 0; tb = t - CE0; } else if (t < CE2) { seg = 2; e = 0; tb = t - CE1; }
  else if (t < CE3) { seg = 3; e = 0; tb = t - CE2; } else if (t < CE4) { seg = 4; e = 0; tb = t - CE3; } else if (t < CE5) { seg = 2; e = 1; tb = t - CE4; }
  else if (t < CE6) { seg = 0; e = 1; tb = t - CE5; } else if (t < CE7) { seg = 1; e = 1; tb = t - CE6; } else if (t < CE8) { seg = 2; e = 2; tb = t - CE7; }
  else if (t < CE9) { seg = 3; e = 1; tb = t - CE8; } else if (t < CE10) { seg = 4; e = 1; tb = t - CE9; } else { seg = 2; e = 3; tb = t - CE10; }
  int dbase = 0;
  if (seg == 0) {
    k0 = (tb / 44) * 64; n0 = (tb % 44) * 64;
    src = p.w_in_even + (size_t)e * 1024 * EVEN_IN; ld = EVEN_IN; dst = p.WinE + (size_t)e * PROJW * 1024; dK = 1024;
  } else if (seg == 1 || seg == 3) {
    k0 = (tb / 16) * 64; n0 = (tb % 16) * 64;
    src = (seg == 3 ? p.w_in_odd : p.w_out_even) + (size_t)e * 1024 * 1024; ld = 1024; dst = (seg == 3 ? p.WinO : p.WoutE) + (size_t)e * 1024 * 1024; dK = 1024;
  } else if (seg == 4) {
    const int g = tb / 16; k0 = ((tb % 16) / 4) * 64; n0 = (tb % 4) * 64;
    src = p.w_pool_grp + (size_t)(e * 4 + g) * 65536; ld = 256; dst = p.Wgrp + (size_t)e * 1024 * 256; dK = 256; dbase = g * 256;
  } else {
    which = tb / 4096; const int r = tb % 4096, le = e * 16 + r / 256; k0 = ((r % 256) / 16) * 64; n0 = (r % 16) * 64;
    const float* base = which == 0 ? p.w_exp_gate : (which == 1 ? p.w_exp_up : p.w_exp_down);
    src = base + (size_t)le * 1024 * 1024; ld = 1024; dK = 1024;
    dst = which < 2 ? p.Wgu + (size_t)le * 2048 * 1024 : p.Wd + (size_t)le * 1024 * 1024;
  }
  const bool gu = (seg == 2 && which < 2);
  float4 v[8];
#pragma unroll
  for (int q = 0; q < 8; ++q) {
    const int idx = tid + q * NTHR, k = idx >> 6, c4 = idx & 63;
    v[q] = *(const float4*)(src + (size_t)(k0 + k) * ld + n0 + c4 * 4);
  }
  __builtin_amdgcn_sched_barrier(0);
#pragma unroll
  for (int q = 0; q < 8; ++q) {
    const int idx = tid + q * NTHR, k = idx >> 6, c4 = idx & 63;
    float* tp = T + k * 257 + c4 * 4;
    tp[0] = v[q].x; tp[1] = v[q].y; tp[2] = v[q].z; tp[3] = v[q].w;
  }
  __syncthreads();
#pragma unroll
  for (int sub = 0; sub < 4; ++sub) {
    const int nl = wv * 8 + (lane >> 3), kq = lane & 7, nn = n0 + sub * 64;
    const int drow0 = gu ? (nn >> 7) * 256 + which * 128 + (nn & 127) : dbase + nn;
    float f[8];
#pragma unroll
    for (int j = 0; j < 8; ++j) f[j] = T[(kq * 8 + j) * 257 + sub * 64 + nl];
    u32x4 w; w.x = cvt_pk_bf16(f[0], f[1]); w.y = cvt_pk_bf16(f[2], f[3]); w.z = cvt_pk_bf16(f[4], f[5]); w.w = cvt_pk_bf16(f[6], f[7]);
    *(u32x4*)(dst + (size_t)(drow0 + nl) * dK + k0 + kq * 8) = w;
  }
}
__device__ __forceinline__ int conv_pull(const Params& p, float* sm) {
  __syncthreads();
  if (ltid() == 0) ((int*)sm)[16500] = (int)__hip_atomic_fetch_add(p.barw, 4u, __ATOMIC_RELAXED, __HIP_MEMORY_SCOPE_AGENT);
  __syncthreads();
  return ((int*)sm)[16500];
}
__device__ __forceinline__ void conv_until(const Params& p, int end, float* sm) {
  int t;
  do { t = conv_pull(p, sm); if (t < CE11) conv_batch(p, t, sm); } while (t + 4 < end);
  __syncthreads();
}
__device__ __forceinline__ void conv_quota(const Params& p, int n, float* sm) {
  for (int i = 0; i < n; ++i) { const int t = conv_pull(p, sm); if (t >= CE11) break; conv_batch(p, t, sm); }
  __syncthreads();
}

__device__ __forceinline__ void ph_init(const Params& p, float* sm) {
  const int tid = ltid(), lane = tid & 63, wv = tid >> 6;
  const size_t gtid = (size_t)lbid() * NTHR + tid, gsz = (size_t)lgdim() * NTHR;
  for (int i = tid; i < 9 * 1024; i += NTHR) {
    const int r = i >> 10, k = i & 1023;
    sm[i] = siluf(r < 8 ? p.c[r * 1024 + k] : p.c_ctx[k]);
  }
  __syncthreads();
  float* part = sm + 9 * 1024;
  for (int item = lbid(); item < 768; item += lgdim()) {
    const int l = item / 192, j0 = (item % 192) * 32;
    const int col = lane & 31, kh = lane >> 5;
    const float* w = p.w_mod + (size_t)l * 1024 * 6144 + j0 + col;
    float acc[9];
#pragma unroll
    for (int r = 0; r < 9; ++r) acc[r] = 0.f;
    const int kb = wv * 128 + kh * 64;
    for (int k0 = 0; k0 < 64; k0 += 16) {
      float wv16[16];
#pragma unroll
      for (int kk = 0; kk < 16; ++kk) wv16[kk] = w[(size_t)(kb + k0 + kk) * 6144];
      __builtin_amdgcn_sched_barrier(0);
#pragma unroll
      for (int kk = 0; kk < 16; ++kk)
#pragma unroll
        for (int r = 0; r < 9; ++r) acc[r] += sm[r * 1024 + kb + k0 + kk] * wv16[kk];
    }
#pragma unroll
    for (int r = 0; r < 9; ++r) part[((wv * 2 + kh) * 9 + r) * 32 + col] = acc[r];
    __syncthreads();
    if (tid < 288) {
      const int r = tid >> 5, cc = tid & 31;
      float s = 0.f;
#pragma unroll
      for (int sl = 0; sl < 16; ++sl) s += part[(sl * 9 + r) * 32 + cc];
      p.mod[(size_t)(l * 9 + r) * 6144 + j0 + cc] = s + p.b_mod[l * 6144 + j0 + cc];
    }
    __syncthreads();
  }
  conv_until(p, CE1, sm);
}

typedef float f32x4m __attribute__((ext_vector_type(4)));
__device__ __forceinline__ void ph_norm(const Params& p, int l, int which, int nrows, int ncomb, int lprev, float* sm) {
  const int tid = ltid(), lane = tid & 63, wv = tid >> 6;
  const bool skinny = (which == 2) || (which == 1 && (l & 1) == 0);
  bf16_t* HROW = (bf16_t*)sm;
  float* PART = sm + 8192;
  bf16x8 Bhi[4], Blo[4];
  if (skinny) {
    const float* wbase; int stride;
    if (which == 2) { wbase = p.w_router + (size_t)l * 1024 * 16; stride = 16; }
    else { wbase = p.w_in_even + (size_t)(l >> 1) * 1024 * EVEN_IN + PROJW; stride = EVEN_IN; }
    const int kg = lane >> 4, n = lane & 15;
#pragma unroll
    for (int ks = 0; ks < 4; ++ks) {
      float f[8], hi[8], lo[8];
#pragma unroll
      for (int j = 0; j < 8; ++j) f[j] = wbase[(size_t)(wv * 128 + ks * 32 + kg * 8 + j) * stride + n];
      const u32x4 hw = pack8(f);
      unpack8(hw, hi);
#pragma unroll
      for (int j = 0; j < 8; ++j) lo[j] = f[j] - hi[j];
      Bhi[ks] = __builtin_bit_cast(bf16x8, hw);
      Blo[ks] = __builtin_bit_cast(bf16x8, pack8(lo));
    }
  }
  const int nwaves = lgdim() * (NTHR / 64), gw = lbid() * (NTHR / 64) + wv;
  const int per = (nrows + nwaves - 1) / nwaves;
  const int rbeg = gw * per, rend = min(nrows, rbeg + per);
  const bool in0 = (l == 0) && (which == 1 || which == 2);
  float4 vn[4];
  u32x2 xnb[4];
  int slvn = -1;
  {
    const int r0 = min(rbeg, nrows - 1);
    if (in0) {
      const float* xs0 = r0 < NL ? p.x + (size_t)r0 * DM : p.ctx + (size_t)(r0 - NL) * DM;
#pragma unroll
      for (int i = 0; i < 4; ++i) vn[i] = ((const float4*)xs0)[i * 64 + lane];
    } else {
#pragma unroll
      for (int i = 0; i < 4; ++i) xnb[i] = ((const u32x2*)(p.xcur + (size_t)r0 * DM))[i * 64 + lane];
    }
    if (r0 < ncomb && lane < 16) slvn = p.slotmap[r0 * 16 + lane];
  }
  float4 cA[4], cB[4], cG[4];
  u32x2 yn[4];
  int mr_c = -1;
  if (which == 2) {
    const u32x2* yp0 = (const u32x2*)(p.ybuf + (size_t)min(rbeg, nrows - 1) * DM);
#pragma unroll
    for (int i = 0; i < 4; ++i) yn[i] = yp0[i * 64 + lane];
  }
  for (int it = 0; it < per; ++it) {
    const int rr = rbeg + it;
    const bool live = rr < rend;
    const int r = min(rr, nrows - 1);
    float4 v[4];
    if (in0) {
#pragma unroll
      for (int i = 0; i < 4; ++i) v[i] = vn[i];
    } else {
#pragma unroll
      for (int i = 0; i < 4; ++i) v[i] = make_float4(__uint_as_float(xnb[i].x << 16), __uint_as_float(xnb[i].x & 0xffff0000u), __uint_as_float(xnb[i].y << 16), __uint_as_float(xnb[i].y & 0xffff0000u));
    }
    const int slv = slvn;
    bf16_t* xr = p.xcur + (size_t)r * DM;
    if (it + 1 < per) {
      const int rn = min(rr + 1, nrows - 1);
      if (in0) {
        const float* xsn = rn < NL ? p.x + (size_t)rn * DM : p.ctx + (size_t)(rn - NL) * DM;
#pragma unroll
        for (int i = 0; i < 4; ++i) vn[i] = ((const float4*)xsn)[i * 64 + lane];
      } else {
#pragma unroll
        for (int i = 0; i < 4; ++i) xnb[i] = ((const u32x2*)(p.xcur + (size_t)rn * DM))[i * 64 + lane];
      }
      slvn = (rn < ncomb && lane < 16) ? p.slotmap[rn * 16 + lane] : -1;
    }
    const int mr = modrow(r);
    if (mr != mr_c) {
      mr_c = mr;
      if (which == 3) {
#pragma unroll
        for (int i = 0; i < 4; ++i) cA[i] = ((const float4*)p.g_final)[i * 64 + lane];
      } else {
        const float* gn = (which == 1 ? p.g_norm1 : p.g_norm2) + l * 1024;
        const float* mrow = p.mod + (size_t)(l * 9 + mr) * 6144;
        const float4* shp = (const float4*)(mrow + (which == 1 ? 0 : 3) * 1024);
        const float4* scp = (const float4*)(mrow + (which == 1 ? 1 : 4) * 1024);
#pragma unroll
        for (int i = 0; i < 4; ++i) {
          const float4 g = ((const float4*)gn)[i * 64 + lane], sc = scp[i * 64 + lane];
          cA[i] = make_float4(g.x * (1.f + sc.x), g.y * (1.f + sc.y), g.z * (1.f + sc.z), g.w * (1.f + sc.w));
          cB[i] = shp[i * 64 + lane];
        }
      }
      if (which == 2) {
        const float4* g2 = (const float4*)(p.mod + (size_t)(l * 9 + mr) * 6144 + 2 * 1024);
        const float4* spv = (const float4*)(p.s_pool + (size_t)(l >> 1) * 1024);
#pragma unroll
        for (int i = 0; i < 4; ++i) {
          float4 g = g2[i * 64 + lane];
          if (l & 1) { const float4 sp4 = spv[i * 64 + lane]; g.x *= sp4.x; g.y *= sp4.y; g.z *= sp4.z; g.w *= sp4.w; }
          cG[i] = g;
        }
      } else if (ncomb > 0) {
        const float4* g5 = (const float4*)(p.mod + (size_t)(lprev * 9 + mr) * 6144 + 5 * 1024);
#pragma unroll
        for (int i = 0; i < 4; ++i) cG[i] = g5[i * 64 + lane];
      }
    }
    if (live && r < ncomb) {
      float4 s4[4];
#pragma unroll
      for (int i = 0; i < 4; ++i) s4[i] = make_float4(0.f, 0.f, 0.f, 0.f);
      unsigned long long mask = __ballot(slv >= 0);
      while (mask) {
        const int e = __ffsll((long long)mask) - 1;
        mask &= mask - 1;
        const int sl = __shfl(slv, e);
        size_t yrow;
        if (r < NL) yrow = (size_t)e * 2048 + (size_t)(r >> 11) * 256 + sl;
        else yrow = (size_t)MOE_L + (size_t)e * 256 + (size_t)((r - NL) >> 8) * 32 + sl;
        const u32x2* yp = (const u32x2*)(p.Ybuf + yrow * DM);
        u32x2 yv[4];
#pragma unroll
        for (int i = 0; i < 4; ++i) yv[i] = yp[i * 64 + lane];
#pragma unroll
        for (int i = 0; i < 4; ++i) {
          const u32x2 y = yv[i];
          s4[i].x += __uint_as_float(y.x << 16); s4[i].y += __uint_as_float(y.x & 0xffff0000u);
          s4[i].z += __uint_as_float(y.y << 16); s4[i].w += __uint_as_float(y.y & 0xffff0000u);
        }
      }
#pragma unroll
      for (int i = 0; i < 4; ++i) {
        const float4 g = cG[i];
        v[i].x += g.x * s4[i].x; v[i].y += g.y * s4[i].y; v[i].z += g.z * s4[i].z; v[i].w += g.w * s4[i].w;
        if (which != 3) { u32x2 xw; xw.x = cvt_pk_bf16(v[i].x, v[i].y); xw.y = cvt_pk_bf16(v[i].z, v[i].w); ((u32x2*)xr)[i * 64 + lane] = xw; }
      }
    }
    if (which == 2) {
      u32x2 yc[4];
#pragma unroll
      for (int i = 0; i < 4; ++i) yc[i] = yn[i];
      if (it + 1 < per) {
        const u32x2* ypn = (const u32x2*)(p.ybuf + (size_t)min(rr + 1, nrows - 1) * DM);
#pragma unroll
        for (int i = 0; i < 4; ++i) yn[i] = ypn[i * 64 + lane];
      }
#pragma unroll
      for (int i = 0; i < 4; ++i) {
        v[i].x += cG[i].x * __uint_as_float(yc[i].x << 16); v[i].y += cG[i].y * __uint_as_float(yc[i].x & 0xffff0000u);
        v[i].z += cG[i].z * __uint_as_float(yc[i].y << 16); v[i].w += cG[i].w * __uint_as_float(yc[i].y & 0xffff0000u);
        if (live) { u32x2 xw; xw.x = cvt_pk_bf16(v[i].x, v[i].y); xw.y = cvt_pk_bf16(v[i].z, v[i].w); ((u32x2*)xr)[i * 64 + lane] = xw; }
      }
    }
    float ss = 0.f;
#pragma unroll
    for (int i = 0; i < 4; ++i) ss += v[i].x * v[i].x + v[i].y * v[i].y + v[i].z * v[i].z + v[i].w * v[i].w;
    ss = wave_sum(ss);
    const float inv = rsqrtf(ss * (1.f / 1024.f) + EPS);
    if (which == 3) {
      if (live) {
#pragma unroll
        for (int i = 0; i < 4; ++i) {
          const float4 g = cA[i];
          ((float4*)(p.out + (size_t)r * DM))[i * 64 + lane] = make_float4(v[i].x * inv * g.x, v[i].y * inv * g.y, v[i].z * inv * g.z, v[i].w * inv * g.w);
        }
      }
      continue;
    }
#pragma unroll
    for (int i = 0; i < 4; ++i) {
      const float h0 = v[i].x * inv * cA[i].x + cB[i].x, h1 = v[i].y * inv * cA[i].y + cB[i].y;
      const float h2 = v[i].z * inv * cA[i].z + cB[i].z, h3 = v[i].w * inv * cA[i].w + cB[i].w;
      u32x2 w; w.x = cvt_pk_bf16(h0, h1); w.y = cvt_pk_bf16(h2, h3);
      if (live) ((u32x2*)(p.hbuf + (size_t)r * DM))[i * 64 + lane] = w;
      if (skinny) {
        const float l0 = h0 - __uint_as_float(w.x << 16), l1 = h1 - __uint_as_float(w.x & 0xffff0000u);
        const float l2 = h2 - __uint_as_float(w.y << 16), l3 = h3 - __uint_as_float(w.y & 0xffff0000u);
        u32x2 wl; wl.x = cvt_pk_bf16(l0, l1); wl.y = cvt_pk_bf16(l2, l3);
        ((u32x2*)(HROW + (wv * 2 + 0) * 1024))[i * 64 + lane] = w;
        ((u32x2*)(HROW + (wv * 2 + 1) * 1024))[i * 64 + lane] = wl;
      }
    }
    if (!skinny) continue;
    LDS_BARRIER();
    {
      const int arow = lane & 7, kg = lane >> 4;
      f32x4m acc = {0.f, 0.f, 0.f, 0.f};
#pragma unroll
      for (int ks = 0; ks < 4; ++ks) {
        const bf16x8 ahi = *(const bf16x8*)(HROW + (arow * 2 + 0) * 1024 + wv * 128 + ks * 32 + kg * 8);
        const bf16x8 alo = *(const bf16x8*)(HROW + (arow * 2 + 1) * 1024 + wv * 128 + ks * 32 + kg * 8);
        acc = __builtin_amdgcn_mfma_f32_16x16x32_bf16(ahi, Bhi[ks], acc, 0, 0, 0);
        acc = __builtin_amdgcn_mfma_f32_16x16x32_bf16(ahi, Blo[ks], acc, 0, 0, 0);
        acc = __builtin_amdgcn_mfma_f32_16x16x32_bf16(alo, Bhi[ks], acc, 0, 0, 0);
      }
      if (kg < 2) {
#pragma unroll
        for (int q = 0; q < 4; ++q) PART[(wv * 8 + kg * 4 + q) * 16 + (lane & 15)] = acc[q];
      }
    }
    LDS_BARRIER();
    {
      float v1 = 0.f;
      if (lane < 16) {
#pragma unroll
        for (int w2 = 0; w2 < 8; ++w2) v1 += PART[(w2 * 8 + wv) * 16 + lane];
      }
      if (which == 2) {
        float mx = v1;
        mx = fmaxf(mx, __shfl_xor(mx, 1)); mx = fmaxf(mx, __shfl_xor(mx, 2)); mx = fmaxf(mx, __shfl_xor(mx, 4)); mx = fmaxf(mx, __shfl_xor(mx, 8));
        const float ex = expf(v1 - mx);
        float sum = ex;
        sum += __shfl_xor(sum, 1); sum += __shfl_xor(sum, 2); sum += __shfl_xor(sum, 4); sum += __shfl_xor(sum, 8);
        if (live && lane < 16) p.aff[(size_t)r * 16 + lane] = ex / sum;
      } else {
        float gvv = v1 + p.b_gate[(l >> 1) * 16 + (lane & 15)];
        if ((lane >> 2) & 1) gvv = logsigmoidf_(gvv);
        if (live && lane < 16) p.gates[(size_t)r * 16 + lane] = gvv;
      }
    }
  }
  __syncthreads();
}

#define LOG2E 1.4426950408889634f
__device__ __forceinline__ int chain_row(int b, int dir, int p) {
  if (p < 256) { const int t = dir ? 255 - p : p; return NL + b * 256 + t; }
  const int q = p - 256; const int t = dir ? 2047 - q : q; return b * 2048 + t;
}
__device__ __forceinline__ float wave_incl_sum(float v, int lane) {
#pragma unroll
  for (int o = 1; o < 64; o <<= 1) { const float t = __shfl_up(v, o); if (lane >= o) v += t; }
  return v;
}
__device__ __forceinline__ float wave_incl_max(float v, int lane) {
#pragma unroll
  for (int o = 1; o < 64; o <<= 1) { const float t = __shfl_up(v, o); if (lane >= o) v = fmaxf(v, t); }
  return v;
}
__device__ __forceinline__ void ph_post_even(const Params& p, int l, float* sm) {
  const int e = l >> 1;
  const int tid = ltid(), lane = tid & 63;
  __syncthreads();
  for (int idx = tid; idx < 1024; idx += NTHR) {
    const int pos = idx >> 4, i = idx & 15;
    const float ang = (float)pos * exp2f(-(float)i * (13.287712379549449f / 16.f));
    float sn, cs;
    sincosf(ang, &sn, &cs);
    sm[2 * idx] = cs; sm[2 * idx + 1] = sn;
  }
  if (tid < 128) sm[2048 + tid] = tid < 64 ? p.g_qnorm[e * 64 + tid] : p.g_knorm[e * 64 + tid - 64];
  for (int idx = tid; idx < 3072; idx += NTHR) sm[2304 + idx] = p.w_conv[(size_t)e * 3 * 1024 + idx];
  __syncthreads();
  const int bid = lbid(), G = lgdim();
  const bool scanner = false;
  const size_t gtid = (size_t)bid * NTHR + tid, gsz = (size_t)G * NTHR;
  if (!scanner) {
  for (size_t it = gtid; it < (size_t)NT * 10; it += gsz) {
    const int r = (int)(it / 10), hh = (int)(it % 10);
    const bool lat = r < NL;
    const int t = r & 2047;
    const int bb = lat ? (r >> 11) : ((r - NL) >> 8);
    const int key = lat ? 256 + t : ((r - NL) & 255);
    const bf16_t* src; bf16_t* dst; const float* g; float osc;
    if (hh < 8) { src = p.proj + (size_t)r * PROJW + hh * 64; dst = p.Qb + (size_t)r * 512 + hh * 64; g = sm + 2048; osc = 0.125f * LOG2E; }
    else { src = p.proj + (size_t)r * PROJW + 512 + (hh - 8) * 64; dst = p.Kb + ((size_t)(bb * 2 + (hh - 8)) * 2304 + key) * 64; g = sm + 2048 + 64; osc = 1.f;
           const u32x4* vs = (const u32x4*)(p.proj + (size_t)r * PROJW + 640 + (hh - 8) * 64);
           u32x4* vd = (u32x4*)(p.Vb + ((size_t)(bb * 2 + (hh - 8)) * 2304 + key) * 64);
           u32x4 vt[8];
#pragma unroll
           for (int q = 0; q < 8; ++q) vt[q] = vs[q];
           __builtin_amdgcn_sched_barrier(0);
#pragma unroll
           for (int q = 0; q < 8; ++q) vd[q] = vt[q]; }
    float x[64];
#pragma unroll
    for (int q = 0; q < 8; ++q) { float f[8]; unpack8(((const u32x4*)src)[q], f);
#pragma unroll
      for (int j = 0; j < 8; ++j) x[q * 8 + j] = f[j]; }
    float ss = 0.f;
#pragma unroll
    for (int j = 0; j < 64; ++j) ss += x[j] * x[j];
    const float inv = rsqrtf(ss * (1.f / 64.f) + EPS) * osc;
#pragma unroll
    for (int j = 0; j < 64; ++j) x[j] *= inv * g[j];
    if (lat) {
#pragma unroll
      for (int a = 0; a < 2; ++a) {
        const int pos = (a == 0) ? (t >> 6) : (t & 63);
#pragma unroll
        for (int i = 0; i < 16; ++i) {
          const float2 cssn = *(const float2*)(sm + 2 * (pos * 16 + i));
          const float x1 = x[a * 32 + i], x2 = x[a * 32 + 16 + i];
          x[a * 32 + i] = x1 * cssn.x - x2 * cssn.y;
          x[a * 32 + 16 + i] = x2 * cssn.x + x1 * cssn.y;
        }
      }
    }
#pragma unroll
    for (int q = 0; q < 8; ++q) { float f[8];
#pragma unroll
      for (int j = 0; j < 8; ++j) f[j] = x[q * 8 + j];
      ((u32x4*)dst)[q] = pack8(f); }
  }
  const float* wc = sm + 2304;
  for (size_t it0 = gtid; it0 < (size_t)NT * 128; it0 += 4 * gsz) {
    u32x4 rc[4], rm[4], rp[4];
#pragma unroll
    for (int u = 0; u < 4; ++u) {
      const size_t it = it0 + (size_t)u * gsz;
      const size_t itc = it < (size_t)NT * 128 ? it : it0;
      const int r = (int)(itc >> 7), c8 = (int)(itc & 127) * 8;
      int t, n;
      if (r < NL) { t = r & 2047; n = 2048; } else { t = (r - NL) & 255; n = 256; }
      const bf16_t* sp = p.proj + (size_t)r * PROJW + 768 + c8;
      rc[u] = *(const u32x4*)sp;
      const u32x4 lm = *(const u32x4*)(sp - (t > 0 ? PROJW : 0)), lp = *(const u32x4*)(sp + (t < n - 1 ? PROJW : 0));
      rm[u].x = t > 0 ? lm.x : 0u; rm[u].y = t > 0 ? lm.y : 0u; rm[u].z = t > 0 ? lm.z : 0u; rm[u].w = t > 0 ? lm.w : 0u;
      rp[u].x = t < n - 1 ? lp.x : 0u; rp[u].y = t < n - 1 ? lp.y : 0u; rp[u].z = t < n - 1 ? lp.z : 0u; rp[u].w = t < n - 1 ? lp.w : 0u;
    }
#pragma unroll
    for (int u = 0; u < 4; ++u) {
      const size_t it = it0 + (size_t)u * gsz;
      if (it < (size_t)NT * 128) {
        const int r = (int)(it >> 7), c8 = (int)(it & 127) * 8;
        float xc[8], xm[8], xp[8], o[8];
        unpack8(rc[u], xc); unpack8(rm[u], xm); unpack8(rp[u], xp);
        const float ksc = c8 < 512 ? 1.f : 0.08838834764831845f;
#pragma unroll
        for (int j = 0; j < 8; ++j) { const float v = wc[c8 + j] * xm[j] + wc[1024 + c8 + j] * xc[j] + wc[2048 + c8 + j] * xp[j]; o[j] = siluf(v) * ksc; }
        bf16_t* dp = c8 < 512 ? p.qm + (size_t)r * 512 + c8 : p.km + (size_t)r * 512 + c8 - 512;
        *(u32x4*)dp = pack8(o);
      }
    }
  }
  }
  {
    const int gw = (int)(gtid >> 6), nw = (int)(gsz >> 6);
    for (int task = gw; task < 64 * 18; task += nw) {
      const int chain = task / 18, c = task % 18;
      const int b = chain >> 3, hd = (chain >> 1) & 3, dir = chain & 1;
      const int p0 = c * 128 + 2 * lane;
      const int r0 = chain_row(b, dir, p0), r1 = chain_row(b, dir, p0 + 1);
      const float ig0 = p.gates[(size_t)r0 * 16 + dir * 8 + hd], lf0 = p.gates[(size_t)r0 * 16 + dir * 8 + 4 + hd];
      const float ig1 = p.gates[(size_t)r1 * 16 + dir * 8 + hd], lf1 = p.gates[(size_t)r1 * 16 + dir * 8 + 4 + hd];
      const float ssum = lf0 + lf1;
      const float incl = wave_incl_sum(ssum, lane);
      const float bq0 = (incl - ssum) + lf0, bq1 = bq0 + lf1;
      const float bend = __shfl(incl, 63);
      const float g0 = ig0 - bq0, g1 = ig1 - bq1;
      const float inclm = wave_incl_max(fmaxf(g0, g1), lane);
      float exclm = __shfl_up(inclm, 1);
      if (lane == 0) exclm = -3.0e38f;
      const float pm0 = fmaxf(exclm, g0), pm1 = fmaxf(pm0, g1);
      const float gmax = __shfl(inclm, 63);
      const size_t i0 = (size_t)r0 * 8 + dir * 4 + hd, i1 = (size_t)r1 * 8 + dir * 4 + hd;
      p.gsG[i0] = g0 * LOG2E; p.gsR[i0] = pm0 * LOG2E; p.gsB[i0] = bq0 * LOG2E;
      p.gsG[i1] = g1 * LOG2E; p.gsR[i1] = pm1 * LOG2E; p.gsB[i1] = bq1 * LOG2E;
      if (lane == 0) { p.cBE[chain * 18 + c] = bend; p.cGM[chain * 18 + c] = gmax; }
    }
  }
}
__device__ __forceinline__ void chain_state(const Params& p, int chain, int cc, float& m_in, float& m_next, float& be) {
  m_in = -1e30f; m_next = -1e30f; be = 0.f;
  for (int c = 0; c <= cc; ++c) {
    be = p.cMIN[chain * 18 + c];
    const float mn = fmaxf(m_in + be, be + p.cE1[chain * 18 + c]);
    if (c < cc) m_in = mn; else m_next = mn;
  }
}

typedef float f32x16 __attribute__((ext_vector_type(16)));
typedef short s16x4 __attribute__((ext_vector_type(4)));
typedef __attribute__((address_space(3))) const char* lds_cptr;
__device__ __forceinline__ s16x4 vtr(lds_cptr p) { return __builtin_bit_cast(s16x4, __builtin_amdgcn_ds_read_tr16_b64_v4i16((__attribute__((address_space(3))) s16x4*)p)); }
#define MX3(a, b, c) __builtin_fmaxf(__builtin_fmaxf((a), (b)), (c))
__device__ __forceinline__ float rowmax32(const f32x16& p0, const f32x16& p1) {
  float a = MX3(p0[0], p0[1], p1[0]), b = MX3(p0[2], p0[3], p1[1]);
  a = MX3(a, p1[2], p1[3]);
#pragma unroll
  for (int r = 4; r < 16; r += 4) { a = MX3(a, p0[r], p0[r + 1]); b = MX3(b, p0[r + 2], p0[r + 3]); a = MX3(a, p1[r], p1[r + 1]); b = MX3(b, p1[r + 2], p1[r + 3]); }
  const float m = __builtin_fmaxf(a, b);
  auto rr = __builtin_amdgcn_permlane32_swap(__float_as_uint(m), __float_as_uint(m), false, false);
  return __builtin_fmaxf(__uint_as_float(rr[0]), __uint_as_float(rr[1]));
}
__device__ __forceinline__ float half_swap_add(float v) {
  auto rr = __builtin_amdgcn_permlane32_swap(__float_as_uint(v), __float_as_uint(v), false, false);
  return __uint_as_float(rr[0]) + __uint_as_float(rr[1]);
}
#define ATT_SLOT 16384
__device__ __forceinline__ void glds16(const void* g, unsigned lds_base) {
  unsigned sv;
  asm volatile("s_mov_b32 %0, m0\n\ts_mov_b32 m0, %2\n\ts_nop 0\n\tglobal_load_lds_dwordx4 %1, off\n\ts_mov_b32 m0, %0" : "=&s"(sv) : "v"(g), "s"(lds_base) : "memory");
}
__device__ __forceinline__ void attn_unit(const bf16_t* Q0, const bf16_t* Kbase, const bf16_t* Vbase, const int nkeys, bf16_t* O0, LAS unsigned char* lds) {
  const int tid = ltid(), lane = tid & 63, r32 = lane & 31, hi = lane >> 5;
  const int wid = __builtin_amdgcn_readfirstlane(tid >> 6);
  const int NTL = nkeys >> 6;
  __syncthreads();
  const bf16_t* ksrc = Kbase + (size_t)lane * 64 + wid * 8;
  const bf16_t* vsrc = Vbase + (size_t)(16 * (wid & 3) + (lane >> 2)) * 64 + (wid >> 2) * 32 + (lane & 3) * 8;
  const unsigned ldsb = (unsigned)(size_t)lds;
#define ATT_STAGE(t, slot) do { \
    glds16(ksrc + (size_t)(t) * 64 * 64, (unsigned)__builtin_amdgcn_readfirstlane(ldsb + (slot) * ATT_SLOT + wid * 1024)); \
    glds16(vsrc + (size_t)(t) * 64 * 64, (unsigned)__builtin_amdgcn_readfirstlane(ldsb + (slot) * ATT_SLOT + 8192 + wid * 1024)); } while (0)
  ATT_STAGE(0, 0);
  if (NTL > 1) ATT_STAGE(1, 1);
  bf16x8 qr[4];
  {
    const bf16_t* Qw = Q0 + (size_t)(wid * 32 + r32) * 512;
#pragma unroll
    for (int d0 = 0; d0 < 4; ++d0) qr[d0] = *(const bf16x8*)(Qw + d0 * 16 + hi * 8);
  }
  f32x16 o0, o1;
#pragma unroll
  for (int r = 0; r < 16; ++r) { o0[r] = 0.f; o1[r] = 0.f; }
  float m = -1e30f, l = 0.f;
  const int koff = hi * 1024 + r32 * 16;
  const int voff = 8192 + ((lane >> 4) & 1) * 32 + (lane & 3) * 8 + (4 * hi + ((lane & 15) >> 2)) * 64;
  const bool grpB = wid >= 4;
  bf16x8 pw[4];
#define ATT_PV(sl) do { const lds_cptr vp_ = (lds_cptr)(lds + (sl) * ATT_SLOT + voff); \
    _Pragma("unroll") for (int s4 = 0; s4 < 4; ++s4) { \
      const s16x4 a0l = vtr(vp_ + s4 * 1024), a0h = vtr(vp_ + s4 * 1024 + 512); \
      const s16x4 a1l = vtr(vp_ + 4096 + s4 * 1024), a1h = vtr(vp_ + 4096 + s4 * 1024 + 512); \
      const bf16x8 a0 = {a0l[0], a0l[1], a0l[2], a0l[3], a0h[0], a0h[1], a0h[2], a0h[3]}; \
      const bf16x8 a1 = {a1l[0], a1l[1], a1l[2], a1l[3], a1h[0], a1h[1], a1h[2], a1h[3]}; \
      o0 = __builtin_amdgcn_mfma_f32_32x32x16_bf16(a0, pw[s4], o0, 0, 0, 0); \
      o1 = __builtin_amdgcn_mfma_f32_32x32x16_bf16(a1, pw[s4], o1, 0, 0, 0); } } while (0)
  for (int t = 0; t <= NTL; ++t) {
    if (t + 1 < NTL) asm volatile("s_waitcnt vmcnt(2) lgkmcnt(0)\n\ts_barrier" ::: "memory"); else asm volatile("s_waitcnt vmcnt(0) lgkmcnt(0)\n\ts_barrier" ::: "memory");
    __builtin_amdgcn_sched_barrier(0);
    if (t + 2 < NTL) ATT_STAGE(t + 2, (t + 2) & 3);
    if (grpB && t > 0) ATT_PV((t - 1) & 3);
    if (t < NTL) {
      const lds_cptr kp = (lds_cptr)(lds + (t & 3) * ATT_SLOT + koff);
      f32x16 pA, pB;
#pragma unroll
      for (int r = 0; r < 16; ++r) { pA[r] = 0.f; pB[r] = 0.f; }
#pragma unroll
      for (int d0 = 0; d0 < 4; ++d0) {
        const bf16x8 k0 = *(const LAS bf16x8*)(kp + d0 * 2048), k1 = *(const LAS bf16x8*)(kp + d0 * 2048 + 512);
        pA = __builtin_amdgcn_mfma_f32_32x32x16_bf16(k0, qr[d0], pA, 0, 0, 0);
        pB = __builtin_amdgcn_mfma_f32_32x32x16_bf16(k1, qr[d0], pB, 0, 0, 0);
      }
      const float rm = rowmax32(pA, pB);
      const float mn = __builtin_fmaxf(m, rm);
      const float alpha = __builtin_amdgcn_exp2f(m - mn);
      m = mn;
      float ps = 0.f;
#pragma unroll
      for (int r = 0; r < 16; ++r) { pA[r] = __builtin_amdgcn_exp2f(pA[r] - mn); pB[r] = __builtin_amdgcn_exp2f(pB[r] - mn); ps += pA[r] + pB[r]; }
      l = l * alpha + ps;
#pragma unroll
      for (int r = 0; r < 16; ++r) { o0[r] *= alpha; o1[r] *= alpha; }
#pragma unroll
      for (int s4 = 0; s4 < 4; ++s4) {
        u32x4 w;
        if (s4 < 2) { w.x = cvt_pk_bf16(pA[8 * s4 + 0], pA[8 * s4 + 1]); w.y = cvt_pk_bf16(pA[8 * s4 + 2], pA[8 * s4 + 3]); w.z = cvt_pk_bf16(pA[8 * s4 + 4], pA[8 * s4 + 5]); w.w = cvt_pk_bf16(pA[8 * s4 + 6], pA[8 * s4 + 7]); }
        else { const int q = s4 - 2; w.x = cvt_pk_bf16(pB[8 * q + 0], pB[8 * q + 1]); w.y = cvt_pk_bf16(pB[8 * q + 2], pB[8 * q + 3]); w.z = cvt_pk_bf16(pB[8 * q + 4], pB[8 * q + 5]); w.w = cvt_pk_bf16(pB[8 * q + 6], pB[8 * q + 7]); }
        pw[s4] = __builtin_bit_cast(bf16x8, w);
      }
      if (!grpB) ATT_PV(t & 3);
    }
  }
#undef ATT_PV
#undef ATT_STAGE
  const float il = 1.f / half_swap_add(l);
  bf16_t* Ow = O0 + (size_t)(wid * 32 + r32) * 1024;
#pragma unroll
  for (int g4 = 0; g4 < 4; ++g4) {
    u32x2 w0, w1;
    w0.x = cvt_pk_bf16(o0[4 * g4 + 0] * il, o0[4 * g4 + 1] * il); w0.y = cvt_pk_bf16(o0[4 * g4 + 2] * il, o0[4 * g4 + 3] * il);
    w1.x = cvt_pk_bf16(o1[4 * g4 + 0] * il, o1[4 * g4 + 1] * il); w1.y = cvt_pk_bf16(o1[4 * g4 + 2] * il, o1[4 * g4 + 3] * il);
    *(u32x2*)(Ow + 8 * g4 + 4 * hi) = w0;
    *(u32x2*)(Ow + 32 + 8 * g4 + 4 * hi) = w1;
  }
}
__device__ __forceinline__ void attn_unit2(const bf16_t* Q0a, const bf16_t* Q0b, const bf16_t* Kbase, const bf16_t* Vbase, const int nkeys, bf16_t* O0a, bf16_t* O0b, LAS unsigned char* lds) {
  const int tid = ltid(), lane = tid & 63, r32 = lane & 31, hi = lane >> 5;
  const int wid = __builtin_amdgcn_readfirstlane(tid >> 6);
  const int NTL = nkeys >> 6;
  __syncthreads();
  const bf16_t* ksrc = Kbase + (size_t)lane * 64 + wid * 8;
  const bf16_t* vsrc = Vbase + (size_t)(16 * (wid & 3) + (lane >> 2)) * 64 + (wid >> 2) * 32 + (lane & 3) * 8;
  const unsigned ldsb = (unsigned)(size_t)lds;
#define ATT_STAGE(t, slot) do { \
    glds16(ksrc + (size_t)(t) * 64 * 64, (unsigned)__builtin_amdgcn_readfirstlane(ldsb + (slot) * ATT_SLOT + wid * 1024)); \
    glds16(vsrc + (size_t)(t) * 64 * 64, (unsigned)__builtin_amdgcn_readfirstlane(ldsb + (slot) * ATT_SLOT + 8192 + wid * 1024)); } while (0)
  ATT_STAGE(0, 0);
  if (NTL > 1) ATT_STAGE(1, 1);
  bf16x8 qr[2][4];
  {
    const bf16_t* Qa = Q0a + (size_t)(wid * 32 + r32) * 512;
    const bf16_t* Qb2 = Q0b + (size_t)(wid * 32 + r32) * 512;
#pragma unroll
    for (int d0 = 0; d0 < 4; ++d0) { qr[0][d0] = *(const bf16x8*)(Qa + d0 * 16 + hi * 8); qr[1][d0] = *(const bf16x8*)(Qb2 + d0 * 16 + hi * 8); }
  }
  f32x16 o0[2], o1[2];
#pragma unroll
  for (int hh = 0; hh < 2; ++hh)
#pragma unroll
    for (int r = 0; r < 16; ++r) { o0[hh][r] = 0.f; o1[hh][r] = 0.f; }
  float m[2] = {-1e30f, -1e30f}, l[2] = {0.f, 0.f};
  const int koff = hi * 1024 + r32 * 16;
  const int voff = 8192 + ((lane >> 4) & 1) * 32 + (lane & 3) * 8 + (4 * hi + ((lane & 15) >> 2)) * 64;
  int slot = 0;
  for (int t = 0; t < NTL; ++t) {
    if (t + 1 < NTL) asm volatile("s_waitcnt vmcnt(2) lgkmcnt(0)\n\ts_barrier" ::: "memory"); else asm volatile("s_waitcnt vmcnt(0) lgkmcnt(0)\n\ts_barrier" ::: "memory");
    __builtin_amdgcn_sched_barrier(0);
    if (t + 2 < NTL) { const int s2 = (slot >= 1) ? slot - 1 : 2; ATT_STAGE(t + 2, s2); }
    const lds_cptr kp = (lds_cptr)(lds + slot * ATT_SLOT + koff);
    const lds_cptr vp = (lds_cptr)(lds + slot * ATT_SLOT + voff);
    f32x16 pA[2], pB[2];
#pragma unroll
    for (int hh = 0; hh < 2; ++hh)
#pragma unroll
      for (int r = 0; r < 16; ++r) { pA[hh][r] = 0.f; pB[hh][r] = 0.f; }
#pragma unroll
    for (int d0 = 0; d0 < 4; ++d0) {
      const bf16x8 k0 = *(const LAS bf16x8*)(kp + d0 * 2048), k1 = *(const LAS bf16x8*)(kp + d0 * 2048 + 512);
#pragma unroll
      for (int hh = 0; hh < 2; ++hh) {
        pA[hh] = __builtin_amdgcn_mfma_f32_32x32x16_bf16(k0, qr[hh][d0], pA[hh], 0, 0, 0);
        pB[hh] = __builtin_amdgcn_mfma_f32_32x32x16_bf16(k1, qr[hh][d0], pB[hh], 0, 0, 0);
      }
    }
    bf16x8 pw[2][4];
#pragma unroll
    for (int hh = 0; hh < 2; ++hh) {
      const float rm = rowmax32(pA[hh], pB[hh]);
      const float mn = __builtin_fmaxf(m[hh], rm);
      const float alpha = __builtin_amdgcn_exp2f(m[hh] - mn);
      m[hh] = mn;
      float ps = 0.f;
#pragma unroll
      for (int r = 0; r < 16; ++r) { pA[hh][r] = __builtin_amdgcn_exp2f(pA[hh][r] - mn); pB[hh][r] = __builtin_amdgcn_exp2f(pB[hh][r] - mn); ps += pA[hh][r] + pB[hh][r]; }
      l[hh] = l[hh] * alpha + ps;
#pragma unroll
      for (int r = 0; r < 16; ++r) { o0[hh][r] *= alpha; o1[hh][r] *= alpha; }
#pragma unroll
      for (int s4 = 0; s4 < 4; ++s4) {
        u32x4 w;
        if (s4 < 2) { w.x = cvt_pk_bf16(pA[hh][8 * s4 + 0], pA[hh][8 * s4 + 1]); w.y = cvt_pk_bf16(pA[hh][8 * s4 + 2], pA[hh][8 * s4 + 3]); w.z = cvt_pk_bf16(pA[hh][8 * s4 + 4], pA[hh][8 * s4 + 5]); w.w = cvt_pk_bf16(pA[hh][8 * s4 + 6], pA[hh][8 * s4 + 7]); }
        else { const int q = s4 - 2; w.x = cvt_pk_bf16(pB[hh][8 * q + 0], pB[hh][8 * q + 1]); w.y = cvt_pk_bf16(pB[hh][8 * q + 2], pB[hh][8 * q + 3]); w.z = cvt_pk_bf16(pB[hh][8 * q + 4], pB[hh][8 * q + 5]); w.w = cvt_pk_bf16(pB[hh][8 * q + 6], pB[hh][8 * q + 7]); }
        pw[hh][s4] = __builtin_bit_cast(bf16x8, w);
      }
    }
#pragma unroll
    for (int s4 = 0; s4 < 4; ++s4) {
      const s16x4 a0l = vtr(vp + s4 * 1024), a0h = vtr(vp + s4 * 1024 + 512);
      const s16x4 a1l = vtr(vp + 4096 + s4 * 1024), a1h = vtr(vp + 4096 + s4 * 1024 + 512);
      const bf16x8 a0 = {a0l[0], a0l[1], a0l[2], a0l[3], a0h[0], a0h[1], a0h[2], a0h[3]};
      const bf16x8 a1 = {a1l[0], a1l[1], a1l[2], a1l[3], a1h[0], a1h[1], a1h[2], a1h[3]};
#pragma unroll
      for (int hh = 0; hh < 2; ++hh) {
        o0[hh] = __builtin_amdgcn_mfma_f32_32x32x16_bf16(a0, pw[hh][s4], o0[hh], 0, 0, 0);
        o1[hh] = __builtin_amdgcn_mfma_f32_32x32x16_bf16(a1, pw[hh][s4], o1[hh], 0, 0, 0);
      }
    }
    slot = (slot == 2) ? 0 : slot + 1;
  }
#undef ATT_STAGE
#pragma unroll
  for (int hh = 0; hh < 2; ++hh) {
    const float il = 1.f / half_swap_add(l[hh]);
    bf16_t* Ow = (hh ? O0b : O0a) + (size_t)(wid * 32 + r32) * 1024;
#pragma unroll
    for (int g4 = 0; g4 < 4; ++g4) {
      u32x2 w0, w1;
      w0.x = cvt_pk_bf16(o0[hh][4 * g4 + 0] * il, o0[hh][4 * g4 + 1] * il); w0.y = cvt_pk_bf16(o0[hh][4 * g4 + 2] * il, o0[hh][4 * g4 + 3] * il);
      w1.x = cvt_pk_bf16(o1[hh][4 * g4 + 0] * il, o1[hh][4 * g4 + 1] * il); w1.y = cvt_pk_bf16(o1[hh][4 * g4 + 2] * il, o1[hh][4 * g4 + 3] * il);
      *(u32x2*)(Ow + 8 * g4 + 4 * hi) = w0;
      *(u32x2*)(Ow + 32 + 8 * g4 + 4 * hi) = w1;
    }
  }
}
__device__ __forceinline__ void ph_att(const Params& p, bool ctx_q, LAS unsigned char* lds) {
  const int c = lbid(), G = lgdim();
  const int nunits = 256 + (ctx_q ? 32 : 0);
  for (int L = c; L < nunits; L += G) {
    if (L < 256) {
      const int grp = (L & 7) * 2 + ((L >> 3) >> 4), within = (L >> 3) & 15;
      const int b = grp >> 1, kvh = grp & 1, h0 = kvh * 4 + 2 * (within >> 3), qt = within & 7;
      const size_t row0 = (size_t)b * 2048 + qt * 256;
      const size_t kvb = (size_t)(b * 2 + kvh) * 2304 * 64;
      attn_unit2(p.Qb + row0 * 512 + h0 * 64, p.Qb + row0 * 512 + (h0 + 1) * 64, p.Kb + kvb, p.Vb + kvb, 2304, p.mix + row0 * 1024 + h0 * 64, p.mix + row0 * 1024 + (h0 + 1) * 64, lds);
    } else {
      const int u = L - 256, b = u >> 2, kvh = (u >> 1) & 1, h0 = kvh * 4 + 2 * (u & 1);
      const size_t row0 = (size_t)NL + b * 256;
      const size_t kvb = (size_t)(b * 2 + kvh) * 2304 * 64;
      attn_unit2(p.Qb + row0 * 512 + h0 * 64, p.Qb + row0 * 512 + (h0 + 1) * 64, p.Kb + kvb, p.Vb + kvb, 256, p.mix + row0 * 1024 + h0 * 64, p.mix + row0 * 1024 + (h0 + 1) * 64, lds);
    }
  }
  __syncthreads();
}

__device__ __forceinline__ int chunk_row0(int b, int dir, int cc) {
  if (cc < 2) return NL + b * 256 + (dir ? 1 - cc : cc) * 128;
  return b * 2048 + (dir ? 15 - (cc - 2) : cc - 2) * 128;
}
__device__ __forceinline__ int trq_addr(int lane, int quarter, int rowbase) {
  return quarter * 8192 + ((lane >> 4) & 1) * 32 + (lane & 3) * 8 + (rowbase + ((lane & 15) >> 2)) * 64;
}
__device__ __forceinline__ bf16x8 cat44(const s16x4 a, const s16x4 b) { return (bf16x8){a[0], a[1], a[2], a[3], b[0], b[1], b[2], b[3]}; }

__device__ __forceinline__ void ph_mlstm_u(const Params& p, LAS unsigned char* lds) {
  const int tid = ltid(), lane = tid & 63, r32 = lane & 31, hi = lane >> 5;
  const int wid = __builtin_amdgcn_readfirstlane(tid >> 6);
  LAS float* WS = (LAS float*)(lds + 65536);
  LAS float* NP = (LAS float*)(lds + 66048);
  LAS float* E1T = (LAS float*)(lds + 68096);
  __syncthreads();
  if (tid < 64) {
    float be[18], gm[18];
#pragma unroll
    for (int c = 0; c < 18; ++c) { be[c] = p.cBE[tid * 18 + c]; gm[c] = p.cGM[tid * 18 + c]; }
    float m_in = -1e30f;
#pragma unroll
    for (int c = 0; c < 18; ++c) {
      const float m_next = fmaxf(m_in + be[c], be[c] + gm[c]);
      E1T[tid * 18 + c] = (be[c] - m_next) * LOG2E;
      if (lbid() == 0) { p.cMIN[tid * 18 + c] = m_in * LOG2E; p.cDEC[tid * 18 + c] = expf(m_in + be[c] - m_next); }
      m_in = m_next;
    }
  }
  __syncthreads();
  for (int unit = lbid(); unit < 64 * 17; unit += lgdim()) {
    const int chain = unit / 17, cc = unit % 17;
    const int b = chain >> 3, hd = (chain >> 1) & 3, dir = chain & 1;
    const int row0 = chunk_row0(b, dir, cc);
    __syncthreads();
#pragma unroll
    for (int n = 0; n < 4; ++n) {
      const int ii = wid * 4 + n, qd = ii >> 3, rg = ii & 7;
      const bf16_t* src = p.km + (size_t)(row0 + rg * 16 + (lane >> 2)) * 512 + hd * 128 + qd * 32 + (lane & 3) * 8;
      __builtin_amdgcn_global_load_lds((const unsigned*)src, (LAS unsigned*)(lds + qd * 8192 + rg * 1024), 16, 0, 0);
    }
    u32x4 vraw[4];
#pragma unroll
    for (int n = 0; n < 4; ++n) {
      const int o = (tid + n * NTHR) * 16, qd = o >> 13, row = (o >> 6) & 127, pc = (o >> 4) & 3;
      vraw[n] = *(const u32x4*)(p.proj + (size_t)(row0 + row) * PROJW + 1792 + hd * 128 + qd * 32 + pc * 8);
    }
    __builtin_amdgcn_sched_barrier(0);
    if (tid < 128) WS[tid] = __builtin_amdgcn_exp2f(p.gsG[(size_t)(row0 + tid) * 8 + dir * 4 + hd] + E1T[chain * 18 + cc]);
    __syncthreads();
#pragma unroll
    for (int n = 0; n < 4; ++n) {
      const int o = (tid + n * NTHR) * 16, row = (o >> 6) & 127;
      float f[8];
      unpack8(vraw[n], f);
      const float w = WS[row];
#pragma unroll
      for (int j = 0; j < 8; ++j) f[j] *= w;
      *(LAS u32x4*)(lds + 32768 + o) = pack8(f);
    }
    asm volatile("s_waitcnt vmcnt(0)" ::: "memory");
    __syncthreads();
    {
      const int d = tid & 127, part = tid >> 7;
      float acc = 0.f;
      for (int s2 = 0; s2 < 32; ++s2) {
        const int srow = part * 32 + s2;
        const bf16_t kv = *(const LAS bf16_t*)(lds + (d >> 5) * 8192 + srow * 64 + (d & 31) * 2);
        acc += WS[srow] * bf2f(kv);
      }
      NP[part * 128 + d] = acc;
    }
    const int eb = wid >> 1, db0 = 2 * (wid & 1);
    f32x16 u0, u1;
#pragma unroll
    for (int r = 0; r < 16; ++r) { u0[r] = 0.f; u1[r] = 0.f; }
#pragma unroll
    for (int ks = 0; ks < 8; ++ks) {
      const int rb = ks * 16 + 8 * hi;
      const bf16x8 a = cat44(vtr((lds_cptr)(lds + 32768 + trq_addr(lane, eb, rb))), vtr((lds_cptr)(lds + 32768 + trq_addr(lane, eb, rb + 4))));
      const bf16x8 b0 = cat44(vtr((lds_cptr)(lds + trq_addr(lane, db0, rb))), vtr((lds_cptr)(lds + trq_addr(lane, db0, rb + 4))));
      const bf16x8 b1 = cat44(vtr((lds_cptr)(lds + trq_addr(lane, db0 + 1, rb))), vtr((lds_cptr)(lds + trq_addr(lane, db0 + 1, rb + 4))));
      u0 = __builtin_amdgcn_mfma_f32_32x32x16_bf16(a, b0, u0, 0, 0, 0);
      u1 = __builtin_amdgcn_mfma_f32_32x32x16_bf16(a, b1, u1, 0, 0, 0);
    }
    float* U = p.Ubuf + ((size_t)chain * 17 + cc) * 16384;
#pragma unroll
    for (int r = 0; r < 16; ++r) {
      const int erow = eb * 32 + (r & 3) + 8 * (r >> 2) + 4 * hi;
      U[(size_t)erow * 128 + db0 * 32 + r32] = u0[r];
      U[(size_t)erow * 128 + (db0 + 1) * 32 + r32] = u1[r];
    }
    __syncthreads();
    if (tid < 128) p.NLb[((size_t)chain * 17 + cc) * 128 + tid] = NP[tid] + NP[128 + tid] + NP[256 + tid] + NP[384 + tid];
  }
  __syncthreads();
}

__device__ __forceinline__ void ph_mlstm_scan(const Params& p, int bskip) {
  const int bsk = lgdim() > bskip ? bskip : 0;
  if (lbid() < bsk) return;
  const size_t gtid = (size_t)(lbid() - bsk) * NTHR + ltid(), gsz = (size_t)(lgdim() - bsk) * NTHR;
  for (size_t it = gtid; it < (size_t)64 * 8192; it += gsz) {
    const int chain = (int)(it >> 13), ed = (int)(it & 8191) * 2;
    float c0 = 0.f, c1 = 0.f;
    float2 uu[17]; float dd[17];
#pragma unroll
    for (int c = 0; c < 17; ++c) { dd[c] = p.cDEC[chain * 18 + c]; uu[c] = *(const float2*)(p.Ubuf + ((size_t)chain * 17 + c) * 16384 + ed); }
    __builtin_amdgcn_sched_barrier(0);
#pragma unroll
    for (int c = 0; c < 17; ++c) {
      c0 = dd[c] * c0 + uu[c].x; c1 = dd[c] * c1 + uu[c].y;
      *(unsigned*)(p.Cbf + ((size_t)chain * 18 + c + 1) * 16384 + ed) = cvt_pk_bf16(c0, c1);
    }
  }
  for (size_t it = gtid; it < (size_t)64 * 128; it += gsz) {
    const int chain = (int)(it >> 7), d = (int)(it & 127);
    float nv = 0.f;
    float nn[17], dd[17];
#pragma unroll
    for (int c = 0; c < 17; ++c) { dd[c] = p.cDEC[chain * 18 + c]; nn[c] = p.NLb[((size_t)chain * 17 + c) * 128 + d]; }
    __builtin_amdgcn_sched_barrier(0);
#pragma unroll
    for (int c = 0; c < 17; ++c) {
      nv = dd[c] * nv + nn[c];
      p.NVb[((size_t)chain * 18 + c + 1) * 128 + d] = nv;
    }
  }
}

__device__ __forceinline__ void ph_mlstm_h(const Params& p, int l, bool ctx_out, LAS unsigned char* lds) {
  const int e2 = l >> 1;
  const int tid = ltid(), lane = tid & 63, r32 = lane & 31, hi = lane >> 5;
  const int wid = __builtin_amdgcn_readfirstlane(tid >> 6);
  const int tb = wid & 3, dir = wid >> 2;
  LAS float* HX = (LAS float*)(lds);
  LAS float* GC = (LAS float*)(lds + 131072);
  const int j0 = ctx_out ? 0 : 2, nj = 18 - j0;
  for (int unit = lbid(); unit < 32 * nj; unit += lgdim()) {
    const int bh = unit / nj, j = j0 + unit % nj, b = bh >> 2, hd = bh & 3;
    const int row0 = (j < 2) ? NL + b * 256 + j * 128 : b * 2048 + (j - 2) * 128;
    const int cc = dir ? (j < 2 ? 1 - j : 19 - j) : j;
    const int chain = b * 8 + hd * 2 + dir;
    __syncthreads();
#pragma unroll
    for (int n = 0; n < 4; ++n) {
      const int ii = wid * 4 + n;
      { const int ch = ii >> 1, rh = ii & 1;
        const bf16_t* src = p.km + (size_t)(row0 + rh * 64 + lane) * 512 + hd * 128 + ch * 8;
        __builtin_amdgcn_global_load_lds((const unsigned*)src, (LAS unsigned*)(lds + ch * 2048 + rh * 1024), 16, 0, 0); }
      { const int qd = ii >> 3, rg = ii & 7;
        const bf16_t* src = p.proj + (size_t)(row0 + rg * 16 + (lane >> 2)) * PROJW + 1792 + hd * 128 + qd * 32 + (lane & 3) * 8;
        __builtin_amdgcn_global_load_lds((const unsigned*)src, (LAS unsigned*)(lds + 32768 + qd * 8192 + rg * 1024), 16, 0, 0); }
    }
#pragma unroll
    for (int n = 0; n < 8; ++n) {
      const int ii2 = wid * 8 + n, dd = ii2 >> 5, ch = (ii2 & 31) >> 1, rh = ii2 & 1;
      const int ccd = dd ? (j < 2 ? 1 - j : 19 - j) : j;
      if (ccd > 0) {
        const bf16_t* src = p.Cbf + ((size_t)(b * 8 + hd * 2 + dd) * 18 + ccd) * 16384 + (size_t)(rh * 64 + lane) * 128 + ch * 8;
        __builtin_amdgcn_global_load_lds((const unsigned*)src, (LAS unsigned*)(lds + 65536 + dd * 32768 + ch * 2048 + rh * 1024), 16, 0, 0);
      }
    }
    const int trow = row0 + tb * 32 + r32;
    bf16x8 qf[8];
#pragma unroll
    for (int ks = 0; ks < 8; ++ks) qf[ks] = *(const bf16x8*)(p.qm + (size_t)trow * 512 + hd * 128 + ks * 16 + hi * 8);
    const float MIN2 = p.cMIN[chain * 18 + cc];
    const float R2 = -fmaxf(MIN2, p.gsR[(size_t)trow * 8 + dir * 4 + hd]), BQ2 = p.gsB[(size_t)trow * 8 + dir * 4 + hd];
    f32x16 acc[4];
#pragma unroll
    for (int eb = 0; eb < 4; ++eb)
#pragma unroll
      for (int r = 0; r < 16; ++r) acc[eb][r] = 0.f;
    float nq = 0.f;
    if (cc > 0) {
      const float* nvp = p.NVb + ((size_t)chain * 18 + cc) * 128 + hi * 8;
#pragma unroll
      for (int ks = 0; ks < 8; ++ks) {
        const f32x4 n0 = *(const f32x4*)(nvp + ks * 16), n1 = *(const f32x4*)(nvp + ks * 16 + 4);
        float qv[8];
        unpack8(__builtin_bit_cast(u32x4, qf[ks]), qv);
        nq += n0[0] * qv[0] + n0[1] * qv[1] + n0[2] * qv[2] + n0[3] * qv[3] + n1[0] * qv[4] + n1[1] * qv[5] + n1[2] * qv[6] + n1[3] * qv[7];
      }
      nq = half_swap_add(nq);
    }
    const float* gh = p.g_hnorm + e2 * 512 + hd * 128;
    const bf16_t* obp = p.proj + (size_t)trow * PROJW + 2304 + hd * 128;
    const float winter = __builtin_amdgcn_exp2f(MIN2 + R2);
    if (tid < 256) GC[tid] = p.gsG[(size_t)(row0 + (tid & 127)) * 8 + (tid >> 7) * 4 + hd];
    asm volatile("s_waitcnt vmcnt(0)" ::: "memory");
    __syncthreads();
    if (cc > 0) {
#pragma unroll
      for (int eb = 0; eb < 4; ++eb)
#pragma unroll
        for (int ks = 0; ks < 8; ++ks) {
          const bf16x8 a = *(const LAS bf16x8*)(lds + 65536 + dir * 32768 + (2 * ks + hi) * 2048 + (eb * 32 + r32) * 16);
          acc[eb] = __builtin_amdgcn_mfma_f32_32x32x16_bf16(a, qf[ks], acc[eb], 0, 0, 0);
        }
#pragma unroll
      for (int eb = 0; eb < 4; ++eb)
#pragma unroll
        for (int r = 0; r < 16; ++r) acc[eb][r] *= winter;
    }
    float sw = 0.f;
    const int sb_lo = dir ? tb : 0, sb_hi = dir ? 3 : tb;
    for (int sb = sb_lo; sb <= sb_hi; ++sb) {
      f32x16 st;
#pragma unroll
      for (int r = 0; r < 16; ++r) st[r] = 0.f;
#pragma unroll
      for (int ks = 0; ks < 8; ++ks) {
        const bf16x8 kf = *(const LAS bf16x8*)(lds + (2 * ks + hi) * 2048 + (sb * 32 + r32) * 16);
        st = __builtin_amdgcn_mfma_f32_32x32x16_bf16(kf, qf[ks], st, 0, 0, 0);
      }
      const bool diag = (sb == tb);
#pragma unroll
      for (int g4 = 0; g4 < 4; ++g4) {
        const f32x4 gc = *(const LAS f32x4*)(GC + dir * 128 + sb * 32 + 8 * g4 + 4 * hi);
#pragma unroll
        for (int q = 0; q < 4; ++q) {
          const int sl = 8 * g4 + 4 * hi + q;
          float w = __builtin_amdgcn_exp2f(R2 + gc[q]) * st[4 * g4 + q];
          const bool keep = !diag || (dir ? (sl >= r32) : (sl <= r32));
          w = keep ? w : 0.f;
          sw += w;
          st[4 * g4 + q] = w;
        }
      }
      u32x4 p0, p1;
      p0.x = cvt_pk_bf16(st[0], st[1]); p0.y = cvt_pk_bf16(st[2], st[3]); p0.z = cvt_pk_bf16(st[4], st[5]); p0.w = cvt_pk_bf16(st[6], st[7]);
      p1.x = cvt_pk_bf16(st[8], st[9]); p1.y = cvt_pk_bf16(st[10], st[11]); p1.z = cvt_pk_bf16(st[12], st[13]); p1.w = cvt_pk_bf16(st[14], st[15]);
      const bf16x8 pw0 = __builtin_bit_cast(bf16x8, p0), pw1 = __builtin_bit_cast(bf16x8, p1);
#pragma unroll
      for (int eb = 0; eb < 4; ++eb) {
        const int rb = sb * 32 + 4 * hi;
        const bf16x8 a0 = cat44(vtr((lds_cptr)(lds + 32768 + trq_addr(lane, eb, rb))), vtr((lds_cptr)(lds + 32768 + trq_addr(lane, eb, rb + 8))));
        const bf16x8 a1 = cat44(vtr((lds_cptr)(lds + 32768 + trq_addr(lane, eb, rb + 16))), vtr((lds_cptr)(lds + 32768 + trq_addr(lane, eb, rb + 24))));
        acc[eb] = __builtin_amdgcn_mfma_f32_32x32x16_bf16(a0, pw0, acc[eb], 0, 0, 0);
        acc[eb] = __builtin_amdgcn_mfma_f32_32x32x16_bf16(a1, pw1, acc[eb], 0, 0, 0);
      }
    }
    sw = half_swap_add(sw);
    const float den = winter * nq + sw;
    const float dn = fmaxf(fabsf(den), __builtin_amdgcn_exp2f(R2 - BQ2));
    const float idn = 1.f / dn;
    __syncthreads();
    if (dir == 1) {
#pragma unroll
      for (int eb = 0; eb < 4; ++eb)
#pragma unroll
        for (int r = 0; r < 16; ++r) HX[(tb * 128 + eb * 32 + (r & 3) + 8 * (r >> 2) + 4 * hi) * 32 + r32] = acc[eb][r] * idn;
    }
    __syncthreads();
    if (dir == 0) {
      float ss = 0.f;
#pragma unroll
      for (int eb = 0; eb < 4; ++eb)
#pragma unroll
        for (int r = 0; r < 16; ++r) {
          const float v = acc[eb][r] * idn + HX[(tb * 128 + eb * 32 + (r & 3) + 8 * (r >> 2) + 4 * hi) * 32 + r32];
          acc[eb][r] = v; ss += v * v;
        }
      ss = half_swap_add(ss);
      const float inv = rsqrtf(ss * (1.f / 128.f) + EPS);
      bf16_t* op = p.mix + (size_t)trow * 1024 + 512 + hd * 128;
#pragma unroll
      for (int eb = 0; eb < 4; ++eb) {
        f32x4 gv[4]; u32x2 ow[4];
#pragma unroll
        for (int g4 = 0; g4 < 4; ++g4) { const int e0 = eb * 32 + 8 * g4 + 4 * hi; gv[g4] = *(const f32x4*)(gh + e0); ow[g4] = *(const u32x2*)(obp + e0); }
#pragma unroll
        for (int g4 = 0; g4 < 4; ++g4) {
          const int e0 = eb * 32 + 8 * g4 + 4 * hi;
          const float ob0 = __uint_as_float(ow[g4].x << 16), ob1 = __uint_as_float(ow[g4].x & 0xffff0000u), ob2 = __uint_as_float(ow[g4].y << 16), ob3 = __uint_as_float(ow[g4].y & 0xffff0000u);
          const float v0 = acc[eb][4 * g4 + 0] * inv * gv[g4][0] * sigmoidf_(ob0), v1 = acc[eb][4 * g4 + 1] * inv * gv[g4][1] * sigmoidf_(ob1);
          const float v2 = acc[eb][4 * g4 + 2] * inv * gv[g4][2] * sigmoidf_(ob2), v3 = acc[eb][4 * g4 + 3] * inv * gv[g4][3] * sigmoidf_(ob3);
          u32x2 w; w.x = cvt_pk_bf16(v0, v1); w.y = cvt_pk_bf16(v2, v3);
          *(u32x2*)(op + e0) = w;
        }
      }
    }
  }
  __syncthreads();
}

template <int EPL>
__device__ __forceinline__ void topk_column(const Params& p, const float* col, int e, int base, int cap, size_t mbase, int lane) {
  unsigned v[EPL];
#pragma unroll
  for (int k = 0; k < EPL; ++k) v[k] = __float_as_uint(col[k * 64 + lane]);
  unsigned thr = 0u;
  for (int bit = 30; bit >= 0; --bit) {
    const unsigned cand = thr | (1u << bit);
    unsigned c = 0;
#pragma unroll
    for (int k = 0; k < EPL; ++k) c += (v[k] >= cand) ? 1u : 0u;
#pragma unroll
    for (int o = 32; o > 0; o >>= 1) c += __shfl_xor(c, o);
    if (c >= (unsigned)cap) thr = cand;
  }
  unsigned totgt = 0;
#pragma unroll
  for (int k = 0; k < EPL; ++k) totgt += (unsigned)__popcll(__ballot(v[k] > thr));
  const unsigned need_eq = (unsigned)cap - totgt;
  unsigned cg = 0, ce = 0;
#pragma unroll
  for (int k = 0; k < EPL; ++k) {
    const bool gt = v[k] > thr, eq = v[k] == thr;
    const unsigned long long bg = __ballot(gt), be = __ballot(eq);
    const unsigned gtb = cg + __builtin_amdgcn_mbcnt_hi((unsigned)(bg >> 32), __builtin_amdgcn_mbcnt_lo((unsigned)bg, 0u));
    const unsigned eqb = ce + __builtin_amdgcn_mbcnt_hi((unsigned)(be >> 32), __builtin_amdgcn_mbcnt_lo((unsigned)be, 0u));
    const bool take = gt || (eq && eqb < need_eq);
    const int r = base + k * 64 + lane;
    const unsigned slot = gtb + (eqb < need_eq ? eqb : need_eq);
    if (take) { p.slotmap[(size_t)r * 16 + e] = (int)slot; p.rowidx[mbase + slot] = r; p.gatev[mbase + slot] = __uint_as_float(v[k]); }
    else p.slotmap[(size_t)r * 16 + e] = -1;
    cg += (unsigned)__popcll(bg); ce += (unsigned)__popcll(be);
  }
}
__device__ __forceinline__ void ph_topk(const Params& p, bool ctx, float* sm) {
  const int tid = ltid(), lane = tid & 63, wv = tid >> 6;
  const int ntask = ctx ? 32 : 16;
  for (int task = lbid(); task < ntask; task += lgdim()) {
    const bool lat = task < 16;
    const int b = (task >> 1) & 7, eh = task & 1, n = lat ? 2048 : 256, cap = lat ? 256 : 32, base = lat ? b * 2048 : NL + b * 256;
    __syncthreads();
    for (int idx0 = tid; idx0 < n * 2; idx0 += 8 * NTHR) {
      float4 a[8];
#pragma unroll
      for (int u = 0; u < 8; ++u) { const int idx = min(idx0 + u * NTHR, n * 2 - 1); a[u] = *(const float4*)(p.aff + (size_t)(base + (idx >> 1)) * 16 + eh * 8 + (idx & 1) * 4); }
      __builtin_amdgcn_sched_barrier(0);
#pragma unroll
      for (int u = 0; u < 8; ++u) {
        const int idx = idx0 + u * NTHR, row = idx >> 1, q = idx & 1;
        if (idx < n * 2) { sm[(q * 4 + 0) * n + row] = a[u].x; sm[(q * 4 + 1) * n + row] = a[u].y; sm[(q * 4 + 2) * n + row] = a[u].z; sm[(q * 4 + 3) * n + row] = a[u].w; }
      }
    }
    __syncthreads();
    {
      const int e = eh * 8 + wv;
      if (lat) topk_column<32>(p, sm + wv * n, e, base, cap, (size_t)e * 2048 + (size_t)b * 256, lane);
      else topk_column<4>(p, sm + wv * n, e, base, cap, (size_t)MOE_L + (size_t)e * 256 + (size_t)b * 32, lane);
    }
  }
  __syncthreads();
}

template <int W>
__device__ __forceinline__ void pool_item(const Params& p, int r, int c8) {
  int t, n;
  if (r < NL) { t = r & 2047; n = 2048; } else { t = (r - NL) & 255; n = 256; }
  constexpr int lo = W / 2;
  const bf16_t* up = p.proj + (size_t)r * 1024 + c8;
  u32x4 raw[W];
  int cnt = 0;
#pragma unroll
  for (int k = 0; k < W; ++k) {
    const int tt = t - lo + k;
    const bool ok = tt >= 0 && tt < n;
    const int tc = tt < 0 ? 0 : (tt >= n ? n - 1 : tt);
    const u32x4 ld = *(const u32x4*)(up + (ptrdiff_t)(tc - t) * 1024);
    raw[k].x = ok ? ld.x : 0u; raw[k].y = ok ? ld.y : 0u; raw[k].z = ok ? ld.z : 0u; raw[k].w = ok ? ld.w : 0u;
    cnt += ok ? 1 : 0;
  }
  float s8[8], f[8], uc[8];
#pragma unroll
  for (int j = 0; j < 8; ++j) s8[j] = 0.f;
#pragma unroll
  for (int k = 0; k < W; ++k) {
    unpack8(raw[k], f);
#pragma unroll
    for (int j = 0; j < 8; ++j) s8[j] += f[j];
  }
  unpack8(raw[lo], uc);
  const float ic = 1.f / (float)cnt;
#pragma unroll
  for (int j = 0; j < 8; ++j) f[j] = s8[j] * ic - uc[j];
  *(u32x4*)(p.mix + (size_t)r * 1024 + c8) = pack8(f);
}
__device__ __forceinline__ void ph_pool(const Params& p, int nrows) {
  const size_t gtid = (size_t)lbid() * NTHR + ltid(), gsz = (size_t)lgdim() * NTHR;
  for (size_t it = gtid; it < (size_t)nrows * 128; it += gsz) {
    const int g = (int)(it / ((size_t)nrows * 32));
    const size_t rem = it - (size_t)g * nrows * 32;
    const int r = (int)(rem >> 5), c8 = g * 256 + (int)(rem & 31) * 8;
    if (g == 0) pool_item<2>(p, r, c8);
    else if (g == 1) pool_item<4>(p, r, c8);
    else if (g == 2) pool_item<8>(p, r, c8);
    else pool_item<16>(p, r, c8);
  }
}

enum { PH_INIT = 0, PH_NORM1, PH_GEMM_IN_EVEN, PH_POST_EVEN, PH_ATT, PH_MLSTM_U, PH_MLSTM_SCAN, PH_MLSTM_H, PH_GEMM_OUT, PH_NORM2, PH_TOPK, PH_GATHER,
       PH_MOE_GU, PH_MOE_D, PH_GEMM_IN_ODD, PH_POOL, PH_GEMM_GRP, PH_FINAL };

typedef const __attribute__((address_space(4))) Params* KParams;
__device__ __forceinline__ const Params& get_params() {
  KParams kp = (KParams)__builtin_amdgcn_kernarg_segment_ptr();
  asm volatile("" : "+s"(kp));
  return *(const Params*)kp;
}
__device__ __forceinline__ int idle_slots(int nu, int G, int c) {
  const int mx = (nu + G - 1) / G, mine = c < nu ? (nu - c + G - 1) / G : 0;
  return mx - mine;
}
__device__ __forceinline__ void run_phase(int ph, int l, unsigned char* shm) {
  const Params& p = get_params();
  float* sm = (float*)shm;
  LAS unsigned char* lds = (LAS unsigned char*)shm;
  const bool ctx_next = (l < 2);
  const bool ctx_used = (l < 3);
  const int G = lgdim(), c = lbid();
  switch (ph) {
    case PH_INIT: ph_init(p, sm); break;
    case PH_NORM1: {
      const int ncomb = (l == 0) ? 0 : ((l - 1) < 2 ? NT : NL);
      ph_norm(p, l, 1, ctx_used ? NT : NL, ncomb, l - 1, sm);
    } break;
    case PH_GEMM_IN_EVEN: {
      g8::SchedDense S{(const char*)p.hbuf, (const char*)(p.WinE + (size_t)(l >> 1) * PROJW * 1024), 1024, 1024, NT / 256, PROJW / 256, 0, G, c};
      g8::EpiBf16 E{p.proj, PROJW};
      g8::gemm_phase(lds, 1024, 1024, 1024, S, E);
      conv_quota(p, idle_slots(S.nM * S.nN, G, c) * 3, sm);
    } break;
    case PH_POST_EVEN: ph_post_even(p, l, sm); break;
    case PH_MLSTM_U: ph_mlstm_u(p, lds); break;
    case PH_ATT: ph_att(p, ctx_next, lds); ph_mlstm_scan(p, ctx_next ? 32 : 0); conv_quota(p, idle_slots(256 + (ctx_next ? 32 : 0), G, c) * 1, sm); break;
    case PH_MLSTM_H: ph_mlstm_h(p, l, ctx_next, lds); conv_quota(p, idle_slots(32 * (ctx_next ? 18 : 16), G, c) * 3, sm); break;
    case PH_GEMM_OUT: {
      g8::SchedDense S{(const char*)p.mix, (const char*)(p.WoutE + (size_t)(l >> 1) * 1024 * 1024), 1024, 1024, (ctx_next ? NT : NL) / 256, 4, 0, G, c};
      g8::EpiBf16 E{p.ybuf, 1024};
      g8::gemm_phase(lds, 1024, 1024, 1024, S, E);
      conv_quota(p, idle_slots(S.nM * S.nN, G, c) * 3, sm);
    } break;
    case PH_NORM2: ph_norm(p, l, 2, ctx_next ? NT : NL, 0, 0, sm); break;
    case PH_TOPK: ph_topk(p, ctx_next, sm); conv_until(p, l == 0 ? CE4 : (l == 1 ? CE7 : (l == 2 ? CE10 : CE11)), sm); break;
    case PH_MOE_GU: {
      g8::SchedMoe S{(const char*)p.Xs, (const char*)(p.Wgu + (size_t)l * NEXP * 2048 * 1024), 8, 2048, 128, ctx_next ? 1152 : 1024, G, c};
      g8::EpiSwiGLU E{p.Abuf};
      g8::gemm_phase<true>(lds, 1024, 1024, 1024, S, E, p.rowidx, (const char*)p.hbuf);
      conv_quota(p, idle_slots(S.nu, G, c) * 3, sm);
    } break;
    case PH_MOE_D: {
      g8::SchedMoe S{(const char*)p.Abuf, (const char*)(p.Wd + (size_t)l * NEXP * 1024 * 1024), 4, 1024, 256, ctx_next ? 576 : 512, G, c};
      g8::EpiDown E{p.Ybuf, p.gatev};
      g8::gemm_phase(lds, 1024, 1024, 1024, S, E);
      conv_quota(p, idle_slots(S.nu, G, c) * 3, sm);
    } break;
    case PH_GEMM_IN_ODD: {
      g8::SchedDense S{(const char*)p.hbuf, (const char*)(p.WinO + (size_t)(l >> 1) * 1024 * 1024), 1024, 1024, (ctx_next ? NT : NL) / 256, 4, 0, G, c};
      g8::EpiBf16 E{p.proj, 1024};
      g8::gemm_phase(lds, 1024, 1024, 1024, S, E);
      conv_quota(p, idle_slots(S.nM * S.nN, G, c) * 3, sm);
    } break;
    case PH_POOL: ph_pool(p, ctx_next ? NT : NL); break;
    case PH_GEMM_GRP: {
      g8::SchedDense S{(const char*)p.mix, (const char*)(p.Wgrp + (size_t)(l >> 1) * 1024 * 256), 1024, 256, (ctx_next ? NT : NL) / 256, 4, 512, G, c};
      g8::EpiBf16 E{p.ybuf, 1024};
      g8::gemm_phase(lds, 256, 1024, 256, S, E);
      conv_quota(p, idle_slots(S.nM * S.nN, G, c) * 1, sm);
    } break;
    case PH_FINAL: ph_norm(p, 3, 3, NL, NL, 3, sm); break;
  }
}

__global__ void __launch_bounds__(NTHR) mega_kernel(Params p) {
  extern __shared__ __attribute__((aligned(16))) unsigned char shm[];
  cg::grid_group grid = cg::this_grid();
  volatile LAS unsigned* st = (volatile LAS unsigned*)((LAS unsigned char*)shm + g8::STAGE_BYTES + 1536);
  if (threadIdx.x < 2) st[threadIdx.x] = 0u;
  __syncthreads();
  unsigned* barw;
  { const Params& q = get_params(); barw = q.barw; }
  const XcdBarrier xb = xcd_barrier_post(barw, st);
  const int nprog = p.nprog;
  for (int i = 0; i < nprog; ++i) {
    int ph, l;
    { const Params& q = get_params(); ph = q.prog_ph[i]; l = q.prog_l[i]; }
    run_phase(ph, l, shm);
    if (i + 1 < nprog) { if (nprog > 1000) grid.sync(); else xcd_barrier(xb); }
  }
}

extern "C" void kernel_launch(void* const* d_in, const int* in_sizes, int n_in, void* d_out, int out_size, void* d_ws, size_t ws_size,
                              hipStream_t stream) {
  Params p{};
  const float* const* in = (const float* const*)d_in;
  p.x = in[0]; p.c = in[1]; p.ctx = in[2]; p.c_ctx = in[3]; p.w_mod = in[4]; p.b_mod = in[5]; p.g_norm1 = in[6]; p.g_norm2 = in[7];
  p.w_in_even = in[8]; p.w_out_even = in[9]; p.g_qnorm = in[10]; p.g_knorm = in[11]; p.w_conv = in[12]; p.b_gate = in[13];
  p.g_hnorm = in[14]; p.w_in_odd = in[15]; p.w_pool_grp = in[16]; p.s_pool = in[17]; p.w_router = in[18]; p.w_exp_gate = in[19];
  p.w_exp_up = in[20]; p.w_exp_down = in[21]; p.g_final = in[22];
  p.out = (float*)d_out;
  char* w = (char*)d_ws;
  size_t off = 0;
  auto take = [&](size_t bytes) { char* r = w + off; off += (bytes + 255) & ~(size_t)255; return (void*)r; };
  p.xcur = (bf16_t*)take((size_t)NT * 1024 * 2);
  p.mod = (float*)take(4 * 9 * 6144 * 4);
  p.hbuf = (bf16_t*)take((size_t)NT * 1024 * 2);
  p.Ybuf = (bf16_t*)take((size_t)MOE_T * 1024 * 2);
  p.gatev = (float*)take(MOE_T * 4);
  p.rowidx = (int*)take(MOE_T * 4);
  p.slotmap = (int*)take((size_t)NT * 16 * 4);
  p.barw = (unsigned*)take(XCD_BAR_WORDS * 4);
  p.aff = (float*)take((size_t)NT * 16 * 4);
  p.gates = (float*)take((size_t)NT * 16 * 4);
  p.WinE = (bf16_t*)take((size_t)2 * PROJW * 1024 * 2);
  p.WoutE = (bf16_t*)take((size_t)2 * 1024 * 1024 * 2);
  p.WinO = (bf16_t*)take((size_t)2 * 1024 * 1024 * 2);
  p.Wgrp = (bf16_t*)take((size_t)2 * 1024 * 256 * 2);
  p.Wgu = (bf16_t*)take((size_t)4 * NEXP * 2048 * 1024 * 2);
  p.Wd = (bf16_t*)take((size_t)4 * NEXP * 1024 * 1024 * 2);
  const size_t uoff = off;
  p.proj = (bf16_t*)take((size_t)NT * PROJW * 2);
  p.Qb = (bf16_t*)take((size_t)NT * 512 * 2);
  p.Kb = (bf16_t*)take((size_t)NB * 2 * 2304 * 64 * 2);
  p.Vb = (bf16_t*)take((size_t)NB * 2 * 2304 * 64 * 2);
  p.qm = (bf16_t*)take((size_t)NT * 512 * 2);
  p.km = (bf16_t*)take((size_t)NT * 512 * 2);
  p.gsG = (float*)take((size_t)NT * 8 * 4);
  p.gsR = (float*)take((size_t)NT * 8 * 4);
  p.gsB = (float*)take((size_t)NT * 8 * 4);
  p.cMIN = (float*)take(64 * 18 * 4);
  p.cE1 = (float*)take(64 * 18 * 4);
  p.cDEC = (float*)take(64 * 18 * 4);
  p.cBE = (float*)take(64 * 18 * 4);
  p.cGM = (float*)take(64 * 18 * 4);
  p.Ubuf = (float*)take((size_t)64 * 17 * 16384 * 4);
  p.NLb = (float*)take((size_t)64 * 17 * 128 * 4);
  p.NVb = (float*)take((size_t)64 * 18 * 128 * 4);
  p.Cbf = (bf16_t*)take((size_t)64 * 18 * 16384 * 2);
  p.mix = (bf16_t*)take((size_t)NT * 1024 * 2);
  p.ybuf = (bf16_t*)take((size_t)NT * 1024 * 2);
  const size_t uend = off;
  off = uoff;
  p.Xs = (bf16_t*)take((size_t)MOE_T * 1024 * 2);
  p.Abuf = (bf16_t*)take((size_t)MOE_T * 1024 * 2);
  if (off < uend) off = uend;
  if (off > ws_size) { fprintf(stderr, "ws too small: need %zu have %zu\n", off, ws_size); return; }

  int n = 0;
  auto add = [&](int ph, int l) { p.prog_ph[n] = (unsigned char)ph; p.prog_l[n] = (unsigned char)l; ++n; };
  add(PH_INIT, 0);
  for (int l = 0; l < 4; ++l) {
    add(PH_NORM1, l);
    if ((l & 1) == 0) {
      add(PH_GEMM_IN_EVEN, l); add(PH_POST_EVEN, l); add(PH_MLSTM_U, l); add(PH_ATT, l); add(PH_MLSTM_H, l); add(PH_GEMM_OUT, l);
    } else {
      add(PH_GEMM_IN_ODD, l); add(PH_POOL, l); add(PH_GEMM_GRP, l);
    }
    add(PH_NORM2, l); add(PH_TOPK, l); add(PH_MOE_GU, l); add(PH_MOE_D, l);
  }
  add(PH_FINAL, 0);
  p.nprog = n;

  const int LDS = g8::STAGE_BYTES + 2048;
  static int grid_blocks = 0;
  if (!grid_blocks) {
    (void)hipFuncSetAttribute((const void*)mega_kernel, hipFuncAttributeMaxDynamicSharedMemorySize, LDS);
    int dev = 0, cus = 0, per_cu = 0;
    (void)hipGetDevice(&dev);
    (void)hipDeviceGetAttribute(&cus, hipDeviceAttributeMultiprocessorCount, dev);
    (void)hipOccupancyMaxActiveBlocksPerMultiprocessor(&per_cu, mega_kernel, NTHR, LDS);
    if (per_cu < 1) per_cu = 1;
    if (per_cu > 1) per_cu = 1;
    grid_blocks = cus * per_cu;
  }
  (void)hipMemsetAsync(p.barw, 0, XCD_BAR_WORDS * 4, stream);
  void* args[] = {&p};
  hipError_t e = hipLaunchCooperativeKernel((void*)mega_kernel, dim3(grid_blocks), dim3(NTHR), args, LDS, stream);
  if (e != hipSuccess) fprintf(stderr, "cooperative launch failed: %s (grid %d)\n", hipGetErrorString(e), grid_blocks);
}
```

```cpp
#include <hip/hip_runtime.h>
#include <hip/hip_cooperative_groups.h>
#include <math.h>
#include <stdio.h>
namespace cg = cooperative_groups;

#define DM 1024
#define NB 8
#define SEQ 2048
#define CTXL 256
#define NL (NB * SEQ)
#define NC (NB * CTXL)
#define NT (NL + NC)
#define EVEN_IN 2832
#define PROJW 2816
#define NEXP 16
#define MOE_L (NEXP * NB * 256)
#define MOE_C (NEXP * NB * 32)
#define MOE_T (MOE_L + MOE_C)
#define EPS 1e-6f
#define NTHR 512
#define LAS __attribute__((address_space(3)))

typedef unsigned short bf16_t;
typedef short bf16x8 __attribute__((ext_vector_type(8)));
typedef float f32x4 __attribute__((ext_vector_type(4)));
typedef unsigned u32x4 __attribute__((ext_vector_type(4)));
typedef unsigned u32x2 __attribute__((ext_vector_type(2)));

struct Params {
  const float *x, *c, *ctx, *c_ctx, *w_mod, *b_mod, *g_norm1, *g_norm2, *w_in_even, *w_out_even, *g_qnorm, *g_knorm,
      *w_conv, *b_gate, *g_hnorm, *w_in_odd, *w_pool_grp, *s_pool, *w_router, *w_exp_gate, *w_exp_up, *w_exp_down, *g_final;
  float* out;
  bf16_t* xcur;
  float *mod, *gates, *aff, *gatev, *gsG, *gsR, *gsB, *cMIN, *cE1, *cDEC, *cBE, *cGM, *Ubuf, *NLb, *NVb;
  bf16_t *hbuf, *proj, *mix, *Xs, *Abuf, *Ybuf, *Qb, *Kb, *Vb, *qm, *km, *Cbf, *ybuf;
  bf16_t *WinE, *WoutE, *WinO, *Wgrp, *Wgu, *Wd;
  int *rowidx, *slotmap;
  unsigned* barw;
  int nprog;
  unsigned char prog_ph[60], prog_l[60];
};

__device__ __forceinline__ float siluf(float v) { return v / (1.f + expf(-v)); }
__device__ __forceinline__ float sigmoidf_(float v) { return 1.f / (1.f + expf(-v)); }
__device__ __forceinline__ float logsigmoidf_(float v) { return fminf(v, 0.f) - __logf(1.f + __expf(-fabsf(v))); }
__device__ __forceinline__ float wave_sum(float v) {
#pragma unroll
  for (int o = 32; o > 0; o >>= 1) v += __shfl_xor(v, o);
  return v;
}
#define LDS_BARRIER() do { asm volatile("s_waitcnt lgkmcnt(0)" ::: "memory"); __builtin_amdgcn_s_barrier(); asm volatile("" ::: "memory"); } while (0)
__device__ __forceinline__ int modrow(int r) { return r < NL ? (r >> 11) : 8; }
__device__ __forceinline__ float bf2f(bf16_t v) { return __uint_as_float(((unsigned)v) << 16); }
typedef float f32x2_t __attribute__((ext_vector_type(2)));
typedef __bf16 bf16x2_t __attribute__((ext_vector_type(2)));
__device__ __forceinline__ unsigned cvt_pk_bf16(float lo, float hi) {
  const f32x2_t v = {lo, hi};
  return __builtin_bit_cast(unsigned, __builtin_convertvector(v, bf16x2_t));
}
__device__ __forceinline__ bf16_t f2bf(float f) { return (bf16_t)(cvt_pk_bf16(f, 0.f) & 0xffffu); }
__device__ __forceinline__ void unpack8(const u32x4 w, float (&f)[8]) {
  f[0] = __uint_as_float(w.x << 16); f[1] = __uint_as_float(w.x & 0xffff0000u); f[2] = __uint_as_float(w.y << 16); f[3] = __uint_as_float(w.y & 0xffff0000u);
  f[4] = __uint_as_float(w.z << 16); f[5] = __uint_as_float(w.z & 0xffff0000u); f[6] = __uint_as_float(w.w << 16); f[7] = __uint_as_float(w.w & 0xffff0000u);
}
__device__ __forceinline__ u32x4 pack8(const float (&f)[8]) {
  u32x4 w; w.x = cvt_pk_bf16(f[0], f[1]); w.y = cvt_pk_bf16(f[2], f[3]); w.z = cvt_pk_bf16(f[4], f[5]); w.w = cvt_pk_bf16(f[6], f[7]);
  return w;
}

__device__ __forceinline__ int ltid() { int t = threadIdx.x; asm volatile("" : "+v"(t)); return t; }
__device__ __forceinline__ int lbid() { int b = blockIdx.x; asm volatile("" : "+s"(b)); return b; }
__device__ __forceinline__ int lgdim() { int g = gridDim.x; asm volatile("" : "+s"(g)); return g; }

#define XB_TMO      128
#define XB_XCNT(j)  (256  + 64 * (j))
#define XB_XSUB(j)  (1280 + 64 * (j))
#define XB_XGEN(j)  (2304 + 64 * (j))
#define XB_TOP      3328
#define XB_TOPGEN   3392
#define XCD_BAR_WORDS 3456
#define XB_SPIN_CAP (1u << 18)
__device__ __forceinline__ unsigned xb_ld(unsigned* p)              { return __hip_atomic_load(p, __ATOMIC_RELAXED, __HIP_MEMORY_SCOPE_AGENT); }
__device__ __forceinline__ unsigned xb_add(unsigned* p, unsigned v) { return __hip_atomic_fetch_add(p, v, __ATOMIC_RELAXED, __HIP_MEMORY_SCOPE_AGENT); }
__device__ __forceinline__ unsigned xb_xcc_id() { return (unsigned)__builtin_amdgcn_s_getreg((3 << 11) | 20) & 0xFu; }
#define XB_SPIN(cond, bar) do { unsigned _sp = 0; while (cond) { __builtin_amdgcn_s_sleep(1); \
    if ((++_sp & 255u) == 0u) { if (xb_ld(&(bar)[XB_TMO])) break; if (_sp > XB_SPIN_CAP) { atomicAdd(&(bar)[XB_TMO], 1u); break; } } } } while (0)
struct XcdBarrier { unsigned* bar; unsigned x; volatile LAS unsigned* st; };
__device__ __forceinline__ XcdBarrier xcd_barrier_post(unsigned* bar, volatile LAS unsigned* st) {
  XcdBarrier b; b.bar = bar; b.x = xb_xcc_id(); b.st = st;
  if (threadIdx.x == 0) (void)xb_add(&bar[XB_XCNT(b.x)], 1u);
  return b;
}
__device__ __forceinline__ void xcd_barrier_complete(unsigned* bar, unsigned x, unsigned& nloc, unsigned& nx) {
  const unsigned G = gridDim.x * gridDim.y * gridDim.z;
  unsigned sum, cnt, mine, sp = 0u;
  for (;;) {
    sum = 0u; cnt = 0u; mine = 0u;
#pragma unroll
    for (unsigned j = 0; j < 16; ++j) { const unsigned c = xb_ld(&bar[XB_XCNT(j)]); sum += c; cnt += (c > 0u) ? 1u : 0u; mine = (j == x) ? c : mine; }
    if (sum == G) break;
    __builtin_amdgcn_s_sleep(1);
    if ((++sp & 255u) == 0u) { if (xb_ld(&bar[XB_TMO])) break; if (sp > XB_SPIN_CAP) { atomicAdd(&bar[XB_TMO], 1u); break; } }
  }
  nloc = mine > 0u ? mine : 1u; nx = cnt > 0u ? cnt : 1u;
}
__device__ __forceinline__ void xcd_barrier(const XcdBarrier& b) {
  asm volatile("s_waitcnt vmcnt(0)" ::: "memory");
  __syncthreads();
  if (threadIdx.x == 0) {
    unsigned* bar = b.bar;
    __builtin_amdgcn_s_waitcnt(0);
    unsigned nloc = b.st[0], nx = b.st[1];
    if (nloc == 0u) { xcd_barrier_complete(bar, b.x, nloc, nx); b.st[0] = nloc; b.st[1] = nx; }
    const unsigned old = xb_add(&bar[XB_XSUB(b.x)], 1u);
    const unsigned gen = old / nloc;
    if (old + 1u == (gen + 1u) * nloc) {
      __builtin_amdgcn_fence(__ATOMIC_RELEASE, "agent");
      asm volatile("s_waitcnt vmcnt(0)" ::: "memory");
      const unsigned og = xb_add(&bar[XB_TOP], 1u);
      const unsigned tg = og / nx;
      if (og + 1u == (tg + 1u) * nx) xb_add(&bar[XB_TOPGEN], 1u);
      else XB_SPIN(xb_ld(&bar[XB_TOPGEN]) == tg, bar);
      __builtin_amdgcn_fence(__ATOMIC_ACQUIRE, "agent");
      xb_add(&bar[XB_XGEN(b.x)], 1u);
      asm volatile("s_waitcnt vmcnt(0)" ::: "memory");
    } else {
      XB_SPIN(xb_ld(&bar[XB_XGEN(b.x)]) == gen, bar);
      __builtin_amdgcn_fence(__ATOMIC_ACQUIRE, "agent");
      asm volatile("s_waitcnt vmcnt(0)" ::: "memory");
    }
  }
  __syncthreads();
}

namespace g8 {
constexpr int BM = 256, BK = 64, HALF = 128, HTB = HALF * BK * 2, STAGE_BYTES = 8 * HTB;
__device__ __forceinline__ int lds_byte(int r, int c) { const int st = (r >> 4) * 2 + (c >> 5), rr = r & 15, cc = c & 31, ob = rr * 64 + cc * 2; return st * 1024 + (ob ^ (((ob >> 9) & 1) << 5)); }
__device__ __forceinline__ void stage_rc(int b, int& R, int& C) { const int st = b / 1024, sb = b % 1024, swz = sb ^ (((sb >> 9) & 1) << 5); R = (st >> 1) * 16 + swz / 64; C = (st & 1) * 32 + (swz % 64) / 2; }
__device__ __forceinline__ int perm32(int rho) { const int n = rho >> 4, i = rho & 15; return 8 * (i >> 2) + 4 * n + (i & 3); }

struct Unit { const char* A; const char* B; int row0, col0; };

template <bool GATHER = false, class Epi, class Sched>
__device__ __forceinline__ void gemm_phase(LAS unsigned char* lds, const int K, const int lda, const int ldb, const Sched& S, const Epi& E, const int* gidx = nullptr, const char* gbaseA = nullptr) {
  const int tid = ltid(), wid = __builtin_amdgcn_readfirstlane(tid >> 6), lane = tid & 63, wr = wid >> 2, wc = wid & 3, fr = lane & 15, fq = lane >> 4;
  const int nt = K / BK;
  unsigned voffA[2], voffB[2], gC2[2];
  int gR[2];
#pragma unroll
  for (int i = 0; i < 2; ++i) {
    int R, C;
    stage_rc(tid * 16 + i * 8192, R, C);
    const int Rb = (R & ~31) + perm32(R & 31);
    voffA[i] = (unsigned)(R * lda + C) * 2u;
    voffB[i] = (unsigned)(Rb * ldb + C) * 2u;
    gR[i] = R; gC2[i] = (unsigned)C * 2u;
  }
  unsigned gcur[2][2], gnxt[2][2];
  auto gload = [&](int row0, unsigned (&g)[2][2]) {
#pragma unroll
    for (int h = 0; h < 2; ++h)
#pragma unroll
      for (int i = 0; i < 2; ++i) g[h][i] = (unsigned)gidx[row0 + h * HALF + gR[i]];
  };
  const size_t kstep = (size_t)(BK * 2);
  const size_t hstepA = (size_t)HALF * lda * 2, hstepB = (size_t)HALF * ldb * 2;
  const unsigned ldsw = (unsigned)wid * 1024u;
  const int aoff = lds_byte(wr * 64 + fr, fq * 8), boff = lds_byte(wc * 32 + fr, fq * 8);
#define PG8_SA(b, h) (((b) * 2 + (h)) * HTB)
#define PG8_SB(b, h) ((4 + (b) * 2 + (h)) * HTB)
#define PG8_STAGE(bufoff, gbase, voff) do { _Pragma("unroll") for (int _i = 0; _i < 2; ++_i) \
    __builtin_amdgcn_global_load_lds((const unsigned*)((const char*)(gbase) + (voff)[_i]), (LAS unsigned*)(lds + (bufoff) + ldsw + _i * 8192), 16, 0, 0); } while (0)
#define PG8_LDA(dst, b, h) do { _Pragma("unroll") for (int m = 0; m < 4; ++m) _Pragma("unroll") for (int k = 0; k < 2; ++k) dst[m][k] = *(const LAS bf16x8*)(lds + PG8_SA(b, h) + aoff + m * 2048 + k * 1024); } while (0)
#define PG8_LDB(dst, b, h) do { _Pragma("unroll") for (int n = 0; n < 2; ++n) _Pragma("unroll") for (int k = 0; k < 2; ++k) dst[n][k] = *(const LAS bf16x8*)(lds + PG8_SB(b, h) + boff + n * 2048 + k * 1024); } while (0)
#define PG8_MMA(ai, bj, At, Bt) do { __builtin_amdgcn_s_setprio(1); _Pragma("unroll") for (int m = 0; m < 4; ++m) _Pragma("unroll") for (int n = 0; n < 2; ++n) _Pragma("unroll") for (int k = 0; k < 2; ++k) \
    acc[ai][bj][m][n] = __builtin_amdgcn_mfma_f32_16x16x32_bf16(Bt[n][k], At[m][k], acc[ai][bj][m][n], 0, 0, 0); __builtin_amdgcn_s_setprio(0); } while (0)
#define PG8_WAIT_V(n) asm volatile("s_waitcnt vmcnt(" #n ")" ::: "memory")
#define PG8_WAIT_L(n) asm volatile("s_waitcnt lgkmcnt(" #n ")" ::: "memory")
#define PG8_BAR __builtin_amdgcn_s_barrier()
#define PG8_SCHED __builtin_amdgcn_sched_barrier(0)
#define PG8_STAGE_A(bufoff, nextu, half, kbytes) do { \
    if constexpr (GATHER) { unsigned go_[2]; _Pragma("unroll") for (int _j = 0; _j < 2; ++_j) go_[_j] = ((nextu) ? gnxt[half][_j] : gcur[half][_j]) * (unsigned)(lda * 2) + gC2[_j]; \
      PG8_STAGE(bufoff, gbaseA + (kbytes), go_); } \
    else { PG8_STAGE(bufoff, ((nextu) ? nA : cA) + (half) * hstepA + (kbytes), voffA); } } while (0)
  Unit cur, nxt;
  int ui = 0;
  if (!S.next(0, cur)) return;
  f32x4 acc[2][2][4][2];
#pragma unroll
  for (int a = 0; a < 2; ++a)
#pragma unroll
    for (int b = 0; b < 2; ++b)
#pragma unroll
      for (int m = 0; m < 4; ++m)
#pragma unroll
        for (int n = 0; n < 2; ++n) acc[a][b][m][n] = (f32x4){0.f, 0.f, 0.f, 0.f};
  bf16x8 At[4][2], B0[2][2], B1[2][2];
  const char* cA = cur.A;
  const char* cB = cur.B;
  const char* nA = cA;
  if constexpr (GATHER) { gload(cur.row0, gcur); gload(cur.row0, gnxt); asm volatile("s_waitcnt vmcnt(0)" ::: "memory"); }
  PG8_STAGE(PG8_SB(0, 0), cB, voffB); PG8_STAGE(PG8_SB(0, 1), cB + hstepB, voffB); PG8_STAGE_A(PG8_SA(0, 0), false, 0, 0); PG8_STAGE_A(PG8_SA(0, 1), false, 1, 0);
  if (wr == 1) PG8_BAR;
  PG8_WAIT_V(2); PG8_BAR;
  PG8_STAGE(PG8_SB(1, 0), cB + kstep, voffB); PG8_STAGE_A(PG8_SA(1, 0), false, 0, kstep); PG8_STAGE(PG8_SB(1, 1), cB + hstepB + kstep, voffB);
  PG8_WAIT_V(6); PG8_BAR;
  for (;;) {
    const bool has_next = S.next(ui + 1, nxt);
    nA = has_next ? nxt.A : cA;
    const char* nB = has_next ? nxt.B : cB;
    if constexpr (GATHER) { if (has_next) gload(nxt.row0, gnxt); else {
#pragma unroll
      for (int h = 0; h < 2; ++h)
#pragma unroll
        for (int i = 0; i < 2; ++i) gnxt[h][i] = gcur[h][i]; } }
    for (int t = 0; t < nt; t += 2) {
      const bool last = (t == nt - 2);
      const size_t k1 = (size_t)(t + 1) * kstep;
      const size_t k2 = last ? 0 : (size_t)(t + 2) * kstep;
      const size_t k3 = k2 + kstep;
      const char* b2 = last ? nB : cB + (size_t)(t + 2) * kstep;
      const char* b3 = b2 + kstep;
      PG8_LDB(B0, 0, 0); PG8_LDB(B1, 0, 1); PG8_SCHED; PG8_LDA(At, 0, 0); PG8_STAGE_A(PG8_SA(1, 1), false, 1, k1);
      PG8_WAIT_V(8); PG8_WAIT_L(0); PG8_BAR; PG8_MMA(0, 0, At, B0); PG8_MMA(0, 1, At, B1); PG8_BAR; PG8_SCHED;
      PG8_LDA(At, 0, 1); PG8_STAGE(PG8_SB(0, 0), b2, voffB); PG8_STAGE(PG8_SB(0, 1), b2 + hstepB, voffB); PG8_STAGE_A(PG8_SA(0, 0), last, 0, k2);
      PG8_WAIT_V(8); PG8_WAIT_L(0); PG8_BAR; PG8_MMA(1, 0, At, B0); PG8_MMA(1, 1, At, B1); PG8_BAR; PG8_SCHED;
      PG8_LDB(B0, 1, 0); PG8_LDB(B1, 1, 1); PG8_SCHED; PG8_LDA(At, 1, 0); PG8_STAGE_A(PG8_SA(0, 1), last, 1, k2);
      PG8_WAIT_V(8); PG8_WAIT_L(0); PG8_BAR; PG8_MMA(0, 0, At, B0); PG8_MMA(0, 1, At, B1); PG8_BAR; PG8_SCHED;
      PG8_LDA(At, 1, 1); PG8_STAGE(PG8_SB(1, 0), b3, voffB); PG8_STAGE(PG8_SB(1, 1), b3 + hstepB, voffB); PG8_STAGE_A(PG8_SA(1, 0), last, 0, k3);
      PG8_WAIT_V(8); PG8_WAIT_L(0); PG8_BAR; PG8_MMA(1, 0, At, B0); PG8_MMA(1, 1, At, B1); PG8_BAR; PG8_SCHED;
    }
    if (wr == 0) PG8_BAR;
    E(acc, cur, wr, wc, fr, fq);
    if (!has_next) break;
#pragma unroll
    for (int a = 0; a < 2; ++a)
#pragma unroll
      for (int b = 0; b < 2; ++b)
#pragma unroll
        for (int m = 0; m < 4; ++m)
#pragma unroll
          for (int n = 0; n < 2; ++n) acc[a][b][m][n] = (f32x4){0.f, 0.f, 0.f, 0.f};
    cur = nxt; cA = nA; cB = nB; ++ui;
    if constexpr (GATHER) {
#pragma unroll
      for (int h = 0; h < 2; ++h)
#pragma unroll
        for (int i = 0; i < 2; ++i) gcur[h][i] = gnxt[h][i];
    }
    if (wr == 1) PG8_BAR;
  }
  PG8_WAIT_V(0);
  PG8_BAR;
#undef PG8_SA
#undef PG8_SB
#undef PG8_STAGE
#undef PG8_STAGE_A
#undef PG8_LDA
#undef PG8_LDB
#undef PG8_MMA
#undef PG8_WAIT_V
#undef PG8_WAIT_L
#undef PG8_BAR
#undef PG8_SCHED
}

struct SchedDense {
  const char* A; const char* B; int lda, ldb, nM, nN, acolstep, G, c;
  __device__ __forceinline__ bool next(int i, Unit& u) const {
    const int nwg = nM * nN;
    const long L = (long)i * G + c;
    if (L >= nwg) return false;
    int wgid = (int)L;
    { const int q = nwg / 8, r = nwg % 8, xcd = wgid % 8, off = wgid / 8; wgid = (xcd < r ? xcd * (q + 1) : r * (q + 1) + (xcd - r) * q) + off; }
    const int nig = 8 * nN, gid = wgid / nig, fm = gid * 8, gsz = (nM - fm) < 8 ? (nM - fm) : 8;
    const int pm = fm + ((wgid % nig) % gsz), pn = (wgid % nig) / gsz;
    u.A = A + (size_t)pm * 256 * lda * 2 + (size_t)pn * acolstep;
    u.B = B + (size_t)pn * 256 * ldb * 2;
    u.row0 = pm * 256; u.col0 = pn * 256;
    return true;
  }
};
struct SchedMoe {
  const char* A; const char* W; int ncol, wrows, colw, nu, G, c;
  __device__ __forceinline__ bool next(int i, Unit& u) const {
    const long L = (long)i * G + c;
    if (L >= nu) return false;
    const int wgid = (int)(L % 8) * (nu / 8) + (int)(L / 8);
    const int UL = 128 * ncol;
    int e, pn, row0;
    if (wgid < UL) { e = wgid / (8 * ncol); const int rem = wgid % (8 * ncol); row0 = e * 2048 + (rem % 8) * 256; pn = rem / 8; }
    else { const int w2 = wgid - UL; e = w2 / ncol; pn = w2 % ncol; row0 = MOE_L + e * 256; }
    u.A = A + (size_t)row0 * 1024 * 2;
    u.B = W + ((size_t)e * wrows + (size_t)pn * 256) * 1024 * 2;
    u.row0 = row0; u.col0 = pn * colw;
    return true;
  }
};

struct EpiBf16 {
  bf16_t* O; int ldo;
  __device__ __forceinline__ void operator()(const f32x4 (&acc)[2][2][4][2], const Unit& u, int wr, int wc, int fr, int fq) const {
#pragma unroll
    for (int ai = 0; ai < 2; ++ai)
#pragma unroll
      for (int m = 0; m < 4; ++m) {
        const int row = u.row0 + ai * 128 + wr * 64 + m * 16 + fr;
        bf16_t* rp = O + (size_t)row * ldo + u.col0 + wc * 32 + 8 * fq;
#pragma unroll
        for (int bj = 0; bj < 2; ++bj) {
          const f32x4 v0 = acc[ai][bj][m][0], v1 = acc[ai][bj][m][1];
          u32x4 w; w.x = cvt_pk_bf16(v0[0], v0[1]); w.y = cvt_pk_bf16(v0[2], v0[3]); w.z = cvt_pk_bf16(v1[0], v1[1]); w.w = cvt_pk_bf16(v1[2], v1[3]);
          *(u32x4*)(rp + bj * 128) = w;
        }
      }
  }
};
struct EpiResid {
  float* x; const float* modg; const float* cs; const float* xl; const float* xc;
  __device__ __forceinline__ void operator()(const f32x4 (&acc)[2][2][4][2], const Unit& u, int wr, int wc, int fr, int fq) const {
#pragma unroll
    for (int ai = 0; ai < 2; ++ai)
#pragma unroll
      for (int m = 0; m < 4; ++m) {
        const int row = u.row0 + ai * 128 + wr * 64 + m * 16 + fr;
        const int c0 = u.col0 + wc * 32 + 8 * fq;
        float* xp = x + (size_t)row * 1024 + c0;
        const float* xi = xl ? (row < NL ? xl + (size_t)row * 1024 + c0 : xc + (size_t)(row - NL) * 1024 + c0) : xp;
        const float* gp = modg + (size_t)modrow(row) * 6144 + c0;
#pragma unroll
        for (int bj = 0; bj < 2; ++bj) {
          f32x4 g0 = *(const f32x4*)(gp + bj * 128), g1 = *(const f32x4*)(gp + bj * 128 + 4);
          if (cs) { g0 *= *(const f32x4*)(cs + c0 + bj * 128); g1 *= *(const f32x4*)(cs + c0 + bj * 128 + 4); }
          f32x4 x0 = *(const f32x4*)(xi + bj * 128), x1 = *(const f32x4*)(xi + bj * 128 + 4);
          x0 += g0 * acc[ai][bj][m][0]; x1 += g1 * acc[ai][bj][m][1];
          *(f32x4*)(xp + bj * 128) = x0; *(f32x4*)(xp + bj * 128 + 4) = x1;
        }
      }
  }
};
struct EpiSwiGLU {
  bf16_t* O;
  __device__ __forceinline__ void operator()(const f32x4 (&acc)[2][2][4][2], const Unit& u, int wr, int wc, int fr, int fq) const {
#pragma unroll
    for (int ai = 0; ai < 2; ++ai)
#pragma unroll
      for (int m = 0; m < 4; ++m) {
        const int row = u.row0 + ai * 128 + wr * 64 + m * 16 + fr;
        bf16_t* rp = O + (size_t)row * 1024 + u.col0 + wc * 32 + 8 * fq;
        float o[8];
#pragma unroll
        for (int n = 0; n < 2; ++n)
#pragma unroll
          for (int j = 0; j < 4; ++j) { const float g = acc[ai][0][m][n][j], up = acc[ai][1][m][n][j]; o[n * 4 + j] = g / (1.f + __expf(-g)) * up; }
        u32x4 w; w.x = cvt_pk_bf16(o[0], o[1]); w.y = cvt_pk_bf16(o[2], o[3]); w.z = cvt_pk_bf16(o[4], o[5]); w.w = cvt_pk_bf16(o[6], o[7]);
        *(u32x4*)rp = w;
      }
  }
};
struct EpiDown {
  bf16_t* O; const float* gatev;
  __device__ __forceinline__ void operator()(const f32x4 (&acc)[2][2][4][2], const Unit& u, int wr, int wc, int fr, int fq) const {
    float gv[2][4];
#pragma unroll
    for (int ai = 0; ai < 2; ++ai)
#pragma unroll
      for (int m = 0; m < 4; ++m) gv[ai][m] = gatev[u.row0 + ai * 128 + wr * 64 + m * 16 + fr];
    __builtin_amdgcn_sched_barrier(0);
#pragma unroll
    for (int ai = 0; ai < 2; ++ai)
#pragma unroll
      for (int m = 0; m < 4; ++m) {
        const int row = u.row0 + ai * 128 + wr * 64 + m * 16 + fr;
        bf16_t* rp = O + (size_t)row * 1024 + u.col0 + wc * 32 + 8 * fq;
#pragma unroll
        for (int bj = 0; bj < 2; ++bj) {
          const f32x4 v0 = acc[ai][bj][m][0] * gv[ai][m], v1 = acc[ai][bj][m][1] * gv[ai][m];
          u32x4 w; w.x = cvt_pk_bf16(v0[0], v0[1]); w.y = cvt_pk_bf16(v0[2], v0[3]); w.z = cvt_pk_bf16(v1[0], v1[1]); w.w = cvt_pk_bf16(v1[2], v1[3]);
          *(u32x4*)(rp + bj * 128) = w;
        }
      }
  }
};
}

#define NT_WINE 1408
#define NT_WOUT 512
#define NT_WINO 512
#define NT_WGRP 128
#define NT_EXP 16384
#define NT_ALL (NT_WINE + NT_WOUT + NT_WINO + NT_WGRP + 3 * NT_EXP)
#define CE0 704
#define CE1 960
#define CE2 13248
#define CE3 13504
#define CE4 13568
#define CE5 25856
#define CE6 26560
#define CE7 26816
#define CE8 39104
#define CE9 39360
#define CE10 39424
#define CE11 51712
__device__ __forceinline__ void conv_batch(const Params& p, int t, float* T) {
  const int tid = ltid(), lane = tid & 63, wv = tid >> 6;
  const float* src; bf16_t* dst; int ld, dK, k0, n0;
  int seg, tb, e, which = 0;
  if (t < CE0) { seg = 0; e = 0; tb = t; } else if (t < CE1) { seg = 1; e = 0; tb = t - CE0; } else if (t < CE2) { seg = 2; e = 0; tb = t - CE1; }
  else if (t < CE3) { seg = 3; e = 0; tb = t - CE2; } else if (t < CE4) { seg = 4; e = 0; tb = t - CE3; } else if (t < CE5) { seg = 2; e = 1; tb = t - CE4; }
  else if (t < CE6) { seg = 0; e = 1; tb = t - CE5; } else if (t < CE7) { seg = 1; e = 1; tb = t - CE6; } else if (t < CE8) { seg = 2; e = 2; tb = t - CE7; }
  else if (t < CE9) { seg = 3; e = 1; tb = t - CE8; } else if (t < CE10) { seg = 4; e = 1; tb = t - CE9; } else { seg = 2; e = 3; tb = t - CE10; }
  int dbase = 0;
  if (seg == 0) {
    k0 = (tb / 44) * 64; n0 = (tb % 44) * 64;
    src = p.w_in_even + (size_t)e * 1024 * EVEN_IN; ld = EVEN_IN; dst = p.WinE + (size_t)e * PROJW * 1024; dK = 1024;
  } else if (seg == 1 || seg == 3) {
    k0 = (tb / 16) * 64; n0 = (tb % 16) * 64;
    src = (seg == 3 ? p.w_in_odd : p.w_out_even) + (size_t)e * 1024 * 1024; ld = 1024; dst = (seg == 3 ? p.WinO : p.WoutE) + (size_t)e * 1024 * 1024; dK = 1024;
  } else if (seg == 4) {
    const int g = tb / 16; k0 = ((tb % 16) / 4) * 64; n0 = (tb % 4) * 64;
    src = p.w_pool_grp + (size_t)(e * 4 + g) * 65536; ld = 256; dst = p.Wgrp + (size_t)e * 1024 * 256; dK = 256; dbase = g * 256;
  } else {
    which = tb / 4096; const int r = tb % 4096, le = e * 16 + r / 256; k0 = ((r % 256) / 16) * 64; n0 = (r % 16) * 64;
    const float* base = which == 0 ? p.w_exp_gate : (which == 1 ? p.w_exp_up : p.w_exp_down);
    src = base + (size_t)le * 1024 * 1024; ld = 1024; dK = 1024;
    dst = which < 2 ? p.Wgu + (size_t)le * 2048 * 1024 : p.Wd + (size_t)le * 1024 * 1024;
  }
  const bool gu = (seg == 2 && which < 2);
  float4 v[8];
#pragma unroll
  for (int q = 0; q < 8; ++q) {
    const int idx = tid + q * NTHR, k = idx >> 6, c4 = idx & 63;
    v[q] = *(const float4*)(src + (size_t)(k0 + k) * ld + n0 + c4 * 4);
  }
  __builtin_amdgcn_sched_barrier(0);
#pragma unroll
  for (int q = 0; q < 8; ++q) {
    const int idx = tid + q * NTHR, k = idx >> 6, c4 = idx & 63;
    float* tp = T + k * 257 + c4 * 4;
    tp[0] = v[q].x; tp[1] = v[q].y; tp[2] = v[q].z; tp[3] = v[q].w;
  }
  __syncthreads();
#pragma unroll
  for (int sub = 0; sub < 4; ++sub) {
    const int nl = wv * 8 + (lane >> 3), kq = lane & 7, nn = n0 + sub * 64;
    const int drow0 = gu ? (nn >> 7) * 256 + which * 128 + (nn & 127) : dbase + nn;
    float f[8];
#pragma unroll
    for (int j = 0; j < 8; ++j) f[j] = T[(kq * 8 + j) * 257 + sub * 64 + nl];
    u32x4 w; w.x = cvt_pk_bf16(f[0], f[1]); w.y = cvt_pk_bf16(f[2], f[3]); w.z = cvt_pk_bf16(f[4], f[5]); w.w = cvt_pk_bf16(f[6], f[7]);
    *(u32x4*)(dst + (size_t)(drow0 + nl) * dK + k0 + kq * 8) = w;
  }
}
__device__ __forceinline__ int conv_pull(const Params& p, float* sm) {
  __syncthreads();
  if (ltid() == 0) ((int*)sm)[16500] = (int)__hip_atomic_fetch_add(p.barw, 4u, __ATOMIC_RELAXED, __HIP_MEMORY_SCOPE_AGENT);
  __syncthreads();
  return ((int*)sm)[16500];
}
__device__ __forceinline__ void conv_until(const Params& p, int end, float* sm) {
  int t;
  do { t = conv_pull(p, sm); if (t < CE11) conv_batch(p, t, sm); } while (t + 4 < end);
  __syncthreads();
}
__device__ __forceinline__ void conv_quota(const Params& p, int n, float* sm) {
  for (int i = 0; i < n; ++i) { const int t = conv_pull(p, sm); if (t >= CE11) break; conv_batch(p, t, sm); }
  __syncthreads();
}

__device__ __forceinline__ void ph_init(const Params& p, float* sm) {
  const int tid = ltid(), lane = tid & 63, wv = tid >> 6;
  const size_t gtid = (size_t)lbid() * NTHR + tid, gsz = (size_t)lgdim() * NTHR;
  for (int i = tid; i < 9 * 1024; i += NTHR) {
    const int r = i >> 10, k = i & 1023;
    sm[i] = siluf(r < 8 ? p.c[r * 1024 + k] : p.c_ctx[k]);
  }
  __syncthreads();
  float* part = sm + 9 * 1024;
  for (int item = lbid(); item < 768; item += lgdim()) {
    const int l = item / 192, j0 = (item % 192) * 32;
    const int col = lane & 31, kh = lane >> 5;
    const float* w = p.w_mod + (size_t)l * 1024 * 6144 + j0 + col;
    float acc[9];
#pragma unroll
    for (int r = 0; r < 9; ++r) acc[r] = 0.f;
    const int kb = wv * 128 + kh * 64;
    for (int k0 = 0; k0 < 64; k0 += 16) {
      float wv16[16];
#pragma unroll
      for (int kk = 0; kk < 16; ++kk) wv16[kk] = w[(size_t)(kb + k0 + kk) * 6144];
      __builtin_amdgcn_sched_barrier(0);
#pragma unroll
      for (int kk = 0; kk < 16; ++kk)
#pragma unroll
        for (int r = 0; r < 9; ++r) acc[r] += sm[r * 1024 + kb + k0 + kk] * wv16[kk];
    }
#pragma unroll
    for (int r = 0; r < 9; ++r) part[((wv * 2 + kh) * 9 + r) * 32 + col] = acc[r];
    __syncthreads();
    if (tid < 288) {
      const int r = tid >> 5, cc = tid & 31;
      float s = 0.f;
#pragma unroll
      for (int sl = 0; sl < 16; ++sl) s += part[(sl * 9 + r) * 32 + cc];
      p.mod[(size_t)(l * 9 + r) * 6144 + j0 + cc] = s + p.b_mod[l * 6144 + j0 + cc];
    }
    __syncthreads();
  }
  conv_until(p, CE1, sm);
}

typedef float f32x4m __attribute__((ext_vector_type(4)));
__device__ __forceinline__ void ph_norm(const Params& p, int l, int which, int nrows, int ncomb, int lprev, float* sm) {
  const int tid = ltid(), lane = tid & 63, wv = tid >> 6;
  const bool skinny = (which == 2) || (which == 1 && (l & 1) == 0);
  bf16_t* HROW = (bf16_t*)sm;
  float* PART = sm + 8192;
  bf16x8 Bhi[4], Blo[4];
  if (skinny) {
    const float* wbase; int stride;
    if (which == 2) { wbase = p.w_router + (size_t)l * 1024 * 16; stride = 16; }
    else { wbase = p.w_in_even + (size_t)(l >> 1) * 1024 * EVEN_IN + PROJW; stride = EVEN_IN; }
    const int kg = lane >> 4, n = lane & 15;
#pragma unroll
    for (int ks = 0; ks < 4; ++ks) {
      float f[8], hi[8], lo[8];
#pragma unroll
      for (int j = 0; j < 8; ++j) f[j] = wbase[(size_t)(wv * 128 + ks * 32 + kg * 8 + j) * stride + n];
      const u32x4 hw = pack8(f);
      unpack8(hw, hi);
#pragma unroll
      for (int j = 0; j < 8; ++j) lo[j] = f[j] - hi[j];
      Bhi[ks] = __builtin_bit_cast(bf16x8, hw);
      Blo[ks] = __builtin_bit_cast(bf16x8, pack8(lo));
    }
  }
  const int nwaves = lgdim() * (NTHR / 64), gw = lbid() * (NTHR / 64) + wv;
  const int per = (nrows + nwaves - 1) / nwaves;
  const int rbeg = gw * per, rend = min(nrows, rbeg + per);
  const bool in0 = (l == 0) && (which == 1 || which == 2);
  float4 vn[4];
  u32x2 xnb[4];
  int slvn = -1;
  {
    const int r0 = min(rbeg, nrows - 1);
    if (in0) {
      const float* xs0 = r0 < NL ? p.x + (size_t)r0 * DM : p.ctx + (size_t)(r0 - NL) * DM;
#pragma unroll
      for (int i = 0; i < 4; ++i) vn[i] = ((const float4*)xs0)[i * 64 + lane];
    } else {
#pragma unroll
      for (int i = 0; i < 4; ++i) xnb[i] = ((const u32x2*)(p.xcur + (size_t)r0 * DM))[i * 64 + lane];
    }
    if (r0 < ncomb && lane < 16) slvn = p.slotmap[r0 * 16 + lane];
  }
  float4 cA[4], cB[4], cG[4];
  u32x2 yn[4];
  int mr_c = -1;
  if (which == 2) {
    const u32x2* yp0 = (const u32x2*)(p.ybuf + (size_t)min(rbeg, nrows - 1) * DM);
#pragma unroll
    for (int i = 0; i < 4; ++i) yn[i] = yp0[i * 64 + lane];
  }
  for (int it = 0; it < per; ++it) {
    const int rr = rbeg + it;
    const bool live = rr < rend;
    const int r = min(rr, nrows - 1);
    float4 v[4];
    if (in0) {
#pragma unroll
      for (int i = 0; i < 4; ++i) v[i] = vn[i];
    } else {
#pragma unroll
      for (int i = 0; i < 4; ++i) v[i] = make_float4(__uint_as_float(xnb[i].x << 16), __uint_as_float(xnb[i].x & 0xffff0000u), __uint_as_float(xnb[i].y << 16), __uint_as_float(xnb[i].y & 0xffff0000u));
    }
    const int slv = slvn;
    bf16_t* xr = p.xcur + (size_t)r * DM;
    if (it + 1 < per) {
      const int rn = min(rr + 1, nrows - 1);
      if (in0) {
        const float* xsn = rn < NL ? p.x + (size_t)rn * DM : p.ctx + (size_t)(rn - NL) * DM;
#pragma unroll
        for (int i = 0; i < 4; ++i) vn[i] = ((const float4*)xsn)[i * 64 + lane];
      } else {
#pragma unroll
        for (int i = 0; i < 4; ++i) xnb[i] = ((const u32x2*)(p.xcur + (size_t)rn * DM))[i * 64 + lane];
      }
      slvn = (rn < ncomb && lane < 16) ? p.slotmap[rn * 16 + lane] : -1;
    }
    const int mr = modrow(r);
    if (mr != mr_c) {
      mr_c = mr;
      if (which == 3) {
#pragma unroll
        for (int i = 0; i < 4; ++i) cA[i] = ((const float4*)p.g_final)[i * 64 + lane];
      } else {
        const float* gn = (which == 1 ? p.g_norm1 : p.g_norm2) + l * 1024;
        const float* mrow = p.mod + (size_t)(l * 9 + mr) * 6144;
        const float4* shp = (const float4*)(mrow + (which == 1 ? 0 : 3) * 1024);
        const float4* scp = (const float4*)(mrow + (which == 1 ? 1 : 4) * 1024);
#pragma unroll
        for (int i = 0; i < 4; ++i) {
          const float4 g = ((const float4*)gn)[i * 64 + lane], sc = scp[i * 64 + lane];
          cA[i] = make_float4(g.x * (1.f + sc.x), g.y * (1.f + sc.y), g.z * (1.f + sc.z), g.w * (1.f + sc.w));
          cB[i] = shp[i * 64 + lane];
        }
      }
      if (which == 2) {
        const float4* g2 = (const float4*)(p.mod + (size_t)(l * 9 + mr) * 6144 + 2 * 1024);
        const float4* spv = (const float4*)(p.s_pool + (size_t)(l >> 1) * 1024);
#pragma unroll
        for (int i = 0; i < 4; ++i) {
          float4 g = g2[i * 64 + lane];
          if (l & 1) { const float4 sp4 = spv[i * 64 + lane]; g.x *= sp4.x; g.y *= sp4.y; g.z *= sp4.z; g.w *= sp4.w; }
          cG[i] = g;
        }
      } else if (ncomb > 0) {
        const float4* g5 = (const float4*)(p.mod + (size_t)(lprev * 9 + mr) * 6144 + 5 * 1024);
#pragma unroll
        for (int i = 0; i < 4; ++i) cG[i] = g5[i * 64 + lane];
      }
    }
    if (live && r < ncomb) {
      float4 s4[4];
#pragma unroll
      for (int i = 0; i < 4; ++i) s4[i] = make_float4(0.f, 0.f, 0.f, 0.f);
      unsigned long long mask = __ballot(slv >= 0);
      while (mask) {
        const int e = __ffsll((long long)mask) - 1;
        mask &= mask - 1;
        const int sl = __shfl(slv, e);
        size_t yrow;
        if (r < NL) yrow = (size_t)e * 2048 + (size_t)(r >> 11) * 256 + sl;
        else yrow = (size_t)MOE_L + (size_t)e * 256 + (size_t)((r - NL) >> 8) * 32 + sl;
        const u32x2* yp = (const u32x2*)(p.Ybuf + yrow * DM);
        u32x2 yv[4];
#pragma unroll
        for (int i = 0; i < 4; ++i) yv[i] = yp[i * 64 + lane];
#pragma unroll
        for (int i = 0; i < 4; ++i) {
          const u32x2 y = yv[i];
          s4[i].x += __uint_as_float(y.x << 16); s4[i].y += __uint_as_float(y.x & 0xffff0000u);
          s4[i].z += __uint_as_float(y.y << 16); s4[i].w += __uint_as_float(y.y & 0xffff0000u);
        }
      }
#pragma unroll
      for (int i = 0; i < 4; ++i) {
        const float4 g = cG[i];
        v[i].x += g.x * s4[i].x; v[i].y += g.y * s4[i].y; v[i].z += g.z * s4[i].z; v[i].w += g.w * s4[i].w;
        if (which != 3) { u32x2 xw; xw.x = cvt_pk_bf16(v[i].x, v[i].y); xw.y = cvt_pk_bf16(v[i].z, v[i].w); ((u32x2*)xr)[i * 64 + lane] = xw; }
      }
    }
    if (which == 2) {
      u32x2 yc[4];
#pragma unroll
      for (int i = 0; i < 4; ++i) yc[i] = yn[i];
      if (it + 1 < per) {
        const u32x2* ypn = (const u32x2*)(p.ybuf + (size_t)min(rr + 1, nrows - 1) * DM);
#pragma unroll
        for (int i = 0; i < 4; ++i) yn[i] = ypn[i * 64 + lane];
      }
#pragma unroll
      for (int i = 0; i < 4; ++i) {
        v[i].x += cG[i].x * __uint_as_float(yc[i].x << 16); v[i].y += cG[i].y * __uint_as_float(yc[i].x & 0xffff0000u);
        v[i].z += cG[i].z * __uint_as_float(yc[i].y << 16); v[i].w += cG[i].w * __uint_as_float(yc[i].y & 0xffff0000u);
        if (live) { u32x2 xw; xw.x = cvt_pk_bf16(v[i].x, v[i].y); xw.y = cvt_pk_bf16(v[i].z, v[i].w); ((u32x2*)xr)[i * 64 + lane] = xw; }
      }
    }
    float ss = 0.f;
#pragma unroll
    for (int i = 0; i < 4; ++i) ss += v[i].x * v[i].x + v[i].y * v[i].y + v[i].z * v[i].z + v[i].w * v[i].w;
    ss = wave_sum(ss);
    const float inv = rsqrtf(ss * (1.f / 1024.f) + EPS);
    if (which == 3) {
      if (live) {
#pragma unroll
        for (int i = 0; i < 4; ++i) {
          const float4 g = cA[i];
          ((float4*)(p.out + (size_t)r * DM))[i * 64 + lane] = make_float4(v[i].x * inv * g.x, v[i].y * inv * g.y, v[i].z * inv * g.z, v[i].w * inv * g.w);
        }
      }
      continue;
    }
#pragma unroll
    for (int i = 0; i < 4; ++i) {
      const float h0 = v[i].x * inv * cA[i].x + cB[i].x, h1 = v[i].y * inv * cA[i].y + cB[i].y;
      const float h2 = v[i].z * inv * cA[i].z + cB[i].z, h3 = v[i].w * inv * cA[i].w + cB[i].w;
      u32x2 w; w.x = cvt_pk_bf16(h0, h1); w.y = cvt_pk_bf16(h2, h3);
      if (live) ((u32x2*)(p.hbuf + (size_t)r * DM))[i * 64 + lane] = w;
      if (skinny) {
        const float l0 = h0 - __uint_as_float(w.x << 16), l1 = h1 - __uint_as_float(w.x & 0xffff0000u);
        const float l2 = h2 - __uint_as_float(w.y << 16), l3 = h3 - __uint_as_float(w.y & 0xffff0000u);
        u32x2 wl; wl.x = cvt_pk_bf16(l0, l1); wl.y = cvt_pk_bf16(l2, l3);
        ((u32x2*)(HROW + (wv * 2 + 0) * 1024))[i * 64 + lane] = w;
        ((u32x2*)(HROW + (wv * 2 + 1) * 1024))[i * 64 + lane] = wl;
      }
    }
    if (!skinny) continue;
    LDS_BARRIER();
    {
      const int arow = lane & 7, kg = lane >> 4;
      f32x4m acc = {0.f, 0.f, 0.f, 0.f};
#pragma unroll
      for (int ks = 0; ks < 4; ++ks) {
        const bf16x8 ahi = *(const bf16x8*)(HROW + (arow * 2 + 0) * 1024 + wv * 128 + ks * 32 + kg * 8);
        const bf16x8 alo = *(const bf16x8*)(HROW + (arow * 2 + 1) * 1024 + wv * 128 + ks * 32 + kg * 8);
        acc = __builtin_amdgcn_mfma_f32_16x16x32_bf16(ahi, Bhi[ks], acc, 0, 0, 0);
        acc = __builtin_amdgcn_mfma_f32_16x16x32_bf16(ahi, Blo[ks], acc, 0, 0, 0);
        acc = __builtin_amdgcn_mfma_f32_16x16x32_bf16(alo, Bhi[ks], acc, 0, 0, 0);
      }
      if (kg < 2) {
#pragma unroll
        for (int q = 0; q < 4; ++q) PART[(wv * 8 + kg * 4 + q) * 16 + (lane & 15)] = acc[q];
      }
    }
    LDS_BARRIER();
    {
      float v1 = 0.f;
      if (lane < 16) {
#pragma unroll
        for (int w2 = 0; w2 < 8; ++w2) v1 += PART[(w2 * 8 + wv) * 16 + lane];
      }
      if (which == 2) {
        float mx = v1;
        mx = fmaxf(mx, __shfl_xor(mx, 1)); mx = fmaxf(mx, __shfl_xor(mx, 2)); mx = fmaxf(mx, __shfl_xor(mx, 4)); mx = fmaxf(mx, __shfl_xor(mx, 8));
        const float ex = expf(v1 - mx);
        float sum = ex;
        sum += __shfl_xor(sum, 1); sum += __shfl_xor(sum, 2); sum += __shfl_xor(sum, 4); sum += __shfl_xor(sum, 8);
        if (live && lane < 16) p.aff[(size_t)r * 16 + lane] = ex / sum;
      } else {
        float gvv = v1 + p.b_gate[(l >> 1) * 16 + (lane & 15)];
        if ((lane >> 2) & 1) gvv = logsigmoidf_(gvv);
        if (live && lane < 16) p.gates[(size_t)r * 16 + lane] = gvv;
      }
    }
  }
  __syncthreads();
}

#define LOG2E 1.4426950408889634f
__device__ __forceinline__ int chain_row(int b, int dir, int p) {
  if (p < 256) { const int t = dir ? 255 - p : p; return NL + b * 256 + t; }
  const int q = p - 256; const int t = dir ? 2047 - q : q; return b * 2048 + t;
}
__device__ __forceinline__ float wave_incl_sum(float v, int lane) {
#pragma unroll
  for (int o = 1; o < 64; o <<= 1) { const float t = __shfl_up(v, o); if (lane >= o) v += t; }
  return v;
}
__device__ __forceinline__ float wave_incl_max(float v, int lane) {
#pragma unroll
  for (int o = 1; o < 64; o <<= 1) { const float t = __shfl_up(v, o); if (lane >= o) v = fmaxf(v, t); }
  return v;
}
__device__ __forceinline__ void ph_post_even(const Params& p, int l, float* sm) {
  const int e = l >> 1;
  const int tid = ltid(), lane = tid & 63;
  __syncthreads();
  for (int idx = tid; idx < 1024; idx += NTHR) {
    const int pos = idx >> 4, i = idx & 15;
    const float ang = (float)pos * exp2f(-(float)i * (13.287712379549449f / 16.f));
    float sn, cs;
    sincosf(ang, &sn, &cs);
    sm[2 * idx] = cs; sm[2 * idx + 1] = sn;
  }
  if (tid < 128) sm[2048 + tid] = tid < 64 ? p.g_qnorm[e * 64 + tid] : p.g_knorm[e * 64 + tid - 64];
  for (int idx = tid; idx < 3072; idx += NTHR) sm[2304 + idx] = p.w_conv[(size_t)e * 3 * 1024 + idx];
  __syncthreads();
  const int bid = lbid(), G = lgdim();
  const bool scanner = false;
  const size_t gtid = (size_t)bid * NTHR + tid, gsz = (size_t)G * NTHR;
  if (!scanner) {
  for (size_t it = gtid; it < (size_t)NT * 10; it += gsz) {
    const int r = (int)(it / 10), hh = (int)(it % 10);
    const bool lat = r < NL;
    const int t = r & 2047;
    const int bb = lat ? (r >> 11) : ((r - NL) >> 8);
    const int key = lat ? 256 + t : ((r - NL) & 255);
    const bf16_t* src; bf16_t* dst; const float* g; float osc;
    if (hh < 8) { src = p.proj + (size_t)r * PROJW + hh * 64; dst = p.Qb + (size_t)r * 512 + hh * 64; g = sm + 2048; osc = 0.125f * LOG2E; }
    else { src = p.proj + (size_t)r * PROJW + 512 + (hh - 8) * 64; dst = p.Kb + ((size_t)(bb * 2 + (hh - 8)) * 2304 + key) * 64; g = sm + 2048 + 64; osc = 1.f;
           const u32x4* vs = (const u32x4*)(p.proj + (size_t)r * PROJW + 640 + (hh - 8) * 64);
           u32x4* vd = (u32x4*)(p.Vb + ((size_t)(bb * 2 + (hh - 8)) * 2304 + key) * 64);
           u32x4 vt[8];
#pragma unroll
           for (int q = 0; q < 8; ++q) vt[q] = vs[q];
           __builtin_amdgcn_sched_barrier(0);
#pragma unroll
           for (int q = 0; q < 8; ++q) vd[q] = vt[q]; }
    float x[64];
#pragma unroll
    for (int q = 0; q < 8; ++q) { float f[8]; unpack8(((const u32x4*)src)[q], f);
#pragma unroll
      for (int j = 0; j < 8; ++j) x[q * 8 + j] = f[j]; }
    float ss = 0.f;
#pragma unroll
    for (int j = 0; j < 64; ++j) ss += x[j] * x[j];
    const float inv = rsqrtf(ss * (1.f / 64.f) + EPS) * osc;
#pragma unroll
    for (int j = 0; j < 64; ++j) x[j] *= inv * g[j];
    if (lat) {
#pragma unroll
      for (int a = 0; a < 2; ++a) {
        const int pos = (a == 0) ? (t >> 6) : (t & 63);
#pragma unroll
        for (int i = 0; i < 16; ++i) {
          const float2 cssn = *(const float2*)(sm + 2 * (pos * 16 + i));
          const float x1 = x[a * 32 + i], x2 = x[a * 32 + 16 + i];
          x[a * 32 + i] = x1 * cssn.x - x2 * cssn.y;
          x[a * 32 + 16 + i] = x2 * cssn.x + x1 * cssn.y;
        }
      }
    }
#pragma unroll
    for (int q = 0; q < 8; ++q) { float f[8];
#pragma unroll
      for (int j = 0; j < 8; ++j) f[j] = x[q * 8 + j];
      ((u32x4*)dst)[q] = pack8(f); }
  }
  const float* wc = sm + 2304;
  for (size_t it0 = gtid; it0 < (size_t)NT * 128; it0 += 4 * gsz) {
    u32x4 rc[4], rm[4], rp[4];
#pragma unroll
    for (int u = 0; u < 4; ++u) {
      const size_t it = it0 + (size_t)u * gsz;
      const size_t itc = it < (size_t)NT * 128 ? it : it0;
      const int r = (int)(itc >> 7), c8 = (int)(itc & 127) * 8;
      int t, n;
      if (r < NL) { t = r & 2047; n = 2048; } else { t = (r - NL) & 255; n = 256; }
      const bf16_t* sp = p.proj + (size_t)r * PROJW + 768 + c8;
      rc[u] = *(const u32x4*)sp;
      const u32x4 lm = *(const u32x4*)(sp - (t > 0 ? PROJW : 0)), lp = *(const u32x4*)(sp + (t < n - 1 ? PROJW : 0));
      rm[u].x = t > 0 ? lm.x : 0u; rm[u].y = t > 0 ? lm.y : 0u; rm[u].z = t > 0 ? lm.z : 0u; rm[u].w = t > 0 ? lm.w : 0u;
      rp[u].x = t < n - 1 ? lp.x : 0u; rp[u].y = t < n - 1 ? lp.y : 0u; rp[u].z = t < n - 1 ? lp.z : 0u; rp[u].w = t < n - 1 ? lp.w : 0u;
    }
#pragma unroll
    for (int u = 0; u < 4; ++u) {
      const size_t it = it0 + (size_t)u * gsz;
      if (it < (size_t)NT * 128) {
        const int r = (int)(it >> 7), c8 = (int)(it & 127) * 8;
        float xc[8], xm[8], xp[8], o[8];
        unpack8(rc[u], xc); unpack8(rm[u], xm); unpack8(rp[u], xp);
        const float ksc = c8 < 512 ? 1.f : 0.08838834764831845f;
#pragma unroll
        for (int j = 0; j < 8; ++j) { const float v = wc[c8 + j] * xm[j] + wc[1024 + c8 + j] * xc[j] + wc[2048 + c8 + j] * xp[j]; o[j] = siluf(v) * ksc; }
        bf16_t* dp = c8 < 512 ? p.qm + (size_t)r * 512 + c8 : p.km + (size_t)r * 512 + c8 - 512;
        *(u32x4*)dp = pack8(o);
      }
    }
  }
  }
  {
    const int gw = (int)(gtid >> 6), nw = (int)(gsz >> 6);
    for (int task = gw; task < 64 * 18; task += nw) {
      const int chain = task / 18, c = task % 18;
      const int b = chain >> 3, hd = (chain >> 1) & 3, dir = chain & 1;
      const int p0 = c * 128 + 2 * lane;
      const int r0 = chain_row(b, dir, p0), r1 = chain_row(b, dir, p0 + 1);
      const float ig0 = p.gates[(size_t)r0 * 16 + dir * 8 + hd], lf0 = p.gates[(size_t)r0 * 16 + dir * 8 + 4 + hd];
      const float ig1 = p.gates[(size_t)r1 * 16 + dir * 8 + hd], lf1 = p.gates[(size_t)r1 * 16 + dir * 8 + 4 + hd];
      const float ssum = lf0 + lf1;
      const float incl = wave_incl_sum(ssum, lane);
      const float bq0 = (incl - ssum) + lf0, bq1 = bq0 + lf1;
      const float bend = __shfl(incl, 63);
      const float g0 = ig0 - bq0, g1 = ig1 - bq1;
      const float inclm = wave_incl_max(fmaxf(g0, g1), lane);
      float exclm = __shfl_up(inclm, 1);
      if (lane == 0) exclm = -3.0e38f;
      const float pm0 = fmaxf(exclm, g0), pm1 = fmaxf(pm0, g1);
      const float gmax = __shfl(inclm, 63);
      const size_t i0 = (size_t)r0 * 8 + dir * 4 + hd, i1 = (size_t)r1 * 8 + dir * 4 + hd;
      p.gsG[i0] = g0 * LOG2E; p.gsR[i0] = pm0 * LOG2E; p.gsB[i0] = bq0 * LOG2E;
      p.gsG[i1] = g1 * LOG2E; p.gsR[i1] = pm1 * LOG2E; p.gsB[i1] = bq1 * LOG2E;
      if (lane == 0) { p.cBE[chain * 18 + c] = bend; p.cGM[chain * 18 + c] = gmax; }
    }
  }
}
__device__ __forceinline__ void chain_state(const Params& p, int chain, int cc, float& m_in, float& m_next, float& be) {
  m_in = -1e30f; m_next = -1e30f; be = 0.f;
  for (int c = 0; c <= cc; ++c) {
    be = p.cMIN[chain * 18 + c];
    const float mn = fmaxf(m_in + be, be + p.cE1[chain * 18 + c]);
    if (c < cc) m_in = mn; else m_next = mn;
  }
}

typedef float f32x16 __attribute__((ext_vector_type(16)));
typedef short s16x4 __attribute__((ext_vector_type(4)));
typedef __attribute__((address_space(3))) const char* lds_cptr;
__device__ __forceinline__ s16x4 vtr(lds_cptr p) { return __builtin_bit_cast(s16x4, __builtin_amdgcn_ds_read_tr16_b64_v4i16((__attribute__((address_space(3))) s16x4*)p)); }
#define MX3(a, b, c) __builtin_fmaxf(__builtin_fmaxf((a), (b)), (c))
__device__ __forceinline__ float rowmax32(const f32x16& p0, const f32x16& p1) {
  float a = MX3(p0[0], p0[1], p1[0]), b = MX3(p0[2], p0[3], p1[1]);
  a = MX3(a, p1[2], p1[3]);
#pragma unroll
  for (int r = 4; r < 16; r += 4) { a = MX3(a, p0[r], p0[r + 1]); b = MX3(b, p0[r + 2], p0[r + 3]); a = MX3(a, p1[r], p1[r + 1]); b = MX3(b, p1[r + 2], p1[r + 3]); }
  const float m = __builtin_fmaxf(a, b);
  auto rr = __builtin_amdgcn_permlane32_swap(__float_as_uint(m), __float_as_uint(m), false, false);
  return __builtin_fmaxf(__uint_as_float(rr[0]), __uint_as_float(rr[1]));
}
__device__ __forceinline__ float half_swap_add(float v) {
  auto rr = __builtin_amdgcn_permlane32_swap(__float_as_uint(v), __float_as_uint(v), false, false);
  return __uint_as_float(rr[0]) + __uint_as_float(rr[1]);
}
#define ATT_SLOT 16384
__device__ __forceinline__ void glds16(const void* g, unsigned lds_base) {
  unsigned sv;
  asm volatile("s_mov_b32 %0, m0\n\ts_mov_b32 m0, %2\n\ts_nop 0\n\tglobal_load_lds_dwordx4 %1, off\n\ts_mov_b32 m0, %0" : "=&s"(sv) : "v"(g), "s"(lds_base) : "memory");
}
__device__ __forceinline__ void attn_unit(const bf16_t* Q0, const bf16_t* Kbase, const bf16_t* Vbase, const int nkeys, bf16_t* O0, LAS unsigned char* lds) {
  const int tid = ltid(), lane = tid & 63, r32 = lane & 31, hi = lane >> 5;
  const int wid = __builtin_amdgcn_readfirstlane(tid >> 6);
  const int NTL = nkeys >> 6;
  __syncthreads();
  const bf16_t* ksrc = Kbase + (size_t)lane * 64 + wid * 8;
  const bf16_t* vsrc = Vbase + (size_t)(16 * (wid & 3) + (lane >> 2)) * 64 + (wid >> 2) * 32 + (lane & 3) * 8;
  const unsigned ldsb = (unsigned)(size_t)lds;
#define ATT_STAGE(t, slot) do { \
    glds16(ksrc + (size_t)(t) * 64 * 64, (unsigned)__builtin_amdgcn_readfirstlane(ldsb + (slot) * ATT_SLOT + wid * 1024)); \
    glds16(vsrc + (size_t)(t) * 64 * 64, (unsigned)__builtin_amdgcn_readfirstlane(ldsb + (slot) * ATT_SLOT + 8192 + wid * 1024)); } while (0)
  ATT_STAGE(0, 0);
  if (NTL > 1) ATT_STAGE(1, 1);
  bf16x8 qr[4];
  {
    const bf16_t* Qw = Q0 + (size_t)(wid * 32 + r32) * 512;
#pragma unroll
    for (int d0 = 0; d0 < 4; ++d0) qr[d0] = *(const bf16x8*)(Qw + d0 * 16 + hi * 8);
  }
  f32x16 o0, o1;
#pragma unroll
  for (int r = 0; r < 16; ++r) { o0[r] = 0.f; o1[r] = 0.f; }
  float m = -1e30f, l = 0.f;
  const int koff = hi * 1024 + r32 * 16;
  const int voff = 8192 + ((lane >> 4) & 1) * 32 + (lane & 3) * 8 + (4 * hi + ((lane & 15) >> 2)) * 64;
  const bool grpB = wid >= 4;
  bf16x8 pw[4];
#define ATT_PV(sl) do { const lds_cptr vp_ = (lds_cptr)(lds + (sl) * ATT_SLOT + voff); \
    _Pragma("unroll") for (int s4 = 0; s4 < 4; ++s4) { \
      const s16x4 a0l = vtr(vp_ + s4 * 1024), a0h = vtr(vp_ + s4 * 1024 + 512); \
      const s16x4 a1l = vtr(vp_ + 4096 + s4 * 1024), a1h = vtr(vp_ + 4096 + s4 * 1024 + 512); \
      const bf16x8 a0 = {a0l[0], a0l[1], a0l[2], a0l[3], a0h[0], a0h[1], a0h[2], a0h[3]}; \
      const bf16x8 a1 = {a1l[0], a1l[1], a1l[2], a1l[3], a1h[0], a1h[1], a1h[2], a1h[3]}; \
      o0 = __builtin_amdgcn_mfma_f32_32x32x16_bf16(a0, pw[s4], o0, 0, 0, 0); \
      o1 = __builtin_amdgcn_mfma_f32_32x32x16_bf16(a1, pw[s4], o1, 0, 0, 0); } } while (0)
  for (int t = 0; t <= NTL; ++t) {
    if (t + 1 < NTL) asm volatile("s_waitcnt vmcnt(2) lgkmcnt(0)\n\ts_barrier" ::: "memory"); else asm volatile("s_waitcnt vmcnt(0) lgkmcnt(0)\n\ts_barrier" ::: "memory");
    __builtin_amdgcn_sched_barrier(0);
    if (t + 2 < NTL) ATT_STAGE(t + 2, (t + 2) & 3);
    if (grpB && t > 0) ATT_PV((t - 1) & 3);
    if (t < NTL) {
      const lds_cptr kp = (lds_cptr)(lds + (t & 3) * ATT_SLOT + koff);
      f32x16 pA, pB;
#pragma unroll
      for (int r = 0; r < 16; ++r) { pA[r] = 0.f; pB[r] = 0.f; }
#pragma unroll
      for (int d0 = 0; d0 < 4; ++d0) {
        const bf16x8 k0 = *(const LAS bf16x8*)(kp + d0 * 2048), k1 = *(const LAS bf16x8*)(kp + d0 * 2048 + 512);
        pA = __builtin_amdgcn_mfma_f32_32x32x16_bf16(k0, qr[d0], pA, 0, 0, 0);
        pB = __builtin_amdgcn_mfma_f32_32x32x16_bf16(k1, qr[d0], pB, 0, 0, 0);
      }
      const float rm = rowmax32(pA, pB);
      const float mn = __builtin_fmaxf(m, rm);
      const float alpha = __builtin_amdgcn_exp2f(m - mn);
      m = mn;
      float ps = 0.f;
#pragma unroll
      for (int r = 0; r < 16; ++r) { pA[r] = __builtin_amdgcn_exp2f(pA[r] - mn); pB[r] = __builtin_amdgcn_exp2f(pB[r] - mn); ps += pA[r] + pB[r]; }
      l = l * alpha + ps;
#pragma unroll
      for (int r = 0; r < 16; ++r) { o0[r] *= alpha; o1[r] *= alpha; }
#pragma unroll
      for (int s4 = 0; s4 < 4; ++s4) {
        u32x4 w;
        if (s4 < 2) { w.x = cvt_pk_bf16(pA[8 * s4 + 0], pA[8 * s4 + 1]); w.y = cvt_pk_bf16(pA[8 * s4 + 2], pA[8 * s4 + 3]); w.z = cvt_pk_bf16(pA[8 * s4 + 4], pA[8 * s4 + 5]); w.w = cvt_pk_bf16(pA[8 * s4 + 6], pA[8 * s4 + 7]); }
        else { const int q = s4 - 2; w.x = cvt_pk_bf16(pB[8 * q + 0], pB[8 * q + 1]); w.y = cvt_pk_bf16(pB[8 * q + 2], pB[8 * q + 3]); w.z = cvt_pk_bf16(pB[8 * q + 4], pB[8 * q + 5]); w.w = cvt_pk_bf16(pB[8 * q + 6], pB[8 * q + 7]); }
        pw[s4] = __builtin_bit_cast(bf16x8, w);
      }
      if (!grpB) ATT_PV(t & 3);
    }
  }
#undef ATT_PV
#undef ATT_STAGE
  const float il = 1.f / half_swap_add(l);
  bf16_t* Ow = O0 + (size_t)(wid * 32 + r32) * 1024;
#pragma unroll
  for (int g4 = 0; g4 < 4; ++g4) {
    u32x2 w0, w1;
    w0.x = cvt_pk_bf16(o0[4 * g4 + 0] * il, o0[4 * g4 + 1] * il); w0.y = cvt_pk_bf16(o0[4 * g4 + 2] * il, o0[4 * g4 + 3] * il);
    w1.x = cvt_pk_bf16(o1[4 * g4 + 0] * il, o1[4 * g4 + 1] * il); w1.y = cvt_pk_bf16(o1[4 * g4 + 2] * il, o1[4 * g4 + 3] * il);
    *(u32x2*)(Ow + 8 * g4 + 4 * hi) = w0;
    *(u32x2*)(Ow + 32 + 8 * g4 + 4 * hi) = w1;
  }
}
__device__ __forceinline__ void attn_unit2(const bf16_t* Q0a, const bf16_t* Q0b, const bf16_t* Kbase, const bf16_t* Vbase, const int nkeys, bf16_t* O0a, bf16_t* O0b, LAS unsigned char* lds) {
  const int tid = ltid(), lane = tid & 63, r32 = lane & 31, hi = lane >> 5;
  const int wid = __builtin_amdgcn_readfirstlane(tid >> 6);
  const int NTL = nkeys >> 6;
  __syncthreads();
  const bf16_t* ksrc = Kbase + (size_t)lane * 64 + wid * 8;
  const bf16_t* vsrc = Vbase + (size_t)(16 * (wid & 3) + (lane >> 2)) * 64 + (wid >> 2) * 32 + (lane & 3) * 8;
  const unsigned ldsb = (unsigned)(size_t)lds;
#define ATT_STAGE(t, slot) do { \
    glds16(ksrc + (size_t)(t) * 64 * 64, (unsigned)__builtin_amdgcn_readfirstlane(ldsb + (slot) * ATT_SLOT + wid * 1024)); \
    glds16(vsrc + (size_t)(t) * 64 * 64, (unsigned)__builtin_amdgcn_readfirstlane(ldsb + (slot) * ATT_SLOT + 8192 + wid * 1024)); } while (0)
  ATT_STAGE(0, 0);
  if (NTL > 1) ATT_STAGE(1, 1);
  bf16x8 qr[2][4];
  {
    const bf16_t* Qa = Q0a + (size_t)(wid * 32 + r32) * 512;
    const bf16_t* Qb2 = Q0b + (size_t)(wid * 32 + r32) * 512;
#pragma unroll
    for (int d0 = 0; d0 < 4; ++d0) { qr[0][d0] = *(const bf16x8*)(Qa + d0 * 16 + hi * 8); qr[1][d0] = *(const bf16x8*)(Qb2 + d0 * 16 + hi * 8); }
  }
  f32x16 o0[2], o1[2];
#pragma unroll
  for (int hh = 0; hh < 2; ++hh)
#pragma unroll
    for (int r = 0; r < 16; ++r) { o0[hh][r] = 0.f; o1[hh][r] = 0.f; }
  float m[2] = {-1e30f, -1e30f}, l[2] = {0.f, 0.f};
  const int koff = hi * 1024 + r32 * 16;
  const int voff = 8192 + ((lane >> 4) & 1) * 32 + (lane & 3) * 8 + (4 * hi + ((lane & 15) >> 2)) * 64;
  int slot = 0;
  for (int t = 0; t < NTL; ++t) {
    if (t + 1 < NTL) asm volatile("s_waitcnt vmcnt(2) lgkmcnt(0)\n\ts_barrier" ::: "memory"); else asm volatile("s_waitcnt vmcnt(0) lgkmcnt(0)\n\ts_barrier" ::: "memory");
    __builtin_amdgcn_sched_barrier(0);
    if (t + 2 < NTL) { const int s2 = (slot >= 1) ? slot - 1 : 2; ATT_STAGE(t + 2, s2); }
    const lds_cptr kp = (lds_cptr)(lds + slot * ATT_SLOT + koff);
    const lds_cptr vp = (lds_cptr)(lds + slot * ATT_SLOT + voff);
    f32x16 pA[2], pB[2];
#pragma unroll
    for (int hh = 0; hh < 2; ++hh)
#pragma unroll
      for (int r = 0; r < 16; ++r) { pA[hh][r] = 0.f; pB[hh][r] = 0.f; }
#pragma unroll
    for (int d0 = 0; d0 < 4; ++d0) {
      const bf16x8 k0 = *(const LAS bf16x8*)(kp + d0 * 2048), k1 = *(const LAS bf16x8*)(kp + d0 * 2048 + 512);
#pragma unroll
      for (int hh = 0; hh < 2; ++hh) {
        pA[hh] = __builtin_amdgcn_mfma_f32_32x32x16_bf16(k0, qr[hh][d0], pA[hh], 0, 0, 0);
        pB[hh] = __builtin_amdgcn_mfma_f32_32x32x16_bf16(k1, qr[hh][d0], pB[hh], 0, 0, 0);
      }
    }
    bf16x8 pw[2][4];
#pragma unroll
    for (int hh = 0; hh < 2; ++hh) {
      const float rm = rowmax32(pA[hh], pB[hh]);
      const float mn = __builtin_fmaxf(m[hh], rm);
      const float alpha = __builtin_amdgcn_exp2f(m[hh] - mn);
      m[hh] = mn;
      float ps = 0.f;
#pragma unroll
      for (int r = 0; r < 16; ++r) { pA[hh][r] = __builtin_amdgcn_exp2f(pA[hh][r] - mn); pB[hh][r] = __builtin_amdgcn_exp2f(pB[hh][r] - mn); ps += pA[hh][r] + pB[hh][r]; }
      l[hh] = l[hh] * alpha + ps;
#pragma unroll
      for (int r = 0; r < 16; ++r) { o0[hh][r] *= alpha; o1[hh][r] *= alpha; }
#pragma unroll
      for (int s4 = 0; s4 < 4; ++s4) {
        u32x4 w;
        if (s4 < 2) { w.x = cvt_pk_bf16(pA[hh][8 * s4 + 0], pA[hh][8 * s4 + 1]); w.y = cvt_pk_bf16(pA[hh][8 * s4 + 2], pA[hh][8 * s4 + 3]); w.z = cvt_pk_bf16(pA[hh][8 * s4 + 4], pA[hh][8 * s4 + 5]); w.w = cvt_pk_bf16(pA[hh][8 * s4 + 6], pA[hh][8 * s4 + 7]); }
        else { const int q = s4 - 2; w.x = cvt_pk_bf16(pB[hh][8 * q + 0], pB[hh][8 * q + 1]); w.y = cvt_pk_bf16(pB[hh][8 * q + 2], pB[hh][8 * q + 3]); w.z = cvt_pk_bf16(pB[hh][8 * q + 4], pB[hh][8 * q + 5]); w.w = cvt_pk_bf16(pB[hh][8 * q + 6], pB[hh][8 * q + 7]); }
        pw[hh][s4] = __builtin_bit_cast(bf16x8, w);
      }
    }
#pragma unroll
    for (int s4 = 0; s4 < 4; ++s4) {
      const s16x4 a0l = vtr(vp + s4 * 1024), a0h = vtr(vp + s4 * 1024 + 512);
      const s16x4 a1l = vtr(vp + 4096 + s4 * 1024), a1h = vtr(vp + 4096 + s4 * 1024 + 512);
      const bf16x8 a0 = {a0l[0], a0l[1], a0l[2], a0l[3], a0h[0], a0h[1], a0h[2], a0h[3]};
      const bf16x8 a1 = {a1l[0], a1l[1], a1l[2], a1l[3], a1h[0], a1h[1], a1h[2], a1h[3]};
#pragma unroll
      for (int hh = 0; hh < 2; ++hh) {
        o0[hh] = __builtin_amdgcn_mfma_f32_32x32x16_bf16(a0, pw[hh][s4], o0[hh], 0, 0, 0);
        o1[hh] = __builtin_amdgcn_mfma_f32_32x32x16_bf16(a1, pw[hh][s4], o1[hh], 0, 0, 0);
      }
    }
    slot = (slot == 2) ? 0 : slot + 1;
  }
#undef ATT_STAGE
#pragma unroll
  for (int hh = 0; hh < 2; ++hh) {
    const float il = 1.f / half_swap_add(l[hh]);
    bf16_t* Ow = (hh ? O0b : O0a) + (size_t)(wid * 32 + r32) * 1024;
#pragma unroll
    for (int g4 = 0; g4 < 4; ++g4) {
      u32x2 w0, w1;
      w0.x = cvt_pk_bf16(o0[hh][4 * g4 + 0] * il, o0[hh][4 * g4 + 1] * il); w0.y = cvt_pk_bf16(o0[hh][4 * g4 + 2] * il, o0[hh][4 * g4 + 3] * il);
      w1.x = cvt_pk_bf16(o1[hh][4 * g4 + 0] * il, o1[hh][4 * g4 + 1] * il); w1.y = cvt_pk_bf16(o1[hh][4 * g4 + 2] * il, o1[hh][4 * g4 + 3] * il);
      *(u32x2*)(Ow + 8 * g4 + 4 * hi) = w0;
      *(u32x2*)(Ow + 32 + 8 * g4 + 4 * hi) = w1;
    }
  }
}
__device__ __forceinline__ void ph_att(const Params& p, bool ctx_q, LAS unsigned char* lds) {
  const int c = lbid(), G = lgdim();
  const int nunits = 256 + (ctx_q ? 32 : 0);
  for (int L = c; L < nunits; L += G) {
    if (L < 256) {
      const int grp = (L & 7) * 2 + ((L >> 3) >> 4), within = (L >> 3) & 15;
      const int b = grp >> 1, kvh = grp & 1, h0 = kvh * 4 + 2 * (within >> 3), qt = within & 7;
      const size_t row0 = (size_t)b * 2048 + qt * 256;
      const size_t kvb = (size_t)(b * 2 + kvh) * 2304 * 64;
      attn_unit2(p.Qb + row0 * 512 + h0 * 64, p.Qb + row0 * 512 + (h0 + 1) * 64, p.Kb + kvb, p.Vb + kvb, 2304, p.mix + row0 * 1024 + h0 * 64, p.mix + row0 * 1024 + (h0 + 1) * 64, lds);
    } else {
      const int u = L - 256, b = u >> 2, kvh = (u >> 1) & 1, h0 = kvh * 4 + 2 * (u & 1);
      const size_t row0 = (size_t)NL + b * 256;
      const size_t kvb = (size_t)(b * 2 + kvh) * 2304 * 64;
      attn_unit2(p.Qb + row0 * 512 + h0 * 64, p.Qb + row0 * 512 + (h0 + 1) * 64, p.Kb + kvb, p.Vb + kvb, 256, p.mix + row0 * 1024 + h0 * 64, p.mix + row0 * 1024 + (h0 + 1) * 64, lds);
    }
  }
  __syncthreads();
}

__device__ __forceinline__ int chunk_row0(int b, int dir, int cc) {
  if (cc < 2) return NL + b * 256 + (dir ? 1 - cc : cc) * 128;
  return b * 2048 + (dir ? 15 - (cc - 2) : cc - 2) * 128;
}
__device__ __forceinline__ int trq_addr(int lane, int quarter, int rowbase) {
  return quarter * 8192 + ((lane >> 4) & 1) * 32 + (lane & 3) * 8 + (rowbase + ((lane & 15) >> 2)) * 64;
}
__device__ __forceinline__ bf16x8 cat44(const s16x4 a, const s16x4 b) { return (bf16x8){a[0], a[1], a[2], a[3], b[0], b[1], b[2], b[3]}; }

__device__ __forceinline__ void glds4(const void* g, unsigned lds_base) {
  unsigned sv;
  asm volatile("s_mov_b32 %0, m0\n\ts_mov_b32 m0, %2\n\ts_nop 0\n\tglobal_load_lds_dword %1, off\n\ts_mov_b32 m0, %0" : "=&s"(sv) : "v"(g), "s"(lds_base) : "memory");
}
#define USC_SLOT 41472
#define USC_WS 124416
#define USC_NP 124928
#define USC_TB 125952
#define USC_CS 133120
__device__ __forceinline__ void ph_mlstm_uscan(const Params& p, LAS unsigned char* lds) {
  const int tid = ltid(), lane = tid & 63, r32 = lane & 31, hi = lane >> 5;
  const int wid = __builtin_amdgcn_readfirstlane(tid >> 6);
  LAS float* WS = (LAS float*)(lds + USC_WS);
  LAS float* NP = (LAS float*)(lds + USC_NP);
  LAS float* TE1 = (LAS float*)(lds + USC_TB);
  LAS float* TDEC = TE1 + 18;
  const unsigned ldsb = (unsigned)(size_t)lds;
  for (int unit = lbid(); unit < 256; unit += lgdim()) {
    const int eb = (unit >> 3) & 3, chain = (unit >> 5) * 8 + (unit & 7);
    const int b = chain >> 3, hd = (chain >> 1) & 3, dir = chain & 1;
    __syncthreads();
#define USC_ISSUE(cc_, s_) do { const int row0_ = chunk_row0(b, dir, (cc_)); \
      _Pragma("unroll") for (int n = 0; n < 4; ++n) { const int ii = wid * 4 + n, qd = ii >> 3, rg = ii & 7; \
        glds16(p.km + (size_t)(row0_ + rg * 16 + (lane >> 2)) * 512 + hd * 128 + qd * 32 + (lane & 3) * 8, \
               (unsigned)__builtin_amdgcn_readfirstlane(ldsb + (s_) * USC_SLOT + qd * 8192 + rg * 1024)); } \
      glds16(p.proj + (size_t)(row0_ + wid * 16 + (lane >> 2)) * PROJW + 1792 + hd * 128 + eb * 32 + (lane & 3) * 8, \
             (unsigned)__builtin_amdgcn_readfirstlane(ldsb + (s_) * USC_SLOT + 32768 + wid * 1024)); \
      if (wid < 2) glds4(p.gsG + (size_t)(row0_ + wid * 64 + lane) * 8 + dir * 4 + hd, (unsigned)__builtin_amdgcn_readfirstlane(ldsb + (s_) * USC_SLOT + 40960 + wid * 256)); \
    } while (0)
    USC_ISSUE(0, 0);
    USC_ISSUE(1, 1);
    if (tid == 0) {
      float be[18], gm[18];
#pragma unroll
      for (int c = 0; c < 18; ++c) { be[c] = p.cBE[chain * 18 + c]; gm[c] = p.cGM[chain * 18 + c]; }
      float m_in = -1e30f;
#pragma unroll
      for (int c = 0; c < 18; ++c) {
        const float m_next = fmaxf(m_in + be[c], be[c] + gm[c]);
        TE1[c] = (be[c] - m_next) * LOG2E;
        TDEC[c] = expf(m_in + be[c] - m_next);
        if (eb == 0) p.cMIN[chain * 18 + c] = m_in * LOG2E;
        m_in = m_next;
      }
    }
    f32x16 cacc;
#pragma unroll
    for (int r = 0; r < 16; ++r) cacc[r] = 0.f;
    float nv = 0.f;
    LDS_BARRIER();
#pragma unroll
    for (int c = 0; c < 17; ++c) {
      const int s = c % 3;
      LAS unsigned char* slot = lds + s * USC_SLOT;
      if (c < 16) asm volatile("s_waitcnt vmcnt(5)" ::: "memory"); else asm volatile("s_waitcnt vmcnt(0)" ::: "memory");
      if (tid < 128) WS[tid] = __builtin_amdgcn_exp2f(*(const LAS float*)(slot + 40960 + tid * 4) + TE1[c]);
      LDS_BARRIER();
      if (c + 2 < 17) USC_ISSUE(c + 2, (c + 2) % 3);
      {
        float f[8];
        unpack8(*(const LAS u32x4*)(slot + 32768 + tid * 16), f);
        const float w = WS[tid >> 2];
#pragma unroll
        for (int j = 0; j < 8; ++j) f[j] *= w;
        *(LAS u32x4*)(slot + 32768 + tid * 16) = pack8(f);
      }
      LDS_BARRIER();
      const float dec = TDEC[c];
      if (wid < 4) {
#pragma unroll
        for (int r = 0; r < 16; ++r) cacc[r] *= dec;
#pragma unroll
        for (int ks = 0; ks < 8; ++ks) {
          const int rb = ks * 16 + 8 * hi;
          const bf16x8 kf = cat44(vtr((lds_cptr)(slot + trq_addr(lane, wid, rb))), vtr((lds_cptr)(slot + trq_addr(lane, wid, rb + 4))));
          const bf16x8 vf = cat44(vtr((lds_cptr)(slot + 32768 + trq_addr(lane, 0, rb))), vtr((lds_cptr)(slot + 32768 + trq_addr(lane, 0, rb + 4))));
          cacc = __builtin_amdgcn_mfma_f32_32x32x16_bf16(kf, vf, cacc, 0, 0, 0);
        }
#pragma unroll
        for (int g4 = 0; g4 < 4; ++g4) {
          u32x2 w2; w2.x = cvt_pk_bf16(cacc[4 * g4], cacc[4 * g4 + 1]); w2.y = cvt_pk_bf16(cacc[4 * g4 + 2], cacc[4 * g4 + 3]);
          *(LAS u32x2*)(lds + USC_CS + r32 * 272 + (wid * 32 + 8 * g4 + 4 * hi) * 2) = w2;
        }
      } else {
        const int t2 = tid - 256, dl = t2 & 31, part = t2 >> 5;
        float acc = 0.f;
#pragma unroll
        for (int i = 0; i < 16; ++i) {
          const int srow = part * 16 + i;
          acc += WS[srow] * bf2f(*(const LAS bf16_t*)(slot + eb * 8192 + srow * 64 + dl * 2));
        }
        NP[part * 32 + dl] = acc;
      }
      LDS_BARRIER();
      {
        const u32x4 cv = *(const LAS u32x4*)(lds + USC_CS + (tid >> 4) * 272 + (tid & 15) * 16);
        *(u32x4*)(p.Cbf + ((size_t)chain * 18 + c + 1) * 16384 + (size_t)(eb * 32 + (tid >> 4)) * 128 + (tid & 15) * 8) = cv;
      }
      if (tid < 32) {
        float sn = 0.f;
#pragma unroll
        for (int q = 0; q < 8; ++q) sn += NP[q * 32 + tid];
        nv = dec * nv + sn;
        p.NVb[((size_t)chain * 18 + c + 1) * 128 + eb * 32 + tid] = nv;
      }
    }
    asm volatile("s_waitcnt vmcnt(0)" ::: "memory");
  }
  __syncthreads();
}

__device__ __forceinline__ void ph_mlstm_h(const Params& p, int l, bool ctx_out, LAS unsigned char* lds) {
  const int e2 = l >> 1;
  const int tid = ltid(), lane = tid & 63, r32 = lane & 31, hi = lane >> 5;
  const int wid = __builtin_amdgcn_readfirstlane(tid >> 6);
  const int tb = wid & 3, dir = wid >> 2;
  LAS float* HX = (LAS float*)(lds);
  LAS float* GC = (LAS float*)(lds + 131072);
  const int j0 = ctx_out ? 0 : 2, nj = 18 - j0;
  for (int unit = lbid(); unit < 32 * nj; unit += lgdim()) {
    const int bh = unit / nj, j = j0 + unit % nj, b = bh >> 2, hd = bh & 3;
    const int row0 = (j < 2) ? NL + b * 256 + j * 128 : b * 2048 + (j - 2) * 128;
    const int cc = dir ? (j < 2 ? 1 - j : 19 - j) : j;
    const int chain = b * 8 + hd * 2 + dir;
    __syncthreads();
#pragma unroll
    for (int n = 0; n < 4; ++n) {
      const int ii = wid * 4 + n;
      { const int ch = ii >> 1, rh = ii & 1;
        const bf16_t* src = p.km + (size_t)(row0 + rh * 64 + lane) * 512 + hd * 128 + ch * 8;
        __builtin_amdgcn_global_load_lds((const unsigned*)src, (LAS unsigned*)(lds + ch * 2048 + rh * 1024), 16, 0, 0); }
      { const int qd = ii >> 3, rg = ii & 7;
        const bf16_t* src = p.proj + (size_t)(row0 + rg * 16 + (lane >> 2)) * PROJW + 1792 + hd * 128 + qd * 32 + (lane & 3) * 8;
        __builtin_amdgcn_global_load_lds((const unsigned*)src, (LAS unsigned*)(lds + 32768 + qd * 8192 + rg * 1024), 16, 0, 0); }
    }
#pragma unroll
    for (int n = 0; n < 8; ++n) {
      const int ii2 = wid * 8 + n, dd = ii2 >> 5, ch = (ii2 & 31) >> 1, rh = ii2 & 1;
      const int ccd = dd ? (j < 2 ? 1 - j : 19 - j) : j;
      if (ccd > 0) {
        const bf16_t* src = p.Cbf + ((size_t)(b * 8 + hd * 2 + dd) * 18 + ccd) * 16384 + (size_t)(rh * 64 + lane) * 128 + ch * 8;
        __builtin_amdgcn_global_load_lds((const unsigned*)src, (LAS unsigned*)(lds + 65536 + dd * 32768 + ch * 2048 + rh * 1024), 16, 0, 0);
      }
    }
    const int trow = row0 + tb * 32 + r32;
    bf16x8 qf[8];
#pragma unroll
    for (int ks = 0; ks < 8; ++ks) qf[ks] = *(const bf16x8*)(p.qm + (size_t)trow * 512 + hd * 128 + ks * 16 + hi * 8);
    const float MIN2 = p.cMIN[chain * 18 + cc];
    const float R2 = -fmaxf(MIN2, p.gsR[(size_t)trow * 8 + dir * 4 + hd]), BQ2 = p.gsB[(size_t)trow * 8 + dir * 4 + hd];
    f32x16 acc[4];
#pragma unroll
    for (int eb = 0; eb < 4; ++eb)
#pragma unroll
      for (int r = 0; r < 16; ++r) acc[eb][r] = 0.f;
    float nq = 0.f;
    if (cc > 0) {
      const float* nvp = p.NVb + ((size_t)chain * 18 + cc) * 128 + hi * 8;
#pragma unroll
      for (int ks = 0; ks < 8; ++ks) {
        const f32x4 n0 = *(const f32x4*)(nvp + ks * 16), n1 = *(const f32x4*)(nvp + ks * 16 + 4);
        float qv[8];
        unpack8(__builtin_bit_cast(u32x4, qf[ks]), qv);
        nq += n0[0] * qv[0] + n0[1] * qv[1] + n0[2] * qv[2] + n0[3] * qv[3] + n1[0] * qv[4] + n1[1] * qv[5] + n1[2] * qv[6] + n1[3] * qv[7];
      }
      nq = half_swap_add(nq);
    }
    const float* gh = p.g_hnorm + e2 * 512 + hd * 128;
    const bf16_t* obp = p.proj + (size_t)trow * PROJW + 2304 + hd * 128;
    const float winter = __builtin_amdgcn_exp2f(MIN2 + R2);
    if (tid < 256) GC[tid] = p.gsG[(size_t)(row0 + (tid & 127)) * 8 + (tid >> 7) * 4 + hd];
    asm volatile("s_waitcnt vmcnt(0)" ::: "memory");
    __syncthreads();
    if (cc > 0) {
#pragma unroll
      for (int eb = 0; eb < 4; ++eb)
#pragma unroll
        for (int ks = 0; ks < 8; ++ks) {
          const bf16x8 a = *(const LAS bf16x8*)(lds + 65536 + dir * 32768 + (2 * ks + hi) * 2048 + (eb * 32 + r32) * 16);
          acc[eb] = __builtin_amdgcn_mfma_f32_32x32x16_bf16(a, qf[ks], acc[eb], 0, 0, 0);
        }
#pragma unroll
      for (int eb = 0; eb < 4; ++eb)
#pragma unroll
        for (int r = 0; r < 16; ++r) acc[eb][r] *= winter;
    }
    float sw = 0.f;
    const int sb_lo = dir ? tb : 0, sb_hi = dir ? 3 : tb;
    for (int sb = sb_lo; sb <= sb_hi; ++sb) {
      f32x16 st;
#pragma unroll
      for (int r = 0; r < 16; ++r) st[r] = 0.f;
#pragma unroll
      for (int ks = 0; ks < 8; ++ks) {
        const bf16x8 kf = *(const LAS bf16x8*)(lds + (2 * ks + hi) * 2048 + (sb * 32 + r32) * 16);
        st = __builtin_amdgcn_mfma_f32_32x32x16_bf16(kf, qf[ks], st, 0, 0, 0);
      }
      const bool diag = (sb == tb);
#pragma unroll
      for (int g4 = 0; g4 < 4; ++g4) {
        const f32x4 gc = *(const LAS f32x4*)(GC + dir * 128 + sb * 32 + 8 * g4 + 4 * hi);
#pragma unroll
        for (int q = 0; q < 4; ++q) {
          const int sl = 8 * g4 + 4 * hi + q;
          float w = __builtin_amdgcn_exp2f(R2 + gc[q]) * st[4 * g4 + q];
          const bool keep = !diag || (dir ? (sl >= r32) : (sl <= r32));
          w = keep ? w : 0.f;
          sw += w;
          st[4 * g4 + q] = w;
        }
      }
      u32x4 p0, p1;
      p0.x = cvt_pk_bf16(st[0], st[1]); p0.y = cvt_pk_bf16(st[2], st[3]); p0.z = cvt_pk_bf16(st[4], st[5]); p0.w = cvt_pk_bf16(st[6], st[7]);
      p1.x = cvt_pk_bf16(st[8], st[9]); p1.y = cvt_pk_bf16(st[10], st[11]); p1.z = cvt_pk_bf16(st[12], st[13]); p1.w = cvt_pk_bf16(st[14], st[15]);
      const bf16x8 pw0 = __builtin_bit_cast(bf16x8, p0), pw1 = __builtin_bit_cast(bf16x8, p1);
#pragma unroll
      for (int eb = 0; eb < 4; ++eb) {
        const int rb = sb * 32 + 4 * hi;
        const bf16x8 a0 = cat44(vtr((lds_cptr)(lds + 32768 + trq_addr(lane, eb, rb))), vtr((lds_cptr)(lds + 32768 + trq_addr(lane, eb, rb + 8))));
        const bf16x8 a1 = cat44(vtr((lds_cptr)(lds + 32768 + trq_addr(lane, eb, rb + 16))), vtr((lds_cptr)(lds + 32768 + trq_addr(lane, eb, rb + 24))));
        acc[eb] = __builtin_amdgcn_mfma_f32_32x32x16_bf16(a0, pw0, acc[eb], 0, 0, 0);
        acc[eb] = __builtin_amdgcn_mfma_f32_32x32x16_bf16(a1, pw1, acc[eb], 0, 0, 0);
      }
    }
    sw = half_swap_add(sw);
    const float den = winter * nq + sw;
    const float dn = fmaxf(fabsf(den), __builtin_amdgcn_exp2f(R2 - BQ2));
    const float idn = 1.f / dn;
    __syncthreads();
    if (dir == 1) {
#pragma unroll
      for (int eb = 0; eb < 4; ++eb)
#pragma unroll
        for (int r = 0; r < 16; ++r) HX[(tb * 128 + eb * 32 + (r & 3) + 8 * (r >> 2) + 4 * hi) * 32 + r32] = acc[eb][r] * idn;
    }
    __syncthreads();
    if (dir == 0) {
      float ss = 0.f;
#pragma unroll
      for (int eb = 0; eb < 4; ++eb)
#pragma unroll
        for (int r = 0; r < 16; ++r) {
          const float v = acc[eb][r] * idn + HX[(tb * 128 + eb * 32 + (r & 3) + 8 * (r >> 2) + 4 * hi) * 32 + r32];
          acc[eb][r] = v; ss += v * v;
        }
      ss = half_swap_add(ss);
      const float inv = rsqrtf(ss * (1.f / 128.f) + EPS);
      bf16_t* op = p.mix + (size_t)trow * 1024 + 512 + hd * 128;
#pragma unroll
      for (int eb = 0; eb < 4; ++eb) {
        f32x4 gv[4]; u32x2 ow[4];
#pragma unroll
        for (int g4 = 0; g4 < 4; ++g4) { const int e0 = eb * 32 + 8 * g4 + 4 * hi; gv[g4] = *(const f32x4*)(gh + e0); ow[g4] = *(const u32x2*)(obp + e0); }
#pragma unroll
        for (int g4 = 0; g4 < 4; ++g4) {
          const int e0 = eb * 32 + 8 * g4 + 4 * hi;
          const float ob0 = __uint_as_float(ow[g4].x << 16), ob1 = __uint_as_float(ow[g4].x & 0xffff0000u), ob2 = __uint_as_float(ow[g4].y << 16), ob3 = __uint_as_float(ow[g4].y & 0xffff0000u);
          const float v0 = acc[eb][4 * g4 + 0] * inv * gv[g4][0] * sigmoidf_(ob0), v1 = acc[eb][4 * g4 + 1] * inv * gv[g4][1] * sigmoidf_(ob1);
          const float v2 = acc[eb][4 * g4 + 2] * inv * gv[g4][2] * sigmoidf_(ob2), v3 = acc[eb][4 * g4 + 3] * inv * gv[g4][3] * sigmoidf_(ob3);
          u32x2 w; w.x = cvt_pk_bf16(v0, v1); w.y = cvt_pk_bf16(v2, v3);
          *(u32x2*)(op + e0) = w;
        }
      }
    }
  }
  __syncthreads();
}

template <int EPL>
__device__ __forceinline__ void topk_column(const Params& p, const float* col, int e, int base, int cap, size_t mbase, int lane) {
  unsigned v[EPL];
#pragma unroll
  for (int k = 0; k < EPL; ++k) v[k] = __float_as_uint(col[k * 64 + lane]);
  unsigned thr = 0u;
  for (int bit = 30; bit >= 0; --bit) {
    const unsigned cand = thr | (1u << bit);
    unsigned c = 0;
#pragma unroll
    for (int k = 0; k < EPL; ++k) c += (v[k] >= cand) ? 1u : 0u;
#pragma unroll
    for (int o = 32; o > 0; o >>= 1) c += __shfl_xor(c, o);
    if (c >= (unsigned)cap) thr = cand;
  }
  unsigned totgt = 0;
#pragma unroll
  for (int k = 0; k < EPL; ++k) totgt += (unsigned)__popcll(__ballot(v[k] > thr));
  const unsigned need_eq = (unsigned)cap - totgt;
  unsigned cg = 0, ce = 0;
#pragma unroll
  for (int k = 0; k < EPL; ++k) {
    const bool gt = v[k] > thr, eq = v[k] == thr;
    const unsigned long long bg = __ballot(gt), be = __ballot(eq);
    const unsigned gtb = cg + __builtin_amdgcn_mbcnt_hi((unsigned)(bg >> 32), __builtin_amdgcn_mbcnt_lo((unsigned)bg, 0u));
    const unsigned eqb = ce + __builtin_amdgcn_mbcnt_hi((unsigned)(be >> 32), __builtin_amdgcn_mbcnt_lo((unsigned)be, 0u));
    const bool take = gt || (eq && eqb < need_eq);
    const int r = base + k * 64 + lane;
    const unsigned slot = gtb + (eqb < need_eq ? eqb : need_eq);
    if (take) { p.slotmap[(size_t)r * 16 + e] = (int)slot; p.rowidx[mbase + slot] = r; p.gatev[mbase + slot] = __uint_as_float(v[k]); }
    else p.slotmap[(size_t)r * 16 + e] = -1;
    cg += (unsigned)__popcll(bg); ce += (unsigned)__popcll(be);
  }
}
__device__ __forceinline__ void ph_topk(const Params& p, bool ctx, float* sm) {
  const int tid = ltid(), lane = tid & 63, wv = tid >> 6;
  const int ntask = ctx ? 32 : 16;
  for (int task = lbid(); task < ntask; task += lgdim()) {
    const bool lat = task < 16;
    const int b = (task >> 1) & 7, eh = task & 1, n = lat ? 2048 : 256, cap = lat ? 256 : 32, base = lat ? b * 2048 : NL + b * 256;
    __syncthreads();
    for (int idx0 = tid; idx0 < n * 2; idx0 += 8 * NTHR) {
      float4 a[8];
#pragma unroll
      for (int u = 0; u < 8; ++u) { const int idx = min(idx0 + u * NTHR, n * 2 - 1); a[u] = *(const float4*)(p.aff + (size_t)(base + (idx >> 1)) * 16 + eh * 8 + (idx & 1) * 4); }
      __builtin_amdgcn_sched_barrier(0);
#pragma unroll
      for (int u = 0; u < 8; ++u) {
        const int idx = idx0 + u * NTHR, row = idx >> 1, q = idx & 1;
        if (idx < n * 2) { sm[(q * 4 + 0) * n + row] = a[u].x; sm[(q * 4 + 1) * n + row] = a[u].y; sm[(q * 4 + 2) * n + row] = a[u].z; sm[(q * 4 + 3) * n + row] = a[u].w; }
      }
    }
    __syncthreads();
    {
      const int e = eh * 8 + wv;
      if (lat) topk_column<32>(p, sm + wv * n, e, base, cap, (size_t)e * 2048 + (size_t)b * 256, lane);
      else topk_column<4>(p, sm + wv * n, e, base, cap, (size_t)MOE_L + (size_t)e * 256 + (size_t)b * 32, lane);
    }
  }
  __syncthreads();
}

template <int W>
__device__ __forceinline__ void pool_item(const Params& p, int r, int c8) {
  int t, n;
  if (r < NL) { t = r & 2047; n = 2048; } else { t = (r - NL) & 255; n = 256; }
  constexpr int lo = W / 2;
  const bf16_t* up = p.proj + (size_t)r * 1024 + c8;
  u32x4 raw[W];
  int cnt = 0;
#pragma unroll
  for (int k = 0; k < W; ++k) {
    const int tt = t - lo + k;
    const bool ok = tt >= 0 && tt < n;
    const int tc = tt < 0 ? 0 : (tt >= n ? n - 1 : tt);
    const u32x4 ld = *(const u32x4*)(up + (ptrdiff_t)(tc - t) * 1024);
    raw[k].x = ok ? ld.x : 0u; raw[k].y = ok ? ld.y : 0u; raw[k].z = ok ? ld.z : 0u; raw[k].w = ok ? ld.w : 0u;
    cnt += ok ? 1 : 0;
  }
  float s8[8], f[8], uc[8];
#pragma unroll
  for (int j = 0; j < 8; ++j) s8[j] = 0.f;
#pragma unroll
  for (int k = 0; k < W; ++k) {
    unpack8(raw[k], f);
#pragma unroll
    for (int j = 0; j < 8; ++j) s8[j] += f[j];
  }
  unpack8(raw[lo], uc);
  const float ic = 1.f / (float)cnt;
#pragma unroll
  for (int j = 0; j < 8; ++j) f[j] = s8[j] * ic - uc[j];
  *(u32x4*)(p.mix + (size_t)r * 1024 + c8) = pack8(f);
}
__device__ __forceinline__ void ph_pool(const Params& p, int nrows) {
  const size_t gtid = (size_t)lbid() * NTHR + ltid(), gsz = (size_t)lgdim() * NTHR;
  for (size_t it = gtid; it < (size_t)nrows * 128; it += gsz) {
    const int g = (int)(it / ((size_t)nrows * 32));
    const size_t rem = it - (size_t)g * nrows * 32;
    const int r = (int)(rem >> 5), c8 = g * 256 + (int)(rem & 31) * 8;
    if (g == 0) pool_item<2>(p, r, c8);
    else if (g == 1) pool_item<4>(p, r, c8);
    else if (g == 2) pool_item<8>(p, r, c8);
    else pool_item<16>(p, r, c8);
  }
}

enum { PH_INIT = 0, PH_NORM1, PH_GEMM_IN_EVEN, PH_POST_EVEN, PH_ATT, PH_MLSTM_U, PH_MLSTM_SCAN, PH_MLSTM_H, PH_GEMM_OUT, PH_NORM2, PH_TOPK, PH_GATHER,
       PH_MOE_GU, PH_MOE_D, PH_GEMM_IN_ODD, PH_POOL, PH_GEMM_GRP, PH_FINAL };

typedef const __attribute__((address_space(4))) Params* KParams;
__device__ __forceinline__ const Params& get_params() {
  KParams kp = (KParams)__builtin_amdgcn_kernarg_segment_ptr();
  asm volatile("" : "+s"(kp));
  return *(const Params*)kp;
}
__device__ __forceinline__ int idle_slots(int nu, int G, int c) {
  const int mx = (nu + G - 1) / G, mine = c < nu ? (nu - c + G - 1) / G : 0;
  return mx - mine;
}
__device__ __forceinline__ void run_phase(int ph, int l, unsigned char* shm) {
  const Params& p = get_params();
  float* sm = (float*)shm;
  LAS unsigned char* lds = (LAS unsigned char*)shm;
  const bool ctx_next = (l < 2);
  const bool ctx_used = (l < 3);
  const int G = lgdim(), c = lbid();
  switch (ph) {
    case PH_INIT: ph_init(p, sm); break;
    case PH_NORM1: {
      const int ncomb = (l == 0) ? 0 : ((l - 1) < 2 ? NT : NL);
      ph_norm(p, l, 1, ctx_used ? NT : NL, ncomb, l - 1, sm);
    } break;
    case PH_GEMM_IN_EVEN: {
      g8::SchedDense S{(const char*)p.hbuf, (const char*)(p.WinE + (size_t)(l >> 1) * PROJW * 1024), 1024, 1024, NT / 256, PROJW / 256, 0, G, c};
      g8::EpiBf16 E{p.proj, PROJW};
      g8::gemm_phase(lds, 1024, 1024, 1024, S, E);
      conv_quota(p, idle_slots(S.nM * S.nN, G, c) * 3, sm);
    } break;
    case PH_POST_EVEN: ph_post_even(p, l, sm); break;
    case PH_ATT: ph_att(p, ctx_next, lds); ph_mlstm_uscan(p, lds); conv_quota(p, idle_slots(256 + (ctx_next ? 32 : 0), G, c) * 1, sm); break;
    case PH_MLSTM_H: ph_mlstm_h(p, l, ctx_next, lds); conv_quota(p, idle_slots(32 * (ctx_next ? 18 : 16), G, c) * 3, sm); break;
    case PH_GEMM_OUT: {
      g8::SchedDense S{(const char*)p.mix, (const char*)(p.WoutE + (size_t)(l >> 1) * 1024 * 1024), 1024, 1024, (ctx_next ? NT : NL) / 256, 4, 0, G, c};
      g8::EpiBf16 E{p.ybuf, 1024};
      g8::gemm_phase(lds, 1024, 1024, 1024, S, E);
      conv_quota(p, idle_slots(S.nM * S.nN, G, c) * 3, sm);
    } break;
    case PH_NORM2: ph_norm(p, l, 2, ctx_next ? NT : NL, 0, 0, sm); break;
    case PH_TOPK: ph_topk(p, ctx_next, sm); conv_until(p, l == 0 ? CE4 : (l == 1 ? CE7 : (l == 2 ? CE10 : CE11)), sm); break;
    case PH_MOE_GU: {
      g8::SchedMoe S{(const char*)p.Xs, (const char*)(p.Wgu + (size_t)l * NEXP * 2048 * 1024), 8, 2048, 128, ctx_next ? 1152 : 1024, G, c};
      g8::EpiSwiGLU E{p.Abuf};
      g8::gemm_phase<true>(lds, 1024, 1024, 1024, S, E, p.rowidx, (const char*)p.hbuf);
      conv_quota(p, idle_slots(S.nu, G, c) * 3, sm);
    } break;
    case PH_MOE_D: {
      g8::SchedMoe S{(const char*)p.Abuf, (const char*)(p.Wd + (size_t)l * NEXP * 1024 * 1024), 4, 1024, 256, ctx_next ? 576 : 512, G, c};
      g8::EpiDown E{p.Ybuf, p.gatev};
      g8::gemm_phase(lds, 1024, 1024, 1024, S, E);
      conv_quota(p, idle_slots(S.nu, G, c) * 3, sm);
    } break;
    case PH_GEMM_IN_ODD: {
      g8::SchedDense S{(const char*)p.hbuf, (const char*)(p.WinO + (size_t)(l >> 1) * 1024 * 1024), 1024, 1024, (ctx_next ? NT : NL) / 256, 4, 0, G, c};
      g8::EpiBf16 E{p.proj, 1024};
      g8::gemm_phase(lds, 1024, 1024, 1024, S, E);
      conv_quota(p, idle_slots(S.nM * S.nN, G, c) * 3, sm);
    } break;
    case PH_POOL: ph_pool(p, ctx_next ? NT : NL); break;
    case PH_GEMM_GRP: {
      g8::SchedDense S{(const char*)p.mix, (const char*)(p.Wgrp + (size_t)(l >> 1) * 1024 * 256), 1024, 256, (ctx_next ? NT : NL) / 256, 4, 512, G, c};
      g8::EpiBf16 E{p.ybuf, 1024};
      g8::gemm_phase(lds, 256, 1024, 256, S, E);
      conv_quota(p, idle_slots(S.nM * S.nN, G, c) * 1, sm);
    } break;
    case PH_FINAL: ph_norm(p, 3, 3, NL, NL, 3, sm); break;
  }
}

__global__ void __launch_bounds__(NTHR) mega_kernel(Params p) {
  extern __shared__ __attribute__((aligned(16))) unsigned char shm[];
  cg::grid_group grid = cg::this_grid();
  volatile LAS unsigned* st = (volatile LAS unsigned*)((LAS unsigned char*)shm + g8::STAGE_BYTES + 1536);
  if (threadIdx.x < 2) st[threadIdx.x] = 0u;
  __syncthreads();
  unsigned* barw;
  { const Params& q = get_params(); barw = q.barw; }
  const XcdBarrier xb = xcd_barrier_post(barw, st);
  const int nprog = p.nprog;
  for (int i = 0; i < nprog; ++i) {
    int ph, l;
    { const Params& q = get_params(); ph = q.prog_ph[i]; l = q.prog_l[i]; }
    run_phase(ph, l, shm);
    if (i + 1 < nprog) { if (nprog > 1000) grid.sync(); else xcd_barrier(xb); }
  }
}

extern "C" void kernel_launch(void* const* d_in, const int* in_sizes, int n_in, void* d_out, int out_size, void* d_ws, size_t ws_size,
                              hipStream_t stream) {
  Params p{};
  const float* const* in = (const float* const*)d_in;
  p.x = in[0]; p.c = in[1]; p.ctx = in[2]; p.c_ctx = in[3]; p.w_mod = in[4]; p.b_mod = in[5]; p.g_norm1 = in[6]; p.g_norm2 = in[7];
  p.w_in_even = in[8]; p.w_out_even = in[9]; p.g_qnorm = in[10]; p.g_knorm = in[11]; p.w_conv = in[12]; p.b_gate = in[13];
  p.g_hnorm = in[14]; p.w_in_odd = in[15]; p.w_pool_grp = in[16]; p.s_pool = in[17]; p.w_router = in[18]; p.w_exp_gate = in[19];
  p.w_exp_up = in[20]; p.w_exp_down = in[21]; p.g_final = in[22];
  p.out = (float*)d_out;
  char* w = (char*)d_ws;
  size_t off = 0;
  auto take = [&](size_t bytes) { char* r = w + off; off += (bytes + 255) & ~(size_t)255; return (void*)r; };
  p.xcur = (bf16_t*)take((size_t)NT * 1024 * 2);
  p.mod = (float*)take(4 * 9 * 6144 * 4);
  p.hbuf = (bf16_t*)take((size_t)NT * 1024 * 2);
  p.Ybuf = (bf16_t*)take((size_t)MOE_T * 1024 * 2);
  p.gatev = (float*)take(MOE_T * 4);
  p.rowidx = (int*)take(MOE_T * 4);
  p.slotmap = (int*)take((size_t)NT * 16 * 4);
  p.barw = (unsigned*)take(XCD_BAR_WORDS * 4);
  p.aff = (float*)take((size_t)NT * 16 * 4);
  p.gates = (float*)take((size_t)NT * 16 * 4);
  p.WinE = (bf16_t*)take((size_t)2 * PROJW * 1024 * 2);
  p.WoutE = (bf16_t*)take((size_t)2 * 1024 * 1024 * 2);
  p.WinO = (bf16_t*)take((size_t)2 * 1024 * 1024 * 2);
  p.Wgrp = (bf16_t*)take((size_t)2 * 1024 * 256 * 2);
  p.Wgu = (bf16_t*)take((size_t)4 * NEXP * 2048 * 1024 * 2);
  p.Wd = (bf16_t*)take((size_t)4 * NEXP * 1024 * 1024 * 2);
  const size_t uoff = off;
  p.proj = (bf16_t*)take((size_t)NT * PROJW * 2);
  p.Qb = (bf16_t*)take((size_t)NT * 512 * 2);
  p.Kb = (bf16_t*)take((size_t)NB * 2 * 2304 * 64 * 2);
  p.Vb = (bf16_t*)take((size_t)NB * 2 * 2304 * 64 * 2);
  p.qm = (bf16_t*)take((size_t)NT * 512 * 2);
  p.km = (bf16_t*)take((size_t)NT * 512 * 2);
  p.gsG = (float*)take((size_t)NT * 8 * 4);
  p.gsR = (float*)take((size_t)NT * 8 * 4);
  p.gsB = (float*)take((size_t)NT * 8 * 4);
  p.cMIN = (float*)take(64 * 18 * 4);
  p.cE1 = (float*)take(64 * 18 * 4);
  p.cDEC = (float*)take(64 * 18 * 4);
  p.cBE = (float*)take(64 * 18 * 4);
  p.cGM = (float*)take(64 * 18 * 4);
  p.Ubuf = (float*)take((size_t)64 * 17 * 16384 * 4);
  p.NLb = (float*)take((size_t)64 * 17 * 128 * 4);
  p.NVb = (float*)take((size_t)64 * 18 * 128 * 4);
  p.Cbf = (bf16_t*)take((size_t)64 * 18 * 16384 * 2);
  p.mix = (bf16_t*)take((size_t)NT * 1024 * 2);
  p.ybuf = (bf16_t*)take((size_t)NT * 1024 * 2);
  const size_t uend = off;
  off = uoff;
  p.Xs = (bf16_t*)take((size_t)MOE_T * 1024 * 2);
  p.Abuf = (bf16_t*)take((size_t)MOE_T * 1024 * 2);
  if (off < uend) off = uend;
  if (off > ws_size) { fprintf(stderr, "ws too small: need %zu have %zu\n", off, ws_size); return; }

  int n = 0;
  auto add = [&](int ph, int l) { p.prog_ph[n] = (unsigned char)ph; p.prog_l[n] = (unsigned char)l; ++n; };
  add(PH_INIT, 0);
  for (int l = 0; l < 4; ++l) {
    add(PH_NORM1, l);
    if ((l & 1) == 0) {
      add(PH_GEMM_IN_EVEN, l); add(PH_POST_EVEN, l); add(PH_ATT, l); add(PH_MLSTM_H, l); add(PH_GEMM_OUT, l);
    } else {
      add(PH_GEMM_IN_ODD, l); add(PH_POOL, l); add(PH_GEMM_GRP, l);
    }
    add(PH_NORM2, l); add(PH_TOPK, l); add(PH_MOE_GU, l); add(PH_MOE_D, l);
  }
  add(PH_FINAL, 0);
  p.nprog = n;

  const int LDS = 143360;
  static int grid_blocks = 0;
  if (!grid_blocks) {
    (void)hipFuncSetAttribute((const void*)mega_kernel, hipFuncAttributeMaxDynamicSharedMemorySize, LDS);
    int dev = 0, cus = 0, per_cu = 0;
    (void)hipGetDevice(&dev);
    (void)hipDeviceGetAttribute(&cus, hipDeviceAttributeMultiprocessorCount, dev);
    (void)hipOccupancyMaxActiveBlocksPerMultiprocessor(&per_cu, mega_kernel, NTHR, LDS);
    if (per_cu < 1) per_cu = 1;
    if (per_cu > 1) per_cu = 1;
    grid_blocks = cus * per_cu;
  }
  (void)hipMemsetAsync(p.barw, 0, XCD_BAR_WORDS * 4, stream);
  void* args[] = {&p};
  hipError_t e = hipLaunchCooperativeKernel((void*)mega_kernel, dim3(grid_blocks), dim3(NTHR), args, LDS, stream);
  if (e != hipSuccess) fprintf(stderr, "cooperative launch failed: %s (grid %d)\n", hipGetErrorString(e), grid_blocks);
}
```

```cpp
#include <hip/hip_runtime.h>
#include <hip/hip_cooperative_groups.h>
#include <math.h>
#include <stdio.h>
namespace cg = cooperative_groups;

#define DM 1024
#define NB 8
#define SEQ 2048
#define CTXL 256
#define NL (NB * SEQ)
#define NC (NB * CTXL)
#define NT (NL + NC)
#define EVEN_IN 2832
#define PROJW 2816
#define NEXP 16
#define MOE_L (NEXP * NB * 256)
#define MOE_C (NEXP * NB * 32)
#define MOE_T (MOE_L + MOE_C)
#define EPS 1e-6f
#define NTHR 512
#define LAS __attribute__((address_space(3)))

typedef unsigned short bf16_t;
typedef short bf16x8 __attribute__((ext_vector_type(8)));
typedef float f32x4 __attribute__((ext_vector_type(4)));
typedef unsigned u32x4 __attribute__((ext_vector_type(4)));
typedef unsigned u32x2 __attribute__((ext_vector_type(2)));

struct Params {
  const float *x, *c, *ctx, *c_ctx, *w_mod, *b_mod, *g_norm1, *g_norm2, *w_in_even, *w_out_even, *g_qnorm, *g_knorm,
      *w_conv, *b_gate, *g_hnorm, *w_in_odd, *w_pool_grp, *s_pool, *w_router, *w_exp_gate, *w_exp_up, *w_exp_down, *g_final;
  float* out;
  bf16_t* xcur;
  float *mod, *gates, *aff, *gatev, *gsG, *gsR, *gsB, *cMIN, *cE1, *cDEC, *cBE, *cGM, *Ubuf, *NLb, *NVb;
  bf16_t *hbuf, *proj, *mix, *Xs, *Abuf, *Ybuf, *Qb, *Kb, *Vb, *qm, *km, *Cbf, *ybuf;
  bf16_t *WinE, *WoutE, *WinO, *Wgrp, *Wgu, *Wd;
  int *rowidx, *slotmap;
  unsigned* barw;
  int nprog;
  unsigned char prog_ph[60], prog_l[60];
};

__device__ __forceinline__ float siluf(float v) { return v / (1.f + expf(-v)); }
__device__ __forceinline__ float sigmoidf_(float v) { return 1.f / (1.f + expf(-v)); }
__device__ __forceinline__ float logsigmoidf_(float v) { return fminf(v, 0.f) - __logf(1.f + __expf(-fabsf(v))); }
__device__ __forceinline__ float wave_sum(float v) {
#pragma unroll
  for (int o = 32; o > 0; o >>= 1) v += __shfl_xor(v, o);
  return v;
}
#define LDS_BARRIER() do { asm volatile("s_waitcnt lgkmcnt(0)" ::: "memory"); __builtin_amdgcn_s_barrier(); asm volatile("" ::: "memory"); } while (0)
__device__ __forceinline__ int modrow(int r) { return r < NL ? (r >> 11) : 8; }
__device__ __forceinline__ float bf2f(bf16_t v) { return __uint_as_float(((unsigned)v) << 16); }
typedef float f32x2_t __attribute__((ext_vector_type(2)));
typedef __bf16 bf16x2_t __attribute__((ext_vector_type(2)));
__device__ __forceinline__ unsigned cvt_pk_bf16(float lo, float hi) {
  const f32x2_t v = {lo, hi};
  return __builtin_bit_cast(unsigned, __builtin_convertvector(v, bf16x2_t));
}
__device__ __forceinline__ bf16_t f2bf(float f) { return (bf16_t)(cvt_pk_bf16(f, 0.f) & 0xffffu); }
__device__ __forceinline__ void unpack8(const u32x4 w, float (&f)[8]) {
  f[0] = __uint_as_float(w.x << 16); f[1] = __uint_as_float(w.x & 0xffff0000u); f[2] = __uint_as_float(w.y << 16); f[3] = __uint_as_float(w.y & 0xffff0000u);
  f[4] = __uint_as_float(w.z << 16); f[5] = __uint_as_float(w.z & 0xffff0000u); f[6] = __uint_as_float(w.w << 16); f[7] = __uint_as_float(w.w & 0xffff0000u);
}
__device__ __forceinline__ u32x4 pack8(const float (&f)[8]) {
  u32x4 w; w.x = cvt_pk_bf16(f[0], f[1]); w.y = cvt_pk_bf16(f[2], f[3]); w.z = cvt_pk_bf16(f[4], f[5]); w.w = cvt_pk_bf16(f[6], f[7]);
  return w;
}

__device__ __forceinline__ int ltid() { int t = threadIdx.x; asm volatile("" : "+v"(t)); return t; }
__device__ __forceinline__ int lbid() { int b = blockIdx.x; asm volatile("" : "+s"(b)); return b; }
__device__ __forceinline__ int lgdim() { int g = gridDim.x; asm volatile("" : "+s"(g)); return g; }

#define XB_TMO      128
#define XB_XCNT(j)  (256  + 64 * (j))
#define XB_XSUB(j)  (1280 + 64 * (j))
#define XB_XGEN(j)  (2304 + 64 * (j))
#define XB_TOP      3328
#define XB_TOPGEN   3392
#define XCD_BAR_WORDS 3456
#define XB_SPIN_CAP (1u << 18)
__device__ __forceinline__ unsigned xb_ld(unsigned* p)              { return __hip_atomic_load(p, __ATOMIC_RELAXED, __HIP_MEMORY_SCOPE_AGENT); }
__device__ __forceinline__ unsigned xb_add(unsigned* p, unsigned v) { return __hip_atomic_fetch_add(p, v, __ATOMIC_RELAXED, __HIP_MEMORY_SCOPE_AGENT); }
__device__ __forceinline__ unsigned xb_xcc_id() { return (unsigned)__builtin_amdgcn_s_getreg((3 << 11) | 20) & 0xFu; }
#define XB_SPIN(cond, bar) do { unsigned _sp = 0; while (cond) { __builtin_amdgcn_s_sleep(1); \
    if ((++_sp & 255u) == 0u) { if (xb_ld(&(bar)[XB_TMO])) break; if (_sp > XB_SPIN_CAP) { atomicAdd(&(bar)[XB_TMO], 1u); break; } } } } while (0)
struct XcdBarrier { unsigned* bar; unsigned x; volatile LAS unsigned* st; };
__device__ __forceinline__ XcdBarrier xcd_barrier_post(unsigned* bar, volatile LAS unsigned* st) {
  XcdBarrier b; b.bar = bar; b.x = xb_xcc_id(); b.st = st;
  if (threadIdx.x == 0) (void)xb_add(&bar[XB_XCNT(b.x)], 1u);
  return b;
}
__device__ __forceinline__ void xcd_barrier_complete(unsigned* bar, unsigned x, unsigned& nloc, unsigned& nx) {
  const unsigned G = gridDim.x * gridDim.y * gridDim.z;
  unsigned sum, cnt, mine, sp = 0u;
  for (;;) {
    sum = 0u; cnt = 0u; mine = 0u;
#pragma unroll
    for (unsigned j = 0; j < 16; ++j) { const unsigned c = xb_ld(&bar[XB_XCNT(j)]); sum += c; cnt += (c > 0u) ? 1u : 0u; mine = (j == x) ? c : mine; }
    if (sum == G) break;
    __builtin_amdgcn_s_sleep(1);
    if ((++sp & 255u) == 0u) { if (xb_ld(&bar[XB_TMO])) break; if (sp > XB_SPIN_CAP) { atomicAdd(&bar[XB_TMO], 1u); break; } }
  }
  nloc = mine > 0u ? mine : 1u; nx = cnt > 0u ? cnt : 1u;
}
__device__ __forceinline__ void xcd_barrier(const XcdBarrier& b) {
  asm volatile("s_waitcnt vmcnt(0)" ::: "memory");
  __syncthreads();
  if (threadIdx.x == 0) {
    unsigned* bar = b.bar;
    __builtin_amdgcn_s_waitcnt(0);
    unsigned nloc = b.st[0], nx = b.st[1];
    if (nloc == 0u) { xcd_barrier_complete(bar, b.x, nloc, nx); b.st[0] = nloc; b.st[1] = nx; }
    const unsigned old = xb_add(&bar[XB_XSUB(b.x)], 1u);
    const unsigned gen = old / nloc;
    if (old + 1u == (gen + 1u) * nloc) {
      __builtin_amdgcn_fence(__ATOMIC_RELEASE, "agent");
      asm volatile("s_waitcnt vmcnt(0)" ::: "memory");
      const unsigned og = xb_add(&bar[XB_TOP], 1u);
      const unsigned tg = og / nx;
      if (og + 1u == (tg + 1u) * nx) xb_add(&bar[XB_TOPGEN], 1u);
      else XB_SPIN(xb_ld(&bar[XB_TOPGEN]) == tg, bar);
      __builtin_amdgcn_fence(__ATOMIC_ACQUIRE, "agent");
      xb_add(&bar[XB_XGEN(b.x)], 1u);
      asm volatile("s_waitcnt vmcnt(0)" ::: "memory");
    } else {
      XB_SPIN(xb_ld(&bar[XB_XGEN(b.x)]) == gen, bar);
      __builtin_amdgcn_fence(__ATOMIC_ACQUIRE, "agent");
      asm volatile("s_waitcnt vmcnt(0)" ::: "memory");
    }
  }
  __syncthreads();
}

namespace g8 {
constexpr int BM = 256, BK = 64, HALF = 128, HTB = HALF * BK * 2, STAGE_BYTES = 8 * HTB;
__device__ __forceinline__ int lds_byte(int r, int c) { const int st = (r >> 4) * 2 + (c >> 5), rr = r & 15, cc = c & 31, ob = rr * 64 + cc * 2; return st * 1024 + (ob ^ (((ob >> 9) & 1) << 5)); }
__device__ __forceinline__ void stage_rc(int b, int& R, int& C) { const int st = b / 1024, sb = b % 1024, swz = sb ^ (((sb >> 9) & 1) << 5); R = (st >> 1) * 16 + swz / 64; C = (st & 1) * 32 + (swz % 64) / 2; }
__device__ __forceinline__ int perm32(int rho) { const int n = rho >> 4, i = rho & 15; return 8 * (i >> 2) + 4 * n + (i & 3); }

struct Unit { const char* A; const char* B; int row0, col0; };

template <bool GATHER = false, class Epi, class Sched>
__device__ __forceinline__ void gemm_phase(LAS unsigned char* lds, const int K, const int lda, const int ldb, const Sched& S, const Epi& E, const int* gidx = nullptr, const char* gbaseA = nullptr) {
  const int tid = ltid(), wid = __builtin_amdgcn_readfirstlane(tid >> 6), lane = tid & 63, wr = wid >> 2, wc = wid & 3, fr = lane & 15, fq = lane >> 4;
  const int nt = K / BK;
  unsigned voffA[2], voffB[2], gC2[2];
  int gR[2];
#pragma unroll
  for (int i = 0; i < 2; ++i) {
    int R, C;
    stage_rc(tid * 16 + i * 8192, R, C);
    const int Rb = (R & ~31) + perm32(R & 31);
    voffA[i] = (unsigned)(R * lda + C) * 2u;
    voffB[i] = (unsigned)(Rb * ldb + C) * 2u;
    gR[i] = R; gC2[i] = (unsigned)C * 2u;
  }
  unsigned gcur[2][2], gnxt[2][2];
  auto gload = [&](int row0, unsigned (&g)[2][2]) {
#pragma unroll
    for (int h = 0; h < 2; ++h)
#pragma unroll
      for (int i = 0; i < 2; ++i) g[h][i] = (unsigned)gidx[row0 + h * HALF + gR[i]];
  };
  const size_t kstep = (size_t)(BK * 2);
  const size_t hstepA = (size_t)HALF * lda * 2, hstepB = (size_t)HALF * ldb * 2;
  const unsigned ldsw = (unsigned)wid * 1024u;
  const int aoff = lds_byte(wr * 64 + fr, fq * 8), boff = lds_byte(wc * 32 + fr, fq * 8);
#define PG8_SA(b, h) (((b) * 2 + (h)) * HTB)
#define PG8_SB(b, h) ((4 + (b) * 2 + (h)) * HTB)
#define PG8_STAGE(bufoff, gbase, voff) do { _Pragma("unroll") for (int _i = 0; _i < 2; ++_i) \
    __builtin_amdgcn_global_load_lds((const unsigned*)((const char*)(gbase) + (voff)[_i]), (LAS unsigned*)(lds + (bufoff) + ldsw + _i * 8192), 16, 0, 0); } while (0)
#define PG8_LDA(dst, b, h) do { _Pragma("unroll") for (int m = 0; m < 4; ++m) _Pragma("unroll") for (int k = 0; k < 2; ++k) dst[m][k] = *(const LAS bf16x8*)(lds + PG8_SA(b, h) + aoff + m * 2048 + k * 1024); } while (0)
#define PG8_LDB(dst, b, h) do { _Pragma("unroll") for (int n = 0; n < 2; ++n) _Pragma("unroll") for (int k = 0; k < 2; ++k) dst[n][k] = *(const LAS bf16x8*)(lds + PG8_SB(b, h) + boff + n * 2048 + k * 1024); } while (0)
#define PG8_MMA(ai, bj, At, Bt) do { __builtin_amdgcn_s_setprio(1); _Pragma("unroll") for (int m = 0; m < 4; ++m) _Pragma("unroll") for (int n = 0; n < 2; ++n) _Pragma("unroll") for (int k = 0; k < 2; ++k) \
    acc[ai][bj][m][n] = __builtin_amdgcn_mfma_f32_16x16x32_bf16(Bt[n][k], At[m][k], acc[ai][bj][m][n], 0, 0, 0); __builtin_amdgcn_s_setprio(0); } while (0)
#define PG8_WAIT_V(n) asm volatile("s_waitcnt vmcnt(" #n ")" ::: "memory")
#define PG8_WAIT_L(n) asm volatile("s_waitcnt lgkmcnt(" #n ")" ::: "memory")
#define PG8_BAR __builtin_amdgcn_s_barrier()
#define PG8_SCHED __builtin_amdgcn_sched_barrier(0)
#define PG8_STAGE_A(bufoff, nextu, half, kbytes) do { \
    if constexpr (GATHER) { unsigned go_[2]; _Pragma("unroll") for (int _j = 0; _j < 2; ++_j) go_[_j] = ((nextu) ? gnxt[half][_j] : gcur[half][_j]) * (unsigned)(lda * 2) + gC2[_j]; \
      PG8_STAGE(bufoff, gbaseA + (kbytes), go_); } \
    else { PG8_STAGE(bufoff, ((nextu) ? nA : cA) + (half) * hstepA + (kbytes), voffA); } } while (0)
  Unit cur, nxt;
  int ui = 0;
  if (!S.next(0, cur)) return;
  f32x4 acc[2][2][4][2];
#pragma unroll
  for (int a = 0; a < 2; ++a)
#pragma unroll
    for (int b = 0; b < 2; ++b)
#pragma unroll
      for (int m = 0; m < 4; ++m)
#pragma unroll
        for (int n = 0; n < 2; ++n) acc[a][b][m][n] = (f32x4){0.f, 0.f, 0.f, 0.f};
  bf16x8 At[4][2], B0[2][2], B1[2][2];
  const char* cA = cur.A;
  const char* cB = cur.B;
  const char* nA = cA;
  if constexpr (GATHER) { gload(cur.row0, gcur); gload(cur.row0, gnxt); asm volatile("s_waitcnt vmcnt(0)" ::: "memory"); }
  PG8_STAGE(PG8_SB(0, 0), cB, voffB); PG8_STAGE(PG8_SB(0, 1), cB + hstepB, voffB); PG8_STAGE_A(PG8_SA(0, 0), false, 0, 0); PG8_STAGE_A(PG8_SA(0, 1), false, 1, 0);
  if (wr == 1) PG8_BAR;
  PG8_WAIT_V(2); PG8_BAR;
  PG8_STAGE(PG8_SB(1, 0), cB + kstep, voffB); PG8_STAGE_A(PG8_SA(1, 0), false, 0, kstep); PG8_STAGE(PG8_SB(1, 1), cB + hstepB + kstep, voffB);
  PG8_WAIT_V(6); PG8_BAR;
  for (;;) {
    const bool has_next = S.next(ui + 1, nxt);
    nA = has_next ? nxt.A : cA;
    const char* nB = has_next ? nxt.B : cB;
    if constexpr (GATHER) { if (has_next) gload(nxt.row0, gnxt); else {
#pragma unroll
      for (int h = 0; h < 2; ++h)
#pragma unroll
        for (int i = 0; i < 2; ++i) gnxt[h][i] = gcur[h][i]; } }
    for (int t = 0; t < nt; t += 2) {
      const bool last = (t == nt - 2);
      const size_t k1 = (size_t)(t + 1) * kstep;
      const size_t k2 = last ? 0 : (size_t)(t + 2) * kstep;
      const size_t k3 = k2 + kstep;
      const char* b2 = last ? nB : cB + (size_t)(t + 2) * kstep;
      const char* b3 = b2 + kstep;
      PG8_LDB(B0, 0, 0); PG8_LDB(B1, 0, 1); PG8_SCHED; PG8_LDA(At, 0, 0); PG8_STAGE_A(PG8_SA(1, 1), false, 1, k1);
      PG8_WAIT_V(8); PG8_WAIT_L(0); PG8_BAR; PG8_MMA(0, 0, At, B0); PG8_MMA(0, 1, At, B1); PG8_BAR; PG8_SCHED;
      PG8_LDA(At, 0, 1); PG8_STAGE(PG8_SB(0, 0), b2, voffB); PG8_STAGE(PG8_SB(0, 1), b2 + hstepB, voffB); PG8_STAGE_A(PG8_SA(0, 0), last, 0, k2);
      PG8_WAIT_V(8); PG8_WAIT_L(0); PG8_BAR; PG8_MMA(1, 0, At, B0); PG8_MMA(1, 1, At, B1); PG8_BAR; PG8_SCHED;
      PG8_LDB(B0, 1, 0); PG8_LDB(B1, 1, 1); PG8_SCHED; PG8_LDA(At, 1, 0); PG8_STAGE_A(PG8_SA(0, 1), last, 1, k2);
      PG8_WAIT_V(8); PG8_WAIT_L(0); PG8_BAR; PG8_MMA(0, 0, At, B0); PG8_MMA(0, 1, At, B1); PG8_BAR; PG8_SCHED;
      PG8_LDA(At, 1, 1); PG8_STAGE(PG8_SB(1, 0), b3, voffB); PG8_STAGE(PG8_SB(1, 1), b3 + hstepB, voffB); PG8_STAGE_A(PG8_SA(1, 0), last, 0, k3);
      PG8_WAIT_V(8); PG8_WAIT_L(0); PG8_BAR; PG8_MMA(1, 0, At, B0); PG8_MMA(1, 1, At, B1); PG8_BAR; PG8_SCHED;
    }
    if (wr == 0) PG8_BAR;
    E(acc, cur, wr, wc, fr, fq);
    if (!has_next) break;
#pragma unroll
    for (int a = 0; a < 2; ++a)
#pragma unroll
      for (int b = 0; b < 2; ++b)
#pragma unroll
        for (int m = 0; m < 4; ++m)
#pragma unroll
          for (int n = 0; n < 2; ++n) acc[a][b][m][n] = (f32x4){0.f, 0.f, 0.f, 0.f};
    cur = nxt; cA = nA; cB = nB; ++ui;
    if constexpr (GATHER) {
#pragma unroll
      for (int h = 0; h < 2; ++h)
#pragma unroll
        for (int i = 0; i < 2; ++i) gcur[h][i] = gnxt[h][i];
    }
    if (wr == 1) PG8_BAR;
  }
  PG8_WAIT_V(0);
  PG8_BAR;
#undef PG8_SA
#undef PG8_SB
#undef PG8_STAGE
#undef PG8_STAGE_A
#undef PG8_LDA
#undef PG8_LDB
#undef PG8_MMA
#undef PG8_WAIT_V
#undef PG8_WAIT_L
#undef PG8_BAR
#undef PG8_SCHED
}

struct SchedDense {
  const char* A; const char* B; int lda, ldb, nM, nN, acolstep, G, c;
  __device__ __forceinline__ bool next(int i, Unit& u) const {
    const int nwg = nM * nN;
    const long L = (long)i * G + c;
    if (L >= nwg) return false;
    int wgid = (int)L;
    { const int q = nwg / 8, r = nwg % 8, xcd = wgid % 8, off = wgid / 8; wgid = (xcd < r ? xcd * (q + 1) : r * (q + 1) + (xcd - r) * q) + off; }
    const int nig = 8 * nN, gid = wgid / nig, fm = gid * 8, gsz = (nM - fm) < 8 ? (nM - fm) : 8;
    const int pm = fm + ((wgid % nig) % gsz), pn = (wgid % nig) / gsz;
    u.A = A + (size_t)pm * 256 * lda * 2 + (size_t)pn * acolstep;
    u.B = B + (size_t)pn * 256 * ldb * 2;
    u.row0 = pm * 256; u.col0 = pn * 256;
    return true;
  }
};
struct SchedMoe {
  const char* A; const char* W; int ncol, wrows, colw, nu, G, c;
  __device__ __forceinline__ bool next(int i, Unit& u) const {
    const long L = (long)i * G + c;
    if (L >= nu) return false;
    const int wgid = (int)(L % 8) * (nu / 8) + (int)(L / 8);
    const int UL = 128 * ncol;
    int e, pn, row0;
    if (wgid < UL) { e = wgid / (8 * ncol); const int rem = wgid % (8 * ncol); row0 = e * 2048 + (rem % 8) * 256; pn = rem / 8; }
    else { const int w2 = wgid - UL; e = w2 / ncol; pn = w2 % ncol; row0 = MOE_L + e * 256; }
    u.A = A + (size_t)row0 * 1024 * 2;
    u.B = W + ((size_t)e * wrows + (size_t)pn * 256) * 1024 * 2;
    u.row0 = row0; u.col0 = pn * colw;
    return true;
  }
};

struct EpiBf16 {
  bf16_t* O; int ldo;
  __device__ __forceinline__ void operator()(const f32x4 (&acc)[2][2][4][2], const Unit& u, int wr, int wc, int fr, int fq) const {
#pragma unroll
    for (int ai = 0; ai < 2; ++ai)
#pragma unroll
      for (int m = 0; m < 4; ++m) {
        const int row = u.row0 + ai * 128 + wr * 64 + m * 16 + fr;
        bf16_t* rp = O + (size_t)row * ldo + u.col0 + wc * 32 + 8 * fq;
#pragma unroll
        for (int bj = 0; bj < 2; ++bj) {
          const f32x4 v0 = acc[ai][bj][m][0], v1 = acc[ai][bj][m][1];
          u32x4 w; w.x = cvt_pk_bf16(v0[0], v0[1]); w.y = cvt_pk_bf16(v0[2], v0[3]); w.z = cvt_pk_bf16(v1[0], v1[1]); w.w = cvt_pk_bf16(v1[2], v1[3]);
          *(u32x4*)(rp + bj * 128) = w;
        }
      }
  }
};
struct EpiResid {
  float* x; const float* modg; const float* cs; const float* xl; const float* xc;
  __device__ __forceinline__ void operator()(const f32x4 (&acc)[2][2][4][2], const Unit& u, int wr, int wc, int fr, int fq) const {
#pragma unroll
    for (int ai = 0; ai < 2; ++ai)
#pragma unroll
      for (int m = 0; m < 4; ++m) {
        const int row = u.row0 + ai * 128 + wr * 64 + m * 16 + fr;
        const int c0 = u.col0 + wc * 32 + 8 * fq;
        float* xp = x + (size_t)row * 1024 + c0;
        const float* xi = xl ? (row < NL ? xl + (size_t)row * 1024 + c0 : xc + (size_t)(row - NL) * 1024 + c0) : xp;
        const float* gp = modg + (size_t)modrow(row) * 6144 + c0;
#pragma unroll
        for (int bj = 0; bj < 2; ++bj) {
          f32x4 g0 = *(const f32x4*)(gp + bj * 128), g1 = *(const f32x4*)(gp + bj * 128 + 4);
          if (cs) { g0 *= *(const f32x4*)(cs + c0 + bj * 128); g1 *= *(const f32x4*)(cs + c0 + bj * 128 + 4); }
          f32x4 x0 = *(const f32x4*)(xi + bj * 128), x1 = *(const f32x4*)(xi + bj * 128 + 4);
          x0 += g0 * acc[ai][bj][m][0]; x1 += g1 * acc[ai][bj][m][1];
          *(f32x4*)(xp + bj * 128) = x0; *(f32x4*)(xp + bj * 128 + 4) = x1;
        }
      }
  }
};
struct EpiSwiGLU {
  bf16_t* O;
  __device__ __forceinline__ void operator()(const f32x4 (&acc)[2][2][4][2], const Unit& u, int wr, int wc, int fr, int fq) const {
#pragma unroll
    for (int ai = 0; ai < 2; ++ai)
#pragma unroll
      for (int m = 0; m < 4; ++m) {
        const int row = u.row0 + ai * 128 + wr * 64 + m * 16 + fr;
        bf16_t* rp = O + (size_t)row * 1024 + u.col0 + wc * 32 + 8 * fq;
        float o[8];
#pragma unroll
        for (int n = 0; n < 2; ++n)
#pragma unroll
          for (int j = 0; j < 4; ++j) { const float g = acc[ai][0][m][n][j], up = acc[ai][1][m][n][j]; o[n * 4 + j] = g / (1.f + __expf(-g)) * up; }
        u32x4 w; w.x = cvt_pk_bf16(o[0], o[1]); w.y = cvt_pk_bf16(o[2], o[3]); w.z = cvt_pk_bf16(o[4], o[5]); w.w = cvt_pk_bf16(o[6], o[7]);
        *(u32x4*)rp = w;
      }
  }
};
struct EpiDown {
  bf16_t* O; const float* gatev;
  __device__ __forceinline__ void operator()(const f32x4 (&acc)[2][2][4][2], const Unit& u, int wr, int wc, int fr, int fq) const {
    float gv[2][4];
#pragma unroll
    for (int ai = 0; ai < 2; ++ai)
#pragma unroll
      for (int m = 0; m < 4; ++m) gv[ai][m] = gatev[u.row0 + ai * 128 + wr * 64 + m * 16 + fr];
    __builtin_amdgcn_sched_barrier(0);
#pragma unroll
    for (int ai = 0; ai < 2; ++ai)
#pragma unroll
      for (int m = 0; m < 4; ++m) {
        const int row = u.row0 + ai * 128 + wr * 64 + m * 16 + fr;
        bf16_t* rp = O + (size_t)row * 1024 + u.col0 + wc * 32 + 8 * fq;
#pragma unroll
        for (int bj = 0; bj < 2; ++bj) {
          const f32x4 v0 = acc[ai][bj][m][0] * gv[ai][m], v1 = acc[ai][bj][m][1] * gv[ai][m];
          u32x4 w; w.x = cvt_pk_bf16(v0[0], v0[1]); w.y = cvt_pk_bf16(v0[2], v0[3]); w.z = cvt_pk_bf16(v1[0], v1[1]); w.w = cvt_pk_bf16(v1[2], v1[3]);
          *(u32x4*)(rp + bj * 128) = w;
        }
      }
  }
};
}

#define NT_WINE 1408
#define NT_WOUT 512
#define NT_WINO 512
#define NT_WGRP 128
#define NT_EXP 16384
#define NT_ALL (NT_WINE + NT_WOUT + NT_WINO + NT_WGRP + 3 * NT_EXP)
#define CE0 704
#define CE1 960
#define CE2 13248
#define CE3 13504
#define CE4 13568
#define CE5 25856
#define CE6 26560
#define CE7 26816
#define CE8 39104
#define CE9 39360
#define CE10 39424
#define CE11 51712
__device__ __forceinline__ void conv_batch(const Params& p, int t, float* T) {
  const int tid = ltid(), lane = tid & 63, wv = tid >> 6;
  const float* src; bf16_t* dst; int ld, dK, k0, n0;
  int seg, tb, e, which = 0;
  if (t < CE0) { seg = 0; e = 0; tb = t; } else if (t < CE1) { seg = 1; e = 0; tb = t - CE0; } else if (t < CE2) { seg = 2; e = 0; tb = t - CE1; }
  else if (t < CE3) { seg = 3; e = 0; tb = t - CE2; } else if (t < CE4) { seg = 4; e = 0; tb = t - CE3; } else if (t < CE5) { seg = 2; e = 1; tb = t - CE4; }
  else if (t < CE6) { seg = 0; e = 1; tb = t - CE5; } else if (t < CE7) { seg = 1; e = 1; tb = t - CE6; } else if (t < CE8) { seg = 2; e = 2; tb = t - CE7; }
  else if (t < CE9) { seg = 3; e = 1; tb = t - CE8; } else if (t < CE10) { seg = 4; e = 1; tb = t - CE9; } else { seg = 2; e = 3; tb = t - CE10; }
  int dbase = 0;
  if (seg == 0) {
    k0 = (tb / 44) * 64; n0 = (tb % 44) * 64;
    src = p.w_in_even + (size_t)e * 1024 * EVEN_IN; ld = EVEN_IN; dst = p.WinE + (size_t)e * PROJW * 1024; dK = 1024;
  } else if (seg == 1 || seg == 3) {
    k0 = (tb / 16) * 64; n0 = (tb % 16) * 64;
    src = (seg == 3 ? p.w_in_odd : p.w_out_even) + (size_t)e * 1024 * 1024; ld = 1024; dst = (seg == 3 ? p.WinO : p.WoutE) + (size_t)e * 1024 * 1024; dK = 1024;
  } else if (seg == 4) {
    const int g = tb / 16; k0 = ((tb % 16) / 4) * 64; n0 = (tb % 4) * 64;
    src = p.w_pool_grp + (size_t)(e * 4 + g) * 65536; ld = 256; dst = p.Wgrp + (size_t)e * 1024 * 256; dK = 256; dbase = g * 256;
  } else {
    which = tb / 4096; const int r = tb % 4096, le = e * 16 + r / 256; k0 = ((r % 256) / 16) * 64; n0 = (r % 16) * 64;
    const float* base = which == 0 ? p.w_exp_gate : (which == 1 ? p.w_exp_up : p.w_exp_down);
    src = base + (size_t)le * 1024 * 1024; ld = 1024; dK = 1024;
    dst = which < 2 ? p.Wgu + (size_t)le * 2048 * 1024 : p.Wd + (size_t)le * 1024 * 1024;
  }
  const bool gu = (seg == 2 && which < 2);
  float4 v[8];
#pragma unroll
  for (int q = 0; q < 8; ++q) {
    const int idx = tid + q * NTHR, k = idx >> 6, c4 = idx & 63;
    v[q] = *(const float4*)(src + (size_t)(k0 + k) * ld + n0 + c4 * 4);
  }
  __builtin_amdgcn_sched_barrier(0);
#pragma unroll
  for (int q = 0; q < 8; ++q) {
    const int idx = tid + q * NTHR, k = idx >> 6, c4 = idx & 63;
    float* tp = T + k * 257 + c4 * 4;
    tp[0] = v[q].x; tp[1] = v[q].y; tp[2] = v[q].z; tp[3] = v[q].w;
  }
  __syncthreads();
#pragma unroll
  for (int sub = 0; sub < 4; ++sub) {
    const int nl = wv * 8 + (lane >> 3), kq = lane & 7, nn = n0 + sub * 64;
    const int drow0 = gu ? (nn >> 7) * 256 + which * 128 + (nn & 127) : dbase + nn;
    float f[8];
#pragma unroll
    for (int j = 0; j < 8; ++j) f[j] = T[(kq * 8 + j) * 257 + sub * 64 + nl];
    u32x4 w; w.x = cvt_pk_bf16(f[0], f[1]); w.y = cvt_pk_bf16(f[2], f[3]); w.z = cvt_pk_bf16(f[4], f[5]); w.w = cvt_pk_bf16(f[6], f[7]);
    *(u32x4*)(dst + (size_t)(drow0 + nl) * dK + k0 + kq * 8) = w;
  }
}
__device__ __forceinline__ int conv_pull(const Params& p, float* sm) {
  __syncthreads();
  if (ltid() == 0) ((int*)sm)[16500] = (int)__hip_atomic_fetch_add(p.barw, 4u, __ATOMIC_RELAXED, __HIP_MEMORY_SCOPE_AGENT);
  __syncthreads();
  return ((int*)sm)[16500];
}
__device__ __forceinline__ void conv_until(const Params& p, int end, float* sm) {
  int t;
  do { t = conv_pull(p, sm); if (t < CE11) conv_batch(p, t, sm); } while (t + 4 < end);
  __syncthreads();
}
__device__ __forceinline__ void conv_quota(const Params& p, int n, float* sm) {
  for (int i = 0; i < n; ++i) { const int t = conv_pull(p, sm); if (t >= CE11) break; conv_batch(p, t, sm); }
  __syncthreads();
}

__device__ __forceinline__ void ph_init(const Params& p, float* sm) {
  const int tid = ltid(), lane = tid & 63, wv = tid >> 6;
  const size_t gtid = (size_t)lbid() * NTHR + tid, gsz = (size_t)lgdim() * NTHR;
  for (int i = tid; i < 9 * 1024; i += NTHR) {
    const int r = i >> 10, k = i & 1023;
    sm[i] = siluf(r < 8 ? p.c[r * 1024 + k] : p.c_ctx[k]);
  }
  __syncthreads();
  float* part = sm + 9 * 1024;
  for (int item = lbid(); item < 768; item += lgdim()) {
    const int l = item / 192, j0 = (item % 192) * 32;
    const int col = lane & 31, kh = lane >> 5;
    const float* w = p.w_mod + (size_t)l * 1024 * 6144 + j0 + col;
    float acc[9];
#pragma unroll
    for (int r = 0; r < 9; ++r) acc[r] = 0.f;
    const int kb = wv * 128 + kh * 64;
    for (int k0 = 0; k0 < 64; k0 += 16) {
      float wv16[16];
#pragma unroll
      for (int kk = 0; kk < 16; ++kk) wv16[kk] = w[(size_t)(kb + k0 + kk) * 6144];
      __builtin_amdgcn_sched_barrier(0);
#pragma unroll
      for (int kk = 0; kk < 16; ++kk)
#pragma unroll
        for (int r = 0; r < 9; ++r) acc[r] += sm[r * 1024 + kb + k0 + kk] * wv16[kk];
    }
#pragma unroll
    for (int r = 0; r < 9; ++r) part[((wv * 2 + kh) * 9 + r) * 32 + col] = acc[r];
    __syncthreads();
    if (tid < 288) {
      const int r = tid >> 5, cc = tid & 31;
      float s = 0.f;
#pragma unroll
      for (int sl = 0; sl < 16; ++sl) s += part[(sl * 9 + r) * 32 + cc];
      p.mod[(size_t)(l * 9 + r) * 6144 + j0 + cc] = s + p.b_mod[l * 6144 + j0 + cc];
    }
    __syncthreads();
  }
  conv_until(p, CE1, sm);
}

typedef float f32x4m __attribute__((ext_vector_type(4)));
__device__ __forceinline__ void ph_norm(const Params& p, int l, int which, int nrows, int ncomb, int lprev, float* sm) {
  const int tid = ltid(), lane = tid & 63, wv = tid >> 6;
  const bool skinny = (which == 2) || (which == 1 && (l & 1) == 0);
  bf16_t* HROW = (bf16_t*)sm;
  float* PART = sm + 8192;
  bf16x8 Bhi[4], Blo[4];
  if (skinny) {
    const float* wbase; int stride;
    if (which == 2) { wbase = p.w_router + (size_t)l * 1024 * 16; stride = 16; }
    else { wbase = p.w_in_even + (size_t)(l >> 1) * 1024 * EVEN_IN + PROJW; stride = EVEN_IN; }
    const int kg = lane >> 4, n = lane & 15;
#pragma unroll
    for (int ks = 0; ks < 4; ++ks) {
      float f[8], hi[8], lo[8];
#pragma unroll
      for (int j = 0; j < 8; ++j) f[j] = wbase[(size_t)(wv * 128 + ks * 32 + kg * 8 + j) * stride + n];
      const u32x4 hw = pack8(f);
      unpack8(hw, hi);
#pragma unroll
      for (int j = 0; j < 8; ++j) lo[j] = f[j] - hi[j];
      Bhi[ks] = __builtin_bit_cast(bf16x8, hw);
      Blo[ks] = __builtin_bit_cast(bf16x8, pack8(lo));
    }
  }
  const int nwaves = lgdim() * (NTHR / 64), gw = lbid() * (NTHR / 64) + wv;
  const int per = (nrows + nwaves - 1) / nwaves;
  const int rbeg = gw * per, rend = min(nrows, rbeg + per);
  const bool in0 = (l == 0) && (which == 1 || which == 2);
  float4 vn[4];
  u32x2 xnb[4];
  int slvn = -1;
  {
    const int r0 = min(rbeg, nrows - 1);
    if (in0) {
      const float* xs0 = r0 < NL ? p.x + (size_t)r0 * DM : p.ctx + (size_t)(r0 - NL) * DM;
#pragma unroll
      for (int i = 0; i < 4; ++i) vn[i] = ((const float4*)xs0)[i * 64 + lane];
    } else {
#pragma unroll
      for (int i = 0; i < 4; ++i) xnb[i] = ((const u32x2*)(p.xcur + (size_t)r0 * DM))[i * 64 + lane];
    }
    if (r0 < ncomb && lane < 16) slvn = p.slotmap[r0 * 16 + lane];
  }
  float4 cA[4], cB[4], cG[4];
  u32x2 yn[4];
  int mr_c = -1;
  if (which == 2) {
    const u32x2* yp0 = (const u32x2*)(p.ybuf + (size_t)min(rbeg, nrows - 1) * DM);
#pragma unroll
    for (int i = 0; i < 4; ++i) yn[i] = yp0[i * 64 + lane];
  }
  for (int it = 0; it < per; ++it) {
    const int rr = rbeg + it;
    const bool live = rr < rend;
    const int r = min(rr, nrows - 1);
    float4 v[4];
    if (in0) {
#pragma unroll
      for (int i = 0; i < 4; ++i) v[i] = vn[i];
    } else {
#pragma unroll
      for (int i = 0; i < 4; ++i) v[i] = make_float4(__uint_as_float(xnb[i].x << 16), __uint_as_float(xnb[i].x & 0xffff0000u), __uint_as_float(xnb[i].y << 16), __uint_as_float(xnb[i].y & 0xffff0000u));
    }
    const int slv = slvn;
    bf16_t* xr = p.xcur + (size_t)r * DM;
    if (it + 1 < per) {
      const int rn = min(rr + 1, nrows - 1);
      if (in0) {
        const float* xsn = rn < NL ? p.x + (size_t)rn * DM : p.ctx + (size_t)(rn - NL) * DM;
#pragma unroll
        for (int i = 0; i < 4; ++i) vn[i] = ((const float4*)xsn)[i * 64 + lane];
      } else {
#pragma unroll
        for (int i = 0; i < 4; ++i) xnb[i] = ((const u32x2*)(p.xcur + (size_t)rn * DM))[i * 64 + lane];
      }
      slvn = (rn < ncomb && lane < 16) ? p.slotmap[rn * 16 + lane] : -1;
    }
    const int mr = modrow(r);
    if (mr != mr_c) {
      mr_c = mr;
      if (which == 3) {
#pragma unroll
        for (int i = 0; i < 4; ++i) cA[i] = ((const float4*)p.g_final)[i * 64 + lane];
      } else {
        const float* gn = (which == 1 ? p.g_norm1 : p.g_norm2) + l * 1024;
        const float* mrow = p.mod + (size_t)(l * 9 + mr) * 6144;
        const float4* shp = (const float4*)(mrow + (which == 1 ? 0 : 3) * 1024);
        const float4* scp = (const float4*)(mrow + (which == 1 ? 1 : 4) * 1024);
#pragma unroll
        for (int i = 0; i < 4; ++i) {
          const float4 g = ((const float4*)gn)[i * 64 + lane], sc = scp[i * 64 + lane];
          cA[i] = make_float4(g.x * (1.f + sc.x), g.y * (1.f + sc.y), g.z * (1.f + sc.z), g.w * (1.f + sc.w));
          cB[i] = shp[i * 64 + lane];
        }
      }
      if (which == 2) {
        const float4* g2 = (const float4*)(p.mod + (size_t)(l * 9 + mr) * 6144 + 2 * 1024);
        const float4* spv = (const float4*)(p.s_pool + (size_t)(l >> 1) * 1024);
#pragma unroll
        for (int i = 0; i < 4; ++i) {
          float4 g = g2[i * 64 + lane];
          if (l & 1) { const float4 sp4 = spv[i * 64 + lane]; g.x *= sp4.x; g.y *= sp4.y; g.z *= sp4.z; g.w *= sp4.w; }
          cG[i] = g;
        }
      } else if (ncomb > 0) {
        const float4* g5 = (const float4*)(p.mod + (size_t)(lprev * 9 + mr) * 6144 + 5 * 1024);
#pragma unroll
        for (int i = 0; i < 4; ++i) cG[i] = g5[i * 64 + lane];
      }
    }
    if (live && r < ncomb) {
      float4 s4[4];
#pragma unroll
      for (int i = 0; i < 4; ++i) s4[i] = make_float4(0.f, 0.f, 0.f, 0.f);
      unsigned long long mask = __ballot(slv >= 0);
      while (mask) {
        const int e = __ffsll((long long)mask) - 1;
        mask &= mask - 1;
        const int sl = __shfl(slv, e);
        size_t yrow;
        if (r < NL) yrow = (size_t)e * 2048 + (size_t)(r >> 11) * 256 + sl;
        else yrow = (size_t)MOE_L + (size_t)e * 256 + (size_t)((r - NL) >> 8) * 32 + sl;
        const u32x2* yp = (const u32x2*)(p.Ybuf + yrow * DM);
        u32x2 yv[4];
#pragma unroll
        for (int i = 0; i < 4; ++i) yv[i] = yp[i * 64 + lane];
#pragma unroll
        for (int i = 0; i < 4; ++i) {
          const u32x2 y = yv[i];
          s4[i].x += __uint_as_float(y.x << 16); s4[i].y += __uint_as_float(y.x & 0xffff0000u);
          s4[i].z += __uint_as_float(y.y << 16); s4[i].w += __uint_as_float(y.y & 0xffff0000u);
        }
      }
#pragma unroll
      for (int i = 0; i < 4; ++i) {
        const float4 g = cG[i];
        v[i].x += g.x * s4[i].x; v[i].y += g.y * s4[i].y; v[i].z += g.z * s4[i].z; v[i].w += g.w * s4[i].w;
        if (which != 3) { u32x2 xw; xw.x = cvt_pk_bf16(v[i].x, v[i].y); xw.y = cvt_pk_bf16(v[i].z, v[i].w); ((u32x2*)xr)[i * 64 + lane] = xw; }
      }
    }
    if (which == 2) {
      u32x2 yc[4];
#pragma unroll
      for (int i = 0; i < 4; ++i) yc[i] = yn[i];
      if (it + 1 < per) {
        const u32x2* ypn = (const u32x2*)(p.ybuf + (size_t)min(rr + 1, nrows - 1) * DM);
#pragma unroll
        for (int i = 0; i < 4; ++i) yn[i] = ypn[i * 64 + lane];
      }
#pragma unroll
      for (int i = 0; i < 4; ++i) {
        v[i].x += cG[i].x * __uint_as_float(yc[i].x << 16); v[i].y += cG[i].y * __uint_as_float(yc[i].x & 0xffff0000u);
        v[i].z += cG[i].z * __uint_as_float(yc[i].y << 16); v[i].w += cG[i].w * __uint_as_float(yc[i].y & 0xffff0000u);
        if (live) { u32x2 xw; xw.x = cvt_pk_bf16(v[i].x, v[i].y); xw.y = cvt_pk_bf16(v[i].z, v[i].w); ((u32x2*)xr)[i * 64 + lane] = xw; }
      }
    }
    float ss = 0.f;
#pragma unroll
    for (int i = 0; i < 4; ++i) ss += v[i].x * v[i].x + v[i].y * v[i].y + v[i].z * v[i].z + v[i].w * v[i].w;
    ss = wave_sum(ss);
    const float inv = rsqrtf(ss * (1.f / 1024.f) + EPS);
    if (which == 3) {
      if (live) {
#pragma unroll
        for (int i = 0; i < 4; ++i) {
          const float4 g = cA[i];
          ((float4*)(p.out + (size_t)r * DM))[i * 64 + lane] = make_float4(v[i].x * inv * g.x, v[i].y * inv * g.y, v[i].z * inv * g.z, v[i].w * inv * g.w);
        }
      }
      continue;
    }
#pragma unroll
    for (int i = 0; i < 4; ++i) {
      const float h0 = v[i].x * inv * cA[i].x + cB[i].x, h1 = v[i].y * inv * cA[i].y + cB[i].y;
      const float h2 = v[i].z * inv * cA[i].z + cB[i].z, h3 = v[i].w * inv * cA[i].w + cB[i].w;
      u32x2 w; w.x = cvt_pk_bf16(h0, h1); w.y = cvt_pk_bf16(h2, h3);
      if (live) ((u32x2*)(p.hbuf + (size_t)r * DM))[i * 64 + lane] = w;
      if (skinny) {
        const float l0 = h0 - __uint_as_float(w.x << 16), l1 = h1 - __uint_as_float(w.x & 0xffff0000u);
        const float l2 = h2 - __uint_as_float(w.y << 16), l3 = h3 - __uint_as_float(w.y & 0xffff0000u);
        u32x2 wl; wl.x = cvt_pk_bf16(l0, l1); wl.y = cvt_pk_bf16(l2, l3);
        ((u32x2*)(HROW + (wv * 2 + 0) * 1024))[i * 64 + lane] = w;
        ((u32x2*)(HROW + (wv * 2 + 1) * 1024))[i * 64 + lane] = wl;
      }
    }
    if (!skinny) continue;
    LDS_BARRIER();
    {
      const int arow = lane & 7, kg = lane >> 4;
      f32x4m acc = {0.f, 0.f, 0.f, 0.f};
#pragma unroll
      for (int ks = 0; ks < 4; ++ks) {
        const bf16x8 ahi = *(const bf16x8*)(HROW + (arow * 2 + 0) * 1024 + wv * 128 + ks * 32 + kg * 8);
        const bf16x8 alo = *(const bf16x8*)(HROW + (arow * 2 + 1) * 1024 + wv * 128 + ks * 32 + kg * 8);
        acc = __builtin_amdgcn_mfma_f32_16x16x32_bf16(ahi, Bhi[ks], acc, 0, 0, 0);
        acc = __builtin_amdgcn_mfma_f32_16x16x32_bf16(ahi, Blo[ks], acc, 0, 0, 0);
        acc = __builtin_amdgcn_mfma_f32_16x16x32_bf16(alo, Bhi[ks], acc, 0, 0, 0);
      }
      if (kg < 2) {
#pragma unroll
        for (int q = 0; q < 4; ++q) PART[(wv * 8 + kg * 4 + q) * 16 + (lane & 15)] = acc[q];
      }
    }
    LDS_BARRIER();
    {
      float v1 = 0.f;
      if (lane < 16) {
#pragma unroll
        for (int w2 = 0; w2 < 8; ++w2) v1 += PART[(w2 * 8 + wv) * 16 + lane];
      }
      if (which == 2) {
        float mx = v1;
        mx = fmaxf(mx, __shfl_xor(mx, 1)); mx = fmaxf(mx, __shfl_xor(mx, 2)); mx = fmaxf(mx, __shfl_xor(mx, 4)); mx = fmaxf(mx, __shfl_xor(mx, 8));
        const float ex = expf(v1 - mx);
        float sum = ex;
        sum += __shfl_xor(sum, 1); sum += __shfl_xor(sum, 2); sum += __shfl_xor(sum, 4); sum += __shfl_xor(sum, 8);
        if (live && lane < 16) p.aff[(size_t)r * 16 + lane] = ex / sum;
      } else {
        float gvv = v1 + p.b_gate[(l >> 1) * 16 + (lane & 15)];
        if ((lane >> 2) & 1) gvv = logsigmoidf_(gvv);
        if (live && lane < 16) p.gates[(size_t)r * 16 + lane] = gvv;
      }
    }
  }
  __syncthreads();
}

#define LOG2E 1.4426950408889634f
__device__ __forceinline__ int chain_row(int b, int dir, int p) {
  if (p < 256) { const int t = dir ? 255 - p : p; return NL + b * 256 + t; }
  const int q = p - 256; const int t = dir ? 2047 - q : q; return b * 2048 + t;
}
__device__ __forceinline__ float wave_incl_sum(float v, int lane) {
#pragma unroll
  for (int o = 1; o < 64; o <<= 1) { const float t = __shfl_up(v, o); if (lane >= o) v += t; }
  return v;
}
__device__ __forceinline__ float wave_incl_max(float v, int lane) {
#pragma unroll
  for (int o = 1; o < 64; o <<= 1) { const float t = __shfl_up(v, o); if (lane >= o) v = fmaxf(v, t); }
  return v;
}
__device__ __forceinline__ void ph_post_even(const Params& p, int l, float* sm) {
  const int e = l >> 1;
  const int tid = ltid(), lane = tid & 63;
  __syncthreads();
  for (int idx = tid; idx < 1024; idx += NTHR) {
    const int pos = idx >> 4, i = idx & 15;
    const float ang = (float)pos * exp2f(-(float)i * (13.287712379549449f / 16.f));
    float sn, cs;
    sincosf(ang, &sn, &cs);
    sm[2 * idx] = cs; sm[2 * idx + 1] = sn;
  }
  if (tid < 128) sm[2048 + tid] = tid < 64 ? p.g_qnorm[e * 64 + tid] : p.g_knorm[e * 64 + tid - 64];
  for (int idx = tid; idx < 3072; idx += NTHR) sm[2304 + idx] = p.w_conv[(size_t)e * 3 * 1024 + idx];
  __syncthreads();
  const int bid = lbid(), G = lgdim();
  const bool scanner = false;
  const size_t gtid = (size_t)bid * NTHR + tid, gsz = (size_t)G * NTHR;
  if (!scanner) {
  for (size_t it = gtid; it < (size_t)NT * 10; it += gsz) {
    const int r = (int)(it / 10), hh = (int)(it % 10);
    const bool lat = r < NL;
    const int t = r & 2047;
    const int bb = lat ? (r >> 11) : ((r - NL) >> 8);
    const int key = lat ? 256 + t : ((r - NL) & 255);
    const bf16_t* src; bf16_t* dst; const float* g; float osc;
    if (hh < 8) { src = p.proj + (size_t)r * PROJW + hh * 64; dst = p.Qb + (size_t)r * 512 + hh * 64; g = sm + 2048; osc = 0.125f * LOG2E; }
    else { src = p.proj + (size_t)r * PROJW + 512 + (hh - 8) * 64; dst = p.Kb + ((size_t)(bb * 2 + (hh - 8)) * 2304 + key) * 64; g = sm + 2048 + 64; osc = 1.f;
           const u32x4* vs = (const u32x4*)(p.proj + (size_t)r * PROJW + 640 + (hh - 8) * 64);
           u32x4* vd = (u32x4*)(p.Vb + ((size_t)(bb * 2 + (hh - 8)) * 2304 + key) * 64);
           u32x4 vt[8];
#pragma unroll
           for (int q = 0; q < 8; ++q) vt[q] = vs[q];
           __builtin_amdgcn_sched_barrier(0);
#pragma unroll
           for (int q = 0; q < 8; ++q) vd[q] = vt[q]; }
    float x[64];
#pragma unroll
    for (int q = 0; q < 8; ++q) { float f[8]; unpack8(((const u32x4*)src)[q], f);
#pragma unroll
      for (int j = 0; j < 8; ++j) x[q * 8 + j] = f[j]; }
    float ss = 0.f;
#pragma unroll
    for (int j = 0; j < 64; ++j) ss += x[j] * x[j];
    const float inv = rsqrtf(ss * (1.f / 64.f) + EPS) * osc;
#pragma unroll
    for (int j = 0; j < 64; ++j) x[j] *= inv * g[j];
    if (lat) {
#pragma unroll
      for (int a = 0; a < 2; ++a) {
        const int pos = (a == 0) ? (t >> 6) : (t & 63);
#pragma unroll
        for (int i = 0; i < 16; ++i) {
          const float2 cssn = *(const float2*)(sm + 2 * (pos * 16 + i));
          const float x1 = x[a * 32 + i], x2 = x[a * 32 + 16 + i];
          x[a * 32 + i] = x1 * cssn.x - x2 * cssn.y;
          x[a * 32 + 16 + i] = x2 * cssn.x + x1 * cssn.y;
        }
      }
    }
#pragma unroll
    for (int q = 0; q < 8; ++q) { float f[8];
#pragma unroll
      for (int j = 0; j < 8; ++j) f[j] = x[q * 8 + j];
      ((u32x4*)dst)[q] = pack8(f); }
  }
  const float* wc = sm + 2304;
  for (size_t it0 = gtid; it0 < (size_t)NT * 128; it0 += 4 * gsz) {
    u32x4 rc[4], rm[4], rp[4];
#pragma unroll
    for (int u = 0; u < 4; ++u) {
      const size_t it = it0 + (size_t)u * gsz;
      const size_t itc = it < (size_t)NT * 128 ? it : it0;
      const int r = (int)(itc >> 7), c8 = (int)(itc & 127) * 8;
      int t, n;
      if (r < NL) { t = r & 2047; n = 2048; } else { t = (r - NL) & 255; n = 256; }
      const bf16_t* sp = p.proj + (size_t)r * PROJW + 768 + c8;
      rc[u] = *(const u32x4*)sp;
      const u32x4 lm = *(const u32x4*)(sp - (t > 0 ? PROJW : 0)), lp = *(const u32x4*)(sp + (t < n - 1 ? PROJW : 0));
      rm[u].x = t > 0 ? lm.x : 0u; rm[u].y = t > 0 ? lm.y : 0u; rm[u].z = t > 0 ? lm.z : 0u; rm[u].w = t > 0 ? lm.w : 0u;
      rp[u].x = t < n - 1 ? lp.x : 0u; rp[u].y = t < n - 1 ? lp.y : 0u; rp[u].z = t < n - 1 ? lp.z : 0u; rp[u].w = t < n - 1 ? lp.w : 0u;
    }
#pragma unroll
    for (int u = 0; u < 4; ++u) {
      const size_t it = it0 + (size_t)u * gsz;
      if (it < (size_t)NT * 128) {
        const int r = (int)(it >> 7), c8 = (int)(it & 127) * 8;
        float xc[8], xm[8], xp[8], o[8];
        unpack8(rc[u], xc); unpack8(rm[u], xm); unpack8(rp[u], xp);
        const float ksc = c8 < 512 ? 1.f : 0.08838834764831845f;
#pragma unroll
        for (int j = 0; j < 8; ++j) { const float v = wc[c8 + j] * xm[j] + wc[1024 + c8 + j] * xc[j] + wc[2048 + c8 + j] * xp[j]; o[j] = siluf(v) * ksc; }
        bf16_t* dp = c8 < 512 ? p.qm + (size_t)r * 512 + c8 : p.km + (size_t)r * 512 + c8 - 512;
        *(u32x4*)dp = pack8(o);
      }
    }
  }
  }
  {
    const int gw = (int)(gtid >> 6), nw = (int)(gsz >> 6);
    for (int task = gw; task < 64 * 18; task += nw) {
      const int chain = task / 18, c = task % 18;
      const int b = chain >> 3, hd = (chain >> 1) & 3, dir = chain & 1;
      const int p0 = c * 128 + 2 * lane;
      const int r0 = chain_row(b, dir, p0), r1 = chain_row(b, dir, p0 + 1);
      const float ig0 = p.gates[(size_t)r0 * 16 + dir * 8 + hd], lf0 = p.gates[(size_t)r0 * 16 + dir * 8 + 4 + hd];
      const float ig1 = p.gates[(size_t)r1 * 16 + dir * 8 + hd], lf1 = p.gates[(size_t)r1 * 16 + dir * 8 + 4 + hd];
      const float ssum = lf0 + lf1;
      const float incl = wave_incl_sum(ssum, lane);
      const float bq0 = (incl - ssum) + lf0, bq1 = bq0 + lf1;
      const float bend = __shfl(incl, 63);
      const float g0 = ig0 - bq0, g1 = ig1 - bq1;
      const float inclm = wave_incl_max(fmaxf(g0, g1), lane);
      float exclm = __shfl_up(inclm, 1);
      if (lane == 0) exclm = -3.0e38f;
      const float pm0 = fmaxf(exclm, g0), pm1 = fmaxf(pm0, g1);
      const float gmax = __shfl(inclm, 63);
      const size_t i0 = (size_t)r0 * 8 + dir * 4 + hd, i1 = (size_t)r1 * 8 + dir * 4 + hd;
      p.gsG[i0] = g0 * LOG2E; p.gsR[i0] = pm0 * LOG2E; p.gsB[i0] = bq0 * LOG2E;
      p.gsG[i1] = g1 * LOG2E; p.gsR[i1] = pm1 * LOG2E; p.gsB[i1] = bq1 * LOG2E;
      if (lane == 0) { p.cBE[chain * 18 + c] = bend; p.cGM[chain * 18 + c] = gmax; }
    }
  }
}
__device__ __forceinline__ void chain_state(const Params& p, int chain, int cc, float& m_in, float& m_next, float& be) {
  m_in = -1e30f; m_next = -1e30f; be = 0.f;
  for (int c = 0; c <= cc; ++c) {
    be = p.cMIN[chain * 18 + c];
    const float mn = fmaxf(m_in + be, be + p.cE1[chain * 18 + c]);
    if (c < cc) m_in = mn; else m_next = mn;
  }
}

typedef float f32x16 __attribute__((ext_vector_type(16)));
typedef short s16x4 __attribute__((ext_vector_type(4)));
typedef __attribute__((address_space(3))) const char* lds_cptr;
__device__ __forceinline__ s16x4 vtr(lds_cptr p) { return __builtin_bit_cast(s16x4, __builtin_amdgcn_ds_read_tr16_b64_v4i16((__attribute__((address_space(3))) s16x4*)p)); }
#define MX3(a, b, c) __builtin_fmaxf(__builtin_fmaxf((a), (b)), (c))
__device__ __forceinline__ float rowmax32(const f32x16& p0, const f32x16& p1) {
  float a = MX3(p0[0], p0[1], p1[0]), b = MX3(p0[2], p0[3], p1[1]);
  a = MX3(a, p1[2], p1[3]);
#pragma unroll
  for (int r = 4; r < 16; r += 4) { a = MX3(a, p0[r], p0[r + 1]); b = MX3(b, p0[r + 2], p0[r + 3]); a = MX3(a, p1[r], p1[r + 1]); b = MX3(b, p1[r + 2], p1[r + 3]); }
  const float m = __builtin_fmaxf(a, b);
  auto rr = __builtin_amdgcn_permlane32_swap(__float_as_uint(m), __float_as_uint(m), false, false);
  return __builtin_fmaxf(__uint_as_float(rr[0]), __uint_as_float(rr[1]));
}
__device__ __forceinline__ float half_swap_add(float v) {
  auto rr = __builtin_amdgcn_permlane32_swap(__float_as_uint(v), __float_as_uint(v), false, false);
  return __uint_as_float(rr[0]) + __uint_as_float(rr[1]);
}
#define ATT_SLOT 16384
__device__ __forceinline__ void glds16(const void* g, unsigned lds_base) {
  unsigned sv;
  asm volatile("s_mov_b32 %0, m0\n\ts_mov_b32 m0, %2\n\ts_nop 0\n\tglobal_load_lds_dwordx4 %1, off\n\ts_mov_b32 m0, %0" : "=&s"(sv) : "v"(g), "s"(lds_base) : "memory");
}
__device__ __forceinline__ void attn_unit(const bf16_t* Q0, const bf16_t* Kbase, const bf16_t* Vbase, const int nkeys, bf16_t* O0, LAS unsigned char* lds) {
  const int tid = ltid(), lane = tid & 63, r32 = lane & 31, hi = lane >> 5;
  const int wid = __builtin_amdgcn_readfirstlane(tid >> 6);
  const int NTL = nkeys >> 6;
  __syncthreads();
  const bf16_t* ksrc = Kbase + (size_t)lane * 64 + wid * 8;
  const bf16_t* vsrc = Vbase + (size_t)(16 * (wid & 3) + (lane >> 2)) * 64 + (wid >> 2) * 32 + (lane & 3) * 8;
  const unsigned ldsb = (unsigned)(size_t)lds;
#define ATT_STAGE(t, slot) do { \
    glds16(ksrc + (size_t)(t) * 64 * 64, (unsigned)__builtin_amdgcn_readfirstlane(ldsb + (slot) * ATT_SLOT + wid * 1024)); \
    glds16(vsrc + (size_t)(t) * 64 * 64, (unsigned)__builtin_amdgcn_readfirstlane(ldsb + (slot) * ATT_SLOT + 8192 + wid * 1024)); } while (0)
  ATT_STAGE(0, 0);
  if (NTL > 1) ATT_STAGE(1, 1);
  bf16x8 qr[4];
  {
    const bf16_t* Qw = Q0 + (size_t)(wid * 32 + r32) * 512;
#pragma unroll
    for (int d0 = 0; d0 < 4; ++d0) qr[d0] = *(const bf16x8*)(Qw + d0 * 16 + hi * 8);
  }
  f32x16 o0, o1;
#pragma unroll
  for (int r = 0; r < 16; ++r) { o0[r] = 0.f; o1[r] = 0.f; }
  float m = -1e30f, l = 0.f;
  const int koff = hi * 1024 + r32 * 16;
  const int voff = 8192 + ((lane >> 4) & 1) * 32 + (lane & 3) * 8 + (4 * hi + ((lane & 15) >> 2)) * 64;
  const bool grpB = wid >= 4;
  bf16x8 pw[4];
#define ATT_PV(sl) do { const lds_cptr vp_ = (lds_cptr)(lds + (sl) * ATT_SLOT + voff); \
    _Pragma("unroll") for (int s4 = 0; s4 < 4; ++s4) { \
      const s16x4 a0l = vtr(vp_ + s4 * 1024), a0h = vtr(vp_ + s4 * 1024 + 512); \
      const s16x4 a1l = vtr(vp_ + 4096 + s4 * 1024), a1h = vtr(vp_ + 4096 + s4 * 1024 + 512); \
      const bf16x8 a0 = {a0l[0], a0l[1], a0l[2], a0l[3], a0h[0], a0h[1], a0h[2], a0h[3]}; \
      const bf16x8 a1 = {a1l[0], a1l[1], a1l[2], a1l[3], a1h[0], a1h[1], a1h[2], a1h[3]}; \
      o0 = __builtin_amdgcn_mfma_f32_32x32x16_bf16(a0, pw[s4], o0, 0, 0, 0); \
      o1 = __builtin_amdgcn_mfma_f32_32x32x16_bf16(a1, pw[s4], o1, 0, 0, 0); } } while (0)
  for (int t = 0; t <= NTL; ++t) {
    if (t + 1 < NTL) asm volatile("s_waitcnt vmcnt(2) lgkmcnt(0)\n\ts_barrier" ::: "memory"); else asm volatile("s_waitcnt vmcnt(0) lgkmcnt(0)\n\ts_barrier" ::: "memory");
    __builtin_amdgcn_sched_barrier(0);
    if (t + 2 < NTL) ATT_STAGE(t + 2, (t + 2) & 3);
    if (grpB && t > 0) ATT_PV((t - 1) & 3);
    if (t < NTL) {
      const lds_cptr kp = (lds_cptr)(lds + (t & 3) * ATT_SLOT + koff);
      f32x16 pA, pB;
#pragma unroll
      for (int r = 0; r < 16; ++r) { pA[r] = 0.f; pB[r] = 0.f; }
#pragma unroll
      for (int d0 = 0; d0 < 4; ++d0) {
        const bf16x8 k0 = *(const LAS bf16x8*)(kp + d0 * 2048), k1 = *(const LAS bf16x8*)(kp + d0 * 2048 + 512);
        pA = __builtin_amdgcn_mfma_f32_32x32x16_bf16(k0, qr[d0], pA, 0, 0, 0);
        pB = __builtin_amdgcn_mfma_f32_32x32x16_bf16(k1, qr[d0], pB, 0, 0, 0);
      }
      const float rm = rowmax32(pA, pB);
      const float mn = __builtin_fmaxf(m, rm);
      const float alpha = __builtin_amdgcn_exp2f(m - mn);
      m = mn;
      float ps = 0.f;
#pragma unroll
      for (int r = 0; r < 16; ++r) { pA[r] = __builtin_amdgcn_exp2f(pA[r] - mn); pB[r] = __builtin_amdgcn_exp2f(pB[r] - mn); ps += pA[r] + pB[r]; }
      l = l * alpha + ps;
#pragma unroll
      for (int r = 0; r < 16; ++r) { o0[r] *= alpha; o1[r] *= alpha; }
#pragma unroll
      for (int s4 = 0; s4 < 4; ++s4) {
        u32x4 w;
        if (s4 < 2) { w.x = cvt_pk_bf16(pA[8 * s4 + 0], pA[8 * s4 + 1]); w.y = cvt_pk_bf16(pA[8 * s4 + 2], pA[8 * s4 + 3]); w.z = cvt_pk_bf16(pA[8 * s4 + 4], pA[8 * s4 + 5]); w.w = cvt_pk_bf16(pA[8 * s4 + 6], pA[8 * s4 + 7]); }
        else { const int q = s4 - 2; w.x = cvt_pk_bf16(pB[8 * q + 0], pB[8 * q + 1]); w.y = cvt_pk_bf16(pB[8 * q + 2], pB[8 * q + 3]); w.z = cvt_pk_bf16(pB[8 * q + 4], pB[8 * q + 5]); w.w = cvt_pk_bf16(pB[8 * q + 6], pB[8 * q + 7]); }
        pw[s4] = __builtin_bit_cast(bf16x8, w);
      }
      if (!grpB) ATT_PV(t & 3);
    }
  }
#undef ATT_PV
#undef ATT_STAGE
  const float il = 1.f / half_swap_add(l);
  bf16_t* Ow = O0 + (size_t)(wid * 32 + r32) * 1024;
#pragma unroll
  for (int g4 = 0; g4 < 4; ++g4) {
    u32x2 w0, w1;
    w0.x = cvt_pk_bf16(o0[4 * g4 + 0] * il, o0[4 * g4 + 1] * il); w0.y = cvt_pk_bf16(o0[4 * g4 + 2] * il, o0[4 * g4 + 3] * il);
    w1.x = cvt_pk_bf16(o1[4 * g4 + 0] * il, o1[4 * g4 + 1] * il); w1.y = cvt_pk_bf16(o1[4 * g4 + 2] * il, o1[4 * g4 + 3] * il);
    *(u32x2*)(Ow + 8 * g4 + 4 * hi) = w0;
    *(u32x2*)(Ow + 32 + 8 * g4 + 4 * hi) = w1;
  }
}
#define ATT_TAU 8.f
__device__ __forceinline__ void attn_unit2(const bf16_t* Q0a, const bf16_t* Q0b, const bf16_t* Kbase, const bf16_t* Vbase, const int nkeys, bf16_t* O0a, bf16_t* O0b, LAS unsigned char* lds) {
  const int tid = ltid(), lane = tid & 63, r32 = lane & 31, hi = lane >> 5;
  const int wid = __builtin_amdgcn_readfirstlane(tid >> 6);
  const int NTL = nkeys >> 6;
  __syncthreads();
  const bf16_t* ksrc = Kbase + (size_t)lane * 64 + wid * 8;
  const bf16_t* vsrc = Vbase + (size_t)(16 * (wid & 3) + (lane >> 2)) * 64 + (wid >> 2) * 32 + (lane & 3) * 8;
  const unsigned ldsb = (unsigned)(size_t)lds;
#define ATT_STAGE(t, slot) do { \
    glds16(ksrc + (size_t)(t) * 64 * 64, (unsigned)__builtin_amdgcn_readfirstlane(ldsb + (slot) * ATT_SLOT + wid * 1024)); \
    glds16(vsrc + (size_t)(t) * 64 * 64, (unsigned)__builtin_amdgcn_readfirstlane(ldsb + (slot) * ATT_SLOT + 8192 + wid * 1024)); } while (0)
  ATT_STAGE(0, 0);
  if (NTL > 1) ATT_STAGE(1, 1);
  bf16x8 qr[2][4];
  {
    const bf16_t* Qa = Q0a + (size_t)(wid * 32 + r32) * 512;
    const bf16_t* Qb2 = Q0b + (size_t)(wid * 32 + r32) * 512;
#pragma unroll
    for (int d0 = 0; d0 < 4; ++d0) { qr[0][d0] = *(const bf16x8*)(Qa + d0 * 16 + hi * 8); qr[1][d0] = *(const bf16x8*)(Qb2 + d0 * 16 + hi * 8); }
  }
  f32x16 o0[2], o1[2];
#pragma unroll
  for (int hh = 0; hh < 2; ++hh)
#pragma unroll
    for (int r = 0; r < 16; ++r) { o0[hh][r] = 0.f; o1[hh][r] = 0.f; }
  f32x16 ng[2];
#pragma unroll
  for (int hh = 0; hh < 2; ++hh)
#pragma unroll
    for (int r = 0; r < 16; ++r) ng[hh][r] = 0.f;
  float l[2] = {0.f, 0.f};
  const int koff = hi * 1024 + r32 * 16;
  const int voff = 8192 + ((lane >> 4) & 1) * 32 + (lane & 3) * 8 + (4 * hi + ((lane & 15) >> 2)) * 64;
  int slot = 0;
  for (int t = 0; t < NTL; ++t) {
    if (t + 1 < NTL) asm volatile("s_waitcnt vmcnt(2) lgkmcnt(0)\n\ts_barrier" ::: "memory"); else asm volatile("s_waitcnt vmcnt(0) lgkmcnt(0)\n\ts_barrier" ::: "memory");
    __builtin_amdgcn_sched_barrier(0);
    if (t + 2 < NTL) { const int s2 = (slot >= 1) ? slot - 1 : 2; ATT_STAGE(t + 2, s2); }
    const lds_cptr kp = (lds_cptr)(lds + slot * ATT_SLOT + koff);
    const lds_cptr vp = (lds_cptr)(lds + slot * ATT_SLOT + voff);
    f32x16 pA[2], pB[2];
#pragma unroll
    for (int d0 = 0; d0 < 4; ++d0) {
      const bf16x8 k0 = *(const LAS bf16x8*)(kp + d0 * 2048), k1 = *(const LAS bf16x8*)(kp + d0 * 2048 + 512);
#pragma unroll
      for (int hh = 0; hh < 2; ++hh) {
        pA[hh] = __builtin_amdgcn_mfma_f32_32x32x16_bf16(k0, qr[hh][d0], d0 == 0 ? ng[hh] : pA[hh], 0, 0, 0);
        pB[hh] = __builtin_amdgcn_mfma_f32_32x32x16_bf16(k1, qr[hh][d0], d0 == 0 ? ng[hh] : pB[hh], 0, 0, 0);
      }
    }
    bf16x8 pw[2][4];
#pragma unroll
    for (int hh = 0; hh < 2; ++hh) {
      const float rm = rowmax32(pA[hh], pB[hh]);
      if (t == 0 || __builtin_amdgcn_ballot_w64(rm > ATT_TAU) != 0ull) {
        const float delta = (t == 0) ? rm : __builtin_fmaxf(rm, 0.f);
        const float alpha = __builtin_amdgcn_exp2f(-delta);
#pragma unroll
        for (int r = 0; r < 16; ++r) { pA[hh][r] -= delta; pB[hh][r] -= delta; o0[hh][r] *= alpha; o1[hh][r] *= alpha; ng[hh][r] -= delta; }
        l[hh] *= alpha;
      }
      float ps = 0.f;
#pragma unroll
      for (int r = 0; r < 16; ++r) { pA[hh][r] = __builtin_amdgcn_exp2f(pA[hh][r]); pB[hh][r] = __builtin_amdgcn_exp2f(pB[hh][r]); ps += pA[hh][r] + pB[hh][r]; }
      l[hh] += ps;
#pragma unroll
      for (int s4 = 0; s4 < 4; ++s4) {
        u32x4 w;
        if (s4 < 2) { w.x = cvt_pk_bf16(pA[hh][8 * s4 + 0], pA[hh][8 * s4 + 1]); w.y = cvt_pk_bf16(pA[hh][8 * s4 + 2], pA[hh][8 * s4 + 3]); w.z = cvt_pk_bf16(pA[hh][8 * s4 + 4], pA[hh][8 * s4 + 5]); w.w = cvt_pk_bf16(pA[hh][8 * s4 + 6], pA[hh][8 * s4 + 7]); }
        else { const int q = s4 - 2; w.x = cvt_pk_bf16(pB[hh][8 * q + 0], pB[hh][8 * q + 1]); w.y = cvt_pk_bf16(pB[hh][8 * q + 2], pB[hh][8 * q + 3]); w.z = cvt_pk_bf16(pB[hh][8 * q + 4], pB[hh][8 * q + 5]); w.w = cvt_pk_bf16(pB[hh][8 * q + 6], pB[hh][8 * q + 7]); }
        pw[hh][s4] = __builtin_bit_cast(bf16x8, w);
      }
    }
#pragma unroll
    for (int s4 = 0; s4 < 4; ++s4) {
      const s16x4 a0l = vtr(vp + s4 * 1024), a0h = vtr(vp + s4 * 1024 + 512);
      const s16x4 a1l = vtr(vp + 4096 + s4 * 1024), a1h = vtr(vp + 4096 + s4 * 1024 + 512);
      const bf16x8 a0 = {a0l[0], a0l[1], a0l[2], a0l[3], a0h[0], a0h[1], a0h[2], a0h[3]};
      const bf16x8 a1 = {a1l[0], a1l[1], a1l[2], a1l[3], a1h[0], a1h[1], a1h[2], a1h[3]};
#pragma unroll
      for (int hh = 0; hh < 2; ++hh) {
        o0[hh] = __builtin_amdgcn_mfma_f32_32x32x16_bf16(a0, pw[hh][s4], o0[hh], 0, 0, 0);
        o1[hh] = __builtin_amdgcn_mfma_f32_32x32x16_bf16(a1, pw[hh][s4], o1[hh], 0, 0, 0);
      }
    }
    slot = (slot == 2) ? 0 : slot + 1;
  }
#undef ATT_STAGE
#pragma unroll
  for (int hh = 0; hh < 2; ++hh) {
    const float il = 1.f / half_swap_add(l[hh]);
    bf16_t* Ow = (hh ? O0b : O0a) + (size_t)(wid * 32 + r32) * 1024;
#pragma unroll
    for (int g4 = 0; g4 < 4; ++g4) {
      u32x2 w0, w1;
      w0.x = cvt_pk_bf16(o0[hh][4 * g4 + 0] * il, o0[hh][4 * g4 + 1] * il); w0.y = cvt_pk_bf16(o0[hh][4 * g4 + 2] * il, o0[hh][4 * g4 + 3] * il);
      w1.x = cvt_pk_bf16(o1[hh][4 * g4 + 0] * il, o1[hh][4 * g4 + 1] * il); w1.y = cvt_pk_bf16(o1[hh][4 * g4 + 2] * il, o1[hh][4 * g4 + 3] * il);
      *(u32x2*)(Ow + 8 * g4 + 4 * hi) = w0;
      *(u32x2*)(Ow + 32 + 8 * g4 + 4 * hi) = w1;
    }
  }
}
__device__ __forceinline__ void ph_att(const Params& p, bool ctx_q, LAS unsigned char* lds) {
  const int c = lbid(), G = lgdim();
  const int nunits = 256 + (ctx_q ? 32 : 0);
  for (int L = c; L < nunits; L += G) {
    if (L < 256) {
      const int grp = (L & 7) * 2 + ((L >> 3) >> 4), within = (L >> 3) & 15;
      const int b = grp >> 1, kvh = grp & 1, h0 = kvh * 4 + 2 * (within >> 3), qt = within & 7;
      const size_t row0 = (size_t)b * 2048 + qt * 256;
      const size_t kvb = (size_t)(b * 2 + kvh) * 2304 * 64;
      attn_unit2(p.Qb + row0 * 512 + h0 * 64, p.Qb + row0 * 512 + (h0 + 1) * 64, p.Kb + kvb, p.Vb + kvb, 2304, p.mix + row0 * 1024 + h0 * 64, p.mix + row0 * 1024 + (h0 + 1) * 64, lds);
    } else {
      const int u = L - 256, b = u >> 2, kvh = (u >> 1) & 1, h0 = kvh * 4 + 2 * (u & 1);
      const size_t row0 = (size_t)NL + b * 256;
      const size_t kvb = (size_t)(b * 2 + kvh) * 2304 * 64;
      attn_unit2(p.Qb + row0 * 512 + h0 * 64, p.Qb + row0 * 512 + (h0 + 1) * 64, p.Kb + kvb, p.Vb + kvb, 256, p.mix + row0 * 1024 + h0 * 64, p.mix + row0 * 1024 + (h0 + 1) * 64, lds);
    }
  }
  __syncthreads();
}

__device__ __forceinline__ int chunk_row0(int b, int dir, int cc) {
  if (cc < 2) return NL + b * 256 + (dir ? 1 - cc : cc) * 128;
  return b * 2048 + (dir ? 15 - (cc - 2) : cc - 2) * 128;
}
__device__ __forceinline__ int trq_addr(int lane, int quarter, int rowbase) {
  return quarter * 8192 + ((lane >> 4) & 1) * 32 + (lane & 3) * 8 + (rowbase + ((lane & 15) >> 2)) * 64;
}
__device__ __forceinline__ bf16x8 cat44(const s16x4 a, const s16x4 b) { return (bf16x8){a[0], a[1], a[2], a[3], b[0], b[1], b[2], b[3]}; }

__device__ __forceinline__ void glds4(const void* g, unsigned lds_base) {
  unsigned sv;
  asm volatile("s_mov_b32 %0, m0\n\ts_mov_b32 m0, %2\n\ts_nop 0\n\tglobal_load_lds_dword %1, off\n\ts_mov_b32 m0, %0" : "=&s"(sv) : "v"(g), "s"(lds_base) : "memory");
}
#define USC_SLOT 41472
#define USC_WS 124416
#define USC_NP 124928
#define USC_TB 125952
#define USC_CS 133120
__device__ __forceinline__ void ph_mlstm_uscan(const Params& p, LAS unsigned char* lds) {
  const int tid = ltid(), lane = tid & 63, r32 = lane & 31, hi = lane >> 5;
  const int wid = __builtin_amdgcn_readfirstlane(tid >> 6);
  LAS float* WS = (LAS float*)(lds + USC_WS);
  LAS float* NP = (LAS float*)(lds + USC_NP);
  LAS float* TE1 = (LAS float*)(lds + USC_TB);
  LAS float* TDEC = TE1 + 18;
  const unsigned ldsb = (unsigned)(size_t)lds;
  for (int unit = lbid(); unit < 256; unit += lgdim()) {
    const int eb = (unit >> 3) & 3, chain = (unit >> 5) * 8 + (unit & 7);
    const int b = chain >> 3, hd = (chain >> 1) & 3, dir = chain & 1;
    __syncthreads();
#define USC_ISSUE(cc_, s_) do { const int row0_ = chunk_row0(b, dir, (cc_)); \
      _Pragma("unroll") for (int n = 0; n < 4; ++n) { const int ii = wid * 4 + n, qd = ii >> 3, rg = ii & 7; \
        glds16(p.km + (size_t)(row0_ + rg * 16 + (lane >> 2)) * 512 + hd * 128 + qd * 32 + (lane & 3) * 8, \
               (unsigned)__builtin_amdgcn_readfirstlane(ldsb + (s_) * USC_SLOT + qd * 8192 + rg * 1024)); } \
      glds16(p.proj + (size_t)(row0_ + wid * 16 + (lane >> 2)) * PROJW + 1792 + hd * 128 + eb * 32 + (lane & 3) * 8, \
             (unsigned)__builtin_amdgcn_readfirstlane(ldsb + (s_) * USC_SLOT + 32768 + wid * 1024)); \
      if (wid < 2) glds4(p.gsG + (size_t)(row0_ + wid * 64 + lane) * 8 + dir * 4 + hd, (unsigned)__builtin_amdgcn_readfirstlane(ldsb + (s_) * USC_SLOT + 40960 + wid * 256)); \
    } while (0)
    USC_ISSUE(0, 0);
    USC_ISSUE(1, 1);
    if (tid == 0) {
      float be[18], gm[18];
#pragma unroll
      for (int c = 0; c < 18; ++c) { be[c] = p.cBE[chain * 18 + c]; gm[c] = p.cGM[chain * 18 + c]; }
      float m_in = -1e30f;
#pragma unroll
      for (int c = 0; c < 18; ++c) {
        const float m_next = fmaxf(m_in + be[c], be[c] + gm[c]);
        TE1[c] = (be[c] - m_next) * LOG2E;
        TDEC[c] = expf(m_in + be[c] - m_next);
        if (eb == 0) p.cMIN[chain * 18 + c] = m_in * LOG2E;
        m_in = m_next;
      }
    }
    f32x16 cacc;
#pragma unroll
    for (int r = 0; r < 16; ++r) cacc[r] = 0.f;
    float nv = 0.f;
    LDS_BARRIER();
#pragma unroll
    for (int c = 0; c < 17; ++c) {
      const int s = c % 3;
      LAS unsigned char* slot = lds + s * USC_SLOT;
      if (c < 16) asm volatile("s_waitcnt vmcnt(5)" ::: "memory"); else asm volatile("s_waitcnt vmcnt(0)" ::: "memory");
      if (tid < 128) WS[tid] = __builtin_amdgcn_exp2f(*(const LAS float*)(slot + 40960 + tid * 4) + TE1[c]);
      LDS_BARRIER();
      if (c + 2 < 17) USC_ISSUE(c + 2, (c + 2) % 3);
      {
        float f[8];
        unpack8(*(const LAS u32x4*)(slot + 32768 + tid * 16), f);
        const float w = WS[tid >> 2];
#pragma unroll
        for (int j = 0; j < 8; ++j) f[j] *= w;
        *(LAS u32x4*)(slot + 32768 + tid * 16) = pack8(f);
      }
      LDS_BARRIER();
      const float dec = TDEC[c];
      if (wid < 4) {
#pragma unroll
        for (int r = 0; r < 16; ++r) cacc[r] *= dec;
#pragma unroll
        for (int ks = 0; ks < 8; ++ks) {
          const int rb = ks * 16 + 8 * hi;
          const bf16x8 kf = cat44(vtr((lds_cptr)(slot + trq_addr(lane, wid, rb))), vtr((lds_cptr)(slot + trq_addr(lane, wid, rb + 4))));
          const bf16x8 vf = cat44(vtr((lds_cptr)(slot + 32768 + trq_addr(lane, 0, rb))), vtr((lds_cptr)(slot + 32768 + trq_addr(lane, 0, rb + 4))));
          cacc = __builtin_amdgcn_mfma_f32_32x32x16_bf16(kf, vf, cacc, 0, 0, 0);
        }
#pragma unroll
        for (int g4 = 0; g4 < 4; ++g4) {
          u32x2 w2; w2.x = cvt_pk_bf16(cacc[4 * g4], cacc[4 * g4 + 1]); w2.y = cvt_pk_bf16(cacc[4 * g4 + 2], cacc[4 * g4 + 3]);
          *(LAS u32x2*)(lds + USC_CS + r32 * 272 + (wid * 32 + 8 * g4 + 4 * hi) * 2) = w2;
        }
      } else {
        const int t2 = tid - 256, dl = t2 & 31, part = t2 >> 5;
        float acc = 0.f;
#pragma unroll
        for (int i = 0; i < 16; ++i) {
          const int srow = part * 16 + i;
          acc += WS[srow] * bf2f(*(const LAS bf16_t*)(slot + eb * 8192 + srow * 64 + dl * 2));
        }
        NP[part * 32 + dl] = acc;
      }
      LDS_BARRIER();
      {
        const u32x4 cv = *(const LAS u32x4*)(lds + USC_CS + (tid >> 4) * 272 + (tid & 15) * 16);
        *(u32x4*)(p.Cbf + ((size_t)chain * 18 + c + 1) * 16384 + (size_t)(eb * 32 + (tid >> 4)) * 128 + (tid & 15) * 8) = cv;
      }
      if (tid < 32) {
        float sn = 0.f;
#pragma unroll
        for (int q = 0; q < 8; ++q) sn += NP[q * 32 + tid];
        nv = dec * nv + sn;
        p.NVb[((size_t)chain * 18 + c + 1) * 128 + eb * 32 + tid] = nv;
      }
    }
    asm volatile("s_waitcnt vmcnt(0)" ::: "memory");
  }
  __syncthreads();
}

__device__ __forceinline__ void ph_mlstm_h(const Params& p, int l, bool ctx_out, LAS unsigned char* lds) {
  const int e2 = l >> 1;
  const int tid = ltid(), lane = tid & 63, r32 = lane & 31, hi = lane >> 5;
  const int wid = __builtin_amdgcn_readfirstlane(tid >> 6);
  const int tb = wid & 3, dir = wid >> 2;
  LAS float* HX = (LAS float*)(lds);
  LAS float* GC = (LAS float*)(lds + 131072);
  const int j0 = ctx_out ? 0 : 2, nj = 18 - j0;
  for (int unit = lbid(); unit < 32 * nj; unit += lgdim()) {
    const int bh = unit / nj, j = j0 + unit % nj, b = bh >> 2, hd = bh & 3;
    const int row0 = (j < 2) ? NL + b * 256 + j * 128 : b * 2048 + (j - 2) * 128;
    const int cc = dir ? (j < 2 ? 1 - j : 19 - j) : j;
    const int chain = b * 8 + hd * 2 + dir;
    __syncthreads();
#pragma unroll
    for (int n = 0; n < 4; ++n) {
      const int ii = wid * 4 + n;
      { const int ch = ii >> 1, rh = ii & 1;
        const bf16_t* src = p.km + (size_t)(row0 + rh * 64 + lane) * 512 + hd * 128 + ch * 8;
        __builtin_amdgcn_global_load_lds((const unsigned*)src, (LAS unsigned*)(lds + ch * 2048 + rh * 1024), 16, 0, 0); }
      { const int qd = ii >> 3, rg = ii & 7;
        const bf16_t* src = p.proj + (size_t)(row0 + rg * 16 + (lane >> 2)) * PROJW + 1792 + hd * 128 + qd * 32 + (lane & 3) * 8;
        __builtin_amdgcn_global_load_lds((const unsigned*)src, (LAS unsigned*)(lds + 32768 + qd * 8192 + rg * 1024), 16, 0, 0); }
    }
#pragma unroll
    for (int n = 0; n < 8; ++n) {
      const int ii2 = wid * 8 + n, dd = ii2 >> 5, ch = (ii2 & 31) >> 1, rh = ii2 & 1;
      const int ccd = dd ? (j < 2 ? 1 - j : 19 - j) : j;
      if (ccd > 0) {
        const bf16_t* src = p.Cbf + ((size_t)(b * 8 + hd * 2 + dd) * 18 + ccd) * 16384 + (size_t)(rh * 64 + lane) * 128 + ch * 8;
        __builtin_amdgcn_global_load_lds((const unsigned*)src, (LAS unsigned*)(lds + 65536 + dd * 32768 + ch * 2048 + rh * 1024), 16, 0, 0);
      }
    }
    const int trow = row0 + tb * 32 + r32;
    bf16x8 qf[8];
#pragma unroll
    for (int ks = 0; ks < 8; ++ks) qf[ks] = *(const bf16x8*)(p.qm + (size_t)trow * 512 + hd * 128 + ks * 16 + hi * 8);
    const float MIN2 = p.cMIN[chain * 18 + cc];
    const float R2 = -fmaxf(MIN2, p.gsR[(size_t)trow * 8 + dir * 4 + hd]), BQ2 = p.gsB[(size_t)trow * 8 + dir * 4 + hd];
    f32x16 acc[4];
#pragma unroll
    for (int eb = 0; eb < 4; ++eb)
#pragma unroll
      for (int r = 0; r < 16; ++r) acc[eb][r] = 0.f;
    float nq = 0.f;
    if (cc > 0) {
      const float* nvp = p.NVb + ((size_t)chain * 18 + cc) * 128 + hi * 8;
#pragma unroll
      for (int ks = 0; ks < 8; ++ks) {
        const f32x4 n0 = *(const f32x4*)(nvp + ks * 16), n1 = *(const f32x4*)(nvp + ks * 16 + 4);
        float qv[8];
        unpack8(__builtin_bit_cast(u32x4, qf[ks]), qv);
        nq += n0[0] * qv[0] + n0[1] * qv[1] + n0[2] * qv[2] + n0[3] * qv[3] + n1[0] * qv[4] + n1[1] * qv[5] + n1[2] * qv[6] + n1[3] * qv[7];
      }
      nq = half_swap_add(nq);
    }
    const float* gh = p.g_hnorm + e2 * 512 + hd * 128;
    const bf16_t* obp = p.proj + (size_t)trow * PROJW + 2304 + hd * 128;
    const float winter = __builtin_amdgcn_exp2f(MIN2 + R2);
    if (tid < 256) GC[tid] = p.gsG[(size_t)(row0 + (tid & 127)) * 8 + (tid >> 7) * 4 + hd];
    asm volatile("s_waitcnt vmcnt(0)" ::: "memory");
    __syncthreads();
    if (cc > 0) {
#pragma unroll
      for (int eb = 0; eb < 4; ++eb)
#pragma unroll
        for (int ks = 0; ks < 8; ++ks) {
          const bf16x8 a = *(const LAS bf16x8*)(lds + 65536 + dir * 32768 + (2 * ks + hi) * 2048 + (eb * 32 + r32) * 16);
          acc[eb] = __builtin_amdgcn_mfma_f32_32x32x16_bf16(a, qf[ks], acc[eb], 0, 0, 0);
        }
#pragma unroll
      for (int eb = 0; eb < 4; ++eb)
#pragma unroll
        for (int r = 0; r < 16; ++r) acc[eb][r] *= winter;
    }
    float sw = 0.f;
    const int sb_lo = dir ? tb : 0, sb_hi = dir ? 3 : tb;
    for (int sb = sb_lo; sb <= sb_hi; ++sb) {
      f32x16 st;
#pragma unroll
      for (int r = 0; r < 16; ++r) st[r] = 0.f;
#pragma unroll
      for (int ks = 0; ks < 8; ++ks) {
        const bf16x8 kf = *(const LAS bf16x8*)(lds + (2 * ks + hi) * 2048 + (sb * 32 + r32) * 16);
        st = __builtin_amdgcn_mfma_f32_32x32x16_bf16(kf, qf[ks], st, 0, 0, 0);
      }
      const bool diag = (sb == tb);
#pragma unroll
      for (int g4 = 0; g4 < 4; ++g4) {
        const f32x4 gc = *(const LAS f32x4*)(GC + dir * 128 + sb * 32 + 8 * g4 + 4 * hi);
#pragma unroll
        for (int q = 0; q < 4; ++q) {
          const int sl = 8 * g4 + 4 * hi + q;
          float w = __builtin_amdgcn_exp2f(R2 + gc[q]) * st[4 * g4 + q];
          const bool keep = !diag || (dir ? (sl >= r32) : (sl <= r32));
          w = keep ? w : 0.f;
          sw += w;
          st[4 * g4 + q] = w;
        }
      }
      u32x4 p0, p1;
      p0.x = cvt_pk_bf16(st[0], st[1]); p0.y = cvt_pk_bf16(st[2], st[3]); p0.z = cvt_pk_bf16(st[4], st[5]); p0.w = cvt_pk_bf16(st[6], st[7]);
      p1.x = cvt_pk_bf16(st[8], st[9]); p1.y = cvt_pk_bf16(st[10], st[11]); p1.z = cvt_pk_bf16(st[12], st[13]); p1.w = cvt_pk_bf16(st[14], st[15]);
      const bf16x8 pw0 = __builtin_bit_cast(bf16x8, p0), pw1 = __builtin_bit_cast(bf16x8, p1);
#pragma unroll
      for (int eb = 0; eb < 4; ++eb) {
        const int rb = sb * 32 + 4 * hi;
        const bf16x8 a0 = cat44(vtr((lds_cptr)(lds + 32768 + trq_addr(lane, eb, rb))), vtr((lds_cptr)(lds + 32768 + trq_addr(lane, eb, rb + 8))));
        const bf16x8 a1 = cat44(vtr((lds_cptr)(lds + 32768 + trq_addr(lane, eb, rb + 16))), vtr((lds_cptr)(lds + 32768 + trq_addr(lane, eb, rb + 24))));
        acc[eb] = __builtin_amdgcn_mfma_f32_32x32x16_bf16(a0, pw0, acc[eb], 0, 0, 0);
        acc[eb] = __builtin_amdgcn_mfma_f32_32x32x16_bf16(a1, pw1, acc[eb], 0, 0, 0);
      }
    }
    sw = half_swap_add(sw);
    const float den = winter * nq + sw;
    const float dn = fmaxf(fabsf(den), __builtin_amdgcn_exp2f(R2 - BQ2));
    const float idn = 1.f / dn;
    __syncthreads();
    if (dir == 1) {
#pragma unroll
      for (int eb = 0; eb < 4; ++eb)
#pragma unroll
        for (int r = 0; r < 16; ++r) HX[(tb * 128 + eb * 32 + (r & 3) + 8 * (r >> 2) + 4 * hi) * 32 + r32] = acc[eb][r] * idn;
    }
    __syncthreads();
    if (dir == 0) {
      float ss = 0.f;
#pragma unroll
      for (int eb = 0; eb < 4; ++eb)
#pragma unroll
        for (int r = 0; r < 16; ++r) {
          const float v = acc[eb][r] * idn + HX[(tb * 128 + eb * 32 + (r & 3) + 8 * (r >> 2) + 4 * hi) * 32 + r32];
          acc[eb][r] = v; ss += v * v;
        }
      ss = half_swap_add(ss);
      const float inv = rsqrtf(ss * (1.f / 128.f) + EPS);
      bf16_t* op = p.mix + (size_t)trow * 1024 + 512 + hd * 128;
#pragma unroll
      for (int eb = 0; eb < 4; ++eb) {
        f32x4 gv[4]; u32x2 ow[4];
#pragma unroll
        for (int g4 = 0; g4 < 4; ++g4) { const int e0 = eb * 32 + 8 * g4 + 4 * hi; gv[g4] = *(const f32x4*)(gh + e0); ow[g4] = *(const u32x2*)(obp + e0); }
#pragma unroll
        for (int g4 = 0; g4 < 4; ++g4) {
          const int e0 = eb * 32 + 8 * g4 + 4 * hi;
          const float ob0 = __uint_as_float(ow[g4].x << 16), ob1 = __uint_as_float(ow[g4].x & 0xffff0000u), ob2 = __uint_as_float(ow[g4].y << 16), ob3 = __uint_as_float(ow[g4].y & 0xffff0000u);
          const float v0 = acc[eb][4 * g4 + 0] * inv * gv[g4][0] * sigmoidf_(ob0), v1 = acc[eb][4 * g4 + 1] * inv * gv[g4][1] * sigmoidf_(ob1);
          const float v2 = acc[eb][4 * g4 + 2] * inv * gv[g4][2] * sigmoidf_(ob2), v3 = acc[eb][4 * g4 + 3] * inv * gv[g4][3] * sigmoidf_(ob3);
          u32x2 w; w.x = cvt_pk_bf16(v0, v1); w.y = cvt_pk_bf16(v2, v3);
          *(u32x2*)(op + e0) = w;
        }
      }
    }
  }
  __syncthreads();
}

template <int EPL>
__device__ __forceinline__ void topk_column(const Params& p, const float* col, int e, int base, int cap, size_t mbase, int lane) {
  unsigned v[EPL];
#pragma unroll
  for (int k = 0; k < EPL; ++k) v[k] = __float_as_uint(col[k * 64 + lane]);
  unsigned thr = 0u;
  for (int bit = 30; bit >= 0; --bit) {
    const unsigned cand = thr | (1u << bit);
    unsigned c = 0;
#pragma unroll
    for (int k = 0; k < EPL; ++k) c += (v[k] >= cand) ? 1u : 0u;
#pragma unroll
    for (int o = 32; o > 0; o >>= 1) c += __shfl_xor(c, o);
    if (c >= (unsigned)cap) thr = cand;
  }
  unsigned totgt = 0;
#pragma unroll
  for (int k = 0; k < EPL; ++k) totgt += (unsigned)__popcll(__ballot(v[k] > thr));
  const unsigned need_eq = (unsigned)cap - totgt;
  unsigned cg = 0, ce = 0;
#pragma unroll
  for (int k = 0; k < EPL; ++k) {
    const bool gt = v[k] > thr, eq = v[k] == thr;
    const unsigned long long bg = __ballot(gt), be = __ballot(eq);
    const unsigned gtb = cg + __builtin_amdgcn_mbcnt_hi((unsigned)(bg >> 32), __builtin_amdgcn_mbcnt_lo((unsigned)bg, 0u));
    const unsigned eqb = ce + __builtin_amdgcn_mbcnt_hi((unsigned)(be >> 32), __builtin_amdgcn_mbcnt_lo((unsigned)be, 0u));
    const bool take = gt || (eq && eqb < need_eq);
    const int r = base + k * 64 + lane;
    const unsigned slot = gtb + (eqb < need_eq ? eqb : need_eq);
    if (take) { p.slotmap[(size_t)r * 16 + e] = (int)slot; p.rowidx[mbase + slot] = r; p.gatev[mbase + slot] = __uint_as_float(v[k]); }
    else p.slotmap[(size_t)r * 16 + e] = -1;
    cg += (unsigned)__popcll(bg); ce += (unsigned)__popcll(be);
  }
}
__device__ __forceinline__ void ph_topk(const Params& p, bool ctx, float* sm) {
  const int tid = ltid(), lane = tid & 63, wv = tid >> 6;
  const int ntask = ctx ? 32 : 16;
  for (int task = lbid(); task < ntask; task += lgdim()) {
    const bool lat = task < 16;
    const int b = (task >> 1) & 7, eh = task & 1, n = lat ? 2048 : 256, cap = lat ? 256 : 32, base = lat ? b * 2048 : NL + b * 256;
    __syncthreads();
    for (int idx0 = tid; idx0 < n * 2; idx0 += 8 * NTHR) {
      float4 a[8];
#pragma unroll
      for (int u = 0; u < 8; ++u) { const int idx = min(idx0 + u * NTHR, n * 2 - 1); a[u] = *(const float4*)(p.aff + (size_t)(base + (idx >> 1)) * 16 + eh * 8 + (idx & 1) * 4); }
      __builtin_amdgcn_sched_barrier(0);
#pragma unroll
      for (int u = 0; u < 8; ++u) {
        const int idx = idx0 + u * NTHR, row = idx >> 1, q = idx & 1;
        if (idx < n * 2) { sm[(q * 4 + 0) * n + row] = a[u].x; sm[(q * 4 + 1) * n + row] = a[u].y; sm[(q * 4 + 2) * n + row] = a[u].z; sm[(q * 4 + 3) * n + row] = a[u].w; }
      }
    }
    __syncthreads();
    {
      const int e = eh * 8 + wv;
      if (lat) topk_column<32>(p, sm + wv * n, e, base, cap, (size_t)e * 2048 + (size_t)b * 256, lane);
      else topk_column<4>(p, sm + wv * n, e, base, cap, (size_t)MOE_L + (size_t)e * 256 + (size_t)b * 32, lane);
    }
  }
  __syncthreads();
}

template <int W>
__device__ __forceinline__ void pool_item(const Params& p, int r, int c8) {
  int t, n;
  if (r < NL) { t = r & 2047; n = 2048; } else { t = (r - NL) & 255; n = 256; }
  constexpr int lo = W / 2;
  const bf16_t* up = p.proj + (size_t)r * 1024 + c8;
  u32x4 raw[W];
  int cnt = 0;
#pragma unroll
  for (int k = 0; k < W; ++k) {
    const int tt = t - lo + k;
    const bool ok = tt >= 0 && tt < n;
    const int tc = tt < 0 ? 0 : (tt >= n ? n - 1 : tt);
    const u32x4 ld = *(const u32x4*)(up + (ptrdiff_t)(tc - t) * 1024);
    raw[k].x = ok ? ld.x : 0u; raw[k].y = ok ? ld.y : 0u; raw[k].z = ok ? ld.z : 0u; raw[k].w = ok ? ld.w : 0u;
    cnt += ok ? 1 : 0;
  }
  float s8[8], f[8], uc[8];
#pragma unroll
  for (int j = 0; j < 8; ++j) s8[j] = 0.f;
#pragma unroll
  for (int k = 0; k < W; ++k) {
    unpack8(raw[k], f);
#pragma unroll
    for (int j = 0; j < 8; ++j) s8[j] += f[j];
  }
  unpack8(raw[lo], uc);
  const float ic = 1.f / (float)cnt;
#pragma unroll
  for (int j = 0; j < 8; ++j) f[j] = s8[j] * ic - uc[j];
  *(u32x4*)(p.mix + (size_t)r * 1024 + c8) = pack8(f);
}
__device__ __forceinline__ void ph_pool(const Params& p, int nrows) {
  const size_t gtid = (size_t)lbid() * NTHR + ltid(), gsz = (size_t)lgdim() * NTHR;
  for (size_t it = gtid; it < (size_t)nrows * 128; it += gsz) {
    const int g = (int)(it / ((size_t)nrows * 32));
    const size_t rem = it - (size_t)g * nrows * 32;
    const int r = (int)(rem >> 5), c8 = g * 256 + (int)(rem & 31) * 8;
    if (g == 0) pool_item<2>(p, r, c8);
    else if (g == 1) pool_item<4>(p, r, c8);
    else if (g == 2) pool_item<8>(p, r, c8);
    else pool_item<16>(p, r, c8);
  }
}

enum { PH_INIT = 0, PH_NORM1, PH_GEMM_IN_EVEN, PH_POST_EVEN, PH_ATT, PH_MLSTM_U, PH_MLSTM_SCAN, PH_MLSTM_H, PH_GEMM_OUT, PH_NORM2, PH_TOPK, PH_GATHER,
       PH_MOE_GU, PH_MOE_D, PH_GEMM_IN_ODD, PH_POOL, PH_GEMM_GRP, PH_FINAL };

typedef const __attribute__((address_space(4))) Params* KParams;
__device__ __forceinline__ const Params& get_params() {
  KParams kp = (KParams)__builtin_amdgcn_kernarg_segment_ptr();
  asm volatile("" : "+s"(kp));
  return *(const Params*)kp;
}
__device__ __forceinline__ int idle_slots(int nu, int G, int c) {
  const int mx = (nu + G - 1) / G, mine = c < nu ? (nu - c + G - 1) / G : 0;
  return mx - mine;
}
__device__ __forceinline__ void run_phase(int ph, int l, unsigned char* shm) {
  const Params& p = get_params();
  float* sm = (float*)shm;
  LAS unsigned char* lds = (LAS unsigned char*)shm;
  const bool ctx_next = (l < 2);
  const bool ctx_used = (l < 3);
  const int G = lgdim(), c = lbid();
  switch (ph) {
    case PH_INIT: ph_init(p, sm); break;
    case PH_NORM1: {
      const int ncomb = (l == 0) ? 0 : ((l - 1) < 2 ? NT : NL);
      ph_norm(p, l, 1, ctx_used ? NT : NL, ncomb, l - 1, sm);
    } break;
    case PH_GEMM_IN_EVEN: {
      g8::SchedDense S{(const char*)p.hbuf, (const char*)(p.WinE + (size_t)(l >> 1) * PROJW * 1024), 1024, 1024, NT / 256, PROJW / 256, 0, G, c};
      g8::EpiBf16 E{p.proj, PROJW};
      g8::gemm_phase(lds, 1024, 1024, 1024, S, E);
      conv_quota(p, idle_slots(S.nM * S.nN, G, c) * 3, sm);
    } break;
    case PH_POST_EVEN: ph_post_even(p, l, sm); break;
    case PH_ATT: ph_att(p, ctx_next, lds); ph_mlstm_uscan(p, lds); conv_quota(p, idle_slots(256 + (ctx_next ? 32 : 0), G, c) * 1, sm); break;
    case PH_MLSTM_H: ph_mlstm_h(p, l, ctx_next, lds); conv_quota(p, idle_slots(32 * (ctx_next ? 18 : 16), G, c) * 3, sm); break;
    case PH_GEMM_OUT: {
      g8::SchedDense S{(const char*)p.mix, (const char*)(p.WoutE + (size_t)(l >> 1) * 1024 * 1024), 1024, 1024, (ctx_next ? NT : NL) / 256, 4, 0, G, c};
      g8::EpiBf16 E{p.ybuf, 1024};
      g8::gemm_phase(lds, 1024, 1024, 1024, S, E);
      conv_quota(p, idle_slots(S.nM * S.nN, G, c) * 3, sm);
    } break;
    case PH_NORM2: ph_norm(p, l, 2, ctx_next ? NT : NL, 0, 0, sm); break;
    case PH_TOPK: ph_topk(p, ctx_next, sm); conv_until(p, l == 0 ? CE4 : (l == 1 ? CE7 : (l == 2 ? CE10 : CE11)), sm); break;
    case PH_MOE_GU: {
      g8::SchedMoe S{(const char*)p.Xs, (const char*)(p.Wgu + (size_t)l * NEXP * 2048 * 1024), 8, 2048, 128, ctx_next ? 1152 : 1024, G, c};
      g8::EpiSwiGLU E{p.Abuf};
      g8::gemm_phase<true>(lds, 1024, 1024, 1024, S, E, p.rowidx, (const char*)p.hbuf);
      conv_quota(p, idle_slots(S.nu, G, c) * 3, sm);
    } break;
    case PH_MOE_D: {
      g8::SchedMoe S{(const char*)p.Abuf, (const char*)(p.Wd + (size_t)l * NEXP * 1024 * 1024), 4, 1024, 256, ctx_next ? 576 : 512, G, c};
      g8::EpiDown E{p.Ybuf, p.gatev};
      g8::gemm_phase(lds, 1024, 1024, 1024, S, E);
      conv_quota(p, idle_slots(S.nu, G, c) * 3, sm);
    } break;
    case PH_GEMM_IN_ODD: {
      g8::SchedDense S{(const char*)p.hbuf, (const char*)(p.WinO + (size_t)(l >> 1) * 1024 * 1024), 1024, 1024, (ctx_next ? NT : NL) / 256, 4, 0, G, c};
      g8::EpiBf16 E{p.proj, 1024};
      g8::gemm_phase(lds, 1024, 1024, 1024, S, E);
      conv_quota(p, idle_slots(S.nM * S.nN, G, c) * 3, sm);
    } break;
    case PH_POOL: ph_pool(p, ctx_next ? NT : NL); break;
    case PH_GEMM_GRP: {
      g8::SchedDense S{(const char*)p.mix, (const char*)(p.Wgrp + (size_t)(l >> 1) * 1024 * 256), 1024, 256, (ctx_next ? NT : NL) / 256, 4, 512, G, c};
      g8::EpiBf16 E{p.ybuf, 1024};
      g8::gemm_phase(lds, 256, 1024, 256, S, E);
      conv_quota(p, idle_slots(S.nM * S.nN, G, c) * 1, sm);
    } break;
    case PH_FINAL: ph_norm(p, 3, 3, NL, NL, 3, sm); break;
  }
}

__global__ void __launch_bounds__(NTHR) mega_kernel(Params p) {
  extern __shared__ __attribute__((aligned(16))) unsigned char shm[];
  cg::grid_group grid = cg::this_grid();
  volatile LAS unsigned* st = (volatile LAS unsigned*)((LAS unsigned char*)shm + g8::STAGE_BYTES + 1536);
  if (threadIdx.x < 2) st[threadIdx.x] = 0u;
  __syncthreads();
  unsigned* barw;
  { const Params& q = get_params(); barw = q.barw; }
  const XcdBarrier xb = xcd_barrier_post(barw, st);
  const int nprog = p.nprog;
  for (int i = 0; i < nprog; ++i) {
    int ph, l;
    { const Params& q = get_params(); ph = q.prog_ph[i]; l = q.prog_l[i]; }
    run_phase(ph, l, shm);
    if (i + 1 < nprog) { if (nprog > 1000) grid.sync(); else xcd_barrier(xb); }
  }
}

extern "C" void kernel_launch(void* const* d_in, const int* in_sizes, int n_in, void* d_out, int out_size, void* d_ws, size_t ws_size,
                              hipStream_t stream) {
  Params p{};
  const float* const* in = (const float* const*)d_in;
  p.x = in[0]; p.c = in[1]; p.ctx = in[2]; p.c_ctx = in[3]; p.w_mod = in[4]; p.b_mod = in[5]; p.g_norm1 = in[6]; p.g_norm2 = in[7];
  p.w_in_even = in[8]; p.w_out_even = in[9]; p.g_qnorm = in[10]; p.g_knorm = in[11]; p.w_conv = in[12]; p.b_gate = in[13];
  p.g_hnorm = in[14]; p.w_in_odd = in[15]; p.w_pool_grp = in[16]; p.s_pool = in[17]; p.w_router = in[18]; p.w_exp_gate = in[19];
  p.w_exp_up = in[20]; p.w_exp_down = in[21]; p.g_final = in[22];
  p.out = (float*)d_out;
  char* w = (char*)d_ws;
  size_t off = 0;
  auto take = [&](size_t bytes) { char* r = w + off; off += (bytes + 255) & ~(size_t)255; return (void*)r; };
  p.xcur = (bf16_t*)take((size_t)NT * 1024 * 2);
  p.mod = (float*)take(4 * 9 * 6144 * 4);
  p.hbuf = (bf16_t*)take((size_t)NT * 1024 * 2);
  p.Ybuf = (bf16_t*)take((size_t)MOE_T * 1024 * 2);
  p.gatev = (float*)take(MOE_T * 4);
  p.rowidx = (int*)take(MOE_T * 4);
  p.slotmap = (int*)take((size_t)NT * 16 * 4);
  p.barw = (unsigned*)take(XCD_BAR_WORDS * 4);
  p.aff = (float*)take((size_t)NT * 16 * 4);
  p.gates = (float*)take((size_t)NT * 16 * 4);
  p.WinE = (bf16_t*)take((size_t)2 * PROJW * 1024 * 2);
  p.WoutE = (bf16_t*)take((size_t)2 * 1024 * 1024 * 2);
  p.WinO = (bf16_t*)take((size_t)2 * 1024 * 1024 * 2);
  p.Wgrp = (bf16_t*)take((size_t)2 * 1024 * 256 * 2);
  p.Wgu = (bf16_t*)take((size_t)4 * NEXP * 2048 * 1024 * 2);
  p.Wd = (bf16_t*)take((size_t)4 * NEXP * 1024 * 1024 * 2);
  const size_t uoff = off;
  p.proj = (bf16_t*)take((size_t)NT * PROJW * 2);
  p.Qb = (bf16_t*)take((size_t)NT * 512 * 2);
  p.Kb = (bf16_t*)take((size_t)NB * 2 * 2304 * 64 * 2);
  p.Vb = (bf16_t*)take((size_t)NB * 2 * 2304 * 64 * 2);
  p.qm = (bf16_t*)take((size_t)NT * 512 * 2);
  p.km = (bf16_t*)take((size_t)NT * 512 * 2);
  p.gsG = (float*)take((size_t)NT * 8 * 4);
  p.gsR = (float*)take((size_t)NT * 8 * 4);
  p.gsB = (float*)take((size_t)NT * 8 * 4);
  p.cMIN = (float*)take(64 * 18 * 4);
  p.cE1 = (float*)take(64 * 18 * 4);
  p.cDEC = (float*)take(64 * 18 * 4);
  p.cBE = (float*)take(64 * 18 * 4);
  p.cGM = (float*)take(64 * 18 * 4);
  p.Ubuf = (float*)take((size_t)64 * 17 * 16384 * 4);
  p.NLb = (float*)take((size_t)64 * 17 * 128 * 4);
  p.NVb = (float*)take((size_t)64 * 18 * 128 * 4);
  p.Cbf = (bf16_t*)take((size_t)64 * 18 * 16384 * 2);
  p.mix = (bf16_t*)take((size_t)NT * 1024 * 2);
  p.ybuf = (bf16_t*)take((size_t)NT * 1024 * 2);
  const size_t uend = off;
  off = uoff;
  p.Xs = (bf16_t*)take((size_t)MOE_T * 1024 * 2);
  p.Abuf = (bf16_t*)take((size_t)MOE_T * 1024 * 2);
  if (off < uend) off = uend;
  if (off > ws_size) { fprintf(stderr, "ws too small: need %zu have %zu\n", off, ws_size); return; }

  int n = 0;
  auto add = [&](int ph, int l) { p.prog_ph[n] = (unsigned char)ph; p.prog_l[n] = (unsigned char)l; ++n; };
  add(PH_INIT, 0);
  for (int l = 0; l < 4; ++l) {
    add(PH_NORM1, l);
    if ((l & 1) == 0) {
      add(PH_GEMM_IN_EVEN, l); add(PH_POST_EVEN, l); add(PH_ATT, l); add(PH_MLSTM_H, l); add(PH_GEMM_OUT, l);
    } else {
      add(PH_GEMM_IN_ODD, l); add(PH_POOL, l); add(PH_GEMM_GRP, l);
    }
    add(PH_NORM2, l); add(PH_TOPK, l); add(PH_MOE_GU, l); add(PH_MOE_D, l);
  }
  add(PH_FINAL, 0);
  p.nprog = n;

  const int LDS = 143360;
  static int grid_blocks = 0;
  if (!grid_blocks) {
    (void)hipFuncSetAttribute((const void*)mega_kernel, hipFuncAttributeMaxDynamicSharedMemorySize, LDS);
    int dev = 0, cus = 0, per_cu = 0;
    (void)hipGetDevice(&dev);
    (void)hipDeviceGetAttribute(&cus, hipDeviceAttributeMultiprocessorCount, dev);
    (void)hipOccupancyMaxActiveBlocksPerMultiprocessor(&per_cu, mega_kernel, NTHR, LDS);
    if (per_cu < 1) per_cu = 1;
    if (per_cu > 1) per_cu = 1;
    grid_blocks = cus * per_cu;
  }
  (void)hipMemsetAsync(p.barw, 0, XCD_BAR_WORDS * 4, stream);
  void* args[] = {&p};
  hipError_t e = hipLaunchCooperativeKernel((void*)mega_kernel, dim3(grid_blocks), dim3(NTHR), args, LDS, stream);
  if (e != hipSuccess) fprintf(stderr, "cooperative launch failed: %s (grid %d)\n", hipGetErrorString(e), grid_blocks);
}
```

```cpp
#include <hip/hip_runtime.h>
#include <hip/hip_cooperative_groups.h>
#include <math.h>
#include <stdio.h>
namespace cg = cooperative_groups;

#define DM 1024
#define NB 8
#define SEQ 2048
#define CTXL 256
#define NL (NB * SEQ)
#define NC (NB * CTXL)
#define NT (NL + NC)
#define EVEN_IN 2832
#define PROJW 2816
#define NEXP 16
#define MOE_L (NEXP * NB * 256)
#define MOE_C (NEXP * NB * 32)
#define MOE_T (MOE_L + MOE_C)
#define EPS 1e-6f
#define NTHR 512
#define LAS __attribute__((address_space(3)))

typedef unsigned short bf16_t;
typedef short bf16x8 __attribute__((ext_vector_type(8)));
typedef float f32x4 __attribute__((ext_vector_type(4)));
typedef unsigned u32x4 __attribute__((ext_vector_type(4)));
typedef unsigned u32x2 __attribute__((ext_vector_type(2)));

struct Params {
  const float *x, *c, *ctx, *c_ctx, *w_mod, *b_mod, *g_norm1, *g_norm2, *w_in_even, *w_out_even, *g_qnorm, *g_knorm,
      *w_conv, *b_gate, *g_hnorm, *w_in_odd, *w_pool_grp, *s_pool, *w_router, *w_exp_gate, *w_exp_up, *w_exp_down, *g_final;
  float* out;
  bf16_t* xcur;
  float *mod, *gates, *aff, *gatev, *gsG, *gsR, *gsB, *cMIN, *cE1, *cDEC, *cBE, *cGM, *Ubuf, *NLb, *NVb;
  bf16_t *hbuf, *proj, *mix, *Xs, *Abuf, *Ybuf, *Qb, *Kb, *Vb, *qm, *km, *Cbf, *ybuf;
  bf16_t *WinE, *WoutE, *WinO, *Wgrp, *Wgu, *Wd;
  int *rowidx, *slotmap;
  unsigned* barw;
  int nprog;
  unsigned char prog_ph[60], prog_l[60];
};

__device__ __forceinline__ float siluf(float v) { return v / (1.f + expf(-v)); }
__device__ __forceinline__ float sigmoidf_(float v) { return 1.f / (1.f + expf(-v)); }
__device__ __forceinline__ float logsigmoidf_(float v) { return fminf(v, 0.f) - __logf(1.f + __expf(-fabsf(v))); }
__device__ __forceinline__ float wave_sum(float v) {
#pragma unroll
  for (int o = 32; o > 0; o >>= 1) v += __shfl_xor(v, o);
  return v;
}
#define LDS_BARRIER() do { asm volatile("s_waitcnt lgkmcnt(0)" ::: "memory"); __builtin_amdgcn_s_barrier(); asm volatile("" ::: "memory"); } while (0)
__device__ __forceinline__ int modrow(int r) { return r < NL ? (r >> 11) : 8; }
__device__ __forceinline__ float bf2f(bf16_t v) { return __uint_as_float(((unsigned)v) << 16); }
typedef float f32x2_t __attribute__((ext_vector_type(2)));
typedef __bf16 bf16x2_t __attribute__((ext_vector_type(2)));
__device__ __forceinline__ unsigned cvt_pk_bf16(float lo, float hi) {
  const f32x2_t v = {lo, hi};
  return __builtin_bit_cast(unsigned, __builtin_convertvector(v, bf16x2_t));
}
__device__ __forceinline__ bf16_t f2bf(float f) { return (bf16_t)(cvt_pk_bf16(f, 0.f) & 0xffffu); }
__device__ __forceinline__ void unpack8(const u32x4 w, float (&f)[8]) {
  f[0] = __uint_as_float(w.x << 16); f[1] = __uint_as_float(w.x & 0xffff0000u); f[2] = __uint_as_float(w.y << 16); f[3] = __uint_as_float(w.y & 0xffff0000u);
  f[4] = __uint_as_float(w.z << 16); f[5] = __uint_as_float(w.z & 0xffff0000u); f[6] = __uint_as_float(w.w << 16); f[7] = __uint_as_float(w.w & 0xffff0000u);
}
__device__ __forceinline__ u32x4 pack8(const float (&f)[8]) {
  u32x4 w; w.x = cvt_pk_bf16(f[0], f[1]); w.y = cvt_pk_bf16(f[2], f[3]); w.z = cvt_pk_bf16(f[4], f[5]); w.w = cvt_pk_bf16(f[6], f[7]);
  return w;
}

__device__ __forceinline__ int ltid() { int t = threadIdx.x; asm volatile("" : "+v"(t)); return t; }
__device__ __forceinline__ int lbid() { int b = blockIdx.x; asm volatile("" : "+s"(b)); return b; }
__device__ __forceinline__ int lgdim() { int g = gridDim.x; asm volatile("" : "+s"(g)); return g; }

#define XB_TMO      128
#define XB_XCNT(j)  (256  + 64 * (j))
#define XB_XSUB(j)  (1280 + 64 * (j))
#define XB_XGEN(j)  (2304 + 64 * (j))
#define XB_TOP      3328
#define XB_TOPGEN   3392
#define XCD_BAR_WORDS 3456
#define XB_SPIN_CAP (1u << 18)
__device__ __forceinline__ unsigned xb_ld(unsigned* p)              { return __hip_atomic_load(p, __ATOMIC_RELAXED, __HIP_MEMORY_SCOPE_AGENT); }
__device__ __forceinline__ unsigned xb_add(unsigned* p, unsigned v) { return __hip_atomic_fetch_add(p, v, __ATOMIC_RELAXED, __HIP_MEMORY_SCOPE_AGENT); }
__device__ __forceinline__ unsigned xb_xcc_id() { return (unsigned)__builtin_amdgcn_s_getreg((3 << 11) | 20) & 0xFu; }
#define XB_SPIN(cond, bar) do { unsigned _sp = 0; while (cond) { __builtin_amdgcn_s_sleep(1); \
    if ((++_sp & 255u) == 0u) { if (xb_ld(&(bar)[XB_TMO])) break; if (_sp > XB_SPIN_CAP) { atomicAdd(&(bar)[XB_TMO], 1u); break; } } } } while (0)
struct XcdBarrier { unsigned* bar; unsigned x; volatile LAS unsigned* st; };
__device__ __forceinline__ XcdBarrier xcd_barrier_post(unsigned* bar, volatile LAS unsigned* st) {
  XcdBarrier b; b.bar = bar; b.x = xb_xcc_id(); b.st = st;
  if (threadIdx.x == 0) (void)xb_add(&bar[XB_XCNT(b.x)], 1u);
  return b;
}
__device__ __forceinline__ void xcd_barrier_complete(unsigned* bar, unsigned x, unsigned& nloc, unsigned& nx) {
  const unsigned G = gridDim.x * gridDim.y * gridDim.z;
  unsigned sum, cnt, mine, sp = 0u;
  for (;;) {
    sum = 0u; cnt = 0u; mine = 0u;
#pragma unroll
    for (unsigned j = 0; j < 16; ++j) { const unsigned c = xb_ld(&bar[XB_XCNT(j)]); sum += c; cnt += (c > 0u) ? 1u : 0u; mine = (j == x) ? c : mine; }
    if (sum == G) break;
    __builtin_amdgcn_s_sleep(1);
    if ((++sp & 255u) == 0u) { if (xb_ld(&bar[XB_TMO])) break; if (sp > XB_SPIN_CAP) { atomicAdd(&bar[XB_TMO], 1u); break; } }
  }
  nloc = mine > 0u ? mine : 1u; nx = cnt > 0u ? cnt : 1u;
}
__device__ __forceinline__ void xcd_barrier(const XcdBarrier& b) {
  asm volatile("s_waitcnt vmcnt(0)" ::: "memory");
  __syncthreads();
  if (threadIdx.x == 0) {
    unsigned* bar = b.bar;
    __builtin_amdgcn_s_waitcnt(0);
    unsigned nloc = b.st[0], nx = b.st[1];
    if (nloc == 0u) { xcd_barrier_complete(bar, b.x, nloc, nx); b.st[0] = nloc; b.st[1] = nx; }
    const unsigned old = xb_add(&bar[XB_XSUB(b.x)], 1u);
    const unsigned gen = old / nloc;
    if (old + 1u == (gen + 1u) * nloc) {
      __builtin_amdgcn_fence(__ATOMIC_RELEASE, "agent");
      asm volatile("s_waitcnt vmcnt(0)" ::: "memory");
      const unsigned og = xb_add(&bar[XB_TOP], 1u);
      const unsigned tg = og / nx;
      if (og + 1u == (tg + 1u) * nx) xb_add(&bar[XB_TOPGEN], 1u);
      else XB_SPIN(xb_ld(&bar[XB_TOPGEN]) == tg, bar);
      __builtin_amdgcn_fence(__ATOMIC_ACQUIRE, "agent");
      xb_add(&bar[XB_XGEN(b.x)], 1u);
      asm volatile("s_waitcnt vmcnt(0)" ::: "memory");
    } else {
      XB_SPIN(xb_ld(&bar[XB_XGEN(b.x)]) == gen, bar);
      __builtin_amdgcn_fence(__ATOMIC_ACQUIRE, "agent");
      asm volatile("s_waitcnt vmcnt(0)" ::: "memory");
    }
  }
  __syncthreads();
}

namespace g8 {
constexpr int BM = 256, BK = 64, HALF = 128, HTB = HALF * BK * 2, STAGE_BYTES = 8 * HTB;
__device__ __forceinline__ int lds_byte(int r, int c) { const int st = (r >> 4) * 2 + (c >> 5), rr = r & 15, cc = c & 31, ob = rr * 64 + cc * 2; return st * 1024 + (ob ^ (((ob >> 9) & 1) << 5)); }
__device__ __forceinline__ void stage_rc(int b, int& R, int& C) { const int st = b / 1024, sb = b % 1024, swz = sb ^ (((sb >> 9) & 1) << 5); R = (st >> 1) * 16 + swz / 64; C = (st & 1) * 32 + (swz % 64) / 2; }
__device__ __forceinline__ int perm32(int rho) { const int n = rho >> 4, i = rho & 15; return 8 * (i >> 2) + 4 * n + (i & 3); }

struct Unit { const char* A; const char* B; int row0, col0; };

template <bool GATHER = false, class Epi, class Sched>
__device__ __forceinline__ void gemm_phase(LAS unsigned char* lds, const int K, const int lda, const int ldb, const Sched& S, const Epi& E, const int* gidx = nullptr, const char* gbaseA = nullptr) {
  const int tid = ltid(), wid = __builtin_amdgcn_readfirstlane(tid >> 6), lane = tid & 63, wr = wid >> 2, wc = wid & 3, fr = lane & 15, fq = lane >> 4;
  const int nt = K / BK;
  unsigned voffA[2], voffB[2], gC2[2];
  int gR[2];
#pragma unroll
  for (int i = 0; i < 2; ++i) {
    int R, C;
    stage_rc(tid * 16 + i * 8192, R, C);
    const int Rb = (R & ~31) + perm32(R & 31);
    voffA[i] = (unsigned)(R * lda + C) * 2u;
    voffB[i] = (unsigned)(Rb * ldb + C) * 2u;
    gR[i] = R; gC2[i] = (unsigned)C * 2u;
  }
  unsigned gcur[2][2], gnxt[2][2];
  auto gload = [&](int row0, unsigned (&g)[2][2]) {
#pragma unroll
    for (int h = 0; h < 2; ++h)
#pragma unroll
      for (int i = 0; i < 2; ++i) g[h][i] = (unsigned)gidx[row0 + h * HALF + gR[i]];
  };
  const size_t kstep = (size_t)(BK * 2);
  const size_t hstepA = (size_t)HALF * lda * 2, hstepB = (size_t)HALF * ldb * 2;
  const unsigned ldsw = (unsigned)wid * 1024u;
  const int aoff = lds_byte(wr * 64 + fr, fq * 8), boff = lds_byte(wc * 32 + fr, fq * 8);
#define PG8_SA(b, h) (((b) * 2 + (h)) * HTB)
#define PG8_SB(b, h) ((4 + (b) * 2 + (h)) * HTB)
#define PG8_STAGE(bufoff, gbase, voff) do { _Pragma("unroll") for (int _i = 0; _i < 2; ++_i) \
    __builtin_amdgcn_global_load_lds((const unsigned*)((const char*)(gbase) + (voff)[_i]), (LAS unsigned*)(lds + (bufoff) + ldsw + _i * 8192), 16, 0, 0); } while (0)
#define PG8_LDA(dst, b, h) do { _Pragma("unroll") for (int m = 0; m < 4; ++m) _Pragma("unroll") for (int k = 0; k < 2; ++k) dst[m][k] = *(const LAS bf16x8*)(lds + PG8_SA(b, h) + aoff + m * 2048 + k * 1024); } while (0)
#define PG8_LDB(dst, b, h) do { _Pragma("unroll") for (int n = 0; n < 2; ++n) _Pragma("unroll") for (int k = 0; k < 2; ++k) dst[n][k] = *(const LAS bf16x8*)(lds + PG8_SB(b, h) + boff + n * 2048 + k * 1024); } while (0)
#define PG8_MMA(ai, bj, At, Bt) do { __builtin_amdgcn_s_setprio(1); _Pragma("unroll") for (int m = 0; m < 4; ++m) _Pragma("unroll") for (int n = 0; n < 2; ++n) _Pragma("unroll") for (int k = 0; k < 2; ++k) \
    acc[ai][bj][m][n] = __builtin_amdgcn_mfma_f32_16x16x32_bf16(Bt[n][k], At[m][k], acc[ai][bj][m][n], 0, 0, 0); __builtin_amdgcn_s_setprio(0); } while (0)
#define PG8_WAIT_V(n) asm volatile("s_waitcnt vmcnt(" #n ")" ::: "memory")
#define PG8_WAIT_L(n) asm volatile("s_waitcnt lgkmcnt(" #n ")" ::: "memory")
#define PG8_BAR __builtin_amdgcn_s_barrier()
#define PG8_SCHED __builtin_amdgcn_sched_barrier(0)
#define PG8_STAGE_A(bufoff, nextu, half, kbytes) do { \
    if constexpr (GATHER) { unsigned go_[2]; _Pragma("unroll") for (int _j = 0; _j < 2; ++_j) go_[_j] = ((nextu) ? gnxt[half][_j] : gcur[half][_j]) * (unsigned)(lda * 2) + gC2[_j]; \
      PG8_STAGE(bufoff, gbaseA + (kbytes), go_); } \
    else { PG8_STAGE(bufoff, ((nextu) ? nA : cA) + (half) * hstepA + (kbytes), voffA); } } while (0)
  Unit cur, nxt;
  int ui = 0;
  if (!S.next(0, cur)) return;
  f32x4 acc[2][2][4][2];
#pragma unroll
  for (int a = 0; a < 2; ++a)
#pragma unroll
    for (int b = 0; b < 2; ++b)
#pragma unroll
      for (int m = 0; m < 4; ++m)
#pragma unroll
        for (int n = 0; n < 2; ++n) acc[a][b][m][n] = (f32x4){0.f, 0.f, 0.f, 0.f};
  bf16x8 At[4][2], B0[2][2], B1[2][2];
  const char* cA = cur.A;
  const char* cB = cur.B;
  const char* nA = cA;
  if constexpr (GATHER) { gload(cur.row0, gcur); gload(cur.row0, gnxt); asm volatile("s_waitcnt vmcnt(0)" ::: "memory"); }
  PG8_STAGE(PG8_SB(0, 0), cB, voffB); PG8_STAGE(PG8_SB(0, 1), cB + hstepB, voffB); PG8_STAGE_A(PG8_SA(0, 0), false, 0, 0); PG8_STAGE_A(PG8_SA(0, 1), false, 1, 0);
  if (wr == 1) PG8_BAR;
  PG8_WAIT_V(2); PG8_BAR;
  PG8_STAGE(PG8_SB(1, 0), cB + kstep, voffB); PG8_STAGE_A(PG8_SA(1, 0), false, 0, kstep); PG8_STAGE(PG8_SB(1, 1), cB + hstepB + kstep, voffB);
  PG8_WAIT_V(6); PG8_BAR;
  for (;;) {
    const bool has_next = S.next(ui + 1, nxt);
    nA = has_next ? nxt.A : cA;
    const char* nB = has_next ? nxt.B : cB;
    if constexpr (GATHER) { if (has_next) gload(nxt.row0, gnxt); else {
#pragma unroll
      for (int h = 0; h < 2; ++h)
#pragma unroll
        for (int i = 0; i < 2; ++i) gnxt[h][i] = gcur[h][i]; } }
    for (int t = 0; t < nt; t += 2) {
      const bool last = (t == nt - 2);
      const size_t k1 = (size_t)(t + 1) * kstep;
      const size_t k2 = last ? 0 : (size_t)(t + 2) * kstep;
      const size_t k3 = k2 + kstep;
      const char* b2 = last ? nB : cB + (size_t)(t + 2) * kstep;
      const char* b3 = b2 + kstep;
      PG8_LDB(B0, 0, 0); PG8_LDB(B1, 0, 1); PG8_SCHED; PG8_LDA(At, 0, 0); PG8_STAGE_A(PG8_SA(1, 1), false, 1, k1);
      PG8_WAIT_V(8); PG8_WAIT_L(0); PG8_BAR; PG8_MMA(0, 0, At, B0); PG8_MMA(0, 1, At, B1); PG8_BAR; PG8_SCHED;
      PG8_LDA(At, 0, 1); PG8_STAGE(PG8_SB(0, 0), b2, voffB); PG8_STAGE(PG8_SB(0, 1), b2 + hstepB, voffB); PG8_STAGE_A(PG8_SA(0, 0), last, 0, k2);
      PG8_WAIT_V(8); PG8_WAIT_L(0); PG8_BAR; PG8_MMA(1, 0, At, B0); PG8_MMA(1, 1, At, B1); PG8_BAR; PG8_SCHED;
      PG8_LDB(B0, 1, 0); PG8_LDB(B1, 1, 1); PG8_SCHED; PG8_LDA(At, 1, 0); PG8_STAGE_A(PG8_SA(0, 1), last, 1, k2);
      PG8_WAIT_V(8); PG8_WAIT_L(0); PG8_BAR; PG8_MMA(0, 0, At, B0); PG8_MMA(0, 1, At, B1); PG8_BAR; PG8_SCHED;
      PG8_LDA(At, 1, 1); PG8_STAGE(PG8_SB(1, 0), b3, voffB); PG8_STAGE(PG8_SB(1, 1), b3 + hstepB, voffB); PG8_STAGE_A(PG8_SA(1, 0), last, 0, k3);
      PG8_WAIT_V(8); PG8_WAIT_L(0); PG8_BAR; PG8_MMA(1, 0, At, B0); PG8_MMA(1, 1, At, B1); PG8_BAR; PG8_SCHED;
    }
    if (wr == 0) PG8_BAR;
    E(acc, cur, wr, wc, fr, fq);
    if (!has_next) break;
#pragma unroll
    for (int a = 0; a < 2; ++a)
#pragma unroll
      for (int b = 0; b < 2; ++b)
#pragma unroll
        for (int m = 0; m < 4; ++m)
#pragma unroll
          for (int n = 0; n < 2; ++n) acc[a][b][m][n] = (f32x4){0.f, 0.f, 0.f, 0.f};
    cur = nxt; cA = nA; cB = nB; ++ui;
    if constexpr (GATHER) {
#pragma unroll
      for (int h = 0; h < 2; ++h)
#pragma unroll
        for (int i = 0; i < 2; ++i) gcur[h][i] = gnxt[h][i];
    }
    if (wr == 1) PG8_BAR;
  }
  PG8_WAIT_V(0);
  PG8_BAR;
#undef PG8_SA
#undef PG8_SB
#undef PG8_STAGE
#undef PG8_STAGE_A
#undef PG8_LDA
#undef PG8_LDB
#undef PG8_MMA
#undef PG8_WAIT_V
#undef PG8_WAIT_L
#undef PG8_BAR
#undef PG8_SCHED
}

struct SchedDense {
  const char* A; const char* B; int lda, ldb, nM, nN, acolstep, G, c;
  __device__ __forceinline__ bool next(int i, Unit& u) const {
    const int nwg = nM * nN;
    const long L = (long)i * G + c;
    if (L >= nwg) return false;
    int wgid = (int)L;
    { const int q = nwg / 8, r = nwg % 8, xcd = wgid % 8, off = wgid / 8; wgid = (xcd < r ? xcd * (q + 1) : r * (q + 1) + (xcd - r) * q) + off; }
    const int nig = 8 * nN, gid = wgid / nig, fm = gid * 8, gsz = (nM - fm) < 8 ? (nM - fm) : 8;
    const int pm = fm + ((wgid % nig) % gsz), pn = (wgid % nig) / gsz;
    u.A = A + (size_t)pm * 256 * lda * 2 + (size_t)pn * acolstep;
    u.B = B + (size_t)pn * 256 * ldb * 2;
    u.row0 = pm * 256; u.col0 = pn * 256;
    return true;
  }
};
struct SchedMoe {
  const char* A; const char* W; int ncol, wrows, colw, nu, G, c;
  __device__ __forceinline__ bool next(int i, Unit& u) const {
    const long L = (long)i * G + c;
    if (L >= nu) return false;
    const int wgid = (int)(L % 8) * (nu / 8) + (int)(L / 8);
    const int UL = 128 * ncol;
    int e, pn, row0;
    if (wgid < UL) { e = wgid / (8 * ncol); const int rem = wgid % (8 * ncol); row0 = e * 2048 + (rem % 8) * 256; pn = rem / 8; }
    else { const int w2 = wgid - UL; e = w2 / ncol; pn = w2 % ncol; row0 = MOE_L + e * 256; }
    u.A = A + (size_t)row0 * 1024 * 2;
    u.B = W + ((size_t)e * wrows + (size_t)pn * 256) * 1024 * 2;
    u.row0 = row0; u.col0 = pn * colw;
    return true;
  }
};

struct EpiBf16 {
  bf16_t* O; int ldo;
  __device__ __forceinline__ void operator()(const f32x4 (&acc)[2][2][4][2], const Unit& u, int wr, int wc, int fr, int fq) const {
#pragma unroll
    for (int ai = 0; ai < 2; ++ai)
#pragma unroll
      for (int m = 0; m < 4; ++m) {
        const int row = u.row0 + ai * 128 + wr * 64 + m * 16 + fr;
        bf16_t* rp = O + (size_t)row * ldo + u.col0 + wc * 32 + 8 * fq;
#pragma unroll
        for (int bj = 0; bj < 2; ++bj) {
          const f32x4 v0 = acc[ai][bj][m][0], v1 = acc[ai][bj][m][1];
          u32x4 w; w.x = cvt_pk_bf16(v0[0], v0[1]); w.y = cvt_pk_bf16(v0[2], v0[3]); w.z = cvt_pk_bf16(v1[0], v1[1]); w.w = cvt_pk_bf16(v1[2], v1[3]);
          *(u32x4*)(rp + bj * 128) = w;
        }
      }
  }
};
struct EpiResid {
  float* x; const float* modg; const float* cs; const float* xl; const float* xc;
  __device__ __forceinline__ void operator()(const f32x4 (&acc)[2][2][4][2], const Unit& u, int wr, int wc, int fr, int fq) const {
#pragma unroll
    for (int ai = 0; ai < 2; ++ai)
#pragma unroll
      for (int m = 0; m < 4; ++m) {
        const int row = u.row0 + ai * 128 + wr * 64 + m * 16 + fr;
        const int c0 = u.col0 + wc * 32 + 8 * fq;
        float* xp = x + (size_t)row * 1024 + c0;
        const float* xi = xl ? (row < NL ? xl + (size_t)row * 1024 + c0 : xc + (size_t)(row - NL) * 1024 + c0) : xp;
        const float* gp = modg + (size_t)modrow(row) * 6144 + c0;
#pragma unroll
        for (int bj = 0; bj < 2; ++bj) {
          f32x4 g0 = *(const f32x4*)(gp + bj * 128), g1 = *(const f32x4*)(gp + bj * 128 + 4);
          if (cs) { g0 *= *(const f32x4*)(cs + c0 + bj * 128); g1 *= *(const f32x4*)(cs + c0 + bj * 128 + 4); }
          f32x4 x0 = *(const f32x4*)(xi + bj * 128), x1 = *(const f32x4*)(xi + bj * 128 + 4);
          x0 += g0 * acc[ai][bj][m][0]; x1 += g1 * acc[ai][bj][m][1];
          *(f32x4*)(xp + bj * 128) = x0; *(f32x4*)(xp + bj * 128 + 4) = x1;
        }
      }
  }
};
struct EpiSwiGLU {
  bf16_t* O;
  __device__ __forceinline__ void operator()(const f32x4 (&acc)[2][2][4][2], const Unit& u, int wr, int wc, int fr, int fq) const {
#pragma unroll
    for (int ai = 0; ai < 2; ++ai)
#pragma unroll
      for (int m = 0; m < 4; ++m) {
        const int row = u.row0 + ai * 128 + wr * 64 + m * 16 + fr;
        bf16_t* rp = O + (size_t)row * 1024 + u.col0 + wc * 32 + 8 * fq;
        float o[8];
#pragma unroll
        for (int n = 0; n < 2; ++n)
#pragma unroll
          for (int j = 0; j < 4; ++j) { const float g = acc[ai][0][m][n][j], up = acc[ai][1][m][n][j]; o[n * 4 + j] = g / (1.f + __expf(-g)) * up; }
        u32x4 w; w.x = cvt_pk_bf16(o[0], o[1]); w.y = cvt_pk_bf16(o[2], o[3]); w.z = cvt_pk_bf16(o[4], o[5]); w.w = cvt_pk_bf16(o[6], o[7]);
        *(u32x4*)rp = w;
      }
  }
};
struct EpiDown {
  bf16_t* O; const float* gatev;
  __device__ __forceinline__ void operator()(const f32x4 (&acc)[2][2][4][2], const Unit& u, int wr, int wc, int fr, int fq) const {
    float gv[2][4];
#pragma unroll
    for (int ai = 0; ai < 2; ++ai)
#pragma unroll
      for (int m = 0; m < 4; ++m) gv[ai][m] = gatev[u.row0 + ai * 128 + wr * 64 + m * 16 + fr];
    __builtin_amdgcn_sched_barrier(0);
#pragma unroll
    for (int ai = 0; ai < 2; ++ai)
#pragma unroll
      for (int m = 0; m < 4; ++m) {
        const int row = u.row0 + ai * 128 + wr * 64 + m * 16 + fr;
        bf16_t* rp = O + (size_t)row * 1024 + u.col0 + wc * 32 + 8 * fq;
#pragma unroll
        for (int bj = 0; bj < 2; ++bj) {
          const f32x4 v0 = acc[ai][bj][m][0] * gv[ai][m], v1 = acc[ai][bj][m][1] * gv[ai][m];
          u32x4 w; w.x = cvt_pk_bf16(v0[0], v0[1]); w.y = cvt_pk_bf16(v0[2], v0[3]); w.z = cvt_pk_bf16(v1[0], v1[1]); w.w = cvt_pk_bf16(v1[2], v1[3]);
          *(u32x4*)(rp + bj * 128) = w;
        }
      }
  }
};
}

#define NT_WINE 1408
#define NT_WOUT 512
#define NT_WINO 512
#define NT_WGRP 128
#define NT_EXP 16384
#define NT_ALL (NT_WINE + NT_WOUT + NT_WINO + NT_WGRP + 3 * NT_EXP)
#define CE0 704
#define CE1 960
#define CE2 13248
#define CE3 13504
#define CE4 13568
#define CE5 25856
#define CE6 26560
#define CE7 26816
#define CE8 39104
#define CE9 39360
#define CE10 39424
#define CE11 51712
__device__ __forceinline__ void conv_batch(const Params& p, int t, float* T) {
  const int tid = ltid(), lane = tid & 63, wv = tid >> 6;
  const float* src; bf16_t* dst; int ld, dK, k0, n0;
  int seg, tb, e, which = 0;
  if (t < CE0) { seg = 0; e = 0; tb = t; } else if (t < CE1) { seg = 1; e = 0; tb = t - CE0; } else if (t < CE2) { seg = 2; e = 0; tb = t - CE1; }
  else if (t < CE3) { seg = 3; e = 0; tb = t - CE2; } else if (t < CE4) { seg = 4; e = 0; tb = t - CE3; } else if (t < CE5) { seg = 2; e = 1; tb = t - CE4; }
  else if (t < CE6) { seg = 0; e = 1; tb = t - CE5; } else if (t < CE7) { seg = 1; e = 1; tb = t - CE6; } else if (t < CE8) { seg = 2; e = 2; tb = t - CE7; }
  else if (t < CE9) { seg = 3; e = 1; tb = t - CE8; } else if (t < CE10) { seg = 4; e = 1; tb = t - CE9; } else { seg = 2; e = 3; tb = t - CE10; }
  int dbase = 0;
  if (seg == 0) {
    k0 = (tb / 44) * 64; n0 = (tb % 44) * 64;
    src = p.w_in_even + (size_t)e * 1024 * EVEN_IN; ld = EVEN_IN; dst = p.WinE + (size_t)e * PROJW * 1024; dK = 1024;
  } else if (seg == 1 || seg == 3) {
    k0 = (tb / 16) * 64; n0 = (tb % 16) * 64;
    src = (seg == 3 ? p.w_in_odd : p.w_out_even) + (size_t)e * 1024 * 1024; ld = 1024; dst = (seg == 3 ? p.WinO : p.WoutE) + (size_t)e * 1024 * 1024; dK = 1024;
  } else if (seg == 4) {
    const int g = tb / 16; k0 = ((tb % 16) / 4) * 64; n0 = (tb % 4) * 64;
    src = p.w_pool_grp + (size_t)(e * 4 + g) * 65536; ld = 256; dst = p.Wgrp + (size_t)e * 1024 * 256; dK = 256; dbase = g * 256;
  } else {
    which = tb / 4096; const int r = tb % 4096, le = e * 16 + r / 256; k0 = ((r % 256) / 16) * 64; n0 = (r % 16) * 64;
    const float* base = which == 0 ? p.w_exp_gate : (which == 1 ? p.w_exp_up : p.w_exp_down);
    src = base + (size_t)le * 1024 * 1024; ld = 1024; dK = 1024;
    dst = which < 2 ? p.Wgu + (size_t)le * 2048 * 1024 : p.Wd + (size_t)le * 1024 * 1024;
  }
  const bool gu = (seg == 2 && which < 2);
  float4 v[8];
#pragma unroll
  for (int q = 0; q < 8; ++q) {
    const int idx = tid + q * NTHR, k = idx >> 6, c4 = idx & 63;
    v[q] = *(const float4*)(src + (size_t)(k0 + k) * ld + n0 + c4 * 4);
  }
  __builtin_amdgcn_sched_barrier(0);
#pragma unroll
  for (int q = 0; q < 8; ++q) {
    const int idx = tid + q * NTHR, k = idx >> 6, c4 = idx & 63;
    float* tp = T + k * 257 + c4 * 4;
    tp[0] = v[q].x; tp[1] = v[q].y; tp[2] = v[q].z; tp[3] = v[q].w;
  }
  __syncthreads();
#pragma unroll
  for (int sub = 0; sub < 4; ++sub) {
    const int nl = wv * 8 + (lane >> 3), kq = lane & 7, nn = n0 + sub * 64;
    const int drow0 = gu ? (nn >> 7) * 256 + which * 128 + (nn & 127) : dbase + nn;
    float f[8];
#pragma unroll
    for (int j = 0; j < 8; ++j) f[j] = T[(kq * 8 + j) * 257 + sub * 64 + nl];
    u32x4 w; w.x = cvt_pk_bf16(f[0], f[1]); w.y = cvt_pk_bf16(f[2], f[3]); w.z = cvt_pk_bf16(f[4], f[5]); w.w = cvt_pk_bf16(f[6], f[7]);
    *(u32x4*)(dst + (size_t)(drow0 + nl) * dK + k0 + kq * 8) = w;
  }
}
__device__ __forceinline__ int conv_pull(const Params& p, float* sm) {
  __syncthreads();
  if (ltid() == 0) ((int*)sm)[16500] = (int)__hip_atomic_fetch_add(p.barw, 4u, __ATOMIC_RELAXED, __HIP_MEMORY_SCOPE_AGENT);
  __syncthreads();
  return ((int*)sm)[16500];
}
__device__ __forceinline__ void conv_until(const Params& p, int end, float* sm) {
  int t;
  do { t = conv_pull(p, sm); if (t < CE11) conv_batch(p, t, sm); } while (t + 4 < end);
  __syncthreads();
}
__device__ __forceinline__ void conv_quota(const Params& p, int n, float* sm) {
  for (int i = 0; i < n; ++i) { const int t = conv_pull(p, sm); if (t >= CE11) break; conv_batch(p, t, sm); }
  __syncthreads();
}

__device__ __forceinline__ void ph_init(const Params& p, float* sm) {
  const int tid = ltid(), lane = tid & 63, wv = tid >> 6;
  const size_t gtid = (size_t)lbid() * NTHR + tid, gsz = (size_t)lgdim() * NTHR;
  for (int i = tid; i < 9 * 1024; i += NTHR) {
    const int r = i >> 10, k = i & 1023;
    sm[i] = siluf(r < 8 ? p.c[r * 1024 + k] : p.c_ctx[k]);
  }
  __syncthreads();
  float* part = sm + 9 * 1024;
  for (int item = lbid(); item < 768; item += lgdim()) {
    const int l = item / 192, j0 = (item % 192) * 32;
    const int col = lane & 31, kh = lane >> 5;
    const float* w = p.w_mod + (size_t)l * 1024 * 6144 + j0 + col;
    float acc[9];
#pragma unroll
    for (int r = 0; r < 9; ++r) acc[r] = 0.f;
    const int kb = wv * 128 + kh * 64;
    for (int k0 = 0; k0 < 64; k0 += 16) {
      float wv16[16];
#pragma unroll
      for (int kk = 0; kk < 16; ++kk) wv16[kk] = w[(size_t)(kb + k0 + kk) * 6144];
      __builtin_amdgcn_sched_barrier(0);
#pragma unroll
      for (int kk = 0; kk < 16; ++kk)
#pragma unroll
        for (int r = 0; r < 9; ++r) acc[r] += sm[r * 1024 + kb + k0 + kk] * wv16[kk];
    }
#pragma unroll
    for (int r = 0; r < 9; ++r) part[((wv * 2 + kh) * 9 + r) * 32 + col] = acc[r];
    __syncthreads();
    if (tid < 288) {
      const int r = tid >> 5, cc = tid & 31;
      float s = 0.f;
#pragma unroll
      for (int sl = 0; sl < 16; ++sl) s += part[(sl * 9 + r) * 32 + cc];
      p.mod[(size_t)(l * 9 + r) * 6144 + j0 + cc] = s + p.b_mod[l * 6144 + j0 + cc];
    }
    __syncthreads();
  }
  conv_until(p, CE1, sm);
}

typedef float f32x4m __attribute__((ext_vector_type(4)));
__device__ __forceinline__ void ph_norm(const Params& p, int l, int which, int nrows, int ncomb, int lprev, float* sm) {
  const int tid = ltid(), lane = tid & 63, wv = tid >> 6;
  const bool skinny = (which == 2) || (which == 1 && (l & 1) == 0);
  bf16_t* HROW0 = (bf16_t*)sm;
  float* PART0 = sm + 16384;
  bf16x8 Bhi[4], Blo[4];
  if (skinny) {
    const float* wbase; int stride;
    if (which == 2) { wbase = p.w_router + (size_t)l * 1024 * 16; stride = 16; }
    else { wbase = p.w_in_even + (size_t)(l >> 1) * 1024 * EVEN_IN + PROJW; stride = EVEN_IN; }
    const int kg = lane >> 4, n = lane & 15;
#pragma unroll
    for (int ks = 0; ks < 4; ++ks) {
      float f[8], hi[8], lo[8];
#pragma unroll
      for (int j = 0; j < 8; ++j) f[j] = wbase[(size_t)(wv * 128 + ks * 32 + kg * 8 + j) * stride + n];
      const u32x4 hw = pack8(f);
      unpack8(hw, hi);
#pragma unroll
      for (int j = 0; j < 8; ++j) lo[j] = f[j] - hi[j];
      Bhi[ks] = __builtin_bit_cast(bf16x8, hw);
      Blo[ks] = __builtin_bit_cast(bf16x8, pack8(lo));
    }
  }
  const int nwaves = lgdim() * (NTHR / 64), gw = lbid() * (NTHR / 64) + wv;
  const int per = (nrows + nwaves - 1) / nwaves;
  const int rbeg = gw * per, rend = min(nrows, rbeg + per);
  const bool in0 = (l == 0) && (which == 1 || which == 2);
  float4 vn[4];
  u32x2 xnb[4];
  int slvn = -1;
  {
    const int r0 = min(rbeg, nrows - 1);
    if (in0) {
      const float* xs0 = r0 < NL ? p.x + (size_t)r0 * DM : p.ctx + (size_t)(r0 - NL) * DM;
#pragma unroll
      for (int i = 0; i < 4; ++i) vn[i] = ((const float4*)xs0)[i * 64 + lane];
    } else {
#pragma unroll
      for (int i = 0; i < 4; ++i) xnb[i] = ((const u32x2*)(p.xcur + (size_t)r0 * DM))[i * 64 + lane];
    }
    if (r0 < ncomb && lane < 16) slvn = p.slotmap[r0 * 16 + lane];
  }
  float4 cA[4], cB[4], cG[4];
  u32x2 yn[4];
  int mr_c = -1;
  if (which == 2) {
    const u32x2* yp0 = (const u32x2*)(p.ybuf + (size_t)min(rbeg, nrows - 1) * DM);
#pragma unroll
    for (int i = 0; i < 4; ++i) yn[i] = yp0[i * 64 + lane];
  }
  const float bgate = (which == 1 && skinny) ? p.b_gate[(l >> 1) * 16 + (lane & 15)] : 0.f;
  auto skinny_finish = [&](const float* PARTF, int rf, bool livef) {
    float v1 = 0.f;
    if (lane < 16) {
#pragma unroll
      for (int w2 = 0; w2 < 8; ++w2) v1 += PARTF[(w2 * 8 + wv) * 16 + lane];
    }
    if (which == 2) {
      float mx = v1;
      mx = fmaxf(mx, __shfl_xor(mx, 1)); mx = fmaxf(mx, __shfl_xor(mx, 2)); mx = fmaxf(mx, __shfl_xor(mx, 4)); mx = fmaxf(mx, __shfl_xor(mx, 8));
      const float ex = expf(v1 - mx);
      float sum = ex;
      sum += __shfl_xor(sum, 1); sum += __shfl_xor(sum, 2); sum += __shfl_xor(sum, 4); sum += __shfl_xor(sum, 8);
      if (livef && lane < 16) p.aff[(size_t)rf * 16 + lane] = ex / sum;
    } else {
      float gvv = v1 + bgate;
      if ((lane >> 2) & 1) gvv = logsigmoidf_(gvv);
      if (livef && lane < 16) p.gates[(size_t)rf * 16 + lane] = gvv;
    }
  };
  int r_prev = 0;
  bool live_prev = false;
  for (int it = 0; it < per; ++it) {
    const int rr = rbeg + it;
    const bool live = rr < rend;
    const int r = min(rr, nrows - 1);
    bf16_t* HROW = HROW0 + (it & 1) * 16384;
    float* PART = PART0 + (it & 1) * 1024;
    float4 v[4];
    if (in0) {
#pragma unroll
      for (int i = 0; i < 4; ++i) v[i] = vn[i];
    } else {
#pragma unroll
      for (int i = 0; i < 4; ++i) v[i] = make_float4(__uint_as_float(xnb[i].x << 16), __uint_as_float(xnb[i].x & 0xffff0000u), __uint_as_float(xnb[i].y << 16), __uint_as_float(xnb[i].y & 0xffff0000u));
    }
    const int slv = slvn;
    bf16_t* xr = p.xcur + (size_t)r * DM;
    if (it + 1 < per) {
      const int rn = min(rr + 1, nrows - 1);
      if (in0) {
        const float* xsn = rn < NL ? p.x + (size_t)rn * DM : p.ctx + (size_t)(rn - NL) * DM;
#pragma unroll
        for (int i = 0; i < 4; ++i) vn[i] = ((const float4*)xsn)[i * 64 + lane];
      } else {
#pragma unroll
        for (int i = 0; i < 4; ++i) xnb[i] = ((const u32x2*)(p.xcur + (size_t)rn * DM))[i * 64 + lane];
      }
      slvn = (rn < ncomb && lane < 16) ? p.slotmap[rn * 16 + lane] : -1;
    }
    const int mr = modrow(r);
    if (mr != mr_c) {
      mr_c = mr;
      if (which == 3) {
#pragma unroll
        for (int i = 0; i < 4; ++i) cA[i] = ((const float4*)p.g_final)[i * 64 + lane];
      } else {
        const float* gn = (which == 1 ? p.g_norm1 : p.g_norm2) + l * 1024;
        const float* mrow = p.mod + (size_t)(l * 9 + mr) * 6144;
        const float4* shp = (const float4*)(mrow + (which == 1 ? 0 : 3) * 1024);
        const float4* scp = (const float4*)(mrow + (which == 1 ? 1 : 4) * 1024);
        float4 gq[4], sq[4];
#pragma unroll
        for (int i = 0; i < 4; ++i) { gq[i] = ((const float4*)gn)[i * 64 + lane]; sq[i] = scp[i * 64 + lane]; cB[i] = shp[i * 64 + lane]; }
        if (which == 2) {
          const float4* g2 = (const float4*)(mrow + 2 * 1024);
          const float4* spv = (const float4*)(p.s_pool + (size_t)(l >> 1) * 1024);
          float4 sp4[4];
#pragma unroll
          for (int i = 0; i < 4; ++i) { cG[i] = g2[i * 64 + lane]; sp4[i] = spv[i * 64 + lane]; }
          __builtin_amdgcn_sched_barrier(0);
          const float odd = (l & 1) ? 1.f : 0.f;
#pragma unroll
          for (int i = 0; i < 4; ++i) {
            cG[i].x *= odd * sp4[i].x + (1.f - odd); cG[i].y *= odd * sp4[i].y + (1.f - odd); cG[i].z *= odd * sp4[i].z + (1.f - odd); cG[i].w *= odd * sp4[i].w + (1.f - odd);
          }
        }
#pragma unroll
        for (int i = 0; i < 4; ++i) cA[i] = make_float4(gq[i].x * (1.f + sq[i].x), gq[i].y * (1.f + sq[i].y), gq[i].z * (1.f + sq[i].z), gq[i].w * (1.f + sq[i].w));
      }
      if (which == 2) {
      } else if (ncomb > 0) {
        const float4* g5 = (const float4*)(p.mod + (size_t)(lprev * 9 + mr) * 6144 + 5 * 1024);
#pragma unroll
        for (int i = 0; i < 4; ++i) cG[i] = g5[i * 64 + lane];
      }
    }
    if (live && r < ncomb) {
      float4 s4[4];
#pragma unroll
      for (int i = 0; i < 4; ++i) s4[i] = make_float4(0.f, 0.f, 0.f, 0.f);
      unsigned long long mask = __ballot(slv >= 0);
      while (mask) {
        const u32x2* yp[4];
        bool ok[4];
#pragma unroll
        for (int j = 0; j < 4; ++j) {
          ok[j] = (mask != 0ull);
          if (ok[j]) {
            const int e = __ffsll((long long)mask) - 1;
            mask &= mask - 1;
            const int sl = __shfl(slv, e);
            size_t yrow;
            if (r < NL) yrow = (size_t)e * 2048 + (size_t)(r >> 11) * 256 + sl;
            else yrow = (size_t)MOE_L + (size_t)e * 256 + (size_t)((r - NL) >> 8) * 32 + sl;
            yp[j] = (const u32x2*)(p.Ybuf + yrow * DM);
          } else yp[j] = yp[0];
        }
        u32x2 yv[4][4];
#pragma unroll
        for (int j = 0; j < 4; ++j)
#pragma unroll
          for (int i = 0; i < 4; ++i) yv[j][i] = yp[j][i * 64 + lane];
        __builtin_amdgcn_sched_barrier(0);
#pragma unroll
        for (int j = 0; j < 4; ++j) {
          if (ok[j]) {
#pragma unroll
            for (int i = 0; i < 4; ++i) {
              const u32x2 y = yv[j][i];
              s4[i].x += __uint_as_float(y.x << 16); s4[i].y += __uint_as_float(y.x & 0xffff0000u);
              s4[i].z += __uint_as_float(y.y << 16); s4[i].w += __uint_as_float(y.y & 0xffff0000u);
            }
          }
        }
      }
#pragma unroll
      for (int i = 0; i < 4; ++i) {
        const float4 g = cG[i];
        v[i].x += g.x * s4[i].x; v[i].y += g.y * s4[i].y; v[i].z += g.z * s4[i].z; v[i].w += g.w * s4[i].w;
        if (which != 3) { u32x2 xw; xw.x = cvt_pk_bf16(v[i].x, v[i].y); xw.y = cvt_pk_bf16(v[i].z, v[i].w); ((u32x2*)xr)[i * 64 + lane] = xw; }
      }
    }
    if (which == 2) {
      u32x2 yc[4];
#pragma unroll
      for (int i = 0; i < 4; ++i) yc[i] = yn[i];
      if (it + 1 < per) {
        const u32x2* ypn = (const u32x2*)(p.ybuf + (size_t)min(rr + 1, nrows - 1) * DM);
#pragma unroll
        for (int i = 0; i < 4; ++i) yn[i] = ypn[i * 64 + lane];
      }
#pragma unroll
      for (int i = 0; i < 4; ++i) {
        v[i].x += cG[i].x * __uint_as_float(yc[i].x << 16); v[i].y += cG[i].y * __uint_as_float(yc[i].x & 0xffff0000u);
        v[i].z += cG[i].z * __uint_as_float(yc[i].y << 16); v[i].w += cG[i].w * __uint_as_float(yc[i].y & 0xffff0000u);
        if (live) { u32x2 xw; xw.x = cvt_pk_bf16(v[i].x, v[i].y); xw.y = cvt_pk_bf16(v[i].z, v[i].w); ((u32x2*)xr)[i * 64 + lane] = xw; }
      }
    }
    float ss = 0.f;
#pragma unroll
    for (int i = 0; i < 4; ++i) ss += v[i].x * v[i].x + v[i].y * v[i].y + v[i].z * v[i].z + v[i].w * v[i].w;
    ss = wave_sum(ss);
    const float inv = rsqrtf(ss * (1.f / 1024.f) + EPS);
    if (which == 3) {
      if (live) {
#pragma unroll
        for (int i = 0; i < 4; ++i) {
          const float4 g = cA[i];
          ((float4*)(p.out + (size_t)r * DM))[i * 64 + lane] = make_float4(v[i].x * inv * g.x, v[i].y * inv * g.y, v[i].z * inv * g.z, v[i].w * inv * g.w);
        }
      }
      continue;
    }
#pragma unroll
    for (int i = 0; i < 4; ++i) {
      const float h0 = v[i].x * inv * cA[i].x + cB[i].x, h1 = v[i].y * inv * cA[i].y + cB[i].y;
      const float h2 = v[i].z * inv * cA[i].z + cB[i].z, h3 = v[i].w * inv * cA[i].w + cB[i].w;
      u32x2 w; w.x = cvt_pk_bf16(h0, h1); w.y = cvt_pk_bf16(h2, h3);
      if (live) ((u32x2*)(p.hbuf + (size_t)r * DM))[i * 64 + lane] = w;
      if (skinny) {
        const float l0 = h0 - __uint_as_float(w.x << 16), l1 = h1 - __uint_as_float(w.x & 0xffff0000u);
        const float l2 = h2 - __uint_as_float(w.y << 16), l3 = h3 - __uint_as_float(w.y & 0xffff0000u);
        u32x2 wl; wl.x = cvt_pk_bf16(l0, l1); wl.y = cvt_pk_bf16(l2, l3);
        ((u32x2*)(HROW + (wv * 2 + 0) * 1024))[i * 64 + lane] = w;
        ((u32x2*)(HROW + (wv * 2 + 1) * 1024))[i * 64 + lane] = wl;
      }
    }
    if (!skinny) continue;
    LDS_BARRIER();
    {
      const int arow = lane & 7, kg = lane >> 4;
      f32x4m acc = {0.f, 0.f, 0.f, 0.f};
#pragma unroll
      for (int ks = 0; ks < 4; ++ks) {
        const bf16x8 ahi = *(const bf16x8*)(HROW + (arow * 2 + 0) * 1024 + wv * 128 + ks * 32 + kg * 8);
        const bf16x8 alo = *(const bf16x8*)(HROW + (arow * 2 + 1) * 1024 + wv * 128 + ks * 32 + kg * 8);
        acc = __builtin_amdgcn_mfma_f32_16x16x32_bf16(ahi, Bhi[ks], acc, 0, 0, 0);
        acc = __builtin_amdgcn_mfma_f32_16x16x32_bf16(ahi, Blo[ks], acc, 0, 0, 0);
        acc = __builtin_amdgcn_mfma_f32_16x16x32_bf16(alo, Bhi[ks], acc, 0, 0, 0);
      }
      if (kg < 2) {
#pragma unroll
        for (int q = 0; q < 4; ++q) PART[(wv * 8 + kg * 4 + q) * 16 + (lane & 15)] = acc[q];
      }
    }
    if (it > 0) skinny_finish(PART0 + ((it & 1) ^ 1) * 1024, r_prev, live_prev);
    r_prev = r; live_prev = live;
  }
  if (skinny) {
    LDS_BARRIER();
    skinny_finish(PART0 + ((per - 1) & 1) * 1024, r_prev, live_prev);
  }
  __syncthreads();
}

#define LOG2E 1.4426950408889634f
__device__ __forceinline__ int chain_row(int b, int dir, int p) {
  if (p < 256) { const int t = dir ? 255 - p : p; return NL + b * 256 + t; }
  const int q = p - 256; const int t = dir ? 2047 - q : q; return b * 2048 + t;
}
__device__ __forceinline__ float wave_incl_sum(float v, int lane) {
#pragma unroll
  for (int o = 1; o < 64; o <<= 1) { const float t = __shfl_up(v, o); if (lane >= o) v += t; }
  return v;
}
__device__ __forceinline__ float wave_incl_max(float v, int lane) {
#pragma unroll
  for (int o = 1; o < 64; o <<= 1) { const float t = __shfl_up(v, o); if (lane >= o) v = fmaxf(v, t); }
  return v;
}
__device__ __forceinline__ void ph_post_even(const Params& p, int l, float* sm) {
  const int e = l >> 1;
  const int tid = ltid(), lane = tid & 63;
  __syncthreads();
  for (int idx = tid; idx < 1024; idx += NTHR) {
    const int pos = idx >> 4, i = idx & 15;
    const float ang = (float)pos * exp2f(-(float)i * (13.287712379549449f / 16.f));
    float sn, cs;
    sincosf(ang, &sn, &cs);
    sm[2 * idx] = cs; sm[2 * idx + 1] = sn;
  }
  if (tid < 128) sm[2048 + tid] = tid < 64 ? p.g_qnorm[e * 64 + tid] : p.g_knorm[e * 64 + tid - 64];
  for (int idx = tid; idx < 3072; idx += NTHR) sm[2304 + idx] = p.w_conv[(size_t)e * 3 * 1024 + idx];
  __syncthreads();
  const int bid = lbid(), G = lgdim();
  const bool scanner = false;
  const size_t gtid = (size_t)bid * NTHR + tid, gsz = (size_t)G * NTHR;
  if (!scanner) {
  for (size_t it = gtid; it < (size_t)NT * 10; it += gsz) {
    const int r = (int)(it / 10), hh = (int)(it % 10);
    const bool lat = r < NL;
    const int t = r & 2047;
    const int bb = lat ? (r >> 11) : ((r - NL) >> 8);
    const int key = lat ? 256 + t : ((r - NL) & 255);
    const bf16_t* src; bf16_t* dst; const float* g; float osc;
    if (hh < 8) { src = p.proj + (size_t)r * PROJW + hh * 64; dst = p.Qb + (size_t)r * 512 + hh * 64; g = sm + 2048; osc = 0.125f * LOG2E; }
    else { src = p.proj + (size_t)r * PROJW + 512 + (hh - 8) * 64; dst = p.Kb + ((size_t)(bb * 2 + (hh - 8)) * 2304 + key) * 64; g = sm + 2048 + 64; osc = 1.f;
           const u32x4* vs = (const u32x4*)(p.proj + (size_t)r * PROJW + 640 + (hh - 8) * 64);
           u32x4* vd = (u32x4*)(p.Vb + ((size_t)(bb * 2 + (hh - 8)) * 2304 + key) * 64);
           u32x4 vt[8];
#pragma unroll
           for (int q = 0; q < 8; ++q) vt[q] = vs[q];
           __builtin_amdgcn_sched_barrier(0);
#pragma unroll
           for (int q = 0; q < 8; ++q) vd[q] = vt[q]; }
    float x[64];
#pragma unroll
    for (int q = 0; q < 8; ++q) { float f[8]; unpack8(((const u32x4*)src)[q], f);
#pragma unroll
      for (int j = 0; j < 8; ++j) x[q * 8 + j] = f[j]; }
    float ss = 0.f;
#pragma unroll
    for (int j = 0; j < 64; ++j) ss += x[j] * x[j];
    const float inv = rsqrtf(ss * (1.f / 64.f) + EPS) * osc;
#pragma unroll
    for (int j = 0; j < 64; ++j) x[j] *= inv * g[j];
    if (lat) {
#pragma unroll
      for (int a = 0; a < 2; ++a) {
        const int pos = (a == 0) ? (t >> 6) : (t & 63);
#pragma unroll
        for (int i = 0; i < 16; ++i) {
          const float2 cssn = *(const float2*)(sm + 2 * (pos * 16 + i));
          const float x1 = x[a * 32 + i], x2 = x[a * 32 + 16 + i];
          x[a * 32 + i] = x1 * cssn.x - x2 * cssn.y;
          x[a * 32 + 16 + i] = x2 * cssn.x + x1 * cssn.y;
        }
      }
    }
#pragma unroll
    for (int q = 0; q < 8; ++q) { float f[8];
#pragma unroll
      for (int j = 0; j < 8; ++j) f[j] = x[q * 8 + j];
      ((u32x4*)dst)[q] = pack8(f); }
  }
  const float* wc = sm + 2304;
  for (size_t it0 = gtid; it0 < (size_t)NT * 128; it0 += 4 * gsz) {
    u32x4 rc[4], rm[4], rp[4];
#pragma unroll
    for (int u = 0; u < 4; ++u) {
      const size_t it = it0 + (size_t)u * gsz;
      const size_t itc = it < (size_t)NT * 128 ? it : it0;
      const int r = (int)(itc >> 7), c8 = (int)(itc & 127) * 8;
      int t, n;
      if (r < NL) { t = r & 2047; n = 2048; } else { t = (r - NL) & 255; n = 256; }
      const bf16_t* sp = p.proj + (size_t)r * PROJW + 768 + c8;
      rc[u] = *(const u32x4*)sp;
      const u32x4 lm = *(const u32x4*)(sp - (t > 0 ? PROJW : 0)), lp = *(const u32x4*)(sp + (t < n - 1 ? PROJW : 0));
      rm[u].x = t > 0 ? lm.x : 0u; rm[u].y = t > 0 ? lm.y : 0u; rm[u].z = t > 0 ? lm.z : 0u; rm[u].w = t > 0 ? lm.w : 0u;
      rp[u].x = t < n - 1 ? lp.x : 0u; rp[u].y = t < n - 1 ? lp.y : 0u; rp[u].z = t < n - 1 ? lp.z : 0u; rp[u].w = t < n - 1 ? lp.w : 0u;
    }
#pragma unroll
    for (int u = 0; u < 4; ++u) {
      const size_t it = it0 + (size_t)u * gsz;
      if (it < (size_t)NT * 128) {
        const int r = (int)(it >> 7), c8 = (int)(it & 127) * 8;
        float xc[8], xm[8], xp[8], o[8];
        unpack8(rc[u], xc); unpack8(rm[u], xm); unpack8(rp[u], xp);
        const float ksc = c8 < 512 ? 1.f : 0.08838834764831845f;
#pragma unroll
        for (int j = 0; j < 8; ++j) { const float v = wc[c8 + j] * xm[j] + wc[1024 + c8 + j] * xc[j] + wc[2048 + c8 + j] * xp[j]; o[j] = siluf(v) * ksc; }
        bf16_t* dp = c8 < 512 ? p.qm + (size_t)r * 512 + c8 : p.km + (size_t)r * 512 + c8 - 512;
        *(u32x4*)dp = pack8(o);
      }
    }
  }
  }
  {
    const int gw = (int)(gtid >> 6), nw = (int)(gsz >> 6);
    for (int task = gw; task < 64 * 18; task += nw) {
      const int chain = task / 18, c = task % 18;
      const int b = chain >> 3, hd = (chain >> 1) & 3, dir = chain & 1;
      const int p0 = c * 128 + 2 * lane;
      const int r0 = chain_row(b, dir, p0), r1 = chain_row(b, dir, p0 + 1);
      const float ig0 = p.gates[(size_t)r0 * 16 + dir * 8 + hd], lf0 = p.gates[(size_t)r0 * 16 + dir * 8 + 4 + hd];
      const float ig1 = p.gates[(size_t)r1 * 16 + dir * 8 + hd], lf1 = p.gates[(size_t)r1 * 16 + dir * 8 + 4 + hd];
      const float ssum = lf0 + lf1;
      const float incl = wave_incl_sum(ssum, lane);
      const float bq0 = (incl - ssum) + lf0, bq1 = bq0 + lf1;
      const float bend = __shfl(incl, 63);
      const float g0 = ig0 - bq0, g1 = ig1 - bq1;
      const float inclm = wave_incl_max(fmaxf(g0, g1), lane);
      float exclm = __shfl_up(inclm, 1);
      if (lane == 0) exclm = -3.0e38f;
      const float pm0 = fmaxf(exclm, g0), pm1 = fmaxf(pm0, g1);
      const float gmax = __shfl(inclm, 63);
      const size_t i0 = (size_t)r0 * 8 + dir * 4 + hd, i1 = (size_t)r1 * 8 + dir * 4 + hd;
      p.gsG[i0] = g0 * LOG2E; p.gsR[i0] = pm0 * LOG2E; p.gsB[i0] = bq0 * LOG2E;
      p.gsG[i1] = g1 * LOG2E; p.gsR[i1] = pm1 * LOG2E; p.gsB[i1] = bq1 * LOG2E;
      if (lane == 0) { p.cBE[chain * 18 + c] = bend; p.cGM[chain * 18 + c] = gmax; }
    }
  }
}
__device__ __forceinline__ void chain_state(const Params& p, int chain, int cc, float& m_in, float& m_next, float& be) {
  m_in = -1e30f; m_next = -1e30f; be = 0.f;
  for (int c = 0; c <= cc; ++c) {
    be = p.cMIN[chain * 18 + c];
    const float mn = fmaxf(m_in + be, be + p.cE1[chain * 18 + c]);
    if (c < cc) m_in = mn; else m_next = mn;
  }
}

typedef float f32x16 __attribute__((ext_vector_type(16)));
typedef short s16x4 __attribute__((ext_vector_type(4)));
typedef __attribute__((address_space(3))) const char* lds_cptr;
__device__ __forceinline__ s16x4 vtr(lds_cptr p) { return __builtin_bit_cast(s16x4, __builtin_amdgcn_ds_read_tr16_b64_v4i16((__attribute__((address_space(3))) s16x4*)p)); }
#define MX3(a, b, c) __builtin_fmaxf(__builtin_fmaxf((a), (b)), (c))
__device__ __forceinline__ float rowmax32(const f32x16& p0, const f32x16& p1) {
  float a = MX3(p0[0], p0[1], p1[0]), b = MX3(p0[2], p0[3], p1[1]);
  a = MX3(a, p1[2], p1[3]);
#pragma unroll
  for (int r = 4; r < 16; r += 4) { a = MX3(a, p0[r], p0[r + 1]); b = MX3(b, p0[r + 2], p0[r + 3]); a = MX3(a, p1[r], p1[r + 1]); b = MX3(b, p1[r + 2], p1[r + 3]); }
  const float m = __builtin_fmaxf(a, b);
  auto rr = __builtin_amdgcn_permlane32_swap(__float_as_uint(m), __float_as_uint(m), false, false);
  return __builtin_fmaxf(__uint_as_float(rr[0]), __uint_as_float(rr[1]));
}
__device__ __forceinline__ float half_swap_add(float v) {
  auto rr = __builtin_amdgcn_permlane32_swap(__float_as_uint(v), __float_as_uint(v), false, false);
  return __uint_as_float(rr[0]) + __uint_as_float(rr[1]);
}
#define ATT_SLOT 16384
__device__ __forceinline__ void glds16(const void* g, unsigned lds_base) {
  unsigned sv;
  asm volatile("s_mov_b32 %0, m0\n\ts_mov_b32 m0, %2\n\ts_nop 0\n\tglobal_load_lds_dwordx4 %1, off\n\ts_mov_b32 m0, %0" : "=&s"(sv) : "v"(g), "s"(lds_base) : "memory");
}
__device__ __forceinline__ void attn_unit(const bf16_t* Q0, const bf16_t* Kbase, const bf16_t* Vbase, const int nkeys, bf16_t* O0, LAS unsigned char* lds) {
  const int tid = ltid(), lane = tid & 63, r32 = lane & 31, hi = lane >> 5;
  const int wid = __builtin_amdgcn_readfirstlane(tid >> 6);
  const int NTL = nkeys >> 6;
  __syncthreads();
  const bf16_t* ksrc = Kbase + (size_t)lane * 64 + wid * 8;
  const bf16_t* vsrc = Vbase + (size_t)(16 * (wid & 3) + (lane >> 2)) * 64 + (wid >> 2) * 32 + (lane & 3) * 8;
  const unsigned ldsb = (unsigned)(size_t)lds;
#define ATT_STAGE(t, slot) do { \
    glds16(ksrc + (size_t)(t) * 64 * 64, (unsigned)__builtin_amdgcn_readfirstlane(ldsb + (slot) * ATT_SLOT + wid * 1024)); \
    glds16(vsrc + (size_t)(t) * 64 * 64, (unsigned)__builtin_amdgcn_readfirstlane(ldsb + (slot) * ATT_SLOT + 8192 + wid * 1024)); } while (0)
  ATT_STAGE(0, 0);
  if (NTL > 1) ATT_STAGE(1, 1);
  bf16x8 qr[4];
  {
    const bf16_t* Qw = Q0 + (size_t)(wid * 32 + r32) * 512;
#pragma unroll
    for (int d0 = 0; d0 < 4; ++d0) qr[d0] = *(const bf16x8*)(Qw + d0 * 16 + hi * 8);
  }
  f32x16 o0, o1;
#pragma unroll
  for (int r = 0; r < 16; ++r) { o0[r] = 0.f; o1[r] = 0.f; }
  float m = -1e30f, l = 0.f;
  const int koff = hi * 1024 + r32 * 16;
  const int voff = 8192 + ((lane >> 4) & 1) * 32 + (lane & 3) * 8 + (4 * hi + ((lane & 15) >> 2)) * 64;
  const bool grpB = wid >= 4;
  bf16x8 pw[4];
#define ATT_PV(sl) do { const lds_cptr vp_ = (lds_cptr)(lds + (sl) * ATT_SLOT + voff); \
    _Pragma("unroll") for (int s4 = 0; s4 < 4; ++s4) { \
      const s16x4 a0l = vtr(vp_ + s4 * 1024), a0h = vtr(vp_ + s4 * 1024 + 512); \
      const s16x4 a1l = vtr(vp_ + 4096 + s4 * 1024), a1h = vtr(vp_ + 4096 + s4 * 1024 + 512); \
      const bf16x8 a0 = {a0l[0], a0l[1], a0l[2], a0l[3], a0h[0], a0h[1], a0h[2], a0h[3]}; \
      const bf16x8 a1 = {a1l[0], a1l[1], a1l[2], a1l[3], a1h[0], a1h[1], a1h[2], a1h[3]}; \
      o0 = __builtin_amdgcn_mfma_f32_32x32x16_bf16(a0, pw[s4], o0, 0, 0, 0); \
      o1 = __builtin_amdgcn_mfma_f32_32x32x16_bf16(a1, pw[s4], o1, 0, 0, 0); } } while (0)
  for (int t = 0; t <= NTL; ++t) {
    if (t + 1 < NTL) asm volatile("s_waitcnt vmcnt(2) lgkmcnt(0)\n\ts_barrier" ::: "memory"); else asm volatile("s_waitcnt vmcnt(0) lgkmcnt(0)\n\ts_barrier" ::: "memory");
    __builtin_amdgcn_sched_barrier(0);
    if (t + 2 < NTL) ATT_STAGE(t + 2, (t + 2) & 3);
    if (grpB && t > 0) ATT_PV((t - 1) & 3);
    if (t < NTL) {
      const lds_cptr kp = (lds_cptr)(lds + (t & 3) * ATT_SLOT + koff);
      f32x16 pA, pB;
#pragma unroll
      for (int r = 0; r < 16; ++r) { pA[r] = 0.f; pB[r] = 0.f; }
#pragma unroll
      for (int d0 = 0; d0 < 4; ++d0) {
        const bf16x8 k0 = *(const LAS bf16x8*)(kp + d0 * 2048), k1 = *(const LAS bf16x8*)(kp + d0 * 2048 + 512);
        pA = __builtin_amdgcn_mfma_f32_32x32x16_bf16(k0, qr[d0], pA, 0, 0, 0);
        pB = __builtin_amdgcn_mfma_f32_32x32x16_bf16(k1, qr[d0], pB, 0, 0, 0);
      }
      const float rm = rowmax32(pA, pB);
      const float mn = __builtin_fmaxf(m, rm);
      const float alpha = __builtin_amdgcn_exp2f(m - mn);
      m = mn;
      float ps = 0.f;
#pragma unroll
      for (int r = 0; r < 16; ++r) { pA[r] = __builtin_amdgcn_exp2f(pA[r] - mn); pB[r] = __builtin_amdgcn_exp2f(pB[r] - mn); ps += pA[r] + pB[r]; }
      l = l * alpha + ps;
#pragma unroll
      for (int r = 0; r < 16; ++r) { o0[r] *= alpha; o1[r] *= alpha; }
#pragma unroll
      for (int s4 = 0; s4 < 4; ++s4) {
        u32x4 w;
        if (s4 < 2) { w.x = cvt_pk_bf16(pA[8 * s4 + 0], pA[8 * s4 + 1]); w.y = cvt_pk_bf16(pA[8 * s4 + 2], pA[8 * s4 + 3]); w.z = cvt_pk_bf16(pA[8 * s4 + 4], pA[8 * s4 + 5]); w.w = cvt_pk_bf16(pA[8 * s4 + 6], pA[8 * s4 + 7]); }
        else { const int q = s4 - 2; w.x = cvt_pk_bf16(pB[8 * q + 0], pB[8 * q + 1]); w.y = cvt_pk_bf16(pB[8 * q + 2], pB[8 * q + 3]); w.z = cvt_pk_bf16(pB[8 * q + 4], pB[8 * q + 5]); w.w = cvt_pk_bf16(pB[8 * q + 6], pB[8 * q + 7]); }
        pw[s4] = __builtin_bit_cast(bf16x8, w);
      }
      if (!grpB) ATT_PV(t & 3);
    }
  }
#undef ATT_PV
#undef ATT_STAGE
  const float il = 1.f / half_swap_add(l);
  bf16_t* Ow = O0 + (size_t)(wid * 32 + r32) * 1024;
#pragma unroll
  for (int g4 = 0; g4 < 4; ++g4) {
    u32x2 w0, w1;
    w0.x = cvt_pk_bf16(o0[4 * g4 + 0] * il, o0[4 * g4 + 1] * il); w0.y = cvt_pk_bf16(o0[4 * g4 + 2] * il, o0[4 * g4 + 3] * il);
    w1.x = cvt_pk_bf16(o1[4 * g4 + 0] * il, o1[4 * g4 + 1] * il); w1.y = cvt_pk_bf16(o1[4 * g4 + 2] * il, o1[4 * g4 + 3] * il);
    *(u32x2*)(Ow + 8 * g4 + 4 * hi) = w0;
    *(u32x2*)(Ow + 32 + 8 * g4 + 4 * hi) = w1;
  }
}
#define ATT_TAU 8.f
__device__ __forceinline__ void attn_unit2(const bf16_t* Q0a, const bf16_t* Q0b, const bf16_t* Kbase, const bf16_t* Vbase, const int nkeys, bf16_t* O0a, bf16_t* O0b, LAS unsigned char* lds) {
  const int tid = ltid(), lane = tid & 63, r32 = lane & 31, hi = lane >> 5;
  const int wid = __builtin_amdgcn_readfirstlane(tid >> 6);
  const int NTL = nkeys >> 6;
  __syncthreads();
  const bf16_t* ksrc = Kbase + (size_t)lane * 64 + wid * 8;
  const bf16_t* vsrc = Vbase + (size_t)(16 * (wid & 3) + (lane >> 2)) * 64 + (wid >> 2) * 32 + (lane & 3) * 8;
  const unsigned ldsb = (unsigned)(size_t)lds;
#define ATT_STAGE(t, slot) do { \
    glds16(ksrc + (size_t)(t) * 64 * 64, (unsigned)__builtin_amdgcn_readfirstlane(ldsb + (slot) * ATT_SLOT + wid * 1024)); \
    glds16(vsrc + (size_t)(t) * 64 * 64, (unsigned)__builtin_amdgcn_readfirstlane(ldsb + (slot) * ATT_SLOT + 8192 + wid * 1024)); } while (0)
  ATT_STAGE(0, 0);
  if (NTL > 1) ATT_STAGE(1, 1);
  bf16x8 qr[2][4];
  {
    const bf16_t* Qa = Q0a + (size_t)(wid * 32 + r32) * 512;
    const bf16_t* Qb2 = Q0b + (size_t)(wid * 32 + r32) * 512;
#pragma unroll
    for (int d0 = 0; d0 < 4; ++d0) { qr[0][d0] = *(const bf16x8*)(Qa + d0 * 16 + hi * 8); qr[1][d0] = *(const bf16x8*)(Qb2 + d0 * 16 + hi * 8); }
  }
  f32x16 o0[2], o1[2];
#pragma unroll
  for (int hh = 0; hh < 2; ++hh)
#pragma unroll
    for (int r = 0; r < 16; ++r) { o0[hh][r] = 0.f; o1[hh][r] = 0.f; }
  f32x16 ng[2];
#pragma unroll
  for (int hh = 0; hh < 2; ++hh)
#pragma unroll
    for (int r = 0; r < 16; ++r) ng[hh][r] = 0.f;
  float l[2] = {0.f, 0.f};
  const int koff = hi * 1024 + r32 * 16;
  const int voff = 8192 + ((lane >> 4) & 1) * 32 + (lane & 3) * 8 + (4 * hi + ((lane & 15) >> 2)) * 64;
  int slot = 0;
  for (int t = 0; t < NTL; ++t) {
    if (t + 1 < NTL) asm volatile("s_waitcnt vmcnt(2) lgkmcnt(0)\n\ts_barrier" ::: "memory"); else asm volatile("s_waitcnt vmcnt(0) lgkmcnt(0)\n\ts_barrier" ::: "memory");
    __builtin_amdgcn_sched_barrier(0);
    if (t + 2 < NTL) { const int s2 = (slot >= 1) ? slot - 1 : 2; ATT_STAGE(t + 2, s2); }
    const lds_cptr kp = (lds_cptr)(lds + slot * ATT_SLOT + koff);
    const lds_cptr vp = (lds_cptr)(lds + slot * ATT_SLOT + voff);
    f32x16 pA[2], pB[2];
#pragma unroll
    for (int d0 = 0; d0 < 4; ++d0) {
      const bf16x8 k0 = *(const LAS bf16x8*)(kp + d0 * 2048), k1 = *(const LAS bf16x8*)(kp + d0 * 2048 + 512);
#pragma unroll
      for (int hh = 0; hh < 2; ++hh) {
        pA[hh] = __builtin_amdgcn_mfma_f32_32x32x16_bf16(k0, qr[hh][d0], d0 == 0 ? ng[hh] : pA[hh], 0, 0, 0);
        pB[hh] = __builtin_amdgcn_mfma_f32_32x32x16_bf16(k1, qr[hh][d0], d0 == 0 ? ng[hh] : pB[hh], 0, 0, 0);
      }
    }
    bf16x8 pw[2][4];
#pragma unroll
    for (int hh = 0; hh < 2; ++hh) {
      const float rm = rowmax32(pA[hh], pB[hh]);
      if (t == 0 || __builtin_amdgcn_ballot_w64(rm > ATT_TAU) != 0ull) {
        const float delta = (t == 0) ? rm : __builtin_fmaxf(rm, 0.f);
        const float alpha = __builtin_amdgcn_exp2f(-delta);
#pragma unroll
        for (int r = 0; r < 16; ++r) { pA[hh][r] -= delta; pB[hh][r] -= delta; o0[hh][r] *= alpha; o1[hh][r] *= alpha; ng[hh][r] -= delta; }
        l[hh] *= alpha;
      }
      float ps = 0.f;
#pragma unroll
      for (int r = 0; r < 16; ++r) { pA[hh][r] = __builtin_amdgcn_exp2f(pA[hh][r]); pB[hh][r] = __builtin_amdgcn_exp2f(pB[hh][r]); ps += pA[hh][r] + pB[hh][r]; }
      l[hh] += ps;
#pragma unroll
      for (int s4 = 0; s4 < 4; ++s4) {
        u32x4 w;
        if (s4 < 2) { w.x = cvt_pk_bf16(pA[hh][8 * s4 + 0], pA[hh][8 * s4 + 1]); w.y = cvt_pk_bf16(pA[hh][8 * s4 + 2], pA[hh][8 * s4 + 3]); w.z = cvt_pk_bf16(pA[hh][8 * s4 + 4], pA[hh][8 * s4 + 5]); w.w = cvt_pk_bf16(pA[hh][8 * s4 + 6], pA[hh][8 * s4 + 7]); }
        else { const int q = s4 - 2; w.x = cvt_pk_bf16(pB[hh][8 * q + 0], pB[hh][8 * q + 1]); w.y = cvt_pk_bf16(pB[hh][8 * q + 2], pB[hh][8 * q + 3]); w.z = cvt_pk_bf16(pB[hh][8 * q + 4], pB[hh][8 * q + 5]); w.w = cvt_pk_bf16(pB[hh][8 * q + 6], pB[hh][8 * q + 7]); }
        pw[hh][s4] = __builtin_bit_cast(bf16x8, w);
      }
    }
#pragma unroll
    for (int s4 = 0; s4 < 4; ++s4) {
      const s16x4 a0l = vtr(vp + s4 * 1024), a0h = vtr(vp + s4 * 1024 + 512);
      const s16x4 a1l = vtr(vp + 4096 + s4 * 1024), a1h = vtr(vp + 4096 + s4 * 1024 + 512);
      const bf16x8 a0 = {a0l[0], a0l[1], a0l[2], a0l[3], a0h[0], a0h[1], a0h[2], a0h[3]};
      const bf16x8 a1 = {a1l[0], a1l[1], a1l[2], a1l[3], a1h[0], a1h[1], a1h[2], a1h[3]};
#pragma unroll
      for (int hh = 0; hh < 2; ++hh) {
        o0[hh] = __builtin_amdgcn_mfma_f32_32x32x16_bf16(a0, pw[hh][s4], o0[hh], 0, 0, 0);
        o1[hh] = __builtin_amdgcn_mfma_f32_32x32x16_bf16(a1, pw[hh][s4], o1[hh], 0, 0, 0);
      }
    }
    slot = (slot == 2) ? 0 : slot + 1;
  }
#undef ATT_STAGE
#pragma unroll
  for (int hh = 0; hh < 2; ++hh) {
    const float il = 1.f / half_swap_add(l[hh]);
    bf16_t* Ow = (hh ? O0b : O0a) + (size_t)(wid * 32 + r32) * 1024;
#pragma unroll
    for (int g4 = 0; g4 < 4; ++g4) {
      u32x2 w0, w1;
      w0.x = cvt_pk_bf16(o0[hh][4 * g4 + 0] * il, o0[hh][4 * g4 + 1] * il); w0.y = cvt_pk_bf16(o0[hh][4 * g4 + 2] * il, o0[hh][4 * g4 + 3] * il);
      w1.x = cvt_pk_bf16(o1[hh][4 * g4 + 0] * il, o1[hh][4 * g4 + 1] * il); w1.y = cvt_pk_bf16(o1[hh][4 * g4 + 2] * il, o1[hh][4 * g4 + 3] * il);
      *(u32x2*)(Ow + 8 * g4 + 4 * hi) = w0;
      *(u32x2*)(Ow + 32 + 8 * g4 + 4 * hi) = w1;
    }
  }
}
__device__ __forceinline__ void ph_att(const Params& p, bool ctx_q, LAS unsigned char* lds) {
  const int c = lbid(), G = lgdim();
  const int nunits = 256 + (ctx_q ? 32 : 0);
  for (int L = c; L < nunits; L += G) {
    if (L < 256) {
      const int grp = (L & 7) * 2 + ((L >> 3) >> 4), within = (L >> 3) & 15;
      const int b = grp >> 1, kvh = grp & 1, h0 = kvh * 4 + 2 * (within >> 3), qt = within & 7;
      const size_t row0 = (size_t)b * 2048 + qt * 256;
      const size_t kvb = (size_t)(b * 2 + kvh) * 2304 * 64;
      attn_unit2(p.Qb + row0 * 512 + h0 * 64, p.Qb + row0 * 512 + (h0 + 1) * 64, p.Kb + kvb, p.Vb + kvb, 2304, p.mix + row0 * 1024 + h0 * 64, p.mix + row0 * 1024 + (h0 + 1) * 64, lds);
    } else {
      const int u = L - 256, b = u >> 2, kvh = (u >> 1) & 1, h0 = kvh * 4 + 2 * (u & 1);
      const size_t row0 = (size_t)NL + b * 256;
      const size_t kvb = (size_t)(b * 2 + kvh) * 2304 * 64;
      attn_unit2(p.Qb + row0 * 512 + h0 * 64, p.Qb + row0 * 512 + (h0 + 1) * 64, p.Kb + kvb, p.Vb + kvb, 256, p.mix + row0 * 1024 + h0 * 64, p.mix + row0 * 1024 + (h0 + 1) * 64, lds);
    }
  }
  __syncthreads();
}

__device__ __forceinline__ int chunk_row0(int b, int dir, int cc) {
  if (cc < 2) return NL + b * 256 + (dir ? 1 - cc : cc) * 128;
  return b * 2048 + (dir ? 15 - (cc - 2) : cc - 2) * 128;
}
__device__ __forceinline__ int trq_addr(int lane, int quarter, int rowbase) {
  return quarter * 8192 + ((lane >> 4) & 1) * 32 + (lane & 3) * 8 + (rowbase + ((lane & 15) >> 2)) * 64;
}
__device__ __forceinline__ bf16x8 cat44(const s16x4 a, const s16x4 b) { return (bf16x8){a[0], a[1], a[2], a[3], b[0], b[1], b[2], b[3]}; }

__device__ __forceinline__ void glds4(const void* g, unsigned lds_base) {
  unsigned sv;
  asm volatile("s_mov_b32 %0, m0\n\ts_mov_b32 m0, %2\n\ts_nop 0\n\tglobal_load_lds_dword %1, off\n\ts_mov_b32 m0, %0" : "=&s"(sv) : "v"(g), "s"(lds_base) : "memory");
}
#define USC_SLOT 41472
#define USC_WS 124416
#define USC_NP 124928
#define USC_TB 125952
#define USC_CS 133120
__device__ __forceinline__ void ph_mlstm_uscan(const Params& p, LAS unsigned char* lds) {
  const int tid = ltid(), lane = tid & 63, r32 = lane & 31, hi = lane >> 5;
  const int wid = __builtin_amdgcn_readfirstlane(tid >> 6);
  LAS float* WS = (LAS float*)(lds + USC_WS);
  LAS float* NP = (LAS float*)(lds + USC_NP);
  LAS float* TE1 = (LAS float*)(lds + USC_TB);
  LAS float* TDEC = TE1 + 18;
  const unsigned ldsb = (unsigned)(size_t)lds;
  for (int unit = lbid(); unit < 256; unit += lgdim()) {
    const int eb = (unit >> 3) & 3, chain = (unit >> 5) * 8 + (unit & 7);
    const int b = chain >> 3, hd = (chain >> 1) & 3, dir = chain & 1;
    __syncthreads();
#define USC_ISSUE(cc_, s_) do { const int row0_ = chunk_row0(b, dir, (cc_)); \
      _Pragma("unroll") for (int n = 0; n < 4; ++n) { const int ii = wid * 4 + n, qd = ii >> 3, rg = ii & 7; \
        glds16(p.km + (size_t)(row0_ + rg * 16 + (lane >> 2)) * 512 + hd * 128 + qd * 32 + (lane & 3) * 8, \
               (unsigned)__builtin_amdgcn_readfirstlane(ldsb + (s_) * USC_SLOT + qd * 8192 + rg * 1024)); } \
      glds16(p.proj + (size_t)(row0_ + wid * 16 + (lane >> 2)) * PROJW + 1792 + hd * 128 + eb * 32 + (lane & 3) * 8, \
             (unsigned)__builtin_amdgcn_readfirstlane(ldsb + (s_) * USC_SLOT + 32768 + wid * 1024)); \
      if (wid < 2) glds4(p.gsG + (size_t)(row0_ + wid * 64 + lane) * 8 + dir * 4 + hd, (unsigned)__builtin_amdgcn_readfirstlane(ldsb + (s_) * USC_SLOT + 40960 + wid * 256)); \
    } while (0)
    USC_ISSUE(0, 0);
    USC_ISSUE(1, 1);
    if (tid == 0) {
      float be[18], gm[18];
#pragma unroll
      for (int c = 0; c < 18; ++c) { be[c] = p.cBE[chain * 18 + c]; gm[c] = p.cGM[chain * 18 + c]; }
      float m_in = -1e30f;
#pragma unroll
      for (int c = 0; c < 18; ++c) {
        const float m_next = fmaxf(m_in + be[c], be[c] + gm[c]);
        TE1[c] = (be[c] - m_next) * LOG2E;
        TDEC[c] = expf(m_in + be[c] - m_next);
        if (eb == 0) p.cMIN[chain * 18 + c] = m_in * LOG2E;
        m_in = m_next;
      }
    }
    f32x16 cacc;
#pragma unroll
    for (int r = 0; r < 16; ++r) cacc[r] = 0.f;
    float nv = 0.f;
    LDS_BARRIER();
#pragma unroll
    for (int c = 0; c < 17; ++c) {
      const int s = c % 3;
      LAS unsigned char* slot = lds + s * USC_SLOT;
      if (c < 16) asm volatile("s_waitcnt vmcnt(5)" ::: "memory"); else asm volatile("s_waitcnt vmcnt(0)" ::: "memory");
      if (tid < 128) WS[tid] = __builtin_amdgcn_exp2f(*(const LAS float*)(slot + 40960 + tid * 4) + TE1[c]);
      LDS_BARRIER();
      if (c + 2 < 17) USC_ISSUE(c + 2, (c + 2) % 3);
      {
        float f[8];
        unpack8(*(const LAS u32x4*)(slot + 32768 + tid * 16), f);
        const float w = WS[tid >> 2];
#pragma unroll
        for (int j = 0; j < 8; ++j) f[j] *= w;
        *(LAS u32x4*)(slot + 32768 + tid * 16) = pack8(f);
      }
      LDS_BARRIER();
      const float dec = TDEC[c];
      if (wid < 4) {
#pragma unroll
        for (int r = 0; r < 16; ++r) cacc[r] *= dec;
#pragma unroll
        for (int ks = 0; ks < 8; ++ks) {
          const int rb = ks * 16 + 8 * hi;
          const bf16x8 kf = cat44(vtr((lds_cptr)(slot + trq_addr(lane, wid, rb))), vtr((lds_cptr)(slot + trq_addr(lane, wid, rb + 4))));
          const bf16x8 vf = cat44(vtr((lds_cptr)(slot + 32768 + trq_addr(lane, 0, rb))), vtr((lds_cptr)(slot + 32768 + trq_addr(lane, 0, rb + 4))));
          cacc = __builtin_amdgcn_mfma_f32_32x32x16_bf16(kf, vf, cacc, 0, 0, 0);
        }
#pragma unroll
        for (int g4 = 0; g4 < 4; ++g4) {
          u32x2 w2; w2.x = cvt_pk_bf16(cacc[4 * g4], cacc[4 * g4 + 1]); w2.y = cvt_pk_bf16(cacc[4 * g4 + 2], cacc[4 * g4 + 3]);
          *(LAS u32x2*)(lds + USC_CS + r32 * 272 + (wid * 32 + 8 * g4 + 4 * hi) * 2) = w2;
        }
      } else {
        const int t2 = tid - 256, dl = t2 & 31, part = t2 >> 5;
        float acc = 0.f;
#pragma unroll
        for (int i = 0; i < 16; ++i) {
          const int srow = part * 16 + i;
          acc += WS[srow] * bf2f(*(const LAS bf16_t*)(slot + eb * 8192 + srow * 64 + dl * 2));
        }
        NP[part * 32 + dl] = acc;
      }
      LDS_BARRIER();
      {
        const u32x4 cv = *(const LAS u32x4*)(lds + USC_CS + (tid >> 4) * 272 + (tid & 15) * 16);
        *(u32x4*)(p.Cbf + ((size_t)chain * 18 + c + 1) * 16384 + (size_t)(eb * 32 + (tid >> 4)) * 128 + (tid & 15) * 8) = cv;
      }
      if (tid < 32) {
        float sn = 0.f;
#pragma unroll
        for (int q = 0; q < 8; ++q) sn += NP[q * 32 + tid];
        nv = dec * nv + sn;
        p.NVb[((size_t)chain * 18 + c + 1) * 128 + eb * 32 + tid] = nv;
      }
    }
    asm volatile("s_waitcnt vmcnt(0)" ::: "memory");
  }
  __syncthreads();
}

__device__ __forceinline__ void ph_mlstm_h(const Params& p, int l, bool ctx_out, LAS unsigned char* lds) {
  const int e2 = l >> 1;
  const int tid = ltid(), lane = tid & 63, r32 = lane & 31, hi = lane >> 5;
  const int wid = __builtin_amdgcn_readfirstlane(tid >> 6);
  const int tb = wid & 3, dir = wid >> 2;
  LAS float* HX = (LAS float*)(lds);
  LAS float* GC = (LAS float*)(lds + 131072);
  const int j0 = ctx_out ? 0 : 2, nj = 18 - j0;
  for (int unit = lbid(); unit < 32 * nj; unit += lgdim()) {
    const int bh = unit / nj, j = j0 + unit % nj, b = bh >> 2, hd = bh & 3;
    const int row0 = (j < 2) ? NL + b * 256 + j * 128 : b * 2048 + (j - 2) * 128;
    const int cc = dir ? (j < 2 ? 1 - j : 19 - j) : j;
    const int chain = b * 8 + hd * 2 + dir;
    __syncthreads();
#pragma unroll
    for (int n = 0; n < 4; ++n) {
      const int ii = wid * 4 + n;
      { const int ch = ii >> 1, rh = ii & 1;
        const bf16_t* src = p.km + (size_t)(row0 + rh * 64 + lane) * 512 + hd * 128 + ch * 8;
        __builtin_amdgcn_global_load_lds((const unsigned*)src, (LAS unsigned*)(lds + ch * 2048 + rh * 1024), 16, 0, 0); }
      { const int qd = ii >> 3, rg = ii & 7;
        const bf16_t* src = p.proj + (size_t)(row0 + rg * 16 + (lane >> 2)) * PROJW + 1792 + hd * 128 + qd * 32 + (lane & 3) * 8;
        __builtin_amdgcn_global_load_lds((const unsigned*)src, (LAS unsigned*)(lds + 32768 + qd * 8192 + rg * 1024), 16, 0, 0); }
    }
#pragma unroll
    for (int n = 0; n < 8; ++n) {
      const int ii2 = wid * 8 + n, dd = ii2 >> 5, ch = (ii2 & 31) >> 1, rh = ii2 & 1;
      const int ccd = dd ? (j < 2 ? 1 - j : 19 - j) : j;
      if (ccd > 0) {
        const bf16_t* src = p.Cbf + ((size_t)(b * 8 + hd * 2 + dd) * 18 + ccd) * 16384 + (size_t)(rh * 64 + lane) * 128 + ch * 8;
        __builtin_amdgcn_global_load_lds((const unsigned*)src, (LAS unsigned*)(lds + 65536 + dd * 32768 + ch * 2048 + rh * 1024), 16, 0, 0);
      }
    }
    const int trow = row0 + tb * 32 + r32;
    bf16x8 qf[8];
#pragma unroll
    for (int ks = 0; ks < 8; ++ks) qf[ks] = *(const bf16x8*)(p.qm + (size_t)trow * 512 + hd * 128 + ks * 16 + hi * 8);
    const float MIN2 = p.cMIN[chain * 18 + cc];
    const float R2 = -fmaxf(MIN2, p.gsR[(size_t)trow * 8 + dir * 4 + hd]), BQ2 = p.gsB[(size_t)trow * 8 + dir * 4 + hd];
    f32x16 acc[4];
#pragma unroll
    for (int eb = 0; eb < 4; ++eb)
#pragma unroll
      for (int r = 0; r < 16; ++r) acc[eb][r] = 0.f;
    float nq = 0.f;
    if (cc > 0) {
      const float* nvp = p.NVb + ((size_t)chain * 18 + cc) * 128 + hi * 8;
#pragma unroll
      for (int ks = 0; ks < 8; ++ks) {
        const f32x4 n0 = *(const f32x4*)(nvp + ks * 16), n1 = *(const f32x4*)(nvp + ks * 16 + 4);
        float qv[8];
        unpack8(__builtin_bit_cast(u32x4, qf[ks]), qv);
        nq += n0[0] * qv[0] + n0[1] * qv[1] + n0[2] * qv[2] + n0[3] * qv[3] + n1[0] * qv[4] + n1[1] * qv[5] + n1[2] * qv[6] + n1[3] * qv[7];
      }
      nq = half_swap_add(nq);
    }
    const float* gh = p.g_hnorm + e2 * 512 + hd * 128;
    const bf16_t* obp = p.proj + (size_t)trow * PROJW + 2304 + hd * 128;
    const float winter = __builtin_amdgcn_exp2f(MIN2 + R2);
    if (tid < 256) GC[tid] = p.gsG[(size_t)(row0 + (tid & 127)) * 8 + (tid >> 7) * 4 + hd];
    asm volatile("s_waitcnt vmcnt(0)" ::: "memory");
    __syncthreads();
    if (cc > 0) {
#pragma unroll
      for (int eb = 0; eb < 4; ++eb)
#pragma unroll
        for (int ks = 0; ks < 8; ++ks) {
          const bf16x8 a = *(const LAS bf16x8*)(lds + 65536 + dir * 32768 + (2 * ks + hi) * 2048 + (eb * 32 + r32) * 16);
          acc[eb] = __builtin_amdgcn_mfma_f32_32x32x16_bf16(a, qf[ks], acc[eb], 0, 0, 0);
        }
#pragma unroll
      for (int eb = 0; eb < 4; ++eb)
#pragma unroll
        for (int r = 0; r < 16; ++r) acc[eb][r] *= winter;
    }
    float sw = 0.f;
    const int sb_lo = dir ? tb : 0, sb_hi = dir ? 3 : tb;
    for (int sb = sb_lo; sb <= sb_hi; ++sb) {
      f32x16 st;
#pragma unroll
      for (int r = 0; r < 16; ++r) st[r] = 0.f;
#pragma unroll
      for (int ks = 0; ks < 8; ++ks) {
        const bf16x8 kf = *(const LAS bf16x8*)(lds + (2 * ks + hi) * 2048 + (sb * 32 + r32) * 16);
        st = __builtin_amdgcn_mfma_f32_32x32x16_bf16(kf, qf[ks], st, 0, 0, 0);
      }
      const bool diag = (sb == tb);
#pragma unroll
      for (int g4 = 0; g4 < 4; ++g4) {
        const f32x4 gc = *(const LAS f32x4*)(GC + dir * 128 + sb * 32 + 8 * g4 + 4 * hi);
#pragma unroll
        for (int q = 0; q < 4; ++q) {
          const int sl = 8 * g4 + 4 * hi + q;
          float w = __builtin_amdgcn_exp2f(R2 + gc[q]) * st[4 * g4 + q];
          const bool keep = !diag || (dir ? (sl >= r32) : (sl <= r32));
          w = keep ? w : 0.f;
          sw += w;
          st[4 * g4 + q] = w;
        }
      }
      u32x4 p0, p1;
      p0.x = cvt_pk_bf16(st[0], st[1]); p0.y = cvt_pk_bf16(st[2], st[3]); p0.z = cvt_pk_bf16(st[4], st[5]); p0.w = cvt_pk_bf16(st[6], st[7]);
      p1.x = cvt_pk_bf16(st[8], st[9]); p1.y = cvt_pk_bf16(st[10], st[11]); p1.z = cvt_pk_bf16(st[12], st[13]); p1.w = cvt_pk_bf16(st[14], st[15]);
      const bf16x8 pw0 = __builtin_bit_cast(bf16x8, p0), pw1 = __builtin_bit_cast(bf16x8, p1);
#pragma unroll
      for (int eb = 0; eb < 4; ++eb) {
        const int rb = sb * 32 + 4 * hi;
        const bf16x8 a0 = cat44(vtr((lds_cptr)(lds + 32768 + trq_addr(lane, eb, rb))), vtr((lds_cptr)(lds + 32768 + trq_addr(lane, eb, rb + 8))));
        const bf16x8 a1 = cat44(vtr((lds_cptr)(lds + 32768 + trq_addr(lane, eb, rb + 16))), vtr((lds_cptr)(lds + 32768 + trq_addr(lane, eb, rb + 24))));
        acc[eb] = __builtin_amdgcn_mfma_f32_32x32x16_bf16(a0, pw0, acc[eb], 0, 0, 0);
        acc[eb] = __builtin_amdgcn_mfma_f32_32x32x16_bf16(a1, pw1, acc[eb], 0, 0, 0);
      }
    }
    sw = half_swap_add(sw);
    const float den = winter * nq + sw;
    const float dn = fmaxf(fabsf(den), __builtin_amdgcn_exp2f(R2 - BQ2));
    const float idn = 1.f / dn;
    __syncthreads();
    if (dir == 1) {
#pragma unroll
      for (int eb = 0; eb < 4; ++eb)
#pragma unroll
        for (int r = 0; r < 16; ++r) HX[(tb * 128 + eb * 32 + (r & 3) + 8 * (r >> 2) + 4 * hi) * 32 + r32] = acc[eb][r] * idn;
    }
    __syncthreads();
    if (dir == 0) {
      float ss = 0.f;
#pragma unroll
      for (int eb = 0; eb < 4; ++eb)
#pragma unroll
        for (int r = 0; r < 16; ++r) {
          const float v = acc[eb][r] * idn + HX[(tb * 128 + eb * 32 + (r & 3) + 8 * (r >> 2) + 4 * hi) * 32 + r32];
          acc[eb][r] = v; ss += v * v;
        }
      ss = half_swap_add(ss);
      const float inv = rsqrtf(ss * (1.f / 128.f) + EPS);
      bf16_t* op = p.mix + (size_t)trow * 1024 + 512 + hd * 128;
#pragma unroll
      for (int eb = 0; eb < 4; ++eb) {
        f32x4 gv[4]; u32x2 ow[4];
#pragma unroll
        for (int g4 = 0; g4 < 4; ++g4) { const int e0 = eb * 32 + 8 * g4 + 4 * hi; gv[g4] = *(const f32x4*)(gh + e0); ow[g4] = *(const u32x2*)(obp + e0); }
#pragma unroll
        for (int g4 = 0; g4 < 4; ++g4) {
          const int e0 = eb * 32 + 8 * g4 + 4 * hi;
          const float ob0 = __uint_as_float(ow[g4].x << 16), ob1 = __uint_as_float(ow[g4].x & 0xffff0000u), ob2 = __uint_as_float(ow[g4].y << 16), ob3 = __uint_as_float(ow[g4].y & 0xffff0000u);
          const float v0 = acc[eb][4 * g4 + 0] * inv * gv[g4][0] * sigmoidf_(ob0), v1 = acc[eb][4 * g4 + 1] * inv * gv[g4][1] * sigmoidf_(ob1);
          const float v2 = acc[eb][4 * g4 + 2] * inv * gv[g4][2] * sigmoidf_(ob2), v3 = acc[eb][4 * g4 + 3] * inv * gv[g4][3] * sigmoidf_(ob3);
          u32x2 w; w.x = cvt_pk_bf16(v0, v1); w.y = cvt_pk_bf16(v2, v3);
          *(u32x2*)(op + e0) = w;
        }
      }
    }
  }
  __syncthreads();
}

template <int EPL>
__device__ __forceinline__ void topk_column(const Params& p, const float* col, int e, int base, int cap, size_t mbase, int lane) {
  unsigned v[EPL];
#pragma unroll
  for (int k = 0; k < EPL; ++k) v[k] = __float_as_uint(col[k * 64 + lane]);
  unsigned thr = 0u;
  for (int bit = 30; bit >= 0; --bit) {
    const unsigned cand = thr | (1u << bit);
    unsigned c = 0;
#pragma unroll
    for (int k = 0; k < EPL; ++k) c += (v[k] >= cand) ? 1u : 0u;
#pragma unroll
    for (int o = 32; o > 0; o >>= 1) c += __shfl_xor(c, o);
    if (c >= (unsigned)cap) thr = cand;
  }
  unsigned totgt = 0;
#pragma unroll
  for (int k = 0; k < EPL; ++k) totgt += (unsigned)__popcll(__ballot(v[k] > thr));
  const unsigned need_eq = (unsigned)cap - totgt;
  unsigned cg = 0, ce = 0;
#pragma unroll
  for (int k = 0; k < EPL; ++k) {
    const bool gt = v[k] > thr, eq = v[k] == thr;
    const unsigned long long bg = __ballot(gt), be = __ballot(eq);
    const unsigned gtb = cg + __builtin_amdgcn_mbcnt_hi((unsigned)(bg >> 32), __builtin_amdgcn_mbcnt_lo((unsigned)bg, 0u));
    const unsigned eqb = ce + __builtin_amdgcn_mbcnt_hi((unsigned)(be >> 32), __builtin_amdgcn_mbcnt_lo((unsigned)be, 0u));
    const bool take = gt || (eq && eqb < need_eq);
    const int r = base + k * 64 + lane;
    const unsigned slot = gtb + (eqb < need_eq ? eqb : need_eq);
    if (take) { p.slotmap[(size_t)r * 16 + e] = (int)slot; p.rowidx[mbase + slot] = r; p.gatev[mbase + slot] = __uint_as_float(v[k]); }
    else p.slotmap[(size_t)r * 16 + e] = -1;
    cg += (unsigned)__popcll(bg); ce += (unsigned)__popcll(be);
  }
}
__device__ __forceinline__ void ph_topk(const Params& p, bool ctx, float* sm) {
  const int tid = ltid(), lane = tid & 63, wv = tid >> 6;
  const int ntask = ctx ? 32 : 16;
  for (int task = lbid(); task < ntask; task += lgdim()) {
    const bool lat = task < 16;
    const int b = (task >> 1) & 7, eh = task & 1, n = lat ? 2048 : 256, cap = lat ? 256 : 32, base = lat ? b * 2048 : NL + b * 256;
    __syncthreads();
    for (int idx0 = tid; idx0 < n * 2; idx0 += 8 * NTHR) {
      float4 a[8];
#pragma unroll
      for (int u = 0; u < 8; ++u) { const int idx = min(idx0 + u * NTHR, n * 2 - 1); a[u] = *(const float4*)(p.aff + (size_t)(base + (idx >> 1)) * 16 + eh * 8 + (idx & 1) * 4); }
      __builtin_amdgcn_sched_barrier(0);
#pragma unroll
      for (int u = 0; u < 8; ++u) {
        const int idx = idx0 + u * NTHR, row = idx >> 1, q = idx & 1;
        if (idx < n * 2) { sm[(q * 4 + 0) * n + row] = a[u].x; sm[(q * 4 + 1) * n + row] = a[u].y; sm[(q * 4 + 2) * n + row] = a[u].z; sm[(q * 4 + 3) * n + row] = a[u].w; }
      }
    }
    __syncthreads();
    {
      const int e = eh * 8 + wv;
      if (lat) topk_column<32>(p, sm + wv * n, e, base, cap, (size_t)e * 2048 + (size_t)b * 256, lane);
      else topk_column<4>(p, sm + wv * n, e, base, cap, (size_t)MOE_L + (size_t)e * 256 + (size_t)b * 32, lane);
    }
  }
  __syncthreads();
}

template <int W>
__device__ __forceinline__ void pool_item(const Params& p, int r, int c8) {
  int t, n;
  if (r < NL) { t = r & 2047; n = 2048; } else { t = (r - NL) & 255; n = 256; }
  constexpr int lo = W / 2;
  const bf16_t* up = p.proj + (size_t)r * 1024 + c8;
  u32x4 raw[W];
  int cnt = 0;
#pragma unroll
  for (int k = 0; k < W; ++k) {
    const int tt = t - lo + k;
    const bool ok = tt >= 0 && tt < n;
    const int tc = tt < 0 ? 0 : (tt >= n ? n - 1 : tt);
    const u32x4 ld = *(const u32x4*)(up + (ptrdiff_t)(tc - t) * 1024);
    raw[k].x = ok ? ld.x : 0u; raw[k].y = ok ? ld.y : 0u; raw[k].z = ok ? ld.z : 0u; raw[k].w = ok ? ld.w : 0u;
    cnt += ok ? 1 : 0;
  }
  float s8[8], f[8], uc[8];
#pragma unroll
  for (int j = 0; j < 8; ++j) s8[j] = 0.f;
#pragma unroll
  for (int k = 0; k < W; ++k) {
    unpack8(raw[k], f);
#pragma unroll
    for (int j = 0; j < 8; ++j) s8[j] += f[j];
  }
  unpack8(raw[lo], uc);
  const float ic = 1.f / (float)cnt;
#pragma unroll
  for (int j = 0; j < 8; ++j) f[j] = s8[j] * ic - uc[j];
  *(u32x4*)(p.mix + (size_t)r * 1024 + c8) = pack8(f);
}
__device__ __forceinline__ void ph_pool(const Params& p, int nrows) {
  const size_t gtid = (size_t)lbid() * NTHR + ltid(), gsz = (size_t)lgdim() * NTHR;
  for (size_t it = gtid; it < (size_t)nrows * 128; it += gsz) {
    const int g = (int)(it / ((size_t)nrows * 32));
    const size_t rem = it - (size_t)g * nrows * 32;
    const int r = (int)(rem >> 5), c8 = g * 256 + (int)(rem & 31) * 8;
    if (g == 0) pool_item<2>(p, r, c8);
    else if (g == 1) pool_item<4>(p, r, c8);
    else if (g == 2) pool_item<8>(p, r, c8);
    else pool_item<16>(p, r, c8);
  }
}

enum { PH_INIT = 0, PH_NORM1, PH_GEMM_IN_EVEN, PH_POST_EVEN, PH_ATT, PH_MLSTM_U, PH_MLSTM_SCAN, PH_MLSTM_H, PH_GEMM_OUT, PH_NORM2, PH_TOPK, PH_GATHER,
       PH_MOE_GU, PH_MOE_D, PH_GEMM_IN_ODD, PH_POOL, PH_GEMM_GRP, PH_FINAL };

typedef const __attribute__((address_space(4))) Params* KParams;
__device__ __forceinline__ const Params& get_params() {
  KParams kp = (KParams)__builtin_amdgcn_kernarg_segment_ptr();
  asm volatile("" : "+s"(kp));
  return *(const Params*)kp;
}
__device__ __forceinline__ int idle_slots(int nu, int G, int c) {
  const int mx = (nu + G - 1) / G, mine = c < nu ? (nu - c + G - 1) / G : 0;
  return mx - mine;
}
__device__ __forceinline__ void run_phase(int ph, int l, unsigned char* shm) {
  const Params& p = get_params();
  float* sm = (float*)shm;
  LAS unsigned char* lds = (LAS unsigned char*)shm;
  const bool ctx_next = (l < 2);
  const bool ctx_used = (l < 3);
  const int G = lgdim(), c = lbid();
  switch (ph) {
    case PH_INIT: ph_init(p, sm); break;
    case PH_NORM1: {
      const int ncomb = (l == 0) ? 0 : ((l - 1) < 2 ? NT : NL);
      ph_norm(p, l, 1, ctx_used ? NT : NL, ncomb, l - 1, sm);
    } break;
    case PH_GEMM_IN_EVEN: {
      g8::SchedDense S{(const char*)p.hbuf, (const char*)(p.WinE + (size_t)(l >> 1) * PROJW * 1024), 1024, 1024, NT / 256, PROJW / 256, 0, G, c};
      g8::EpiBf16 E{p.proj, PROJW};
      g8::gemm_phase(lds, 1024, 1024, 1024, S, E);
      conv_quota(p, idle_slots(S.nM * S.nN, G, c) * 3, sm);
    } break;
    case PH_POST_EVEN: ph_post_even(p, l, sm); break;
    case PH_ATT: ph_att(p, ctx_next, lds); ph_mlstm_uscan(p, lds); conv_quota(p, idle_slots(256 + (ctx_next ? 32 : 0), G, c) * 1, sm); break;
    case PH_MLSTM_H: ph_mlstm_h(p, l, ctx_next, lds); conv_quota(p, idle_slots(32 * (ctx_next ? 18 : 16), G, c) * 3, sm); break;
    case PH_GEMM_OUT: {
      g8::SchedDense S{(const char*)p.mix, (const char*)(p.WoutE + (size_t)(l >> 1) * 1024 * 1024), 1024, 1024, (ctx_next ? NT : NL) / 256, 4, 0, G, c};
      g8::EpiBf16 E{p.ybuf, 1024};
      g8::gemm_phase(lds, 1024, 1024, 1024, S, E);
      conv_quota(p, idle_slots(S.nM * S.nN, G, c) * 3, sm);
    } break;
    case PH_NORM2: ph_norm(p, l, 2, ctx_next ? NT : NL, 0, 0, sm); break;
    case PH_TOPK: ph_topk(p, ctx_next, sm); conv_until(p, l == 0 ? CE4 : (l == 1 ? CE7 : (l == 2 ? CE10 : CE11)), sm); break;
    case PH_MOE_GU: {
      g8::SchedMoe S{(const char*)p.Xs, (const char*)(p.Wgu + (size_t)l * NEXP * 2048 * 1024), 8, 2048, 128, ctx_next ? 1152 : 1024, G, c};
      g8::EpiSwiGLU E{p.Abuf};
      g8::gemm_phase<true>(lds, 1024, 1024, 1024, S, E, p.rowidx, (const char*)p.hbuf);
      conv_quota(p, idle_slots(S.nu, G, c) * 3, sm);
    } break;
    case PH_MOE_D: {
      g8::SchedMoe S{(const char*)p.Abuf, (const char*)(p.Wd + (size_t)l * NEXP * 1024 * 1024), 4, 1024, 256, ctx_next ? 576 : 512, G, c};
      g8::EpiDown E{p.Ybuf, p.gatev};
      g8::gemm_phase(lds, 1024, 1024, 1024, S, E);
      conv_quota(p, idle_slots(S.nu, G, c) * 3, sm);
    } break;
    case PH_GEMM_IN_ODD: {
      g8::SchedDense S{(const char*)p.hbuf, (const char*)(p.WinO + (size_t)(l >> 1) * 1024 * 1024), 1024, 1024, (ctx_next ? NT : NL) / 256, 4, 0, G, c};
      g8::EpiBf16 E{p.proj, 1024};
      g8::gemm_phase(lds, 1024, 1024, 1024, S, E);
      conv_quota(p, idle_slots(S.nM * S.nN, G, c) * 3, sm);
    } break;
    case PH_POOL: ph_pool(p, ctx_next ? NT : NL); break;
    case PH_GEMM_GRP: {
      g8::SchedDense S{(const char*)p.mix, (const char*)(p.Wgrp + (size_t)(l >> 1) * 1024 * 256), 1024, 256, (ctx_next ? NT : NL) / 256, 4, 512, G, c};
      g8::EpiBf16 E{p.ybuf, 1024};
      g8::gemm_phase(lds, 256, 1024, 256, S, E);
      conv_quota(p, idle_slots(S.nM * S.nN, G, c) * 1, sm);
    } break;
    case PH_FINAL: ph_norm(p, 3, 3, NL, NL, 3, sm); break;
  }
}

__global__ void __launch_bounds__(NTHR) mega_kernel(Params p) {
  extern __shared__ __attribute__((aligned(16))) unsigned char shm[];
  cg::grid_group grid = cg::this_grid();
  volatile LAS unsigned* st = (volatile LAS unsigned*)((LAS unsigned char*)shm + g8::STAGE_BYTES + 1536);
  if (threadIdx.x < 2) st[threadIdx.x] = 0u;
  __syncthreads();
  unsigned* barw;
  { const Params& q = get_params(); barw = q.barw; }
  const XcdBarrier xb = xcd_barrier_post(barw, st);
  const int nprog = p.nprog;
  for (int i = 0; i < nprog; ++i) {
    int ph, l;
    { const Params& q = get_params(); ph = q.prog_ph[i]; l = q.prog_l[i]; }
    run_phase(ph, l, shm);
    if (i + 1 < nprog) { if (nprog > 1000) grid.sync(); else xcd_barrier(xb); }
  }
}

extern "C" void kernel_launch(void* const* d_in, const int* in_sizes, int n_in, void* d_out, int out_size, void* d_ws, size_t ws_size,
                              hipStream_t stream) {
  Params p{};
  const float* const* in = (const float* const*)d_in;
  p.x = in[0]; p.c = in[1]; p.ctx = in[2]; p.c_ctx = in[3]; p.w_mod = in[4]; p.b_mod = in[5]; p.g_norm1 = in[6]; p.g_norm2 = in[7];
  p.w_in_even = in[8]; p.w_out_even = in[9]; p.g_qnorm = in[10]; p.g_knorm = in[11]; p.w_conv = in[12]; p.b_gate = in[13];
  p.g_hnorm = in[14]; p.w_in_odd = in[15]; p.w_pool_grp = in[16]; p.s_pool = in[17]; p.w_router = in[18]; p.w_exp_gate = in[19];
  p.w_exp_up = in[20]; p.w_exp_down = in[21]; p.g_final = in[22];
  p.out = (float*)d_out;
  char* w = (char*)d_ws;
  size_t off = 0;
  auto take = [&](size_t bytes) { char* r = w + off; off += (bytes + 255) & ~(size_t)255; return (void*)r; };
  p.xcur = (bf16_t*)take((size_t)NT * 1024 * 2);
  p.mod = (float*)take(4 * 9 * 6144 * 4);
  p.hbuf = (bf16_t*)take((size_t)NT * 1024 * 2);
  p.Ybuf = (bf16_t*)take((size_t)MOE_T * 1024 * 2);
  p.gatev = (float*)take(MOE_T * 4);
  p.rowidx = (int*)take(MOE_T * 4);
  p.slotmap = (int*)take((size_t)NT * 16 * 4);
  p.barw = (unsigned*)take(XCD_BAR_WORDS * 4);
  p.aff = (float*)take((size_t)NT * 16 * 4);
  p.gates = (float*)take((size_t)NT * 16 * 4);
  p.WinE = (bf16_t*)take((size_t)2 * PROJW * 1024 * 2);
  p.WoutE = (bf16_t*)take((size_t)2 * 1024 * 1024 * 2);
  p.WinO = (bf16_t*)take((size_t)2 * 1024 * 1024 * 2);
  p.Wgrp = (bf16_t*)take((size_t)2 * 1024 * 256 * 2);
  p.Wgu = (bf16_t*)take((size_t)4 * NEXP * 2048 * 1024 * 2);
  p.Wd = (bf16_t*)take((size_t)4 * NEXP * 1024 * 1024 * 2);
  const size_t uoff = off;
  p.proj = (bf16_t*)take((size_t)NT * PROJW * 2);
  p.Qb = (bf16_t*)take((size_t)NT * 512 * 2);
  p.Kb = (bf16_t*)take((size_t)NB * 2 * 2304 * 64 * 2);
  p.Vb = (bf16_t*)take((size_t)NB * 2 * 2304 * 64 * 2);
  p.qm = (bf16_t*)take((size_t)NT * 512 * 2);
  p.km = (bf16_t*)take((size_t)NT * 512 * 2);
  p.gsG = (float*)take((size_t)NT * 8 * 4);
  p.gsR = (float*)take((size_t)NT * 8 * 4);
  p.gsB = (float*)take((size_t)NT * 8 * 4);
  p.cMIN = (float*)take(64 * 18 * 4);
  p.cE1 = (float*)take(64 * 18 * 4);
  p.cDEC = (float*)take(64 * 18 * 4);
  p.cBE = (float*)take(64 * 18 * 4);
  p.cGM = (float*)take(64 * 18 * 4);
  p.Ubuf = (float*)take((size_t)64 * 17 * 16384 * 4);
  p.NLb = (float*)take((size_t)64 * 17 * 128 * 4);
  p.NVb = (float*)take((size_t)64 * 18 * 128 * 4);
  p.Cbf = (bf16_t*)take((size_t)64 * 18 * 16384 * 2);
  p.mix = (bf16_t*)take((size_t)NT * 1024 * 2);
  p.ybuf = (bf16_t*)take((size_t)NT * 1024 * 2);
  const size_t uend = off;
  off = uoff;
  p.Xs = (bf16_t*)take((size_t)MOE_T * 1024 * 2);
  p.Abuf = (bf16_t*)take((size_t)MOE_T * 1024 * 2);
  if (off < uend) off = uend;
  if (off > ws_size) { fprintf(stderr, "ws too small: need %zu have %zu\n", off, ws_size); return; }

  int n = 0;
  auto add = [&](int ph, int l) { p.prog_ph[n] = (unsigned char)ph; p.prog_l[n] = (unsigned char)l; ++n; };
  add(PH_INIT, 0);
  for (int l = 0; l < 4; ++l) {
    add(PH_NORM1, l);
    if ((l & 1) == 0) {
      add(PH_GEMM_IN_EVEN, l); add(PH_POST_EVEN, l); add(PH_ATT, l); add(PH_MLSTM_H, l); add(PH_GEMM_OUT, l);
    } else {
      add(PH_GEMM_IN_ODD, l); add(PH_POOL, l); add(PH_GEMM_GRP, l);
    }
    add(PH_NORM2, l); add(PH_TOPK, l); add(PH_MOE_GU, l); add(PH_MOE_D, l);
  }
  add(PH_FINAL, 0);
  p.nprog = n;

  const int LDS = 143360;
  static int grid_blocks = 0;
  if (!grid_blocks) {
    (void)hipFuncSetAttribute((const void*)mega_kernel, hipFuncAttributeMaxDynamicSharedMemorySize, LDS);
    int dev = 0, cus = 0, per_cu = 0;
    (void)hipGetDevice(&dev);
    (void)hipDeviceGetAttribute(&cus, hipDeviceAttributeMultiprocessorCount, dev);
    (void)hipOccupancyMaxActiveBlocksPerMultiprocessor(&per_cu, mega_kernel, NTHR, LDS);
    if (per_cu < 1) per_cu = 1;
    if (per_cu > 1) per_cu = 1;
    grid_blocks = cus * per_cu;
  }
  (void)hipMemsetAsync(p.barw, 0, XCD_BAR_WORDS * 4, stream);
  void* args[] = {&p};
  hipError_t e = hipLaunchCooperativeKernel((void*)mega_kernel, dim3(grid_blocks), dim3(NTHR), args, LDS, stream);
  if (e != hipSuccess) fprintf(stderr, "cooperative launch failed: %s (grid %d)\n", hipGetErrorString(e), grid_blocks);
}
```

```cpp
#include <hip/hip_runtime.h>
#include <hip/hip_cooperative_groups.h>
#include <math.h>
#include <stdio.h>
namespace cg = cooperative_groups;

#define DM 1024
#define NB 8
#define SEQ 2048
#define CTXL 256
#define NL (NB * SEQ)
#define NC (NB * CTXL)
#define NT (NL + NC)
#define EVEN_IN 2832
#define PROJW 2816
#define NEXP 16
#define MOE_L (NEXP * NB * 256)
#define MOE_C (NEXP * NB * 32)
#define MOE_T (MOE_L + MOE_C)
#define EPS 1e-6f
#define NTHR 512
#define LAS __attribute__((address_space(3)))

typedef unsigned short bf16_t;
typedef short bf16x8 __attribute__((ext_vector_type(8)));
typedef float f32x4 __attribute__((ext_vector_type(4)));
typedef unsigned u32x4 __attribute__((ext_vector_type(4)));
typedef unsigned u32x2 __attribute__((ext_vector_type(2)));

struct Params {
  const float *x, *c, *ctx, *c_ctx, *w_mod, *b_mod, *g_norm1, *g_norm2, *w_in_even, *w_out_even, *g_qnorm, *g_knorm,
      *w_conv, *b_gate, *g_hnorm, *w_in_odd, *w_pool_grp, *s_pool, *w_router, *w_exp_gate, *w_exp_up, *w_exp_down, *g_final;
  float* out;
  bf16_t* xcur;
  float *mod, *gates, *aff, *gatev, *gsG, *gsR, *gsB, *cMIN, *cBE, *cGM, *NVb;
  bf16_t *hbuf, *proj, *mix, *Xs, *Abuf, *Ybuf, *Qb, *Kb, *Vb, *qm, *km, *Cbf, *ybuf;
  bf16_t *WinE, *WoutE, *WinO, *Wgrp, *Wgu, *Wd;
  int *rowidx, *slotmap;
  unsigned* barw;
  int nprog;
  unsigned char prog_ph[60], prog_l[60];
};

__device__ __forceinline__ float siluf(float v) { return v / (1.f + expf(-v)); }
__device__ __forceinline__ float sigmoid_fast(float v) { return __builtin_amdgcn_rcpf(1.f + __expf(-v)); }
__device__ __forceinline__ float silu_fast(float v) { return v * sigmoid_fast(v); }
__device__ __forceinline__ float sigmoidf_(float v) { return 1.f / (1.f + expf(-v)); }
__device__ __forceinline__ float logsigmoidf_(float v) { return fminf(v, 0.f) - __logf(1.f + __expf(-fabsf(v))); }
template <int CTRL, int ROWMASK>
__device__ __forceinline__ float dpp_f(float v) {
  return __uint_as_float((unsigned)__builtin_amdgcn_update_dpp(0, (int)__float_as_uint(v), CTRL, ROWMASK, 0xF, true));
}
__device__ __forceinline__ float row16_sum(float v) {
  v += dpp_f<0xB1, 0xF>(v);
  v += dpp_f<0x4E, 0xF>(v);
  v += dpp_f<0x141, 0xF>(v);
  v += dpp_f<0x140, 0xF>(v);
  return v;
}
__device__ __forceinline__ float row16_max(float v) {
  v = fmaxf(v, dpp_f<0xB1, 0xF>(v));
  v = fmaxf(v, dpp_f<0x4E, 0xF>(v));
  v = fmaxf(v, dpp_f<0x141, 0xF>(v));
  v = fmaxf(v, dpp_f<0x140, 0xF>(v));
  return v;
}
__device__ __forceinline__ float wave_sum(float v) {
  v = row16_sum(v);
  v += dpp_f<0x142, 0xA>(v);
  v += dpp_f<0x143, 0xC>(v);
  return __uint_as_float((unsigned)__builtin_amdgcn_readlane((int)__float_as_uint(v), 63));
}
#define LOADS_ISSUED() do { asm volatile("" ::: "memory"); __builtin_amdgcn_sched_barrier(0); } while (0)
#define LDS_BARRIER() do { asm volatile("s_waitcnt lgkmcnt(0)" ::: "memory"); __builtin_amdgcn_s_barrier(); asm volatile("" ::: "memory"); } while (0)
__device__ __forceinline__ int modrow(int r) { return r < NL ? (r >> 11) : 8; }
__device__ __forceinline__ float bf2f(bf16_t v) { return __uint_as_float(((unsigned)v) << 16); }
typedef float f32x2_t __attribute__((ext_vector_type(2)));
typedef __bf16 bf16x2_t __attribute__((ext_vector_type(2)));
__device__ __forceinline__ unsigned cvt_pk_bf16(float lo, float hi) {
  const f32x2_t v = {lo, hi};
  return __builtin_bit_cast(unsigned, __builtin_convertvector(v, bf16x2_t));
}
__device__ __forceinline__ bf16_t f2bf(float f) { return (bf16_t)(cvt_pk_bf16(f, 0.f) & 0xffffu); }
__device__ __forceinline__ void unpack8(const u32x4 w, float (&f)[8]) {
  f[0] = __uint_as_float(w.x << 16); f[1] = __uint_as_float(w.x & 0xffff0000u); f[2] = __uint_as_float(w.y << 16); f[3] = __uint_as_float(w.y & 0xffff0000u);
  f[4] = __uint_as_float(w.z << 16); f[5] = __uint_as_float(w.z & 0xffff0000u); f[6] = __uint_as_float(w.w << 16); f[7] = __uint_as_float(w.w & 0xffff0000u);
}
__device__ __forceinline__ u32x4 pack8(const float (&f)[8]) {
  u32x4 w; w.x = cvt_pk_bf16(f[0], f[1]); w.y = cvt_pk_bf16(f[2], f[3]); w.z = cvt_pk_bf16(f[4], f[5]); w.w = cvt_pk_bf16(f[6], f[7]);
  return w;
}

__device__ __forceinline__ int ltid() { int t = threadIdx.x; asm volatile("" : "+v"(t)); return t; }
__device__ __forceinline__ int lbid() { int b = blockIdx.x; asm volatile("" : "+s"(b)); return b; }
__device__ __forceinline__ int lgdim() { int g = gridDim.x; asm volatile("" : "+s"(g)); return g; }

#define XB_TMO      128
#define XB_XCNT(j)  (256  + 64 * (j))
#define XB_XSUB(j)  (1280 + 64 * (j))
#define XB_XGEN(j)  (2304 + 64 * (j))
#define XB_TOP      3328
#define XB_TOPGEN   3392
#define XCD_BAR_WORDS 3456
#define XB_SPIN_CAP (1u << 18)
__device__ __forceinline__ unsigned xb_ld(unsigned* p)              { return __hip_atomic_load(p, __ATOMIC_RELAXED, __HIP_MEMORY_SCOPE_AGENT); }
__device__ __forceinline__ unsigned xb_add(unsigned* p, unsigned v) { return __hip_atomic_fetch_add(p, v, __ATOMIC_RELAXED, __HIP_MEMORY_SCOPE_AGENT); }
__device__ __forceinline__ unsigned xb_xcc_id() { return (unsigned)__builtin_amdgcn_s_getreg((3 << 11) | 20) & 0xFu; }
#define XB_SPIN(cond, bar) do { unsigned _sp = 0; while (cond) { __builtin_amdgcn_s_sleep(1); \
    if ((++_sp & 255u) == 0u) { if (xb_ld(&(bar)[XB_TMO])) break; if (_sp > XB_SPIN_CAP) { atomicAdd(&(bar)[XB_TMO], 1u); break; } } } } while (0)
struct XcdBarrier { unsigned* bar; unsigned x; volatile LAS unsigned* st; };
__device__ __forceinline__ XcdBarrier xcd_barrier_post(unsigned* bar, volatile LAS unsigned* st) {
  XcdBarrier b; b.bar = bar; b.x = xb_xcc_id(); b.st = st;
  if (threadIdx.x == 0) (void)xb_add(&bar[XB_XCNT(b.x)], 1u);
  return b;
}
__device__ __forceinline__ void xcd_barrier_complete(unsigned* bar, unsigned x, unsigned& nloc, unsigned& nx) {
  const unsigned G = gridDim.x * gridDim.y * gridDim.z;
  unsigned sum, cnt, mine, sp = 0u;
  for (;;) {
    sum = 0u; cnt = 0u; mine = 0u;
#pragma unroll
    for (unsigned j = 0; j < 16; ++j) { const unsigned c = xb_ld(&bar[XB_XCNT(j)]); sum += c; cnt += (c > 0u) ? 1u : 0u; mine = (j == x) ? c : mine; }
    if (sum == G) break;
    __builtin_amdgcn_s_sleep(1);
    if ((++sp & 255u) == 0u) { if (xb_ld(&bar[XB_TMO])) break; if (sp > XB_SPIN_CAP) { atomicAdd(&bar[XB_TMO], 1u); break; } }
  }
  nloc = mine > 0u ? mine : 1u; nx = cnt > 0u ? cnt : 1u;
}
__device__ __forceinline__ void xcd_barrier(const XcdBarrier& b) {
  asm volatile("s_waitcnt vmcnt(0)" ::: "memory");
  __syncthreads();
  if (threadIdx.x == 0) {
    unsigned* bar = b.bar;
    __builtin_amdgcn_s_waitcnt(0);
    unsigned nloc = b.st[0], nx = b.st[1];
    if (nloc == 0u) { xcd_barrier_complete(bar, b.x, nloc, nx); b.st[0] = nloc; b.st[1] = nx; }
    const unsigned old = xb_add(&bar[XB_XSUB(b.x)], 1u);
    const unsigned gen = old / nloc;
    if (old + 1u == (gen + 1u) * nloc) {
      __builtin_amdgcn_fence(__ATOMIC_RELEASE, "agent");
      asm volatile("s_waitcnt vmcnt(0)" ::: "memory");
      const unsigned og = xb_add(&bar[XB_TOP], 1u);
      const unsigned tg = og / nx;
      if (og + 1u == (tg + 1u) * nx) xb_add(&bar[XB_TOPGEN], 1u);
      else XB_SPIN(xb_ld(&bar[XB_TOPGEN]) == tg, bar);
      __builtin_amdgcn_fence(__ATOMIC_ACQUIRE, "agent");
      xb_add(&bar[XB_XGEN(b.x)], 1u);
      asm volatile("s_waitcnt vmcnt(0)" ::: "memory");
    } else {
      XB_SPIN(xb_ld(&bar[XB_XGEN(b.x)]) == gen, bar);
      __builtin_amdgcn_fence(__ATOMIC_ACQUIRE, "agent");
      asm volatile("s_waitcnt vmcnt(0)" ::: "memory");
    }
  }
  __syncthreads();
}

namespace g8 {
constexpr int BM = 256, BK = 64, HALF = 128, HTB = HALF * BK * 2, STAGE_BYTES = 8 * HTB;
__device__ __forceinline__ int lds_byte(int r, int c) { const int st = (r >> 4) * 2 + (c >> 5), rr = r & 15, cc = c & 31, ob = rr * 64 + cc * 2; return st * 1024 + (ob ^ (((ob >> 9) & 1) << 5)); }
__device__ __forceinline__ void stage_rc(int b, int& R, int& C) { const int st = b / 1024, sb = b % 1024, swz = sb ^ (((sb >> 9) & 1) << 5); R = (st >> 1) * 16 + swz / 64; C = (st & 1) * 32 + (swz % 64) / 2; }
__device__ __forceinline__ int perm32(int rho) { const int n = rho >> 4, i = rho & 15; return 8 * (i >> 2) + 4 * n + (i & 3); }

struct Unit { const char* A; const char* B; int row0, col0; };

template <bool GATHER = false, class Epi, class Sched>
__device__ __forceinline__ void gemm_phase(LAS unsigned char* lds, const int K, const int lda, const int ldb, const Sched& S, const Epi& E, const int* gidx = nullptr, const char* gbaseA = nullptr) {
  const int tid = ltid(), wid = __builtin_amdgcn_readfirstlane(tid >> 6), lane = tid & 63, wr = wid >> 2, wc = wid & 3, fr = lane & 15, fq = lane >> 4;
  const int nt = K / BK;
  unsigned voffA[2], voffB[2], gC2[2];
  int gR[2];
#pragma unroll
  for (int i = 0; i < 2; ++i) {
    int R, C;
    stage_rc(tid * 16 + i * 8192, R, C);
    const int Rb = (R & ~31) + perm32(R & 31);
    voffA[i] = (unsigned)(R * lda + C) * 2u;
    voffB[i] = (unsigned)(Rb * ldb + C) * 2u;
    gR[i] = R; gC2[i] = (unsigned)C * 2u;
  }
  unsigned gcur[2][2], gnxt[2][2];
  auto gload = [&](int row0, unsigned (&g)[2][2]) {
#pragma unroll
    for (int h = 0; h < 2; ++h)
#pragma unroll
      for (int i = 0; i < 2; ++i) g[h][i] = (unsigned)gidx[row0 + h * HALF + gR[i]];
  };
  const size_t kstep = (size_t)(BK * 2);
  const size_t hstepA = (size_t)HALF * lda * 2, hstepB = (size_t)HALF * ldb * 2;
  const unsigned ldsw = (unsigned)wid * 1024u;
  const int aoff = lds_byte(wr * 64 + fr, fq * 8), boff = lds_byte(wc * 32 + fr, fq * 8);
#define PG8_SA(b, h) (((b) * 2 + (h)) * HTB)
#define PG8_SB(b, h) ((4 + (b) * 2 + (h)) * HTB)
#define PG8_STAGE(bufoff, gbase, voff) do { _Pragma("unroll") for (int _i = 0; _i < 2; ++_i) \
    __builtin_amdgcn_global_load_lds((const unsigned*)((const char*)(gbase) + (voff)[_i]), (LAS unsigned*)(lds + (bufoff) + ldsw + _i * 8192), 16, 0, 0); } while (0)
#define PG8_LDA(dst, b, h) do { _Pragma("unroll") for (int m = 0; m < 4; ++m) _Pragma("unroll") for (int k = 0; k < 2; ++k) dst[m][k] = *(const LAS bf16x8*)(lds + PG8_SA(b, h) + aoff + m * 2048 + k * 1024); } while (0)
#define PG8_LDB(dst, b, h) do { _Pragma("unroll") for (int n = 0; n < 2; ++n) _Pragma("unroll") for (int k = 0; k < 2; ++k) dst[n][k] = *(const LAS bf16x8*)(lds + PG8_SB(b, h) + boff + n * 2048 + k * 1024); } while (0)
#define PG8_MMA(ai, bj, At, Bt) do { __builtin_amdgcn_s_setprio(1); _Pragma("unroll") for (int m = 0; m < 4; ++m) _Pragma("unroll") for (int n = 0; n < 2; ++n) _Pragma("unroll") for (int k = 0; k < 2; ++k) \
    acc[ai][bj][m][n] = __builtin_amdgcn_mfma_f32_16x16x32_bf16(Bt[n][k], At[m][k], acc[ai][bj][m][n], 0, 0, 0); __builtin_amdgcn_s_setprio(0); } while (0)
#define PG8_WAIT_V(n) asm volatile("s_waitcnt vmcnt(" #n ")" ::: "memory")
#define PG8_WAIT_L(n) asm volatile("s_waitcnt lgkmcnt(" #n ")" ::: "memory")
#define PG8_BAR __builtin_amdgcn_s_barrier()
#define PG8_SCHED __builtin_amdgcn_sched_barrier(0)
#define PG8_STAGE_A(bufoff, nextu, half, kbytes) do { \
    if constexpr (GATHER) { unsigned go_[2]; _Pragma("unroll") for (int _j = 0; _j < 2; ++_j) go_[_j] = ((nextu) ? gnxt[half][_j] : gcur[half][_j]) * (unsigned)(lda * 2) + gC2[_j]; \
      PG8_STAGE(bufoff, gbaseA + (kbytes), go_); } \
    else { PG8_STAGE(bufoff, ((nextu) ? nA : cA) + (half) * hstepA + (kbytes), voffA); } } while (0)
  Unit cur, nxt;
  int ui = 0;
  if (!S.next(0, cur)) return;
  f32x4 acc[2][2][4][2];
#pragma unroll
  for (int a = 0; a < 2; ++a)
#pragma unroll
    for (int b = 0; b < 2; ++b)
#pragma unroll
      for (int m = 0; m < 4; ++m)
#pragma unroll
        for (int n = 0; n < 2; ++n) acc[a][b][m][n] = (f32x4){0.f, 0.f, 0.f, 0.f};
  bf16x8 At[4][2], B0[2][2], B1[2][2];
  const char* cA = cur.A;
  const char* cB = cur.B;
  const char* nA = cA;
  if constexpr (GATHER) { gload(cur.row0, gcur); gload(cur.row0, gnxt); asm volatile("s_waitcnt vmcnt(0)" ::: "memory"); }
  PG8_STAGE(PG8_SB(0, 0), cB, voffB); PG8_STAGE(PG8_SB(0, 1), cB + hstepB, voffB); PG8_STAGE_A(PG8_SA(0, 0), false, 0, 0); PG8_STAGE_A(PG8_SA(0, 1), false, 1, 0);
  if (wr == 1) PG8_BAR;
  PG8_WAIT_V(2); PG8_BAR;
  PG8_STAGE(PG8_SB(1, 0), cB + kstep, voffB); PG8_STAGE_A(PG8_SA(1, 0), false, 0, kstep); PG8_STAGE(PG8_SB(1, 1), cB + hstepB + kstep, voffB);
  PG8_WAIT_V(6); PG8_BAR;
  for (;;) {
    const bool has_next = S.next(ui + 1, nxt);
    nA = has_next ? nxt.A : cA;
    const char* nB = has_next ? nxt.B : cB;
    if constexpr (GATHER) { if (has_next) gload(nxt.row0, gnxt); else {
#pragma unroll
      for (int h = 0; h < 2; ++h)
#pragma unroll
        for (int i = 0; i < 2; ++i) gnxt[h][i] = gcur[h][i]; } }
    for (int t = 0; t < nt; t += 2) {
      const bool last = (t == nt - 2);
      const size_t k1 = (size_t)(t + 1) * kstep;
      const size_t k2 = last ? 0 : (size_t)(t + 2) * kstep;
      const size_t k3 = k2 + kstep;
      const char* b2 = last ? nB : cB + (size_t)(t + 2) * kstep;
      const char* b3 = b2 + kstep;
      PG8_LDB(B0, 0, 0); PG8_LDB(B1, 0, 1); PG8_SCHED; PG8_LDA(At, 0, 0); PG8_STAGE_A(PG8_SA(1, 1), false, 1, k1);
      PG8_WAIT_V(8); PG8_WAIT_L(0); PG8_BAR; PG8_MMA(0, 0, At, B0); PG8_MMA(0, 1, At, B1); PG8_BAR; PG8_SCHED;
      PG8_LDA(At, 0, 1); PG8_STAGE(PG8_SB(0, 0), b2, voffB); PG8_STAGE(PG8_SB(0, 1), b2 + hstepB, voffB); PG8_STAGE_A(PG8_SA(0, 0), last, 0, k2);
      PG8_WAIT_V(8); PG8_WAIT_L(0); PG8_BAR; PG8_MMA(1, 0, At, B0); PG8_MMA(1, 1, At, B1); PG8_BAR; PG8_SCHED;
      PG8_LDB(B0, 1, 0); PG8_LDB(B1, 1, 1); PG8_SCHED; PG8_LDA(At, 1, 0); PG8_STAGE_A(PG8_SA(0, 1), last, 1, k2);
      PG8_WAIT_V(8); PG8_WAIT_L(0); PG8_BAR; PG8_MMA(0, 0, At, B0); PG8_MMA(0, 1, At, B1); PG8_BAR; PG8_SCHED;
      PG8_LDA(At, 1, 1); PG8_STAGE(PG8_SB(1, 0), b3, voffB); PG8_STAGE(PG8_SB(1, 1), b3 + hstepB, voffB); PG8_STAGE_A(PG8_SA(1, 0), last, 0, k3);
      PG8_WAIT_V(8); PG8_WAIT_L(0); PG8_BAR; PG8_MMA(1, 0, At, B0); PG8_MMA(1, 1, At, B1); PG8_BAR; PG8_SCHED;
    }
    if (wr == 0) PG8_BAR;
    E(acc, cur, wr, wc, fr, fq);
    if (!has_next) break;
#pragma unroll
    for (int a = 0; a < 2; ++a)
#pragma unroll
      for (int b = 0; b < 2; ++b)
#pragma unroll
        for (int m = 0; m < 4; ++m)
#pragma unroll
          for (int n = 0; n < 2; ++n) acc[a][b][m][n] = (f32x4){0.f, 0.f, 0.f, 0.f};
    cur = nxt; cA = nA; cB = nB; ++ui;
    if constexpr (GATHER) {
#pragma unroll
      for (int h = 0; h < 2; ++h)
#pragma unroll
        for (int i = 0; i < 2; ++i) gcur[h][i] = gnxt[h][i];
    }
    if (wr == 1) PG8_BAR;
  }
  PG8_WAIT_V(0);
  PG8_BAR;
#undef PG8_SA
#undef PG8_SB
#undef PG8_STAGE
#undef PG8_STAGE_A
#undef PG8_LDA
#undef PG8_LDB
#undef PG8_MMA
#undef PG8_WAIT_V
#undef PG8_WAIT_L
#undef PG8_BAR
#undef PG8_SCHED
}

struct SchedDense {
  const char* A; const char* B; int lda, ldb, nM, nN, acolstep, G, c;
  __device__ __forceinline__ bool next(int i, Unit& u) const {
    const int nwg = nM * nN;
    const long L = (long)i * G + c;
    if (L >= nwg) return false;
    int wgid = (int)L;
    { const int q = nwg / 8, r = nwg % 8, xcd = wgid % 8, off = wgid / 8; wgid = (xcd < r ? xcd * (q + 1) : r * (q + 1) + (xcd - r) * q) + off; }
    const int nig = 8 * nN, gid = wgid / nig, fm = gid * 8, gsz = (nM - fm) < 8 ? (nM - fm) : 8;
    const int pm = fm + ((wgid % nig) % gsz), pn = (wgid % nig) / gsz;
    u.A = A + (size_t)pm * 256 * lda * 2 + (size_t)pn * acolstep;
    u.B = B + (size_t)pn * 256 * ldb * 2;
    u.row0 = pm * 256; u.col0 = pn * 256;
    return true;
  }
};
struct SchedMoe {
  const char* A; const char* W; int ncol, wrows, colw, nu, G, c;
  __device__ __forceinline__ bool next(int i, Unit& u) const {
    const long L = (long)i * G + c;
    if (L >= nu) return false;
    const int wgid = (int)(L % 8) * (nu / 8) + (int)(L / 8);
    const int UL = 128 * ncol;
    int e, pn, row0;
    if (wgid < UL) { e = wgid / (8 * ncol); const int rem = wgid % (8 * ncol); row0 = e * 2048 + (rem % 8) * 256; pn = rem / 8; }
    else { const int w2 = wgid - UL; e = w2 / ncol; pn = w2 % ncol; row0 = MOE_L + e * 256; }
    u.A = A + (size_t)row0 * 1024 * 2;
    u.B = W + ((size_t)e * wrows + (size_t)pn * 256) * 1024 * 2;
    u.row0 = row0; u.col0 = pn * colw;
    return true;
  }
};

struct EpiBf16 {
  bf16_t* O; int ldo;
  __device__ __forceinline__ void operator()(const f32x4 (&acc)[2][2][4][2], const Unit& u, int wr, int wc, int fr, int fq) const {
#pragma unroll
    for (int ai = 0; ai < 2; ++ai)
#pragma unroll
      for (int m = 0; m < 4; ++m) {
        const int row = u.row0 + ai * 128 + wr * 64 + m * 16 + fr;
        bf16_t* rp = O + (size_t)row * ldo + u.col0 + wc * 32 + 8 * fq;
#pragma unroll
        for (int bj = 0; bj < 2; ++bj) {
          const f32x4 v0 = acc[ai][bj][m][0], v1 = acc[ai][bj][m][1];
          u32x4 w; w.x = cvt_pk_bf16(v0[0], v0[1]); w.y = cvt_pk_bf16(v0[2], v0[3]); w.z = cvt_pk_bf16(v1[0], v1[1]); w.w = cvt_pk_bf16(v1[2], v1[3]);
          *(u32x4*)(rp + bj * 128) = w;
        }
      }
  }
};
struct EpiResid {
  float* x; const float* modg; const float* cs; const float* xl; const float* xc;
  __device__ __forceinline__ void operator()(const f32x4 (&acc)[2][2][4][2], const Unit& u, int wr, int wc, int fr, int fq) const {
#pragma unroll
    for (int ai = 0; ai < 2; ++ai)
#pragma unroll
      for (int m = 0; m < 4; ++m) {
        const int row = u.row0 + ai * 128 + wr * 64 + m * 16 + fr;
        const int c0 = u.col0 + wc * 32 + 8 * fq;
        float* xp = x + (size_t)row * 1024 + c0;
        const float* xi = xl ? (row < NL ? xl + (size_t)row * 1024 + c0 : xc + (size_t)(row - NL) * 1024 + c0) : xp;
        const float* gp = modg + (size_t)modrow(row) * 6144 + c0;
#pragma unroll
        for (int bj = 0; bj < 2; ++bj) {
          f32x4 g0 = *(const f32x4*)(gp + bj * 128), g1 = *(const f32x4*)(gp + bj * 128 + 4);
          if (cs) { g0 *= *(const f32x4*)(cs + c0 + bj * 128); g1 *= *(const f32x4*)(cs + c0 + bj * 128 + 4); }
          f32x4 x0 = *(const f32x4*)(xi + bj * 128), x1 = *(const f32x4*)(xi + bj * 128 + 4);
          x0 += g0 * acc[ai][bj][m][0]; x1 += g1 * acc[ai][bj][m][1];
          *(f32x4*)(xp + bj * 128) = x0; *(f32x4*)(xp + bj * 128 + 4) = x1;
        }
      }
  }
};
struct EpiSwiGLU {
  bf16_t* O;
  __device__ __forceinline__ void operator()(const f32x4 (&acc)[2][2][4][2], const Unit& u, int wr, int wc, int fr, int fq) const {
#pragma unroll
    for (int ai = 0; ai < 2; ++ai)
#pragma unroll
      for (int m = 0; m < 4; ++m) {
        const int row = u.row0 + ai * 128 + wr * 64 + m * 16 + fr;
        bf16_t* rp = O + (size_t)row * 1024 + u.col0 + wc * 32 + 8 * fq;
        float o[8];
#pragma unroll
        for (int n = 0; n < 2; ++n)
#pragma unroll
          for (int j = 0; j < 4; ++j) { const float g = acc[ai][0][m][n][j], up = acc[ai][1][m][n][j]; o[n * 4 + j] = silu_fast(g) * up; }
        u32x4 w; w.x = cvt_pk_bf16(o[0], o[1]); w.y = cvt_pk_bf16(o[2], o[3]); w.z = cvt_pk_bf16(o[4], o[5]); w.w = cvt_pk_bf16(o[6], o[7]);
        *(u32x4*)rp = w;
      }
  }
};
struct EpiDown {
  bf16_t* O; const float* gatev;
  __device__ __forceinline__ void operator()(const f32x4 (&acc)[2][2][4][2], const Unit& u, int wr, int wc, int fr, int fq) const {
    float gv[2][4];
#pragma unroll
    for (int ai = 0; ai < 2; ++ai)
#pragma unroll
      for (int m = 0; m < 4; ++m) gv[ai][m] = gatev[u.row0 + ai * 128 + wr * 64 + m * 16 + fr];
    __builtin_amdgcn_sched_barrier(0);
#pragma unroll
    for (int ai = 0; ai < 2; ++ai)
#pragma unroll
      for (int m = 0; m < 4; ++m) {
        const int row = u.row0 + ai * 128 + wr * 64 + m * 16 + fr;
        bf16_t* rp = O + (size_t)row * 1024 + u.col0 + wc * 32 + 8 * fq;
#pragma unroll
        for (int bj = 0; bj < 2; ++bj) {
          const f32x4 v0 = acc[ai][bj][m][0] * gv[ai][m], v1 = acc[ai][bj][m][1] * gv[ai][m];
          u32x4 w; w.x = cvt_pk_bf16(v0[0], v0[1]); w.y = cvt_pk_bf16(v0[2], v0[3]); w.z = cvt_pk_bf16(v1[0], v1[1]); w.w = cvt_pk_bf16(v1[2], v1[3]);
          *(u32x4*)(rp + bj * 128) = w;
        }
      }
  }
};
}

#define NT_WINE 1408
#define NT_WOUT 512
#define NT_WINO 512
#define NT_WGRP 128
#define NT_EXP 16384
#define NT_ALL (NT_WINE + NT_WOUT + NT_WINO + NT_WGRP + 3 * NT_EXP)
#define CE0 704
#define CE1 960
#define CE2 13248
#define CE3 13504
#define CE4 13568
#define CE5 25856
#define CE6 26560
#define CE7 26816
#define CE8 39104
#define CE9 39360
#define CE10 39424
#define CE11 51712
typedef float f32x4c __attribute__((ext_vector_type(4)));
__device__ __forceinline__ void conv_batch(const Params& p, int t, float* T) {
  const int tid = ltid(), lane = tid & 63, wv = tid >> 6;
  const float* src; bf16_t* dst; int ld, dK, k0, n0;
  int seg, tb, e, which = 0;
  if (t < CE0) { seg = 0; e = 0; tb = t; } else if (t < CE1) { seg = 1; e = 0; tb = t - CE0; } else if (t < CE2) { seg = 2; e = 0; tb = t - CE1; }
  else if (t < CE3) { seg = 3; e = 0; tb = t - CE2; } else if (t < CE4) { seg = 4; e = 0; tb = t - CE3; } else if (t < CE5) { seg = 2; e = 1; tb = t - CE4; }
  else if (t < CE6) { seg = 0; e = 1; tb = t - CE5; } else if (t < CE7) { seg = 1; e = 1; tb = t - CE6; } else if (t < CE8) { seg = 2; e = 2; tb = t - CE7; }
  else if (t < CE9) { seg = 3; e = 1; tb = t - CE8; } else if (t < CE10) { seg = 4; e = 1; tb = t - CE9; } else { seg = 2; e = 3; tb = t - CE10; }
  int dbase = 0;
  if (seg == 0) {
    k0 = (tb / 44) * 64; n0 = (tb % 44) * 64;
    src = p.w_in_even + (size_t)e * 1024 * EVEN_IN; ld = EVEN_IN; dst = p.WinE + (size_t)e * PROJW * 1024; dK = 1024;
  } else if (seg == 1 || seg == 3) {
    k0 = (tb / 16) * 64; n0 = (tb % 16) * 64;
    src = (seg == 3 ? p.w_in_odd : p.w_out_even) + (size_t)e * 1024 * 1024; ld = 1024; dst = (seg == 3 ? p.WinO : p.WoutE) + (size_t)e * 1024 * 1024; dK = 1024;
  } else if (seg == 4) {
    const int g = tb / 16; k0 = ((tb % 16) / 4) * 64; n0 = (tb % 4) * 64;
    src = p.w_pool_grp + (size_t)(e * 4 + g) * 65536; ld = 256; dst = p.Wgrp + (size_t)e * 1024 * 256; dK = 256; dbase = g * 256;
  } else {
    which = tb / 4096; const int r = tb % 4096, le = e * 16 + r / 256; k0 = ((r % 256) / 16) * 64; n0 = (r % 16) * 64;
    const float* base = which == 0 ? p.w_exp_gate : (which == 1 ? p.w_exp_up : p.w_exp_down);
    src = base + (size_t)le * 1024 * 1024; ld = 1024; dK = 1024;
    dst = which < 2 ? p.Wgu + (size_t)le * 2048 * 1024 : p.Wd + (size_t)le * 1024 * 1024;
  }
  const bool gu = (seg == 2 && which < 2);
  float4 v[8];
#pragma unroll
  for (int q = 0; q < 8; ++q) {
    const int idx = tid + q * NTHR, k = idx >> 6, c4 = idx & 63;
    { const f32x4c t_ = __builtin_nontemporal_load((const f32x4c*)(src + (size_t)(k0 + k) * ld + n0 + c4 * 4)); v[q] = make_float4(t_[0], t_[1], t_[2], t_[3]); }
  }
  __builtin_amdgcn_sched_barrier(0);
#pragma unroll
  for (int q = 0; q < 8; ++q) {
    const int idx = tid + q * NTHR, k = idx >> 6, c4 = idx & 63;
    float* tp = T + k * 257 + c4 * 4;
    tp[0] = v[q].x; tp[1] = v[q].y; tp[2] = v[q].z; tp[3] = v[q].w;
  }
  __syncthreads();
#pragma unroll
  for (int sub = 0; sub < 4; ++sub) {
    const int nl = wv * 8 + (lane >> 3), kq = lane & 7, nn = n0 + sub * 64;
    const int drow0 = gu ? (nn >> 7) * 256 + which * 128 + (nn & 127) : dbase + nn;
    float f[8];
#pragma unroll
    for (int j = 0; j < 8; ++j) f[j] = T[(kq * 8 + j) * 257 + sub * 64 + nl];
    u32x4 w; w.x = cvt_pk_bf16(f[0], f[1]); w.y = cvt_pk_bf16(f[2], f[3]); w.z = cvt_pk_bf16(f[4], f[5]); w.w = cvt_pk_bf16(f[6], f[7]);
    __builtin_nontemporal_store(w, (u32x4*)(dst + (size_t)(drow0 + nl) * dK + k0 + kq * 8));
  }
}
__device__ __forceinline__ int conv_pull(const Params& p, float* sm) {
  __syncthreads();
  if (ltid() == 0) ((int*)sm)[16500] = (int)__hip_atomic_fetch_add(p.barw, 4u, __ATOMIC_RELAXED, __HIP_MEMORY_SCOPE_AGENT);
  __syncthreads();
  return ((int*)sm)[16500];
}
__device__ __forceinline__ void conv_until(const Params& p, int end, float* sm) {
  int t;
  do { t = conv_pull(p, sm); if (t < CE11) conv_batch(p, t, sm); } while (t + 4 < end);
  __syncthreads();
}
__device__ __forceinline__ void conv_quota(const Params& p, int n, float* sm) {
  for (int i = 0; i < n; ++i) { const int t = conv_pull(p, sm); if (t >= CE11) break; conv_batch(p, t, sm); }
  __syncthreads();
}

__device__ __forceinline__ void ph_init(const Params& p, float* sm) {
  const int tid = ltid(), lane = tid & 63, wv = tid >> 6;
  for (int i = tid; i < 9 * 1024; i += NTHR) {
    const int r = i >> 10, k = i & 1023;
    sm[k * 12 + r] = siluf(r < 8 ? p.c[r * 1024 + k] : p.c_ctx[k]);
  }
  __syncthreads();
  float* part = sm + 12 * 1024;
  for (int item = lbid(); item < 768; item += lgdim()) {
    const int l = item / 192, j0 = (item % 192) * 32;
    const int col = lane & 31, kh = lane >> 5;
    const float* w = p.w_mod + (size_t)l * 1024 * 6144 + j0 + col;
    f32x4 a0 = {0.f, 0.f, 0.f, 0.f}, a1 = {0.f, 0.f, 0.f, 0.f};
    float a8 = 0.f;
    const int kb = wv * 128 + kh * 64;
    for (int k0 = 0; k0 < 64; k0 += 32) {
      float wv16[32];
#pragma unroll
      for (int kk = 0; kk < 32; ++kk) wv16[kk] = w[(size_t)(kb + k0 + kk) * 6144];
      __builtin_amdgcn_sched_barrier(0);
#pragma unroll
      for (int kk = 0; kk < 32; ++kk) {
        const float* sp = sm + (kb + k0 + kk) * 12;
        const f32x4 s0 = *(const f32x4*)sp, s1 = *(const f32x4*)(sp + 4);
        const float s8 = sp[8], wk = wv16[kk];
        a0 += s0 * wk; a1 += s1 * wk; a8 += s8 * wk;
      }
    }
    {
      float* pp = part + ((wv * 2 + kh) * 9) * 32 + col;
      pp[0 * 32] = a0[0]; pp[1 * 32] = a0[1]; pp[2 * 32] = a0[2]; pp[3 * 32] = a0[3];
      pp[4 * 32] = a1[0]; pp[5 * 32] = a1[1]; pp[6 * 32] = a1[2]; pp[7 * 32] = a1[3]; pp[8 * 32] = a8;
    }
    __syncthreads();
    if (tid < 288) {
      const int r = tid >> 5, cc = tid & 31;
      float s = 0.f;
#pragma unroll
      for (int sl = 0; sl < 16; ++sl) s += part[(sl * 9 + r) * 32 + cc];
      p.mod[(size_t)(l * 9 + r) * 6144 + j0 + cc] = s + p.b_mod[l * 6144 + j0 + cc];
    }
    __syncthreads();
  }
  conv_until(p, CE1, sm);
}

typedef float f32x4m __attribute__((ext_vector_type(4)));
__device__ __forceinline__ void ph_norm(const Params& p, int l, int which, int nrows, int ncomb, int lprev, float* sm) {
  const int tid = ltid(), lane = tid & 63, wv = tid >> 6;
  const bool skinny = (which == 2) || (which == 1 && (l & 1) == 0);
  bf16_t* HROW0 = (bf16_t*)sm;
  float* PART0 = sm + 16512;
  bf16x8 Bhi[4], Blo[4];
  if (skinny) {
    const float* wbase; int stride;
    if (which == 2) { wbase = p.w_router + (size_t)l * 1024 * 16; stride = 16; }
    else { wbase = p.w_in_even + (size_t)(l >> 1) * 1024 * EVEN_IN + PROJW; stride = EVEN_IN; }
    const int kg = lane >> 4, n = lane & 15;
    float fw[4][8];
#pragma unroll
    for (int ks = 0; ks < 4; ++ks)
#pragma unroll
      for (int j = 0; j < 8; ++j) fw[ks][j] = wbase[(size_t)(wv * 128 + ks * 32 + kg * 8 + j) * stride + n];
    float zf = 0.f;
    asm volatile("" : "+v"(zf) : "v"(fw[0][0]), "v"(fw[0][1]), "v"(fw[0][2]), "v"(fw[0][3]), "v"(fw[0][4]), "v"(fw[0][5]), "v"(fw[0][6]), "v"(fw[0][7]),
                 "v"(fw[1][0]), "v"(fw[1][1]), "v"(fw[1][2]), "v"(fw[1][3]), "v"(fw[1][4]), "v"(fw[1][5]), "v"(fw[1][6]), "v"(fw[1][7]));
    asm volatile("" : "+v"(zf) : "v"(fw[2][0]), "v"(fw[2][1]), "v"(fw[2][2]), "v"(fw[2][3]), "v"(fw[2][4]), "v"(fw[2][5]), "v"(fw[2][6]), "v"(fw[2][7]),
                 "v"(fw[3][0]), "v"(fw[3][1]), "v"(fw[3][2]), "v"(fw[3][3]), "v"(fw[3][4]), "v"(fw[3][5]), "v"(fw[3][6]), "v"(fw[3][7]));
#pragma unroll
    for (int ks = 0; ks < 4; ++ks) {
      float f[8], hi[8], lo[8];
#pragma unroll
      for (int j = 0; j < 8; ++j) f[j] = fw[ks][j] + zf;
      const u32x4 hw = pack8(f);
      unpack8(hw, hi);
#pragma unroll
      for (int j = 0; j < 8; ++j) lo[j] = f[j] - hi[j];
      Bhi[ks] = __builtin_bit_cast(bf16x8, hw);
      Blo[ks] = __builtin_bit_cast(bf16x8, pack8(lo));
    }
  }
  const int nwaves = lgdim() * (NTHR / 64), gw = lbid() * (NTHR / 64) + wv;
  const int per = (nrows + nwaves - 1) / nwaves;
  const int rbeg = gw * per, rend = min(nrows, rbeg + per);
  const bool in0 = (l == 0) && (which == 1 || which == 2);
  float4 vn[4];
  u32x2 xnb[4];
  int slvn = -1;
  {
    const int r0 = min(rbeg, nrows - 1);
    if (in0) {
      const float* xs0 = r0 < NL ? p.x + (size_t)r0 * DM : p.ctx + (size_t)(r0 - NL) * DM;
#pragma unroll
      for (int i = 0; i < 4; ++i) vn[i] = ((const float4*)xs0)[i * 64 + lane];
    } else {
#pragma unroll
      for (int i = 0; i < 4; ++i) xnb[i] = __builtin_nontemporal_load((const u32x2*)(p.xcur + (size_t)r0 * DM) + i * 64 + lane);
    }
    if (r0 < ncomb && lane < 16) slvn = p.slotmap[r0 * 16 + lane];
  }
  float4 cA[4], cB[4], cG[4];
  u32x2 yn[4];
  int mr_c = -1;
  if (which == 2) {
    const u32x2* yp0 = (const u32x2*)(p.ybuf + (size_t)min(rbeg, nrows - 1) * DM);
#pragma unroll
    for (int i = 0; i < 4; ++i) yn[i] = __builtin_nontemporal_load(yp0 + i * 64 + lane);
  }
  const float bgate = (which == 1 && skinny) ? p.b_gate[(l >> 1) * 16 + (lane & 15)] : 0.f;
  auto skinny_finish = [&](const float* PARTF, int rf, bool livef) {
    float v1 = 0.f;
    if (lane < 16) {
#pragma unroll
      for (int w2 = 0; w2 < 8; ++w2) v1 += PARTF[(w2 * 8 + wv) * 16 + lane];
    }
    if (which == 2) {
      float mx = v1;
      mx = row16_max(mx);
      const float ex = expf(v1 - mx);
      float sum = ex;
      sum = row16_sum(sum);
      if (livef && lane < 16) p.aff[(size_t)rf * 16 + lane] = ex / sum;
    } else {
      float gvv = v1 + bgate;
      if ((lane >> 2) & 1) gvv = logsigmoidf_(gvv);
      if (livef && lane < 16) p.gates[(size_t)rf * 16 + lane] = gvv;
    }
  };
  int r_prev = 0;
  bool live_prev = false;
  for (int it = 0; it < per; ++it) {
    const int rr = rbeg + it;
    const bool live = rr < rend;
    const int r = min(rr, nrows - 1);
    bf16_t* HROW = HROW0 + (it & 1) * 16512;
    float* PART = PART0 + (it & 1) * 1024;
    float4 v[4];
    if (in0) {
#pragma unroll
      for (int i = 0; i < 4; ++i) v[i] = vn[i];
    } else {
#pragma unroll
      for (int i = 0; i < 4; ++i) v[i] = make_float4(__uint_as_float(xnb[i].x << 16), __uint_as_float(xnb[i].x & 0xffff0000u), __uint_as_float(xnb[i].y << 16), __uint_as_float(xnb[i].y & 0xffff0000u));
    }
    const int slv = slvn;
    bf16_t* xr = p.xcur + (size_t)r * DM;
    if (it + 1 < per) {
      const int rn = min(rr + 1, nrows - 1);
      if (in0) {
        const float* xsn = rn < NL ? p.x + (size_t)rn * DM : p.ctx + (size_t)(rn - NL) * DM;
#pragma unroll
        for (int i = 0; i < 4; ++i) vn[i] = ((const float4*)xsn)[i * 64 + lane];
      } else {
#pragma unroll
        for (int i = 0; i < 4; ++i) xnb[i] = __builtin_nontemporal_load((const u32x2*)(p.xcur + (size_t)rn * DM) + i * 64 + lane);
      }
      slvn = (rn < ncomb && lane < 16) ? p.slotmap[rn * 16 + lane] : -1;
    }
    const int mr = modrow(r);
    if (mr != mr_c) {
      mr_c = mr;
      if (which == 3) {
#pragma unroll
        for (int i = 0; i < 4; ++i) cA[i] = ((const float4*)p.g_final)[i * 64 + lane];
      } else {
        const float* gn = (which == 1 ? p.g_norm1 : p.g_norm2) + l * 1024;
        const float* mrow = p.mod + (size_t)(l * 9 + mr) * 6144;
        const float4* shp = (const float4*)(mrow + (which == 1 ? 0 : 3) * 1024);
        const float4* scp = (const float4*)(mrow + (which == 1 ? 1 : 4) * 1024);
        float4 gq[4], sq[4];
        float onef = 1.f, odd = 0.f;
#pragma unroll
        for (int i = 0; i < 4; ++i) { gq[i] = ((const float4*)gn)[i * 64 + lane]; sq[i] = scp[i * 64 + lane]; cB[i] = shp[i * 64 + lane]; }
        if (which == 2) {
          const float4* g2 = (const float4*)(mrow + 2 * 1024);
          const float4* spv = (const float4*)(p.s_pool + (size_t)(l >> 1) * 1024);
          float4 sp4[4];
#pragma unroll
          for (int i = 0; i < 4; ++i) { cG[i] = g2[i * 64 + lane]; sp4[i] = spv[i * 64 + lane]; }
          odd = (l & 1) ? 1.f : 0.f;
#define V4(a) "v"(__builtin_bit_cast(f32x4m, a))
          asm volatile("" : "+v"(onef), "+v"(odd) : V4(gq[0]), V4(gq[1]), V4(gq[2]), V4(gq[3]), V4(sq[0]), V4(sq[1]), V4(sq[2]), V4(sq[3]), V4(cB[0]), V4(cB[1]), V4(cB[2]), V4(cB[3]),
                       V4(cG[0]), V4(cG[1]), V4(cG[2]), V4(cG[3]), V4(sp4[0]), V4(sp4[1]), V4(sp4[2]), V4(sp4[3]));
#pragma unroll
          for (int i = 0; i < 4; ++i) {
            cG[i].x *= odd * sp4[i].x + (onef - odd); cG[i].y *= odd * sp4[i].y + (onef - odd); cG[i].z *= odd * sp4[i].z + (onef - odd); cG[i].w *= odd * sp4[i].w + (onef - odd);
          }
        }
        if (which != 2) {
          if (ncomb > 0) {
            const float4* g5 = (const float4*)(p.mod + (size_t)(lprev * 9 + mr) * 6144 + 5 * 1024);
#pragma unroll
            for (int i = 0; i < 4; ++i) cG[i] = g5[i * 64 + lane];
            asm volatile("" : "+v"(onef) : V4(gq[0]), V4(gq[1]), V4(gq[2]), V4(gq[3]), V4(sq[0]), V4(sq[1]), V4(sq[2]), V4(sq[3]), V4(cB[0]), V4(cB[1]), V4(cB[2]), V4(cB[3]),
                         V4(cG[0]), V4(cG[1]), V4(cG[2]), V4(cG[3]));
          } else {
            asm volatile("" : "+v"(onef) : V4(gq[0]), V4(gq[1]), V4(gq[2]), V4(gq[3]), V4(sq[0]), V4(sq[1]), V4(sq[2]), V4(sq[3]), V4(cB[0]), V4(cB[1]), V4(cB[2]), V4(cB[3]));
          }
        }
#pragma unroll
        for (int i = 0; i < 4; ++i) cA[i] = make_float4(gq[i].x * (onef + sq[i].x), gq[i].y * (onef + sq[i].y), gq[i].z * (onef + sq[i].z), gq[i].w * (onef + sq[i].w));
      }
      if (which == 3 && ncomb > 0) {
        const float4* g5 = (const float4*)(p.mod + (size_t)(lprev * 9 + mr) * 6144 + 5 * 1024);
#pragma unroll
        for (int i = 0; i < 4; ++i) cG[i] = g5[i * 64 + lane];
        LOADS_ISSUED();
      }
    }
    if (live && r < ncomb) {
      float4 s4[4];
#pragma unroll
      for (int i = 0; i < 4; ++i) s4[i] = make_float4(0.f, 0.f, 0.f, 0.f);
      unsigned long long mask = __ballot(slv >= 0);
      while (mask) {
        const u32x2* yp[4];
        bool ok[4];
#pragma unroll
        for (int j = 0; j < 4; ++j) {
          ok[j] = (mask != 0ull);
          if (ok[j]) {
            const int e = __ffsll((long long)mask) - 1;
            mask &= mask - 1;
            const int sl = __builtin_amdgcn_readlane(slv, e);
            size_t yrow;
            if (r < NL) yrow = (size_t)e * 2048 + (size_t)(r >> 11) * 256 + sl;
            else yrow = (size_t)MOE_L + (size_t)e * 256 + (size_t)((r - NL) >> 8) * 32 + sl;
            yp[j] = (const u32x2*)(p.Ybuf + yrow * DM);
          } else yp[j] = yp[0];
        }
        u32x2 yv[4][4];
#pragma unroll
        for (int j = 0; j < 4; ++j)
#pragma unroll
          for (int i = 0; i < 4; ++i) yv[j][i] = __builtin_nontemporal_load(yp[j] + i * 64 + lane);
        __builtin_amdgcn_sched_barrier(0);
#pragma unroll
        for (int j = 0; j < 4; ++j) {
          if (ok[j]) {
#pragma unroll
            for (int i = 0; i < 4; ++i) {
              const u32x2 y = yv[j][i];
              s4[i].x += __uint_as_float(y.x << 16); s4[i].y += __uint_as_float(y.x & 0xffff0000u);
              s4[i].z += __uint_as_float(y.y << 16); s4[i].w += __uint_as_float(y.y & 0xffff0000u);
            }
          }
        }
      }
#pragma unroll
      for (int i = 0; i < 4; ++i) {
        const float4 g = cG[i];
        v[i].x += g.x * s4[i].x; v[i].y += g.y * s4[i].y; v[i].z += g.z * s4[i].z; v[i].w += g.w * s4[i].w;
        if (which != 3) { u32x2 xw; xw.x = cvt_pk_bf16(v[i].x, v[i].y); xw.y = cvt_pk_bf16(v[i].z, v[i].w); ((u32x2*)xr)[i * 64 + lane] = xw; }
      }
    }
    if (which == 2) {
      u32x2 yc[4];
#pragma unroll
      for (int i = 0; i < 4; ++i) yc[i] = yn[i];
      if (it + 1 < per) {
        const u32x2* ypn = (const u32x2*)(p.ybuf + (size_t)min(rr + 1, nrows - 1) * DM);
#pragma unroll
        for (int i = 0; i < 4; ++i) yn[i] = __builtin_nontemporal_load(ypn + i * 64 + lane);
      }
#pragma unroll
      for (int i = 0; i < 4; ++i) {
        v[i].x += cG[i].x * __uint_as_float(yc[i].x << 16); v[i].y += cG[i].y * __uint_as_float(yc[i].x & 0xffff0000u);
        v[i].z += cG[i].z * __uint_as_float(yc[i].y << 16); v[i].w += cG[i].w * __uint_as_float(yc[i].y & 0xffff0000u);
        if (live) { u32x2 xw; xw.x = cvt_pk_bf16(v[i].x, v[i].y); xw.y = cvt_pk_bf16(v[i].z, v[i].w); ((u32x2*)xr)[i * 64 + lane] = xw; }
      }
    }
    float ss = 0.f;
#pragma unroll
    for (int i = 0; i < 4; ++i) ss += v[i].x * v[i].x + v[i].y * v[i].y + v[i].z * v[i].z + v[i].w * v[i].w;
    ss = wave_sum(ss);
    const float inv = rsqrtf(ss * (1.f / 1024.f) + EPS);
    if (which == 3) {
      if (live) {
#pragma unroll
        for (int i = 0; i < 4; ++i) {
          const float4 g = cA[i];
          ((float4*)(p.out + (size_t)r * DM))[i * 64 + lane] = make_float4(v[i].x * inv * g.x, v[i].y * inv * g.y, v[i].z * inv * g.z, v[i].w * inv * g.w);
        }
      }
      continue;
    }
#pragma unroll
    for (int i = 0; i < 4; ++i) {
      const float h0 = v[i].x * inv * cA[i].x + cB[i].x, h1 = v[i].y * inv * cA[i].y + cB[i].y;
      const float h2 = v[i].z * inv * cA[i].z + cB[i].z, h3 = v[i].w * inv * cA[i].w + cB[i].w;
      u32x2 w; w.x = cvt_pk_bf16(h0, h1); w.y = cvt_pk_bf16(h2, h3);
      if (live) ((u32x2*)(p.hbuf + (size_t)r * DM))[i * 64 + lane] = w;
      if (skinny) {
        const float l0 = h0 - __uint_as_float(w.x << 16), l1 = h1 - __uint_as_float(w.x & 0xffff0000u);
        const float l2 = h2 - __uint_as_float(w.y << 16), l3 = h3 - __uint_as_float(w.y & 0xffff0000u);
        u32x2 wl; wl.x = cvt_pk_bf16(l0, l1); wl.y = cvt_pk_bf16(l2, l3);
        ((u32x2*)(HROW + (wv * 2 + 0) * 1032))[i * 64 + lane] = w;
        ((u32x2*)(HROW + (wv * 2 + 1) * 1032))[i * 64 + lane] = wl;
      }
    }
    if (!skinny) continue;
    LDS_BARRIER();
    {
      const int arow = lane & 7, kg = lane >> 4;
      f32x4m acc = {0.f, 0.f, 0.f, 0.f};
#pragma unroll
      for (int ks = 0; ks < 4; ++ks) {
        const bf16x8 ahi = *(const bf16x8*)(HROW + (arow * 2 + 0) * 1032 + wv * 128 + ks * 32 + kg * 8);
        const bf16x8 alo = *(const bf16x8*)(HROW + (arow * 2 + 1) * 1032 + wv * 128 + ks * 32 + kg * 8);
        acc = __builtin_amdgcn_mfma_f32_16x16x32_bf16(ahi, Bhi[ks], acc, 0, 0, 0);
        acc = __builtin_amdgcn_mfma_f32_16x16x32_bf16(ahi, Blo[ks], acc, 0, 0, 0);
        acc = __builtin_amdgcn_mfma_f32_16x16x32_bf16(alo, Bhi[ks], acc, 0, 0, 0);
      }
      if (kg < 2) {
#pragma unroll
        for (int q = 0; q < 4; ++q) PART[(wv * 8 + kg * 4 + q) * 16 + (lane & 15)] = acc[q];
      }
    }
    if (it > 0) skinny_finish(PART0 + ((it & 1) ^ 1) * 1024, r_prev, live_prev);
    r_prev = r; live_prev = live;
  }
  if (skinny) {
    LDS_BARRIER();
    skinny_finish(PART0 + ((per - 1) & 1) * 1024, r_prev, live_prev);
  }
  __syncthreads();
}

#define LOG2E 1.4426950408889634f
__device__ __forceinline__ int chain_row(int b, int dir, int p) {
  if (p < 256) { const int t = dir ? 255 - p : p; return NL + b * 256 + t; }
  const int q = p - 256; const int t = dir ? 2047 - q : q; return b * 2048 + t;
}
__device__ __forceinline__ float wave_incl_sum(float v, int lane) {
#pragma unroll
  for (int o = 1; o < 64; o <<= 1) { const float t = __shfl_up(v, o); if (lane >= o) v += t; }
  return v;
}
__device__ __forceinline__ float wave_incl_max(float v, int lane) {
#pragma unroll
  for (int o = 1; o < 64; o <<= 1) { const float t = __shfl_up(v, o); if (lane >= o) v = fmaxf(v, t); }
  return v;
}
__device__ __forceinline__ void ph_post_even(const Params& p, int l, float* sm) {
  const int e = l >> 1;
  const int tid = ltid(), lane = tid & 63;
  __syncthreads();
  for (int idx = tid; idx < 1024; idx += NTHR) {
    const int pos = idx >> 4, i = idx & 15;
    const float ang = (float)pos * exp2f(-(float)i * (13.287712379549449f / 16.f));
    float sn, cs;
    sincosf(ang, &sn, &cs);
    sm[2 * idx] = cs; sm[2 * idx + 1] = sn;
  }
  if (tid < 128) sm[2048 + tid] = tid < 64 ? p.g_qnorm[e * 64 + tid] : p.g_knorm[e * 64 + tid - 64];
  for (int idx = tid; idx < 3072; idx += NTHR) sm[2304 + idx] = p.w_conv[(size_t)e * 3 * 1024 + idx];
  __syncthreads();
  const int bid = lbid(), G = lgdim();
  const bool scanner = false;
  const size_t gtid = (size_t)bid * NTHR + tid, gsz = (size_t)G * NTHR;
  if (!scanner) {
  for (size_t it = gtid; it < (size_t)NT * 10; it += gsz) {
    const int r = (int)(it / 10), hh = (int)(it % 10);
    const bool lat = r < NL;
    const int t = r & 2047;
    const int bb = lat ? (r >> 11) : ((r - NL) >> 8);
    const int key = lat ? 256 + t : ((r - NL) & 255);
    const bf16_t* src; bf16_t* dst; const float* g; float osc;
    if (hh < 8) { src = p.proj + (size_t)r * PROJW + hh * 64; dst = p.Qb + (size_t)r * 512 + hh * 64; g = sm + 2048; osc = 0.125f * LOG2E; }
    else { src = p.proj + (size_t)r * PROJW + 512 + (hh - 8) * 64; dst = p.Kb + ((size_t)(bb * 2 + (hh - 8)) * 2304 + key) * 64; g = sm + 2048 + 64; osc = 1.f;
           const u32x4* vs = (const u32x4*)(p.proj + (size_t)r * PROJW + 640 + (hh - 8) * 64);
           u32x4* vd = (u32x4*)(p.Vb + ((size_t)(bb * 2 + (hh - 8)) * 2304 + key) * 64);
           u32x4 vt[8];
#pragma unroll
           for (int q = 0; q < 8; ++q) vt[q] = vs[q];
           __builtin_amdgcn_sched_barrier(0);
#pragma unroll
           for (int q = 0; q < 8; ++q) vd[q] = vt[q]; }
    float x[64];
#pragma unroll
    for (int q = 0; q < 8; ++q) { float f[8]; unpack8(((const u32x4*)src)[q], f);
#pragma unroll
      for (int j = 0; j < 8; ++j) x[q * 8 + j] = f[j]; }
    float ss = 0.f;
#pragma unroll
    for (int j = 0; j < 64; ++j) ss += x[j] * x[j];
    const float inv = rsqrtf(ss * (1.f / 64.f) + EPS) * osc;
#pragma unroll
    for (int j = 0; j < 64; ++j) x[j] *= inv * g[j];
    if (lat) {
#pragma unroll
      for (int a = 0; a < 2; ++a) {
        const int pos = (a == 0) ? (t >> 6) : (t & 63);
#pragma unroll
        for (int i = 0; i < 16; ++i) {
          const float2 cssn = *(const float2*)(sm + 2 * (pos * 16 + i));
          const float x1 = x[a * 32 + i], x2 = x[a * 32 + 16 + i];
          x[a * 32 + i] = x1 * cssn.x - x2 * cssn.y;
          x[a * 32 + 16 + i] = x2 * cssn.x + x1 * cssn.y;
        }
      }
    }
#pragma unroll
    for (int q = 0; q < 8; ++q) { float f[8];
#pragma unroll
      for (int j = 0; j < 8; ++j) f[j] = x[q * 8 + j];
      ((u32x4*)dst)[q] = pack8(f); }
  }
  const float* wc = sm + 2304;
  const size_t NAH = (size_t)NT * 10, NCV = (size_t)NT * 128;
  const size_t nS = (NAH % gsz), cper = NCV / gsz;
  const bool clsS = gtid < nS;
  const size_t cntS = (nS > 0 && nS < gsz && cper > 5) ? cper - 5 : cper;
  const size_t cbase = clsS ? gtid : nS * cntS + (gtid - nS), cstr = clsS ? nS : gsz - nS;
  const size_t ccnt = clsS ? cntS : (NCV - nS * cntS + (gsz - nS) - 1) / (gsz - nS);
  for (size_t k0 = 0; k0 < ccnt; k0 += 4) {
    const size_t it0 = cbase + k0 * cstr;
    u32x4 rc[4], rm[4], rp[4];
#pragma unroll
    for (int u = 0; u < 4; ++u) {
      const size_t it = (k0 + u < ccnt) ? cbase + (k0 + u) * cstr : NCV;
      const size_t itc = it < (size_t)NT * 128 ? it : it0;
      const int r = (int)(itc >> 7), c8 = (int)(itc & 127) * 8;
      int t, n;
      if (r < NL) { t = r & 2047; n = 2048; } else { t = (r - NL) & 255; n = 256; }
      const bf16_t* sp = p.proj + (size_t)r * PROJW + 768 + c8;
      rc[u] = *(const u32x4*)sp;
      const u32x4 lm = *(const u32x4*)(sp - (t > 0 ? PROJW : 0)), lp = *(const u32x4*)(sp + (t < n - 1 ? PROJW : 0));
      rm[u].x = t > 0 ? lm.x : 0u; rm[u].y = t > 0 ? lm.y : 0u; rm[u].z = t > 0 ? lm.z : 0u; rm[u].w = t > 0 ? lm.w : 0u;
      rp[u].x = t < n - 1 ? lp.x : 0u; rp[u].y = t < n - 1 ? lp.y : 0u; rp[u].z = t < n - 1 ? lp.z : 0u; rp[u].w = t < n - 1 ? lp.w : 0u;
    }
#pragma unroll
    for (int u = 0; u < 4; ++u) {
      const size_t it = (k0 + u < ccnt) ? cbase + (k0 + u) * cstr : NCV;
      if (it < (size_t)NT * 128) {
        const int r = (int)(it >> 7), c8 = (int)(it & 127) * 8;
        float xc[8], xm[8], xp[8], o[8];
        unpack8(rc[u], xc); unpack8(rm[u], xm); unpack8(rp[u], xp);
        const float ksc = c8 < 512 ? 1.f : 0.08838834764831845f;
#pragma unroll
        for (int j = 0; j < 8; ++j) { const float v = wc[c8 + j] * xm[j] + wc[1024 + c8 + j] * xc[j] + wc[2048 + c8 + j] * xp[j]; o[j] = silu_fast(v) * ksc; }
        bf16_t* dp = c8 < 512 ? p.qm + (size_t)r * 512 + c8 : p.km + (size_t)r * 512 + c8 - 512;
        *(u32x4*)dp = pack8(o);
      }
    }
  }
  }
  {
    const int nw = (int)(gsz >> 6), gw = ((int)(gtid >> 6) + nw - (int)(((size_t)NT * 10 % gsz) >> 6)) % nw;
    for (int task = gw; task < 64 * 18; task += nw) {
      const int chain = task / 18, c = task % 18;
      const int b = chain >> 3, hd = (chain >> 1) & 3, dir = chain & 1;
      const int p0 = c * 128 + 2 * lane;
      const int r0 = chain_row(b, dir, p0), r1 = chain_row(b, dir, p0 + 1);
      const float ig0 = p.gates[(size_t)r0 * 16 + dir * 8 + hd], lf0 = p.gates[(size_t)r0 * 16 + dir * 8 + 4 + hd];
      const float ig1 = p.gates[(size_t)r1 * 16 + dir * 8 + hd], lf1 = p.gates[(size_t)r1 * 16 + dir * 8 + 4 + hd];
      const float ssum = lf0 + lf1;
      const float incl = wave_incl_sum(ssum, lane);
      const float bq0 = (incl - ssum) + lf0, bq1 = bq0 + lf1;
      const float bend = __shfl(incl, 63);
      const float g0 = ig0 - bq0, g1 = ig1 - bq1;
      const float inclm = wave_incl_max(fmaxf(g0, g1), lane);
      float exclm = __shfl_up(inclm, 1);
      if (lane == 0) exclm = -3.0e38f;
      const float pm0 = fmaxf(exclm, g0), pm1 = fmaxf(pm0, g1);
      const float gmax = __shfl(inclm, 63);
      const size_t i0 = (size_t)r0 * 8 + dir * 4 + hd, i1 = (size_t)r1 * 8 + dir * 4 + hd;
      p.gsG[i0] = g0 * LOG2E; p.gsR[i0] = pm0 * LOG2E; p.gsB[i0] = bq0 * LOG2E;
      p.gsG[i1] = g1 * LOG2E; p.gsR[i1] = pm1 * LOG2E; p.gsB[i1] = bq1 * LOG2E;
      if (lane == 0) { p.cBE[chain * 18 + c] = bend; p.cGM[chain * 18 + c] = gmax; }
    }
  }
}
typedef float f32x16 __attribute__((ext_vector_type(16)));
typedef short s16x4 __attribute__((ext_vector_type(4)));
typedef __attribute__((address_space(3))) const char* lds_cptr;
__device__ __forceinline__ s16x4 vtr(lds_cptr p) { return __builtin_bit_cast(s16x4, __builtin_amdgcn_ds_read_tr16_b64_v4i16((__attribute__((address_space(3))) s16x4*)p)); }
#define MX3(a, b, c) __builtin_fmaxf(__builtin_fmaxf((a), (b)), (c))
__device__ __forceinline__ float rowmax32(const f32x16& p0, const f32x16& p1) {
  float a = MX3(p0[0], p0[1], p1[0]), b = MX3(p0[2], p0[3], p1[1]);
  a = MX3(a, p1[2], p1[3]);
#pragma unroll
  for (int r = 4; r < 16; r += 4) { a = MX3(a, p0[r], p0[r + 1]); b = MX3(b, p0[r + 2], p0[r + 3]); a = MX3(a, p1[r], p1[r + 1]); b = MX3(b, p1[r + 2], p1[r + 3]); }
  const float m = __builtin_fmaxf(a, b);
  auto rr = __builtin_amdgcn_permlane32_swap(__float_as_uint(m), __float_as_uint(m), false, false);
  return __builtin_fmaxf(__uint_as_float(rr[0]), __uint_as_float(rr[1]));
}
__device__ __forceinline__ float half_swap_add(float v) {
  auto rr = __builtin_amdgcn_permlane32_swap(__float_as_uint(v), __float_as_uint(v), false, false);
  return __uint_as_float(rr[0]) + __uint_as_float(rr[1]);
}
#define ATT_SLOT 16384
__device__ __forceinline__ void glds16(const void* g, unsigned lds_base) {
  unsigned sv;
  asm volatile("s_mov_b32 %0, m0\n\ts_mov_b32 m0, %2\n\ts_nop 0\n\tglobal_load_lds_dwordx4 %1, off\n\ts_mov_b32 m0, %0" : "=&s"(sv) : "v"(g), "s"(lds_base) : "memory");
}
__device__ __forceinline__ void attn_unit(const bf16_t* Q0, const bf16_t* Kbase, const bf16_t* Vbase, const int nkeys, bf16_t* O0, LAS unsigned char* lds) {
  const int tid = ltid(), lane = tid & 63, r32 = lane & 31, hi = lane >> 5;
  const int wid = __builtin_amdgcn_readfirstlane(tid >> 6);
  const int NTL = nkeys >> 6;
  __syncthreads();
  const bf16_t* ksrc = Kbase + (size_t)lane * 64 + wid * 8;
  const bf16_t* vsrc = Vbase + (size_t)(16 * (wid & 3) + (lane >> 2)) * 64 + (wid >> 2) * 32 + (lane & 3) * 8;
  const unsigned ldsb = (unsigned)(size_t)lds;
#define ATT_STAGE(t, slot) do { \
    glds16(ksrc + (size_t)(t) * 64 * 64, (unsigned)__builtin_amdgcn_readfirstlane(ldsb + (slot) * ATT_SLOT + wid * 1024)); \
    glds16(vsrc + (size_t)(t) * 64 * 64, (unsigned)__builtin_amdgcn_readfirstlane(ldsb + (slot) * ATT_SLOT + 8192 + wid * 1024)); } while (0)
  ATT_STAGE(0, 0);
  if (NTL > 1) ATT_STAGE(1, 1);
  bf16x8 qr[4];
  {
    const bf16_t* Qw = Q0 + (size_t)(wid * 32 + r32) * 512;
#pragma unroll
    for (int d0 = 0; d0 < 4; ++d0) qr[d0] = *(const bf16x8*)(Qw + d0 * 16 + hi * 8);
  }
  f32x16 o0, o1;
#pragma unroll
  for (int r = 0; r < 16; ++r) { o0[r] = 0.f; o1[r] = 0.f; }
  float m = -1e30f, l = 0.f;
  const int koff = hi * 1024 + r32 * 16;
  const int voff = 8192 + ((lane >> 4) & 1) * 32 + (lane & 3) * 8 + (4 * hi + ((lane & 15) >> 2)) * 64;
  const bool grpB = wid >= 4;
  bf16x8 pw[4];
#define ATT_PV(sl) do { const lds_cptr vp_ = (lds_cptr)(lds + (sl) * ATT_SLOT + voff); \
    _Pragma("unroll") for (int s4 = 0; s4 < 4; ++s4) { \
      const s16x4 a0l = vtr(vp_ + s4 * 1024), a0h = vtr(vp_ + s4 * 1024 + 512); \
      const s16x4 a1l = vtr(vp_ + 4096 + s4 * 1024), a1h = vtr(vp_ + 4096 + s4 * 1024 + 512); \
      const bf16x8 a0 = {a0l[0], a0l[1], a0l[2], a0l[3], a0h[0], a0h[1], a0h[2], a0h[3]}; \
      const bf16x8 a1 = {a1l[0], a1l[1], a1l[2], a1l[3], a1h[0], a1h[1], a1h[2], a1h[3]}; \
      o0 = __builtin_amdgcn_mfma_f32_32x32x16_bf16(a0, pw[s4], o0, 0, 0, 0); \
      o1 = __builtin_amdgcn_mfma_f32_32x32x16_bf16(a1, pw[s4], o1, 0, 0, 0); } } while (0)
  for (int t = 0; t <= NTL; ++t) {
    if (t + 1 < NTL) asm volatile("s_waitcnt vmcnt(2) lgkmcnt(0)\n\ts_barrier" ::: "memory"); else asm volatile("s_waitcnt vmcnt(0) lgkmcnt(0)\n\ts_barrier" ::: "memory");
    __builtin_amdgcn_sched_barrier(0);
    if (t + 2 < NTL) ATT_STAGE(t + 2, (t + 2) & 3);
    if (grpB && t > 0) ATT_PV((t - 1) & 3);
    if (t < NTL) {
      const lds_cptr kp = (lds_cptr)(lds + (t & 3) * ATT_SLOT + koff);
      f32x16 pA, pB;
#pragma unroll
      for (int r = 0; r < 16; ++r) { pA[r] = 0.f; pB[r] = 0.f; }
#pragma unroll
      for (int d0 = 0; d0 < 4; ++d0) {
        const bf16x8 k0 = *(const LAS bf16x8*)(kp + d0 * 2048), k1 = *(const LAS bf16x8*)(kp + d0 * 2048 + 512);
        pA = __builtin_amdgcn_mfma_f32_32x32x16_bf16(k0, qr[d0], pA, 0, 0, 0);
        pB = __builtin_amdgcn_mfma_f32_32x32x16_bf16(k1, qr[d0], pB, 0, 0, 0);
      }
      const float rm = rowmax32(pA, pB);
      const float mn = __builtin_fmaxf(m, rm);
      const float alpha = __builtin_amdgcn_exp2f(m - mn);
      m = mn;
      float ps = 0.f;
#pragma unroll
      for (int r = 0; r < 16; ++r) { pA[r] = __builtin_amdgcn_exp2f(pA[r] - mn); pB[r] = __builtin_amdgcn_exp2f(pB[r] - mn); ps += pA[r] + pB[r]; }
      l = l * alpha + ps;
#pragma unroll
      for (int r = 0; r < 16; ++r) { o0[r] *= alpha; o1[r] *= alpha; }
#pragma unroll
      for (int s4 = 0; s4 < 4; ++s4) {
        u32x4 w;
        if (s4 < 2) { w.x = cvt_pk_bf16(pA[8 * s4 + 0], pA[8 * s4 + 1]); w.y = cvt_pk_bf16(pA[8 * s4 + 2], pA[8 * s4 + 3]); w.z = cvt_pk_bf16(pA[8 * s4 + 4], pA[8 * s4 + 5]); w.w = cvt_pk_bf16(pA[8 * s4 + 6], pA[8 * s4 + 7]); }
        else { const int q = s4 - 2; w.x = cvt_pk_bf16(pB[8 * q + 0], pB[8 * q + 1]); w.y = cvt_pk_bf16(pB[8 * q + 2], pB[8 * q + 3]); w.z = cvt_pk_bf16(pB[8 * q + 4], pB[8 * q + 5]); w.w = cvt_pk_bf16(pB[8 * q + 6], pB[8 * q + 7]); }
        pw[s4] = __builtin_bit_cast(bf16x8, w);
      }
      if (!grpB) ATT_PV(t & 3);
    }
  }
#undef ATT_PV
#undef ATT_STAGE
  const float il = 1.f / half_swap_add(l);
  bf16_t* Ow = O0 + (size_t)(wid * 32 + r32) * 1024;
#pragma unroll
  for (int g4 = 0; g4 < 4; ++g4) {
    u32x2 w0, w1;
    w0.x = cvt_pk_bf16(o0[4 * g4 + 0] * il, o0[4 * g4 + 1] * il); w0.y = cvt_pk_bf16(o0[4 * g4 + 2] * il, o0[4 * g4 + 3] * il);
    w1.x = cvt_pk_bf16(o1[4 * g4 + 0] * il, o1[4 * g4 + 1] * il); w1.y = cvt_pk_bf16(o1[4 * g4 + 2] * il, o1[4 * g4 + 3] * il);
    *(u32x2*)(Ow + 8 * g4 + 4 * hi) = w0;
    *(u32x2*)(Ow + 32 + 8 * g4 + 4 * hi) = w1;
  }
}
#define ATT_TAU 8.f
__device__ __forceinline__ void attn_unit2(const bf16_t* Q0a, const bf16_t* Q0b, const bf16_t* Kbase, const bf16_t* Vbase, const int nkeys, bf16_t* O0a, bf16_t* O0b, LAS unsigned char* lds) {
  const int tid = ltid(), lane = tid & 63, r32 = lane & 31, hi = lane >> 5;
  const int wid = __builtin_amdgcn_readfirstlane(tid >> 6);
  const int NTL = nkeys >> 6;
  __syncthreads();
  const bf16_t* ksrc = Kbase + (size_t)lane * 64 + wid * 8;
  const bf16_t* vsrc = Vbase + (size_t)(16 * (wid & 3) + (lane >> 2)) * 64 + (wid >> 2) * 32 + (lane & 3) * 8;
  const unsigned ldsb = (unsigned)(size_t)lds;
#define ATT_STAGE(t, slot) do { \
    glds16(ksrc + (size_t)(t) * 64 * 64, (unsigned)__builtin_amdgcn_readfirstlane(ldsb + (slot) * ATT_SLOT + wid * 1024)); \
    glds16(vsrc + (size_t)(t) * 64 * 64, (unsigned)__builtin_amdgcn_readfirstlane(ldsb + (slot) * ATT_SLOT + 8192 + wid * 1024)); } while (0)
  ATT_STAGE(0, 0);
  if (NTL > 1) ATT_STAGE(1, 1);
  bf16x8 qr[2][4];
  {
    const bf16_t* Qa = Q0a + (size_t)(wid * 32 + r32) * 512;
    const bf16_t* Qb2 = Q0b + (size_t)(wid * 32 + r32) * 512;
#pragma unroll
    for (int d0 = 0; d0 < 4; ++d0) { qr[0][d0] = *(const bf16x8*)(Qa + d0 * 16 + hi * 8); qr[1][d0] = *(const bf16x8*)(Qb2 + d0 * 16 + hi * 8); }
  }
  f32x16 o0[2], o1[2];
#pragma unroll
  for (int hh = 0; hh < 2; ++hh)
#pragma unroll
    for (int r = 0; r < 16; ++r) { o0[hh][r] = 0.f; o1[hh][r] = 0.f; }
  f32x16 ng[2];
#pragma unroll
  for (int hh = 0; hh < 2; ++hh)
#pragma unroll
    for (int r = 0; r < 16; ++r) ng[hh][r] = 0.f;
  float l[2] = {0.f, 0.f};
  const int koff = hi * 1024 + r32 * 16;
  const int voff = 8192 + ((lane >> 4) & 1) * 32 + (lane & 3) * 8 + (4 * hi + ((lane & 15) >> 2)) * 64;
  int slot = 0;
  for (int t = 0; t < NTL; ++t) {
    if (t + 1 < NTL) asm volatile("s_waitcnt vmcnt(2) lgkmcnt(0)\n\ts_barrier" ::: "memory"); else asm volatile("s_waitcnt vmcnt(0) lgkmcnt(0)\n\ts_barrier" ::: "memory");
    __builtin_amdgcn_sched_barrier(0);
    if (t + 2 < NTL) { const int s2 = (slot >= 1) ? slot - 1 : 2; ATT_STAGE(t + 2, s2); }
    const lds_cptr kp = (lds_cptr)(lds + slot * ATT_SLOT + koff);
    const lds_cptr vp = (lds_cptr)(lds + slot * ATT_SLOT + voff);
    f32x16 pA[2], pB[2];
#pragma unroll
    for (int d0 = 0; d0 < 4; ++d0) {
      const bf16x8 k0 = *(const LAS bf16x8*)(kp + d0 * 2048), k1 = *(const LAS bf16x8*)(kp + d0 * 2048 + 512);
#pragma unroll
      for (int hh = 0; hh < 2; ++hh) {
        pA[hh] = __builtin_amdgcn_mfma_f32_32x32x16_bf16(k0, qr[hh][d0], d0 == 0 ? ng[hh] : pA[hh], 0, 0, 0);
        pB[hh] = __builtin_amdgcn_mfma_f32_32x32x16_bf16(k1, qr[hh][d0], d0 == 0 ? ng[hh] : pB[hh], 0, 0, 0);
      }
    }
    bf16x8 pw[2][4];
#pragma unroll
    for (int hh = 0; hh < 2; ++hh) {
      const float rm = rowmax32(pA[hh], pB[hh]);
      if (t == 0 || __builtin_amdgcn_ballot_w64(rm > ATT_TAU) != 0ull) {
        const float delta = (t == 0) ? rm : __builtin_fmaxf(rm, 0.f);
        const float alpha = __builtin_amdgcn_exp2f(-delta);
#pragma unroll
        for (int r = 0; r < 16; ++r) { pA[hh][r] -= delta; pB[hh][r] -= delta; o0[hh][r] *= alpha; o1[hh][r] *= alpha; ng[hh][r] -= delta; }
        l[hh] *= alpha;
      }
      float ps = 0.f;
#pragma unroll
      for (int r = 0; r < 16; ++r) { pA[hh][r] = __builtin_amdgcn_exp2f(pA[hh][r]); pB[hh][r] = __builtin_amdgcn_exp2f(pB[hh][r]); ps += pA[hh][r] + pB[hh][r]; }
      l[hh] += ps;
#pragma unroll
      for (int s4 = 0; s4 < 4; ++s4) {
        u32x4 w;
        if (s4 < 2) { w.x = cvt_pk_bf16(pA[hh][8 * s4 + 0], pA[hh][8 * s4 + 1]); w.y = cvt_pk_bf16(pA[hh][8 * s4 + 2], pA[hh][8 * s4 + 3]); w.z = cvt_pk_bf16(pA[hh][8 * s4 + 4], pA[hh][8 * s4 + 5]); w.w = cvt_pk_bf16(pA[hh][8 * s4 + 6], pA[hh][8 * s4 + 7]); }
        else { const int q = s4 - 2; w.x = cvt_pk_bf16(pB[hh][8 * q + 0], pB[hh][8 * q + 1]); w.y = cvt_pk_bf16(pB[hh][8 * q + 2], pB[hh][8 * q + 3]); w.z = cvt_pk_bf16(pB[hh][8 * q + 4], pB[hh][8 * q + 5]); w.w = cvt_pk_bf16(pB[hh][8 * q + 6], pB[hh][8 * q + 7]); }
        pw[hh][s4] = __builtin_bit_cast(bf16x8, w);
      }
    }
#pragma unroll
    for (int s4 = 0; s4 < 4; ++s4) {
      const s16x4 a0l = vtr(vp + s4 * 1024), a0h = vtr(vp + s4 * 1024 + 512);
      const s16x4 a1l = vtr(vp + 4096 + s4 * 1024), a1h = vtr(vp + 4096 + s4 * 1024 + 512);
      const bf16x8 a0 = {a0l[0], a0l[1], a0l[2], a0l[3], a0h[0], a0h[1], a0h[2], a0h[3]};
      const bf16x8 a1 = {a1l[0], a1l[1], a1l[2], a1l[3], a1h[0], a1h[1], a1h[2], a1h[3]};
#pragma unroll
      for (int hh = 0; hh < 2; ++hh) {
        o0[hh] = __builtin_amdgcn_mfma_f32_32x32x16_bf16(a0, pw[hh][s4], o0[hh], 0, 0, 0);
        o1[hh] = __builtin_amdgcn_mfma_f32_32x32x16_bf16(a1, pw[hh][s4], o1[hh], 0, 0, 0);
      }
    }
    slot = (slot == 2) ? 0 : slot + 1;
  }
#undef ATT_STAGE
#pragma unroll
  for (int hh = 0; hh < 2; ++hh) {
    const float il = 1.f / half_swap_add(l[hh]);
    bf16_t* Ow = (hh ? O0b : O0a) + (size_t)(wid * 32 + r32) * 1024;
#pragma unroll
    for (int g4 = 0; g4 < 4; ++g4) {
      u32x2 w0, w1;
      w0.x = cvt_pk_bf16(o0[hh][4 * g4 + 0] * il, o0[hh][4 * g4 + 1] * il); w0.y = cvt_pk_bf16(o0[hh][4 * g4 + 2] * il, o0[hh][4 * g4 + 3] * il);
      w1.x = cvt_pk_bf16(o1[hh][4 * g4 + 0] * il, o1[hh][4 * g4 + 1] * il); w1.y = cvt_pk_bf16(o1[hh][4 * g4 + 2] * il, o1[hh][4 * g4 + 3] * il);
      *(u32x2*)(Ow + 8 * g4 + 4 * hi) = w0;
      *(u32x2*)(Ow + 32 + 8 * g4 + 4 * hi) = w1;
    }
  }
}
__device__ __forceinline__ void ph_att(const Params& p, bool ctx_q, LAS unsigned char* lds) {
  const int c = lbid(), G = lgdim();
  const int nunits = 256 + (ctx_q ? 32 : 0);
  for (int L = c; L < nunits; L += G) {
    if (L < 256) {
      const int grp = (L & 7) * 2 + ((L >> 3) >> 4), within = (L >> 3) & 15;
      const int b = grp >> 1, kvh = grp & 1, h0 = kvh * 4 + 2 * (within >> 3), qt = within & 7;
      const size_t row0 = (size_t)b * 2048 + qt * 256;
      const size_t kvb = (size_t)(b * 2 + kvh) * 2304 * 64;
      attn_unit2(p.Qb + row0 * 512 + h0 * 64, p.Qb + row0 * 512 + (h0 + 1) * 64, p.Kb + kvb, p.Vb + kvb, 2304, p.mix + row0 * 1024 + h0 * 64, p.mix + row0 * 1024 + (h0 + 1) * 64, lds);
    } else {
      const int u = L - 256, b = u >> 2, kvh = (u >> 1) & 1, h0 = kvh * 4 + 2 * (u & 1);
      const size_t row0 = (size_t)NL + b * 256;
      const size_t kvb = (size_t)(b * 2 + kvh) * 2304 * 64;
      attn_unit2(p.Qb + row0 * 512 + h0 * 64, p.Qb + row0 * 512 + (h0 + 1) * 64, p.Kb + kvb, p.Vb + kvb, 256, p.mix + row0 * 1024 + h0 * 64, p.mix + row0 * 1024 + (h0 + 1) * 64, lds);
    }
  }
  __syncthreads();
}

__device__ __forceinline__ int chunk_row0(int b, int dir, int cc) {
  if (cc < 2) return NL + b * 256 + (dir ? 1 - cc : cc) * 128;
  return b * 2048 + (dir ? 15 - (cc - 2) : cc - 2) * 128;
}
__device__ __forceinline__ int trq_addr(int lane, int quarter, int rowbase) {
  return quarter * 8192 + ((lane >> 4) & 1) * 32 + (lane & 3) * 8 + (rowbase + ((lane & 15) >> 2)) * 64;
}
__device__ __forceinline__ bf16x8 cat44(const s16x4 a, const s16x4 b) { return (bf16x8){a[0], a[1], a[2], a[3], b[0], b[1], b[2], b[3]}; }

__device__ __forceinline__ void glds4(const void* g, unsigned lds_base) {
  unsigned sv;
  asm volatile("s_mov_b32 %0, m0\n\ts_mov_b32 m0, %2\n\ts_nop 0\n\tglobal_load_lds_dword %1, off\n\ts_mov_b32 m0, %0" : "=&s"(sv) : "v"(g), "s"(lds_base) : "memory");
}
#define USC_SLOT 41472
#define USC_WS 124416
#define USC_NP 124928
#define USC_TB 126976
#define USC_CS 133120
__device__ __forceinline__ void ph_mlstm_uscan(const Params& p, LAS unsigned char* lds) {
  const int tid = ltid(), lane = tid & 63, r32 = lane & 31, hi = lane >> 5;
  const int wid = __builtin_amdgcn_readfirstlane(tid >> 6);
  LAS float* WS = (LAS float*)(lds + USC_WS);
  LAS float* NP = (LAS float*)(lds + USC_NP);
  LAS float* TE1 = (LAS float*)(lds + USC_TB);
  LAS float* TDEC = TE1 + 18;
  const unsigned ldsb = (unsigned)(size_t)lds;
  for (int unit = lbid(); unit < 256; unit += lgdim()) {
    const int eb = (unit >> 3) & 3, chain = (unit >> 5) * 8 + (unit & 7);
    const int b = chain >> 3, hd = (chain >> 1) & 3, dir = chain & 1;
    __syncthreads();
#define USC_ISSUE(cc_, s_) do { const int row0_ = chunk_row0(b, dir, (cc_)); \
      _Pragma("unroll") for (int n = 0; n < 4; ++n) { const int ii = wid * 4 + n, qd = ii >> 3, rg = ii & 7; \
        glds16(p.km + (size_t)(row0_ + rg * 16 + (lane >> 2)) * 512 + hd * 128 + qd * 32 + (lane & 3) * 8, \
               (unsigned)__builtin_amdgcn_readfirstlane(ldsb + (s_) * USC_SLOT + qd * 8192 + rg * 1024)); } \
      glds16(p.proj + (size_t)(row0_ + wid * 16 + (lane >> 2)) * PROJW + 1792 + hd * 128 + eb * 32 + (lane & 3) * 8, \
             (unsigned)__builtin_amdgcn_readfirstlane(ldsb + (s_) * USC_SLOT + 32768 + wid * 1024)); \
      if (wid < 2) glds4(p.gsG + (size_t)(row0_ + wid * 64 + lane) * 8 + dir * 4 + hd, (unsigned)__builtin_amdgcn_readfirstlane(ldsb + (s_) * USC_SLOT + 40960 + wid * 256)); \
    } while (0)
    USC_ISSUE(0, 0);
    USC_ISSUE(1, 1);
    if (tid == 0) {
      float be[18], gm[18];
#pragma unroll
      for (int c = 0; c < 18; ++c) { be[c] = p.cBE[chain * 18 + c]; gm[c] = p.cGM[chain * 18 + c]; }
      float m_in = -1e30f;
#pragma unroll
      for (int c = 0; c < 18; ++c) {
        const float m_next = fmaxf(m_in + be[c], be[c] + gm[c]);
        TE1[c] = (be[c] - m_next) * LOG2E;
        TDEC[c] = expf(m_in + be[c] - m_next);
        if (eb == 0) p.cMIN[chain * 18 + c] = m_in * LOG2E;
        m_in = m_next;
      }
    }
    f32x16 cacc;
#pragma unroll
    for (int r = 0; r < 16; ++r) cacc[r] = 0.f;
    float nv = 0.f;
#define USC_SCALE(c_, s_) do { LAS unsigned char* sl_ = lds + (s_) * USC_SLOT; \
      const float w_ = __builtin_amdgcn_exp2f(*(const LAS float*)(sl_ + 40960 + (tid >> 2) * 4) + TE1[c_]); \
      float f_[8]; unpack8(*(const LAS u32x4*)(sl_ + 32768 + tid * 16), f_); \
      _Pragma("unroll") for (int j = 0; j < 8; ++j) f_[j] *= w_; \
      *(LAS u32x4*)(sl_ + 32768 + tid * 16) = pack8(f_); \
      if ((tid & 3) == 0) WS[tid >> 2] = w_; } while (0)
    asm volatile("s_waitcnt vmcnt(5)" ::: "memory");
    LDS_BARRIER();
    USC_SCALE(0, 0);
    LDS_BARRIER();
#pragma unroll
    for (int c = 0; c < 17; ++c) {
      const int s = c % 3;
      LAS unsigned char* slot = lds + s * USC_SLOT;
      if (c + 2 < 17) USC_ISSUE(c + 2, (c + 2) % 3);
      const float dec = TDEC[c];
      if (wid < 4) {
        bf16x8 kf[8], vf[8];
#pragma unroll
        for (int ks = 0; ks < 8; ++ks) {
          const int rb = ks * 16 + 8 * hi;
          kf[ks] = cat44(vtr((lds_cptr)(slot + trq_addr(lane, wid, rb))), vtr((lds_cptr)(slot + trq_addr(lane, wid, rb + 4))));
          vf[ks] = cat44(vtr((lds_cptr)(slot + 32768 + trq_addr(lane, 0, rb))), vtr((lds_cptr)(slot + 32768 + trq_addr(lane, 0, rb + 4))));
        }
        __builtin_amdgcn_sched_barrier(0);
        f32x16 u1;
#pragma unroll
        for (int r = 0; r < 16; ++r) { cacc[r] *= dec; u1[r] = 0.f; }
#pragma unroll
        for (int ks = 0; ks < 8; ks += 2) {
          cacc = __builtin_amdgcn_mfma_f32_32x32x16_bf16(kf[ks], vf[ks], cacc, 0, 0, 0);
          u1 = __builtin_amdgcn_mfma_f32_32x32x16_bf16(kf[ks + 1], vf[ks + 1], u1, 0, 0, 0);
        }
#pragma unroll
        for (int r = 0; r < 16; ++r) cacc[r] += u1[r];
#pragma unroll
        for (int g4 = 0; g4 < 4; ++g4) {
          u32x2 w2; w2.x = cvt_pk_bf16(cacc[4 * g4], cacc[4 * g4 + 1]); w2.y = cvt_pk_bf16(cacc[4 * g4 + 2], cacc[4 * g4 + 3]);
          *(LAS u32x2*)(lds + USC_CS + r32 * 272 + (wid * 32 + 8 * g4 + 4 * hi) * 2) = w2;
        }
      } else {
        const int t2 = tid - 256, dp = t2 & 15, part = t2 >> 4;
        unsigned kq[8];
        float wq[8];
#pragma unroll
        for (int i = 0; i < 8; ++i) {
          const int srow = part * 8 + i;
          kq[i] = *(const LAS unsigned*)(slot + eb * 8192 + srow * 64 + dp * 4);
          wq[i] = WS[srow];
        }
        __builtin_amdgcn_sched_barrier(0);
        float acc0 = 0.f, acc1 = 0.f;
#pragma unroll
        for (int i = 0; i < 8; ++i) { acc0 += wq[i] * __uint_as_float(kq[i] << 16); acc1 += wq[i] * __uint_as_float(kq[i] & 0xffff0000u); }
        NP[part * 32 + dp * 2] = acc0; NP[part * 32 + dp * 2 + 1] = acc1;
      }
      if (c + 1 < 17) { if (c + 2 < 17) asm volatile("s_waitcnt vmcnt(5)" ::: "memory"); else asm volatile("s_waitcnt vmcnt(0)" ::: "memory"); }
      LDS_BARRIER();
      {
        const u32x4 cv = *(const LAS u32x4*)(lds + USC_CS + (tid >> 4) * 272 + (tid & 15) * 16);
        *(u32x4*)(p.Cbf + ((size_t)chain * 18 + c + 1) * 16384 + (size_t)(eb * 32 + (tid >> 4)) * 128 + (tid & 15) * 8) = cv;
      }
      if (tid < 32) {
        float sn = 0.f;
#pragma unroll
        for (int q = 0; q < 16; ++q) sn += NP[q * 32 + tid];
        nv = dec * nv + sn;
        p.NVb[((size_t)chain * 18 + c + 1) * 128 + eb * 32 + tid] = nv;
      }
      if (c + 1 < 17) {
        USC_SCALE(c + 1, (c + 1) % 3);
        LDS_BARRIER();
      }
    }
    asm volatile("s_waitcnt vmcnt(0)" ::: "memory");
  }
  __syncthreads();
}

__device__ __forceinline__ void ph_mlstm_h(const Params& p, int l, bool ctx_out, LAS unsigned char* lds) {
  const int e2 = l >> 1;
  const int tid = ltid(), lane = tid & 63, r32 = lane & 31, hi = lane >> 5;
  const int wid = __builtin_amdgcn_readfirstlane(tid >> 6);
  const int tb = wid & 3, dir = wid >> 2;
  LAS float* HX = (LAS float*)(lds);
  LAS float* GC = (LAS float*)(lds + 131072);
  const int j0 = ctx_out ? 0 : 2, nj = 18 - j0;
  const unsigned ldsb = (unsigned)(size_t)lds;
  auto issue_c = [&](int u) {
    const int bh_ = u / nj, j_ = j0 + u % nj, b_ = bh_ >> 2, hd_ = bh_ & 3;
#pragma unroll
    for (int n = 0; n < 8; ++n) {
      const int ii2 = wid * 8 + n, dd = ii2 >> 5, ch = (ii2 & 31) >> 1, rh = ii2 & 1;
      const int ccd = dd ? (j_ < 2 ? 1 - j_ : 19 - j_) : j_;
      if (ccd > 0) {
        const bf16_t* src = p.Cbf + ((size_t)(b_ * 8 + hd_ * 2 + dd) * 18 + ccd) * 16384 + (size_t)(rh * 64 + lane) * 128 + ch * 8;
        glds16(src, (unsigned)__builtin_amdgcn_readfirstlane(ldsb + 65536 + dd * 32768 + ch * 2048 + rh * 1024));
      }
    }
  };
  bool cpre = false;
  for (int unit = lbid(); unit < 32 * nj; unit += lgdim()) {
    const int bh = unit / nj, j = j0 + unit % nj, b = bh >> 2, hd = bh & 3;
    const int row0 = (j < 2) ? NL + b * 256 + j * 128 : b * 2048 + (j - 2) * 128;
    const int cc = dir ? (j < 2 ? 1 - j : 19 - j) : j;
    const int chain = b * 8 + hd * 2 + dir;
    __syncthreads();
#pragma unroll
    for (int n = 0; n < 4; ++n) {
      const int ii = wid * 4 + n;
      { const int ch = ii >> 1, rh = ii & 1;
        const bf16_t* src = p.km + (size_t)(row0 + rh * 64 + lane) * 512 + hd * 128 + ch * 8;
        __builtin_amdgcn_global_load_lds((const unsigned*)src, (LAS unsigned*)(lds + ch * 2048 + rh * 1024), 16, 0, 0); }
      { const int qd = ii >> 3, rg = ii & 7;
        const bf16_t* src = p.proj + (size_t)(row0 + rg * 16 + (lane >> 2)) * PROJW + 1792 + hd * 128 + qd * 32 + (lane & 3) * 8;
        __builtin_amdgcn_global_load_lds((const unsigned*)src, (LAS unsigned*)(lds + 32768 + qd * 8192 + rg * 1024), 16, 0, 0); }
    }
    if (!cpre) issue_c(unit);
    const int trow = row0 + tb * 32 + r32;
    bf16x8 qf[8];
#pragma unroll
    for (int ks = 0; ks < 8; ++ks) qf[ks] = *(const bf16x8*)(p.qm + (size_t)trow * 512 + hd * 128 + ks * 16 + hi * 8);
    const float MIN2 = p.cMIN[chain * 18 + cc];
    const float R2 = -fmaxf(MIN2, p.gsR[(size_t)trow * 8 + dir * 4 + hd]), BQ2 = p.gsB[(size_t)trow * 8 + dir * 4 + hd];
    f32x16 acc[4];
#pragma unroll
    for (int eb = 0; eb < 4; ++eb)
#pragma unroll
      for (int r = 0; r < 16; ++r) acc[eb][r] = 0.f;
    float nq = 0.f;
    if (cc > 0) {
      const float* nvp = p.NVb + ((size_t)chain * 18 + cc) * 128 + hi * 8;
#pragma unroll
      for (int ks = 0; ks < 8; ++ks) {
        const f32x4 n0 = *(const f32x4*)(nvp + ks * 16), n1 = *(const f32x4*)(nvp + ks * 16 + 4);
        float qv[8];
        unpack8(__builtin_bit_cast(u32x4, qf[ks]), qv);
        nq += n0[0] * qv[0] + n0[1] * qv[1] + n0[2] * qv[2] + n0[3] * qv[3] + n1[0] * qv[4] + n1[1] * qv[5] + n1[2] * qv[6] + n1[3] * qv[7];
      }
      nq = half_swap_add(nq);
    }
    const float* gh = p.g_hnorm + e2 * 512 + hd * 128;
    const bf16_t* obp = p.proj + (size_t)trow * PROJW + 2304 + hd * 128;
    const float winter = __builtin_amdgcn_exp2f(MIN2 + R2);
    if (tid < 256) GC[tid] = p.gsG[(size_t)(row0 + (tid & 127)) * 8 + (tid >> 7) * 4 + hd];
    asm volatile("s_waitcnt vmcnt(0)" ::: "memory");
    __syncthreads();
    if (cc > 0) {
#pragma unroll
      for (int ks = 0; ks < 8; ks += 2) {
        bf16x8 af[2][4];
#pragma unroll
        for (int k2 = 0; k2 < 2; ++k2)
#pragma unroll
          for (int eb = 0; eb < 4; ++eb) af[k2][eb] = *(const LAS bf16x8*)(lds + 65536 + dir * 32768 + (2 * (ks + k2) + hi) * 2048 + (eb * 32 + r32) * 16);
        __builtin_amdgcn_sched_barrier(0);
#pragma unroll
        for (int k2 = 0; k2 < 2; ++k2)
#pragma unroll
          for (int eb = 0; eb < 4; ++eb) acc[eb] = __builtin_amdgcn_mfma_f32_32x32x16_bf16(af[k2][eb], qf[ks + k2], acc[eb], 0, 0, 0);
        __builtin_amdgcn_sched_barrier(0);
      }
#pragma unroll
      for (int eb = 0; eb < 4; ++eb)
#pragma unroll
        for (int r = 0; r < 16; ++r) acc[eb][r] *= winter;
    }
    float sw = 0.f;
    const int sb_lo = dir ? tb : 0, sb_hi = dir ? 3 : tb;
    for (int sb = sb_lo; sb <= sb_hi; ++sb) {
      f32x16 st, st1;
#pragma unroll
      for (int r = 0; r < 16; ++r) { st[r] = 0.f; st1[r] = 0.f; }
      {
        bf16x8 kf[8];
#pragma unroll
        for (int ks = 0; ks < 8; ++ks) kf[ks] = *(const LAS bf16x8*)(lds + (2 * ks + hi) * 2048 + (sb * 32 + r32) * 16);
        __builtin_amdgcn_sched_barrier(0);
#pragma unroll
        for (int ks = 0; ks < 8; ks += 2) {
          st = __builtin_amdgcn_mfma_f32_32x32x16_bf16(kf[ks], qf[ks], st, 0, 0, 0);
          st1 = __builtin_amdgcn_mfma_f32_32x32x16_bf16(kf[ks + 1], qf[ks + 1], st1, 0, 0, 0);
        }
#pragma unroll
        for (int r = 0; r < 16; ++r) st[r] += st1[r];
      }
      const bool diag = (sb == tb);
#pragma unroll
      for (int g4 = 0; g4 < 4; ++g4) {
        const f32x4 gc = *(const LAS f32x4*)(GC + dir * 128 + sb * 32 + 8 * g4 + 4 * hi);
#pragma unroll
        for (int q = 0; q < 4; ++q) {
          const int sl = 8 * g4 + 4 * hi + q;
          float w = __builtin_amdgcn_exp2f(R2 + gc[q]) * st[4 * g4 + q];
          const bool keep = !diag || (dir ? (sl >= r32) : (sl <= r32));
          w = keep ? w : 0.f;
          sw += w;
          st[4 * g4 + q] = w;
        }
      }
      u32x4 p0, p1;
      p0.x = cvt_pk_bf16(st[0], st[1]); p0.y = cvt_pk_bf16(st[2], st[3]); p0.z = cvt_pk_bf16(st[4], st[5]); p0.w = cvt_pk_bf16(st[6], st[7]);
      p1.x = cvt_pk_bf16(st[8], st[9]); p1.y = cvt_pk_bf16(st[10], st[11]); p1.z = cvt_pk_bf16(st[12], st[13]); p1.w = cvt_pk_bf16(st[14], st[15]);
      const bf16x8 pw0 = __builtin_bit_cast(bf16x8, p0), pw1 = __builtin_bit_cast(bf16x8, p1);
      {
        const int rb = sb * 32 + 4 * hi;
        bf16x8 a0[4], a1[4];
#pragma unroll
        for (int eb = 0; eb < 4; ++eb) {
          a0[eb] = cat44(vtr((lds_cptr)(lds + 32768 + trq_addr(lane, eb, rb))), vtr((lds_cptr)(lds + 32768 + trq_addr(lane, eb, rb + 8))));
          a1[eb] = cat44(vtr((lds_cptr)(lds + 32768 + trq_addr(lane, eb, rb + 16))), vtr((lds_cptr)(lds + 32768 + trq_addr(lane, eb, rb + 24))));
        }
        __builtin_amdgcn_sched_barrier(0);
#pragma unroll
        for (int eb = 0; eb < 4; ++eb) acc[eb] = __builtin_amdgcn_mfma_f32_32x32x16_bf16(a0[eb], pw0, acc[eb], 0, 0, 0);
#pragma unroll
        for (int eb = 0; eb < 4; ++eb) acc[eb] = __builtin_amdgcn_mfma_f32_32x32x16_bf16(a1[eb], pw1, acc[eb], 0, 0, 0);
      }
    }
    sw = half_swap_add(sw);
    const float den = winter * nq + sw;
    const float dn = fmaxf(fabsf(den), __builtin_amdgcn_exp2f(R2 - BQ2));
    const float idn = 1.f / dn;
    __syncthreads();
    cpre = (unit + lgdim() < 32 * nj);
    if (cpre) issue_c(unit + lgdim());
    if (dir == 1) {
#pragma unroll
      for (int eb = 0; eb < 4; ++eb)
#pragma unroll
        for (int r = 0; r < 16; ++r) HX[(tb * 128 + eb * 32 + (r & 3) + 8 * (r >> 2) + 4 * hi) * 32 + r32] = acc[eb][r] * idn;
    }
    LDS_BARRIER();
    if (dir == 0) {
      float ss = 0.f;
#pragma unroll
      for (int eb = 0; eb < 4; ++eb)
#pragma unroll
        for (int r = 0; r < 16; ++r) {
          const float v = acc[eb][r] * idn + HX[(tb * 128 + eb * 32 + (r & 3) + 8 * (r >> 2) + 4 * hi) * 32 + r32];
          acc[eb][r] = v; ss += v * v;
        }
      ss = half_swap_add(ss);
      const float inv = rsqrtf(ss * (1.f / 128.f) + EPS);
      bf16_t* op = p.mix + (size_t)trow * 1024 + 512 + hd * 128;
#pragma unroll
      for (int eb = 0; eb < 4; ++eb) {
        f32x4 gv[4]; u32x2 ow[4];
#pragma unroll
        for (int g4 = 0; g4 < 4; ++g4) { const int e0 = eb * 32 + 8 * g4 + 4 * hi; gv[g4] = *(const f32x4*)(gh + e0); ow[g4] = *(const u32x2*)(obp + e0); }
#pragma unroll
        for (int g4 = 0; g4 < 4; ++g4) {
          const int e0 = eb * 32 + 8 * g4 + 4 * hi;
          const float ob0 = __uint_as_float(ow[g4].x << 16), ob1 = __uint_as_float(ow[g4].x & 0xffff0000u), ob2 = __uint_as_float(ow[g4].y << 16), ob3 = __uint_as_float(ow[g4].y & 0xffff0000u);
          const float v0 = acc[eb][4 * g4 + 0] * inv * gv[g4][0] * sigmoid_fast(ob0), v1 = acc[eb][4 * g4 + 1] * inv * gv[g4][1] * sigmoid_fast(ob1);
          const float v2 = acc[eb][4 * g4 + 2] * inv * gv[g4][2] * sigmoid_fast(ob2), v3 = acc[eb][4 * g4 + 3] * inv * gv[g4][3] * sigmoid_fast(ob3);
          u32x2 w; w.x = cvt_pk_bf16(v0, v1); w.y = cvt_pk_bf16(v2, v3);
          *(u32x2*)(op + e0) = w;
        }
      }
    }
  }
  __syncthreads();
}

template <int EPL>
__device__ __forceinline__ void topk_column(const Params& p, const float* col, int e, int base, int cap, size_t mbase, int lane) {
  unsigned v[EPL];
#pragma unroll
  for (int k = 0; k < EPL; ++k) v[k] = __float_as_uint(col[k * 64 + lane]);
  unsigned thr = 0u;
  for (int bit = 30; bit >= 0; --bit) {
    const unsigned cand = thr | (1u << bit);
    unsigned cl = 0;
#pragma unroll
    for (int k = 0; k < EPL; ++k) cl += (v[k] - cand) >> 31;
    unsigned clt = 0;
#pragma unroll
    for (int b2 = 0; b2 < 6; ++b2) clt += (unsigned)__popcll(__ballot(((cl >> b2) & 1u) != 0u)) << b2;
    const unsigned c = 64u * EPL - clt;
    if (c >= (unsigned)cap) thr = cand;
  }
  unsigned totgt = 0;
#pragma unroll
  for (int k = 0; k < EPL; ++k) totgt += (unsigned)__popcll(__ballot(v[k] > thr));
  const unsigned need_eq = (unsigned)cap - totgt;
  unsigned cg = 0, ce = 0;
#pragma unroll
  for (int k = 0; k < EPL; ++k) {
    const bool gt = v[k] > thr, eq = v[k] == thr;
    const unsigned long long bg = __ballot(gt), be = __ballot(eq);
    const unsigned gtb = cg + __builtin_amdgcn_mbcnt_hi((unsigned)(bg >> 32), __builtin_amdgcn_mbcnt_lo((unsigned)bg, 0u));
    const unsigned eqb = ce + __builtin_amdgcn_mbcnt_hi((unsigned)(be >> 32), __builtin_amdgcn_mbcnt_lo((unsigned)be, 0u));
    const bool take = gt || (eq && eqb < need_eq);
    const int r = base + k * 64 + lane;
    const unsigned slot = gtb + (eqb < need_eq ? eqb : need_eq);
    if (take) { p.slotmap[(size_t)r * 16 + e] = (int)slot; p.rowidx[mbase + slot] = r; p.gatev[mbase + slot] = __uint_as_float(v[k]); }
    else p.slotmap[(size_t)r * 16 + e] = -1;
    cg += (unsigned)__popcll(bg); ce += (unsigned)__popcll(be);
  }
}
__device__ __forceinline__ void ph_topk(const Params& p, bool ctx, float* sm) {
  const int tid = ltid(), lane = tid & 63, wv = tid >> 6;
  const int ntask = ctx ? 32 : 16;
  for (int task = lbid(); task < ntask; task += lgdim()) {
    const bool lat = task < 16;
    const int b = (task >> 1) & 7, eh = task & 1, n = lat ? 2048 : 256, cap = lat ? 256 : 32, base = lat ? b * 2048 : NL + b * 256;
    __syncthreads();
    for (int idx0 = tid; idx0 < n * 2; idx0 += 8 * NTHR) {
      float4 a[8];
#pragma unroll
      for (int u = 0; u < 8; ++u) { const int idx = min(idx0 + u * NTHR, n * 2 - 1); a[u] = *(const float4*)(p.aff + (size_t)(base + (idx >> 1)) * 16 + eh * 8 + (idx & 1) * 4); }
      __builtin_amdgcn_sched_barrier(0);
#pragma unroll
      for (int u = 0; u < 8; ++u) {
        const int idx = idx0 + u * NTHR, row = idx >> 1, q = idx & 1;
        if (idx < n * 2) { sm[(q * 4 + 0) * n + row] = a[u].x; sm[(q * 4 + 1) * n + row] = a[u].y; sm[(q * 4 + 2) * n + row] = a[u].z; sm[(q * 4 + 3) * n + row] = a[u].w; }
      }
    }
    __syncthreads();
    {
      const int e = eh * 8 + wv;
      if (lat) topk_column<32>(p, sm + wv * n, e, base, cap, (size_t)e * 2048 + (size_t)b * 256, lane);
      else topk_column<4>(p, sm + wv * n, e, base, cap, (size_t)MOE_L + (size_t)e * 256 + (size_t)b * 32, lane);
    }
  }
  __syncthreads();
}

template <int W>
__device__ __forceinline__ void pool_item(const Params& p, int r, int c8) {
  int t, n;
  if (r < NL) { t = r & 2047; n = 2048; } else { t = (r - NL) & 255; n = 256; }
  constexpr int lo = W / 2;
  const bf16_t* up = p.proj + (size_t)r * 1024 + c8;
  u32x4 raw[W];
  int cnt = 0;
#pragma unroll
  for (int k = 0; k < W; ++k) {
    const int tt = t - lo + k;
    const bool ok = tt >= 0 && tt < n;
    const int tc = tt < 0 ? 0 : (tt >= n ? n - 1 : tt);
    const u32x4 ld = *(const u32x4*)(up + (ptrdiff_t)(tc - t) * 1024);
    raw[k].x = ok ? ld.x : 0u; raw[k].y = ok ? ld.y : 0u; raw[k].z = ok ? ld.z : 0u; raw[k].w = ok ? ld.w : 0u;
    cnt += ok ? 1 : 0;
  }
  float s8[8], f[8], uc[8];
#pragma unroll
  for (int j = 0; j < 8; ++j) s8[j] = 0.f;
#pragma unroll
  for (int k = 0; k < W; ++k) {
    unpack8(raw[k], f);
#pragma unroll
    for (int j = 0; j < 8; ++j) s8[j] += f[j];
  }
  unpack8(raw[lo], uc);
  const float ic = __builtin_amdgcn_rcpf((float)cnt);
#pragma unroll
  for (int j = 0; j < 8; ++j) f[j] = s8[j] * ic - uc[j];
  *(u32x4*)(p.mix + (size_t)r * 1024 + c8) = pack8(f);
}
__device__ __forceinline__ void ph_pool(const Params& p, int nrows) {
  const size_t gtid = (size_t)lbid() * NTHR + ltid(), gsz = (size_t)lgdim() * NTHR;
  const unsigned nr32 = (unsigned)nrows * 32u;
  for (size_t it = gtid; it < (size_t)nrows * 128; it += gsz) {
    const unsigned itu = (unsigned)it;
    const int g = (itu >= nr32 ? 1 : 0) + (itu >= 2u * nr32 ? 1 : 0) + (itu >= 3u * nr32 ? 1 : 0);
    const unsigned rem = itu - (unsigned)g * nr32;
    const int r = (int)(rem >> 5), c8 = g * 256 + (int)(rem & 31u) * 8;
    if (g == 0) pool_item<2>(p, r, c8);
    else if (g == 1) pool_item<4>(p, r, c8);
    else if (g == 2) pool_item<8>(p, r, c8);
    else pool_item<16>(p, r, c8);
  }
}

enum { PH_INIT = 0, PH_NORM1, PH_GEMM_IN_EVEN, PH_POST_EVEN, PH_ATT, PH_MLSTM_U, PH_MLSTM_SCAN, PH_MLSTM_H, PH_GEMM_OUT, PH_NORM2, PH_TOPK, PH_GATHER,
       PH_MOE_GU, PH_MOE_D, PH_GEMM_IN_ODD, PH_POOL, PH_GEMM_GRP, PH_FINAL };

typedef const __attribute__((address_space(4))) Params* KParams;
__device__ __forceinline__ const Params& get_params() {
  KParams kp = (KParams)__builtin_amdgcn_kernarg_segment_ptr();
  asm volatile("" : "+s"(kp));
  return *(const Params*)kp;
}
__device__ __forceinline__ int idle_slots(int nu, int G, int c) {
  const int mx = (nu + G - 1) / G, mine = c < nu ? (nu - c + G - 1) / G : 0;
  return mx - mine;
}
__device__ __forceinline__ void run_phase(int ph, int l, unsigned char* shm) {
  const Params& p = get_params();
  float* sm = (float*)shm;
  LAS unsigned char* lds = (LAS unsigned char*)shm;
  const bool ctx_next = (l < 2);
  const bool ctx_used = (l < 3);
  const int G = lgdim(), c = lbid();
  switch (ph) {
    case PH_INIT: ph_init(p, sm); break;
    case PH_NORM1: {
      const int ncomb = (l == 0) ? 0 : ((l - 1) < 2 ? NT : NL);
      ph_norm(p, l, 1, ctx_used ? NT : NL, ncomb, l - 1, sm);
    } break;
    case PH_GEMM_IN_EVEN: {
      g8::SchedDense S{(const char*)p.hbuf, (const char*)(p.WinE + (size_t)(l >> 1) * PROJW * 1024), 1024, 1024, NT / 256, PROJW / 256, 0, G, c};
      g8::EpiBf16 E{p.proj, PROJW};
      g8::gemm_phase(lds, 1024, 1024, 1024, S, E);
      conv_quota(p, idle_slots(S.nM * S.nN, G, c) * 5, sm);
    } break;
    case PH_POST_EVEN: ph_post_even(p, l, sm); break;
    case PH_ATT: ph_att(p, ctx_next, lds); ph_mlstm_uscan(p, lds); conv_quota(p, idle_slots(256 + (ctx_next ? 32 : 0), G, c) * 1, sm); break;
    case PH_MLSTM_H: ph_mlstm_h(p, l, ctx_next, lds); conv_quota(p, idle_slots(32 * (ctx_next ? 18 : 16), G, c) * 3, sm); break;
    case PH_GEMM_OUT: {
      g8::SchedDense S{(const char*)p.mix, (const char*)(p.WoutE + (size_t)(l >> 1) * 1024 * 1024), 1024, 1024, (ctx_next ? NT : NL) / 256, 4, 0, G, c};
      g8::EpiBf16 E{p.ybuf, 1024};
      g8::gemm_phase(lds, 1024, 1024, 1024, S, E);
      conv_quota(p, idle_slots(S.nM * S.nN, G, c) * 5, sm);
    } break;
    case PH_NORM2: ph_norm(p, l, 2, ctx_next ? NT : NL, 0, 0, sm); break;
    case PH_TOPK:
      ph_topk(p, ctx_next, sm);
      conv_until(p, l == 0 ? CE4 : (l == 1 ? CE7 : (l == 2 ? CE10 : CE11)), sm);
      if (l < 3 && c >= (ctx_next ? 32 : 16)) conv_quota(p, 3, sm);
      break;
    case PH_MOE_GU: {
      g8::SchedMoe S{(const char*)p.Xs, (const char*)(p.Wgu + (size_t)l * NEXP * 2048 * 1024), 8, 2048, 128, ctx_next ? 1152 : 1024, G, c};
      g8::EpiSwiGLU E{p.Abuf};
      g8::gemm_phase<true>(lds, 1024, 1024, 1024, S, E, p.rowidx, (const char*)p.hbuf);
      conv_quota(p, idle_slots(S.nu, G, c) * 6, sm);
    } break;
    case PH_MOE_D: {
      g8::SchedMoe S{(const char*)p.Abuf, (const char*)(p.Wd + (size_t)l * NEXP * 1024 * 1024), 4, 1024, 256, ctx_next ? 576 : 512, G, c};
      g8::EpiDown E{p.Ybuf, p.gatev};
      g8::gemm_phase(lds, 1024, 1024, 1024, S, E);
      conv_quota(p, idle_slots(S.nu, G, c) * 6, sm);
    } break;
    case PH_GEMM_IN_ODD: {
      g8::SchedDense S{(const char*)p.hbuf, (const char*)(p.WinO + (size_t)(l >> 1) * 1024 * 1024), 1024, 1024, (ctx_next ? NT : NL) / 256, 4, 0, G, c};
      g8::EpiBf16 E{p.proj, 1024};
      g8::gemm_phase(lds, 1024, 1024, 1024, S, E);
      conv_quota(p, idle_slots(S.nM * S.nN, G, c) * 5, sm);
    } break;
    case PH_POOL: ph_pool(p, ctx_next ? NT : NL); break;
    case PH_GEMM_GRP: {
      g8::SchedDense S{(const char*)p.mix, (const char*)(p.Wgrp + (size_t)(l >> 1) * 1024 * 256), 1024, 256, (ctx_next ? NT : NL) / 256, 4, 512, G, c};
      g8::EpiBf16 E{p.ybuf, 1024};
      g8::gemm_phase(lds, 256, 1024, 256, S, E);
      conv_quota(p, idle_slots(S.nM * S.nN, G, c) * 1, sm);
    } break;
    case PH_FINAL: ph_norm(p, 3, 3, NL, NL, 3, sm); break;
  }
}

__global__ void __launch_bounds__(NTHR) mega_kernel(Params p) {
  extern __shared__ __attribute__((aligned(16))) unsigned char shm[];
  cg::grid_group grid = cg::this_grid();
  volatile LAS unsigned* st = (volatile LAS unsigned*)((LAS unsigned char*)shm + g8::STAGE_BYTES + 1536);
  if (threadIdx.x < 2) st[threadIdx.x] = 0u;
  __syncthreads();
  unsigned* barw;
  { const Params& q = get_params(); barw = q.barw; }
  const XcdBarrier xb = xcd_barrier_post(barw, st);
  const int nprog = p.nprog;
  for (int i = 0; i < nprog; ++i) {
    int ph, l;
    { const Params& q = get_params(); ph = q.prog_ph[i]; l = q.prog_l[i]; }
    run_phase(ph, l, shm);
    if (i + 1 < nprog) { if (nprog > 1000) grid.sync(); else xcd_barrier(xb); }
  }
}

extern "C" void kernel_launch(void* const* d_in, const int* in_sizes, int n_in, void* d_out, int out_size, void* d_ws, size_t ws_size,
                              hipStream_t stream) {
  Params p{};
  const float* const* in = (const float* const*)d_in;
  p.x = in[0]; p.c = in[1]; p.ctx = in[2]; p.c_ctx = in[3]; p.w_mod = in[4]; p.b_mod = in[5]; p.g_norm1 = in[6]; p.g_norm2 = in[7];
  p.w_in_even = in[8]; p.w_out_even = in[9]; p.g_qnorm = in[10]; p.g_knorm = in[11]; p.w_conv = in[12]; p.b_gate = in[13];
  p.g_hnorm = in[14]; p.w_in_odd = in[15]; p.w_pool_grp = in[16]; p.s_pool = in[17]; p.w_router = in[18]; p.w_exp_gate = in[19];
  p.w_exp_up = in[20]; p.w_exp_down = in[21]; p.g_final = in[22];
  p.out = (float*)d_out;
  char* w = (char*)d_ws;
  size_t off = 0;
  auto take = [&](size_t bytes) { char* r = w + off; off += (bytes + 255) & ~(size_t)255; return (void*)r; };
  p.xcur = (bf16_t*)take((size_t)NT * 1024 * 2);
  p.mod = (float*)take(4 * 9 * 6144 * 4);
  p.hbuf = (bf16_t*)take((size_t)NT * 1024 * 2);
  p.Ybuf = (bf16_t*)take((size_t)MOE_T * 1024 * 2);
  p.gatev = (float*)take(MOE_T * 4);
  p.rowidx = (int*)take(MOE_T * 4);
  p.slotmap = (int*)take((size_t)NT * 16 * 4);
  p.barw = (unsigned*)take(XCD_BAR_WORDS * 4);
  p.aff = (float*)take((size_t)NT * 16 * 4);
  p.gates = (float*)take((size_t)NT * 16 * 4);
  p.WinE = (bf16_t*)take((size_t)2 * PROJW * 1024 * 2);
  p.WoutE = (bf16_t*)take((size_t)2 * 1024 * 1024 * 2);
  p.WinO = (bf16_t*)take((size_t)2 * 1024 * 1024 * 2);
  p.Wgrp = (bf16_t*)take((size_t)2 * 1024 * 256 * 2);
  p.Wgu = (bf16_t*)take((size_t)4 * NEXP * 2048 * 1024 * 2);
  p.Wd = (bf16_t*)take((size_t)4 * NEXP * 1024 * 1024 * 2);
  const size_t uoff = off;
  p.proj = (bf16_t*)take((size_t)NT * PROJW * 2);
  p.Qb = (bf16_t*)take((size_t)NT * 512 * 2);
  p.Kb = (bf16_t*)take((size_t)NB * 2 * 2304 * 64 * 2);
  p.Vb = (bf16_t*)take((size_t)NB * 2 * 2304 * 64 * 2);
  p.qm = (bf16_t*)take((size_t)NT * 512 * 2);
  p.km = (bf16_t*)take((size_t)NT * 512 * 2);
  p.gsG = (float*)take((size_t)NT * 8 * 4);
  p.gsR = (float*)take((size_t)NT * 8 * 4);
  p.gsB = (float*)take((size_t)NT * 8 * 4);
  p.cMIN = (float*)take(64 * 18 * 4);
  p.cBE = (float*)take(64 * 18 * 4);
  p.cGM = (float*)take(64 * 18 * 4);
  p.NVb = (float*)take((size_t)64 * 18 * 128 * 4);
  p.Cbf = (bf16_t*)take((size_t)64 * 18 * 16384 * 2);
  p.mix = (bf16_t*)take((size_t)NT * 1024 * 2);
  p.ybuf = (bf16_t*)take((size_t)NT * 1024 * 2);
  const size_t uend = off;
  off = uoff;
  p.Xs = (bf16_t*)take((size_t)MOE_T * 1024 * 2);
  p.Abuf = (bf16_t*)take((size_t)MOE_T * 1024 * 2);
  if (off < uend) off = uend;
  if (off > ws_size) { fprintf(stderr, "ws too small: need %zu have %zu\n", off, ws_size); return; }

  int n = 0;
  auto add = [&](int ph, int l) { p.prog_ph[n] = (unsigned char)ph; p.prog_l[n] = (unsigned char)l; ++n; };
  add(PH_INIT, 0);
  for (int l = 0; l < 4; ++l) {
    add(PH_NORM1, l);
    if ((l & 1) == 0) {
      add(PH_GEMM_IN_EVEN, l); add(PH_POST_EVEN, l); add(PH_ATT, l); add(PH_MLSTM_H, l); add(PH_GEMM_OUT, l);
    } else {
      add(PH_GEMM_IN_ODD, l); add(PH_POOL, l); add(PH_GEMM_GRP, l);
    }
    add(PH_NORM2, l); add(PH_TOPK, l); add(PH_MOE_GU, l); add(PH_MOE_D, l);
  }
  add(PH_FINAL, 0);
  p.nprog = n;

  const int LDS = 143360;
  static int grid_blocks = 0;
  if (!grid_blocks) {
    (void)hipFuncSetAttribute((const void*)mega_kernel, hipFuncAttributeMaxDynamicSharedMemorySize, LDS);
    int dev = 0, cus = 0, per_cu = 0;
    (void)hipGetDevice(&dev);
    (void)hipDeviceGetAttribute(&cus, hipDeviceAttributeMultiprocessorCount, dev);
    (void)hipOccupancyMaxActiveBlocksPerMultiprocessor(&per_cu, mega_kernel, NTHR, LDS);
    if (per_cu < 1) per_cu = 1;
    if (per_cu > 1) per_cu = 1;
    grid_blocks = cus * per_cu;
  }
  (void)hipMemsetAsync(p.barw, 0, XCD_BAR_WORDS * 4, stream);
  void* args[] = {&p};
  hipError_t e = hipLaunchCooperativeKernel((void*)mega_kernel, dim3(grid_blocks), dim3(NTHR), args, LDS, stream);
  if (e != hipSuccess) fprintf(stderr, "cooperative launch failed: %s (grid %d)\n", hipGetErrorString(e), grid_blocks);
}
```
